# Optimizing an MI355X kernel written in HIP

```python
import jax, jax.numpy as jnp
from jax import lax
import numpy as np

D_MODEL = 2048
BATCH = 4
SEQ = 4096
DEPTH = 2

GRID_W = 64
CTX_LEN = 256
ROPE_THETA = 10000.0
NORM_EPS = 1e-6
Q_BLOCK = 128

GLA_HEADS = 4
GLA_DK = 64
GLA_DV = 128
GLA_GATE_RANK = 16
GLA_TAU = 16.0
GLA_CHUNK = 64

MLA_HEADS = 6
MLA_Q_RANK = 384
MLA_KV_RANK = 512
MLA_NOPE = 128
MLA_ROPE = 64
MLA_DV = 128

GQA_HEADS = 6
GQA_KV_HEADS = 2
GQA_DH = 128

MIX_WIDTH = GLA_HEADS * GLA_DV + MLA_HEADS * MLA_DV + GQA_HEADS * GQA_DH

IN_SIZES = (
    GLA_HEADS * GLA_DK,
    GLA_HEADS * GLA_DK,
    GLA_HEADS * GLA_DV,
    GLA_HEADS * GLA_DV,
    GLA_GATE_RANK,
    GLA_GATE_RANK,
    MLA_Q_RANK,
    MLA_KV_RANK,
    MLA_ROPE,
    GQA_HEADS * GQA_DH,
    GQA_KV_HEADS * GQA_DH,
    GQA_KV_HEADS * GQA_DH,
)
IN_WIDTH = sum(IN_SIZES)

N_EXPERTS = 64
TOP_K = 8
N_GROUPS = 8
TOPK_GROUPS = 4
D_EXPERT = 512
D_SHARED = 512
ROUTED_SCALE = 2.5
MOE_BLOCK = 256

kernel_name = "hybrid_gla_mla_gqa_moe_dit_block"


def _rmsnorm(x, g):
    xf = x.astype(jnp.float32)
    y = xf * lax.rsqrt(jnp.mean(xf * xf, axis=-1, keepdims=True) + NORM_EPS)
    return (y * g.astype(jnp.float32)).astype(x.dtype)


def _grid_positions(n_tokens):
    rows_count = n_tokens // GRID_W
    rows = jnp.repeat(jnp.arange(rows_count, dtype=jnp.int32), GRID_W)
    cols = jnp.tile(jnp.arange(GRID_W, dtype=jnp.int32), rows_count)
    return rows, cols


def _axial_rope(x, rows, cols):
    d = x.shape[-1]
    half = d // 2
    inv = ROPE_THETA ** (-jnp.arange(0, half, 2, dtype=jnp.float32) / half)
    xf = x.astype(jnp.float32)

    def rot(xa, p):
        ang = p.astype(jnp.float32)[:, None] * inv[None, :]
        cos = jnp.cos(ang)[None, :, None, :]
        sin = jnp.sin(ang)[None, :, None, :]
        x1, x2 = jnp.split(xa, 2, axis=-1)
        return jnp.concatenate([x1 * cos - x2 * sin, x2 * cos + x1 * sin], axis=-1)

    out = jnp.concatenate([rot(xf[..., :half], rows), rot(xf[..., half:], cols)], axis=-1)
    return out.astype(x.dtype)


def _block_attention(q, k, v, scale):
    B, Sq, Hk, G, Dk = q.shape
    nb = Sq // Q_BLOCK
    qb = jnp.moveaxis(q.reshape(B, nb, Q_BLOCK, Hk, G, Dk), 1, 0)

    def attend(qi):
        s = jnp.einsum('bqhgd,bkhd->bhgqk', qi, k, preferred_element_type=jnp.float32) * scale
        p = jax.nn.softmax(s, axis=-1)
        return jnp.einsum('bhgqk,bkhd->bqhgd', p.astype(v.dtype), v)

    o = lax.map(attend, qb)
    return jnp.moveaxis(o, 0, 1).reshape(B, Sq, Hk, G, v.shape[-1])


def _gla_chunked(q, k, v, la, s0):
    B, H, T, _ = q.shape
    dv = v.shape[-1]
    nc = T // GLA_CHUNK
    shp = lambda t: t.reshape(B, H, nc, GLA_CHUNK, t.shape[-1])
    q, k, v, la = shp(q), shp(k), shp(v), shp(la)
    b = jnp.cumsum(la, axis=3)
    b_last = b[:, :, :, -1:, :]
    q_dec = q * jnp.exp(b)
    k_inv = k * jnp.exp(-b)
    k_end = k * jnp.exp(b_last - b)
    mask = jnp.tril(jnp.ones((GLA_CHUNK, GLA_CHUNK), dtype=bool))
    att = jnp.where(mask, jnp.einsum('bhcld,bhcmd->bhclm', q_dec, k_inv), 0.0)
    o_intra = jnp.einsum('bhclm,bhcmv->bhclv', att, v)
    ds = jnp.einsum('bhcld,bhclv->bhcdv', k_end, v)
    decay = jnp.exp(b_last[:, :, :, 0, :])

    def step(s, inp):
        dc, dsc = inp
        return dc[..., None] * s + dsc, s

    s_fin, s_prev = lax.scan(step, s0, (jnp.moveaxis(decay, 2, 0), jnp.moveaxis(ds, 2, 0)))
    o_inter = jnp.einsum('bhcld,bhcdv->bhclv', q_dec, jnp.moveaxis(s_prev, 0, 2))
    return (o_intra + o_inter).reshape(B, H, T, dv), s_fin


def _gla_dir(q, k, v, la, s0, reverse):
    if reverse:
        fl = lambda t: jnp.flip(t, axis=2)
        o, s = _gla_chunked(fl(q), fl(k), fl(v), fl(la), s0)
        return fl(o), s
    return _gla_chunked(q, k, v, la, s0)


def _gla_stream(gq, gk, gv, gzf, gzb, wg2_f, bg_f, wg2_b, bg_b):
    B, S, _ = gq.shape
    heads = lambda t, d: t.reshape(B, S, GLA_HEADS, d).transpose(0, 2, 1, 3).astype(jnp.float32)
    q = heads(gq, GLA_DK) * (GLA_DK ** -0.5)
    k = heads(gk, GLA_DK)
    v = heads(gv, GLA_DV)
    la_f = heads(jax.nn.log_sigmoid((gzf @ wg2_f + bg_f).astype(jnp.float32)) / GLA_TAU, GLA_DK)
    la_b = heads(jax.nn.log_sigmoid((gzb @ wg2_b + bg_b).astype(jnp.float32)) / GLA_TAU, GLA_DK)
    return q, k, v, la_f, la_b


def _gla_out(o, gr, g_out):
    B, H, S, dv = o.shape
    o = _rmsnorm(o.transpose(0, 2, 1, 3), g_out).reshape(B, S, H * dv)
    return (o * jax.nn.silu(gr.astype(jnp.float32))).astype(gr.dtype)


def _gla_mixer(lat, ctx, wg2_f, bg_f, wg2_b, bg_b, g_out):
    ql, kl, vl, lfl, lbl = _gla_stream(lat[0], lat[1], lat[2], lat[4], lat[5], wg2_f, bg_f, wg2_b, bg_b)
    qc, kc, vc, lfc, lbc = _gla_stream(ctx[0], ctx[1], ctx[2], ctx[4], ctx[5], wg2_f, bg_f, wg2_b, bg_b)
    B = ql.shape[0]
    s0 = jnp.zeros((B, GLA_HEADS, GLA_DK, GLA_DV), jnp.float32)
    oc_f, sc_f = _gla_dir(qc, kc, vc, lfc, s0, False)
    oc_b, sc_b = _gla_dir(qc, kc, vc, lbc, s0, True)
    ol_f, _ = _gla_dir(ql, kl, vl, lfl, sc_f, False)
    ol_b, _ = _gla_dir(ql, kl, vl, lbl, sc_b, True)
    return _gla_out(ol_f + ol_b, lat[3], g_out), _gla_out(oc_f + oc_b, ctx[3], g_out)


def _mla_stream(cq, ckv, kr, g_q, w_uq, g_kv, w_ukv, pos):
    B, S, _ = cq.shape
    q = (_rmsnorm(cq, g_q) @ w_uq).reshape(B, S, MLA_HEADS, MLA_NOPE + MLA_ROPE)
    kv = (_rmsnorm(ckv, g_kv) @ w_ukv).reshape(B, S, MLA_HEADS, MLA_NOPE + MLA_DV)
    q_nope, q_rope = q[..., :MLA_NOPE], q[..., MLA_NOPE:]
    k_nope, v = kv[..., :MLA_NOPE], kv[..., MLA_NOPE:]
    k_rope = kr.reshape(B, S, 1, MLA_ROPE)
    if pos is not None:
        q_rope = _axial_rope(q_rope, pos[0], pos[1])
        k_rope = _axial_rope(k_rope, pos[0], pos[1])
    q = jnp.concatenate([q_nope, q_rope], axis=-1)
    k = jnp.concatenate([k_nope, jnp.broadcast_to(k_rope, (B, S, MLA_HEADS, MLA_ROPE))], axis=-1)
    return q, k, v


def _mla_mixer(lat, ctx, g_q, w_uq, g_kv, w_ukv, pos, want_ctx):
    ql, kl, vl = _mla_stream(lat[0], lat[1], lat[2], g_q, w_uq, g_kv, w_ukv, pos)
    qc, kc, vc = _mla_stream(ctx[0], ctx[1], ctx[2], g_q, w_uq, g_kv, w_ukv, None)
    scale = (MLA_NOPE + MLA_ROPE) ** -0.5
    B, S = ql.shape[:2]
    k_all = jnp.concatenate([kc, kl], axis=1)
    v_all = jnp.concatenate([vc, vl], axis=1)
    out_l = _block_attention(ql[:, :, :, None, :], k_all, v_all, scale).reshape(B, S, MLA_HEADS * MLA_DV)
    out_c = None
    if want_ctx:
        out_c = _block_attention(qc[:, :, :, None, :], kc, vc, scale).reshape(B, qc.shape[1], MLA_HEADS * MLA_DV)
    return out_l, out_c


def _gqa_stream(aq, ak, av, g_q, g_k, pos):
    B, S, _ = aq.shape
    q = _rmsnorm(aq.reshape(B, S, GQA_HEADS, GQA_DH), g_q)
    k = _rmsnorm(ak.reshape(B, S, GQA_KV_HEADS, GQA_DH), g_k)
    v = av.reshape(B, S, GQA_KV_HEADS, GQA_DH)
    if pos is not None:
        q = _axial_rope(q, pos[0], pos[1])
        k = _axial_rope(k, pos[0], pos[1])
    return q.reshape(B, S, GQA_KV_HEADS, GQA_HEADS // GQA_KV_HEADS, GQA_DH), k, v


def _gqa_mixer(lat, ctx, g_q, g_k, pos, want_ctx):
    ql, kl, vl = _gqa_stream(lat[0], lat[1], lat[2], g_q, g_k, pos)
    qc, kc, vc = _gqa_stream(ctx[0], ctx[1], ctx[2], g_q, g_k, None)
    scale = GQA_DH ** -0.5
    B, S = ql.shape[:2]
    out_l = _block_attention(ql, jnp.concatenate([kc, kl], axis=1),
                             jnp.concatenate([vc, vl], axis=1), scale).reshape(B, S, GQA_HEADS * GQA_DH)
    out_c = None
    if want_ctx:
        out_c = _block_attention(qc, kc, vc, scale).reshape(B, qc.shape[1], GQA_HEADS * GQA_DH)
    return out_l, out_c


def _swiglu(x, w1, w3, w2):
    return (jax.nn.silu(x @ w1) * (x @ w3)) @ w2


def _routed_experts(x, eidx, wts, w1, w3, w2):
    N, D = x.shape
    E = w1.shape[0]
    A = N * TOP_K
    flat_e = eidx.reshape(-1)
    flat_t = jnp.repeat(jnp.arange(N, dtype=jnp.int32), TOP_K)
    flat_w = wts.reshape(-1)
    order = jnp.argsort(flat_e)
    se = flat_e[order]
    counts = jnp.bincount(flat_e, length=E)
    padded = ((counts + MOE_BLOCK - 1) // MOE_BLOCK) * MOE_BLOCK
    pend = jnp.cumsum(padded)
    pstart = pend - padded
    sstart = jnp.cumsum(counts) - counts
    dest = pstart[se] + (jnp.arange(A, dtype=jnp.int32) - sstart[se])
    n_blocks = -(-A // MOE_BLOCK) + E
    P = n_blocks * MOE_BLOCK
    buf_t = jnp.full((P,), N, jnp.int32).at[dest].set(flat_t[order])
    buf_w = jnp.zeros((P,), jnp.float32).at[dest].set(flat_w[order])
    block_e = jnp.minimum(jnp.searchsorted(pend, jnp.arange(n_blocks) * MOE_BLOCK, side='right'), E - 1)
    x_pad = jnp.concatenate([x, jnp.zeros((1, D), x.dtype)], axis=0)

    def step(acc, blk):
        t, wb, e = blk
        xb = x_pad[t]
        yb = _swiglu(xb, w1[e], w3[e], w2[e]).astype(jnp.float32) * wb[:, None]
        return acc.at[t].add(yb), None

    acc0 = jnp.zeros((N + 1, D), jnp.float32)
    acc, _ = lax.scan(step, acc0, (buf_t.reshape(n_blocks, MOE_BLOCK),
                                   buf_w.reshape(n_blocks, MOE_BLOCK), block_e))
    return acc[:N].astype(x.dtype)


def _moe(x, router_w, router_b, w1, w3, w2, s1, s3, s2):
    N = x.shape[0]
    scores = jax.nn.sigmoid((x @ router_w).astype(jnp.float32))
    sel = scores + router_b.astype(jnp.float32)
    grp = sel.reshape(N, N_GROUPS, N_EXPERTS // N_GROUPS)
    grp_score = lax.top_k(grp, 2)[0].sum(-1)
    _, gidx = lax.top_k(grp_score, TOPK_GROUPS)
    gmask = jax.nn.one_hot(gidx, N_GROUPS).sum(axis=1) > 0
    emask = jnp.repeat(gmask, N_EXPERTS // N_GROUPS, axis=1)
    _, eidx = lax.top_k(jnp.where(emask, sel, -jnp.inf), TOP_K)
    w = jnp.take_along_axis(scores, eidx, axis=1)
    w = w / jnp.sum(w, axis=-1, keepdims=True) * ROUTED_SCALE
    return _routed_experts(x, eidx, w, w1, w3, w2) + _swiglu(x, s1, s3, s2)


def _modulation(cvec, w_mod, b_mod):
    return jnp.split(jax.nn.silu(cvec) @ w_mod + b_mod, 6, axis=-1)


def _adaln(x, g, shift, scale):
    return _rmsnorm(x, g) * (1.0 + scale) + shift


def _layer(x, xc, c, c_ctx, pos, want_ctx, w_mod, b_mod, g_pre_mix, g_post_mix, g_pre_ffn,
           g_post_ffn, w_in, gla_wg2_f, gla_bg_f, gla_wg2_b, gla_bg_b, gla_g_out, mla_g_q,
           mla_w_uq, mla_g_kv, mla_w_ukv, gqa_g_q, gqa_g_k, w_out, router_w, router_b,
           exp_w1, exp_w3, exp_w2, sh_w1, sh_w3, sh_w2):
    B, S, D = x.shape
    sh_m, sc_m, gt_m, sh_f, sc_f, gt_f = [m[:, None, :] for m in _modulation(c, w_mod, b_mod)]
    csh_m, csc_m, cgt_m, csh_f, csc_f, cgt_f = _modulation(c_ctx, w_mod, b_mod)
    offs = np.cumsum(IN_SIZES)[:-1]

    pl = jnp.split(_adaln(x, g_pre_mix, sh_m, sc_m) @ w_in, offs, axis=-1)
    pc = jnp.split(_adaln(xc, g_pre_mix, csh_m, csc_m) @ w_in, offs, axis=-1)
    gla_l, gla_c = _gla_mixer(pl[0:6], pc[0:6], gla_wg2_f, gla_bg_f, gla_wg2_b, gla_bg_b, gla_g_out)
    mla_l, mla_c = _mla_mixer(pl[6:9], pc[6:9], mla_g_q, mla_w_uq, mla_g_kv, mla_w_ukv, pos, want_ctx)
    gqa_l, gqa_c = _gqa_mixer(pl[9:12], pc[9:12], gqa_g_q, gqa_g_k, pos, want_ctx)
    y = jnp.concatenate([gla_l, mla_l, gqa_l], axis=-1) @ w_out
    x = x + gt_m * _rmsnorm(y, g_post_mix)

    if want_ctx:
        yc = jnp.concatenate([gla_c, mla_c, gqa_c], axis=-1) @ w_out
        xc = xc + cgt_m * _rmsnorm(yc, g_post_mix)
        hf = _adaln(x, g_pre_ffn, sh_f, sc_f).reshape(-1, D)
        hfc = _adaln(xc, g_pre_ffn, csh_f, csc_f).reshape(-1, D)
        yf = _moe(jnp.concatenate([hf, hfc], axis=0), router_w, router_b,
                  exp_w1, exp_w3, exp_w2, sh_w1, sh_w3, sh_w2)
        x = x + gt_f * _rmsnorm(yf[:B * S].reshape(B, S, D), g_post_ffn)
        xc = xc + cgt_f * _rmsnorm(yf[B * S:].reshape(xc.shape), g_post_ffn)
    else:
        hf = _adaln(x, g_pre_ffn, sh_f, sc_f).reshape(-1, D)
        yf = _moe(hf, router_w, router_b, exp_w1, exp_w3, exp_w2, sh_w1, sh_w3, sh_w2)
        x = x + gt_f * _rmsnorm(yf.reshape(B, S, D), g_post_ffn)
    return x, xc


def setup_inputs(seed: int = 0) -> dict:
    key = jax.random.key(seed)
    ks = iter(jax.random.split(key, 40))
    L, D = DEPTH, D_MODEL

    def nrm(shape, scale):
        return jax.random.normal(next(ks), shape, jnp.float32) * scale

    def gain(n):
        return 1.0 + nrm((L, n), 0.02)

    return {
        "x": nrm((BATCH, SEQ, D), 1.0),
        "c": nrm((BATCH, D), 1.0),
        "ctx": nrm((BATCH, CTX_LEN, D), 1.0),
        "c_ctx": nrm((D,), 1.0),
        "w_mod": nrm((L, D, 6 * D), 0.5 * D ** -0.5),
        "b_mod": nrm((L, 6 * D), 0.02),
        "g_pre_mix": gain(D),
        "g_post_mix": gain(D),
        "g_pre_ffn": gain(D),
        "g_post_ffn": gain(D),
        "w_in": nrm((L, D, IN_WIDTH), D ** -0.5),
        "gla_wg2_f": nrm((L, GLA_GATE_RANK, GLA_HEADS * GLA_DK), GLA_GATE_RANK ** -0.5),
        "gla_bg_f": nrm((L, GLA_HEADS * GLA_DK), 0.1),
        "gla_wg2_b": nrm((L, GLA_GATE_RANK, GLA_HEADS * GLA_DK), GLA_GATE_RANK ** -0.5),
        "gla_bg_b": nrm((L, GLA_HEADS * GLA_DK), 0.1),
        "gla_g_out": gain(GLA_DV),
        "mla_g_q": gain(MLA_Q_RANK),
        "mla_w_uq": nrm((L, MLA_Q_RANK, MLA_HEADS * (MLA_NOPE + MLA_ROPE)), MLA_Q_RANK ** -0.5),
        "mla_g_kv": gain(MLA_KV_RANK),
        "mla_w_ukv": nrm((L, MLA_KV_RANK, MLA_HEADS * (MLA_NOPE + MLA_DV)), MLA_KV_RANK ** -0.5),
        "gqa_g_q": gain(GQA_DH),
        "gqa_g_k": gain(GQA_DH),
        "w_out": nrm((L, MIX_WIDTH, D), MIX_WIDTH ** -0.5),
        "router_w": nrm((L, D, N_EXPERTS), D ** -0.5),
        "router_b": nrm((L, N_EXPERTS), 0.01),
        "exp_w1": nrm((L, N_EXPERTS, D, D_EXPERT), D ** -0.5),
        "exp_w3": nrm((L, N_EXPERTS, D, D_EXPERT), D ** -0.5),
        "exp_w2": nrm((L, N_EXPERTS, D_EXPERT, D), D_EXPERT ** -0.5),
        "sh_w1": nrm((L, D, D_SHARED), D ** -0.5),
        "sh_w3": nrm((L, D, D_SHARED), D ** -0.5),
        "sh_w2": nrm((L, D_SHARED, D), D_SHARED ** -0.5),
    }


def reference(x, c, ctx, c_ctx, w_mod, b_mod, g_pre_mix, g_post_mix, g_pre_ffn, g_post_ffn,
              w_in, gla_wg2_f, gla_bg_f, gla_wg2_b, gla_bg_b, gla_g_out, mla_g_q, mla_w_uq,
              mla_g_kv, mla_w_ukv, gqa_g_q, gqa_g_k, w_out, router_w, router_b,
              exp_w1, exp_w3, exp_w2, sh_w1, sh_w3, sh_w2):
    pos = _grid_positions(x.shape[1])
    xc = ctx
    for i in range(DEPTH):
        x, xc = _layer(x, xc, c, c_ctx, pos, i < DEPTH - 1,
                       w_mod[i], b_mod[i], g_pre_mix[i], g_post_mix[i], g_pre_ffn[i],
                       g_post_ffn[i], w_in[i], gla_wg2_f[i], gla_bg_f[i], gla_wg2_b[i],
                       gla_bg_b[i], gla_g_out[i], mla_g_q[i], mla_w_uq[i], mla_g_kv[i],
                       mla_w_ukv[i], gqa_g_q[i], gqa_g_k[i], w_out[i], router_w[i], router_b[i],
                       exp_w1[i], exp_w3[i], exp_w2[i], sh_w1[i], sh_w3[i], sh_w2[i])
    return x
```

```cpp
#include <hip/hip_runtime.h>
#include <stdint.h>
#include <stdio.h>

#ifndef PH_MASK
#define PH_MASK 0x1FFF
#endif
#ifndef SUB
#define SUB 7
#endif
#ifndef ATT_SD_M
#define ATT_SD_M 1
#endif
#ifndef ATT_SD_G
#define ATT_SD_G 2
#endif
#ifndef ATT_NQR_M
#define ATT_NQR_M 4
#endif
#ifndef MK_MULTI
#define MK_MULTI 0
#endif

typedef unsigned short bf16_t;
typedef short bf16x8 __attribute__((ext_vector_type(8)));
typedef short s16x4 __attribute__((ext_vector_type(4)));
typedef float f32x4 __attribute__((ext_vector_type(4)));
typedef float f32x16 __attribute__((ext_vector_type(16)));
typedef unsigned u32x4 __attribute__((ext_vector_type(4)));
typedef unsigned u32x2 __attribute__((ext_vector_type(2)));
#define DI __device__ __forceinline__

constexpr int D = 2048, NB = 4, SEQ = 4096, CTXL = 256, NLAT = NB * SEQ, NCTX = NB * CTXL, NTOK = NLAT + NCTX, SKV = SEQ + CTXL;
constexpr int INW = 3808, INWP = 3840;
constexpr int C_GQ = 0, C_GK = 256, C_GV = 512, C_GG = 1024, C_ZF = 1536, C_ZB = 1552, C_CQ = 1568, C_CKV = 1952, C_KR = 2464, C_AQ = 2528, C_AK = 3296, C_AV = 3552;
constexpr int NE = 64, TOPK = 8, DEXP = 512;
constexpr int PMAX = NTOK * TOPK + NE * 256;
constexpr int NTHREADS = 512;
constexpr float EPS = 1e-6f;

constexpr size_t MiB = 1024ull * 1024ull;
constexpr size_t al256(size_t x) { return (x + 255) / 256 * 256; }
constexpr size_t WS_BAR = 0;
constexpr size_t WS_CNT = 16384;
constexpr size_t WS_META = WS_CNT + 1024;
constexpr size_t WS_MOD = WS_META + 2 * 4096;
constexpr size_t WS_ROPEG = al256(WS_MOD + 2 * 5 * 12288 * 4);
constexpr size_t WS_ROPEM = WS_ROPEG + 64 * 32 * 8;
constexpr size_t WS_ZROW = WS_ROPEM + 64 * 16 * 8;
constexpr size_t WS_GDEC = WS_ZROW + 4096;
constexpr size_t WS_EIDX = al256(WS_GDEC + 2 * 16 * 68 * 64 * 4);
constexpr size_t WS_EW = WS_EIDX + (size_t)NTOK * 8 * 4;
constexpr size_t WS_EPOS = WS_EW + (size_t)NTOK * 8 * 4;
constexpr size_t WS_SASG = WS_EPOS + (size_t)NTOK * 8 * 4;
constexpr size_t WS_SW = al256(WS_SASG + (size_t)PMAX * 4);
constexpr size_t WS_SMALL_END = al256(WS_SW + (size_t)PMAX * 4);
static_assert(WS_SMALL_END <= 8 * MiB, "small region");
constexpr size_t SZ_WIN = (size_t)INWP * D * 2, SZ_WUQ = (size_t)1280 * 384 * 2, SZ_WUKV = (size_t)1536 * 512 * 2, SZ_WOUT = (size_t)D * D * 2, SZ_WR = (size_t)64 * D * 2;
constexpr size_t SZ_W13 = (size_t)65 * 1024 * D * 2, SZ_W2 = (size_t)65 * D * 512 * 2;
constexpr size_t WL_WIN = 0, WL_WUQ = WL_WIN + SZ_WIN, WL_WUKV = WL_WUQ + SZ_WUQ, WL_WOUT = WL_WUKV + SZ_WUKV, WL_WRH = WL_WOUT + SZ_WOUT, WL_WRL = WL_WRH + SZ_WR,
                 WL_W13 = WL_WRL + SZ_WR, WL_W2 = WL_W13 + SZ_W13, WL_END = WL_W2 + SZ_W2;
constexpr size_t WS_WEIGHTS = 8 * MiB;
constexpr size_t WS_XRES = WS_WEIGHTS + 2 * WL_END;
constexpr size_t WS_HBUF = WS_XRES + (size_t)NTOK * D * 4;
constexpr size_t WS_U = WS_HBUF + (size_t)NTOK * D * 2;
constexpr size_t U_Y = 0;
constexpr size_t U_PROJ = U_Y + (size_t)NTOK * D * 4;
constexpr size_t U_QM = U_PROJ + (size_t)NTOK * INWP * 2;
constexpr size_t U_KM = U_QM + (size_t)NB * 6 * SKV * 192 * 2;
constexpr size_t U_VM = U_KM + (size_t)NB * 6 * SKV * 192 * 2;
constexpr size_t U_QG = U_VM + (size_t)NB * 6 * SKV * 128 * 2;
constexpr size_t U_KG = U_QG + (size_t)NB * 6 * SKV * 128 * 2;
constexpr size_t U_VG = U_KG + (size_t)NB * 2 * SKV * 128 * 2;
constexpr size_t U_GS = U_VG + (size_t)NB * 2 * SKV * 128 * 2;
constexpr size_t U_MIX = U_GS + (size_t)2 * 16 * 68 * 64 * 128 * 4;
constexpr size_t U_CQN = U_MIX + (size_t)NTOK * D * 2;
constexpr size_t U_CKVN = U_CQN + (size_t)NTOK * 384 * 2;
constexpr size_t U_MIX_END = U_CKVN + (size_t)NTOK * 512 * 2;
constexpr size_t U_HLO = U_PROJ;
constexpr size_t U_ACT = U_HLO + (size_t)NTOK * D * 2;
constexpr size_t U_OASG = U_ACT + (size_t)(PMAX + NTOK) * 512 * 2;
constexpr size_t U_MOE_END = U_OASG + (size_t)NTOK * 8 * D * 2;
constexpr size_t WS_TOTAL = WS_U + (U_MIX_END > U_MOE_END ? U_MIX_END : U_MOE_END);
static_assert(WS_TOTAL <= 2048ull * MiB, "workspace over 2 GiB");

struct Params {
    const float *x, *c, *ctx, *c_ctx, *w_mod, *b_mod, *g_pre_mix, *g_post_mix, *g_pre_ffn, *g_post_ffn, *w_in, *gla_wg2_f, *gla_bg_f, *gla_wg2_b, *gla_bg_b, *gla_g_out,
        *mla_g_q, *mla_w_uq, *mla_g_kv, *mla_w_ukv, *gqa_g_q, *gqa_g_k, *w_out, *router_w, *router_b, *exp_w1, *exp_w3, *exp_w2, *sh_w1, *sh_w3, *sh_w2;
    float* out; unsigned char* ws;
};

#define CAS __attribute__((address_space(4)))
typedef const CAS Params& PR;
DI int tid_here() { int t = threadIdx.x; asm volatile("" : "+v"(t)); return t; }
DI float bf2f(bf16_t v) { return __uint_as_float(((unsigned)v) << 16); }
DI bf16_t f2bf(float f) { unsigned u = __float_as_uint(f); u += 0x7FFFu + ((u >> 16) & 1u); return (bf16_t)(u >> 16); }
DI unsigned pk2(float lo, float hi) { return (unsigned)f2bf(lo) | ((unsigned)f2bf(hi) << 16); }
DI float shx(float v, int o, int lane) { return __int_as_float(__builtin_amdgcn_ds_bpermute((lane ^ o) << 2, __float_as_int(v))); }
DI float wave_sum(float v) {
    const int lane = tid_here() & 63;
#pragma unroll
    for (int o = 32; o > 0; o >>= 1) v += shx(v, o, lane);
    return v;
}
DI float silu_f(float v) { return v / (1.f + __expf(-v)); }
DI float sigmoid_f(float v) { return 1.f / (1.f + __expf(-v)); }
struct Tok { int b, s, isctx, mrow, kvpos; };
DI Tok tok_of(int r) { Tok t; if (r < NLAT) { t.b = r >> 12; t.s = r & 4095; t.isctx = 0; t.mrow = t.b; t.kvpos = CTXL + t.s; } else { const int q = r - NLAT; t.b = q >> 8; t.s = q & 255; t.isctx = 1; t.mrow = 4; t.kvpos = t.s; } return t; }
DI const float* xrow_in(PR p, int l, int r) { if (l == 0) return r < NLAT ? p.x + (size_t)r * D : p.ctx + (size_t)(r - NLAT) * D; return (const float*)(p.ws + WS_XRES) + (size_t)r * D; }

#define XB_TMO      128
#define XB_XCNT(j)  (256  + 64 * (j))
#define XB_XSUB(j)  (1280 + 64 * (j))
#define XB_XGEN(j)  (2304 + 64 * (j))
#define XB_TOP      3328
#define XB_TOPGEN   3392
#define XCD_BAR_WORDS 3456
#define XB_SPIN_CAP (1u << 18)
#define LAS __attribute__((address_space(3)))
__device__ __forceinline__ unsigned xb_ld(unsigned* p)              { return __hip_atomic_load(p, __ATOMIC_RELAXED, __HIP_MEMORY_SCOPE_AGENT); }
__device__ __forceinline__ unsigned xb_add(unsigned* p, unsigned v) { return __hip_atomic_fetch_add(p, v, __ATOMIC_RELAXED, __HIP_MEMORY_SCOPE_AGENT); }
__device__ __forceinline__ unsigned xb_xcc_id() { return (unsigned)__builtin_amdgcn_s_getreg((3 << 11) | 20) & 0xFu; }
#define XB_SPIN(cond, bar) do { unsigned _sp = 0; while (cond) { __builtin_amdgcn_s_sleep(1); \
    if ((++_sp & 255u) == 0u) { if (xb_ld(&(bar)[XB_TMO])) break; if (_sp > XB_SPIN_CAP) { atomicAdd(&(bar)[XB_TMO], 1u); break; } } } } while (0)
struct XcdBarrier { unsigned* bar; unsigned x; volatile LAS unsigned* st; };
__device__ __forceinline__ XcdBarrier xcd_barrier_post(unsigned* bar, volatile LAS unsigned* st) {
    XcdBarrier b; b.bar = bar; b.x = xb_xcc_id(); b.st = st;
    if (threadIdx.x == 0) (void)xb_add(&bar[XB_XCNT(b.x)], 1u);
    return b;
}
__device__ __forceinline__ void xcd_barrier_complete(unsigned* bar, unsigned x, unsigned& nloc, unsigned& nx) {
    const unsigned G = gridDim.x * gridDim.y * gridDim.z;
    unsigned sum, cnt, mine, sp = 0u;
    for (;;) {
        sum = 0u; cnt = 0u; mine = 0u;
#pragma unroll
        for (unsigned j = 0; j < 16; ++j) { const unsigned c = xb_ld(&bar[XB_XCNT(j)]); sum += c; cnt += (c > 0u) ? 1u : 0u; mine = (j == x) ? c : mine; }
        if (sum == G) break;
        __builtin_amdgcn_s_sleep(1);
        if ((++sp & 255u) == 0u) { if (xb_ld(&bar[XB_TMO])) break; if (sp > XB_SPIN_CAP) { atomicAdd(&bar[XB_TMO], 1u); break; } }
    }
    nloc = mine > 0u ? mine : 1u; nx = cnt > 0u ? cnt : 1u;
}
__device__ __forceinline__ void xcd_barrier(const XcdBarrier& b) {
    asm volatile("s_waitcnt vmcnt(0)" ::: "memory");
    __syncthreads();
    if (threadIdx.x == 0) {
        unsigned* bar = b.bar;
        __builtin_amdgcn_s_waitcnt(0);
        unsigned nloc = b.st[0], nx = b.st[1];
        if (nloc == 0u) { xcd_barrier_complete(bar, b.x, nloc, nx); b.st[0] = nloc; b.st[1] = nx; }
        const unsigned old = xb_add(&bar[XB_XSUB(b.x)], 1u);
        const unsigned gen = old / nloc;
        if (old + 1u == (gen + 1u) * nloc) {
            __builtin_amdgcn_fence(__ATOMIC_RELEASE, "agent");
            asm volatile("s_waitcnt vmcnt(0)" ::: "memory");
            const unsigned og = xb_add(&bar[XB_TOP], 1u);
            const unsigned tg = og / nx;
            if (og + 1u == (tg + 1u) * nx) xb_add(&bar[XB_TOPGEN], 1u);
            else XB_SPIN(xb_ld(&bar[XB_TOPGEN]) == tg, bar);
            __builtin_amdgcn_fence(__ATOMIC_ACQUIRE, "agent");
            xb_add(&bar[XB_XGEN(b.x)], 1u);
            asm volatile("s_waitcnt vmcnt(0)" ::: "memory");
        } else {
            XB_SPIN(xb_ld(&bar[XB_XGEN(b.x)]) == gen, bar);
            __builtin_amdgcn_fence(__ATOMIC_ACQUIRE, "agent");
            asm volatile("s_waitcnt vmcnt(0)" ::: "memory");
        }
    }
    __syncthreads();
}

DI void cvt_tile(char* lds, const float* src, int ldS, int Nvalid, bf16_t* dst, bf16_t* dst_lo, int ldD, int k0, int n0, int drow0, const float* gk) {
    float* T = (float*)lds;
    const int tid = tid_here();
    {
        const int c4 = tid & 15, kr = tid >> 4;
#pragma unroll
        for (int i = 0; i < 2; ++i) {
            const int k = kr + 32 * i, n = n0 + c4 * 4;
            f32x4 v = {0.f, 0.f, 0.f, 0.f};
            if (n < Nvalid) v = *(const f32x4*)(src + (size_t)(k0 + k) * ldS + n);
            if (gk) { const float g = gk[k0 + k]; v = v * g; }
            T[k * 65 + c4 * 4 + 0] = v[0]; T[k * 65 + c4 * 4 + 1] = v[1]; T[k * 65 + c4 * 4 + 2] = v[2]; T[k * 65 + c4 * 4 + 3] = v[3];
        }
    }
    __syncthreads();
    {
        const int nl = tid >> 3, kc = (tid & 7) * 8;
        float v[8];
#pragma unroll
        for (int j = 0; j < 8; ++j) v[j] = T[(kc + j) * 65 + nl];
        u32x4 w; w.x = pk2(v[0], v[1]); w.y = pk2(v[2], v[3]); w.z = pk2(v[4], v[5]); w.w = pk2(v[6], v[7]);
        *(u32x4*)(dst + (size_t)(drow0 + nl) * ldD + k0 + kc) = w;
        if (dst_lo) {
            float r[8];
#pragma unroll
            for (int j = 0; j < 8; ++j) r[j] = v[j] - bf2f(f2bf(v[j]));
            u32x4 w2; w2.x = pk2(r[0], r[1]); w2.y = pk2(r[2], r[3]); w2.z = pk2(r[4], r[5]); w2.w = pk2(r[6], r[7]);
            *(u32x4*)(dst_lo + (size_t)(drow0 + nl) * ldD + k0 + kc) = w2;
        }
    }
    __syncthreads();
}
DI void cvt_matrix(char* lds, const float* src, int K, int N, int Npad, bf16_t* dst, bf16_t* dst_lo, int mode, const float* gk) {
    const int nkt = K / 64, nnt = Npad / 64, nt = nkt * nnt;
    for (int t = blockIdx.x; t < nt; t += gridDim.x) {
        const int kt = t % nkt, ntile = t / nkt, n0 = ntile * 64;
        int drow0 = n0;
        if (mode == 1) drow0 = (n0 >> 7) * 256 + (n0 & 127);
        else if (mode == 2) drow0 = (n0 >> 7) * 256 + 128 + (n0 & 127);
        cvt_tile(lds, src, N, N, dst, dst_lo, K, kt * 64, n0, drow0, gk);
    }
}
DI void phase_prologue(PR p, char* lds) {
    const int tid = tid_here();
    unsigned char* ws = p.ws;
    if (blockIdx.x == 0) {
        unsigned* cnt = (unsigned*)(ws + WS_CNT);
        if (tid < 128) cnt[tid] = 0u;
        unsigned* z = (unsigned*)(ws + WS_ZROW);
        for (int i = tid; i < 1024; i += NTHREADS) z[i] = 0u;
        float2* rg = (float2*)(ws + WS_ROPEG);
        for (int i = tid; i < 64 * 32; i += NTHREADS) { const int pos = i >> 5, f = i & 31; const float inv = powf(10000.f, -(float)(2 * f) / 64.f); float s, c; sincosf((float)pos * inv, &s, &c); rg[i] = make_float2(c, s); }
        float2* rm = (float2*)(ws + WS_ROPEM);
        for (int i = tid; i < 64 * 16; i += NTHREADS) { const int pos = i >> 4, f = i & 15; const float inv = powf(10000.f, -(float)(2 * f) / 32.f); float s, c; sincosf((float)pos * inv, &s, &c); rm[i] = make_float2(c, s); }
    }
    {
        float* sc = (float*)lds;
        float* red = sc + 5 * 2048;
        bool loaded = false;
        for (int u = blockIdx.x; u < 192; u += gridDim.x) {
            if (!loaded) { for (int i = tid; i < 5 * 2048; i += NTHREADS) { const int r = i >> 11, k = i & 2047; const float v = r < 4 ? p.c[r * 2048 + k] : p.c_ctx[k]; sc[i] = silu_f(v); } loaded = true; __syncthreads(); }
            const int l = u / 96, col0 = (u % 96) * 128;
            const int cg = tid & 31, kp = tid >> 5;
            f32x4 acc[5];
#pragma unroll
            for (int r = 0; r < 5; ++r) acc[r] = (f32x4){0.f, 0.f, 0.f, 0.f};
            const float* wb = p.w_mod + ((size_t)l * 2048) * 12288 + col0 + cg * 4;
            for (int kk = 0; kk < 128; ++kk) {
                const int k = kp * 128 + kk;
                const f32x4 w = *(const f32x4*)(wb + (size_t)k * 12288);
#pragma unroll
                for (int r = 0; r < 5; ++r) acc[r] += w * sc[r * 2048 + k];
            }
#pragma unroll
            for (int r = 0; r < 5; ++r)
#pragma unroll
                for (int j = 0; j < 4; ++j) red[(kp * 5 + r) * 128 + cg * 4 + j] = acc[r][j];
            __syncthreads();
            for (int i = tid; i < 640; i += NTHREADS) {
                const int r = i >> 7, cc = i & 127; float s = p.b_mod[l * 12288 + col0 + cc];
#pragma unroll
                for (int q = 0; q < 16; ++q) s += red[(q * 5 + r) * 128 + cc];
                ((float*)(ws + WS_MOD))[((size_t)l * 5 + r) * 12288 + col0 + cc] = s;
            }
            __syncthreads();
        }
        __syncthreads();
    }
    for (int l = 0; l < 2; ++l) {
        unsigned char* wl = ws + WS_WEIGHTS + (size_t)l * WL_END;
        cvt_matrix(lds, p.w_in + (size_t)l * D * INW, D, INW, INWP, (bf16_t*)(wl + WL_WIN), nullptr, 0, nullptr);
        cvt_matrix(lds, p.mla_w_uq + (size_t)l * 384 * 1152, 384, 1152, 1280, (bf16_t*)(wl + WL_WUQ), nullptr, 0, p.mla_g_q + l * 384);
        cvt_matrix(lds, p.mla_w_ukv + (size_t)l * 512 * 1536, 512, 1536, 1536, (bf16_t*)(wl + WL_WUKV), nullptr, 0, p.mla_g_kv + l * 512);
        cvt_matrix(lds, p.w_out + (size_t)l * D * D, D, D, D, (bf16_t*)(wl + WL_WOUT), nullptr, 0, nullptr);
        cvt_matrix(lds, p.router_w + (size_t)l * D * 64, D, 64, 64, (bf16_t*)(wl + WL_WRH), (bf16_t*)(wl + WL_WRL), 0, nullptr);
        for (int e = 0; e < 65; ++e) {
            const float* s1 = e < 64 ? p.exp_w1 + ((size_t)l * 64 + e) * D * 512 : p.sh_w1 + (size_t)l * D * 512;
            const float* s3 = e < 64 ? p.exp_w3 + ((size_t)l * 64 + e) * D * 512 : p.sh_w3 + (size_t)l * D * 512;
            const float* s2 = e < 64 ? p.exp_w2 + ((size_t)l * 64 + e) * 512 * D : p.sh_w2 + (size_t)l * 512 * D;
            bf16_t* d13 = (bf16_t*)(wl + WL_W13) + (size_t)e * 1024 * D;
            bf16_t* d2 = (bf16_t*)(wl + WL_W2) + (size_t)e * D * 512;
            cvt_matrix(lds, s1, D, 512, 512, d13, nullptr, 1, nullptr);
            cvt_matrix(lds, s3, D, 512, 512, d13, nullptr, 2, nullptr);
            cvt_matrix(lds, s2, 512, D, D, d2, nullptr, 0, nullptr);
        }
    }
}

DI void load_row(const float* src, f32x4 (&v)[8], int lane) {
#pragma unroll
    for (int i = 0; i < 8; ++i) v[i] = *(const f32x4*)(src + i * 256 + lane * 4);
}
DI float row_sumsq(const f32x4 (&v)[8]) {
    float s = 0.f;
#pragma unroll
    for (int i = 0; i < 8; ++i) s += v[i][0] * v[i][0] + v[i][1] * v[i][1] + v[i][2] * v[i][2] + v[i][3] * v[i][3];
    return wave_sum(s);
}
DI void adaln_store(const f32x4 (&x)[8], const float* g, const float* shift, const float* scale, bf16_t* hi, bf16_t* lo, int lane) {
    const float rstd = rsqrtf(row_sumsq(x) * (1.f / D) + EPS);
#pragma unroll
    for (int i = 0; i < 8; ++i) {
        const int c = i * 256 + lane * 4;
        const f32x4 gg = *(const f32x4*)(g + c), sh = *(const f32x4*)(shift + c), sc = *(const f32x4*)(scale + c);
        f32x4 h;
#pragma unroll
        for (int j = 0; j < 4; ++j) h[j] = x[i][j] * rstd * gg[j] * (1.f + sc[j]) + sh[j];
        u32x2 w; w.x = pk2(h[0], h[1]); w.y = pk2(h[2], h[3]);
        *(u32x2*)(hi + c) = w;
        if (lo) { u32x2 w2; w2.x = pk2(h[0] - bf2f(f2bf(h[0])), h[1] - bf2f(f2bf(h[1]))); w2.y = pk2(h[2] - bf2f(f2bf(h[2])), h[3] - bf2f(f2bf(h[3]))); *(u32x2*)(lo + c) = w2; }
    }
}
DI void phase_norm1(PR p, int l) {
    const int tid_ = tid_here(), lane = tid_ & 63, wid = tid_ >> 6;
    const float* mod = (const float*)(p.ws + WS_MOD) + (size_t)l * 5 * 12288;
    bf16_t* hb = (bf16_t*)(p.ws + WS_HBUF);
    for (int r = blockIdx.x * 8 + wid; r < NTOK; r += gridDim.x * 8) {
        const Tok t = tok_of(r);
        f32x4 x[8]; load_row(xrow_in(p, l, r), x, lane);
        adaln_store(x, p.g_pre_mix + l * D, mod + (size_t)t.mrow * 12288 + 0 * D, mod + (size_t)t.mrow * 12288 + 1 * D, hb + (size_t)r * D, nullptr, lane);
    }
}
DI void phase_postmix(PR p, int l) {
    const int tid_ = tid_here(), lane = tid_ & 63, wid = tid_ >> 6;
    const float* mod = (const float*)(p.ws + WS_MOD) + (size_t)l * 5 * 12288;
    const float* Y = (const float*)(p.ws + WS_U + U_Y);
    float* XR = (float*)(p.ws + WS_XRES);
    bf16_t* hb = (bf16_t*)(p.ws + WS_HBUF); bf16_t* hl = (bf16_t*)(p.ws + WS_U + U_HLO);
    const int nrows = l == 0 ? NTOK : NLAT;
    for (int r = blockIdx.x * 8 + wid; r < nrows; r += gridDim.x * 8) {
        const Tok t = tok_of(r);
        f32x4 x[8], y[8]; load_row(xrow_in(p, l, r), x, lane); load_row(Y + (size_t)r * D, y, lane);
        const float rstd = rsqrtf(row_sumsq(y) * (1.f / D) + EPS);
        const float* gate = mod + (size_t)t.mrow * 12288 + 2 * D; const float* g = p.g_post_mix + l * D;
#pragma unroll
        for (int i = 0; i < 8; ++i) {
            const int c = i * 256 + lane * 4; const f32x4 gg = *(const f32x4*)(g + c), gt = *(const f32x4*)(gate + c);
#pragma unroll
            for (int j = 0; j < 4; ++j) x[i][j] += gt[j] * (y[i][j] * rstd * gg[j]);
            *(f32x4*)(XR + (size_t)r * D + c) = x[i];
        }
        adaln_store(x, p.g_pre_ffn + l * D, mod + (size_t)t.mrow * 12288 + 3 * D, mod + (size_t)t.mrow * 12288 + 4 * D, hb + (size_t)r * D, hl + (size_t)r * D, lane);
    }
}
DI void phase_postffn(PR p, int l) {
    const int tid_ = tid_here(), lane = tid_ & 63, wid = tid_ >> 6;
    const float* mod = (const float*)(p.ws + WS_MOD) + (size_t)l * 5 * 12288;
    const float* YS = (const float*)(p.ws + WS_U + U_Y);
    const bf16_t* OA = (const bf16_t*)(p.ws + WS_U + U_OASG);
    float* XR = (float*)(p.ws + WS_XRES);
    bf16_t* hb = (bf16_t*)(p.ws + WS_HBUF);
    const int nrows = l == 0 ? NTOK : NLAT;
    for (int r = blockIdx.x * 8 + wid; r < nrows; r += gridDim.x * 8) {
        const Tok t = tok_of(r);
        f32x4 x[8], y[8]; load_row((const float*)(p.ws + WS_XRES) + (size_t)r * D, x, lane); load_row(YS + (size_t)r * D, y, lane);
        for (int k = 0; k < 8; ++k) {
            const bf16_t* o = OA + ((size_t)r * 8 + k) * D;
#pragma unroll
            for (int i = 0; i < 8; ++i) { const u32x2 w = *(const u32x2*)(o + i * 256 + lane * 4);
                y[i][0] += __uint_as_float(w.x << 16); y[i][1] += __uint_as_float(w.x & 0xFFFF0000u); y[i][2] += __uint_as_float(w.y << 16); y[i][3] += __uint_as_float(w.y & 0xFFFF0000u); }
        }
        const float rstd = rsqrtf(row_sumsq(y) * (1.f / D) + EPS);
        const float* gate = mod + (size_t)t.mrow * 12288 + 5 * D; const float* g = p.g_post_ffn + l * D;
        float* dstrow = l == 0 ? XR + (size_t)r * D : p.out + (size_t)r * D;
#pragma unroll
        for (int i = 0; i < 8; ++i) {
            const int c = i * 256 + lane * 4; const f32x4 gg = *(const f32x4*)(g + c), gt = *(const f32x4*)(gate + c);
#pragma unroll
            for (int j = 0; j < 4; ++j) x[i][j] += gt[j] * (y[i][j] * rstd * gg[j]);
            *(f32x4*)(dstrow + c) = x[i];
        }
        if (l == 0) {
            const float* mod1 = (const float*)(p.ws + WS_MOD) + (size_t)1 * 5 * 12288;
            adaln_store(x, p.g_pre_mix + 1 * D, mod1 + (size_t)t.mrow * 12288 + 0 * D, mod1 + (size_t)t.mrow * 12288 + 1 * D, hb + (size_t)r * D, nullptr, lane);
        }
    }
}

struct GemmUnit {
    const bf16_t* A; long lda; const int* rows; int rowshift;
    const bf16_t* Bt; long ldb;
    int K;
};
constexpr int GS_LD = 72;
struct LaneId { int wr, wc, fr, fq; };
DI LaneId gemm_kloop_simple(char* lds, const GemmUnit& g, f32x4 (&acc)[2][2][4][2]) {
    int tid = threadIdx.x; asm volatile("" : "+v"(tid));
    const int wid = tid >> 6, lane = tid & 63, wr = wid >> 2, wc = wid & 3, fr = lane & 15, fq = lane >> 4;
    bf16_t* As = (bf16_t*)lds; bf16_t* Bs = As + 256 * GS_LD;
#pragma unroll
    for (int a = 0; a < 2; ++a)
#pragma unroll
        for (int b = 0; b < 2; ++b)
#pragma unroll
            for (int m = 0; m < 4; ++m)
#pragma unroll
                for (int n = 0; n < 2; ++n) acc[a][b][m][n] = (f32x4){0.f, 0.f, 0.f, 0.f};
    const int srow = tid >> 3, skc = (tid & 7) * 8;
    const bf16_t* ap[4]; const bf16_t* bp[4];
#pragma unroll
    for (int i = 0; i < 4; ++i) {
        const int r = srow + 64 * i;
        if (g.rows) { const int idx = g.rows[r]; ap[i] = g.A + (size_t)(idx >= 0 ? (idx >> g.rowshift) : 0) * g.lda + skc; }
        else ap[i] = g.A + (size_t)r * g.lda + skc;
        bp[i] = g.Bt + (size_t)r * g.ldb + skc;
    }
    const int nkt = g.K / 64;
    u32x4 ra[4], rb[4];
#pragma unroll
    for (int i = 0; i < 4; ++i) { ra[i] = *(const u32x4*)(ap[i]); rb[i] = *(const u32x4*)(bp[i]); }
    for (int kt = 0; kt < nkt; ++kt) {
        __syncthreads();
#pragma unroll
        for (int i = 0; i < 4; ++i) { *(u32x4*)(As + (srow + 64 * i) * GS_LD + skc) = ra[i]; *(u32x4*)(Bs + (srow + 64 * i) * GS_LD + skc) = rb[i]; }
        __syncthreads();
        if (kt + 1 < nkt) {
#pragma unroll
            for (int i = 0; i < 4; ++i) { ra[i] = *(const u32x4*)(ap[i] + (kt + 1) * 64); rb[i] = *(const u32x4*)(bp[i] + (kt + 1) * 64); }
        }
#pragma unroll
        for (int kk = 0; kk < 2; ++kk) {
            bf16x8 bf[2][2];
#pragma unroll
            for (int bj = 0; bj < 2; ++bj)
#pragma unroll
                for (int n = 0; n < 2; ++n) bf[bj][n] = *(const bf16x8*)(Bs + (128 * bj + 32 * wc + 16 * n + fr) * GS_LD + kk * 32 + fq * 8);
#pragma unroll
            for (int ai = 0; ai < 2; ++ai)
#pragma unroll
                for (int m = 0; m < 4; ++m) {
                    const bf16x8 af = *(const bf16x8*)(As + (128 * ai + 64 * wr + 16 * m + fr) * GS_LD + kk * 32 + fq * 8);
#pragma unroll
                    for (int bj = 0; bj < 2; ++bj)
#pragma unroll
                        for (int n = 0; n < 2; ++n) acc[ai][bj][m][n] = __builtin_amdgcn_mfma_f32_16x16x32_bf16(bf[bj][n], af, acc[ai][bj][m][n], 0, 0, 0);
                }
        }
    }
    __syncthreads();
    LaneId id; id.wr = wr; id.wc = wc; id.fr = fr; id.fq = fq; return id;
}
#define GEMM_ACC f32x4 acc[2][2][4][2]
#define ACC_FOREACH(...) \
    _Pragma("unroll") for (int ai = 0; ai < 2; ++ai) _Pragma("unroll") for (int m = 0; m < 4; ++m) { const int trow = 128 * ai + 64 * wr + 16 * m + fr; \
    _Pragma("unroll") for (int bj = 0; bj < 2; ++bj) _Pragma("unroll") for (int n = 0; n < 2; ++n) { const int tcol = 128 * bj + 32 * wc + 16 * n + 4 * fq; const f32x4 v = acc[ai][bj][m][n]; __VA_ARGS__ } }

struct EpiProj {
    bf16_t* O; int row0, col0;
    DI void operator()(const f32x4 (&acc)[2][2][4][2], int wr, int wc, int fr, int fq) const {
        ACC_FOREACH({ u32x2 w; w.x = pk2(v[0], v[1]); w.y = pk2(v[2], v[3]); *(u32x2*)(O + (size_t)(row0 + trow) * INWP + col0 + tcol) = w; })
    }
};
struct EpiF32 {
    float* O; int row0, col0, ld;
    DI void operator()(const f32x4 (&acc)[2][2][4][2], int wr, int wc, int fr, int fq) const {
        ACC_FOREACH({ *(f32x4*)(O + (size_t)(row0 + trow) * ld + col0 + tcol) = v; })
    }
};
struct EpiUq {
    bf16_t* Q; const float2* ropem; int row0, col0;
    DI void operator()(const f32x4 (&acc)[2][2][4][2], int wr, int wc, int fr, int fq) const {
#pragma unroll
        for (int ai = 0; ai < 2; ++ai)
#pragma unroll
            for (int m = 0; m < 4; ++m) {
                const int r = row0 + 128 * ai + 64 * wr + 16 * m + fr; const Tok t = tok_of(r);
#pragma unroll
                for (int bj = 0; bj < 2; ++bj) {
                    const int cbase = col0 + 128 * bj + 32 * wc;
                    if (cbase >= 1152) continue;
                    const int h = cbase / 192, jb = cbase % 192;
                    f32x4 v0 = acc[ai][bj][m][0], v1 = acc[ai][bj][m][1];
                    if (jb >= 128 && !t.isctx) {
                        const int pos = (jb == 128) ? (t.s >> 6) : (t.s & 63);
#pragma unroll
                        for (int i = 0; i < 4; ++i) { const float2 cs = ropem[pos * 16 + 4 * fq + i]; const float x1 = v0[i], x2 = v1[i]; v0[i] = x1 * cs.x - x2 * cs.y; v1[i] = x2 * cs.x + x1 * cs.y; }
                    }
                    bf16_t* dst = Q + (((size_t)t.b * 6 + h) * SKV + t.kvpos) * 192 + jb + 4 * fq;
                    u32x2 w0; w0.x = pk2(v0[0], v0[1]); w0.y = pk2(v0[2], v0[3]); *(u32x2*)(dst) = w0;
                    u32x2 w1; w1.x = pk2(v1[0], v1[1]); w1.y = pk2(v1[2], v1[3]); *(u32x2*)(dst + 16) = w1;
                }
            }
    }
};
struct EpiUkv {
    bf16_t* Km; bf16_t* Vm; int row0, col0;
    DI void operator()(const f32x4 (&acc)[2][2][4][2], int wr, int wc, int fr, int fq) const {
        ACC_FOREACH({ const int r = row0 + trow; const Tok t = tok_of(r); const int c = col0 + tcol, h = c >> 8, j = c & 255;
            u32x2 w; w.x = pk2(v[0], v[1]); w.y = pk2(v[2], v[3]);
            if (j < 128) *(u32x2*)(Km + (((size_t)t.b * 6 + h) * SKV + t.kvpos) * 192 + j) = w;
            else *(u32x2*)(Vm + (((size_t)t.b * 6 + h) * SKV + t.kvpos) * 128 + (j - 128)) = w; })
    }
};
struct EpiMoe1 {
    bf16_t* act; int arow0, hcol0;
    DI void operator()(const f32x4 (&acc)[2][2][4][2], int wr, int wc, int fr, int fq) const {
#pragma unroll
        for (int ai = 0; ai < 2; ++ai)
#pragma unroll
            for (int m = 0; m < 4; ++m) {
                const int trow = 128 * ai + 64 * wr + 16 * m + fr;
#pragma unroll
                for (int n = 0; n < 2; ++n) {
                    const f32x4 a = acc[ai][0][m][n], b = acc[ai][1][m][n]; f32x4 h;
#pragma unroll
                    for (int i = 0; i < 4; ++i) h[i] = silu_f(a[i]) * b[i];
                    u32x2 w; w.x = pk2(h[0], h[1]); w.y = pk2(h[2], h[3]);
                    *(u32x2*)(act + (size_t)(arow0 + trow) * 512 + hcol0 + 32 * wc + 16 * n + 4 * fq) = w;
                }
            }
    }
};
struct EpiMoe2 {
    bf16_t* oasg; const int* sasg; const float* sw; int srow0, col0;
    DI void operator()(const f32x4 (&acc)[2][2][4][2], int wr, int wc, int fr, int fq) const {
#pragma unroll
        for (int ai = 0; ai < 2; ++ai)
#pragma unroll
            for (int m = 0; m < 4; ++m) {
                const int trow = 128 * ai + 64 * wr + 16 * m + fr; const int a = sasg[srow0 + trow]; const float wgt = sw[srow0 + trow];
                if (a < 0) continue;
#pragma unroll
                for (int bj = 0; bj < 2; ++bj)
#pragma unroll
                    for (int n = 0; n < 2; ++n) { const f32x4 v = acc[ai][bj][m][n] * wgt; u32x2 w; w.x = pk2(v[0], v[1]); w.y = pk2(v[2], v[3]);
                        *(u32x2*)(oasg + (size_t)a * D + col0 + 128 * bj + 32 * wc + 16 * n + 4 * fq) = w; }
            }
    }
};

DI void phase_postproj_rows(PR p, int l) {
    const int tid_ = tid_here(), lane = tid_ & 63, wid = tid_ >> 6;
    unsigned char* U = p.ws + WS_U;
    const bf16_t* PR = (const bf16_t*)(U + U_PROJ);
    bf16_t* CQN = (bf16_t*)(U + U_CQN); bf16_t* CKVN = (bf16_t*)(U + U_CKVN);
    bf16_t* Km = (bf16_t*)(U + U_KM); bf16_t* Qg = (bf16_t*)(U + U_QG); bf16_t* Kg = (bf16_t*)(U + U_KG); bf16_t* Vg = (bf16_t*)(U + U_VG);
    const float2* ropeg = (const float2*)(p.ws + WS_ROPEG); const float2* ropem = (const float2*)(p.ws + WS_ROPEM);
    const float* gq = p.gqa_g_q + l * 128; const float* gk = p.gqa_g_k + l * 128;
    for (int r = blockIdx.x * 8 + wid; r < NTOK; r += gridDim.x * 8) {
        const Tok t = tok_of(r);
        const bf16_t* pr = PR + (size_t)r * INWP;
        {
            float v[6], ss = 0.f;
#pragma unroll
            for (int i = 0; i < 6; ++i) { v[i] = bf2f(pr[C_CQ + lane + 64 * i]); ss += v[i] * v[i]; }
            const float rstd = rsqrtf(wave_sum(ss) * (1.f / 384.f) + EPS);
#pragma unroll
            for (int i = 0; i < 6; ++i) CQN[(size_t)r * 384 + lane + 64 * i] = f2bf(v[i] * rstd);
        }
        {
            float v[8], ss = 0.f;
#pragma unroll
            for (int i = 0; i < 8; ++i) { v[i] = bf2f(pr[C_CKV + lane + 64 * i]); ss += v[i] * v[i]; }
            const float rstd = rsqrtf(wave_sum(ss) * (1.f / 512.f) + EPS);
#pragma unroll
            for (int i = 0; i < 8; ++i) CKVN[(size_t)r * 512 + lane + 64 * i] = f2bf(v[i] * rstd);
        }
        {
            float x = bf2f(pr[C_KR + lane]);
            const float other = shx(x, 16, lane);
            if (!t.isctx) {
                const int g = lane >> 5, idx = lane & 31, fi = idx & 15; const bool second = idx >= 16;
                const int pos = g == 0 ? (t.s >> 6) : (t.s & 63);
                const float2 cs = ropem[pos * 16 + fi];
                x = second ? x * cs.x + other * cs.y : x * cs.x - other * cs.y;
            }
            const bf16_t xb = f2bf(x);
#pragma unroll
            for (int h = 0; h < 6; ++h) Km[(((size_t)t.b * 6 + h) * SKV + t.kvpos) * 192 + 128 + lane] = xb;
        }
        const int fi = lane & 31; const bool second = lane >= 32;
        float2 cs0 = make_float2(1.f, 0.f), cs1 = make_float2(1.f, 0.f);
        if (!t.isctx) { cs0 = ropeg[(t.s >> 6) * 32 + fi]; cs1 = ropeg[(t.s & 63) * 32 + fi]; }
#pragma unroll
        for (int hh = 0; hh < 8; ++hh) {
            const bool isq = hh < 6; const int h = isq ? hh : hh - 6; const float* g = isq ? gq : gk;
            const int cb = (isq ? C_AQ : C_AK) + h * 128;
            float e0 = bf2f(pr[cb + lane]), e1 = bf2f(pr[cb + 64 + lane]);
            const float rstd = rsqrtf(wave_sum(e0 * e0 + e1 * e1) * (1.f / 128.f) + EPS);
            e0 = e0 * rstd * g[lane]; e1 = e1 * rstd * g[64 + lane];
            const float o0 = shx(e0, 32, lane), o1 = shx(e1, 32, lane);
            const float r0 = second ? e0 * cs0.x + o0 * cs0.y : e0 * cs0.x - o0 * cs0.y;
            const float r1 = second ? e1 * cs1.x + o1 * cs1.y : e1 * cs1.x - o1 * cs1.y;
            bf16_t* dst = isq ? Qg + (((size_t)t.b * 6 + h) * SKV + t.kvpos) * 128 : Kg + (((size_t)t.b * 2 + h) * SKV + t.kvpos) * 128;
            dst[lane] = f2bf(r0); dst[64 + lane] = f2bf(r1);
        }
#pragma unroll
        for (int h = 0; h < 2; ++h) { bf16_t* dst = Vg + (((size_t)t.b * 2 + h) * SKV + t.kvpos) * 128; dst[lane] = pr[C_AV + h * 128 + lane]; dst[64 + lane] = pr[C_AV + h * 128 + 64 + lane]; }
    }
}

constexpr int GL_K = 0, GL_LF = 4160, GL_LB = 8320, GL_ZF = 12480, GL_ZB = 13504, GL_WF = 14528, GL_WB = 15552, GL_V = 16576, GL_X0 = 24768;
constexpr int GL_KEF = GL_X0, GL_KEB = GL_X0 + 4160;
constexpr int GL_Q = GL_X0, GL_QD = GL_X0 + 4160, GL_KI = GL_X0 + 8320, GL_ATT = GL_ZF, GL_RED = GL_X0 + 12480;
DI int gla_row0(int b, int c) { return c < 4 ? NLAT + b * CTXL + c * 64 : b * SEQ + (c - 4) * 64; }
DI void gla_prep(PR p, int l, float* L, int b, int h, int c, bool needq) {
    int tid = threadIdx.x; asm volatile("" : "+v"(tid));
    const bf16_t* PR = (const bf16_t*)(p.ws + WS_U + U_PROJ);
    const int row0 = gla_row0(b, c);
    {
        const int t = tid >> 3, dg = (tid & 7) * 8; const bf16_t* pr = PR + (size_t)(row0 + t) * INWP;
        const bf16x8 kv = *(const bf16x8*)(pr + C_GK + h * 64 + dg);
#pragma unroll
        for (int j = 0; j < 8; ++j) L[GL_K + t * 65 + dg + j] = bf2f((bf16_t)kv[j]);
        if (needq) { const bf16x8 qv = *(const bf16x8*)(pr + C_GQ + h * 64 + dg);
#pragma unroll
            for (int j = 0; j < 8; ++j) L[GL_Q + t * 65 + dg + j] = bf2f((bf16_t)qv[j]) * 0.125f; }
        const int jg = (tid & 7) * 16;
#pragma unroll
        for (int q = 0; q < 2; ++q) { const bf16x8 vv = *(const bf16x8*)(pr + C_GV + h * 128 + jg + 8 * q);
#pragma unroll
            for (int j = 0; j < 8; ++j) L[GL_V + t * 128 + jg + 8 * q + j] = bf2f((bf16_t)vv[j]); }
        if (tid < 256) { const int tt = (tid & 127) >> 1, half = tid & 1, dir = tid >> 7; const bf16x8 zv = *(const bf16x8*)(PR + (size_t)(row0 + tt) * INWP + (dir ? C_ZB : C_ZF) + half * 8);
#pragma unroll
            for (int j = 0; j < 8; ++j) L[(dir ? GL_ZB : GL_ZF) + tt * 16 + half * 8 + j] = bf2f((bf16_t)zv[j]); }
        for (int i = tid; i < 2048; i += NTHREADS) { const int dir = i >> 10, rr = (i >> 6) & 15, d = i & 63;
            L[(dir ? GL_WB : GL_WF) + rr * 64 + d] = (dir ? p.gla_wg2_b : p.gla_wg2_f)[((size_t)l * 16 + rr) * 256 + h * 64 + d]; }
    }
    __syncthreads();
    for (int idx = tid; idx < 8192; idx += NTHREADS) {
        const int dir = idx >> 12, t = (idx >> 6) & 63, d = idx & 63;
        const float* Z = L + (dir ? GL_ZB : GL_ZF) + t * 16; const float* W = L + (dir ? GL_WB : GL_WF) + d;
        float z = (dir ? p.gla_bg_b : p.gla_bg_f)[l * 256 + h * 64 + d];
#pragma unroll
        for (int rr = 0; rr < 16; ++rr) z += Z[rr] * W[rr * 64];
        const float ls = fminf(z, 0.f) - log1pf(expf(-fabsf(z)));
        L[(dir ? GL_LB : GL_LF) + t * 65 + d] = ls * (1.f / 16.f);
    }
    __syncthreads();
    if (tid < 64) { float s = 0.f; for (int t = 0; t < 64; ++t) { s += L[GL_LF + t * 65 + tid]; L[GL_LF + t * 65 + tid] = s; } }
    else if (tid < 128) { const int d = tid - 64; float s = 0.f; for (int t = 63; t >= 0; --t) { s += L[GL_LB + t * 65 + d]; L[GL_LB + t * 65 + d] = s; } }
    __syncthreads();
}
DI void gla_phaseA(PR p, int l, char* lds) {
    float* L = (float*)lds; int tid = threadIdx.x; asm volatile("" : "+v"(tid));
    float* GS = (float*)(p.ws + WS_U + U_GS); float* GD = (float*)(p.ws + WS_GDEC);
    for (int u = blockIdx.x; u < 16 * 68; u += gridDim.x) {
        const int bh = u / 68, c = u % 68, b = bh >> 2, h = bh & 3;
        gla_prep(p, l, L, b, h, c, false);
        for (int idx = tid; idx < 4096; idx += NTHREADS) { const int t = idx >> 6, d = idx & 63; const float k = L[GL_K + t * 65 + d];
            L[GL_KEF + t * 65 + d] = k * expf(L[GL_LF + 63 * 65 + d] - L[GL_LF + t * 65 + d]);
            L[GL_KEB + t * 65 + d] = k * expf(L[GL_LB + 0 * 65 + d] - L[GL_LB + t * 65 + d]); }
        if (tid < 64) GD[((size_t)(0 * 16 + bh) * 68 + c) * 64 + tid] = expf(L[GL_LF + 63 * 65 + tid]);
        else if (tid < 128) GD[((size_t)(1 * 16 + bh) * 68 + c) * 64 + (tid - 64)] = expf(L[GL_LB + 0 * 65 + (tid - 64)]);
        __syncthreads();
        const int j = tid & 127, dq = tid >> 7;
        float af[16], ab[16];
#pragma unroll
        for (int i = 0; i < 16; ++i) { af[i] = 0.f; ab[i] = 0.f; }
        for (int t = 0; t < 64; ++t) { const float vv = L[GL_V + t * 128 + j];
#pragma unroll
            for (int i = 0; i < 16; ++i) { af[i] += L[GL_KEF + t * 65 + dq * 16 + i] * vv; ab[i] += L[GL_KEB + t * 65 + dq * 16 + i] * vv; } }
#pragma unroll
        for (int i = 0; i < 16; ++i) { GS[((size_t)(0 * 16 + bh) * 68 + c) * 8192 + (dq * 16 + i) * 128 + j] = af[i]; GS[((size_t)(1 * 16 + bh) * 68 + c) * 8192 + (dq * 16 + i) * 128 + j] = ab[i]; }
        __syncthreads();
    }
}
DI void gla_scan(PR p) {
    float* GS = (float*)(p.ws + WS_U + U_GS); const float* GD = (const float*)(p.ws + WS_GDEC);
    for (int u = blockIdx.x; u < 512; u += gridDim.x) {
        const int e = u * NTHREADS + tid_here(), db = e >> 13, dj = e & 8191, d = dj >> 7;
        const int dir = db >> 4;
        float S = 0.f;
        for (int i = 0; i < 68; ++i) {
            const int c = dir == 0 ? i : (i < 4 ? 3 - i : 71 - i);
            float* ptr = GS + ((size_t)db * 68 + c) * 8192 + dj;
            const float ds = *ptr, dec = GD[((size_t)db * 68 + c) * 64 + d];
            *ptr = S; S = dec * S + ds;
        }
    }
}
DI void gla_phaseC(PR p, int l, char* lds) {
    float* L = (float*)lds; int tid = threadIdx.x; asm volatile("" : "+v"(tid)); const int wid = tid >> 6;
    const float* GS = (const float*)(p.ws + WS_U + U_GS);
    const bf16_t* PR = (const bf16_t*)(p.ws + WS_U + U_PROJ); bf16_t* MIX = (bf16_t*)(p.ws + WS_U + U_MIX);
    for (int u = blockIdx.x; u < 16 * 68; u += gridDim.x) {
        const int bh = u / 68, c = u % 68, b = bh >> 2, h = bh & 3;
        if (l == 1 && c < 4) continue;
        gla_prep(p, l, L, b, h, c, true);
        const int j = tid & 127, tq = tid >> 7;
        float o[16];
#pragma unroll
        for (int i = 0; i < 16; ++i) o[i] = 0.f;
        for (int dir = 0; dir < 2; ++dir) {
            const float* LC = L + (dir ? GL_LB : GL_LF);
            for (int idx = tid; idx < 4096; idx += NTHREADS) { const int t = idx >> 6, d = idx & 63; const float bc = LC[t * 65 + d];
                L[GL_QD + t * 65 + d] = L[GL_Q + t * 65 + d] * expf(bc); L[GL_KI + t * 65 + d] = L[GL_K + t * 65 + d] * expf(-bc); }
            __syncthreads();
            { const int s = tid & 63, tg = tid >> 6;
                float a[8];
#pragma unroll
                for (int i = 0; i < 8; ++i) a[i] = 0.f;
                for (int d = 0; d < 64; ++d) { const float kv = L[GL_KI + s * 65 + d];
#pragma unroll
                    for (int i = 0; i < 8; ++i) a[i] += L[GL_QD + (tg * 8 + i) * 65 + d] * kv; }
#pragma unroll
                for (int i = 0; i < 8; ++i) { const int t = tg * 8 + i; const bool ok = dir == 0 ? (s <= t) : (s >= t); L[GL_ATT + t * 64 + s] = ok ? a[i] : 0.f; } }
            __syncthreads();
            for (int s = 0; s < 64; ++s) { const float vv = L[GL_V + s * 128 + j];
#pragma unroll
                for (int i = 0; i < 16; ++i) o[i] += L[GL_ATT + (tq * 16 + i) * 64 + s] * vv; }
            const float* Sg = GS + ((size_t)(dir * 16 + bh) * 68 + c) * 8192;
            for (int d = 0; d < 64; ++d) { const float sv = Sg[d * 128 + j];
#pragma unroll
                for (int i = 0; i < 16; ++i) o[i] += L[GL_QD + (tq * 16 + i) * 65 + d] * sv; }
            __syncthreads();
        }
#pragma unroll
        for (int i = 0; i < 16; ++i) { const float ss = wave_sum(o[i] * o[i]); if ((tid & 63) == 0) L[GL_RED + wid * 16 + i] = ss; }
        __syncthreads();
        const int row0 = gla_row0(b, c); const float go = p.gla_g_out[l * 128 + j];
#pragma unroll
        for (int i = 0; i < 16; ++i) {
            const int t = tq * 16 + i; const float tot = L[GL_RED + (2 * tq) * 16 + i] + L[GL_RED + (2 * tq + 1) * 16 + i];
            const float rstd = rsqrtf(tot * (1.f / 128.f) + EPS);
            const float gate = bf2f(PR[(size_t)(row0 + t) * INWP + C_GG + h * 128 + j]);
            MIX[(size_t)(row0 + t) * D + h * 128 + j] = f2bf(o[i] * rstd * go * silu_f(gate));
        }
        __syncthreads();
    }
}

#define SBAR() __builtin_amdgcn_sched_barrier(0)
DI int crow(int r, int hi) { return (r & 3) + 8 * (r >> 2) + 4 * hi; }
DI unsigned cvtpk(float lo, float hi) { unsigned r; asm volatile("v_cvt_pk_bf16_f32 %0, %1, %2" : "=v"(r) : "v"(lo), "v"(hi)); return r; }
constexpr float ATT_THR = 8.f;
template <int DQK> struct AttnCfg {
    static constexpr int KROWB = DQK * 2;
    static constexpr int SHM_V = 64 * 128 * 2, SHM_K = 64 * DQK * 2;
    static constexpr int ND0 = DQK / 16;
    static constexpr int NKCH = DQK / 64;
    static constexpr int NQR = DQK == 128 ? 8 : ATT_NQR_M;
    static constexpr int SHM_Q = 8 * (ND0 - NQR) * 1024;
    static constexpr int SHM_TOTAL = 2 * SHM_V + 2 * SHM_K + 8 * 64 * 4 + SHM_Q;
};
template <int DQK> DI int kswz(int row, int colB) { return row * (DQK * 2) + (colB ^ ((row & 7) << 4)); }
DI void partialSM(f32x16& p0, f32x16& p1, float& m_reg, float& mn, float& alpha, const float SCALE) {
    const float C = SCALE * 1.4426950408889634f;
    float pmax = p0[0];
#pragma unroll
    for (int r = 1; r < 16; ++r) pmax = fmaxf(pmax, p0[r]);
#pragma unroll
    for (int r = 0; r < 16; ++r) pmax = fmaxf(pmax, p1[r]);
    { auto rr = __builtin_amdgcn_permlane32_swap(__float_as_uint(pmax), __float_as_uint(pmax), false, false);
      pmax = fmaxf(__uint_as_float(rr[0]), __uint_as_float(rr[1])); }
    if (__builtin_expect(__all(pmax - m_reg <= ATT_THR / SCALE), 1)) { mn = m_reg; alpha = 1.f; }
    else { mn = fmaxf(m_reg, pmax); alpha = __builtin_amdgcn_exp2f((m_reg - mn) * C); m_reg = mn; }
    const float mnC = -mn * C;
#pragma unroll
    for (int r = 0; r < 16; ++r) p0[r] = fmaf(p0[r], C, mnC);
#pragma unroll
    for (int r = 0; r < 16; ++r) p1[r] = fmaf(p1[r], C, mnC);
#pragma unroll
    for (int r = 0; r < 16; ++r) p0[r] = __builtin_amdgcn_exp2f(p0[r]);
}
DI void finishSM(f32x16& p0, f32x16& p1, float alpha, float& l_reg, bf16x8& pa0, bf16x8& pa1, bf16x8& pa2, bf16x8& pa3) {
#pragma unroll
    for (int r = 0; r < 16; ++r) p1[r] = __builtin_amdgcn_exp2f(p1[r]);
    float ps = 0;
#pragma unroll
    for (int r = 0; r < 16; ++r) ps += p0[r];
#pragma unroll
    for (int r = 0; r < 16; ++r) ps += p1[r];
    { auto rr = __builtin_amdgcn_permlane32_swap(__float_as_uint(ps), __float_as_uint(ps), false, false);
      ps = __uint_as_float(rr[0]) + __uint_as_float(rr[1]); }
    l_reg = l_reg * alpha + ps;
#define PK4(P, BASE, OUT) do { unsigned a0 = cvtpk(P[BASE + 0], P[BASE + 1]), a1 = cvtpk(P[BASE + 2], P[BASE + 3]);   \
    unsigned b0 = cvtpk(P[BASE + 4], P[BASE + 5]), b1 = cvtpk(P[BASE + 6], P[BASE + 7]);                              \
    auto r0 = __builtin_amdgcn_permlane32_swap(a0, b0, false, false); auto r1 = __builtin_amdgcn_permlane32_swap(a1, b1, false, false); \
    u32x4 w = {r0[0], r1[0], r0[1], r1[1]}; OUT = *reinterpret_cast<bf16x8*>(&w); } while (0)
    PK4(p0, 0, pa0); PK4(p0, 8, pa1); PK4(p1, 0, pa2); PK4(p1, 8, pa3);
#undef PK4
}
template <int DQK, int NQR>
DI void qkt(f32x16& p0, f32x16& p1, const int (&kb)[4], int bufoff, const bf16x8* qr, int qs_addr, int r32, int hi) {
    asm volatile("" : "+v"(qs_addr));
    const LAS char* Qs = (const LAS char*)qs_addr;
#pragma unroll
    for (int r = 0; r < 16; ++r) { p0[r] = 0.f; p1[r] = 0.f; }
#pragma unroll
    for (int d0 = 0; d0 < DQK / 16; ++d0) {
        const LAS char* ka = (const LAS char*)(kb[d0 & 3]) + bufoff + 128 * (d0 >> 2);
        const bf16x8 b0 = *(const LAS bf16x8*)(ka);
        const bf16x8 b1 = *(const LAS bf16x8*)(ka + 32 * DQK * 2);
        bf16x8 q;
        if (d0 < NQR) q = qr[d0]; else q = *(const LAS bf16x8*)(Qs + (d0 - NQR) * 1024);
        p0 = __builtin_amdgcn_mfma_f32_32x32x16_bf16(b0, q, p0, 0, 0, 0);
        p1 = __builtin_amdgcn_mfma_f32_32x32x16_bf16(b1, q, p1, 0, 0, 0); }
}
DI int v_st(int k, int c) { const int kk = (k & ~0xC) | ((k & 4) << 1) | ((k & 8) >> 1); return ((kk >> 3) * 4 + (c >> 5)) * 512 + ((kk & 7) * 32 + (c & 31)) * 2; }
DI int v_rd_base(int lane) { return ((lane & 3) << 3) | (((lane >> 2) & 3) << 6) | (((lane >> 4) & 1) << 5) | (((lane >> 5) & 1) << 8); }
constexpr int v_rd_off(int d0, int ks, int half) { return d0 * 512 + ks * 4096 + half * 2048; }
template <int OFF> DI s16x4 tr_read(int vb) { s16x4 r; asm volatile("ds_read_b64_tr_b16 %0, %1 offset:%2" : "=&v"(r) : "v"(vb), "i"(OFF) : "memory"); return r; }
template <int D0> DI void pv_one(f32x16& od, int vb, bf16x8 pa0, bf16x8 pa1, bf16x8 pa2, bf16x8 pa3) {
    const s16x4 l0 = tr_read<v_rd_off(D0, 0, 0)>(vb), h0 = tr_read<v_rd_off(D0, 0, 1)>(vb), l1 = tr_read<v_rd_off(D0, 1, 0)>(vb), h1 = tr_read<v_rd_off(D0, 1, 1)>(vb);
    const s16x4 l2 = tr_read<v_rd_off(D0, 2, 0)>(vb), h2 = tr_read<v_rd_off(D0, 2, 1)>(vb), l3 = tr_read<v_rd_off(D0, 3, 0)>(vb), h3 = tr_read<v_rd_off(D0, 3, 1)>(vb);
    asm volatile("s_waitcnt lgkmcnt(0)" ::: "memory"); SBAR();
#define PKV(L, H) (bf16x8){L[0], L[1], L[2], L[3], H[0], H[1], H[2], H[3]}
    od = __builtin_amdgcn_mfma_f32_32x32x16_bf16(pa0, PKV(l0, h0), od, 0, 0, 0);
    od = __builtin_amdgcn_mfma_f32_32x32x16_bf16(pa1, PKV(l1, h1), od, 0, 0, 0);
    od = __builtin_amdgcn_mfma_f32_32x32x16_bf16(pa2, PKV(l2, h2), od, 0, 0, 0);
    od = __builtin_amdgcn_mfma_f32_32x32x16_bf16(pa3, PKV(l3, h3), od, 0, 0, 0);
#undef PKV
}
DI void pv_d0(f32x16* o, int vb, bf16x8 pa0, bf16x8 pa1, bf16x8 pa2, bf16x8 pa3) {
    pv_one<0>(o[0], vb, pa0, pa1, pa2, pa3); pv_one<1>(o[1], vb, pa0, pa1, pa2, pa3); pv_one<2>(o[2], vb, pa0, pa1, pa2, pa3); pv_one<3>(o[3], vb, pa0, pa1, pa2, pa3);
}
template <int DQK, int SDEPTH>
DI void attn_body(const bf16_t* __restrict__ Qb, const bf16_t* __restrict__ Kh, const bf16_t* __restrict__ Vh, bf16_t* __restrict__ Ob, int ldo, int seq, char* lds, const float SCALE) {
    using Cfg = AttnCfg<DQK>;
    constexpr int SHM_V = Cfg::SHM_V, SHM_K = Cfg::SHM_K, ND0 = Cfg::ND0, NKCH = Cfg::NKCH, KCPR = DQK / 8, NQR = Cfg::NQR;
    int tid = threadIdx.x; asm volatile("" : "+v"(tid));
    const int wid = tid >> 6, lane = tid & 63, r32 = lane & 31, hi = lane >> 5;
    char* V_lds = lds; char* K_lds = lds + 2 * SHM_V;
    float* ws = (float*)(lds + 2 * SHM_V + 2 * SHM_K) + wid * 64; float* li_l = ws; float* al_l = ws + 32;
    float m_reg = -1e30f, l_reg = 0; f32x16 o[4]; bf16x8 qr[NQR > 0 ? NQR : 1];
    char* Qs = lds + 2 * SHM_V + 2 * SHM_K + 8 * 64 * 4 + (wid * (ND0 - NQR) * 64 + lane) * 16;
#pragma unroll
    for (int d = 0; d < 4; ++d)
#pragma unroll
        for (int r = 0; r < 16; ++r) o[d][r] = 0.f;
    const bf16_t* Qw = Qb + (long)(wid * 32 + r32) * DQK + hi * 8;
#pragma unroll
    for (int d0 = 0; d0 < ND0; ++d0) { const bf16x8 qv = *reinterpret_cast<const bf16x8*>(Qw + d0 * 16); if (d0 < NQR) qr[d0] = qv; else *reinterpret_cast<bf16x8*>(Qs + (d0 - NQR) * 1024) = qv; }
    asm volatile("s_waitcnt lgkmcnt(0)" ::: "memory");
    const int sr = tid >> 4, sc = (tid & 15) * 8, vst0 = v_st(sr, sc), vst1 = v_st(32 + sr, sc);
    const int kgo = (tid >> 3) * DQK + (tid & 7) * 8, klo = (tid >> 3) * (DQK * 2) + (((tid & 7) << 4) ^ (((tid >> 3) & 7) << 4));
    const int vb0 = (int)(uintptr_t)V_lds + v_rd_base(lane);
    int kb[4];
#pragma unroll
    for (int m = 0; m < 4; ++m) { kb[m] = (int)(uintptr_t)K_lds + r32 * (DQK * 2) + 16 * (hi ^ (r32 & 1)) + 32 * (m ^ ((r32 >> 1) & 3)); asm volatile("" : "+v"(kb[m])); }
    struct { bf16x8 vs0, vs1, ks[NKCH]; } sr_[SDEPTH];
#define SLOAD(i, k0) do { sr_[i].vs0 = *(const bf16x8*)(&Vh[(long)((k0) + sr) * 128 + sc]); sr_[i].vs1 = *(const bf16x8*)(&Vh[(long)((k0) + 32 + sr) * 128 + sc]); \
    _Pragma("unroll") for (int q_ = 0; q_ < NKCH; ++q_) sr_[i].ks[q_] = *(const bf16x8*)(&Kh[(long)(k0) * DQK + kgo + q_ * 64]); } while (0)
#define SWRITE(b, i) do { *(bf16x8*)(V_lds + (b) * SHM_V + vst0) = sr_[i].vs0; *(bf16x8*)(V_lds + (b) * SHM_V + vst1) = sr_[i].vs1; \
    _Pragma("unroll") for (int q_ = 0; q_ < NKCH; ++q_) *(bf16x8*)(K_lds + (b) * SHM_K + klo + q_ * 128) = sr_[i].ks[q_]; } while (0)
#define SWAIT() do { if constexpr (SDEPTH == 1) asm volatile("s_waitcnt vmcnt(0)" ::: "memory"); else if constexpr (NKCH == 2) asm volatile("s_waitcnt vmcnt(4)" ::: "memory"); else asm volatile("s_waitcnt vmcnt(5)" ::: "memory"); } while (0)
#define RESC(a) do { if (__any((a) < 1.f)) { if (hi == 0) al_l[r32] = (a); asm volatile("s_waitcnt lgkmcnt(0)" ::: "memory"); \
    _Pragma("unroll") for (int d = 0; d < 4; ++d) _Pragma("unroll") for (int r = 0; r < 16; ++r) o[d][r] *= al_l[crow(r, hi)]; } } while (0)
    f32x16 pA0, pA1, pB0, pB1; float mnA, mnB, alA, alB; bf16x8 pa0, pa1, pa2, pa3; const int NT = seq / 64;
    constexpr int SE = 0, SO = SDEPTH - 1;
    SLOAD(SE, 0); asm volatile("s_waitcnt vmcnt(0)" ::: "memory"); SWRITE(0, SE); __syncthreads();
    qkt<DQK, NQR>(pA0, pA1, kb, 0, qr, (int)(uintptr_t)Qs, r32, hi); partialSM(pA0, pA1, m_reg, mnA, alA, SCALE);
    SLOAD(SO, 64); if constexpr (SDEPTH == 2) { if (2 < NT) SLOAD(SE, 2 * 64); }
    SWAIT(); SWRITE(1, SO); __syncthreads();
    for (int j = 1; j + 1 < NT; j += 2) {
        SBAR(); qkt<DQK, NQR>(pB0, pB1, kb, SHM_K, qr, (int)(uintptr_t)Qs, r32, hi);
        finishSM(pA0, pA1, alA, l_reg, pa0, pa1, pa2, pa3); SBAR();
        SLOAD(SO, (j + SDEPTH) * 64); SBAR();
        pv_d0(o, vb0, pa0, pa1, pa2, pa3); partialSM(pB0, pB1, m_reg, mnB, alB, SCALE);
        __syncthreads(); SWAIT(); SWRITE(0, SE);
        RESC(alB); __syncthreads();
        SBAR(); qkt<DQK, NQR>(pA0, pA1, kb, 0, qr, (int)(uintptr_t)Qs, r32, hi);
        finishSM(pB0, pB1, alB, l_reg, pa0, pa1, pa2, pa3); SBAR();
        if (SDEPTH == 1 || j + 3 < NT) SLOAD(SE, (j + 1 + SDEPTH) * 64); SBAR();
        pv_d0(o, vb0 + SHM_V, pa0, pa1, pa2, pa3); partialSM(pA0, pA1, m_reg, mnA, alA, SCALE);
        __syncthreads(); SWAIT(); SWRITE(1, SO);
        RESC(alA); __syncthreads();
    }
    SBAR(); qkt<DQK, NQR>(pB0, pB1, kb, SHM_K, qr, (int)(uintptr_t)Qs, r32, hi);
    finishSM(pA0, pA1, alA, l_reg, pa0, pa1, pa2, pa3); SBAR();
    pv_d0(o, vb0, pa0, pa1, pa2, pa3); partialSM(pB0, pB1, m_reg, mnB, alB, SCALE);
    __syncthreads(); RESC(alB);
    finishSM(pB0, pB1, alB, l_reg, pa0, pa1, pa2, pa3); SBAR();
    pv_d0(o, vb0 + SHM_V, pa0, pa1, pa2, pa3);
    if (hi == 0) li_l[r32] = l_reg; asm volatile("s_waitcnt lgkmcnt(0)" ::: "memory");
    float rli[16];
#pragma unroll
    for (int r = 0; r < 16; ++r) rli[r] = __builtin_amdgcn_rcpf(li_l[crow(r, hi)]);
    bf16_t* Ow = Ob + (long)(wid * 32) * ldo;
#pragma unroll
    for (int r = 0; r < 16; ++r) { const int orow = crow(r, hi);
#pragma unroll
        for (int d0 = 0; d0 < 4; ++d0) Ow[(long)orow * ldo + d0 * 32 + r32] = f2bf(o[d0][r] * rli[r]); }
    __syncthreads();
#undef SLOAD
#undef SWRITE
#undef SWAIT
#undef RESC
}

DI void phase_router(PR p, int l, char* lds) {
    const int tid = tid_here(), wid = tid >> 6, lane = tid & 63;
    const unsigned char* wl = p.ws + WS_WEIGHTS + (size_t)l * WL_END;
    const bf16_t* WH = (const bf16_t*)(wl + WL_WRH); const bf16_t* WLo = (const bf16_t*)(wl + WL_WRL);
    const bf16_t* HH = (const bf16_t*)(p.ws + WS_HBUF); const bf16_t* HL = (const bf16_t*)(p.ws + WS_U + U_HLO);
    int* EIDX = (int*)(p.ws + WS_EIDX); float* EW = (float*)(p.ws + WS_EW); int* EPOS = (int*)(p.ws + WS_EPOS);
    unsigned* cnt = (unsigned*)(p.ws + WS_CNT) + l * 64;
    const float* rb = p.router_b + l * 64;
    float* SEL = (float*)lds + wid * (2 * 16 * 65);
    float* SCO = SEL + 16 * 65;
    const int ntok = l == 0 ? NTOK : NLAT, ngrp = ntok / 16;
    const int fr = lane & 15, fq = lane >> 4;
    for (int gidx = blockIdx.x * 8 + wid; gidx < ngrp; gidx += gridDim.x * 8) {
        const int row0 = gidx * 16;
        f32x4 acc[4];
#pragma unroll
        for (int e = 0; e < 4; ++e) acc[e] = (f32x4){0.f, 0.f, 0.f, 0.f};
        const bf16_t* ah = HH + (size_t)(row0 + fr) * D + fq * 8; const bf16_t* al = HL + (size_t)(row0 + fr) * D + fq * 8;
        for (int k0 = 0; k0 < D; k0 += 32) {
            const bf16x8 a_hi = *(const bf16x8*)(ah + k0), a_lo = *(const bf16x8*)(al + k0);
#pragma unroll
            for (int e = 0; e < 4; ++e) {
                const bf16x8 b_hi = *(const bf16x8*)(WH + (size_t)(e * 16 + fr) * D + k0 + fq * 8), b_lo = *(const bf16x8*)(WLo + (size_t)(e * 16 + fr) * D + k0 + fq * 8);
                acc[e] = __builtin_amdgcn_mfma_f32_16x16x32_bf16(a_hi, b_hi, acc[e], 0, 0, 0);
                acc[e] = __builtin_amdgcn_mfma_f32_16x16x32_bf16(a_hi, b_lo, acc[e], 0, 0, 0);
                acc[e] = __builtin_amdgcn_mfma_f32_16x16x32_bf16(a_lo, b_hi, acc[e], 0, 0, 0);
            }
        }
#pragma unroll
        for (int e = 0; e < 4; ++e)
#pragma unroll
            for (int i = 0; i < 4; ++i) { const int ex = e * 16 + fr; const float s = sigmoid_f(acc[e][i]); SCO[(fq * 4 + i) * 65 + ex] = s; SEL[(fq * 4 + i) * 65 + ex] = s + rb[ex]; }
        asm volatile("s_waitcnt lgkmcnt(0)" ::: "memory");
        __builtin_amdgcn_wave_barrier();
        if (lane < 16) {
            float* sel = SEL + lane * 65; const float* sco = SCO + lane * 65;
            float gs[8];
#pragma unroll
            for (int g = 0; g < 8; ++g) { float m1 = -INFINITY, m2 = -INFINITY;
#pragma unroll
                for (int i = 0; i < 8; ++i) { const float v = sel[g * 8 + i]; if (v > m1) { m2 = m1; m1 = v; } else if (v > m2) m2 = v; }
                gs[g] = m1 + m2; }
            unsigned gmask = 0u;
#pragma unroll
            for (int it = 0; it < 4; ++it) { float best = -INFINITY; int bi = 0;
#pragma unroll
                for (int g = 0; g < 8; ++g) { const bool free_ = ((gmask >> g) & 1u) == 0u; if (free_ && gs[g] > best) { best = gs[g]; bi = g; } }
                gmask |= 1u << bi; }
            int ei[8]; float ew[8]; float wsum = 0.f;
#pragma unroll
            for (int k = 0; k < 8; ++k) { float best = -INFINITY; int bi = 0;
                for (int e = 0; e < 64; ++e) { const float v = sel[e]; if (((gmask >> (e >> 3)) & 1u) && v > best) { best = v; bi = e; } }
                sel[bi] = -INFINITY; ei[k] = bi; ew[k] = sco[bi]; wsum += ew[k]; }
            const float sc = 2.5f / wsum; const int t = row0 + lane;
#pragma unroll
            for (int k = 0; k < 8; ++k) { const unsigned pos = atomicAdd(&cnt[ei[k]], 1u); EIDX[t * 8 + k] = ei[k]; EW[t * 8 + k] = ew[k] * sc; EPOS[t * 8 + k] = (int)pos; }
        }
        __builtin_amdgcn_wave_barrier();
    }
}
DI void phase_moe_index(PR p, int l, char* lds) {
    const int tid = tid_here();
    int* S = (int*)lds;
    const unsigned* cnt = (const unsigned*)(p.ws + WS_CNT) + l * 64;
    int* META = (int*)(p.ws + WS_META) + l * 1024;
    const int* EIDX = (const int*)(p.ws + WS_EIDX); const float* EW = (const float*)(p.ws + WS_EW); const int* EPOS = (const int*)(p.ws + WS_EPOS);
    int* SASG = (int*)(p.ws + WS_SASG); float* SW = (float*)(p.ws + WS_SW);
    if (tid < 64) S[128 + tid] = (int)cnt[tid];
    __syncthreads();
    if (tid == 0) { int s = 0; for (int e = 0; e < 64; ++e) { S[e] = s; s += (S[128 + e] + 255) / 256 * 256; } S[64] = s; }
    __syncthreads();
    const int ntok = l == 0 ? NTOK : NLAT;
    for (int a = blockIdx.x * NTHREADS + tid; a < ntok * 8; a += gridDim.x * NTHREADS) { const int e = EIDX[a], pos = S[e] + EPOS[a]; SASG[pos] = a; SW[pos] = EW[a]; }
    for (int i = blockIdx.x * NTHREADS + tid; i < 64 * 256; i += gridDim.x * NTHREADS) { const int e = i >> 8, q = i & 255, c = S[128 + e]; if (S[e] + c + q < S[e + 1]) { SASG[S[e] + c + q] = -1; SW[S[e] + c + q] = 0.f; } }
    if (blockIdx.x == 0) {
        if (tid == 0) META[0] = S[64] / 256;
        if (tid < 64) { for (int t = S[tid] / 256; t < S[tid + 1] / 256; ++t) META[256 + t] = tid; }
    }
}

DI void phase_inproj(PR p, int l, char* lds) {
    const bf16_t* A = (const bf16_t*)(p.ws + WS_HBUF); const bf16_t* W = (const bf16_t*)(p.ws + WS_WEIGHTS + (size_t)l * WL_END + WL_WIN);
    for (int u = blockIdx.x; u < 68 * 15; u += gridDim.x) {
        const int pm = u / 15, pn = u % 15;
        GemmUnit g; g.A = A + (size_t)pm * 256 * D; g.lda = D; g.rows = nullptr; g.rowshift = 0; g.Bt = W + (size_t)pn * 256 * D; g.ldb = D; g.K = D;
        EpiProj E; E.O = (bf16_t*)(p.ws + WS_U + U_PROJ); E.row0 = pm * 256; E.col0 = pn * 256;
        GEMM_ACC; const LaneId id = gemm_kloop_simple(lds, g, acc); E(acc, id.wr, id.wc, id.fr, id.fq);
    }
}
DI void phase_mla_up(PR p, int l, char* lds) {
    unsigned char* U = p.ws + WS_U; const unsigned char* wl = p.ws + WS_WEIGHTS + (size_t)l * WL_END;
    for (int u = blockIdx.x; u < 68 * 11; u += gridDim.x) {
        const int pm = u / 11, q = u % 11;
        GemmUnit g; g.rows = nullptr; g.rowshift = 0;
        if (q < 5) { g.A = (const bf16_t*)(U + U_CQN) + (size_t)pm * 256 * 384; g.lda = 384; g.Bt = (const bf16_t*)(wl + WL_WUQ) + (size_t)q * 256 * 384; g.ldb = 384; g.K = 384; }
        else { g.A = (const bf16_t*)(U + U_CKVN) + (size_t)pm * 256 * 512; g.lda = 512; g.Bt = (const bf16_t*)(wl + WL_WUKV) + (size_t)(q - 5) * 256 * 512; g.ldb = 512; g.K = 512; }
        GEMM_ACC; const LaneId id = gemm_kloop_simple(lds, g, acc);
        if (q < 5) { EpiUq E; E.Q = (bf16_t*)(U + U_QM); E.ropem = (const float2*)(p.ws + WS_ROPEM); E.row0 = pm * 256; E.col0 = q * 256; E(acc, id.wr, id.wc, id.fr, id.fq); }
        else { EpiUkv E; E.Km = (bf16_t*)(U + U_KM); E.Vm = (bf16_t*)(U + U_VM); E.row0 = pm * 256; E.col0 = (q - 5) * 256; E(acc, id.wr, id.wc, id.fr, id.fq); }
    }
}
DI void phase_outproj(PR p, int l, char* lds) {
    const bf16_t* A = (const bf16_t*)(p.ws + WS_U + U_MIX); const bf16_t* W = (const bf16_t*)(p.ws + WS_WEIGHTS + (size_t)l * WL_END + WL_WOUT);
    const int nm = l == 0 ? 68 : 64;
    for (int u = blockIdx.x; u < nm * 8; u += gridDim.x) {
        const int pm = u / 8, pn = u % 8;
        GemmUnit g; g.A = A + (size_t)pm * 256 * D; g.lda = D; g.rows = nullptr; g.rowshift = 0; g.Bt = W + (size_t)pn * 256 * D; g.ldb = D; g.K = D;
        EpiF32 E; E.O = (float*)(p.ws + WS_U + U_Y); E.row0 = pm * 256; E.col0 = pn * 256; E.ld = D;
        GEMM_ACC; const LaneId id = gemm_kloop_simple(lds, g, acc); E(acc, id.wr, id.wc, id.fr, id.fq);
    }
}
DI void phase_moe1(PR p, int l, char* lds) {
    const int* META = (const int*)(p.ws + WS_META) + l * 1024; const int ntiles = META[0], nsh = l == 0 ? 68 : 64;
    const bf16_t* H = (const bf16_t*)(p.ws + WS_HBUF); const bf16_t* W13 = (const bf16_t*)(p.ws + WS_WEIGHTS + (size_t)l * WL_END + WL_W13);
    bf16_t* ACT = (bf16_t*)(p.ws + WS_U + U_ACT); const int* SASG = (const int*)(p.ws + WS_SASG);
    for (int u = blockIdx.x; u < (ntiles + nsh) * 4; u += gridDim.x) {
        const int tile = u >> 2, pn = u & 3;
        GemmUnit g; g.lda = D; g.ldb = D; g.K = D; g.rowshift = 3;
        EpiMoe1 E; E.act = ACT; E.hcol0 = pn * 128;
        if (tile < ntiles) { const int e = META[256 + tile]; g.A = H; g.rows = SASG + tile * 256; g.Bt = W13 + ((size_t)e * 1024 + pn * 256) * D; E.arow0 = tile * 256; }
        else { const int ts = tile - ntiles; g.A = H + (size_t)ts * 256 * D; g.rows = nullptr; g.Bt = W13 + ((size_t)64 * 1024 + pn * 256) * D; E.arow0 = PMAX + ts * 256; }
        GEMM_ACC; const LaneId id = gemm_kloop_simple(lds, g, acc); E(acc, id.wr, id.wc, id.fr, id.fq);
    }
}
DI void phase_moe2(PR p, int l, char* lds) {
    const int* META = (const int*)(p.ws + WS_META) + l * 1024; const int ntiles = META[0], nsh = l == 0 ? 68 : 64;
    const bf16_t* W2 = (const bf16_t*)(p.ws + WS_WEIGHTS + (size_t)l * WL_END + WL_W2);
    const bf16_t* ACT = (const bf16_t*)(p.ws + WS_U + U_ACT);
    for (int u = blockIdx.x; u < (ntiles + nsh) * 8; u += gridDim.x) {
        const int tile = u >> 3, pn = u & 7;
        GemmUnit g; g.lda = 512; g.ldb = 512; g.K = 512; g.rows = nullptr; g.rowshift = 0;
        const int e = tile < ntiles ? META[256 + tile] : 64, ts = tile - ntiles;
        g.A = ACT + (size_t)(tile < ntiles ? tile * 256 : PMAX + ts * 256) * 512; g.Bt = W2 + ((size_t)e * D + pn * 256) * 512;
        GEMM_ACC; const LaneId id = gemm_kloop_simple(lds, g, acc);
        if (tile < ntiles) { EpiMoe2 E; E.oasg = (bf16_t*)(p.ws + WS_U + U_OASG); E.sasg = (const int*)(p.ws + WS_SASG); E.sw = (const float*)(p.ws + WS_SW); E.srow0 = tile * 256; E.col0 = pn * 256; E(acc, id.wr, id.wc, id.fr, id.fq); }
        else { EpiF32 E; E.O = (float*)(p.ws + WS_U + U_Y); E.row0 = ts * 256; E.col0 = pn * 256; E.ld = D; E(acc, id.wr, id.wc, id.fr, id.fq); }
    }
}
DI void phase_attention(PR p, int l, char* lds) {
#define ATT_PTRS unsigned char* U = p.ws + WS_U; asm volatile("" : "+s"(U)); \
    const bf16_t* Qm = (const bf16_t*)(U + U_QM); const bf16_t* Km = (const bf16_t*)(U + U_KM); const bf16_t* Vm = (const bf16_t*)(U + U_VM); \
    const bf16_t* Qg = (const bf16_t*)(U + U_QG); const bf16_t* Kg = (const bf16_t*)(U + U_KG); const bf16_t* Vg = (const bf16_t*)(U + U_VG); bf16_t* MIX = (bf16_t*)(U + U_MIX);
    const int nun = 384 + (l == 0 ? 24 : 0);
    if (SUB & 1) for (int u = blockIdx.x; u < nun; u += gridDim.x) {
        ATT_PTRS; (void)Qg; (void)Kg; (void)Vg;
        int b, h, qt, isctx;
        if (u < 384) { qt = u & 15; h = (u >> 4) % 6; b = u / 96; isctx = 0; } else { const int w = u - 384; h = w % 6; b = w / 6; qt = 0; isctx = 1; }
        const int qpos = isctx ? 0 : CTXL + qt * 256, seq = isctx ? CTXL : SKV, orow = isctx ? NLAT + b * CTXL : b * SEQ + qt * 256;
        attn_body<192, ATT_SD_M>(Qm + (((size_t)b * 6 + h) * SKV + qpos) * 192, Km + ((size_t)b * 6 + h) * SKV * 192, Vm + ((size_t)b * 6 + h) * SKV * 128,
                                 MIX + (size_t)orow * D + 512 + h * 128, D, seq, lds, 0.07216878364870322f);
    }
    if (SUB & 2) for (int u = gridDim.x - 1 - blockIdx.x; u < nun; u += gridDim.x) {
        ATT_PTRS; (void)Qm; (void)Km; (void)Vm;
        int b, h, qt, isctx;
        if (u < 384) { qt = u & 15; h = (u >> 4) % 6; b = u / 96; isctx = 0; } else { const int w = u - 384; h = w % 6; b = w / 6; qt = 0; isctx = 1; }
        const int qpos = isctx ? 0 : CTXL + qt * 256, seq = isctx ? CTXL : SKV, orow = isctx ? NLAT + b * CTXL : b * SEQ + qt * 256;
        attn_body<128, ATT_SD_G>(Qg + (((size_t)b * 6 + h) * SKV + qpos) * 128, Kg + ((size_t)b * 2 + (h / 3)) * SKV * 128, Vg + ((size_t)b * 2 + (h / 3)) * SKV * 128,
                                 MIX + (size_t)orow * D + 1280 + h * 128, D, seq, lds, 0.08838834764831845f);
    }
#undef ATT_PTRS
    if (SUB & 4) gla_phaseC(p, l, lds);
}

constexpr int NPH_LAYER = 12, NPH = 1 + 2 * NPH_LAYER;
constexpr int LDS_BYTES = 160 * 1024;
__global__ void __launch_bounds__(NTHREADS, 2) fwd(Params p_arg, int ph_lo, int ph_hi) {
    extern __shared__ __attribute__((aligned(16))) char shm[];
    char* lds = shm + 256;
    volatile LAS unsigned* xbw = (volatile LAS unsigned*)shm;
    const bool fused = (ph_hi - ph_lo) > 1;
    XcdBarrier bar; bar.bar = (unsigned*)(p_arg.ws + WS_BAR); bar.x = 0; bar.st = xbw;
    if (fused) {
        if (threadIdx.x == 0) { xbw[0] = 0u; xbw[1] = 0u; xbw[2] = 0u; xbw[3] = 0u; }
        __syncthreads();
        bar = xcd_barrier_post((unsigned*)(p_arg.ws + WS_BAR), xbw);
    }
    const CAS Params* pk = (const CAS Params*)__builtin_amdgcn_kernarg_segment_ptr();
#define PHASE(idx, CALL) do { if (((PH_MASK >> ((idx) == 0 ? 0 : ((idx) - 1) % NPH_LAYER + 1)) & 1) && (idx) >= ph_lo && (idx) < ph_hi) { const CAS Params* q_ = pk; asm volatile("" : "+s"(q_)); PR p = *q_; CALL; if (fused && (idx) + 1 < ph_hi) xcd_barrier(bar); } } while (0)
    PHASE(0, phase_prologue(p, lds));
    for (int l = 0; l < 2; ++l) {
        const int b0 = 1 + l * NPH_LAYER;
        if (l == 0) PHASE(b0 + 0, phase_norm1(p, 0));
        PHASE(b0 + 1, phase_inproj(p, l, lds));
        PHASE(b0 + 2, (phase_postproj_rows(p, l), gla_phaseA(p, l, lds)));
        PHASE(b0 + 3, (phase_mla_up(p, l, lds), gla_scan(p)));
        PHASE(b0 + 4, phase_attention(p, l, lds));
        PHASE(b0 + 5, phase_outproj(p, l, lds));
        PHASE(b0 + 6, phase_postmix(p, l));
        PHASE(b0 + 7, phase_router(p, l, lds));
        PHASE(b0 + 8, phase_moe_index(p, l, lds));
        PHASE(b0 + 9, phase_moe1(p, l, lds));
        PHASE(b0 + 10, phase_moe2(p, l, lds));
        PHASE(b0 + 11, phase_postffn(p, l));
    }
#undef PHASE
}

extern "C" void kernel_launch(void* const* d_in, const int* in_sizes, int n_in, void* d_out, int out_size, void* d_ws, size_t ws_size, hipStream_t stream) {
    static int grid = 0;
    if (!grid) {
        if (ws_size < WS_TOTAL) { fprintf(stderr, "kernel_launch: workspace too small: %zu < %zu\n", ws_size, (size_t)WS_TOTAL); return; }
        if (hipFuncSetAttribute((const void*)fwd, hipFuncAttributeMaxDynamicSharedMemorySize, LDS_BYTES) != hipSuccess) { fprintf(stderr, "kernel_launch: hipFuncSetAttribute failed\n"); return; }
        int dev = 0, cus = 0, per_cu = 0;
        hipGetDevice(&dev);
        hipDeviceGetAttribute(&cus, hipDeviceAttributeMultiprocessorCount, dev);
        hipOccupancyMaxActiveBlocksPerMultiprocessor(&per_cu, fwd, NTHREADS, LDS_BYTES);
        if (per_cu < 1) { fprintf(stderr, "kernel_launch: occupancy query says %d\n", per_cu); return; }
        grid = cus;
    }
    Params p{};
    const float** f = (const float**)&p;
    for (int i = 0; i < 31; ++i) f[i] = (const float*)d_in[i];
    p.out = (float*)d_out; p.ws = (unsigned char*)d_ws;
    hipMemsetAsync((unsigned char*)d_ws + WS_BAR, 0, XCD_BAR_WORDS * sizeof(unsigned), stream);
#if MK_MULTI
    for (int ph = 0; ph < NPH; ++ph) { if (ph == 1 + NPH_LAYER) continue; hipLaunchKernelGGL(fwd, dim3(grid), dim3(NTHREADS), LDS_BYTES, stream, p, ph, ph + 1); }
#else
    hipLaunchKernelGGL(fwd, dim3(grid), dim3(NTHREADS), LDS_BYTES, stream, p, 0, NPH);
#endif
    const hipError_t le = hipPeekAtLastError();
    if (le != hipSuccess) fprintf(stderr, "kernel_launch: launch failed: %s\n", hipGetErrorName(le));
}
```

```cpp
#include <hip/hip_runtime.h>
#include <stdint.h>
#include <stdio.h>

#ifndef PH_MASK
#define PH_MASK 0x1FFF
#endif
#ifndef SUB
#define SUB 7
#endif
#ifndef ATT_SD_M
#define ATT_SD_M 1
#endif
#ifndef ATT_SD_G
#define ATT_SD_G 2
#endif
#ifndef ATT_NQR_M
#define ATT_NQR_M 4
#endif
#ifndef MK_MULTI
#define MK_MULTI 0
#endif

typedef unsigned short bf16_t;
typedef short bf16x8 __attribute__((ext_vector_type(8)));
typedef short s16x4 __attribute__((ext_vector_type(4)));
typedef float f32x4 __attribute__((ext_vector_type(4)));
typedef float f32x16 __attribute__((ext_vector_type(16)));
typedef unsigned u32x4 __attribute__((ext_vector_type(4)));
typedef unsigned u32x2 __attribute__((ext_vector_type(2)));
#define DI __device__ __forceinline__

constexpr int D = 2048, NB = 4, SEQ = 4096, CTXL = 256, NLAT = NB * SEQ, NCTX = NB * CTXL, NTOK = NLAT + NCTX, SKV = SEQ + CTXL;
constexpr int INW = 3808, INWP = 3840;
constexpr int C_GQ = 0, C_GK = 256, C_GV = 512, C_GG = 1024, C_ZF = 1536, C_ZB = 1552, C_CQ = 1568, C_CKV = 1952, C_KR = 2464, C_AQ = 2528, C_AK = 3296, C_AV = 3552;
constexpr int NE = 64, TOPK = 8, DEXP = 512;
constexpr int PMAX = NTOK * TOPK + NE * 256;
constexpr int NTHREADS = 512;
constexpr float EPS = 1e-6f;

constexpr size_t MiB = 1024ull * 1024ull;
constexpr size_t al256(size_t x) { return (x + 255) / 256 * 256; }
constexpr size_t WS_BAR = 0;
constexpr size_t WS_CNT = 16384;
constexpr size_t WS_META = WS_CNT + 1024;
constexpr size_t WS_MOD = WS_META + 2 * 4096;
constexpr size_t WS_ROPEG = al256(WS_MOD + 2 * 5 * 12288 * 4);
constexpr size_t WS_ROPEM = WS_ROPEG + 64 * 32 * 8;
constexpr size_t WS_ZROW = WS_ROPEM + 64 * 16 * 8;
constexpr size_t WS_GDEC = WS_ZROW + 4096;
constexpr size_t WS_EIDX = al256(WS_GDEC + 2 * 16 * 68 * 64 * 4);
constexpr size_t WS_EW = WS_EIDX + (size_t)NTOK * 8 * 4;
constexpr size_t WS_EPOS = WS_EW + (size_t)NTOK * 8 * 4;
constexpr size_t WS_SASG = WS_EPOS + (size_t)NTOK * 8 * 4;
constexpr size_t WS_SW = al256(WS_SASG + (size_t)PMAX * 4);
constexpr size_t WS_SMALL_END = al256(WS_SW + (size_t)PMAX * 4);
static_assert(WS_SMALL_END <= 8 * MiB, "small region");
constexpr size_t SZ_WIN = (size_t)INWP * D * 2, SZ_WUQ = (size_t)1280 * 512 * 2, SZ_WUKV = (size_t)1536 * 512 * 2, SZ_WOUT = (size_t)D * D * 2, SZ_WR = (size_t)64 * D * 2;
constexpr size_t SZ_W13 = (size_t)65 * 1024 * D * 2, SZ_W2 = (size_t)65 * D * 512 * 2;
constexpr size_t WL_WIN = 0, WL_WUQ = WL_WIN + SZ_WIN, WL_WUKV = WL_WUQ + SZ_WUQ, WL_WOUT = WL_WUKV + SZ_WUKV, WL_WRH = WL_WOUT + SZ_WOUT, WL_WRL = WL_WRH + SZ_WR,
                 WL_W13 = WL_WRL + SZ_WR, WL_W2 = WL_W13 + SZ_W13, WL_END = WL_W2 + SZ_W2;
constexpr size_t WS_WEIGHTS = 8 * MiB;
constexpr size_t WS_XRES = WS_WEIGHTS + 2 * WL_END;
constexpr size_t WS_HBUF = WS_XRES + (size_t)NTOK * D * 4;
constexpr size_t WS_U = WS_HBUF + (size_t)NTOK * D * 2;
constexpr size_t U_Y = 0;
constexpr size_t U_PROJ = U_Y + (size_t)NTOK * D * 4;
constexpr size_t U_QM = U_PROJ + (size_t)NTOK * INWP * 2;
constexpr size_t U_KM = U_QM + (size_t)NB * 6 * SKV * 192 * 2;
constexpr size_t U_VM = U_KM + (size_t)NB * 6 * SKV * 192 * 2;
constexpr size_t U_QG = U_VM + (size_t)NB * 6 * SKV * 128 * 2;
constexpr size_t U_KG = U_QG + (size_t)NB * 6 * SKV * 128 * 2;
constexpr size_t U_VG = U_KG + (size_t)NB * 2 * SKV * 128 * 2;
constexpr size_t U_GS = U_VG + (size_t)NB * 2 * SKV * 128 * 2;
constexpr size_t U_MIX = U_GS + (size_t)2 * 16 * 68 * 64 * 128 * 4;
constexpr size_t U_CQN = U_MIX + (size_t)NTOK * D * 2;
constexpr size_t U_CKVN = U_CQN + (size_t)NTOK * 512 * 2;
constexpr size_t U_MIX_END = U_CKVN + (size_t)NTOK * 512 * 2;
constexpr size_t U_HLO = U_PROJ;
constexpr size_t U_ACT = U_HLO + (size_t)NTOK * D * 2;
constexpr size_t U_OASG = U_ACT + (size_t)(PMAX + NTOK) * 512 * 2;
constexpr size_t U_MOE_END = U_OASG + (size_t)NTOK * 8 * D * 2;
constexpr size_t WS_TOTAL = WS_U + (U_MIX_END > U_MOE_END ? U_MIX_END : U_MOE_END);
static_assert(WS_TOTAL <= 2048ull * MiB, "workspace over 2 GiB");

struct Params {
    const float *x, *c, *ctx, *c_ctx, *w_mod, *b_mod, *g_pre_mix, *g_post_mix, *g_pre_ffn, *g_post_ffn, *w_in, *gla_wg2_f, *gla_bg_f, *gla_wg2_b, *gla_bg_b, *gla_g_out,
        *mla_g_q, *mla_w_uq, *mla_g_kv, *mla_w_ukv, *gqa_g_q, *gqa_g_k, *w_out, *router_w, *router_b, *exp_w1, *exp_w3, *exp_w2, *sh_w1, *sh_w3, *sh_w2;
    float* out; unsigned char* ws;
};

#define CAS __attribute__((address_space(4)))
typedef const CAS Params& PR;
DI int bid_here() { int b = blockIdx.x; asm volatile("" : "+s"(b)); return b; }
DI int tid_here() { int t = threadIdx.x; asm volatile("" : "+v"(t)); return t; }
DI float bf2f(bf16_t v) { return __uint_as_float(((unsigned)v) << 16); }
DI bf16_t f2bf(float f) { unsigned u = __float_as_uint(f); u += 0x7FFFu + ((u >> 16) & 1u); return (bf16_t)(u >> 16); }
DI unsigned pk2(float lo, float hi) { return (unsigned)f2bf(lo) | ((unsigned)f2bf(hi) << 16); }
DI float shx(float v, int o, int lane) { return __int_as_float(__builtin_amdgcn_ds_bpermute((lane ^ o) << 2, __float_as_int(v))); }
DI float wave_sum(float v) {
    const int lane = tid_here() & 63;
#pragma unroll
    for (int o = 32; o > 0; o >>= 1) v += shx(v, o, lane);
    return v;
}
DI float silu_f(float v) { return v / (1.f + __expf(-v)); }
DI float sigmoid_f(float v) { return 1.f / (1.f + __expf(-v)); }
struct Tok { int b, s, isctx, mrow, kvpos; };
DI Tok tok_of(int r) { Tok t; if (r < NLAT) { t.b = r >> 12; t.s = r & 4095; t.isctx = 0; t.mrow = t.b; t.kvpos = CTXL + t.s; } else { const int q = r - NLAT; t.b = q >> 8; t.s = q & 255; t.isctx = 1; t.mrow = 4; t.kvpos = t.s; } return t; }
DI const float* xrow_in(PR p, int l, int r) { if (l == 0) return r < NLAT ? p.x + (size_t)r * D : p.ctx + (size_t)(r - NLAT) * D; return (const float*)(p.ws + WS_XRES) + (size_t)r * D; }

#define XB_TMO      128
#define XB_XCNT(j)  (256  + 64 * (j))
#define XB_XSUB(j)  (1280 + 64 * (j))
#define XB_XGEN(j)  (2304 + 64 * (j))
#define XB_TOP      3328
#define XB_TOPGEN   3392
#define XCD_BAR_WORDS 3456
#define XB_SPIN_CAP (1u << 18)
#define LAS __attribute__((address_space(3)))
__device__ __forceinline__ unsigned xb_ld(unsigned* p)              { return __hip_atomic_load(p, __ATOMIC_RELAXED, __HIP_MEMORY_SCOPE_AGENT); }
__device__ __forceinline__ unsigned xb_add(unsigned* p, unsigned v) { return __hip_atomic_fetch_add(p, v, __ATOMIC_RELAXED, __HIP_MEMORY_SCOPE_AGENT); }
__device__ __forceinline__ unsigned xb_xcc_id() { return (unsigned)__builtin_amdgcn_s_getreg((3 << 11) | 20) & 0xFu; }
#define XB_SPIN(cond, bar) do { unsigned _sp = 0; while (cond) { __builtin_amdgcn_s_sleep(1); \
    if ((++_sp & 255u) == 0u) { if (xb_ld(&(bar)[XB_TMO])) break; if (_sp > XB_SPIN_CAP) { atomicAdd(&(bar)[XB_TMO], 1u); break; } } } } while (0)
struct XcdBarrier { unsigned* bar; unsigned x; volatile LAS unsigned* st; };
__device__ __forceinline__ XcdBarrier xcd_barrier_post(unsigned* bar, volatile LAS unsigned* st) {
    XcdBarrier b; b.bar = bar; b.x = xb_xcc_id(); b.st = st;
    if (threadIdx.x == 0) (void)xb_add(&bar[XB_XCNT(b.x)], 1u);
    return b;
}
__device__ __forceinline__ void xcd_barrier_complete(unsigned* bar, unsigned x, unsigned& nloc, unsigned& nx) {
    const unsigned G = gridDim.x * gridDim.y * gridDim.z;
    unsigned sum, cnt, mine, sp = 0u;
    for (;;) {
        sum = 0u; cnt = 0u; mine = 0u;
#pragma unroll
        for (unsigned j = 0; j < 16; ++j) { const unsigned c = xb_ld(&bar[XB_XCNT(j)]); sum += c; cnt += (c > 0u) ? 1u : 0u; mine = (j == x) ? c : mine; }
        if (sum == G) break;
        __builtin_amdgcn_s_sleep(1);
        if ((++sp & 255u) == 0u) { if (xb_ld(&bar[XB_TMO])) break; if (sp > XB_SPIN_CAP) { atomicAdd(&bar[XB_TMO], 1u); break; } }
    }
    nloc = mine > 0u ? mine : 1u; nx = cnt > 0u ? cnt : 1u;
}
__device__ __forceinline__ void xcd_barrier(const XcdBarrier& b) {
    asm volatile("s_waitcnt vmcnt(0)" ::: "memory");
    __syncthreads();
    if (threadIdx.x == 0) {
        unsigned* bar = b.bar;
        __builtin_amdgcn_s_waitcnt(0);
        unsigned nloc = b.st[0], nx = b.st[1];
        if (nloc == 0u) { xcd_barrier_complete(bar, b.x, nloc, nx); b.st[0] = nloc; b.st[1] = nx; }
        const unsigned old = xb_add(&bar[XB_XSUB(b.x)], 1u);
        const unsigned gen = old / nloc;
        if (old + 1u == (gen + 1u) * nloc) {
            __builtin_amdgcn_fence(__ATOMIC_RELEASE, "agent");
            asm volatile("s_waitcnt vmcnt(0)" ::: "memory");
            const unsigned og = xb_add(&bar[XB_TOP], 1u);
            const unsigned tg = og / nx;
            if (og + 1u == (tg + 1u) * nx) xb_add(&bar[XB_TOPGEN], 1u);
            else XB_SPIN(xb_ld(&bar[XB_TOPGEN]) == tg, bar);
            __builtin_amdgcn_fence(__ATOMIC_ACQUIRE, "agent");
            xb_add(&bar[XB_XGEN(b.x)], 1u);
            asm volatile("s_waitcnt vmcnt(0)" ::: "memory");
        } else {
            XB_SPIN(xb_ld(&bar[XB_XGEN(b.x)]) == gen, bar);
            __builtin_amdgcn_fence(__ATOMIC_ACQUIRE, "agent");
            asm volatile("s_waitcnt vmcnt(0)" ::: "memory");
        }
    }
    __syncthreads();
}

DI void cvt_tile(char* lds, const float* src, int ldS, int Nvalid, bf16_t* dst, bf16_t* dst_lo, int ldD, int k0, int n0, int drow0, const float* gk) {
    float* T = (float*)lds;
    const int tid = tid_here();
    {
        const int c4 = tid & 15, kr = tid >> 4;
#pragma unroll
        for (int i = 0; i < 2; ++i) {
            const int k = kr + 32 * i, n = n0 + c4 * 4;
            f32x4 v = {0.f, 0.f, 0.f, 0.f};
            if (n < Nvalid) v = *(const f32x4*)(src + (size_t)(k0 + k) * ldS + n);
            if (gk) { const float g = gk[k0 + k]; v = v * g; }
            T[k * 65 + c4 * 4 + 0] = v[0]; T[k * 65 + c4 * 4 + 1] = v[1]; T[k * 65 + c4 * 4 + 2] = v[2]; T[k * 65 + c4 * 4 + 3] = v[3];
        }
    }
    __syncthreads();
    {
        const int nl = tid >> 3, kc = (tid & 7) * 8;
        float v[8];
#pragma unroll
        for (int j = 0; j < 8; ++j) v[j] = T[(kc + j) * 65 + nl];
        u32x4 w; w.x = pk2(v[0], v[1]); w.y = pk2(v[2], v[3]); w.z = pk2(v[4], v[5]); w.w = pk2(v[6], v[7]);
        *(u32x4*)(dst + (size_t)(drow0 + nl) * ldD + k0 + kc) = w;
        if (dst_lo) {
            float r[8];
#pragma unroll
            for (int j = 0; j < 8; ++j) r[j] = v[j] - bf2f(f2bf(v[j]));
            u32x4 w2; w2.x = pk2(r[0], r[1]); w2.y = pk2(r[2], r[3]); w2.z = pk2(r[4], r[5]); w2.w = pk2(r[6], r[7]);
            *(u32x4*)(dst_lo + (size_t)(drow0 + nl) * ldD + k0 + kc) = w2;
        }
    }
    __syncthreads();
}
DI void cvt_matrix(char* lds, const float* src, int K, int N, int Npad, bf16_t* dst, bf16_t* dst_lo, int mode, const float* gk, int ldD = 0) {
    if (ldD == 0) ldD = K;
    const int nkt = K / 64, nnt = Npad / 64, nt = nkt * nnt;
    for (int t = blockIdx.x; t < nt; t += gridDim.x) {
        const int kt = t % nkt, ntile = t / nkt, n0 = ntile * 64;
        int drow0 = n0;
        if (mode == 1) drow0 = (n0 >> 7) * 256 + (n0 & 127);
        else if (mode == 2) drow0 = (n0 >> 7) * 256 + 128 + (n0 & 127);
        cvt_tile(lds, src, N, N, dst, dst_lo, ldD, kt * 64, n0, drow0, gk);
    }
}
DI void phase_prologue(PR p, char* lds) {
    const int tid = tid_here();
    unsigned char* ws = p.ws;
    if (blockIdx.x == 0) {
        unsigned* cnt = (unsigned*)(ws + WS_CNT);
        if (tid < 128) cnt[tid] = 0u;
        unsigned* z = (unsigned*)(ws + WS_ZROW);
        for (int i = tid; i < 1024; i += NTHREADS) z[i] = 0u;
        float2* rg = (float2*)(ws + WS_ROPEG);
        for (int i = tid; i < 64 * 32; i += NTHREADS) { const int pos = i >> 5, f = i & 31; const float inv = powf(10000.f, -(float)(2 * f) / 64.f); float s, c; sincosf((float)pos * inv, &s, &c); rg[i] = make_float2(c, s); }
        float2* rm = (float2*)(ws + WS_ROPEM);
        for (int i = tid; i < 64 * 16; i += NTHREADS) { const int pos = i >> 4, f = i & 15; const float inv = powf(10000.f, -(float)(2 * f) / 32.f); float s, c; sincosf((float)pos * inv, &s, &c); rm[i] = make_float2(c, s); }
    }
    {
        float* sc = (float*)lds;
        float* red = sc + 5 * 2048;
        bool loaded = false;
        for (int u = blockIdx.x; u < 192; u += gridDim.x) {
            if (!loaded) { for (int i = tid; i < 5 * 2048; i += NTHREADS) { const int r = i >> 11, k = i & 2047; const float v = r < 4 ? p.c[r * 2048 + k] : p.c_ctx[k]; sc[i] = silu_f(v); } loaded = true; __syncthreads(); }
            const int l = u / 96, col0 = (u % 96) * 128;
            const int cg = tid & 31, kp = tid >> 5;
            f32x4 acc[5];
#pragma unroll
            for (int r = 0; r < 5; ++r) acc[r] = (f32x4){0.f, 0.f, 0.f, 0.f};
            const float* wb = p.w_mod + ((size_t)l * 2048) * 12288 + col0 + cg * 4;
            for (int kk = 0; kk < 128; ++kk) {
                const int k = kp * 128 + kk;
                const f32x4 w = *(const f32x4*)(wb + (size_t)k * 12288);
#pragma unroll
                for (int r = 0; r < 5; ++r) acc[r] += w * sc[r * 2048 + k];
            }
#pragma unroll
            for (int r = 0; r < 5; ++r)
#pragma unroll
                for (int j = 0; j < 4; ++j) red[(kp * 5 + r) * 128 + cg * 4 + j] = acc[r][j];
            __syncthreads();
            for (int i = tid; i < 640; i += NTHREADS) {
                const int r = i >> 7, cc = i & 127; float s = p.b_mod[l * 12288 + col0 + cc];
#pragma unroll
                for (int q = 0; q < 16; ++q) s += red[(q * 5 + r) * 128 + cc];
                ((float*)(ws + WS_MOD))[((size_t)l * 5 + r) * 12288 + col0 + cc] = s;
            }
            __syncthreads();
        }
        __syncthreads();
    }
    for (int l = 0; l < 2; ++l) {
        unsigned char* wl = ws + WS_WEIGHTS + (size_t)l * WL_END;
        cvt_matrix(lds, p.w_in + (size_t)l * D * INW, D, INW, INWP, (bf16_t*)(wl + WL_WIN), nullptr, 0, nullptr);
        cvt_matrix(lds, p.mla_w_uq + (size_t)l * 384 * 1152, 384, 1152, 1280, (bf16_t*)(wl + WL_WUQ), nullptr, 0, p.mla_g_q + l * 384, 512);
        for (int i = bid_here() * NTHREADS + tid; i < 1280 * 64; i += gridDim.x * NTHREADS) ((unsigned*)(wl + WL_WUQ))[(size_t)(i >> 6) * 256 + 192 + (i & 63)] = 0u;
        cvt_matrix(lds, p.mla_w_ukv + (size_t)l * 512 * 1536, 512, 1536, 1536, (bf16_t*)(wl + WL_WUKV), nullptr, 0, p.mla_g_kv + l * 512);
        cvt_matrix(lds, p.w_out + (size_t)l * D * D, D, D, D, (bf16_t*)(wl + WL_WOUT), nullptr, 0, nullptr);
        cvt_matrix(lds, p.router_w + (size_t)l * D * 64, D, 64, 64, (bf16_t*)(wl + WL_WRH), (bf16_t*)(wl + WL_WRL), 0, nullptr);
        for (int e = 0; e < 65; ++e) {
            const float* s1 = e < 64 ? p.exp_w1 + ((size_t)l * 64 + e) * D * 512 : p.sh_w1 + (size_t)l * D * 512;
            const float* s3 = e < 64 ? p.exp_w3 + ((size_t)l * 64 + e) * D * 512 : p.sh_w3 + (size_t)l * D * 512;
            const float* s2 = e < 64 ? p.exp_w2 + ((size_t)l * 64 + e) * 512 * D : p.sh_w2 + (size_t)l * 512 * D;
            bf16_t* d13 = (bf16_t*)(wl + WL_W13) + (size_t)e * 1024 * D;
            bf16_t* d2 = (bf16_t*)(wl + WL_W2) + (size_t)e * D * 512;
            cvt_matrix(lds, s1, D, 512, 512, d13, nullptr, 1, nullptr);
            cvt_matrix(lds, s3, D, 512, 512, d13, nullptr, 2, nullptr);
            cvt_matrix(lds, s2, 512, D, D, d2, nullptr, 0, nullptr);
        }
    }
}

DI void load_row(const float* src, f32x4 (&v)[8], int lane) {
#pragma unroll
    for (int i = 0; i < 8; ++i) v[i] = *(const f32x4*)(src + i * 256 + lane * 4);
}
DI float row_sumsq(const f32x4 (&v)[8]) {
    float s = 0.f;
#pragma unroll
    for (int i = 0; i < 8; ++i) s += v[i][0] * v[i][0] + v[i][1] * v[i][1] + v[i][2] * v[i][2] + v[i][3] * v[i][3];
    return wave_sum(s);
}
DI void adaln_store(const f32x4 (&x)[8], const float* g, const float* shift, const float* scale, bf16_t* hi, bf16_t* lo, int lane) {
    const float rstd = rsqrtf(row_sumsq(x) * (1.f / D) + EPS);
#pragma unroll
    for (int i = 0; i < 8; ++i) {
        const int c = i * 256 + lane * 4;
        const f32x4 gg = *(const f32x4*)(g + c), sh = *(const f32x4*)(shift + c), sc = *(const f32x4*)(scale + c);
        f32x4 h;
#pragma unroll
        for (int j = 0; j < 4; ++j) h[j] = x[i][j] * rstd * gg[j] * (1.f + sc[j]) + sh[j];
        u32x2 w; w.x = pk2(h[0], h[1]); w.y = pk2(h[2], h[3]);
        *(u32x2*)(hi + c) = w;
        if (lo) { u32x2 w2; w2.x = pk2(h[0] - bf2f(f2bf(h[0])), h[1] - bf2f(f2bf(h[1]))); w2.y = pk2(h[2] - bf2f(f2bf(h[2])), h[3] - bf2f(f2bf(h[3]))); *(u32x2*)(lo + c) = w2; }
    }
}
DI void phase_norm1(PR p, int l) {
    const int tid_ = tid_here(), lane = tid_ & 63, wid = tid_ >> 6;
    const float* mod = (const float*)(p.ws + WS_MOD) + (size_t)l * 5 * 12288;
    bf16_t* hb = (bf16_t*)(p.ws + WS_HBUF);
    for (int r = blockIdx.x * 8 + wid; r < NTOK; r += gridDim.x * 8) {
        const Tok t = tok_of(r);
        f32x4 x[8]; load_row(xrow_in(p, l, r), x, lane);
        adaln_store(x, p.g_pre_mix + l * D, mod + (size_t)t.mrow * 12288 + 0 * D, mod + (size_t)t.mrow * 12288 + 1 * D, hb + (size_t)r * D, nullptr, lane);
    }
}
DI void phase_postmix(PR p, int l) {
    const int tid_ = tid_here(), lane = tid_ & 63, wid = tid_ >> 6;
    const float* mod = (const float*)(p.ws + WS_MOD) + (size_t)l * 5 * 12288;
    const float* Y = (const float*)(p.ws + WS_U + U_Y);
    float* XR = (float*)(p.ws + WS_XRES);
    bf16_t* hb = (bf16_t*)(p.ws + WS_HBUF); bf16_t* hl = (bf16_t*)(p.ws + WS_U + U_HLO);
    const int nrows = l == 0 ? NTOK : NLAT;
    for (int r = blockIdx.x * 8 + wid; r < nrows; r += gridDim.x * 8) {
        const Tok t = tok_of(r);
        f32x4 x[8], y[8]; load_row(xrow_in(p, l, r), x, lane); load_row(Y + (size_t)r * D, y, lane);
        const float rstd = rsqrtf(row_sumsq(y) * (1.f / D) + EPS);
        const float* gate = mod + (size_t)t.mrow * 12288 + 2 * D; const float* g = p.g_post_mix + l * D;
#pragma unroll
        for (int i = 0; i < 8; ++i) {
            const int c = i * 256 + lane * 4; const f32x4 gg = *(const f32x4*)(g + c), gt = *(const f32x4*)(gate + c);
#pragma unroll
            for (int j = 0; j < 4; ++j) x[i][j] += gt[j] * (y[i][j] * rstd * gg[j]);
            *(f32x4*)(XR + (size_t)r * D + c) = x[i];
        }
        adaln_store(x, p.g_pre_ffn + l * D, mod + (size_t)t.mrow * 12288 + 3 * D, mod + (size_t)t.mrow * 12288 + 4 * D, hb + (size_t)r * D, hl + (size_t)r * D, lane);
    }
}
DI void phase_postffn(PR p, int l) {
    const int tid_ = tid_here(), lane = tid_ & 63, wid = tid_ >> 6;
    const float* mod = (const float*)(p.ws + WS_MOD) + (size_t)l * 5 * 12288;
    const float* YS = (const float*)(p.ws + WS_U + U_Y);
    const bf16_t* OA = (const bf16_t*)(p.ws + WS_U + U_OASG);
    float* XR = (float*)(p.ws + WS_XRES);
    bf16_t* hb = (bf16_t*)(p.ws + WS_HBUF);
    const int nrows = l == 0 ? NTOK : NLAT;
    for (int r = blockIdx.x * 8 + wid; r < nrows; r += gridDim.x * 8) {
        const Tok t = tok_of(r);
        f32x4 x[8], y[8]; load_row((const float*)(p.ws + WS_XRES) + (size_t)r * D, x, lane); load_row(YS + (size_t)r * D, y, lane);
        for (int k = 0; k < 8; ++k) {
            const bf16_t* o = OA + ((size_t)r * 8 + k) * D;
#pragma unroll
            for (int i = 0; i < 8; ++i) { const u32x2 w = *(const u32x2*)(o + i * 256 + lane * 4);
                y[i][0] += __uint_as_float(w.x << 16); y[i][1] += __uint_as_float(w.x & 0xFFFF0000u); y[i][2] += __uint_as_float(w.y << 16); y[i][3] += __uint_as_float(w.y & 0xFFFF0000u); }
        }
        const float rstd = rsqrtf(row_sumsq(y) * (1.f / D) + EPS);
        const float* gate = mod + (size_t)t.mrow * 12288 + 5 * D; const float* g = p.g_post_ffn + l * D;
        float* dstrow = l == 0 ? XR + (size_t)r * D : p.out + (size_t)r * D;
#pragma unroll
        for (int i = 0; i < 8; ++i) {
            const int c = i * 256 + lane * 4; const f32x4 gg = *(const f32x4*)(g + c), gt = *(const f32x4*)(gate + c);
#pragma unroll
            for (int j = 0; j < 4; ++j) x[i][j] += gt[j] * (y[i][j] * rstd * gg[j]);
            *(f32x4*)(dstrow + c) = x[i];
        }
        if (l == 0) {
            const float* mod1 = (const float*)(p.ws + WS_MOD) + (size_t)1 * 5 * 12288;
            adaln_store(x, p.g_pre_mix + 1 * D, mod1 + (size_t)t.mrow * 12288 + 0 * D, mod1 + (size_t)t.mrow * 12288 + 1 * D, hb + (size_t)r * D, nullptr, lane);
        }
    }
}

struct GemmUnit {
    const bf16_t* A; long lda; const int* rows; int rowshift;
    const bf16_t* Bt; long ldb;
    int K;
};
constexpr int GS_LD = 72;
struct LaneId { int wr, wc, fr, fq; };
DI LaneId gemm_kloop_simple(char* lds, const GemmUnit& g, f32x4 (&acc)[2][2][4][2]) {
    int tid = threadIdx.x; asm volatile("" : "+v"(tid));
    const int wid = tid >> 6, lane = tid & 63, wr = wid >> 2, wc = wid & 3, fr = lane & 15, fq = lane >> 4;
    bf16_t* As = (bf16_t*)lds; bf16_t* Bs = As + 256 * GS_LD;
#pragma unroll
    for (int a = 0; a < 2; ++a)
#pragma unroll
        for (int b = 0; b < 2; ++b)
#pragma unroll
            for (int m = 0; m < 4; ++m)
#pragma unroll
                for (int n = 0; n < 2; ++n) acc[a][b][m][n] = (f32x4){0.f, 0.f, 0.f, 0.f};
    const int srow = tid >> 3, skc = (tid & 7) * 8;
    const bf16_t* ap[4]; const bf16_t* bp[4];
#pragma unroll
    for (int i = 0; i < 4; ++i) {
        const int r = srow + 64 * i;
        if (g.rows) { const int idx = g.rows[r]; ap[i] = g.A + (size_t)(idx >= 0 ? (idx >> g.rowshift) : 0) * g.lda + skc; }
        else ap[i] = g.A + (size_t)r * g.lda + skc;
        bp[i] = g.Bt + (size_t)r * g.ldb + skc;
    }
    const int nkt = g.K / 64;
    u32x4 ra[4], rb[4];
#pragma unroll
    for (int i = 0; i < 4; ++i) { ra[i] = *(const u32x4*)(ap[i]); rb[i] = *(const u32x4*)(bp[i]); }
    for (int kt = 0; kt < nkt; ++kt) {
        __syncthreads();
#pragma unroll
        for (int i = 0; i < 4; ++i) { *(u32x4*)(As + (srow + 64 * i) * GS_LD + skc) = ra[i]; *(u32x4*)(Bs + (srow + 64 * i) * GS_LD + skc) = rb[i]; }
        __syncthreads();
        if (kt + 1 < nkt) {
#pragma unroll
            for (int i = 0; i < 4; ++i) { ra[i] = *(const u32x4*)(ap[i] + (kt + 1) * 64); rb[i] = *(const u32x4*)(bp[i] + (kt + 1) * 64); }
        }
#pragma unroll
        for (int kk = 0; kk < 2; ++kk) {
            bf16x8 bf[2][2];
#pragma unroll
            for (int bj = 0; bj < 2; ++bj)
#pragma unroll
                for (int n = 0; n < 2; ++n) bf[bj][n] = *(const bf16x8*)(Bs + (128 * bj + 32 * wc + 16 * n + fr) * GS_LD + kk * 32 + fq * 8);
#pragma unroll
            for (int ai = 0; ai < 2; ++ai)
#pragma unroll
                for (int m = 0; m < 4; ++m) {
                    const bf16x8 af = *(const bf16x8*)(As + (128 * ai + 64 * wr + 16 * m + fr) * GS_LD + kk * 32 + fq * 8);
#pragma unroll
                    for (int bj = 0; bj < 2; ++bj)
#pragma unroll
                        for (int n = 0; n < 2; ++n) acc[ai][bj][m][n] = __builtin_amdgcn_mfma_f32_16x16x32_bf16(bf[bj][n], af, acc[ai][bj][m][n], 0, 0, 0);
                }
        }
    }
    __syncthreads();
    LaneId id; id.wr = wr; id.wc = wc; id.fr = fr; id.fq = fq; return id;
}
#define GEMM_ACC f32x4 acc[2][2][4][2]
#define ACC_FOREACH(...) \
    _Pragma("unroll") for (int ai = 0; ai < 2; ++ai) _Pragma("unroll") for (int m = 0; m < 4; ++m) { const int trow = 128 * ai + 64 * wr + 16 * m + fr; \
    _Pragma("unroll") for (int bj = 0; bj < 2; ++bj) _Pragma("unroll") for (int n = 0; n < 2; ++n) { const int tcol = 128 * bj + 32 * wc + 16 * n + 4 * fq; const f32x4 v = acc[ai][bj][m][n]; __VA_ARGS__ } }

struct EpiProj {
    bf16_t* O; int row0, col0;
    DI void operator()(const f32x4 (&acc)[2][2][4][2], int wr, int wc, int fr, int fq) const {
        ACC_FOREACH({ u32x2 w; w.x = pk2(v[0], v[1]); w.y = pk2(v[2], v[3]); *(u32x2*)(O + (size_t)(row0 + trow) * INWP + col0 + tcol) = w; })
    }
};
struct EpiF32 {
    float* O; int row0, col0, ld;
    DI void operator()(const f32x4 (&acc)[2][2][4][2], int wr, int wc, int fr, int fq) const {
        ACC_FOREACH({ *(f32x4*)(O + (size_t)(row0 + trow) * ld + col0 + tcol) = v; })
    }
};
struct EpiUq {
    bf16_t* Q; const float2* ropem; int row0, col0;
    DI void operator()(const f32x4 (&acc)[2][2][4][2], int wr, int wc, int fr, int fq) const {
#pragma unroll
        for (int ai = 0; ai < 2; ++ai)
#pragma unroll
            for (int m = 0; m < 4; ++m) {
                const int r = row0 + 128 * ai + 64 * wr + 16 * m + fr; const Tok t = tok_of(r);
#pragma unroll
                for (int bj = 0; bj < 2; ++bj) {
                    const int cbase = col0 + 128 * bj + 32 * wc;
                    if (cbase >= 1152) continue;
                    const int h = cbase / 192, jb = cbase % 192;
                    f32x4 v0 = acc[ai][bj][m][0], v1 = acc[ai][bj][m][1];
                    if (jb >= 128 && !t.isctx) {
                        const int pos = (jb == 128) ? (t.s >> 6) : (t.s & 63);
#pragma unroll
                        for (int i = 0; i < 4; ++i) { const float2 cs = ropem[pos * 16 + 4 * fq + i]; const float x1 = v0[i], x2 = v1[i]; v0[i] = x1 * cs.x - x2 * cs.y; v1[i] = x2 * cs.x + x1 * cs.y; }
                    }
                    bf16_t* dst = Q + (((size_t)t.b * 6 + h) * SKV + t.kvpos) * 192 + jb + 4 * fq;
                    u32x2 w0; w0.x = pk2(v0[0], v0[1]); w0.y = pk2(v0[2], v0[3]); *(u32x2*)(dst) = w0;
                    u32x2 w1; w1.x = pk2(v1[0], v1[1]); w1.y = pk2(v1[2], v1[3]); *(u32x2*)(dst + 16) = w1;
                }
            }
    }
};
struct EpiUkv {
    bf16_t* Km; bf16_t* Vm; int row0, col0;
    DI void operator()(const f32x4 (&acc)[2][2][4][2], int wr, int wc, int fr, int fq) const {
        ACC_FOREACH({ const int r = row0 + trow; const Tok t = tok_of(r); const int c = col0 + tcol, h = c >> 8, j = c & 255;
            u32x2 w; w.x = pk2(v[0], v[1]); w.y = pk2(v[2], v[3]);
            if (j < 128) *(u32x2*)(Km + (((size_t)t.b * 6 + h) * SKV + t.kvpos) * 192 + j) = w;
            else *(u32x2*)(Vm + (((size_t)t.b * 6 + h) * SKV + t.kvpos) * 128 + (j - 128)) = w; })
    }
};
struct EpiMoe1 {
    bf16_t* act; int arow0, hcol0;
    DI void operator()(const f32x4 (&acc)[2][2][4][2], int wr, int wc, int fr, int fq) const {
#pragma unroll
        for (int ai = 0; ai < 2; ++ai)
#pragma unroll
            for (int m = 0; m < 4; ++m) {
                const int trow = 128 * ai + 64 * wr + 16 * m + fr;
#pragma unroll
                for (int n = 0; n < 2; ++n) {
                    const f32x4 a = acc[ai][0][m][n], b = acc[ai][1][m][n]; f32x4 h;
#pragma unroll
                    for (int i = 0; i < 4; ++i) h[i] = silu_f(a[i]) * b[i];
                    u32x2 w; w.x = pk2(h[0], h[1]); w.y = pk2(h[2], h[3]);
                    *(u32x2*)(act + (size_t)(arow0 + trow) * 512 + hcol0 + 32 * wc + 16 * n + 4 * fq) = w;
                }
            }
    }
};
struct EpiMoe2 {
    bf16_t* oasg; const int* sasg; const float* sw; int srow0, col0;
    DI void operator()(const f32x4 (&acc)[2][2][4][2], int wr, int wc, int fr, int fq) const {
#pragma unroll
        for (int ai = 0; ai < 2; ++ai)
#pragma unroll
            for (int m = 0; m < 4; ++m) {
                const int trow = 128 * ai + 64 * wr + 16 * m + fr; const int a = sasg[srow0 + trow]; const float wgt = sw[srow0 + trow];
                if (a < 0) continue;
#pragma unroll
                for (int bj = 0; bj < 2; ++bj)
#pragma unroll
                    for (int n = 0; n < 2; ++n) { const f32x4 v = acc[ai][bj][m][n] * wgt; u32x2 w; w.x = pk2(v[0], v[1]); w.y = pk2(v[2], v[3]);
                        *(u32x2*)(oasg + (size_t)a * D + col0 + 128 * bj + 32 * wc + 16 * n + 4 * fq) = w; }
            }
    }
};

DI void phase_postproj_rows(PR p, int l) {
    const int tid_ = tid_here(), lane = tid_ & 63, wid = tid_ >> 6;
    unsigned char* U = p.ws + WS_U;
    const bf16_t* PR = (const bf16_t*)(U + U_PROJ);
    bf16_t* CQN = (bf16_t*)(U + U_CQN); bf16_t* CKVN = (bf16_t*)(U + U_CKVN);
    bf16_t* Km = (bf16_t*)(U + U_KM); bf16_t* Qg = (bf16_t*)(U + U_QG); bf16_t* Kg = (bf16_t*)(U + U_KG); bf16_t* Vg = (bf16_t*)(U + U_VG);
    const float2* ropeg = (const float2*)(p.ws + WS_ROPEG); const float2* ropem = (const float2*)(p.ws + WS_ROPEM);
    const float* gq = p.gqa_g_q + l * 128; const float* gk = p.gqa_g_k + l * 128;
    for (int r = blockIdx.x * 8 + wid; r < NTOK; r += gridDim.x * 8) {
        const Tok t = tok_of(r);
        const bf16_t* pr = PR + (size_t)r * INWP;
        {
            float v[6], ss = 0.f;
#pragma unroll
            for (int i = 0; i < 6; ++i) { v[i] = bf2f(pr[C_CQ + lane + 64 * i]); ss += v[i] * v[i]; }
            const float rstd = rsqrtf(wave_sum(ss) * (1.f / 384.f) + EPS);
#pragma unroll
            for (int i = 0; i < 6; ++i) CQN[(size_t)r * 512 + lane + 64 * i] = f2bf(v[i] * rstd);
            CQN[(size_t)r * 512 + 384 + lane] = 0; CQN[(size_t)r * 512 + 448 + lane] = 0;
        }
        {
            float v[8], ss = 0.f;
#pragma unroll
            for (int i = 0; i < 8; ++i) { v[i] = bf2f(pr[C_CKV + lane + 64 * i]); ss += v[i] * v[i]; }
            const float rstd = rsqrtf(wave_sum(ss) * (1.f / 512.f) + EPS);
#pragma unroll
            for (int i = 0; i < 8; ++i) CKVN[(size_t)r * 512 + lane + 64 * i] = f2bf(v[i] * rstd);
        }
        {
            float x = bf2f(pr[C_KR + lane]);
            const float other = shx(x, 16, lane);
            if (!t.isctx) {
                const int g = lane >> 5, idx = lane & 31, fi = idx & 15; const bool second = idx >= 16;
                const int pos = g == 0 ? (t.s >> 6) : (t.s & 63);
                const float2 cs = ropem[pos * 16 + fi];
                x = second ? x * cs.x + other * cs.y : x * cs.x - other * cs.y;
            }
            const bf16_t xb = f2bf(x);
#pragma unroll
            for (int h = 0; h < 6; ++h) Km[(((size_t)t.b * 6 + h) * SKV + t.kvpos) * 192 + 128 + lane] = xb;
        }
        const int fi = lane & 31; const bool second = lane >= 32;
        float2 cs0 = make_float2(1.f, 0.f), cs1 = make_float2(1.f, 0.f);
        if (!t.isctx) { cs0 = ropeg[(t.s >> 6) * 32 + fi]; cs1 = ropeg[(t.s & 63) * 32 + fi]; }
#pragma unroll
        for (int hh = 0; hh < 8; ++hh) {
            const bool isq = hh < 6; const int h = isq ? hh : hh - 6; const float* g = isq ? gq : gk;
            const int cb = (isq ? C_AQ : C_AK) + h * 128;
            float e0 = bf2f(pr[cb + lane]), e1 = bf2f(pr[cb + 64 + lane]);
            const float rstd = rsqrtf(wave_sum(e0 * e0 + e1 * e1) * (1.f / 128.f) + EPS);
            e0 = e0 * rstd * g[lane]; e1 = e1 * rstd * g[64 + lane];
            const float o0 = shx(e0, 32, lane), o1 = shx(e1, 32, lane);
            const float r0 = second ? e0 * cs0.x + o0 * cs0.y : e0 * cs0.x - o0 * cs0.y;
            const float r1 = second ? e1 * cs1.x + o1 * cs1.y : e1 * cs1.x - o1 * cs1.y;
            bf16_t* dst = isq ? Qg + (((size_t)t.b * 6 + h) * SKV + t.kvpos) * 128 : Kg + (((size_t)t.b * 2 + h) * SKV + t.kvpos) * 128;
            dst[lane] = f2bf(r0); dst[64 + lane] = f2bf(r1);
        }
#pragma unroll
        for (int h = 0; h < 2; ++h) { bf16_t* dst = Vg + (((size_t)t.b * 2 + h) * SKV + t.kvpos) * 128; dst[lane] = pr[C_AV + h * 128 + lane]; dst[64 + lane] = pr[C_AV + h * 128 + 64 + lane]; }
    }
}

constexpr int GL_K = 0, GL_LF = 4160, GL_LB = 8320, GL_ZF = 12480, GL_ZB = 13504, GL_WF = 14528, GL_WB = 15552, GL_V = 16576, GL_X0 = 24768;
constexpr int GL_KEF = GL_X0, GL_KEB = GL_X0 + 4160;
constexpr int GL_Q = GL_X0, GL_QD = GL_X0 + 4160, GL_KI = GL_X0 + 8320, GL_ATT = GL_ZF, GL_RED = GL_X0 + 12480;
DI int gla_row0(int b, int c) { return c < 4 ? NLAT + b * CTXL + c * 64 : b * SEQ + (c - 4) * 64; }
DI void gla_prep(PR p, int l, float* L, int b, int h, int c, bool needq) {
    int tid = threadIdx.x; asm volatile("" : "+v"(tid));
    const bf16_t* PR = (const bf16_t*)(p.ws + WS_U + U_PROJ);
    const int row0 = gla_row0(b, c);
    {
        const int t = tid >> 3, dg = (tid & 7) * 8; const bf16_t* pr = PR + (size_t)(row0 + t) * INWP;
        const bf16x8 kv = *(const bf16x8*)(pr + C_GK + h * 64 + dg);
#pragma unroll
        for (int j = 0; j < 8; ++j) L[GL_K + t * 65 + dg + j] = bf2f((bf16_t)kv[j]);
        if (needq) { const bf16x8 qv = *(const bf16x8*)(pr + C_GQ + h * 64 + dg);
#pragma unroll
            for (int j = 0; j < 8; ++j) L[GL_Q + t * 65 + dg + j] = bf2f((bf16_t)qv[j]) * 0.125f; }
        const int jg = (tid & 7) * 16;
#pragma unroll
        for (int q = 0; q < 2; ++q) { const bf16x8 vv = *(const bf16x8*)(pr + C_GV + h * 128 + jg + 8 * q);
#pragma unroll
            for (int j = 0; j < 8; ++j) L[GL_V + t * 128 + jg + 8 * q + j] = bf2f((bf16_t)vv[j]); }
        if (tid < 256) { const int tt = (tid & 127) >> 1, half = tid & 1, dir = tid >> 7; const bf16x8 zv = *(const bf16x8*)(PR + (size_t)(row0 + tt) * INWP + (dir ? C_ZB : C_ZF) + half * 8);
#pragma unroll
            for (int j = 0; j < 8; ++j) L[(dir ? GL_ZB : GL_ZF) + tt * 16 + half * 8 + j] = bf2f((bf16_t)zv[j]); }
        for (int i = tid; i < 2048; i += NTHREADS) { const int dir = i >> 10, rr = (i >> 6) & 15, d = i & 63;
            L[(dir ? GL_WB : GL_WF) + rr * 64 + d] = (dir ? p.gla_wg2_b : p.gla_wg2_f)[((size_t)l * 16 + rr) * 256 + h * 64 + d]; }
    }
    __syncthreads();
    for (int idx = tid; idx < 8192; idx += NTHREADS) {
        const int dir = idx >> 12, t = (idx >> 6) & 63, d = idx & 63;
        const float* Z = L + (dir ? GL_ZB : GL_ZF) + t * 16; const float* W = L + (dir ? GL_WB : GL_WF) + d;
        float z = (dir ? p.gla_bg_b : p.gla_bg_f)[l * 256 + h * 64 + d];
#pragma unroll
        for (int rr = 0; rr < 16; ++rr) z += Z[rr] * W[rr * 64];
        const float ls = fminf(z, 0.f) - log1pf(expf(-fabsf(z)));
        L[(dir ? GL_LB : GL_LF) + t * 65 + d] = ls * (1.f / 16.f);
    }
    __syncthreads();
    if (tid < 64) { float s = 0.f; for (int t = 0; t < 64; ++t) { s += L[GL_LF + t * 65 + tid]; L[GL_LF + t * 65 + tid] = s; } }
    else if (tid < 128) { const int d = tid - 64; float s = 0.f; for (int t = 63; t >= 0; --t) { s += L[GL_LB + t * 65 + d]; L[GL_LB + t * 65 + d] = s; } }
    __syncthreads();
}
DI void gla_phaseA(PR p, int l, char* lds) {
    float* L = (float*)lds; int tid = threadIdx.x; asm volatile("" : "+v"(tid));
    float* GS = (float*)(p.ws + WS_U + U_GS); float* GD = (float*)(p.ws + WS_GDEC);
    for (int u = blockIdx.x; u < 16 * 68; u += gridDim.x) {
        const int bh = u / 68, c = u % 68, b = bh >> 2, h = bh & 3;
        gla_prep(p, l, L, b, h, c, false);
        for (int idx = tid; idx < 4096; idx += NTHREADS) { const int t = idx >> 6, d = idx & 63; const float k = L[GL_K + t * 65 + d];
            L[GL_KEF + t * 65 + d] = k * expf(L[GL_LF + 63 * 65 + d] - L[GL_LF + t * 65 + d]);
            L[GL_KEB + t * 65 + d] = k * expf(L[GL_LB + 0 * 65 + d] - L[GL_LB + t * 65 + d]); }
        if (tid < 64) GD[((size_t)(0 * 16 + bh) * 68 + c) * 64 + tid] = expf(L[GL_LF + 63 * 65 + tid]);
        else if (tid < 128) GD[((size_t)(1 * 16 + bh) * 68 + c) * 64 + (tid - 64)] = expf(L[GL_LB + 0 * 65 + (tid - 64)]);
        __syncthreads();
        const int j = tid & 127, dq = tid >> 7;
        float af[16], ab[16];
#pragma unroll
        for (int i = 0; i < 16; ++i) { af[i] = 0.f; ab[i] = 0.f; }
        for (int t = 0; t < 64; ++t) { const float vv = L[GL_V + t * 128 + j];
#pragma unroll
            for (int i = 0; i < 16; ++i) { af[i] += L[GL_KEF + t * 65 + dq * 16 + i] * vv; ab[i] += L[GL_KEB + t * 65 + dq * 16 + i] * vv; } }
#pragma unroll
        for (int i = 0; i < 16; ++i) { GS[((size_t)(0 * 16 + bh) * 68 + c) * 8192 + (dq * 16 + i) * 128 + j] = af[i]; GS[((size_t)(1 * 16 + bh) * 68 + c) * 8192 + (dq * 16 + i) * 128 + j] = ab[i]; }
        __syncthreads();
    }
}
DI void gla_scan(PR p) {
    float* GS = (float*)(p.ws + WS_U + U_GS); const float* GD = (const float*)(p.ws + WS_GDEC);
    for (int u = blockIdx.x; u < 512; u += gridDim.x) {
        const int e = u * NTHREADS + tid_here(), db = e >> 13, dj = e & 8191, d = dj >> 7;
        const int dir = db >> 4;
        float S = 0.f;
        for (int i = 0; i < 68; ++i) {
            const int c = dir == 0 ? i : (i < 4 ? 3 - i : 71 - i);
            float* ptr = GS + ((size_t)db * 68 + c) * 8192 + dj;
            const float ds = *ptr, dec = GD[((size_t)db * 68 + c) * 64 + d];
            *ptr = S; S = dec * S + ds;
        }
    }
}
DI void gla_phaseC(PR p, int l, char* lds) {
    float* L = (float*)lds; int tid = threadIdx.x; asm volatile("" : "+v"(tid)); const int wid = tid >> 6;
    const float* GS = (const float*)(p.ws + WS_U + U_GS);
    const bf16_t* PR = (const bf16_t*)(p.ws + WS_U + U_PROJ); bf16_t* MIX = (bf16_t*)(p.ws + WS_U + U_MIX);
    for (int u = blockIdx.x; u < 16 * 68; u += gridDim.x) {
        const int bh = u / 68, c = u % 68, b = bh >> 2, h = bh & 3;
        if (l == 1 && c < 4) continue;
        gla_prep(p, l, L, b, h, c, true);
        const int j = tid & 127, tq = tid >> 7;
        float o[16];
#pragma unroll
        for (int i = 0; i < 16; ++i) o[i] = 0.f;
        for (int dir = 0; dir < 2; ++dir) {
            const float* LC = L + (dir ? GL_LB : GL_LF);
            for (int idx = tid; idx < 4096; idx += NTHREADS) { const int t = idx >> 6, d = idx & 63; const float bc = LC[t * 65 + d];
                L[GL_QD + t * 65 + d] = L[GL_Q + t * 65 + d] * expf(bc); L[GL_KI + t * 65 + d] = L[GL_K + t * 65 + d] * expf(-bc); }
            __syncthreads();
            { const int s = tid & 63, tg = tid >> 6;
                float a[8];
#pragma unroll
                for (int i = 0; i < 8; ++i) a[i] = 0.f;
                for (int d = 0; d < 64; ++d) { const float kv = L[GL_KI + s * 65 + d];
#pragma unroll
                    for (int i = 0; i < 8; ++i) a[i] += L[GL_QD + (tg * 8 + i) * 65 + d] * kv; }
#pragma unroll
                for (int i = 0; i < 8; ++i) { const int t = tg * 8 + i; const bool ok = dir == 0 ? (s <= t) : (s >= t); L[GL_ATT + t * 64 + s] = ok ? a[i] : 0.f; } }
            __syncthreads();
            for (int s = 0; s < 64; ++s) { const float vv = L[GL_V + s * 128 + j];
#pragma unroll
                for (int i = 0; i < 16; ++i) o[i] += L[GL_ATT + (tq * 16 + i) * 64 + s] * vv; }
            const float* Sg = GS + ((size_t)(dir * 16 + bh) * 68 + c) * 8192;
            for (int d = 0; d < 64; ++d) { const float sv = Sg[d * 128 + j];
#pragma unroll
                for (int i = 0; i < 16; ++i) o[i] += L[GL_QD + (tq * 16 + i) * 65 + d] * sv; }
            __syncthreads();
        }
#pragma unroll
        for (int i = 0; i < 16; ++i) { const float ss = wave_sum(o[i] * o[i]); if ((tid & 63) == 0) L[GL_RED + wid * 16 + i] = ss; }
        __syncthreads();
        const int row0 = gla_row0(b, c); const float go = p.gla_g_out[l * 128 + j];
#pragma unroll
        for (int i = 0; i < 16; ++i) {
            const int t = tq * 16 + i; const float tot = L[GL_RED + (2 * tq) * 16 + i] + L[GL_RED + (2 * tq + 1) * 16 + i];
            const float rstd = rsqrtf(tot * (1.f / 128.f) + EPS);
            const float gate = bf2f(PR[(size_t)(row0 + t) * INWP + C_GG + h * 128 + j]);
            MIX[(size_t)(row0 + t) * D + h * 128 + j] = f2bf(o[i] * rstd * go * silu_f(gate));
        }
        __syncthreads();
    }
}

#define SBAR() __builtin_amdgcn_sched_barrier(0)
DI int crow(int r, int hi) { return (r & 3) + 8 * (r >> 2) + 4 * hi; }
DI unsigned cvtpk(float lo, float hi) { unsigned r; asm volatile("v_cvt_pk_bf16_f32 %0, %1, %2" : "=v"(r) : "v"(lo), "v"(hi)); return r; }
constexpr float ATT_THR = 8.f;
template <int DQK> struct AttnCfg {
    static constexpr int KROWB = DQK * 2;
    static constexpr int SHM_V = 64 * 128 * 2, SHM_K = 64 * DQK * 2;
    static constexpr int ND0 = DQK / 16;
    static constexpr int NKCH = DQK / 64;
    static constexpr int NQR = DQK == 128 ? 8 : ATT_NQR_M;
    static constexpr int SHM_Q = 8 * (ND0 - NQR) * 1024;
    static constexpr int SHM_TOTAL = 2 * SHM_V + 2 * SHM_K + 8 * 64 * 4 + SHM_Q;
};
template <int DQK> DI int kswz(int row, int colB) { return row * (DQK * 2) + (colB ^ ((row & 7) << 4)); }
DI void partialSM(f32x16& p0, f32x16& p1, float& m_reg, float& mn, float& alpha, const float SCALE) {
    const float C = SCALE * 1.4426950408889634f;
    float pmax = p0[0];
#pragma unroll
    for (int r = 1; r < 16; ++r) pmax = fmaxf(pmax, p0[r]);
#pragma unroll
    for (int r = 0; r < 16; ++r) pmax = fmaxf(pmax, p1[r]);
    { auto rr = __builtin_amdgcn_permlane32_swap(__float_as_uint(pmax), __float_as_uint(pmax), false, false);
      pmax = fmaxf(__uint_as_float(rr[0]), __uint_as_float(rr[1])); }
    if (__builtin_expect(__all(pmax - m_reg <= ATT_THR / SCALE), 1)) { mn = m_reg; alpha = 1.f; }
    else { mn = fmaxf(m_reg, pmax); alpha = __builtin_amdgcn_exp2f((m_reg - mn) * C); m_reg = mn; }
    const float mnC = -mn * C;
#pragma unroll
    for (int r = 0; r < 16; ++r) p0[r] = fmaf(p0[r], C, mnC);
#pragma unroll
    for (int r = 0; r < 16; ++r) p1[r] = fmaf(p1[r], C, mnC);
#pragma unroll
    for (int r = 0; r < 16; ++r) p0[r] = __builtin_amdgcn_exp2f(p0[r]);
}
DI void finishSM(f32x16& p0, f32x16& p1, float alpha, float& l_reg, bf16x8& pa0, bf16x8& pa1, bf16x8& pa2, bf16x8& pa3) {
#pragma unroll
    for (int r = 0; r < 16; ++r) p1[r] = __builtin_amdgcn_exp2f(p1[r]);
    float ps = 0;
#pragma unroll
    for (int r = 0; r < 16; ++r) ps += p0[r];
#pragma unroll
    for (int r = 0; r < 16; ++r) ps += p1[r];
    { auto rr = __builtin_amdgcn_permlane32_swap(__float_as_uint(ps), __float_as_uint(ps), false, false);
      ps = __uint_as_float(rr[0]) + __uint_as_float(rr[1]); }
    l_reg = l_reg * alpha + ps;
#define PK4(P, BASE, OUT) do { unsigned a0 = cvtpk(P[BASE + 0], P[BASE + 1]), a1 = cvtpk(P[BASE + 2], P[BASE + 3]);   \
    unsigned b0 = cvtpk(P[BASE + 4], P[BASE + 5]), b1 = cvtpk(P[BASE + 6], P[BASE + 7]);                              \
    auto r0 = __builtin_amdgcn_permlane32_swap(a0, b0, false, false); auto r1 = __builtin_amdgcn_permlane32_swap(a1, b1, false, false); \
    u32x4 w = {r0[0], r1[0], r0[1], r1[1]}; OUT = *reinterpret_cast<bf16x8*>(&w); } while (0)
    PK4(p0, 0, pa0); PK4(p0, 8, pa1); PK4(p1, 0, pa2); PK4(p1, 8, pa3);
#undef PK4
}
template <int DQK, int NQR>
DI void qkt(f32x16& p0, f32x16& p1, const int (&kb)[4], int bufoff, const bf16x8* qr, int qs_addr, int r32, int hi) {
    asm volatile("" : "+v"(qs_addr));
    const LAS char* Qs = (const LAS char*)qs_addr;
#pragma unroll
    for (int r = 0; r < 16; ++r) { p0[r] = 0.f; p1[r] = 0.f; }
#pragma unroll
    for (int d0 = 0; d0 < DQK / 16; ++d0) {
        const LAS char* ka = (const LAS char*)(kb[d0 & 3]) + bufoff + 128 * (d0 >> 2);
        const bf16x8 b0 = *(const LAS bf16x8*)(ka);
        const bf16x8 b1 = *(const LAS bf16x8*)(ka + 32 * DQK * 2);
        bf16x8 q;
        if (d0 < NQR) q = qr[d0]; else q = *(const LAS bf16x8*)(Qs + (d0 - NQR) * 1024);
        p0 = __builtin_amdgcn_mfma_f32_32x32x16_bf16(b0, q, p0, 0, 0, 0);
        p1 = __builtin_amdgcn_mfma_f32_32x32x16_bf16(b1, q, p1, 0, 0, 0); }
}
DI int v_st(int k, int c) { const int kk = (k & ~0xC) | ((k & 4) << 1) | ((k & 8) >> 1); return ((kk >> 3) * 4 + (c >> 5)) * 512 + ((kk & 7) * 32 + (c & 31)) * 2; }
DI int v_rd_base(int lane) { return ((lane & 3) << 3) | (((lane >> 2) & 3) << 6) | (((lane >> 4) & 1) << 5) | (((lane >> 5) & 1) << 8); }
constexpr int v_rd_off(int d0, int ks, int half) { return d0 * 512 + ks * 4096 + half * 2048; }
template <int OFF> DI s16x4 tr_read(int vb) { s16x4 r; asm volatile("ds_read_b64_tr_b16 %0, %1 offset:%2" : "=&v"(r) : "v"(vb), "i"(OFF) : "memory"); return r; }
template <int D0> DI void pv_one(f32x16& od, int vb, bf16x8 pa0, bf16x8 pa1, bf16x8 pa2, bf16x8 pa3) {
    const s16x4 l0 = tr_read<v_rd_off(D0, 0, 0)>(vb), h0 = tr_read<v_rd_off(D0, 0, 1)>(vb), l1 = tr_read<v_rd_off(D0, 1, 0)>(vb), h1 = tr_read<v_rd_off(D0, 1, 1)>(vb);
    const s16x4 l2 = tr_read<v_rd_off(D0, 2, 0)>(vb), h2 = tr_read<v_rd_off(D0, 2, 1)>(vb), l3 = tr_read<v_rd_off(D0, 3, 0)>(vb), h3 = tr_read<v_rd_off(D0, 3, 1)>(vb);
    asm volatile("s_waitcnt lgkmcnt(0)" ::: "memory"); SBAR();
#define PKV(L, H) (bf16x8){L[0], L[1], L[2], L[3], H[0], H[1], H[2], H[3]}
    od = __builtin_amdgcn_mfma_f32_32x32x16_bf16(pa0, PKV(l0, h0), od, 0, 0, 0);
    od = __builtin_amdgcn_mfma_f32_32x32x16_bf16(pa1, PKV(l1, h1), od, 0, 0, 0);
    od = __builtin_amdgcn_mfma_f32_32x32x16_bf16(pa2, PKV(l2, h2), od, 0, 0, 0);
    od = __builtin_amdgcn_mfma_f32_32x32x16_bf16(pa3, PKV(l3, h3), od, 0, 0, 0);
#undef PKV
}
DI void pv_d0(f32x16* o, int vb, bf16x8 pa0, bf16x8 pa1, bf16x8 pa2, bf16x8 pa3) {
    pv_one<0>(o[0], vb, pa0, pa1, pa2, pa3); pv_one<1>(o[1], vb, pa0, pa1, pa2, pa3); pv_one<2>(o[2], vb, pa0, pa1, pa2, pa3); pv_one<3>(o[3], vb, pa0, pa1, pa2, pa3);
}
template <int DQK, int SDEPTH>
DI void attn_body(const bf16_t* __restrict__ Qb, const bf16_t* __restrict__ Kh, const bf16_t* __restrict__ Vh, bf16_t* __restrict__ Ob, int ldo, int seq, char* lds, const float SCALE) {
    using Cfg = AttnCfg<DQK>;
    constexpr int SHM_V = Cfg::SHM_V, SHM_K = Cfg::SHM_K, ND0 = Cfg::ND0, NKCH = Cfg::NKCH, KCPR = DQK / 8, NQR = Cfg::NQR;
    int tid = threadIdx.x; asm volatile("" : "+v"(tid));
    const int wid = tid >> 6, lane = tid & 63, r32 = lane & 31, hi = lane >> 5;
    char* V_lds = lds; char* K_lds = lds + 2 * SHM_V;
    float* ws = (float*)(lds + 2 * SHM_V + 2 * SHM_K) + wid * 64; float* li_l = ws; float* al_l = ws + 32;
    float m_reg = -1e30f, l_reg = 0; f32x16 o[4]; bf16x8 qr[NQR > 0 ? NQR : 1];
    char* Qs = lds + 2 * SHM_V + 2 * SHM_K + 8 * 64 * 4 + (wid * (ND0 - NQR) * 64 + lane) * 16;
#pragma unroll
    for (int d = 0; d < 4; ++d)
#pragma unroll
        for (int r = 0; r < 16; ++r) o[d][r] = 0.f;
    const bf16_t* Qw = Qb + (long)(wid * 32 + r32) * DQK + hi * 8;
#pragma unroll
    for (int d0 = 0; d0 < ND0; ++d0) { const bf16x8 qv = *reinterpret_cast<const bf16x8*>(Qw + d0 * 16); if (d0 < NQR) qr[d0] = qv; else *reinterpret_cast<bf16x8*>(Qs + (d0 - NQR) * 1024) = qv; }
    asm volatile("s_waitcnt lgkmcnt(0)" ::: "memory");
    const int sr = tid >> 4, sc = (tid & 15) * 8, vst0 = v_st(sr, sc), vst1 = v_st(32 + sr, sc);
    const int kgo = (tid >> 3) * DQK + (tid & 7) * 8, klo = (tid >> 3) * (DQK * 2) + (((tid & 7) << 4) ^ (((tid >> 3) & 7) << 4));
    const int vb0 = (int)(uintptr_t)V_lds + v_rd_base(lane);
    int kb[4];
#pragma unroll
    for (int m = 0; m < 4; ++m) { kb[m] = (int)(uintptr_t)K_lds + r32 * (DQK * 2) + 16 * (hi ^ (r32 & 1)) + 32 * (m ^ ((r32 >> 1) & 3)); asm volatile("" : "+v"(kb[m])); }
    struct { bf16x8 vs0, vs1, ks[NKCH]; } sr_[SDEPTH];
#define SLOAD(i, k0) do { sr_[i].vs0 = *(const bf16x8*)(&Vh[(long)((k0) + sr) * 128 + sc]); sr_[i].vs1 = *(const bf16x8*)(&Vh[(long)((k0) + 32 + sr) * 128 + sc]); \
    _Pragma("unroll") for (int q_ = 0; q_ < NKCH; ++q_) sr_[i].ks[q_] = *(const bf16x8*)(&Kh[(long)(k0) * DQK + kgo + q_ * 64]); } while (0)
#define SWRITE(b, i) do { *(bf16x8*)(V_lds + (b) * SHM_V + vst0) = sr_[i].vs0; *(bf16x8*)(V_lds + (b) * SHM_V + vst1) = sr_[i].vs1; \
    _Pragma("unroll") for (int q_ = 0; q_ < NKCH; ++q_) *(bf16x8*)(K_lds + (b) * SHM_K + klo + q_ * 128) = sr_[i].ks[q_]; } while (0)
#define SWAIT() do { if constexpr (SDEPTH == 1) asm volatile("s_waitcnt vmcnt(0)" ::: "memory"); else if constexpr (NKCH == 2) asm volatile("s_waitcnt vmcnt(4)" ::: "memory"); else asm volatile("s_waitcnt vmcnt(5)" ::: "memory"); } while (0)
#define RESC(a) do { if (__any((a) < 1.f)) { if (hi == 0) al_l[r32] = (a); asm volatile("s_waitcnt lgkmcnt(0)" ::: "memory"); \
    _Pragma("unroll") for (int d = 0; d < 4; ++d) _Pragma("unroll") for (int r = 0; r < 16; ++r) o[d][r] *= al_l[crow(r, hi)]; } } while (0)
    f32x16 pA0, pA1, pB0, pB1; float mnA, mnB, alA, alB; bf16x8 pa0, pa1, pa2, pa3; const int NT = seq / 64;
    constexpr int SE = 0, SO = SDEPTH - 1;
    SLOAD(SE, 0); asm volatile("s_waitcnt vmcnt(0)" ::: "memory"); SWRITE(0, SE); __syncthreads();
    qkt<DQK, NQR>(pA0, pA1, kb, 0, qr, (int)(uintptr_t)Qs, r32, hi); partialSM(pA0, pA1, m_reg, mnA, alA, SCALE);
    SLOAD(SO, 64); if constexpr (SDEPTH == 2) { if (2 < NT) SLOAD(SE, 2 * 64); }
    SWAIT(); SWRITE(1, SO); __syncthreads();
    for (int j = 1; j + 1 < NT; j += 2) {
        SBAR(); qkt<DQK, NQR>(pB0, pB1, kb, SHM_K, qr, (int)(uintptr_t)Qs, r32, hi);
        finishSM(pA0, pA1, alA, l_reg, pa0, pa1, pa2, pa3); SBAR();
        SLOAD(SO, (j + SDEPTH) * 64); SBAR();
        pv_d0(o, vb0, pa0, pa1, pa2, pa3); partialSM(pB0, pB1, m_reg, mnB, alB, SCALE);
        __syncthreads(); SWAIT(); SWRITE(0, SE);
        RESC(alB); __syncthreads();
        SBAR(); qkt<DQK, NQR>(pA0, pA1, kb, 0, qr, (int)(uintptr_t)Qs, r32, hi);
        finishSM(pB0, pB1, alB, l_reg, pa0, pa1, pa2, pa3); SBAR();
        if (SDEPTH == 1 || j + 3 < NT) SLOAD(SE, (j + 1 + SDEPTH) * 64); SBAR();
        pv_d0(o, vb0 + SHM_V, pa0, pa1, pa2, pa3); partialSM(pA0, pA1, m_reg, mnA, alA, SCALE);
        __syncthreads(); SWAIT(); SWRITE(1, SO);
        RESC(alA); __syncthreads();
    }
    SBAR(); qkt<DQK, NQR>(pB0, pB1, kb, SHM_K, qr, (int)(uintptr_t)Qs, r32, hi);
    finishSM(pA0, pA1, alA, l_reg, pa0, pa1, pa2, pa3); SBAR();
    pv_d0(o, vb0, pa0, pa1, pa2, pa3); partialSM(pB0, pB1, m_reg, mnB, alB, SCALE);
    __syncthreads(); RESC(alB);
    finishSM(pB0, pB1, alB, l_reg, pa0, pa1, pa2, pa3); SBAR();
    pv_d0(o, vb0 + SHM_V, pa0, pa1, pa2, pa3);
    if (hi == 0) li_l[r32] = l_reg; asm volatile("s_waitcnt lgkmcnt(0)" ::: "memory");
    float rli[16];
#pragma unroll
    for (int r = 0; r < 16; ++r) rli[r] = __builtin_amdgcn_rcpf(li_l[crow(r, hi)]);
    bf16_t* Ow = Ob + (long)(wid * 32) * ldo;
#pragma unroll
    for (int r = 0; r < 16; ++r) { const int orow = crow(r, hi);
#pragma unroll
        for (int d0 = 0; d0 < 4; ++d0) Ow[(long)orow * ldo + d0 * 32 + r32] = f2bf(o[d0][r] * rli[r]); }
    __syncthreads();
#undef SLOAD
#undef SWRITE
#undef SWAIT
#undef RESC
}

namespace pg {
constexpr int BK = 64, HALF = 128, HTB = HALF * BK * 2, STAGE_BYTES = 8 * HTB;
DI int lds_byte(int r, int c) { const int st = (r >> 4) * 2 + (c >> 5), rr = r & 15, cc = c & 31, ob = rr * 64 + cc * 2; return st * 1024 + (ob ^ (((ob >> 9) & 1) << 5)); }
DI void stage_rc(int b, int& R, int& C) { const int st = b / 1024, sb = b % 1024, swz = sb ^ (((sb >> 9) & 1) << 5); R = (st >> 1) * 16 + swz / 64; C = (st & 1) * 32 + (swz % 64) / 2; }
struct XUnit {
    const char* A;
    const char* B;
    int arow0;
    int list;
    int e0, e1, e2, e3;
};
template <class Sched>
DI void gemm_phase(LAS unsigned char* lds, const LAS int* rowlists, const Sched& S) {
    int tid = threadIdx.x; asm volatile("" : "+v"(tid));
    const int wid = __builtin_amdgcn_readfirstlane(tid >> 6), lane = tid & 63, wr = wid >> 2, wc = wid & 3, fr = lane & 15, fq = lane >> 4;
    const int K = S.K, nt = K / BK;
    unsigned voffB[2];
#pragma unroll
    for (int i = 0; i < 2; ++i) { int R_, C_; stage_rc(tid * 16 + i * 8192, R_, C_); voffB[i] = (unsigned)R_ * (unsigned)S.ldb + (unsigned)C_ * 2u; }
    const size_t kstep = (size_t)(BK * 2), hstepB = (size_t)HALF * S.ldb;
    const unsigned ldsw = (unsigned)wid * 1024u;
    const int aoff = lds_byte(wr * 64 + fr, fq * 8), boff = lds_byte(wc * 32 + fr, fq * 8);
#define PG_SA(b, h) (((b) * 2 + (h)) * HTB)
#define PG_SB(b, h) ((4 + (b) * 2 + (h)) * HTB)
#define PG_STAGE(bufoff, gbase, voff) do { _Pragma("unroll") for (int _i = 0; _i < 2; ++_i) \
        __builtin_amdgcn_global_load_lds((const unsigned*)((const char*)(gbase) + (voff)[_i]), (LAS unsigned*)(lds + (bufoff) + ldsw + _i * 8192), 16, 0, 0); } while (0)
#define PG_LDA(dst, b, h) do { _Pragma("unroll") for (int m = 0; m < 4; ++m) _Pragma("unroll") for (int k = 0; k < 2; ++k) dst[m][k] = *(const LAS bf16x8*)(lds + PG_SA(b, h) + aoff + m * 2048 + k * 1024); } while (0)
#define PG_LDB(dst, b, h) do { _Pragma("unroll") for (int n = 0; n < 2; ++n) _Pragma("unroll") for (int k = 0; k < 2; ++k) dst[n][k] = *(const LAS bf16x8*)(lds + PG_SB(b, h) + boff + n * 2048 + k * 1024); } while (0)
#define PG_MMA(ai, bj, At, Bt) do { __builtin_amdgcn_s_setprio(1); _Pragma("unroll") for (int m = 0; m < 4; ++m) _Pragma("unroll") for (int n = 0; n < 2; ++n) _Pragma("unroll") for (int k = 0; k < 2; ++k) \
        acc[ai][bj][m][n] = __builtin_amdgcn_mfma_f32_16x16x32_bf16(Bt[n][k], At[m][k], acc[ai][bj][m][n], 0, 0, 0); __builtin_amdgcn_s_setprio(0); } while (0)
#define PG_WAIT_V(n) asm volatile("s_waitcnt vmcnt(" #n ")" ::: "memory")
#define PG_WAIT_L(n) asm volatile("s_waitcnt lgkmcnt(" #n ")" ::: "memory")
#define PG_BAR __builtin_amdgcn_s_barrier()
#define PG_SCHED __builtin_amdgcn_sched_barrier(0)
#define PG_AOFFS(dst, u) do { const int _t = tid_here(); _Pragma("unroll") for (int _i = 0; _i < 2; ++_i) { int _R, _C; stage_rc(_t * 16 + _i * 8192, _R, _C); _Pragma("unroll") for (int _h = 0; _h < 2; ++_h) { \
        unsigned _row; if ((u).list >= 0) { const int _x = rowlists[(u).list + _h * HALF + _R]; _row = _x >= 0 ? (unsigned)(_x >> S.rowshift) : 0u; } else _row = (unsigned)((u).arow0 + _h * HALF + _R); \
        dst[_h][_i] = _row * (unsigned)S.lda + (unsigned)_C * 2u; } } } while (0)
    XUnit cur, nxt; int ui = 0;
    if (!S.next(0, cur)) return;
    f32x4 acc[2][2][4][2];
#pragma unroll
    for (int a = 0; a < 2; ++a)
#pragma unroll
        for (int b = 0; b < 2; ++b)
#pragma unroll
            for (int m = 0; m < 4; ++m)
#pragma unroll
                for (int n = 0; n < 2; ++n) acc[a][b][m][n] = (f32x4){0.f, 0.f, 0.f, 0.f};
    bf16x8 At[4][2], B0[2][2], B1[2][2];
    unsigned ao[2][2];
    PG_AOFFS(ao, cur);
    PG_WAIT_L(0); PG_SCHED;
    const char* cA = cur.A; const char* cB = cur.B;
    PG_STAGE(PG_SB(0, 0), cB, voffB); PG_STAGE(PG_SA(0, 0), cA, ao[0]); PG_STAGE(PG_SB(0, 1), cB + hstepB, voffB); PG_STAGE(PG_SA(0, 1), cA, ao[1]);
    if (wr == 1) PG_BAR;
    PG_WAIT_V(4); PG_BAR;
    PG_STAGE(PG_SB(1, 0), cB + kstep, voffB); PG_STAGE(PG_SA(1, 0), cA + kstep, ao[0]); PG_STAGE(PG_SB(1, 1), cB + hstepB + kstep, voffB);
    PG_WAIT_V(6); PG_BAR;
    for (;;) {
        const bool has_next = S.next(ui + 1, nxt);
        const char* nA = has_next ? nxt.A : cA; const char* nB = has_next ? nxt.B : cB;
        for (int t = 0; t < nt; t += 2) {
            const bool last = (t == nt - 2);
            const char* a1 = cA + (size_t)(t + 1) * kstep;
            const char* a2 = last ? nA : cA + (size_t)(t + 2) * kstep; const char* b2 = last ? nB : cB + (size_t)(t + 2) * kstep;
            const char* a3 = a2 + kstep; const char* b3 = b2 + kstep;
            PG_LDB(B0, 0, 0); PG_SCHED; PG_LDA(At, 0, 0); PG_STAGE(PG_SA(1, 1), a1, ao[1]);
            PG_WAIT_L(8); PG_BAR; PG_WAIT_L(0); PG_MMA(0, 0, At, B0); PG_BAR; PG_SCHED;
            if (last && has_next) { PG_AOFFS(ao, nxt); }
            PG_LDB(B1, 0, 1); PG_STAGE(PG_SB(0, 0), b2, voffB);
            PG_BAR; PG_WAIT_L(0); PG_MMA(0, 1, At, B1); PG_BAR;
            PG_LDA(At, 0, 1); PG_STAGE(PG_SA(0, 0), a2, ao[0]);
            PG_BAR; PG_WAIT_L(0); PG_MMA(1, 0, At, B0); PG_BAR; PG_SCHED;
            PG_STAGE(PG_SB(0, 1), b2 + hstepB, voffB);
            PG_WAIT_V(6); PG_BAR; PG_MMA(1, 1, At, B1); PG_BAR;
            PG_LDB(B0, 1, 0); PG_SCHED; PG_LDA(At, 1, 0); PG_STAGE(PG_SA(0, 1), a2, ao[1]);
            PG_WAIT_L(8); PG_BAR; PG_WAIT_L(0); PG_MMA(0, 0, At, B0); PG_BAR; PG_SCHED;
            PG_LDB(B1, 1, 1); PG_STAGE(PG_SB(1, 0), b3, voffB);
            PG_BAR; PG_WAIT_L(0); PG_MMA(0, 1, At, B1); PG_BAR;
            PG_LDA(At, 1, 1); PG_STAGE(PG_SA(1, 0), a3, ao[0]);
            PG_BAR; PG_WAIT_L(0); PG_MMA(1, 0, At, B0); PG_BAR; PG_SCHED;
            PG_STAGE(PG_SB(1, 1), b3 + hstepB, voffB);
            PG_WAIT_V(6); PG_BAR; PG_MMA(1, 1, At, B1); PG_BAR;
        }
        S.epi(acc, cur, wr, wc, fr, fq);
        if (!has_next) break;
#pragma unroll
        for (int a = 0; a < 2; ++a)
#pragma unroll
            for (int b = 0; b < 2; ++b)
#pragma unroll
                for (int m = 0; m < 4; ++m)
#pragma unroll
                    for (int n = 0; n < 2; ++n) acc[a][b][m][n] = (f32x4){0.f, 0.f, 0.f, 0.f};
        cur = nxt; cA = nA; cB = nB; ++ui;
    }
    PG_WAIT_V(0);
    if (wr == 0) PG_BAR;
    PG_BAR;
#undef PG_SA
#undef PG_SB
#undef PG_STAGE
#undef PG_LDA
#undef PG_LDB
#undef PG_MMA
#undef PG_WAIT_V
#undef PG_WAIT_L
#undef PG_BAR
#undef PG_SCHED
#undef PG_AOFFS
}
}

DI void phase_router(PR p, int l, char* lds) {
    const int tid = tid_here(), wid = tid >> 6, lane = tid & 63;
    const unsigned char* wl = p.ws + WS_WEIGHTS + (size_t)l * WL_END;
    const bf16_t* WH = (const bf16_t*)(wl + WL_WRH); const bf16_t* WLo = (const bf16_t*)(wl + WL_WRL);
    const bf16_t* HH = (const bf16_t*)(p.ws + WS_HBUF); const bf16_t* HL = (const bf16_t*)(p.ws + WS_U + U_HLO);
    int* EIDX = (int*)(p.ws + WS_EIDX); float* EW = (float*)(p.ws + WS_EW); int* EPOS = (int*)(p.ws + WS_EPOS);
    unsigned* cnt = (unsigned*)(p.ws + WS_CNT) + l * 64;
    const float* rb = p.router_b + l * 64;
    float* SEL = (float*)lds + wid * (2 * 16 * 65);
    float* SCO = SEL + 16 * 65;
    const int ntok = l == 0 ? NTOK : NLAT, ngrp = ntok / 16;
    const int fr = lane & 15, fq = lane >> 4;
    for (int gidx = blockIdx.x * 8 + wid; gidx < ngrp; gidx += gridDim.x * 8) {
        const int row0 = gidx * 16;
        f32x4 acc[4];
#pragma unroll
        for (int e = 0; e < 4; ++e) acc[e] = (f32x4){0.f, 0.f, 0.f, 0.f};
        const bf16_t* ah = HH + (size_t)(row0 + fr) * D + fq * 8; const bf16_t* al = HL + (size_t)(row0 + fr) * D + fq * 8;
        for (int k0 = 0; k0 < D; k0 += 32) {
            const bf16x8 a_hi = *(const bf16x8*)(ah + k0), a_lo = *(const bf16x8*)(al + k0);
#pragma unroll
            for (int e = 0; e < 4; ++e) {
                const bf16x8 b_hi = *(const bf16x8*)(WH + (size_t)(e * 16 + fr) * D + k0 + fq * 8), b_lo = *(const bf16x8*)(WLo + (size_t)(e * 16 + fr) * D + k0 + fq * 8);
                acc[e] = __builtin_amdgcn_mfma_f32_16x16x32_bf16(a_hi, b_hi, acc[e], 0, 0, 0);
                acc[e] = __builtin_amdgcn_mfma_f32_16x16x32_bf16(a_hi, b_lo, acc[e], 0, 0, 0);
                acc[e] = __builtin_amdgcn_mfma_f32_16x16x32_bf16(a_lo, b_hi, acc[e], 0, 0, 0);
            }
        }
#pragma unroll
        for (int e = 0; e < 4; ++e)
#pragma unroll
            for (int i = 0; i < 4; ++i) { const int ex = e * 16 + fr; const float s = sigmoid_f(acc[e][i]); SCO[(fq * 4 + i) * 65 + ex] = s; SEL[(fq * 4 + i) * 65 + ex] = s + rb[ex]; }
        asm volatile("s_waitcnt lgkmcnt(0)" ::: "memory");
        __builtin_amdgcn_wave_barrier();
        if (lane < 16) {
            float* sel = SEL + lane * 65; const float* sco = SCO + lane * 65;
            float gs[8];
#pragma unroll
            for (int g = 0; g < 8; ++g) { float m1 = -INFINITY, m2 = -INFINITY;
#pragma unroll
                for (int i = 0; i < 8; ++i) { const float v = sel[g * 8 + i]; if (v > m1) { m2 = m1; m1 = v; } else if (v > m2) m2 = v; }
                gs[g] = m1 + m2; }
            unsigned gmask = 0u;
#pragma unroll
            for (int it = 0; it < 4; ++it) { float best = -INFINITY; int bi = 0;
#pragma unroll
                for (int g = 0; g < 8; ++g) { const bool free_ = ((gmask >> g) & 1u) == 0u; if (free_ && gs[g] > best) { best = gs[g]; bi = g; } }
                gmask |= 1u << bi; }
            int ei[8]; float ew[8]; float wsum = 0.f;
#pragma unroll
            for (int k = 0; k < 8; ++k) { float best = -INFINITY; int bi = 0;
                for (int e = 0; e < 64; ++e) { const float v = sel[e]; if (((gmask >> (e >> 3)) & 1u) && v > best) { best = v; bi = e; } }
                sel[bi] = -INFINITY; ei[k] = bi; ew[k] = sco[bi]; wsum += ew[k]; }
            const float sc = 2.5f / wsum; const int t = row0 + lane;
#pragma unroll
            for (int k = 0; k < 8; ++k) { const unsigned pos = atomicAdd(&cnt[ei[k]], 1u); EIDX[t * 8 + k] = ei[k]; EW[t * 8 + k] = ew[k] * sc; EPOS[t * 8 + k] = (int)pos; }
        }
        __builtin_amdgcn_wave_barrier();
    }
}
DI void phase_moe_index(PR p, int l, char* lds) {
    const int tid = tid_here();
    int* S = (int*)lds;
    const unsigned* cnt = (const unsigned*)(p.ws + WS_CNT) + l * 64;
    int* META = (int*)(p.ws + WS_META) + l * 1024;
    const int* EIDX = (const int*)(p.ws + WS_EIDX); const float* EW = (const float*)(p.ws + WS_EW); const int* EPOS = (const int*)(p.ws + WS_EPOS);
    int* SASG = (int*)(p.ws + WS_SASG); float* SW = (float*)(p.ws + WS_SW);
    if (tid < 64) S[128 + tid] = (int)cnt[tid];
    __syncthreads();
    if (tid == 0) { int s = 0; for (int e = 0; e < 64; ++e) { S[e] = s; s += (S[128 + e] + 255) / 256 * 256; } S[64] = s; }
    __syncthreads();
    const int ntok = l == 0 ? NTOK : NLAT;
    for (int a = bid_here() * NTHREADS + tid; a < ntok * 8; a += gridDim.x * NTHREADS) { const int e = EIDX[a], pos = S[e] + EPOS[a]; SASG[pos] = a; SW[pos] = EW[a]; }
    for (int i = bid_here() * NTHREADS + tid; i < 64 * 256; i += gridDim.x * NTHREADS) { const int e = i >> 8, q = i & 255, c = S[128 + e]; if (S[e] + c + q < S[e + 1]) { SASG[S[e] + c + q] = -1; SW[S[e] + c + q] = 0.f; } }
    if (blockIdx.x == 0) {
        if (tid == 0) META[0] = S[64] / 256;
        if (tid < 64) { for (int t = S[tid] / 256; t < S[tid + 1] / 256; ++t) META[256 + t] = tid; }
    }
}

struct OrderXcd {
    int nM, nN, nwg;
    DI void init(int nM_, int nN_) { nM = nM_; nN = nN_; nwg = nM_ * nN_; }
    DI bool map(int i, int& pm, int& pn) const {
        const long L = (long)i * gridDim.x + blockIdx.x; if (L >= nwg) return false;
        int wgid = (int)L; { const int q = nwg / 8, r = nwg % 8, xcd = wgid % 8, off = wgid / 8; wgid = (xcd < r ? xcd * (q + 1) : r * (q + 1) + (xcd - r) * q) + off; }
        const int nig = 8 * nN, gid = wgid / nig, fm = gid * 8, gsz = (nM - fm) < 8 ? (nM - fm) : 8;
        pm = fm + ((wgid % nig) % gsz); pn = (wgid % nig) / gsz; return true;
    }
    DI bool lin(int i, int& w) const {
        const long L = (long)i * gridDim.x + blockIdx.x; if (L >= nwg) return false;
        const int q = nwg / 8, r = nwg % 8, xcd = (int)(L % 8), off = (int)(L / 8); w = (xcd < r ? xcd * (q + 1) : r * (q + 1) + (xcd - r) * q) + off; return true;
    }
};
#define GACC const f32x4 (&acc)[2][2][4][2]
struct SchedInproj {
    int lda, ldb, K, rowshift; const char* A; const char* W; bf16_t* proj; OrderXcd o;
    DI bool next(int i, pg::XUnit& u) const { int pm, pn; if (!o.map(i, pm, pn)) return false; u.A = A; u.B = W + (size_t)pn * 256 * ldb; u.arow0 = pm * 256; u.list = -1; u.e0 = pm * 256; u.e1 = pn * 256; return true; }
    DI void epi(GACC, const pg::XUnit& u, int wr, int wc, int fr, int fq) const { EpiProj E; E.O = proj; E.row0 = u.e0; E.col0 = u.e1; E(acc, wr, wc, fr, fq); }
};
DI void phase_inproj(PR p, int l, char* lds) {
    SchedInproj S; S.lda = D * 2; S.ldb = D * 2; S.K = D; S.rowshift = 0; S.A = (const char*)(p.ws + WS_HBUF); S.W = (const char*)(p.ws + WS_WEIGHTS + (size_t)l * WL_END + WL_WIN);
    S.proj = (bf16_t*)(p.ws + WS_U + U_PROJ); S.o.init(68, 15);
    pg::gemm_phase((LAS unsigned char*)lds, (const LAS int*)(lds + pg::STAGE_BYTES), S);
}
struct SchedMlaUp {
    int lda, ldb, K, rowshift; const char* CQ; const char* CKV; const char* WQ; const char* WKV; bf16_t* Qm; bf16_t* Km; bf16_t* Vm; const float2* ropem; OrderXcd o;
    DI bool next(int i, pg::XUnit& u) const { int w; if (!o.lin(i, w)) return false; u.list = -1;
        if (w < 340) { const int pm = w / 5, pn = w % 5; u.A = CQ; u.B = WQ + (size_t)pn * 256 * ldb; u.arow0 = pm * 256; u.e0 = pm * 256; u.e1 = pn * 256; u.e3 = 0; }
        else { const int v = w - 340, pm = v / 6, pn = v % 6; u.A = CKV; u.B = WKV + (size_t)pn * 256 * ldb; u.arow0 = pm * 256; u.e0 = pm * 256; u.e1 = pn * 256; u.e3 = 1; }
        return true; }
    DI void epi(GACC, const pg::XUnit& u, int wr, int wc, int fr, int fq) const {
        if (u.e3 == 0) { EpiUq E; E.Q = Qm; E.ropem = ropem; E.row0 = u.e0; E.col0 = u.e1; E(acc, wr, wc, fr, fq); }
        else { EpiUkv E; E.Km = Km; E.Vm = Vm; E.row0 = u.e0; E.col0 = u.e1; E(acc, wr, wc, fr, fq); } }
};
DI void phase_mla_up(PR p, int l, char* lds) {
    unsigned char* U = p.ws + WS_U; const unsigned char* wl = p.ws + WS_WEIGHTS + (size_t)l * WL_END;
    SchedMlaUp S; S.lda = 1024; S.ldb = 1024; S.K = 512; S.rowshift = 0; S.CQ = (const char*)(U + U_CQN); S.CKV = (const char*)(U + U_CKVN); S.WQ = (const char*)(wl + WL_WUQ); S.WKV = (const char*)(wl + WL_WUKV);
    S.Qm = (bf16_t*)(U + U_QM); S.Km = (bf16_t*)(U + U_KM); S.Vm = (bf16_t*)(U + U_VM); S.ropem = (const float2*)(p.ws + WS_ROPEM); S.o.init(748, 1);
    pg::gemm_phase((LAS unsigned char*)lds, (const LAS int*)(lds + pg::STAGE_BYTES), S);
}
struct SchedOutproj {
    int lda, ldb, K, rowshift; const char* A; const char* W; float* Y; OrderXcd o;
    DI bool next(int i, pg::XUnit& u) const { int pm, pn; if (!o.map(i, pm, pn)) return false; u.A = A; u.B = W + (size_t)pn * 256 * ldb; u.arow0 = pm * 256; u.list = -1; u.e0 = pm * 256; u.e1 = pn * 256; return true; }
    DI void epi(GACC, const pg::XUnit& u, int wr, int wc, int fr, int fq) const { EpiF32 E; E.O = Y; E.row0 = u.e0; E.col0 = u.e1; E.ld = D; E(acc, wr, wc, fr, fq); }
};
DI void phase_outproj(PR p, int l, char* lds) {
    SchedOutproj S; S.lda = D * 2; S.ldb = D * 2; S.K = D; S.rowshift = 0; S.A = (const char*)(p.ws + WS_U + U_MIX); S.W = (const char*)(p.ws + WS_WEIGHTS + (size_t)l * WL_END + WL_WOUT);
    S.Y = (float*)(p.ws + WS_U + U_Y); S.o.init(l == 0 ? 68 : 64, 8);
    pg::gemm_phase((LAS unsigned char*)lds, (const LAS int*)(lds + pg::STAGE_BYTES), S);
}
struct SchedMoe1 {
    int lda, ldb, K, rowshift; const char* H; const char* W13; bf16_t* act; const LAS int* uexp; int ntiles; OrderXcd o;
    DI bool next(int i, pg::XUnit& u) const { int tile, pn; if (!o.map(i, tile, pn)) return false; u.A = H;
        if (tile < ntiles) { const int e = uexp[i]; u.B = W13 + ((size_t)e * 1024 + pn * 256) * ldb; u.list = i * 256; u.arow0 = 0; u.e0 = tile * 256; }
        else { const int ts = tile - ntiles; u.B = W13 + ((size_t)64 * 1024 + pn * 256) * ldb; u.list = -1; u.arow0 = ts * 256; u.e0 = PMAX + ts * 256; }
        u.e1 = pn * 128; return true; }
    DI void epi(GACC, const pg::XUnit& u, int wr, int wc, int fr, int fq) const { EpiMoe1 E; E.act = act; E.arow0 = u.e0; E.hcol0 = u.e1; E(acc, wr, wc, fr, fq); }
};
DI void phase_moe1(PR p, int l, char* lds) {
    const int* META = (const int*)(p.ws + WS_META) + l * 1024; const int ntiles = META[0], nsh = l == 0 ? 68 : 64;
    SchedMoe1 S; S.lda = D * 2; S.ldb = D * 2; S.K = D; S.rowshift = 3; S.H = (const char*)(p.ws + WS_HBUF); S.W13 = (const char*)(p.ws + WS_WEIGHTS + (size_t)l * WL_END + WL_W13);
    S.act = (bf16_t*)(p.ws + WS_U + U_ACT); S.uexp = (const LAS int*)(lds + pg::STAGE_BYTES) + 31 * 256; S.ntiles = ntiles; S.o.init(ntiles + nsh, 4);
    { const int tid = tid_here(); LAS int* RL = (LAS int*)(lds + pg::STAGE_BYTES); const int* SASG = (const int*)(p.ws + WS_SASG);
      for (int i = 0; i < 31; ++i) { int tile, pn; if (!S.o.map(i, tile, pn)) break; if (tile < ntiles && tid < 256) RL[i * 256 + tid] = SASG[tile * 256 + tid];
          if (tid == 0) RL[31 * 256 + i] = tile < ntiles ? META[256 + tile] : 64; }
      __syncthreads(); }
    pg::gemm_phase((LAS unsigned char*)lds, (const LAS int*)(lds + pg::STAGE_BYTES), S);
}
struct SchedMoe2 {
    int lda, ldb, K, rowshift; const char* ACT; const char* W2; bf16_t* oasg; const int* sasg; const float* sw; float* ysh; const LAS int* uexp; int ntiles; OrderXcd o;
    DI bool next(int i, pg::XUnit& u) const { int tile, pn; if (!o.map(i, tile, pn)) return false; u.A = ACT; u.list = -1;
        if (tile < ntiles) { const int e = uexp[i]; u.B = W2 + ((size_t)e * D + pn * 256) * ldb; u.arow0 = tile * 256; u.e0 = tile * 256; u.e3 = 0; }
        else { const int ts = tile - ntiles; u.B = W2 + ((size_t)64 * D + pn * 256) * ldb; u.arow0 = PMAX + ts * 256; u.e0 = ts * 256; u.e3 = 1; }
        u.e1 = pn * 256; return true; }
    DI void epi(GACC, const pg::XUnit& u, int wr, int wc, int fr, int fq) const {
        if (u.e3 == 0) { EpiMoe2 E; E.oasg = oasg; E.sasg = sasg; E.sw = sw; E.srow0 = u.e0; E.col0 = u.e1; E(acc, wr, wc, fr, fq); }
        else { EpiF32 E; E.O = ysh; E.row0 = u.e0; E.col0 = u.e1; E.ld = D; E(acc, wr, wc, fr, fq); } }
};
DI void phase_moe2(PR p, int l, char* lds) {
    const int* META = (const int*)(p.ws + WS_META) + l * 1024; const int ntiles = META[0], nsh = l == 0 ? 68 : 64;
    SchedMoe2 S; S.lda = 1024; S.ldb = 1024; S.K = 512; S.rowshift = 0; S.ACT = (const char*)(p.ws + WS_U + U_ACT); S.W2 = (const char*)(p.ws + WS_WEIGHTS + (size_t)l * WL_END + WL_W2);
    S.oasg = (bf16_t*)(p.ws + WS_U + U_OASG); S.sasg = (const int*)(p.ws + WS_SASG); S.sw = (const float*)(p.ws + WS_SW); S.ysh = (float*)(p.ws + WS_U + U_Y); S.uexp = (const LAS int*)(lds + pg::STAGE_BYTES); S.ntiles = ntiles; S.o.init(ntiles + nsh, 8);
    { const int tid = tid_here(); LAS int* UE = (LAS int*)(lds + pg::STAGE_BYTES);
      if (tid == 0) for (int i = 0; i < 64; ++i) { int tile, pn; if (!S.o.map(i, tile, pn)) break; UE[i] = tile < ntiles ? META[256 + tile] : 64; }
      __syncthreads(); }
    pg::gemm_phase((LAS unsigned char*)lds, (const LAS int*)(lds + pg::STAGE_BYTES), S);
}
DI void phase_attention(PR p, int l, char* lds) {
#define ATT_PTRS unsigned char* U = p.ws + WS_U; asm volatile("" : "+s"(U)); \
    const bf16_t* Qm = (const bf16_t*)(U + U_QM); const bf16_t* Km = (const bf16_t*)(U + U_KM); const bf16_t* Vm = (const bf16_t*)(U + U_VM); \
    const bf16_t* Qg = (const bf16_t*)(U + U_QG); const bf16_t* Kg = (const bf16_t*)(U + U_KG); const bf16_t* Vg = (const bf16_t*)(U + U_VG); bf16_t* MIX = (bf16_t*)(U + U_MIX);
    const int nun = 384 + (l == 0 ? 24 : 0);
    if (SUB & 1) for (int u = blockIdx.x; u < nun; u += gridDim.x) {
        ATT_PTRS; (void)Qg; (void)Kg; (void)Vg;
        int b, h, qt, isctx;
        if (u < 384) { qt = u & 15; h = (u >> 4) % 6; b = u / 96; isctx = 0; } else { const int w = u - 384; h = w % 6; b = w / 6; qt = 0; isctx = 1; }
        const int qpos = isctx ? 0 : CTXL + qt * 256, seq = isctx ? CTXL : SKV, orow = isctx ? NLAT + b * CTXL : b * SEQ + qt * 256;
        attn_body<192, ATT_SD_M>(Qm + (((size_t)b * 6 + h) * SKV + qpos) * 192, Km + ((size_t)b * 6 + h) * SKV * 192, Vm + ((size_t)b * 6 + h) * SKV * 128,
                                 MIX + (size_t)orow * D + 512 + h * 128, D, seq, lds, 0.07216878364870322f);
    }
    if (SUB & 2) for (int u = gridDim.x - 1 - blockIdx.x; u < nun; u += gridDim.x) {
        ATT_PTRS; (void)Qm; (void)Km; (void)Vm;
        int b, h, qt, isctx;
        if (u < 384) { qt = u & 15; h = (u >> 4) % 6; b = u / 96; isctx = 0; } else { const int w = u - 384; h = w % 6; b = w / 6; qt = 0; isctx = 1; }
        const int qpos = isctx ? 0 : CTXL + qt * 256, seq = isctx ? CTXL : SKV, orow = isctx ? NLAT + b * CTXL : b * SEQ + qt * 256;
        attn_body<128, ATT_SD_G>(Qg + (((size_t)b * 6 + h) * SKV + qpos) * 128, Kg + ((size_t)b * 2 + (h / 3)) * SKV * 128, Vg + ((size_t)b * 2 + (h / 3)) * SKV * 128,
                                 MIX + (size_t)orow * D + 1280 + h * 128, D, seq, lds, 0.08838834764831845f);
    }
#undef ATT_PTRS
    if (SUB & 4) gla_phaseC(p, l, lds);
}

constexpr int NPH_LAYER = 12, NPH = 1 + 2 * NPH_LAYER;
constexpr int LDS_BYTES = 160 * 1024;
__global__ void __launch_bounds__(NTHREADS, 2) fwd(Params p_arg, int ph_lo, int ph_hi) {
    extern __shared__ __attribute__((aligned(16))) char shm[];
    char* lds = shm + 256;
    volatile LAS unsigned* xbw = (volatile LAS unsigned*)shm;
    const bool fused = (ph_hi - ph_lo) > 1;
    XcdBarrier bar; bar.bar = (unsigned*)(p_arg.ws + WS_BAR); bar.x = 0; bar.st = xbw;
    if (fused) {
        if (threadIdx.x == 0) { xbw[0] = 0u; xbw[1] = 0u; xbw[2] = 0u; xbw[3] = 0u; }
        __syncthreads();
        bar = xcd_barrier_post((unsigned*)(p_arg.ws + WS_BAR), xbw);
    }
    const CAS Params* pk = (const CAS Params*)__builtin_amdgcn_kernarg_segment_ptr();
#define PHASE(idx, CALL) do { if (((PH_MASK >> ((idx) == 0 ? 0 : ((idx) - 1) % NPH_LAYER + 1)) & 1) && (idx) >= ph_lo && (idx) < ph_hi) { const CAS Params* q_ = pk; asm volatile("" : "+s"(q_)); PR p = *q_; CALL; if (fused && (idx) + 1 < ph_hi) xcd_barrier(bar); } } while (0)
    PHASE(0, phase_prologue(p, lds));
    for (int l = 0; l < 2; ++l) {
        const int b0 = 1 + l * NPH_LAYER;
        if (l == 0) PHASE(b0 + 0, phase_norm1(p, 0));
        PHASE(b0 + 1, phase_inproj(p, l, lds));
        PHASE(b0 + 2, (phase_postproj_rows(p, l), gla_phaseA(p, l, lds)));
        PHASE(b0 + 3, (phase_mla_up(p, l, lds), gla_scan(p)));
        PHASE(b0 + 4, phase_attention(p, l, lds));
        PHASE(b0 + 5, phase_outproj(p, l, lds));
        PHASE(b0 + 6, phase_postmix(p, l));
        PHASE(b0 + 7, phase_router(p, l, lds));
        PHASE(b0 + 8, phase_moe_index(p, l, lds));
        PHASE(b0 + 9, phase_moe1(p, l, lds));
        PHASE(b0 + 10, phase_moe2(p, l, lds));
        PHASE(b0 + 11, phase_postffn(p, l));
    }
#undef PHASE
}

extern "C" void kernel_launch(void* const* d_in, const int* in_sizes, int n_in, void* d_out, int out_size, void* d_ws, size_t ws_size, hipStream_t stream) {
    static int grid = 0;
    if (!grid) {
        if (ws_size < WS_TOTAL) { fprintf(stderr, "kernel_launch: workspace too small: %zu < %zu\n", ws_size, (size_t)WS_TOTAL); return; }
        if (hipFuncSetAttribute((const void*)fwd, hipFuncAttributeMaxDynamicSharedMemorySize, LDS_BYTES) != hipSuccess) { fprintf(stderr, "kernel_launch: hipFuncSetAttribute failed\n"); return; }
        int dev = 0, cus = 0, per_cu = 0;
        hipGetDevice(&dev);
        hipDeviceGetAttribute(&cus, hipDeviceAttributeMultiprocessorCount, dev);
        hipOccupancyMaxActiveBlocksPerMultiprocessor(&per_cu, fwd, NTHREADS, LDS_BYTES);
        if (per_cu < 1) { fprintf(stderr, "kernel_launch: occupancy query says %d\n", per_cu); return; }
        grid = cus;
    }
    Params p{};
    const float** f = (const float**)&p;
    for (int i = 0; i < 31; ++i) f[i] = (const float*)d_in[i];
    p.out = (float*)d_out; p.ws = (unsigned char*)d_ws;
    hipMemsetAsync((unsigned char*)d_ws + WS_BAR, 0, XCD_BAR_WORDS * sizeof(unsigned), stream);
#if MK_MULTI
    for (int ph = 0; ph < NPH; ++ph) { if (ph == 1 + NPH_LAYER) continue; hipLaunchKernelGGL(fwd, dim3(grid), dim3(NTHREADS), LDS_BYTES, stream, p, ph, ph + 1); }
#else
    hipLaunchKernelGGL(fwd, dim3(grid), dim3(NTHREADS), LDS_BYTES, stream, p, 0, NPH);
#endif
    const hipError_t le = hipPeekAtLastError();
    if (le != hipSuccess) fprintf(stderr, "kernel_launch: launch failed: %s\n", hipGetErrorName(le));
}
```

```cpp
#include <hip/hip_runtime.h>
#include <stdint.h>
#include <stdio.h>

#ifndef PH_MASK
#define PH_MASK 0x1FFF
#endif
#ifndef SUB
#define SUB 7
#endif
#ifndef ATT_SD_M
#define ATT_SD_M 1
#endif
#ifndef ATT_SD_G
#define ATT_SD_G 2
#endif
#ifndef ATT_NQR_M
#define ATT_NQR_M 12
#endif
#ifndef PROBE_MASK
#define PROBE_MASK 0x0
#endif
#ifndef MK_MULTI
#define MK_MULTI 0
#endif

typedef unsigned short bf16_t;
typedef short bf16x8 __attribute__((ext_vector_type(8)));
typedef short s16x4 __attribute__((ext_vector_type(4)));
typedef float f32x4 __attribute__((ext_vector_type(4)));
typedef float f32x16 __attribute__((ext_vector_type(16)));
typedef unsigned u32x4 __attribute__((ext_vector_type(4)));
typedef unsigned u32x2 __attribute__((ext_vector_type(2)));
#define DI __device__ __forceinline__

constexpr int D = 2048, NB = 4, SEQ = 4096, CTXL = 256, NLAT = NB * SEQ, NCTX = NB * CTXL, NTOK = NLAT + NCTX, SKV = SEQ + CTXL;
constexpr int INW = 3808, INWP = 3840;
constexpr int C_GQ = 0, C_GK = 256, C_GV = 512, C_GG = 1024, C_ZF = 1536, C_ZB = 1552, C_CQ = 1568, C_CKV = 1952, C_KR = 2464, C_AQ = 2528, C_AK = 3296, C_AV = 3552;
constexpr int NE = 64, TOPK = 8, DEXP = 512;
constexpr int PMAX = NTOK * TOPK + NE * 256;
constexpr int NTHREADS = 512;
constexpr float EPS = 1e-6f;

constexpr size_t MiB = 1024ull * 1024ull;
constexpr size_t al256(size_t x) { return (x + 255) / 256 * 256; }
constexpr size_t WS_BAR = 0;
constexpr size_t WS_CNT = 16384;
constexpr size_t WS_META = WS_CNT + 1024;
constexpr size_t WS_MOD = WS_META + 2 * 4096;
constexpr size_t WS_ROPEG = al256(WS_MOD + 2 * 5 * 12288 * 4);
constexpr size_t WS_ROPEM = WS_ROPEG + 64 * 32 * 8;
constexpr size_t WS_ZROW = WS_ROPEM + 64 * 16 * 8;
constexpr size_t WS_GDEC = WS_ZROW + 4096;
constexpr size_t WS_EIDX = al256(WS_GDEC + 2 * 16 * 68 * 64 * 4);
constexpr size_t WS_EW = WS_EIDX + (size_t)NTOK * 8 * 4;
constexpr size_t WS_EPOS = WS_EW + (size_t)NTOK * 8 * 4;
constexpr size_t WS_SASG = WS_EPOS + (size_t)NTOK * 8 * 4;
constexpr size_t WS_SW = al256(WS_SASG + (size_t)PMAX * 4);
constexpr size_t WS_SMALL_END = al256(WS_SW + (size_t)PMAX * 4);
static_assert(WS_SMALL_END <= 8 * MiB, "small region");
constexpr size_t SZ_WIN = (size_t)INWP * D * 2, SZ_WUQ = (size_t)1280 * 512 * 2, SZ_WUKV = (size_t)1536 * 512 * 2, SZ_WOUT = (size_t)D * D * 2, SZ_WR = (size_t)64 * D * 2;
constexpr size_t SZ_W13 = (size_t)65 * 1024 * D * 2, SZ_W2 = (size_t)65 * D * 512 * 2;
constexpr size_t WL_WIN = 0, WL_WUQ = WL_WIN + SZ_WIN, WL_WUKV = WL_WUQ + SZ_WUQ, WL_WOUT = WL_WUKV + SZ_WUKV, WL_WRH = WL_WOUT + SZ_WOUT, WL_WRL = WL_WRH + SZ_WR,
                 WL_W13 = WL_WRL + SZ_WR, WL_W2 = WL_W13 + SZ_W13, WL_END = WL_W2 + SZ_W2;
constexpr size_t WS_WEIGHTS = 8 * MiB;
constexpr size_t WS_XRES = WS_WEIGHTS + 2 * WL_END;
constexpr size_t WS_HBUF = WS_XRES + (size_t)NTOK * D * 4;
constexpr size_t WS_U = WS_HBUF + (size_t)NTOK * D * 2;
constexpr size_t U_Y = 0;
constexpr size_t U_YSH = (size_t)NTOK * D * 2;
constexpr size_t U_PROJ = U_Y + (size_t)NTOK * D * 4;
constexpr size_t U_QM = U_PROJ + (size_t)NTOK * INWP * 2;
constexpr size_t U_KM = U_QM + (size_t)NB * 6 * SKV * 192 * 2;
constexpr size_t U_VM = U_KM + (size_t)NB * 6 * SKV * 192 * 2;
constexpr size_t U_QG = U_VM + (size_t)NB * 6 * SKV * 128 * 2;
constexpr size_t U_KG = U_QG + (size_t)NB * 6 * SKV * 128 * 2;
constexpr size_t U_VG = U_KG + (size_t)NB * 2 * SKV * 128 * 2;
constexpr size_t U_GS = U_VG + (size_t)NB * 2 * SKV * 128 * 2;
constexpr size_t U_MIX = U_GS + (size_t)2 * 16 * 68 * 64 * 128 * 4;
constexpr size_t U_CQN = U_MIX + (size_t)NTOK * D * 2;
constexpr size_t U_CKVN = U_CQN + (size_t)NTOK * 512 * 2;
constexpr size_t U_GST = U_CKVN + (size_t)NTOK * 512 * 2;
constexpr size_t U_MIX_END = U_GST + (size_t)2 * 16 * 68 * 8192 * 2;
constexpr size_t U_HLO = U_PROJ;
constexpr size_t U_ACT = U_HLO + (size_t)NTOK * D * 2;
constexpr size_t U_OASG = U_ACT + (size_t)(PMAX + NTOK) * 512 * 2;
constexpr size_t U_MOE_END = U_OASG + (size_t)NTOK * 8 * D * 2;
constexpr size_t WS_TOTAL = WS_U + (U_MIX_END > U_MOE_END ? U_MIX_END : U_MOE_END);
static_assert(WS_TOTAL <= 2048ull * MiB, "workspace over 2 GiB");

struct Params {
    const float *x, *c, *ctx, *c_ctx, *w_mod, *b_mod, *g_pre_mix, *g_post_mix, *g_pre_ffn, *g_post_ffn, *w_in, *gla_wg2_f, *gla_bg_f, *gla_wg2_b, *gla_bg_b, *gla_g_out,
        *mla_g_q, *mla_w_uq, *mla_g_kv, *mla_w_ukv, *gqa_g_q, *gqa_g_k, *w_out, *router_w, *router_b, *exp_w1, *exp_w3, *exp_w2, *sh_w1, *sh_w3, *sh_w2;
    float* out; unsigned char* ws;
};

#define CAS __attribute__((address_space(4)))
typedef const CAS Params& PR;
DI int bid_here() { int b = blockIdx.x; asm volatile("" : "+s"(b)); return b; }
DI int tid_here() { int t = threadIdx.x; asm volatile("" : "+v"(t)); return t; }
DI float bf2f(bf16_t v) { return __uint_as_float(((unsigned)v) << 16); }
DI bf16_t f2bf(float f) { unsigned u = __float_as_uint(f); u += 0x7FFFu + ((u >> 16) & 1u); return (bf16_t)(u >> 16); }
DI unsigned pk2(float lo, float hi) { return (unsigned)f2bf(lo) | ((unsigned)f2bf(hi) << 16); }
DI float shx(float v, int o, int lane) { return __int_as_float(__builtin_amdgcn_ds_bpermute((lane ^ o) << 2, __float_as_int(v))); }
DI float wave_sum(float v) {
    const int lane = tid_here() & 63;
#pragma unroll
    for (int o = 32; o > 0; o >>= 1) v += shx(v, o, lane);
    return v;
}
DI float silu_f(float v) { return v / (1.f + __expf(-v)); }
DI float sigmoid_f(float v) { return 1.f / (1.f + __expf(-v)); }
struct Tok { int b, s, isctx, mrow, kvpos; };
DI Tok tok_of(int r) { Tok t; if (r < NLAT) { t.b = r >> 12; t.s = r & 4095; t.isctx = 0; t.mrow = t.b; t.kvpos = CTXL + t.s; } else { const int q = r - NLAT; t.b = q >> 8; t.s = q & 255; t.isctx = 1; t.mrow = 4; t.kvpos = t.s; } return t; }
DI const float* xrow_in(PR p, int l, int r) { if (l == 0) return r < NLAT ? p.x + (size_t)r * D : p.ctx + (size_t)(r - NLAT) * D; return (const float*)(p.ws + WS_XRES) + (size_t)r * D; }

#define XB_TMO      128
#define XB_XCNT(j)  (256  + 64 * (j))
#define XB_XSUB(j)  (1280 + 64 * (j))
#define XB_XGEN(j)  (2304 + 64 * (j))
#define XB_TOP      3328
#define XB_TOPGEN   3392
#define XCD_BAR_WORDS 3456
#define XB_SPIN_CAP (1u << 18)
#define LAS __attribute__((address_space(3)))
__device__ __forceinline__ unsigned xb_ld(unsigned* p)              { return __hip_atomic_load(p, __ATOMIC_RELAXED, __HIP_MEMORY_SCOPE_AGENT); }
__device__ __forceinline__ unsigned xb_add(unsigned* p, unsigned v) { return __hip_atomic_fetch_add(p, v, __ATOMIC_RELAXED, __HIP_MEMORY_SCOPE_AGENT); }
__device__ __forceinline__ unsigned xb_xcc_id() { return (unsigned)__builtin_amdgcn_s_getreg((3 << 11) | 20) & 0xFu; }
#define XB_SPIN(cond, bar) do { unsigned _sp = 0; while (cond) { __builtin_amdgcn_s_sleep(1); \
    if ((++_sp & 255u) == 0u) { if (xb_ld(&(bar)[XB_TMO])) break; if (_sp > XB_SPIN_CAP) { atomicAdd(&(bar)[XB_TMO], 1u); break; } } } } while (0)
struct XcdBarrier { unsigned* bar; unsigned x; volatile LAS unsigned* st; };
__device__ __forceinline__ XcdBarrier xcd_barrier_post(unsigned* bar, volatile LAS unsigned* st) {
    XcdBarrier b; b.bar = bar; b.x = xb_xcc_id(); b.st = st;
    if (threadIdx.x == 0) (void)xb_add(&bar[XB_XCNT(b.x)], 1u);
    return b;
}
__device__ __forceinline__ void xcd_barrier_complete(unsigned* bar, unsigned x, unsigned& nloc, unsigned& nx) {
    const unsigned G = gridDim.x * gridDim.y * gridDim.z;
    unsigned sum, cnt, mine, sp = 0u;
    for (;;) {
        sum = 0u; cnt = 0u; mine = 0u;
#pragma unroll
        for (unsigned j = 0; j < 16; ++j) { const unsigned c = xb_ld(&bar[XB_XCNT(j)]); sum += c; cnt += (c > 0u) ? 1u : 0u; mine = (j == x) ? c : mine; }
        if (sum == G) break;
        __builtin_amdgcn_s_sleep(1);
        if ((++sp & 255u) == 0u) { if (xb_ld(&bar[XB_TMO])) break; if (sp > XB_SPIN_CAP) { atomicAdd(&bar[XB_TMO], 1u); break; } }
    }
    nloc = mine > 0u ? mine : 1u; nx = cnt > 0u ? cnt : 1u;
}
__device__ __forceinline__ void xcd_barrier(const XcdBarrier& b) {
    asm volatile("s_waitcnt vmcnt(0)" ::: "memory");
    __syncthreads();
    if (threadIdx.x == 0) {
        unsigned* bar = b.bar;
        __builtin_amdgcn_s_waitcnt(0);
        unsigned nloc = b.st[0], nx = b.st[1];
        if (nloc == 0u) { xcd_barrier_complete(bar, b.x, nloc, nx); b.st[0] = nloc; b.st[1] = nx; }
        const unsigned old = xb_add(&bar[XB_XSUB(b.x)], 1u);
        const unsigned gen = old / nloc;
        if (old + 1u == (gen + 1u) * nloc) {
            __builtin_amdgcn_fence(__ATOMIC_RELEASE, "agent");
            asm volatile("s_waitcnt vmcnt(0)" ::: "memory");
            const unsigned og = xb_add(&bar[XB_TOP], 1u);
            const unsigned tg = og / nx;
            if (og + 1u == (tg + 1u) * nx) xb_add(&bar[XB_TOPGEN], 1u);
            else XB_SPIN(xb_ld(&bar[XB_TOPGEN]) == tg, bar);
            __builtin_amdgcn_fence(__ATOMIC_ACQUIRE, "agent");
            xb_add(&bar[XB_XGEN(b.x)], 1u);
            asm volatile("s_waitcnt vmcnt(0)" ::: "memory");
        } else {
            XB_SPIN(xb_ld(&bar[XB_XGEN(b.x)]) == gen, bar);
            __builtin_amdgcn_fence(__ATOMIC_ACQUIRE, "agent");
            asm volatile("s_waitcnt vmcnt(0)" ::: "memory");
        }
    }
    __syncthreads();
}

DI void cvt_tile(char* lds, const float* src, int ldS, int Nvalid, bf16_t* dst, bf16_t* dst_lo, int ldD, int k0, int n0, int drow0, const float* gk) {
    float* T = (float*)lds;
    const int tid = tid_here();
    {
        const int c4 = tid & 15, kr = tid >> 4;
#pragma unroll
        for (int i = 0; i < 2; ++i) {
            const int k = kr + 32 * i, n = n0 + c4 * 4;
            f32x4 v = {0.f, 0.f, 0.f, 0.f};
            if (n < Nvalid) v = *(const f32x4*)(src + (size_t)(k0 + k) * ldS + n);
            if (gk) { const float g = gk[k0 + k]; v = v * g; }
            T[k * 65 + c4 * 4 + 0] = v[0]; T[k * 65 + c4 * 4 + 1] = v[1]; T[k * 65 + c4 * 4 + 2] = v[2]; T[k * 65 + c4 * 4 + 3] = v[3];
        }
    }
    __syncthreads();
    {
        const int nl = tid >> 3, kc = (tid & 7) * 8;
        float v[8];
#pragma unroll
        for (int j = 0; j < 8; ++j) v[j] = T[(kc + j) * 65 + nl];
        u32x4 w; w.x = pk2(v[0], v[1]); w.y = pk2(v[2], v[3]); w.z = pk2(v[4], v[5]); w.w = pk2(v[6], v[7]);
        *(u32x4*)(dst + (size_t)(drow0 + nl) * ldD + k0 + kc) = w;
        if (dst_lo) {
            float r[8];
#pragma unroll
            for (int j = 0; j < 8; ++j) r[j] = v[j] - bf2f(f2bf(v[j]));
            u32x4 w2; w2.x = pk2(r[0], r[1]); w2.y = pk2(r[2], r[3]); w2.z = pk2(r[4], r[5]); w2.w = pk2(r[6], r[7]);
            *(u32x4*)(dst_lo + (size_t)(drow0 + nl) * ldD + k0 + kc) = w2;
        }
    }
    __syncthreads();
}
DI void cvt_matrix(char* lds, const float* src, int K, int N, int Npad, bf16_t* dst, bf16_t* dst_lo, int mode, const float* gk, int ldD = 0) {
    if (ldD == 0) ldD = K;
    const int nkt = K / 64, nnt = Npad / 64, nt = nkt * nnt;
    for (int t = bid_here(); t < nt; t += gridDim.x) {
        const int kt = t % nkt, ntile = t / nkt, n0 = ntile * 64;
        int drow0 = n0;
        if (mode == 1) drow0 = (n0 >> 7) * 256 + (n0 & 127);
        else if (mode == 2) drow0 = (n0 >> 7) * 256 + 128 + (n0 & 127);
        cvt_tile(lds, src, N, N, dst, dst_lo, ldD, kt * 64, n0, drow0, gk);
    }
}
DI void phase_prologue(PR p, char* lds) {
    const int tid = tid_here();
    unsigned char* ws = p.ws;
    if (blockIdx.x == 0) {
        unsigned* cnt = (unsigned*)(ws + WS_CNT);
        if (tid < 128) cnt[tid] = 0u;
        unsigned* z = (unsigned*)(ws + WS_ZROW);
        for (int i = tid; i < 1024; i += NTHREADS) z[i] = 0u;
        float2* rg = (float2*)(ws + WS_ROPEG);
        for (int i = tid; i < 64 * 32; i += NTHREADS) { const int pos = i >> 5, f = i & 31; const float inv = powf(10000.f, -(float)(2 * f) / 64.f); float s, c; sincosf((float)pos * inv, &s, &c); rg[i] = make_float2(c, s); }
        float2* rm = (float2*)(ws + WS_ROPEM);
        for (int i = tid; i < 64 * 16; i += NTHREADS) { const int pos = i >> 4, f = i & 15; const float inv = powf(10000.f, -(float)(2 * f) / 32.f); float s, c; sincosf((float)pos * inv, &s, &c); rm[i] = make_float2(c, s); }
    }
    {
        float* sc = (float*)lds;
        float* red = sc + 5 * 2048;
        bool loaded = false;
        for (int u = bid_here(); u < 192; u += gridDim.x) {
            if (!loaded) { for (int i = tid; i < 5 * 2048; i += NTHREADS) { const int r = i >> 11, k = i & 2047; const float v = r < 4 ? p.c[r * 2048 + k] : p.c_ctx[k]; sc[i] = silu_f(v); } loaded = true; __syncthreads(); }
            const int l = u / 96, col0 = (u % 96) * 128;
            const int cg = tid & 31, kp = tid >> 5;
            f32x4 acc[5];
#pragma unroll
            for (int r = 0; r < 5; ++r) acc[r] = (f32x4){0.f, 0.f, 0.f, 0.f};
            const float* wb = p.w_mod + ((size_t)l * 2048) * 12288 + col0 + cg * 4;
            for (int kk = 0; kk < 128; ++kk) {
                const int k = kp * 128 + kk;
                const f32x4 w = *(const f32x4*)(wb + (size_t)k * 12288);
#pragma unroll
                for (int r = 0; r < 5; ++r) acc[r] += w * sc[r * 2048 + k];
            }
#pragma unroll
            for (int r = 0; r < 5; ++r)
#pragma unroll
                for (int j = 0; j < 4; ++j) red[(kp * 5 + r) * 128 + cg * 4 + j] = acc[r][j];
            __syncthreads();
            for (int i = tid; i < 640; i += NTHREADS) {
                const int r = i >> 7, cc = i & 127; float s = p.b_mod[l * 12288 + col0 + cc];
#pragma unroll
                for (int q = 0; q < 16; ++q) s += red[(q * 5 + r) * 128 + cc];
                ((float*)(ws + WS_MOD))[((size_t)l * 5 + r) * 12288 + col0 + cc] = s;
            }
            __syncthreads();
        }
        __syncthreads();
    }
    for (int l = 0; l < 2; ++l) {
        unsigned char* wl = ws + WS_WEIGHTS + (size_t)l * WL_END;
        cvt_matrix(lds, p.w_in + (size_t)l * D * INW, D, INW, INWP, (bf16_t*)(wl + WL_WIN), nullptr, 0, nullptr);
        cvt_matrix(lds, p.mla_w_uq + (size_t)l * 384 * 1152, 384, 1152, 1280, (bf16_t*)(wl + WL_WUQ), nullptr, 0, p.mla_g_q + l * 384, 512);
        for (int i = bid_here() * NTHREADS + tid; i < 1280 * 64; i += gridDim.x * NTHREADS) ((unsigned*)(wl + WL_WUQ))[(size_t)(i >> 6) * 256 + 192 + (i & 63)] = 0u;
        cvt_matrix(lds, p.mla_w_ukv + (size_t)l * 512 * 1536, 512, 1536, 1536, (bf16_t*)(wl + WL_WUKV), nullptr, 0, p.mla_g_kv + l * 512);
        cvt_matrix(lds, p.w_out + (size_t)l * D * D, D, D, D, (bf16_t*)(wl + WL_WOUT), nullptr, 0, nullptr);
        cvt_matrix(lds, p.router_w + (size_t)l * D * 64, D, 64, 64, (bf16_t*)(wl + WL_WRH), (bf16_t*)(wl + WL_WRL), 0, nullptr);
        for (int e = 0; e < 65; ++e) {
            const float* s1 = e < 64 ? p.exp_w1 + ((size_t)l * 64 + e) * D * 512 : p.sh_w1 + (size_t)l * D * 512;
            const float* s3 = e < 64 ? p.exp_w3 + ((size_t)l * 64 + e) * D * 512 : p.sh_w3 + (size_t)l * D * 512;
            const float* s2 = e < 64 ? p.exp_w2 + ((size_t)l * 64 + e) * 512 * D : p.sh_w2 + (size_t)l * 512 * D;
            bf16_t* d13 = (bf16_t*)(wl + WL_W13) + (size_t)e * 1024 * D;
            bf16_t* d2 = (bf16_t*)(wl + WL_W2) + (size_t)e * D * 512;
            cvt_matrix(lds, s1, D, 512, 512, d13, nullptr, 1, nullptr);
            cvt_matrix(lds, s3, D, 512, 512, d13, nullptr, 2, nullptr);
            cvt_matrix(lds, s2, 512, D, D, d2, nullptr, 0, nullptr);
        }
    }
}

DI void load_row_bf(const bf16_t* src, f32x4 (&v)[8], int lane) {
#pragma unroll
    for (int i = 0; i < 8; ++i) { const u32x2 w = *(const u32x2*)(src + i * 256 + lane * 4);
        v[i][0] = __uint_as_float(w.x << 16); v[i][1] = __uint_as_float(w.x & 0xFFFF0000u); v[i][2] = __uint_as_float(w.y << 16); v[i][3] = __uint_as_float(w.y & 0xFFFF0000u); }
}
DI void load_row(const float* src, f32x4 (&v)[8], int lane) {
#pragma unroll
    for (int i = 0; i < 8; ++i) v[i] = *(const f32x4*)(src + i * 256 + lane * 4);
}
DI float row_sumsq(const f32x4 (&v)[8]) {
    float s = 0.f;
#pragma unroll
    for (int i = 0; i < 8; ++i) s += v[i][0] * v[i][0] + v[i][1] * v[i][1] + v[i][2] * v[i][2] + v[i][3] * v[i][3];
    return wave_sum(s);
}
DI void adaln_store(const f32x4 (&x)[8], const float* g, const float* shift, const float* scale, bf16_t* hi, bf16_t* lo, int lane) {
    const float rstd = rsqrtf(row_sumsq(x) * (1.f / D) + EPS);
#pragma unroll
    for (int i = 0; i < 8; ++i) {
        const int c = i * 256 + lane * 4;
        const f32x4 gg = *(const f32x4*)(g + c), sh = *(const f32x4*)(shift + c), sc = *(const f32x4*)(scale + c);
        f32x4 h;
#pragma unroll
        for (int j = 0; j < 4; ++j) h[j] = x[i][j] * rstd * gg[j] * (1.f + sc[j]) + sh[j];
        u32x2 w; w.x = pk2(h[0], h[1]); w.y = pk2(h[2], h[3]);
        *(u32x2*)(hi + c) = w;
        if (lo) { u32x2 w2; w2.x = pk2(h[0] - bf2f(f2bf(h[0])), h[1] - bf2f(f2bf(h[1]))); w2.y = pk2(h[2] - bf2f(f2bf(h[2])), h[3] - bf2f(f2bf(h[3]))); *(u32x2*)(lo + c) = w2; }
    }
}
DI void phase_norm1(PR p, int l) {
    const int tid_ = tid_here(), lane = tid_ & 63, wid = tid_ >> 6;
    const float* mod = (const float*)(p.ws + WS_MOD) + (size_t)l * 5 * 12288;
    bf16_t* hb = (bf16_t*)(p.ws + WS_HBUF);
    for (int r = bid_here() * 8 + wid; r < NTOK; r += gridDim.x * 8) {
        const Tok t = tok_of(r);
        f32x4 x[8]; load_row(xrow_in(p, l, r), x, lane);
        adaln_store(x, p.g_pre_mix + l * D, mod + (size_t)t.mrow * 12288 + 0 * D, mod + (size_t)t.mrow * 12288 + 1 * D, hb + (size_t)r * D, nullptr, lane);
    }
}
DI void phase_postmix(PR p, int l) {
    const int tid_ = tid_here(), lane = tid_ & 63, wid = tid_ >> 6;
    const float* mod = (const float*)(p.ws + WS_MOD) + (size_t)l * 5 * 12288;
    const bf16_t* Y = (const bf16_t*)(p.ws + WS_U + U_Y);
    float* XR = (float*)(p.ws + WS_XRES);
    bf16_t* hb = (bf16_t*)(p.ws + WS_HBUF); bf16_t* hl = (bf16_t*)(p.ws + WS_U + U_HLO);
    const int nrows = l == 0 ? NTOK : NLAT;
    for (int r = bid_here() * 8 + wid; r < nrows; r += gridDim.x * 8) {
        const Tok t = tok_of(r);
        f32x4 x[8], y[8]; load_row(xrow_in(p, l, r), x, lane); load_row_bf(Y + (size_t)r * D, y, lane);
        const float rstd = rsqrtf(row_sumsq(y) * (1.f / D) + EPS);
        const float* gate = mod + (size_t)t.mrow * 12288 + 2 * D; const float* g = p.g_post_mix + l * D;
#pragma unroll
        for (int i = 0; i < 8; ++i) {
            const int c = i * 256 + lane * 4; const f32x4 gg = *(const f32x4*)(g + c), gt = *(const f32x4*)(gate + c);
#pragma unroll
            for (int j = 0; j < 4; ++j) x[i][j] += gt[j] * (y[i][j] * rstd * gg[j]);
            *(f32x4*)(XR + (size_t)r * D + c) = x[i];
        }
        adaln_store(x, p.g_pre_ffn + l * D, mod + (size_t)t.mrow * 12288 + 3 * D, mod + (size_t)t.mrow * 12288 + 4 * D, hb + (size_t)r * D, hl + (size_t)r * D, lane);
    }
}
DI void phase_postffn(PR p, int l) {
    const int tid_ = tid_here(), lane = tid_ & 63, wid = tid_ >> 6;
    const float* mod = (const float*)(p.ws + WS_MOD) + (size_t)l * 5 * 12288;
    const bf16_t* YS = (const bf16_t*)(p.ws + WS_U + U_YSH);
    const bf16_t* OA = (const bf16_t*)(p.ws + WS_U + U_OASG);
    float* XR = (float*)(p.ws + WS_XRES);
    bf16_t* hb = (bf16_t*)(p.ws + WS_HBUF);
    const int nrows = l == 0 ? NTOK : NLAT;
    for (int r = bid_here() * 8 + wid; r < nrows; r += gridDim.x * 8) {
        const Tok t = tok_of(r);
        f32x4 x[8], y[8]; load_row((const float*)(p.ws + WS_XRES) + (size_t)r * D, x, lane); load_row_bf(YS + (size_t)r * D, y, lane);
        for (int k = 0; k < 8; ++k) {
            const bf16_t* o = OA + ((size_t)r * 8 + k) * D;
#pragma unroll
            for (int i = 0; i < 8; ++i) { const u32x2 w = *(const u32x2*)(o + i * 256 + lane * 4);
                y[i][0] += __uint_as_float(w.x << 16); y[i][1] += __uint_as_float(w.x & 0xFFFF0000u); y[i][2] += __uint_as_float(w.y << 16); y[i][3] += __uint_as_float(w.y & 0xFFFF0000u); }
        }
        const float rstd = rsqrtf(row_sumsq(y) * (1.f / D) + EPS);
        const float* gate = mod + (size_t)t.mrow * 12288 + 5 * D; const float* g = p.g_post_ffn + l * D;
        float* dstrow = l == 0 ? XR + (size_t)r * D : p.out + (size_t)r * D;
#pragma unroll
        for (int i = 0; i < 8; ++i) {
            const int c = i * 256 + lane * 4; const f32x4 gg = *(const f32x4*)(g + c), gt = *(const f32x4*)(gate + c);
#pragma unroll
            for (int j = 0; j < 4; ++j) x[i][j] += gt[j] * (y[i][j] * rstd * gg[j]);
            *(f32x4*)(dstrow + c) = x[i];
        }
        if (l == 0) {
            const float* mod1 = (const float*)(p.ws + WS_MOD) + (size_t)1 * 5 * 12288;
            adaln_store(x, p.g_pre_mix + 1 * D, mod1 + (size_t)t.mrow * 12288 + 0 * D, mod1 + (size_t)t.mrow * 12288 + 1 * D, hb + (size_t)r * D, nullptr, lane);
        }
    }
}

struct GemmUnit {
    const bf16_t* A; long lda; const int* rows; int rowshift;
    const bf16_t* Bt; long ldb;
    int K;
};
constexpr int GS_LD = 72;
struct LaneId { int wr, wc, fr, fq; };
DI LaneId gemm_kloop_simple(char* lds, const GemmUnit& g, f32x4 (&acc)[2][2][4][2]) {
    int tid = threadIdx.x; asm volatile("" : "+v"(tid));
    const int wid = tid >> 6, lane = tid & 63, wr = wid >> 2, wc = wid & 3, fr = lane & 15, fq = lane >> 4;
    bf16_t* As = (bf16_t*)lds; bf16_t* Bs = As + 256 * GS_LD;
#pragma unroll
    for (int a = 0; a < 2; ++a)
#pragma unroll
        for (int b = 0; b < 2; ++b)
#pragma unroll
            for (int m = 0; m < 4; ++m)
#pragma unroll
                for (int n = 0; n < 2; ++n) acc[a][b][m][n] = (f32x4){0.f, 0.f, 0.f, 0.f};
    const int srow = tid >> 3, skc = (tid & 7) * 8;
    const bf16_t* ap[4]; const bf16_t* bp[4];
#pragma unroll
    for (int i = 0; i < 4; ++i) {
        const int r = srow + 64 * i;
        if (g.rows) { const int idx = g.rows[r]; ap[i] = g.A + (size_t)(idx >= 0 ? (idx >> g.rowshift) : 0) * g.lda + skc; }
        else ap[i] = g.A + (size_t)r * g.lda + skc;
        bp[i] = g.Bt + (size_t)r * g.ldb + skc;
    }
    const int nkt = g.K / 64;
    u32x4 ra[4], rb[4];
#pragma unroll
    for (int i = 0; i < 4; ++i) { ra[i] = *(const u32x4*)(ap[i]); rb[i] = *(const u32x4*)(bp[i]); }
    for (int kt = 0; kt < nkt; ++kt) {
        __syncthreads();
#pragma unroll
        for (int i = 0; i < 4; ++i) { *(u32x4*)(As + (srow + 64 * i) * GS_LD + skc) = ra[i]; *(u32x4*)(Bs + (srow + 64 * i) * GS_LD + skc) = rb[i]; }
        __syncthreads();
        if (kt + 1 < nkt) {
#pragma unroll
            for (int i = 0; i < 4; ++i) { ra[i] = *(const u32x4*)(ap[i] + (kt + 1) * 64); rb[i] = *(const u32x4*)(bp[i] + (kt + 1) * 64); }
        }
#pragma unroll
        for (int kk = 0; kk < 2; ++kk) {
            bf16x8 bf[2][2];
#pragma unroll
            for (int bj = 0; bj < 2; ++bj)
#pragma unroll
                for (int n = 0; n < 2; ++n) bf[bj][n] = *(const bf16x8*)(Bs + (128 * bj + 32 * wc + 16 * n + fr) * GS_LD + kk * 32 + fq * 8);
#pragma unroll
            for (int ai = 0; ai < 2; ++ai)
#pragma unroll
                for (int m = 0; m < 4; ++m) {
                    const bf16x8 af = *(const bf16x8*)(As + (128 * ai + 64 * wr + 16 * m + fr) * GS_LD + kk * 32 + fq * 8);
#pragma unroll
                    for (int bj = 0; bj < 2; ++bj)
#pragma unroll
                        for (int n = 0; n < 2; ++n) acc[ai][bj][m][n] = __builtin_amdgcn_mfma_f32_16x16x32_bf16(bf[bj][n], af, acc[ai][bj][m][n], 0, 0, 0);
                }
        }
    }
    __syncthreads();
    LaneId id; id.wr = wr; id.wc = wc; id.fr = fr; id.fq = fq; return id;
}
#define GEMM_ACC f32x4 acc[2][2][4][2]
#define ACC_FOREACH(...) \
    _Pragma("unroll") for (int ai = 0; ai < 2; ++ai) _Pragma("unroll") for (int m = 0; m < 4; ++m) { const int trow = 128 * ai + 64 * wr + 16 * m + fr; \
    _Pragma("unroll") for (int bj = 0; bj < 2; ++bj) _Pragma("unroll") for (int n = 0; n < 2; ++n) { const int tcol = 128 * bj + 32 * wc + 16 * n + 4 * fq; const f32x4 v = acc[ai][bj][m][n]; __VA_ARGS__ } }

struct EpiProj {
    bf16_t* O; int row0, col0;
    DI void operator()(const f32x4 (&acc)[2][2][4][2], int wr, int wc, int fr, int fq) const {
        ACC_FOREACH({ u32x2 w; w.x = pk2(v[0], v[1]); w.y = pk2(v[2], v[3]); *(u32x2*)(O + (size_t)(row0 + trow) * INWP + col0 + tcol) = w; })
    }
};
struct EpiB16 {
    bf16_t* O; int row0, col0, ld;
    DI void operator()(const f32x4 (&acc)[2][2][4][2], int wr, int wc, int fr, int fq) const {
        ACC_FOREACH({ u32x2 w; w.x = pk2(v[0], v[1]); w.y = pk2(v[2], v[3]); *(u32x2*)(O + (size_t)(row0 + trow) * ld + col0 + tcol) = w; })
    }
};
struct EpiF32 {
    float* O; int row0, col0, ld;
    DI void operator()(const f32x4 (&acc)[2][2][4][2], int wr, int wc, int fr, int fq) const {
        ACC_FOREACH({ *(f32x4*)(O + (size_t)(row0 + trow) * ld + col0 + tcol) = v; })
    }
};
struct EpiUq {
    bf16_t* Q; const float2* ropem; int row0, col0;
    DI void operator()(const f32x4 (&acc)[2][2][4][2], int wr, int wc, int fr, int fq) const {
#pragma unroll
        for (int ai = 0; ai < 2; ++ai)
#pragma unroll
            for (int m = 0; m < 4; ++m) {
                const int r = row0 + 128 * ai + 64 * wr + 16 * m + fr; const Tok t = tok_of(r);
#pragma unroll
                for (int bj = 0; bj < 2; ++bj) {
                    const int cbase = col0 + 128 * bj + 32 * wc;
                    if (cbase >= 1152) continue;
                    const int h = cbase / 192, jb = cbase % 192;
                    f32x4 v0 = acc[ai][bj][m][0], v1 = acc[ai][bj][m][1];
                    if (jb >= 128 && !t.isctx) {
                        const int pos = (jb == 128) ? (t.s >> 6) : (t.s & 63);
#pragma unroll
                        for (int i = 0; i < 4; ++i) { const float2 cs = ropem[pos * 16 + 4 * fq + i]; const float x1 = v0[i], x2 = v1[i]; v0[i] = x1 * cs.x - x2 * cs.y; v1[i] = x2 * cs.x + x1 * cs.y; }
                    }
                    bf16_t* dst = Q + (((size_t)t.b * 6 + h) * SKV + t.kvpos) * 192 + jb + 4 * fq;
                    u32x2 w0; w0.x = pk2(v0[0], v0[1]); w0.y = pk2(v0[2], v0[3]); *(u32x2*)(dst) = w0;
                    u32x2 w1; w1.x = pk2(v1[0], v1[1]); w1.y = pk2(v1[2], v1[3]); *(u32x2*)(dst + 16) = w1;
                }
            }
    }
};
struct EpiUkv {
    bf16_t* Km; bf16_t* Vm; int row0, col0;
    DI void operator()(const f32x4 (&acc)[2][2][4][2], int wr, int wc, int fr, int fq) const {
        ACC_FOREACH({ const int r = row0 + trow; const Tok t = tok_of(r); const int c = col0 + tcol, h = c >> 8, j = c & 255;
            u32x2 w; w.x = pk2(v[0], v[1]); w.y = pk2(v[2], v[3]);
            if (j < 128) *(u32x2*)(Km + (((size_t)t.b * 6 + h) * SKV + t.kvpos) * 192 + j) = w;
            else *(u32x2*)(Vm + (((size_t)t.b * 6 + h) * SKV + t.kvpos) * 128 + (j - 128)) = w; })
    }
};
struct EpiMoe1 {
    bf16_t* act; int arow0, hcol0;
    DI void operator()(const f32x4 (&acc)[2][2][4][2], int wr, int wc, int fr, int fq) const {
#pragma unroll
        for (int ai = 0; ai < 2; ++ai)
#pragma unroll
            for (int m = 0; m < 4; ++m) {
                const int trow = 128 * ai + 64 * wr + 16 * m + fr;
#pragma unroll
                for (int n = 0; n < 2; ++n) {
                    const f32x4 a = acc[ai][0][m][n], b = acc[ai][1][m][n]; f32x4 h;
#pragma unroll
                    for (int i = 0; i < 4; ++i) h[i] = silu_f(a[i]) * b[i];
                    u32x2 w; w.x = pk2(h[0], h[1]); w.y = pk2(h[2], h[3]);
                    *(u32x2*)(act + (size_t)(arow0 + trow) * 512 + hcol0 + 32 * wc + 16 * n + 4 * fq) = w;
                }
            }
    }
};
struct EpiMoe2 {
    bf16_t* oasg; const int* sasg; const float* sw; int srow0, col0;
    DI void operator()(const f32x4 (&acc)[2][2][4][2], int wr, int wc, int fr, int fq) const {
#pragma unroll
        for (int ai = 0; ai < 2; ++ai)
#pragma unroll
            for (int m = 0; m < 4; ++m) {
                const int trow = 128 * ai + 64 * wr + 16 * m + fr; const int a = sasg[srow0 + trow]; const float wgt = sw[srow0 + trow];
                if (a < 0) continue;
#pragma unroll
                for (int bj = 0; bj < 2; ++bj)
#pragma unroll
                    for (int n = 0; n < 2; ++n) { const f32x4 v = acc[ai][bj][m][n] * wgt; u32x2 w; w.x = pk2(v[0], v[1]); w.y = pk2(v[2], v[3]);
                        *(u32x2*)(oasg + (size_t)a * D + col0 + 128 * bj + 32 * wc + 16 * n + 4 * fq) = w; }
            }
    }
};

DI void phase_postproj_rows(PR p, int l) {
    const int tid_ = tid_here(), lane = tid_ & 63, wid = tid_ >> 6;
    unsigned char* U = p.ws + WS_U;
    const bf16_t* PR = (const bf16_t*)(U + U_PROJ);
    bf16_t* CQN = (bf16_t*)(U + U_CQN); bf16_t* CKVN = (bf16_t*)(U + U_CKVN);
    bf16_t* Km = (bf16_t*)(U + U_KM); bf16_t* Qg = (bf16_t*)(U + U_QG); bf16_t* Kg = (bf16_t*)(U + U_KG); bf16_t* Vg = (bf16_t*)(U + U_VG);
    const float2* ropeg = (const float2*)(p.ws + WS_ROPEG); const float2* ropem = (const float2*)(p.ws + WS_ROPEM);
    const float* gq = p.gqa_g_q + l * 128; const float* gk = p.gqa_g_k + l * 128;
    for (int r = bid_here() * 8 + wid; r < NTOK; r += gridDim.x * 8) {
        const Tok t = tok_of(r);
        const bf16_t* pr = PR + (size_t)r * INWP;
        {
            float v[6], ss = 0.f;
#pragma unroll
            for (int i = 0; i < 6; ++i) { v[i] = bf2f(pr[C_CQ + lane + 64 * i]); ss += v[i] * v[i]; }
            const float rstd = rsqrtf(wave_sum(ss) * (1.f / 384.f) + EPS);
#pragma unroll
            for (int i = 0; i < 6; ++i) CQN[(size_t)r * 512 + lane + 64 * i] = f2bf(v[i] * rstd);
            CQN[(size_t)r * 512 + 384 + lane] = 0; CQN[(size_t)r * 512 + 448 + lane] = 0;
        }
        {
            float v[8], ss = 0.f;
#pragma unroll
            for (int i = 0; i < 8; ++i) { v[i] = bf2f(pr[C_CKV + lane + 64 * i]); ss += v[i] * v[i]; }
            const float rstd = rsqrtf(wave_sum(ss) * (1.f / 512.f) + EPS);
#pragma unroll
            for (int i = 0; i < 8; ++i) CKVN[(size_t)r * 512 + lane + 64 * i] = f2bf(v[i] * rstd);
        }
        {
            float x = bf2f(pr[C_KR + lane]);
            const float other = shx(x, 16, lane);
            if (!t.isctx) {
                const int g = lane >> 5, idx = lane & 31, fi = idx & 15; const bool second = idx >= 16;
                const int pos = g == 0 ? (t.s >> 6) : (t.s & 63);
                const float2 cs = ropem[pos * 16 + fi];
                x = second ? x * cs.x + other * cs.y : x * cs.x - other * cs.y;
            }
            const bf16_t xb = f2bf(x);
#pragma unroll
            for (int h = 0; h < 6; ++h) Km[(((size_t)t.b * 6 + h) * SKV + t.kvpos) * 192 + 128 + lane] = xb;
        }
        const int fi = lane & 31; const bool second = lane >= 32;
        float2 cs0 = make_float2(1.f, 0.f), cs1 = make_float2(1.f, 0.f);
        if (!t.isctx) { cs0 = ropeg[(t.s >> 6) * 32 + fi]; cs1 = ropeg[(t.s & 63) * 32 + fi]; }
#pragma unroll
        for (int hh = 0; hh < 8; ++hh) {
            const bool isq = hh < 6; const int h = isq ? hh : hh - 6; const float* g = isq ? gq : gk;
            const int cb = (isq ? C_AQ : C_AK) + h * 128;
            float e0 = bf2f(pr[cb + lane]), e1 = bf2f(pr[cb + 64 + lane]);
            const float rstd = rsqrtf(wave_sum(e0 * e0 + e1 * e1) * (1.f / 128.f) + EPS);
            e0 = e0 * rstd * g[lane]; e1 = e1 * rstd * g[64 + lane];
            const float o0 = shx(e0, 32, lane), o1 = shx(e1, 32, lane);
            const float r0 = second ? e0 * cs0.x + o0 * cs0.y : e0 * cs0.x - o0 * cs0.y;
            const float r1 = second ? e1 * cs1.x + o1 * cs1.y : e1 * cs1.x - o1 * cs1.y;
            bf16_t* dst = isq ? Qg + (((size_t)t.b * 6 + h) * SKV + t.kvpos) * 128 : Kg + (((size_t)t.b * 2 + h) * SKV + t.kvpos) * 128;
            dst[lane] = f2bf(r0); dst[64 + lane] = f2bf(r1);
        }
#pragma unroll
        for (int h = 0; h < 2; ++h) { bf16_t* dst = Vg + (((size_t)t.b * 2 + h) * SKV + t.kvpos) * 128; dst[lane] = pr[C_AV + h * 128 + lane]; dst[64 + lane] = pr[C_AV + h * 128 + 64 + lane]; }
    }
}

#define SBAR() __builtin_amdgcn_sched_barrier(0)
DI int crow(int r, int hi) { return (r & 3) + 8 * (r >> 2) + 4 * hi; }
DI unsigned cvtpk(float lo, float hi) { unsigned r; asm volatile("v_cvt_pk_bf16_f32 %0, %1, %2" : "=v"(r) : "v"(lo), "v"(hi)); return r; }
constexpr float ATT_THR = 8.f;
template <int DQK> struct AttnCfg {
    static constexpr int KROWB = DQK * 2;
    static constexpr int SHM_V = 64 * 128 * 2, SHM_K = 64 * DQK * 2;
    static constexpr int ND0 = DQK / 16;
    static constexpr int NKCH = DQK / 64;
    static constexpr int NQR = DQK == 128 ? 8 : ATT_NQR_M;
    static constexpr int SHM_Q = 8 * (ND0 - NQR) * 1024;
    static constexpr int SHM_TOTAL = 2 * SHM_V + 2 * SHM_K + 8 * 64 * 4 + SHM_Q;
};
template <int DQK> DI int kswz(int row, int colB) { return row * (DQK * 2) + (colB ^ ((row & 7) << 4)); }
DI void partialSM(f32x16& p0, f32x16& p1, float& m_reg, float& mn, float& alpha, const float SCALE) {
    const float C = SCALE * 1.4426950408889634f;
    float pmax = p0[0];
#pragma unroll
    for (int r = 1; r < 16; ++r) pmax = fmaxf(pmax, p0[r]);
#pragma unroll
    for (int r = 0; r < 16; ++r) pmax = fmaxf(pmax, p1[r]);
    { auto rr = __builtin_amdgcn_permlane32_swap(__float_as_uint(pmax), __float_as_uint(pmax), false, false);
      pmax = fmaxf(__uint_as_float(rr[0]), __uint_as_float(rr[1])); }
    if (__builtin_expect(__all(pmax - m_reg <= ATT_THR / SCALE), 1)) { mn = m_reg; alpha = 1.f; }
    else { mn = fmaxf(m_reg, pmax); alpha = __builtin_amdgcn_exp2f((m_reg - mn) * C); m_reg = mn; }
    const float mnC = -mn * C;
#pragma unroll
    for (int r = 0; r < 16; ++r) p0[r] = fmaf(p0[r], C, mnC);
#pragma unroll
    for (int r = 0; r < 16; ++r) p1[r] = fmaf(p1[r], C, mnC);
#pragma unroll
    for (int r = 0; r < 16; ++r) p0[r] = __builtin_amdgcn_exp2f(p0[r]);
}
DI void finishSM(f32x16& p0, f32x16& p1, float alpha, float& l_reg, bf16x8& pa0, bf16x8& pa1, bf16x8& pa2, bf16x8& pa3) {
#pragma unroll
    for (int r = 0; r < 16; ++r) p1[r] = __builtin_amdgcn_exp2f(p1[r]);
    float ps = 0;
#pragma unroll
    for (int r = 0; r < 16; ++r) ps += p0[r];
#pragma unroll
    for (int r = 0; r < 16; ++r) ps += p1[r];
    { auto rr = __builtin_amdgcn_permlane32_swap(__float_as_uint(ps), __float_as_uint(ps), false, false);
      ps = __uint_as_float(rr[0]) + __uint_as_float(rr[1]); }
    l_reg = l_reg * alpha + ps;
#define PK4(P, BASE, OUT) do { unsigned a0 = cvtpk(P[BASE + 0], P[BASE + 1]), a1 = cvtpk(P[BASE + 2], P[BASE + 3]);   \
    unsigned b0 = cvtpk(P[BASE + 4], P[BASE + 5]), b1 = cvtpk(P[BASE + 6], P[BASE + 7]);                              \
    auto r0 = __builtin_amdgcn_permlane32_swap(a0, b0, false, false); auto r1 = __builtin_amdgcn_permlane32_swap(a1, b1, false, false); \
    u32x4 w = {r0[0], r1[0], r0[1], r1[1]}; OUT = *reinterpret_cast<bf16x8*>(&w); } while (0)
    PK4(p0, 0, pa0); PK4(p0, 8, pa1); PK4(p1, 0, pa2); PK4(p1, 8, pa3);
#undef PK4
}
template <int DQK, int NQR>
DI void qkt(f32x16& p0, f32x16& p1, const int (&kb)[4], int bufoff, const bf16x8* qr, int qs_addr, int r32, int hi) {
    asm volatile("" : "+v"(qs_addr));
    const LAS char* Qs = (const LAS char*)qs_addr;
#pragma unroll
    for (int r = 0; r < 16; ++r) { p0[r] = 0.f; p1[r] = 0.f; }
#pragma unroll
    for (int d0 = 0; d0 < DQK / 16; ++d0) {
        const LAS char* ka = (const LAS char*)(kb[d0 & 3]) + bufoff + 128 * (d0 >> 2);
        const bf16x8 b0 = *(const LAS bf16x8*)(ka);
        const bf16x8 b1 = *(const LAS bf16x8*)(ka + 32 * DQK * 2);
        bf16x8 q;
        if (d0 < NQR) q = qr[d0]; else q = *(const LAS bf16x8*)(Qs + (d0 - NQR) * 1024);
        p0 = __builtin_amdgcn_mfma_f32_32x32x16_bf16(b0, q, p0, 0, 0, 0);
        p1 = __builtin_amdgcn_mfma_f32_32x32x16_bf16(b1, q, p1, 0, 0, 0); }
}
DI int v_st(int k, int c) { const int kk = (k & ~0xC) | ((k & 4) << 1) | ((k & 8) >> 1); return ((kk >> 3) * 4 + (c >> 5)) * 512 + ((kk & 7) * 32 + (c & 31)) * 2; }
DI int v_rd_base(int lane) { return ((lane & 3) << 3) | (((lane >> 2) & 3) << 6) | (((lane >> 4) & 1) << 5) | (((lane >> 5) & 1) << 8); }
constexpr int v_rd_off(int d0, int ks, int half) { return d0 * 512 + ks * 4096 + half * 2048; }
template <int OFF> DI s16x4 tr_read(int vb) { s16x4 r; asm volatile("ds_read_b64_tr_b16 %0, %1 offset:%2" : "=&v"(r) : "v"(vb), "i"(OFF) : "memory"); return r; }
template <int D0> DI void pv_one(f32x16& od, int vb, bf16x8 pa0, bf16x8 pa1, bf16x8 pa2, bf16x8 pa3) {
    const s16x4 l0 = tr_read<v_rd_off(D0, 0, 0)>(vb), h0 = tr_read<v_rd_off(D0, 0, 1)>(vb), l1 = tr_read<v_rd_off(D0, 1, 0)>(vb), h1 = tr_read<v_rd_off(D0, 1, 1)>(vb);
    const s16x4 l2 = tr_read<v_rd_off(D0, 2, 0)>(vb), h2 = tr_read<v_rd_off(D0, 2, 1)>(vb), l3 = tr_read<v_rd_off(D0, 3, 0)>(vb), h3 = tr_read<v_rd_off(D0, 3, 1)>(vb);
    asm volatile("s_waitcnt lgkmcnt(0)" ::: "memory"); SBAR();
#define PKV(L, H) (bf16x8){L[0], L[1], L[2], L[3], H[0], H[1], H[2], H[3]}
    od = __builtin_amdgcn_mfma_f32_32x32x16_bf16(pa0, PKV(l0, h0), od, 0, 0, 0);
    od = __builtin_amdgcn_mfma_f32_32x32x16_bf16(pa1, PKV(l1, h1), od, 0, 0, 0);
    od = __builtin_amdgcn_mfma_f32_32x32x16_bf16(pa2, PKV(l2, h2), od, 0, 0, 0);
    od = __builtin_amdgcn_mfma_f32_32x32x16_bf16(pa3, PKV(l3, h3), od, 0, 0, 0);
#undef PKV
}
DI void pv_d0(f32x16* o, int vb, bf16x8 pa0, bf16x8 pa1, bf16x8 pa2, bf16x8 pa3) {
    pv_one<0>(o[0], vb, pa0, pa1, pa2, pa3); pv_one<1>(o[1], vb, pa0, pa1, pa2, pa3); pv_one<2>(o[2], vb, pa0, pa1, pa2, pa3); pv_one<3>(o[3], vb, pa0, pa1, pa2, pa3);
}
template <int DQK, int SDEPTH>
DI void attn_body(const bf16_t* __restrict__ Qb, const bf16_t* __restrict__ Kh, const bf16_t* __restrict__ Vh, bf16_t* __restrict__ Ob, int ldo, int seq, char* lds, const float SCALE) {
    using Cfg = AttnCfg<DQK>;
    constexpr int SHM_V = Cfg::SHM_V, SHM_K = Cfg::SHM_K, ND0 = Cfg::ND0, NKCH = Cfg::NKCH, KCPR = DQK / 8, NQR = Cfg::NQR;
    int tid = threadIdx.x; asm volatile("" : "+v"(tid));
    const int wid = tid >> 6, lane = tid & 63, r32 = lane & 31, hi = lane >> 5;
    char* V_lds = lds; char* K_lds = lds + 2 * SHM_V;
    float* ws = (float*)(lds + 2 * SHM_V + 2 * SHM_K) + wid * 64; float* li_l = ws; float* al_l = ws + 32;
    float m_reg = -1e30f, l_reg = 0; f32x16 o[4]; bf16x8 qr[NQR > 0 ? NQR : 1];
    char* Qs = lds + 2 * SHM_V + 2 * SHM_K + 8 * 64 * 4 + (wid * (ND0 - NQR) * 64 + lane) * 16;
#pragma unroll
    for (int d = 0; d < 4; ++d)
#pragma unroll
        for (int r = 0; r < 16; ++r) o[d][r] = 0.f;
    const bf16_t* Qw = Qb + (long)(wid * 32 + r32) * DQK + hi * 8;
#pragma unroll
    for (int d0 = 0; d0 < ND0; ++d0) { const bf16x8 qv = *reinterpret_cast<const bf16x8*>(Qw + d0 * 16); if (d0 < NQR) qr[d0] = qv; else *reinterpret_cast<bf16x8*>(Qs + (d0 - NQR) * 1024) = qv; }
    asm volatile("s_waitcnt lgkmcnt(0)" ::: "memory");
    const int sr = tid >> 4, sc = (tid & 15) * 8, vst0 = v_st(sr, sc), vst1 = v_st(32 + sr, sc);
    const int kgo = (tid >> 3) * DQK + (tid & 7) * 8, klo = (tid >> 3) * (DQK * 2) + (((tid & 7) << 4) ^ (((tid >> 3) & 7) << 4));
    const int vb0 = (int)(uintptr_t)V_lds + v_rd_base(lane);
    int kb[4];
#pragma unroll
    for (int m = 0; m < 4; ++m) { kb[m] = (int)(uintptr_t)K_lds + r32 * (DQK * 2) + 16 * (hi ^ (r32 & 1)) + 32 * (m ^ ((r32 >> 1) & 3)); asm volatile("" : "+v"(kb[m])); }
    struct { bf16x8 vs0, vs1, ks[NKCH]; } sr_[SDEPTH];
#define SLOAD(i, k0) do { sr_[i].vs0 = *(const bf16x8*)(&Vh[(long)((k0) + sr) * 128 + sc]); sr_[i].vs1 = *(const bf16x8*)(&Vh[(long)((k0) + 32 + sr) * 128 + sc]); \
    _Pragma("unroll") for (int q_ = 0; q_ < NKCH; ++q_) sr_[i].ks[q_] = *(const bf16x8*)(&Kh[(long)(k0) * DQK + kgo + q_ * 64]); } while (0)
#define SWRITE(b, i) do { *(bf16x8*)(V_lds + (b) * SHM_V + vst0) = sr_[i].vs0; *(bf16x8*)(V_lds + (b) * SHM_V + vst1) = sr_[i].vs1; \
    _Pragma("unroll") for (int q_ = 0; q_ < NKCH; ++q_) *(bf16x8*)(K_lds + (b) * SHM_K + klo + q_ * 128) = sr_[i].ks[q_]; } while (0)
#define SWAIT() do { if constexpr (SDEPTH == 1) asm volatile("s_waitcnt vmcnt(0)" ::: "memory"); else if constexpr (NKCH == 2) asm volatile("s_waitcnt vmcnt(4)" ::: "memory"); else asm volatile("s_waitcnt vmcnt(5)" ::: "memory"); } while (0)
#define RESC(a) do { if (__any((a) < 1.f)) { if (hi == 0) al_l[r32] = (a); asm volatile("s_waitcnt lgkmcnt(0)" ::: "memory"); \
    _Pragma("unroll") for (int d = 0; d < 4; ++d) _Pragma("unroll") for (int r = 0; r < 16; ++r) o[d][r] *= al_l[crow(r, hi)]; } } while (0)
    f32x16 pA0, pA1, pB0, pB1; float mnA, mnB, alA, alB; bf16x8 pa0, pa1, pa2, pa3; const int NT = seq / 64;
    constexpr int SE = 0, SO = SDEPTH - 1;
    SLOAD(SE, 0); asm volatile("s_waitcnt vmcnt(0)" ::: "memory"); SWRITE(0, SE); __syncthreads();
    qkt<DQK, NQR>(pA0, pA1, kb, 0, qr, (int)(uintptr_t)Qs, r32, hi); partialSM(pA0, pA1, m_reg, mnA, alA, SCALE);
    SLOAD(SO, 64); if constexpr (SDEPTH == 2) { if (2 < NT) SLOAD(SE, 2 * 64); }
    SWAIT(); SWRITE(1, SO); __syncthreads();
    for (int j = 1; j + 1 < NT; j += 2) {
        SBAR(); qkt<DQK, NQR>(pB0, pB1, kb, SHM_K, qr, (int)(uintptr_t)Qs, r32, hi);
        finishSM(pA0, pA1, alA, l_reg, pa0, pa1, pa2, pa3); SBAR();
        SLOAD(SO, (j + SDEPTH) * 64); SBAR();
        pv_d0(o, vb0, pa0, pa1, pa2, pa3); partialSM(pB0, pB1, m_reg, mnB, alB, SCALE);
        __syncthreads(); SWAIT(); SWRITE(0, SE);
        RESC(alB); __syncthreads();
        SBAR(); qkt<DQK, NQR>(pA0, pA1, kb, 0, qr, (int)(uintptr_t)Qs, r32, hi);
        finishSM(pB0, pB1, alB, l_reg, pa0, pa1, pa2, pa3); SBAR();
        if (SDEPTH == 1 || j + 3 < NT) SLOAD(SE, (j + 1 + SDEPTH) * 64); SBAR();
        pv_d0(o, vb0 + SHM_V, pa0, pa1, pa2, pa3); partialSM(pA0, pA1, m_reg, mnA, alA, SCALE);
        __syncthreads(); SWAIT(); SWRITE(1, SO);
        RESC(alA); __syncthreads();
    }
    SBAR(); qkt<DQK, NQR>(pB0, pB1, kb, SHM_K, qr, (int)(uintptr_t)Qs, r32, hi);
    finishSM(pA0, pA1, alA, l_reg, pa0, pa1, pa2, pa3); SBAR();
    pv_d0(o, vb0, pa0, pa1, pa2, pa3); partialSM(pB0, pB1, m_reg, mnB, alB, SCALE);
    __syncthreads(); RESC(alB);
    finishSM(pB0, pB1, alB, l_reg, pa0, pa1, pa2, pa3); SBAR();
    pv_d0(o, vb0 + SHM_V, pa0, pa1, pa2, pa3);
    if (hi == 0) li_l[r32] = l_reg; asm volatile("s_waitcnt lgkmcnt(0)" ::: "memory");
    float rli[16];
#pragma unroll
    for (int r = 0; r < 16; ++r) rli[r] = __builtin_amdgcn_rcpf(li_l[crow(r, hi)]);
    bf16_t* Ow = Ob + (long)(wid * 32) * ldo;
#pragma unroll
    for (int r = 0; r < 16; ++r) { const int orow = crow(r, hi);
#pragma unroll
        for (int d0 = 0; d0 < 4; ++d0) Ow[(long)orow * ldo + d0 * 32 + r32] = f2bf(o[d0][r] * rli[r]); }
    __syncthreads();
#undef SLOAD
#undef SWRITE
#undef SWAIT
#undef RESC
}

constexpr int GL_V = 0;
constexpr int GL_K = 16384;
constexpr int GL_Q = GL_K + 9216;
constexpr int GL_ZF = GL_Q + 9216;
constexpr int GL_ZB = GL_ZF + 4096;
constexpr int GL_LF = GL_ZB + 4096;
constexpr int GL_LB = GL_LF + 16640;
constexpr int GL_X0 = GL_LB + 16640;
constexpr int GL_KEF = GL_X0, GL_KEB = GL_X0 + 9216;
constexpr int GL_QD = GL_X0, GL_KI = GL_X0 + 9216;
constexpr int GL_O = GL_X0 + 18432;
static_assert(GL_O + 64 * 132 * 4 <= 160 * 1024 - 256, "GLA LDS");
DI int gla_row0(int b, int c) { return c < 4 ? NLAT + b * CTXL + c * 64 : b * SEQ + (c - 4) * 64; }
DI void gla_prep(PR p, int l, char* lds, int b, int h, int c, bool needq) {
    const int tid = tid_here(), lane = tid & 63, wid = tid >> 6;
    const bf16_t* PR_ = (const bf16_t*)(p.ws + WS_U + U_PROJ);
    const int row0 = gla_row0(b, c);
    {
        const int t = tid >> 3, dg = (tid & 7) * 8; const bf16_t* pr = PR_ + (size_t)(row0 + t) * INWP;
        *(bf16x8*)(lds + GL_K + t * 144 + dg * 2) = *(const bf16x8*)(pr + C_GK + h * 64 + dg);
        if (needq) { const bf16x8 qv = *(const bf16x8*)(pr + C_GQ + h * 64 + dg); u32x4 w;
            w.x = pk2(bf2f((bf16_t)qv[0]) * 0.125f, bf2f((bf16_t)qv[1]) * 0.125f); w.y = pk2(bf2f((bf16_t)qv[2]) * 0.125f, bf2f((bf16_t)qv[3]) * 0.125f);
            w.z = pk2(bf2f((bf16_t)qv[4]) * 0.125f, bf2f((bf16_t)qv[5]) * 0.125f); w.w = pk2(bf2f((bf16_t)qv[6]) * 0.125f, bf2f((bf16_t)qv[7]) * 0.125f);
            *(u32x4*)(lds + GL_Q + t * 144 + dg * 2) = w; }
        const int sr = tid >> 4, sc = (tid & 15) * 8;
        *(bf16x8*)(lds + GL_V + v_st(sr, sc)) = *(const bf16x8*)(PR_ + (size_t)(row0 + sr) * INWP + C_GV + h * 128 + sc);
        *(bf16x8*)(lds + GL_V + v_st(32 + sr, sc)) = *(const bf16x8*)(PR_ + (size_t)(row0 + 32 + sr) * INWP + C_GV + h * 128 + sc);
        if (tid < 256) { const int tt = (tid & 127) >> 1, half = tid & 1, dir = tid >> 7; const bf16x8 zv = *(const bf16x8*)(PR_ + (size_t)(row0 + tt) * INWP + (dir ? C_ZB : C_ZF) + half * 8);
            float* Z = (float*)(lds + (dir ? GL_ZB : GL_ZF)) + tt * 16 + half * 8;
#pragma unroll
            for (int j = 0; j < 8; ++j) Z[j] = bf2f((bf16_t)zv[j]); }
    }
    float wf[16], wb[16];
#pragma unroll
    for (int r = 0; r < 16; ++r) { wf[r] = p.gla_wg2_f[((size_t)l * 16 + r) * 256 + h * 64 + lane]; wb[r] = p.gla_wg2_b[((size_t)l * 16 + r) * 256 + h * 64 + lane]; }
    const float bgf = p.gla_bg_f[l * 256 + h * 64 + lane], bgb = p.gla_bg_b[l * 256 + h * 64 + lane];
    __syncthreads();
#pragma unroll
    for (int i = 0; i < 8; ++i) {
        const int t = wid * 8 + i; const float* ZF = (const float*)(lds + GL_ZF) + t * 16; const float* ZB = (const float*)(lds + GL_ZB) + t * 16;
        float zf = bgf, zb = bgb;
#pragma unroll
        for (int r = 0; r < 16; ++r) { zf += ZF[r] * wf[r]; zb += ZB[r] * wb[r]; }
        const float lf = fminf(zf, 0.f) - __logf(1.f + __expf(-fabsf(zf))), lb = fminf(zb, 0.f) - __logf(1.f + __expf(-fabsf(zb)));
        ((float*)(lds + GL_LF))[t * 65 + lane] = lf * 0.0625f; ((float*)(lds + GL_LB))[t * 65 + lane] = lb * 0.0625f;
    }
    __syncthreads();
#pragma unroll
    for (int i = 0; i < 8; ++i) {
        const int d = wid * 8 + i;
        float* F = (float*)(lds + GL_LF) + lane * 65 + d; float* Bk = (float*)(lds + GL_LB) + lane * 65 + d;
        float f = *F, g = *Bk;
#pragma unroll
        for (int o = 1; o < 64; o <<= 1) {
            const float fu = __int_as_float(__builtin_amdgcn_ds_bpermute(((lane - o) & 63) << 2, __float_as_int(f)));
            const float gu = __int_as_float(__builtin_amdgcn_ds_bpermute(((lane + o) & 63) << 2, __float_as_int(g)));
            if (lane >= o) f += fu; if (lane + o < 64) g += gu;
        }
        *F = f; *Bk = g;
    }
    __syncthreads();
}
DI void gla_phaseA(PR p, int l, char* lds) {
    float* GS = (float*)(p.ws + WS_U + U_GS); float* GD = (float*)(p.ws + WS_GDEC);
    for (int u = bid_here(); u < 16 * 68; u += gridDim.x) {
        const int bh = u / 68, c = u % 68, b = bh >> 2, h = bh & 3;
        gla_prep(p, l, lds, b, h, c, false);
        const int tid = tid_here(), lane = tid & 63, wid = tid >> 6, r32 = lane & 31, hi = lane >> 5;
        {
            const float* LF = (const float*)(lds + GL_LF); const float* LB = (const float*)(lds + GL_LB);
            const float lastf = LF[63 * 65 + lane], lastb = LB[0 * 65 + lane];
            float ef[8], eb[8];
#pragma unroll
            for (int i = 0; i < 8; ++i) { const int t = wid * 8 + i; const float k = bf2f(*(const bf16_t*)(lds + GL_K + t * 144 + lane * 2));
                ef[i] = k * __expf(lastf - LF[t * 65 + lane]); eb[i] = k * __expf(lastb - LB[t * 65 + lane]); }
            u32x4 w; w.x = pk2(ef[0], ef[1]); w.y = pk2(ef[2], ef[3]); w.z = pk2(ef[4], ef[5]); w.w = pk2(ef[6], ef[7]); *(u32x4*)(lds + GL_KEF + lane * 144 + wid * 16) = w;
            w.x = pk2(eb[0], eb[1]); w.y = pk2(eb[2], eb[3]); w.z = pk2(eb[4], eb[5]); w.w = pk2(eb[6], eb[7]); *(u32x4*)(lds + GL_KEB + lane * 144 + wid * 16) = w;
            if (wid == 0) { GD[((size_t)(0 * 16 + bh) * 68 + c) * 64 + lane] = __expf(lastf); GD[((size_t)(1 * 16 + bh) * 68 + c) * 64 + lane] = __expf(lastb); }
        }
        __syncthreads();
        {
            const int rh = wid & 1, cb = wid >> 1;
            const int vb = (int)(uintptr_t)(lds + GL_V) + v_rd_base(lane) + cb * 512;
#pragma unroll
            for (int dir = 0; dir < 2; ++dir) {
                const char* KE = lds + (dir ? GL_KEB : GL_KEF) + (rh * 32 + r32) * 144 + hi * 16;
                const bf16x8 a0 = *(const bf16x8*)(KE), a1 = *(const bf16x8*)(KE + 32), a2 = *(const bf16x8*)(KE + 64), a3 = *(const bf16x8*)(KE + 96);
                f32x16 od;
#pragma unroll
                for (int r = 0; r < 16; ++r) od[r] = 0.f;
                pv_one<0>(od, vb, a0, a1, a2, a3);
                float* dst = GS + ((size_t)(dir * 16 + bh) * 68 + c) * 8192 + (size_t)(cb * 32 + r32) * 64 + rh * 32 + 4 * hi;
#pragma unroll
                for (int g = 0; g < 4; ++g) *(f32x4*)(dst + 8 * g) = (f32x4){od[4 * g], od[4 * g + 1], od[4 * g + 2], od[4 * g + 3]};
            }
        }
        __syncthreads();
    }
}
DI void gla_scan(PR p) {
    const float* GS = (const float*)(p.ws + WS_U + U_GS); const float* GD = (const float*)(p.ws + WS_GDEC); bf16_t* GST = (bf16_t*)(p.ws + WS_U + U_GST);
    const int tid = tid_here();
    for (int u = bid_here(); u < 128; u += gridDim.x) {
        const int e = u * NTHREADS + tid, db = e >> 11, jd4 = e & 2047, d4 = (jd4 & 15) * 4;
        const int dir = db >> 4;
        const float* base = GS + (size_t)db * 68 * 8192 + jd4 * 4; const float* dbase = GD + (size_t)db * 68 * 64 + d4; bf16_t* obase = GST + (size_t)db * 68 * 8192 + jd4 * 4;
#define SC_C(i) (dir == 0 ? (i) : ((i) < 4 ? 3 - (i) : 71 - (i)))
        float z0 = 0.f; asm volatile("" : "+v"(z0));
        f32x4 S = {z0, z0, z0, z0};
        f32x4 cur[4], nxt[4], dc[4], dn[4];
#pragma unroll
        for (int q = 0; q < 4; ++q) { const int c = SC_C(q); cur[q] = *(const f32x4*)(base + (size_t)c * 8192); dc[q] = *(const f32x4*)(dbase + c * 64); }
        for (int i = 0; i < 68; i += 4) {
            if (i + 4 < 68) {
#pragma unroll
                for (int q = 0; q < 4; ++q) { const int c = SC_C(i + 4 + q); nxt[q] = *(const f32x4*)(base + (size_t)c * 8192); dn[q] = *(const f32x4*)(dbase + c * 64); }
            }
#pragma unroll
            for (int q = 0; q < 4; ++q) { const int c = SC_C(i + q); u32x2 w; w.x = pk2(S[0], S[1]); w.y = pk2(S[2], S[3]); *(u32x2*)(obase + (size_t)c * 8192) = w; S = S * dc[q] + cur[q]; }
#pragma unroll
            for (int q = 0; q < 4; ++q) { cur[q] = nxt[q]; dc[q] = dn[q]; }
        }
#undef SC_C
    }
}
DI void gla_phaseC(PR p, int l, char* lds) {
    const bf16_t* GST = (const bf16_t*)(p.ws + WS_U + U_GST);
    const bf16_t* PR_ = (const bf16_t*)(p.ws + WS_U + U_PROJ); bf16_t* MIX = (bf16_t*)(p.ws + WS_U + U_MIX);
    for (int u = bid_here(); u < 16 * 68; u += gridDim.x) {
        const int bh = u / 68, c = u % 68, b = bh >> 2, h = bh & 3;
        if (l == 1 && c < 4) continue;
        gla_prep(p, l, lds, b, h, c, true);
        const int tid = tid_here(), lane = tid & 63, wid = tid >> 6, r32 = lane & 31, hi = lane >> 5, rh = wid & 1, cb = wid >> 1;
        const int vb = (int)(uintptr_t)(lds + GL_V) + v_rd_base(lane) + cb * 512;
        f32x16 o;
#pragma unroll
        for (int r = 0; r < 16; ++r) o[r] = 0.f;
#pragma unroll
        for (int dir = 0; dir < 2; ++dir) {
            {
                const int t = tid >> 3, dg = (tid & 7) * 8; const float* LC = (const float*)(lds + (dir ? GL_LB : GL_LF)) + t * 65 + dg;
                const bf16x8 qv = *(const bf16x8*)(lds + GL_Q + t * 144 + dg * 2), kv = *(const bf16x8*)(lds + GL_K + t * 144 + dg * 2);
                float qd[8], ki[8];
#pragma unroll
                for (int j = 0; j < 8; ++j) { const float bc = LC[j]; qd[j] = bf2f((bf16_t)qv[j]) * __expf(bc); ki[j] = bf2f((bf16_t)kv[j]) * __expf(-bc); }
                u32x4 w; w.x = pk2(qd[0], qd[1]); w.y = pk2(qd[2], qd[3]); w.z = pk2(qd[4], qd[5]); w.w = pk2(qd[6], qd[7]); *(u32x4*)(lds + GL_QD + t * 144 + dg * 2) = w;
                w.x = pk2(ki[0], ki[1]); w.y = pk2(ki[2], ki[3]); w.z = pk2(ki[4], ki[5]); w.w = pk2(ki[6], ki[7]); *(u32x4*)(lds + GL_KI + t * 144 + dg * 2) = w;
            }
            __syncthreads();
            {
                const char* QD = lds + GL_QD + (rh * 32 + r32) * 144 + hi * 16; const char* KI = lds + GL_KI + r32 * 144 + hi * 16;
                bf16x8 qf[4];
#pragma unroll
                for (int d0 = 0; d0 < 4; ++d0) qf[d0] = *(const bf16x8*)(QD + d0 * 32);
                f32x16 p0, p1;
#pragma unroll
                for (int r = 0; r < 16; ++r) { p0[r] = 0.f; p1[r] = 0.f; }
#pragma unroll
                for (int d0 = 0; d0 < 4; ++d0) {
                    const bf16x8 k0 = *(const bf16x8*)(KI + d0 * 32), k1 = *(const bf16x8*)(KI + 32 * 144 + d0 * 32);
                    p0 = __builtin_amdgcn_mfma_f32_32x32x16_bf16(k0, qf[d0], p0, 0, 0, 0);
                    p1 = __builtin_amdgcn_mfma_f32_32x32x16_bf16(k1, qf[d0], p1, 0, 0, 0);
                }
                const int tq = rh * 32 + r32;
#pragma unroll
                for (int r = 0; r < 16; ++r) { const int s0 = crow(r, hi), s1 = 32 + s0;
                    const bool ok0 = dir == 0 ? (s0 <= tq) : (s0 >= tq), ok1 = dir == 0 ? (s1 <= tq) : (s1 >= tq);
                    p0[r] = ok0 ? p0[r] : 0.f; p1[r] = ok1 ? p1[r] : 0.f; }
                bf16x8 pa0, pa1, pa2, pa3;
#define PK4(P, BASE, OUT) do { unsigned a0 = cvtpk(P[BASE + 0], P[BASE + 1]), a1 = cvtpk(P[BASE + 2], P[BASE + 3]);   \
    unsigned b0 = cvtpk(P[BASE + 4], P[BASE + 5]), b1 = cvtpk(P[BASE + 6], P[BASE + 7]);                              \
    auto r0 = __builtin_amdgcn_permlane32_swap(a0, b0, false, false); auto r1 = __builtin_amdgcn_permlane32_swap(a1, b1, false, false); \
    u32x4 w_ = {r0[0], r1[0], r0[1], r1[1]}; OUT = *reinterpret_cast<bf16x8*>(&w_); } while (0)
                PK4(p0, 0, pa0); PK4(p0, 8, pa1); PK4(p1, 0, pa2); PK4(p1, 8, pa3);
#undef PK4
                pv_one<0>(o, vb, pa0, pa1, pa2, pa3);
                const bf16_t* Sg = GST + ((size_t)(dir * 16 + bh) * 68 + c) * 8192 + (size_t)(cb * 32 + r32) * 64 + hi * 8;
                const bf16x8 s0 = *(const bf16x8*)(Sg), s1 = *(const bf16x8*)(Sg + 16), s2 = *(const bf16x8*)(Sg + 32), s3 = *(const bf16x8*)(Sg + 48);
                o = __builtin_amdgcn_mfma_f32_32x32x16_bf16(qf[0], s0, o, 0, 0, 0);
                o = __builtin_amdgcn_mfma_f32_32x32x16_bf16(qf[1], s1, o, 0, 0, 0);
                o = __builtin_amdgcn_mfma_f32_32x32x16_bf16(qf[2], s2, o, 0, 0, 0);
                o = __builtin_amdgcn_mfma_f32_32x32x16_bf16(qf[3], s3, o, 0, 0, 0);
            }
            __syncthreads();
        }
        { float* O = (float*)(lds + GL_O);
#pragma unroll
          for (int r = 0; r < 16; ++r) O[(rh * 32 + crow(r, hi)) * 132 + cb * 32 + r32] = o[r]; }
        __syncthreads();
        {
            const int t = tid >> 3, jg = (tid & 7) * 16; const float* O = (const float*)(lds + GL_O) + t * 132 + jg;
            float v[16], ss = 0.f;
#pragma unroll
            for (int q = 0; q < 4; ++q) { const f32x4 x = *(const f32x4*)(O + 4 * q); v[4 * q] = x[0]; v[4 * q + 1] = x[1]; v[4 * q + 2] = x[2]; v[4 * q + 3] = x[3]; ss += x[0] * x[0] + x[1] * x[1] + x[2] * x[2] + x[3] * x[3]; }
            ss += shx(ss, 1, lane); ss += shx(ss, 2, lane); ss += shx(ss, 4, lane);
            const float rstd = rsqrtf(ss * (1.f / 128.f) + EPS);
            const int row = gla_row0(b, c) + t;
            const bf16_t* gp = PR_ + (size_t)row * INWP + C_GG + h * 128 + jg; const float* go = p.gla_g_out + l * 128 + jg;
            const bf16x8 g0 = *(const bf16x8*)(gp), g1 = *(const bf16x8*)(gp + 8);
            float ov[16];
#pragma unroll
            for (int j = 0; j < 16; ++j) { const float gate = bf2f((bf16_t)(j < 8 ? g0[j] : g1[j - 8])); ov[j] = v[j] * rstd * go[j] * silu_f(gate); }
            u32x4 w0, w1; w0.x = pk2(ov[0], ov[1]); w0.y = pk2(ov[2], ov[3]); w0.z = pk2(ov[4], ov[5]); w0.w = pk2(ov[6], ov[7]); w1.x = pk2(ov[8], ov[9]); w1.y = pk2(ov[10], ov[11]); w1.z = pk2(ov[12], ov[13]); w1.w = pk2(ov[14], ov[15]);
            bf16_t* dst = MIX + (size_t)row * D + h * 128 + jg; *(u32x4*)(dst) = w0; *(u32x4*)(dst + 8) = w1;
        }
        __syncthreads();
    }
}

namespace pg {
constexpr int BK = 64, HALF = 128, HTB = HALF * BK * 2, STAGE_BYTES = 8 * HTB;
DI int lds_byte(int r, int c) { const int st = (r >> 4) * 2 + (c >> 5), rr = r & 15, cc = c & 31, ob = rr * 64 + cc * 2; return st * 1024 + (ob ^ (((ob >> 9) & 1) << 5)); }
DI void stage_rc(int b, int& R, int& C) { const int st = b / 1024, sb = b % 1024, swz = sb ^ (((sb >> 9) & 1) << 5); R = (st >> 1) * 16 + swz / 64; C = (st & 1) * 32 + (swz % 64) / 2; }
struct XUnit {
    const char* A;
    const char* B;
    int arow0;
    int list;
    int e0, e1, e2, e3;
};
template <class Sched>
DI void gemm_phase(LAS unsigned char* lds, const LAS int* rowlists, const Sched& S) {
    int tid = threadIdx.x; asm volatile("" : "+v"(tid));
    const int wid = __builtin_amdgcn_readfirstlane(tid >> 6), lane = tid & 63, wr = wid >> 2, wc = wid & 3, fr = lane & 15, fq = lane >> 4;
    const int K = S.K, nt = K / BK;
    unsigned voffB[2];
#pragma unroll
    for (int i = 0; i < 2; ++i) { int R_, C_; stage_rc(tid * 16 + i * 8192, R_, C_); voffB[i] = (unsigned)R_ * (unsigned)S.ldb + (unsigned)C_ * 2u; }
    const size_t kstep = (size_t)(BK * 2), hstepB = (size_t)HALF * S.ldb;
    const unsigned ldsw = (unsigned)wid * 1024u;
    const int aoff = lds_byte(wr * 64 + fr, fq * 8), boff = lds_byte(wc * 32 + fr, fq * 8);
#define PG_SA(b, h) (((b) * 2 + (h)) * HTB)
#define PG_SB(b, h) ((4 + (b) * 2 + (h)) * HTB)
#define PG_STAGE(bufoff, gbase, voff) do { _Pragma("unroll") for (int _i = 0; _i < 2; ++_i) \
        __builtin_amdgcn_global_load_lds((const unsigned*)((const char*)(gbase) + (voff)[_i]), (LAS unsigned*)(lds + (bufoff) + ldsw + _i * 8192), 16, 0, 0); } while (0)
#define PG_LDA(dst, b, h) do { _Pragma("unroll") for (int m = 0; m < 4; ++m) _Pragma("unroll") for (int k = 0; k < 2; ++k) dst[m][k] = *(const LAS bf16x8*)(lds + PG_SA(b, h) + aoff + m * 2048 + k * 1024); } while (0)
#define PG_LDB(dst, b, h) do { _Pragma("unroll") for (int n = 0; n < 2; ++n) _Pragma("unroll") for (int k = 0; k < 2; ++k) dst[n][k] = *(const LAS bf16x8*)(lds + PG_SB(b, h) + boff + n * 2048 + k * 1024); } while (0)
#define PG_MMA(ai, bj, At, Bt) do { __builtin_amdgcn_s_setprio(1); _Pragma("unroll") for (int m = 0; m < 4; ++m) _Pragma("unroll") for (int n = 0; n < 2; ++n) _Pragma("unroll") for (int k = 0; k < 2; ++k) \
        acc[ai][bj][m][n] = __builtin_amdgcn_mfma_f32_16x16x32_bf16(Bt[n][k], At[m][k], acc[ai][bj][m][n], 0, 0, 0); __builtin_amdgcn_s_setprio(0); } while (0)
#define PG_WAIT_V(n) asm volatile("s_waitcnt vmcnt(" #n ")" ::: "memory")
#define PG_WAIT_L(n) asm volatile("s_waitcnt lgkmcnt(" #n ")" ::: "memory")
#define PG_BAR __builtin_amdgcn_s_barrier()
#define PG_SCHED __builtin_amdgcn_sched_barrier(0)
#define PG_AOFFS(dst, u) do { const int _t = tid_here(); _Pragma("unroll") for (int _i = 0; _i < 2; ++_i) { int _R, _C; stage_rc(_t * 16 + _i * 8192, _R, _C); _Pragma("unroll") for (int _h = 0; _h < 2; ++_h) { \
        unsigned _row; if ((u).list >= 0) { const int _x = rowlists[(u).list + _h * HALF + _R]; _row = _x >= 0 ? (unsigned)(_x >> S.rowshift) : 0u; } else _row = (unsigned)((u).arow0 + _h * HALF + _R); \
        dst[_h][_i] = _row * (unsigned)S.lda + (unsigned)_C * 2u; } } } while (0)
    XUnit cur, nxt; int ui = 0;
    if (!S.next(0, cur)) return;
    f32x4 acc[2][2][4][2];
#pragma unroll
    for (int a = 0; a < 2; ++a)
#pragma unroll
        for (int b = 0; b < 2; ++b)
#pragma unroll
            for (int m = 0; m < 4; ++m)
#pragma unroll
                for (int n = 0; n < 2; ++n) acc[a][b][m][n] = (f32x4){0.f, 0.f, 0.f, 0.f};
    bf16x8 At[4][2], B0[2][2], B1[2][2];
    unsigned ao[2][2];
    PG_AOFFS(ao, cur);
    PG_WAIT_L(0); PG_SCHED;
    const char* cA = cur.A; const char* cB = cur.B;
    PG_STAGE(PG_SB(0, 0), cB, voffB); PG_STAGE(PG_SA(0, 0), cA, ao[0]); PG_STAGE(PG_SB(0, 1), cB + hstepB, voffB); PG_STAGE(PG_SA(0, 1), cA, ao[1]);
    if (wr == 1) PG_BAR;
    PG_WAIT_V(4); PG_BAR;
    PG_STAGE(PG_SB(1, 0), cB + kstep, voffB); PG_STAGE(PG_SA(1, 0), cA + kstep, ao[0]); PG_STAGE(PG_SB(1, 1), cB + hstepB + kstep, voffB);
    PG_WAIT_V(6); PG_BAR;
    for (;;) {
        const bool has_next = S.next(ui + 1, nxt);
        const char* nA = has_next ? nxt.A : cA; const char* nB = has_next ? nxt.B : cB;
        for (int t = 0; t < nt; t += 2) {
            const bool last = (t == nt - 2);
            const char* a1 = cA + (size_t)(t + 1) * kstep;
            const char* a2 = last ? nA : cA + (size_t)(t + 2) * kstep; const char* b2 = last ? nB : cB + (size_t)(t + 2) * kstep;
            const char* a3 = a2 + kstep; const char* b3 = b2 + kstep;
            PG_LDB(B0, 0, 0); PG_SCHED; PG_LDA(At, 0, 0); PG_STAGE(PG_SA(1, 1), a1, ao[1]);
            PG_WAIT_L(8); PG_BAR; PG_WAIT_L(0); PG_MMA(0, 0, At, B0); PG_BAR; PG_SCHED;
            if (last && has_next) { PG_AOFFS(ao, nxt); }
            PG_LDB(B1, 0, 1); PG_STAGE(PG_SB(0, 0), b2, voffB);
            PG_BAR; PG_WAIT_L(0); PG_MMA(0, 1, At, B1); PG_BAR;
            PG_LDA(At, 0, 1); PG_STAGE(PG_SA(0, 0), a2, ao[0]);
            PG_BAR; PG_WAIT_L(0); PG_MMA(1, 0, At, B0); PG_BAR; PG_SCHED;
            PG_STAGE(PG_SB(0, 1), b2 + hstepB, voffB);
            PG_WAIT_V(6); PG_BAR; PG_MMA(1, 1, At, B1); PG_BAR;
            PG_LDB(B0, 1, 0); PG_SCHED; PG_LDA(At, 1, 0); PG_STAGE(PG_SA(0, 1), a2, ao[1]);
            PG_WAIT_L(8); PG_BAR; PG_WAIT_L(0); PG_MMA(0, 0, At, B0); PG_BAR; PG_SCHED;
            PG_LDB(B1, 1, 1); PG_STAGE(PG_SB(1, 0), b3, voffB);
            PG_BAR; PG_WAIT_L(0); PG_MMA(0, 1, At, B1); PG_BAR;
            PG_LDA(At, 1, 1); PG_STAGE(PG_SA(1, 0), a3, ao[0]);
            PG_BAR; PG_WAIT_L(0); PG_MMA(1, 0, At, B0); PG_BAR; PG_SCHED;
            PG_STAGE(PG_SB(1, 1), b3 + hstepB, voffB);
            PG_WAIT_V(6); PG_BAR; PG_MMA(1, 1, At, B1); PG_BAR;
        }
        { const int t2 = tid_here(), w2 = t2 >> 6, l2 = t2 & 63; S.epi(acc, cur, w2 >> 2, w2 & 3, l2 & 15, l2 >> 4); }
        if (!has_next) break;
#pragma unroll
        for (int a = 0; a < 2; ++a)
#pragma unroll
            for (int b = 0; b < 2; ++b)
#pragma unroll
                for (int m = 0; m < 4; ++m)
#pragma unroll
                    for (int n = 0; n < 2; ++n) acc[a][b][m][n] = (f32x4){0.f, 0.f, 0.f, 0.f};
        cur = nxt; cA = nA; cB = nB; ++ui;
    }
    PG_WAIT_V(0);
    if (wr == 0) PG_BAR;
    PG_BAR;
#undef PG_SA
#undef PG_SB
#undef PG_STAGE
#undef PG_LDA
#undef PG_LDB
#undef PG_MMA
#undef PG_WAIT_V
#undef PG_WAIT_L
#undef PG_BAR
#undef PG_SCHED
#undef PG_AOFFS
}
}

DI void phase_router(PR p, int l, char* lds) {
    const int tid = tid_here(), wid = tid >> 6, lane = tid & 63;
    const unsigned char* wl = p.ws + WS_WEIGHTS + (size_t)l * WL_END;
    const bf16_t* WH = (const bf16_t*)(wl + WL_WRH); const bf16_t* WLo = (const bf16_t*)(wl + WL_WRL);
    const bf16_t* HH = (const bf16_t*)(p.ws + WS_HBUF); const bf16_t* HL = (const bf16_t*)(p.ws + WS_U + U_HLO);
    int* EIDX = (int*)(p.ws + WS_EIDX); float* EW = (float*)(p.ws + WS_EW); int* EPOS = (int*)(p.ws + WS_EPOS);
    unsigned* cnt = (unsigned*)(p.ws + WS_CNT) + l * 64;
    const float* rb = p.router_b + l * 64;
    float* SEL = (float*)lds + wid * (2 * 16 * 65);
    float* SCO = SEL + 16 * 65;
    unsigned* LC = (unsigned*)((float*)lds + 8 * (2 * 16 * 65)) + wid * 128; unsigned* LB_ = LC + 64;
    const int ntok = l == 0 ? NTOK : NLAT, ngrp = ntok / 16;
    const int fr = lane & 15, fq = lane >> 4;
    for (int gidx = bid_here() * 8 + wid; gidx < ngrp; gidx += gridDim.x * 8) {
        const int row0 = gidx * 16;
        f32x4 acc[4];
#pragma unroll
        for (int e = 0; e < 4; ++e) acc[e] = (f32x4){0.f, 0.f, 0.f, 0.f};
        const bf16_t* ah = HH + (size_t)(row0 + fr) * D + fq * 8; const bf16_t* al = HL + (size_t)(row0 + fr) * D + fq * 8;
        for (int k0 = 0; k0 < D; k0 += 32) {
            const bf16x8 a_hi = *(const bf16x8*)(ah + k0), a_lo = *(const bf16x8*)(al + k0);
#pragma unroll
            for (int e = 0; e < 4; ++e) {
                const bf16x8 b_hi = *(const bf16x8*)(WH + (size_t)(e * 16 + fr) * D + k0 + fq * 8), b_lo = *(const bf16x8*)(WLo + (size_t)(e * 16 + fr) * D + k0 + fq * 8);
                acc[e] = __builtin_amdgcn_mfma_f32_16x16x32_bf16(a_hi, b_hi, acc[e], 0, 0, 0);
                acc[e] = __builtin_amdgcn_mfma_f32_16x16x32_bf16(a_hi, b_lo, acc[e], 0, 0, 0);
                acc[e] = __builtin_amdgcn_mfma_f32_16x16x32_bf16(a_lo, b_hi, acc[e], 0, 0, 0);
            }
        }
#pragma unroll
        for (int e = 0; e < 4; ++e)
#pragma unroll
            for (int i = 0; i < 4; ++i) { const int ex = e * 16 + fr; const float s = sigmoid_f(acc[e][i]); SCO[(fq * 4 + i) * 65 + ex] = s; SEL[(fq * 4 + i) * 65 + ex] = s + rb[ex]; }
        LC[lane] = 0u;
        asm volatile("s_waitcnt lgkmcnt(0)" ::: "memory");
        __builtin_amdgcn_wave_barrier();
        int erank[8], eik[8];
#pragma unroll
        for (int k = 0; k < 8; ++k) { erank[k] = 0; eik[k] = 0; }
        if (lane < 16) {
            float* sel = SEL + lane * 65; const float* sco = SCO + lane * 65;
            float gs[8];
#pragma unroll
            for (int g = 0; g < 8; ++g) { float m1 = -INFINITY, m2 = -INFINITY;
#pragma unroll
                for (int i = 0; i < 8; ++i) { const float v = sel[g * 8 + i]; if (v > m1) { m2 = m1; m1 = v; } else if (v > m2) m2 = v; }
                gs[g] = m1 + m2; }
            unsigned gmask = 0u;
#pragma unroll
            for (int it = 0; it < 4; ++it) { float best = -INFINITY; int bi = 0;
#pragma unroll
                for (int g = 0; g < 8; ++g) { const bool free_ = ((gmask >> g) & 1u) == 0u; if (free_ && gs[g] > best) { best = gs[g]; bi = g; } }
                gmask |= 1u << bi; }
            int ei[8]; float ew[8]; float wsum = 0.f;
#pragma unroll
            for (int k = 0; k < 8; ++k) { float best = -INFINITY; int bi = 0;
                for (int e = 0; e < 64; ++e) { const float v = sel[e]; if (((gmask >> (e >> 3)) & 1u) && v > best) { best = v; bi = e; } }
                sel[bi] = -INFINITY; ei[k] = bi; ew[k] = sco[bi]; wsum += ew[k]; }
            const float sc = 2.5f / wsum; const int t = row0 + lane;
#pragma unroll
            for (int k = 0; k < 8; ++k) { EIDX[t * 8 + k] = ei[k]; EW[t * 8 + k] = ew[k] * sc; erank[k] = (int)atomicAdd(&LC[ei[k]], 1u); eik[k] = ei[k]; }
        }
        asm volatile("s_waitcnt lgkmcnt(0)" ::: "memory");
        __builtin_amdgcn_wave_barrier();
        { const unsigned cgrp = LC[lane]; const unsigned base = cgrp ? atomicAdd(&cnt[lane], cgrp) : 0u; LB_[lane] = base; }
        asm volatile("s_waitcnt vmcnt(0) lgkmcnt(0)" ::: "memory");
        __builtin_amdgcn_wave_barrier();
        if (lane < 16) { const int t = row0 + lane;
#pragma unroll
            for (int k = 0; k < 8; ++k) EPOS[t * 8 + k] = (int)LB_[eik[k]] + erank[k]; }
        __builtin_amdgcn_wave_barrier();
    }
}
DI void phase_moe_index(PR p, int l, char* lds) {
    const int tid = tid_here();
    int* S = (int*)lds;
    const unsigned* cnt = (const unsigned*)(p.ws + WS_CNT) + l * 64;
    int* META = (int*)(p.ws + WS_META) + l * 1024;
    const int* EIDX = (const int*)(p.ws + WS_EIDX); const float* EW = (const float*)(p.ws + WS_EW); const int* EPOS = (const int*)(p.ws + WS_EPOS);
    int* SASG = (int*)(p.ws + WS_SASG); float* SW = (float*)(p.ws + WS_SW);
    if (tid < 64) S[128 + tid] = (int)cnt[tid];
    __syncthreads();
    if (tid == 0) { int s = 0; for (int e = 0; e < 64; ++e) { S[e] = s; s += (S[128 + e] + 255) / 256 * 256; } S[64] = s; }
    __syncthreads();
    const int ntok = l == 0 ? NTOK : NLAT;
    for (int a = bid_here() * NTHREADS + tid; a < ntok * 8; a += gridDim.x * NTHREADS) { const int e = EIDX[a], pos = S[e] + EPOS[a]; SASG[pos] = a; SW[pos] = EW[a]; }
    for (int i = bid_here() * NTHREADS + tid; i < 64 * 256; i += gridDim.x * NTHREADS) { const int e = i >> 8, q = i & 255, c = S[128 + e]; if (S[e] + c + q < S[e + 1]) { SASG[S[e] + c + q] = -1; SW[S[e] + c + q] = 0.f; } }
    if (blockIdx.x == 0) {
        if (tid == 0) META[0] = S[64] / 256;
        if (tid < 64) { for (int t = S[tid] / 256; t < S[tid + 1] / 256; ++t) META[256 + t] = tid; }
    }
}

struct OrderXcd {
    int nM, nN, nwg;
    DI void init(int nM_, int nN_) { nM = nM_; nN = nN_; nwg = nM_ * nN_; }
    DI bool map(int i, int& pm, int& pn) const {
        const int L = i * (int)gridDim.x + (int)blockIdx.x; if (L >= nwg) return false;
        int wgid = L; { const int q = nwg / 8, r = nwg % 8, xcd = wgid % 8, off = wgid / 8; wgid = (xcd < r ? xcd * (q + 1) : r * (q + 1) + (xcd - r) * q) + off; }
        const int nig = 8 * nN, gid = wgid / nig, fm = gid * 8, gsz = (nM - fm) < 8 ? (nM - fm) : 8;
        pm = fm + ((wgid % nig) % gsz); pn = (wgid % nig) / gsz; return true;
    }
    DI bool lin(int i, int& w) const {
        const int L = i * (int)gridDim.x + (int)blockIdx.x; if (L >= nwg) return false;
        const int q = nwg / 8, r = nwg % 8, xcd = L % 8, off = L / 8; w = (xcd < r ? xcd * (q + 1) : r * (q + 1) + (xcd - r) * q) + off; return true;
    }
};
#define GACC const f32x4 (&acc)[2][2][4][2]
struct SchedInproj {
    int lda, ldb, K, rowshift; const char* A; const char* W; bf16_t* proj; OrderXcd o;
    DI bool next(int i, pg::XUnit& u) const { int pm, pn; if (!o.map(i, pm, pn)) return false; u.A = A; u.B = W + (size_t)pn * 256 * ldb; u.arow0 = pm * 256; u.list = -1; u.e0 = pm * 256; u.e1 = pn * 256; return true; }
    DI void epi(GACC, const pg::XUnit& u, int wr, int wc, int fr, int fq) const { EpiProj E; E.O = proj; E.row0 = u.e0; E.col0 = u.e1; E(acc, wr, wc, fr, fq); }
};
DI void phase_inproj(PR p, int l, char* lds) {
    SchedInproj S; S.lda = D * 2; S.ldb = D * 2; S.K = D; S.rowshift = 0; S.A = (const char*)(p.ws + WS_HBUF); S.W = (const char*)(p.ws + WS_WEIGHTS + (size_t)l * WL_END + WL_WIN);
    S.proj = (bf16_t*)(p.ws + WS_U + U_PROJ); S.o.init(68, 15);
    pg::gemm_phase((LAS unsigned char*)lds, (const LAS int*)(lds + pg::STAGE_BYTES), S);
}
struct SchedMlaUp {
    int lda, ldb, K, rowshift; const char* CQ; const char* CKV; const char* WQ; const char* WKV; bf16_t* Qm; bf16_t* Km; bf16_t* Vm; const float2* ropem; OrderXcd o;
    DI bool next(int i, pg::XUnit& u) const { int w; if (!o.lin(i, w)) return false; u.list = -1;
        if (w < 340) { const int pm = w / 5, pn = w % 5; u.A = CQ; u.B = WQ + (size_t)pn * 256 * ldb; u.arow0 = pm * 256; u.e0 = pm * 256; u.e1 = pn * 256; u.e3 = 0; }
        else { const int v = w - 340, pm = v / 6, pn = v % 6; u.A = CKV; u.B = WKV + (size_t)pn * 256 * ldb; u.arow0 = pm * 256; u.e0 = pm * 256; u.e1 = pn * 256; u.e3 = 1; }
        return true; }
    DI void epi(GACC, const pg::XUnit& u, int wr, int wc, int fr, int fq) const {
        if (u.e3 == 0) { EpiUq E; E.Q = Qm; E.ropem = ropem; E.row0 = u.e0; E.col0 = u.e1; E(acc, wr, wc, fr, fq); }
        else { EpiUkv E; E.Km = Km; E.Vm = Vm; E.row0 = u.e0; E.col0 = u.e1; E(acc, wr, wc, fr, fq); } }
};
DI void phase_mla_up(PR p, int l, char* lds) {
    unsigned char* U = p.ws + WS_U; const unsigned char* wl = p.ws + WS_WEIGHTS + (size_t)l * WL_END;
    SchedMlaUp S; S.lda = 1024; S.ldb = 1024; S.K = 512; S.rowshift = 0; S.CQ = (const char*)(U + U_CQN); S.CKV = (const char*)(U + U_CKVN); S.WQ = (const char*)(wl + WL_WUQ); S.WKV = (const char*)(wl + WL_WUKV);
    S.Qm = (bf16_t*)(U + U_QM); S.Km = (bf16_t*)(U + U_KM); S.Vm = (bf16_t*)(U + U_VM); S.ropem = (const float2*)(p.ws + WS_ROPEM); S.o.init(748, 1);
    pg::gemm_phase((LAS unsigned char*)lds, (const LAS int*)(lds + pg::STAGE_BYTES), S);
}
struct SchedOutproj {
    int lda, ldb, K, rowshift; const char* A; const char* W; bf16_t* Y; OrderXcd o;
    DI bool next(int i, pg::XUnit& u) const { int pm, pn; if (!o.map(i, pm, pn)) return false; u.A = A; u.B = W + (size_t)pn * 256 * ldb; u.arow0 = pm * 256; u.list = -1; u.e0 = pm * 256; u.e1 = pn * 256; return true; }
    DI void epi(GACC, const pg::XUnit& u, int wr, int wc, int fr, int fq) const { EpiB16 E; E.O = Y; E.row0 = u.e0; E.col0 = u.e1; E.ld = D; E(acc, wr, wc, fr, fq); }
};
DI void phase_outproj(PR p, int l, char* lds) {
    SchedOutproj S; S.lda = D * 2; S.ldb = D * 2; S.K = D; S.rowshift = 0; S.A = (const char*)(p.ws + WS_U + U_MIX); S.W = (const char*)(p.ws + WS_WEIGHTS + (size_t)l * WL_END + WL_WOUT);
    S.Y = (bf16_t*)(p.ws + WS_U + U_Y); S.o.init(l == 0 ? 68 : 64, 8);
    pg::gemm_phase((LAS unsigned char*)lds, (const LAS int*)(lds + pg::STAGE_BYTES), S);
}
struct SchedMoe1 {
    int lda, ldb, K, rowshift; const char* H; const char* W13; bf16_t* act; const LAS int* uexp; int ntiles; OrderXcd o;
    DI bool next(int i, pg::XUnit& u) const { int tile, pn; if (!o.map(i, tile, pn)) return false; u.A = H;
        if (tile < ntiles) { const int e = __builtin_amdgcn_readfirstlane(uexp[i]); u.B = W13 + ((size_t)e * 1024 + pn * 256) * ldb; u.list = i * 256; u.arow0 = 0; u.e0 = tile * 256; }
        else { const int ts = tile - ntiles; u.B = W13 + ((size_t)64 * 1024 + pn * 256) * ldb; u.list = -1; u.arow0 = ts * 256; u.e0 = PMAX + ts * 256; }
        u.e1 = pn * 128; return true; }
    DI void epi(GACC, const pg::XUnit& u, int wr, int wc, int fr, int fq) const { EpiMoe1 E; E.act = act; E.arow0 = u.e0; E.hcol0 = u.e1; E(acc, wr, wc, fr, fq); }
};
DI void phase_moe1(PR p, int l, char* lds) {
    const int* META = (const int*)(p.ws + WS_META) + l * 1024; const int ntiles = __builtin_amdgcn_readfirstlane(META[0]), nsh = l == 0 ? 68 : 64;
    SchedMoe1 S; S.lda = D * 2; S.ldb = D * 2; S.K = D; S.rowshift = 3; S.H = (const char*)(p.ws + WS_HBUF); S.W13 = (const char*)(p.ws + WS_WEIGHTS + (size_t)l * WL_END + WL_W13);
    S.act = (bf16_t*)(p.ws + WS_U + U_ACT); S.uexp = (const LAS int*)(lds + pg::STAGE_BYTES) + 31 * 256; S.ntiles = ntiles; S.o.init(ntiles + nsh, 4);
    { const int tid = tid_here(); LAS int* RL = (LAS int*)(lds + pg::STAGE_BYTES); const int* SASG = (const int*)(p.ws + WS_SASG);
      for (int i = 0; i < 31; ++i) { int tile, pn; if (!S.o.map(i, tile, pn)) break; if (tile < ntiles && tid < 256) RL[i * 256 + tid] = SASG[tile * 256 + tid];
          if (tid == 0) RL[31 * 256 + i] = tile < ntiles ? META[256 + tile] : 64; }
      __syncthreads(); }
    pg::gemm_phase((LAS unsigned char*)lds, (const LAS int*)(lds + pg::STAGE_BYTES), S);
}
struct SchedMoe2 {
    int lda, ldb, K, rowshift; const char* ACT; const char* W2; bf16_t* oasg; const int* sasg; const float* sw; bf16_t* ysh; const LAS int* uexp; int ntiles; OrderXcd o;
    DI bool next(int i, pg::XUnit& u) const { int tile, pn; if (!o.map(i, tile, pn)) return false; u.A = ACT; u.list = -1;
        if (tile < ntiles) { const int e = __builtin_amdgcn_readfirstlane(uexp[i]); u.B = W2 + ((size_t)e * D + pn * 256) * ldb; u.arow0 = tile * 256; u.e0 = tile * 256; u.e3 = 0; }
        else { const int ts = tile - ntiles; u.B = W2 + ((size_t)64 * D + pn * 256) * ldb; u.arow0 = PMAX + ts * 256; u.e0 = ts * 256; u.e3 = 1; }
        u.e1 = pn * 256; return true; }
    DI void epi(GACC, const pg::XUnit& u, int wr, int wc, int fr, int fq) const {
        if (u.e3 == 0) { EpiMoe2 E; E.oasg = oasg; E.sasg = sasg; E.sw = sw; E.srow0 = u.e0; E.col0 = u.e1; E(acc, wr, wc, fr, fq); }
        else { EpiB16 E; E.O = ysh; E.row0 = u.e0; E.col0 = u.e1; E.ld = D; E(acc, wr, wc, fr, fq); } }
};
DI void phase_moe2(PR p, int l, char* lds) {
    const int* META = (const int*)(p.ws + WS_META) + l * 1024; const int ntiles = __builtin_amdgcn_readfirstlane(META[0]), nsh = l == 0 ? 68 : 64;
    SchedMoe2 S; S.lda = 1024; S.ldb = 1024; S.K = 512; S.rowshift = 0; S.ACT = (const char*)(p.ws + WS_U + U_ACT); S.W2 = (const char*)(p.ws + WS_WEIGHTS + (size_t)l * WL_END + WL_W2);
    S.oasg = (bf16_t*)(p.ws + WS_U + U_OASG); S.sasg = (const int*)(p.ws + WS_SASG); S.sw = (const float*)(p.ws + WS_SW); S.ysh = (bf16_t*)(p.ws + WS_U + U_YSH); S.uexp = (const LAS int*)(lds + pg::STAGE_BYTES); S.ntiles = ntiles; S.o.init(ntiles + nsh, 8);
    { const int tid = tid_here(); LAS int* UE = (LAS int*)(lds + pg::STAGE_BYTES);
      if (tid < 64) { int tile, pn; if (S.o.map(tid, tile, pn)) UE[tid] = tile < ntiles ? META[256 + tile] : 64; }
      __syncthreads(); }
    pg::gemm_phase((LAS unsigned char*)lds, (const LAS int*)(lds + pg::STAGE_BYTES), S);
}
DI void phase_attention(PR p, int l, char* lds) {
#define ATT_PTRS unsigned char* U = p.ws + WS_U; asm volatile("" : "+s"(U)); \
    const bf16_t* Qm = (const bf16_t*)(U + U_QM); const bf16_t* Km = (const bf16_t*)(U + U_KM); const bf16_t* Vm = (const bf16_t*)(U + U_VM); \
    const bf16_t* Qg = (const bf16_t*)(U + U_QG); const bf16_t* Kg = (const bf16_t*)(U + U_KG); const bf16_t* Vg = (const bf16_t*)(U + U_VG); bf16_t* MIX = (bf16_t*)(U + U_MIX);
    const int xcd = blockIdx.x & 7, rank = blockIdx.x >> 3, nr = (gridDim.x + 7 - xcd) >> 3;
    const int nloc = 48 + (l == 0 ? 3 : 0);
    if (SUB & 1) for (int v = rank; v < nloc; v += nr) {
        ATT_PTRS; (void)Qg; (void)Kg; (void)Vg;
        int b, h, qt, isctx;
        if (v < 48) { const int bh = xcd * 3 + v / 16; b = bh / 6; h = bh % 6; qt = v & 15; isctx = 0; } else { const int bh = xcd * 3 + (v - 48); b = bh / 6; h = bh % 6; qt = 0; isctx = 1; }
        const int qpos = isctx ? 0 : CTXL + qt * 256, seq = isctx ? CTXL : SKV, orow = isctx ? NLAT + b * CTXL : b * SEQ + qt * 256;
        attn_body<192, ATT_SD_M>(Qm + (((size_t)b * 6 + h) * SKV + qpos) * 192, Km + ((size_t)b * 6 + h) * SKV * 192, Vm + ((size_t)b * 6 + h) * SKV * 128,
                                 MIX + (size_t)orow * D + 512 + h * 128, D, seq, lds, 0.07216878364870322f);
    }
    if (SUB & 2) for (int v = nr - 1 - rank; v < nloc; v += nr) {
        ATT_PTRS; (void)Qm; (void)Km; (void)Vm;
        int b, h, qt, isctx; const int kvh = xcd & 1; b = xcd >> 1;
        if (v < 48) { h = kvh * 3 + v / 16; qt = v & 15; isctx = 0; } else { h = kvh * 3 + (v - 48); qt = 0; isctx = 1; }
        const int qpos = isctx ? 0 : CTXL + qt * 256, seq = isctx ? CTXL : SKV, orow = isctx ? NLAT + b * CTXL : b * SEQ + qt * 256;
        attn_body<128, ATT_SD_G>(Qg + (((size_t)b * 6 + h) * SKV + qpos) * 128, Kg + ((size_t)b * 2 + kvh) * SKV * 128, Vg + ((size_t)b * 2 + kvh) * SKV * 128,
                                 MIX + (size_t)orow * D + 1280 + h * 128, D, seq, lds, 0.08838834764831845f);
    }
#undef ATT_PTRS
    if (SUB & 4) gla_phaseC(p, l, lds);
}

constexpr int NPH_LAYER = 12, NPH = 1 + 2 * NPH_LAYER;
constexpr int LDS_BYTES = 160 * 1024;
__global__ void __launch_bounds__(NTHREADS, 2) fwd(Params p_arg, int ph_lo, int ph_hi) {
    extern __shared__ __attribute__((aligned(16))) char shm[];
    char* lds = shm + 256;
    volatile LAS unsigned* xbw = (volatile LAS unsigned*)shm;
    const bool fused = (ph_hi - ph_lo) > 1;
    XcdBarrier bar; bar.bar = (unsigned*)(p_arg.ws + WS_BAR); bar.x = 0; bar.st = xbw;
    if (fused) {
        if (threadIdx.x == 0) { xbw[0] = 0u; xbw[1] = 0u; xbw[2] = 0u; xbw[3] = 0u; }
        __syncthreads();
        bar = xcd_barrier_post((unsigned*)(p_arg.ws + WS_BAR), xbw);
    }
    const CAS Params* pk = (const CAS Params*)__builtin_amdgcn_kernarg_segment_ptr();
#define PHASE(idx, CALL) do { if (((PH_MASK >> ((idx) == 0 ? 0 : ((idx) - 1) % NPH_LAYER + 1)) & 1) && (idx) >= ph_lo && (idx) < ph_hi) { const CAS Params* q_ = pk; asm volatile("" : "+s"(q_)); PR p = *q_; int probe_pass = 0; (void)probe_pass; CALL; if ((PROBE_MASK >> ((idx) == 0 ? 0 : ((idx) - 1) % NPH_LAYER + 1)) & 1) { probe_pass = 1; CALL; } if (fused && (idx) + 1 < ph_hi) xcd_barrier(bar); } } while (0)
    PHASE(0, phase_prologue(p, lds));
    for (int l = 0; l < 2; ++l) {
        const int b0 = 1 + l * NPH_LAYER;
        if (l == 0) PHASE(b0 + 0, phase_norm1(p, 0));
        PHASE(b0 + 1, phase_inproj(p, l, lds));
        PHASE(b0 + 2, (phase_postproj_rows(p, l), gla_phaseA(p, l, lds)));
        PHASE(b0 + 3, (phase_mla_up(p, l, lds), gla_scan(p)));
        PHASE(b0 + 4, phase_attention(p, l, lds));
        PHASE(b0 + 5, phase_outproj(p, l, lds));
        PHASE(b0 + 6, ((probe_pass && l == 1) ? (void)0 : phase_postmix(p, l)));
        PHASE(b0 + 7, (probe_pass ? (void)0 : phase_router(p, l, lds)));
        PHASE(b0 + 8, phase_moe_index(p, l, lds));
        PHASE(b0 + 9, phase_moe1(p, l, lds));
        PHASE(b0 + 10, phase_moe2(p, l, lds));
        PHASE(b0 + 11, ((probe_pass && l == 0) ? (void)0 : phase_postffn(p, l)));
    }
#undef PHASE
}

extern "C" void kernel_launch(void* const* d_in, const int* in_sizes, int n_in, void* d_out, int out_size, void* d_ws, size_t ws_size, hipStream_t stream) {
    static int grid = 0;
    if (!grid) {
        if (ws_size < WS_TOTAL) { fprintf(stderr, "kernel_launch: workspace too small: %zu < %zu\n", ws_size, (size_t)WS_TOTAL); return; }
        if (hipFuncSetAttribute((const void*)fwd, hipFuncAttributeMaxDynamicSharedMemorySize, LDS_BYTES) != hipSuccess) { fprintf(stderr, "kernel_launch: hipFuncSetAttribute failed\n"); return; }
        int dev = 0, cus = 0, per_cu = 0;
        hipGetDevice(&dev);
        hipDeviceGetAttribute(&cus, hipDeviceAttributeMultiprocessorCount, dev);
        hipOccupancyMaxActiveBlocksPerMultiprocessor(&per_cu, fwd, NTHREADS, LDS_BYTES);
        if (per_cu < 1) { fprintf(stderr, "kernel_launch: occupancy query says %d\n", per_cu); return; }
        grid = cus;
    }
    Params p{};
    const float** f = (const float**)&p;
    for (int i = 0; i < 31; ++i) f[i] = (const float*)d_in[i];
    p.out = (float*)d_out; p.ws = (unsigned char*)d_ws;
    hipMemsetAsync((unsigned char*)d_ws + WS_BAR, 0, XCD_BAR_WORDS * sizeof(unsigned), stream);
#if MK_MULTI
    for (int ph = 0; ph < NPH; ++ph) { if (ph == 1 + NPH_LAYER) continue; hipLaunchKernelGGL(fwd, dim3(grid), dim3(NTHREADS), LDS_BYTES, stream, p, ph, ph + 1); }
#else
    hipLaunchKernelGGL(fwd, dim3(grid), dim3(NTHREADS), LDS_BYTES, stream, p, 0, NPH);
#endif
    const hipError_t le = hipPeekAtLastError();
    if (le != hipSuccess) fprintf(stderr, "kernel_launch: launch failed: %s\n", hipGetErrorName(le));
}
```

```cpp
#include <hip/hip_runtime.h>
#include <stdint.h>
#include <stdio.h>

#ifndef PH_MASK
#define PH_MASK 0x1FFF
#endif
#ifndef SUB
#define SUB 7
#endif
#ifndef ATT_SD_M
#define ATT_SD_M 1
#endif
#ifndef ATT_SD_G
#define ATT_SD_G 2
#endif
#ifndef ATT_NQR_M
#define ATT_NQR_M 12
#endif
#ifndef PROBE_MASK
#define PROBE_MASK 0x0
#endif
#ifndef MK_MULTI
#define MK_MULTI 0
#endif

typedef unsigned short bf16_t;
typedef short bf16x8 __attribute__((ext_vector_type(8)));
typedef short s16x4 __attribute__((ext_vector_type(4)));
typedef float f32x4 __attribute__((ext_vector_type(4)));
typedef float f32x16 __attribute__((ext_vector_type(16)));
typedef unsigned u32x4 __attribute__((ext_vector_type(4)));
typedef unsigned u32x2 __attribute__((ext_vector_type(2)));
#define DI __device__ __forceinline__

constexpr int D = 2048, NB = 4, SEQ = 4096, CTXL = 256, NLAT = NB * SEQ, NCTX = NB * CTXL, NTOK = NLAT + NCTX, SKV = SEQ + CTXL;
constexpr int INW = 3808, INWP = 3840;
constexpr int C_GQ = 0, C_GK = 256, C_GV = 512, C_GG = 1024, C_ZF = 1536, C_ZB = 1552, C_CQ = 1568, C_CKV = 1952, C_KR = 2464, C_AQ = 2528, C_AK = 3296, C_AV = 3552;
constexpr int NE = 64, TOPK = 8, DEXP = 512;
constexpr int PMAX = NTOK * TOPK + NE * 256;
constexpr int NTHREADS = 512;
constexpr float EPS = 1e-6f;

constexpr size_t MiB = 1024ull * 1024ull;
constexpr size_t al256(size_t x) { return (x + 255) / 256 * 256; }
constexpr size_t WS_BAR = 0;
constexpr size_t WS_CNT = 16384;
constexpr size_t WS_META = WS_CNT + 1024;
constexpr size_t WS_MOD = WS_META + 2 * 4096;
constexpr size_t WS_ROPEG = al256(WS_MOD + 2 * 5 * 12288 * 4);
constexpr size_t WS_ROPEM = WS_ROPEG + 64 * 32 * 8;
constexpr size_t WS_ZROW = WS_ROPEM + 64 * 16 * 8;
constexpr size_t WS_GDEC = WS_ZROW + 4096;
constexpr size_t WS_EIDX = al256(WS_GDEC + 2 * 16 * 68 * 64 * 4);
constexpr size_t WS_EW = WS_EIDX + (size_t)NTOK * 8 * 4;
constexpr size_t WS_EPOS = WS_EW + (size_t)NTOK * 8 * 4;
constexpr size_t WS_SASG = WS_EPOS + (size_t)NTOK * 8 * 4;
constexpr size_t WS_SW = al256(WS_SASG + (size_t)PMAX * 4);
constexpr size_t WS_SMALL_END = al256(WS_SW + (size_t)PMAX * 4);
static_assert(WS_SMALL_END <= 8 * MiB, "small region");
constexpr size_t SZ_WIN = (size_t)INWP * D * 2, SZ_WUQ = (size_t)1280 * 512 * 2, SZ_WUKV = (size_t)1536 * 512 * 2, SZ_WOUT = (size_t)D * D * 2, SZ_WR = (size_t)64 * D * 2;
constexpr size_t SZ_W13 = (size_t)65 * 1024 * D * 2, SZ_W2 = (size_t)65 * D * 512 * 2;
constexpr size_t WL_WIN = 0, WL_WUQ = WL_WIN + SZ_WIN, WL_WUKV = WL_WUQ + SZ_WUQ, WL_WOUT = WL_WUKV + SZ_WUKV, WL_WRH = WL_WOUT + SZ_WOUT, WL_WRL = WL_WRH + SZ_WR,
                 WL_W13 = WL_WRL + SZ_WR, WL_W2 = WL_W13 + SZ_W13, WL_END = WL_W2 + SZ_W2;
constexpr size_t WS_WEIGHTS = 8 * MiB;
constexpr size_t WS_XRES = WS_WEIGHTS + 2 * WL_END;
constexpr size_t WS_HBUF = WS_XRES + (size_t)NTOK * D * 4;
constexpr size_t WS_U = WS_HBUF + (size_t)NTOK * D * 2;
constexpr size_t U_Y = 0;
constexpr size_t U_YSH = (size_t)NTOK * D * 2;
constexpr size_t U_PROJ = U_Y + (size_t)NTOK * D * 4;
constexpr size_t U_QM = U_PROJ + (size_t)NTOK * INWP * 2;
constexpr size_t U_KM = U_QM + (size_t)NB * 6 * SKV * 192 * 2;
constexpr size_t U_VM = U_KM + (size_t)NB * 6 * SKV * 192 * 2;
constexpr size_t U_QG = U_VM + (size_t)NB * 6 * SKV * 128 * 2;
constexpr size_t U_KG = U_QG + (size_t)NB * 6 * SKV * 128 * 2;
constexpr size_t U_VG = U_KG + (size_t)NB * 2 * SKV * 128 * 2;
constexpr size_t U_GS = U_VG + (size_t)NB * 2 * SKV * 128 * 2;
constexpr size_t U_MIX = U_GS + (size_t)2 * 16 * 68 * 64 * 128 * 4;
constexpr size_t U_CQN = U_MIX + (size_t)NTOK * D * 2;
constexpr size_t U_CKVN = U_CQN + (size_t)NTOK * 512 * 2;
constexpr size_t U_GST = U_CKVN + (size_t)NTOK * 512 * 2;
constexpr size_t U_MIX_END = U_GST + (size_t)2 * 16 * 68 * 8192 * 2;
constexpr size_t U_HLO = U_PROJ;
constexpr size_t U_ACT = U_HLO + (size_t)NTOK * D * 2;
constexpr size_t U_OASG = U_ACT + (size_t)(PMAX + NTOK) * 512 * 2;
constexpr size_t U_MOE_END = U_OASG + (size_t)NTOK * 8 * D * 2;
constexpr size_t WS_TOTAL = WS_U + (U_MIX_END > U_MOE_END ? U_MIX_END : U_MOE_END);
static_assert(WS_TOTAL <= 2048ull * MiB, "workspace over 2 GiB");

struct Params {
    const float *x, *c, *ctx, *c_ctx, *w_mod, *b_mod, *g_pre_mix, *g_post_mix, *g_pre_ffn, *g_post_ffn, *w_in, *gla_wg2_f, *gla_bg_f, *gla_wg2_b, *gla_bg_b, *gla_g_out,
        *mla_g_q, *mla_w_uq, *mla_g_kv, *mla_w_ukv, *gqa_g_q, *gqa_g_k, *w_out, *router_w, *router_b, *exp_w1, *exp_w3, *exp_w2, *sh_w1, *sh_w3, *sh_w2;
    float* out; unsigned char* ws;
};

#define CAS __attribute__((address_space(4)))
typedef const CAS Params& PR;
DI int bid_here() { int b = blockIdx.x; asm volatile("" : "+s"(b)); return b; }
DI int tid_here() { int t = threadIdx.x; asm volatile("" : "+v"(t)); return t; }
DI float bf2f(bf16_t v) { return __uint_as_float(((unsigned)v) << 16); }
DI bf16_t f2bf(float f) { unsigned u = __float_as_uint(f); u += 0x7FFFu + ((u >> 16) & 1u); return (bf16_t)(u >> 16); }
DI unsigned pk2(float lo, float hi) { unsigned r; asm("v_cvt_pk_bf16_f32 %0, %1, %2" : "=v"(r) : "v"(lo), "v"(hi)); return r; }
DI float shx(float v, int o, int lane) { return __int_as_float(__builtin_amdgcn_ds_bpermute((lane ^ o) << 2, __float_as_int(v))); }
DI float wave_sum(float v) {
    const int lane = tid_here() & 63;
#pragma unroll
    for (int o = 32; o > 0; o >>= 1) v += shx(v, o, lane);
    return v;
}
DI float silu_f(float v) { return v / (1.f + __expf(-v)); }
DI float sigmoid_f(float v) { return 1.f / (1.f + __expf(-v)); }
struct Tok { int b, s, isctx, mrow, kvpos; };
DI Tok tok_of(int r) { Tok t; if (r < NLAT) { t.b = r >> 12; t.s = r & 4095; t.isctx = 0; t.mrow = t.b; t.kvpos = CTXL + t.s; } else { const int q = r - NLAT; t.b = q >> 8; t.s = q & 255; t.isctx = 1; t.mrow = 4; t.kvpos = t.s; } return t; }
DI const float* xrow_in(PR p, int l, int r) { if (l == 0) return r < NLAT ? p.x + (size_t)r * D : p.ctx + (size_t)(r - NLAT) * D; return (const float*)(p.ws + WS_XRES) + (size_t)r * D; }

#define XB_TMO      128
#define XB_XCNT(j)  (256  + 64 * (j))
#define XB_XSUB(j)  (1280 + 64 * (j))
#define XB_XGEN(j)  (2304 + 64 * (j))
#define XB_TOP      3328
#define XB_TOPGEN   3392
#define XCD_BAR_WORDS 3456
#define XB_SPIN_CAP (1u << 18)
#define LAS __attribute__((address_space(3)))
__device__ __forceinline__ unsigned xb_ld(unsigned* p)              { return __hip_atomic_load(p, __ATOMIC_RELAXED, __HIP_MEMORY_SCOPE_AGENT); }
__device__ __forceinline__ unsigned xb_add(unsigned* p, unsigned v) { return __hip_atomic_fetch_add(p, v, __ATOMIC_RELAXED, __HIP_MEMORY_SCOPE_AGENT); }
__device__ __forceinline__ unsigned xb_xcc_id() { return (unsigned)__builtin_amdgcn_s_getreg((3 << 11) | 20) & 0xFu; }
#define XB_SPIN(cond, bar) do { unsigned _sp = 0; while (cond) { __builtin_amdgcn_s_sleep(1); \
    if ((++_sp & 255u) == 0u) { if (xb_ld(&(bar)[XB_TMO])) break; if (_sp > XB_SPIN_CAP) { atomicAdd(&(bar)[XB_TMO], 1u); break; } } } } while (0)
struct XcdBarrier { unsigned* bar; unsigned x; volatile LAS unsigned* st; };
__device__ __forceinline__ XcdBarrier xcd_barrier_post(unsigned* bar, volatile LAS unsigned* st) {
    XcdBarrier b; b.bar = bar; b.x = xb_xcc_id(); b.st = st;
    if (threadIdx.x == 0) (void)xb_add(&bar[XB_XCNT(b.x)], 1u);
    return b;
}
__device__ __forceinline__ void xcd_barrier_complete(unsigned* bar, unsigned x, unsigned& nloc, unsigned& nx) {
    const unsigned G = gridDim.x * gridDim.y * gridDim.z;
    unsigned sum, cnt, mine, sp = 0u;
    for (;;) {
        sum = 0u; cnt = 0u; mine = 0u;
#pragma unroll
        for (unsigned j = 0; j < 16; ++j) { const unsigned c = xb_ld(&bar[XB_XCNT(j)]); sum += c; cnt += (c > 0u) ? 1u : 0u; mine = (j == x) ? c : mine; }
        if (sum == G) break;
        __builtin_amdgcn_s_sleep(1);
        if ((++sp & 255u) == 0u) { if (xb_ld(&bar[XB_TMO])) break; if (sp > XB_SPIN_CAP) { atomicAdd(&bar[XB_TMO], 1u); break; } }
    }
    nloc = mine > 0u ? mine : 1u; nx = cnt > 0u ? cnt : 1u;
}
__device__ __forceinline__ void xcd_barrier(const XcdBarrier& b) {
    asm volatile("s_waitcnt vmcnt(0)" ::: "memory");
    __syncthreads();
    if (threadIdx.x == 0) {
        unsigned* bar = b.bar;
        __builtin_amdgcn_s_waitcnt(0);
        unsigned nloc = b.st[0], nx = b.st[1];
        if (nloc == 0u) { xcd_barrier_complete(bar, b.x, nloc, nx); b.st[0] = nloc; b.st[1] = nx; }
        const unsigned old = xb_add(&bar[XB_XSUB(b.x)], 1u);
        const unsigned gen = old / nloc;
        if (old + 1u == (gen + 1u) * nloc) {
            __builtin_amdgcn_fence(__ATOMIC_RELEASE, "agent");
            asm volatile("s_waitcnt vmcnt(0)" ::: "memory");
            const unsigned og = xb_add(&bar[XB_TOP], 1u);
            const unsigned tg = og / nx;
            if (og + 1u == (tg + 1u) * nx) xb_add(&bar[XB_TOPGEN], 1u);
            else XB_SPIN(xb_ld(&bar[XB_TOPGEN]) == tg, bar);
            __builtin_amdgcn_fence(__ATOMIC_ACQUIRE, "agent");
            xb_add(&bar[XB_XGEN(b.x)], 1u);
            asm volatile("s_waitcnt vmcnt(0)" ::: "memory");
        } else {
            XB_SPIN(xb_ld(&bar[XB_XGEN(b.x)]) == gen, bar);
            __builtin_amdgcn_fence(__ATOMIC_ACQUIRE, "agent");
            asm volatile("s_waitcnt vmcnt(0)" ::: "memory");
        }
    }
    __syncthreads();
}

template <int KT>
DI void cvt_tile(char* lds, const float* src, int ldS, int Nvalid, bf16_t* dst, bf16_t* dst_lo, int ldD, int k0, int n0, int drow0, const float* gk) {
    float* T = (float*)lds;
    const int tid = tid_here();
    {
        const int c4 = tid & 15, kr = tid >> 4, n = n0 + c4 * 4;
        f32x4 v[KT / 32];
#pragma unroll
        for (int i = 0; i < KT / 32; ++i) { v[i] = (f32x4){0.f, 0.f, 0.f, 0.f}; if (n < Nvalid) v[i] = *(const f32x4*)(src + (size_t)(k0 + kr + 32 * i) * ldS + n); }
#pragma unroll
        for (int i = 0; i < KT / 32; ++i) { const int k = kr + 32 * i; if (gk) v[i] = v[i] * gk[k0 + k];
            T[k * 65 + c4 * 4 + 0] = v[i][0]; T[k * 65 + c4 * 4 + 1] = v[i][1]; T[k * 65 + c4 * 4 + 2] = v[i][2]; T[k * 65 + c4 * 4 + 3] = v[i][3]; }
    }
    __syncthreads();
    {
        constexpr int KPL = KT / 8;
        const int nl = tid >> 3, kc = (tid & 7) * KPL;
#pragma unroll
        for (int q = 0; q < KPL / 8; ++q) {
            float v[8];
#pragma unroll
            for (int j = 0; j < 8; ++j) v[j] = T[(kc + q * 8 + j) * 65 + nl];
            u32x4 w; w.x = pk2(v[0], v[1]); w.y = pk2(v[2], v[3]); w.z = pk2(v[4], v[5]); w.w = pk2(v[6], v[7]);
            *(u32x4*)(dst + (size_t)(drow0 + nl) * ldD + k0 + kc + q * 8) = w;
            if (dst_lo) {
                float r[8];
#pragma unroll
                for (int j = 0; j < 8; ++j) r[j] = v[j] - bf2f(f2bf(v[j]));
                u32x4 w2; w2.x = pk2(r[0], r[1]); w2.y = pk2(r[2], r[3]); w2.z = pk2(r[4], r[5]); w2.w = pk2(r[6], r[7]);
                *(u32x4*)(dst_lo + (size_t)(drow0 + nl) * ldD + k0 + kc + q * 8) = w2;
            }
        }
    }
    __syncthreads();
}
template <int KT>
DI void cvt_matrix(char* lds, const float* src, int K, int N, int Npad, bf16_t* dst, bf16_t* dst_lo, int mode, const float* gk, int ldD = 0) {
    if (ldD == 0) ldD = K;
    const int nkt = K / KT, nnt = Npad / 64, nt = nkt * nnt;
    for (int t = bid_here(); t < nt; t += gridDim.x) {
        const int kt = t % nkt, ntile = t / nkt, n0 = ntile * 64;
        int drow0 = n0;
        if (mode == 1) drow0 = (n0 >> 7) * 256 + (n0 & 127);
        else if (mode == 2) drow0 = (n0 >> 7) * 256 + 128 + (n0 & 127);
        cvt_tile<KT>(lds, src, N, N, dst, dst_lo, ldD, kt * KT, n0, drow0, gk);
    }
}
DI void phase_prologue(PR p, char* lds) {
    const int tid = tid_here();
    unsigned char* ws = p.ws;
    if (blockIdx.x == 0) {
        unsigned* cnt = (unsigned*)(ws + WS_CNT);
        if (tid < 128) cnt[tid] = 0u;
        unsigned* z = (unsigned*)(ws + WS_ZROW);
        for (int i = tid; i < 1024; i += NTHREADS) z[i] = 0u;
        float2* rg = (float2*)(ws + WS_ROPEG);
        for (int i = tid; i < 64 * 32; i += NTHREADS) { const int pos = i >> 5, f = i & 31; const float inv = powf(10000.f, -(float)(2 * f) / 64.f); float s, c; sincosf((float)pos * inv, &s, &c); rg[i] = make_float2(c, s); }
        float2* rm = (float2*)(ws + WS_ROPEM);
        for (int i = tid; i < 64 * 16; i += NTHREADS) { const int pos = i >> 4, f = i & 15; const float inv = powf(10000.f, -(float)(2 * f) / 32.f); float s, c; sincosf((float)pos * inv, &s, &c); rm[i] = make_float2(c, s); }
    }
    {
        float* sc = (float*)lds;
        float* red = sc + 5 * 2048;
        bool loaded = false;
        for (int u = bid_here(); u < 192; u += gridDim.x) {
            if (!loaded) { for (int i = tid; i < 5 * 2048; i += NTHREADS) { const int r = i >> 11, k = i & 2047; const float v = r < 4 ? p.c[r * 2048 + k] : p.c_ctx[k]; sc[i] = silu_f(v); } loaded = true; __syncthreads(); }
            const int l = u / 96, col0 = (u % 96) * 128;
            const int cg = tid & 31, kp = tid >> 5;
            f32x4 acc[5];
#pragma unroll
            for (int r = 0; r < 5; ++r) acc[r] = (f32x4){0.f, 0.f, 0.f, 0.f};
            const float* wb = p.w_mod + ((size_t)l * 2048) * 12288 + col0 + cg * 4;
            for (int kk = 0; kk < 128; ++kk) {
                const int k = kp * 128 + kk;
                const f32x4 w = *(const f32x4*)(wb + (size_t)k * 12288);
#pragma unroll
                for (int r = 0; r < 5; ++r) acc[r] += w * sc[r * 2048 + k];
            }
#pragma unroll
            for (int r = 0; r < 5; ++r)
#pragma unroll
                for (int j = 0; j < 4; ++j) red[(kp * 5 + r) * 128 + cg * 4 + j] = acc[r][j];
            __syncthreads();
            for (int i = tid; i < 640; i += NTHREADS) {
                const int r = i >> 7, cc = i & 127; float s = p.b_mod[l * 12288 + col0 + cc];
#pragma unroll
                for (int q = 0; q < 16; ++q) s += red[(q * 5 + r) * 128 + cc];
                ((float*)(ws + WS_MOD))[((size_t)l * 5 + r) * 12288 + col0 + cc] = s;
            }
            __syncthreads();
        }
        __syncthreads();
    }
    for (int l = 0; l < 2; ++l) {
        unsigned char* wl = ws + WS_WEIGHTS + (size_t)l * WL_END;
        cvt_matrix<256>(lds, p.w_in + (size_t)l * D * INW, D, INW, INWP, (bf16_t*)(wl + WL_WIN), nullptr, 0, nullptr);
        cvt_matrix<128>(lds, p.mla_w_uq + (size_t)l * 384 * 1152, 384, 1152, 1280, (bf16_t*)(wl + WL_WUQ), nullptr, 0, p.mla_g_q + l * 384, 512);
        for (int i = bid_here() * NTHREADS + tid; i < 1280 * 64; i += gridDim.x * NTHREADS) ((unsigned*)(wl + WL_WUQ))[(size_t)(i >> 6) * 256 + 192 + (i & 63)] = 0u;
        cvt_matrix<256>(lds, p.mla_w_ukv + (size_t)l * 512 * 1536, 512, 1536, 1536, (bf16_t*)(wl + WL_WUKV), nullptr, 0, p.mla_g_kv + l * 512);
        cvt_matrix<256>(lds, p.w_out + (size_t)l * D * D, D, D, D, (bf16_t*)(wl + WL_WOUT), nullptr, 0, nullptr);
        cvt_matrix<256>(lds, p.router_w + (size_t)l * D * 64, D, 64, 64, (bf16_t*)(wl + WL_WRH), (bf16_t*)(wl + WL_WRL), 0, nullptr);
        for (int g = bid_here(); g < 65 * 192; g += gridDim.x) {
            const int e = g / 192, r = g % 192, m = r >> 6, t = r & 63;
            bf16_t* d13 = (bf16_t*)(wl + WL_W13) + (size_t)e * 1024 * D; bf16_t* d2 = (bf16_t*)(wl + WL_W2) + (size_t)e * D * 512;
            if (m < 2) {
                const float* src = m == 0 ? (e < 64 ? p.exp_w1 + ((size_t)l * 64 + e) * D * 512 : p.sh_w1 + (size_t)l * D * 512) : (e < 64 ? p.exp_w3 + ((size_t)l * 64 + e) * D * 512 : p.sh_w3 + (size_t)l * D * 512);
                const int kt = t & 7, n0 = (t >> 3) * 64, drow0 = (n0 >> 7) * 256 + m * 128 + (n0 & 127);
                cvt_tile<256>(lds, src, 512, 512, d13, nullptr, D, kt * 256, n0, drow0, nullptr);
            } else {
                const float* src = e < 64 ? p.exp_w2 + ((size_t)l * 64 + e) * 512 * D : p.sh_w2 + (size_t)l * 512 * D;
                const int kt = t & 1, n0 = (t >> 1) * 64;
                cvt_tile<256>(lds, src, D, D, d2, nullptr, 512, kt * 256, n0, n0, nullptr);
            }
        }
    }
}

DI void load_row_bf(const bf16_t* src, f32x4 (&v)[8], int lane) {
#pragma unroll
    for (int i = 0; i < 8; ++i) { const u32x2 w = *(const u32x2*)(src + i * 256 + lane * 4);
        v[i][0] = __uint_as_float(w.x << 16); v[i][1] = __uint_as_float(w.x & 0xFFFF0000u); v[i][2] = __uint_as_float(w.y << 16); v[i][3] = __uint_as_float(w.y & 0xFFFF0000u); }
}
DI void load_row(const float* src, f32x4 (&v)[8], int lane) {
#pragma unroll
    for (int i = 0; i < 8; ++i) v[i] = *(const f32x4*)(src + i * 256 + lane * 4);
}
DI float row_sumsq(const f32x4 (&v)[8]) {
    float s = 0.f;
#pragma unroll
    for (int i = 0; i < 8; ++i) s += v[i][0] * v[i][0] + v[i][1] * v[i][1] + v[i][2] * v[i][2] + v[i][3] * v[i][3];
    return wave_sum(s);
}
DI void adaln_store(const f32x4 (&x)[8], const float* g, const float* shift, const float* scale, bf16_t* hi, bf16_t* lo, int lane) {
    const float rstd = rsqrtf(row_sumsq(x) * (1.f / D) + EPS);
#pragma unroll
    for (int i = 0; i < 8; ++i) {
        const int c = i * 256 + lane * 4;
        const f32x4 gg = *(const f32x4*)(g + c), sh = *(const f32x4*)(shift + c), sc = *(const f32x4*)(scale + c);
        f32x4 h;
#pragma unroll
        for (int j = 0; j < 4; ++j) h[j] = x[i][j] * rstd * gg[j] * (1.f + sc[j]) + sh[j];
        u32x2 w; w.x = pk2(h[0], h[1]); w.y = pk2(h[2], h[3]);
        *(u32x2*)(hi + c) = w;
        if (lo) { u32x2 w2; w2.x = pk2(h[0] - bf2f(f2bf(h[0])), h[1] - bf2f(f2bf(h[1]))); w2.y = pk2(h[2] - bf2f(f2bf(h[2])), h[3] - bf2f(f2bf(h[3]))); *(u32x2*)(lo + c) = w2; }
    }
}
DI void phase_norm1(PR p, int l) {
    const int tid_ = tid_here(), lane = tid_ & 63, wid = tid_ >> 6;
    const float* mod = (const float*)(p.ws + WS_MOD) + (size_t)l * 5 * 12288;
    bf16_t* hb = (bf16_t*)(p.ws + WS_HBUF);
    for (int r = bid_here() * 8 + wid; r < NTOK; r += gridDim.x * 8) {
        const Tok t = tok_of(r);
        f32x4 x[8]; load_row(xrow_in(p, l, r), x, lane);
        adaln_store(x, p.g_pre_mix + l * D, mod + (size_t)t.mrow * 12288 + 0 * D, mod + (size_t)t.mrow * 12288 + 1 * D, hb + (size_t)r * D, nullptr, lane);
    }
}
DI void phase_postmix(PR p, int l) {
    const int tid_ = tid_here(), lane = tid_ & 63, wid = tid_ >> 6;
    const float* mod = (const float*)(p.ws + WS_MOD) + (size_t)l * 5 * 12288;
    const bf16_t* Y = (const bf16_t*)(p.ws + WS_U + U_Y);
    float* XR = (float*)(p.ws + WS_XRES);
    bf16_t* hb = (bf16_t*)(p.ws + WS_HBUF); bf16_t* hl = (bf16_t*)(p.ws + WS_U + U_HLO);
    const int nrows = l == 0 ? NTOK : NLAT;
    for (int r = bid_here() * 8 + wid; r < nrows; r += gridDim.x * 8) {
        const Tok t = tok_of(r);
        f32x4 x[8], y[8]; load_row(xrow_in(p, l, r), x, lane); load_row_bf(Y + (size_t)r * D, y, lane);
        const float rstd = rsqrtf(row_sumsq(y) * (1.f / D) + EPS);
        const float* gate = mod + (size_t)t.mrow * 12288 + 2 * D; const float* g = p.g_post_mix + l * D;
#pragma unroll
        for (int i = 0; i < 8; ++i) {
            const int c = i * 256 + lane * 4; const f32x4 gg = *(const f32x4*)(g + c), gt = *(const f32x4*)(gate + c);
#pragma unroll
            for (int j = 0; j < 4; ++j) x[i][j] += gt[j] * (y[i][j] * rstd * gg[j]);
            *(f32x4*)(XR + (size_t)r * D + c) = x[i];
        }
        adaln_store(x, p.g_pre_ffn + l * D, mod + (size_t)t.mrow * 12288 + 3 * D, mod + (size_t)t.mrow * 12288 + 4 * D, hb + (size_t)r * D, hl + (size_t)r * D, lane);
    }
}
DI void phase_postffn(PR p, int l) {
    const int tid_ = tid_here(), lane = tid_ & 63, wid = tid_ >> 6;
    const float* mod = (const float*)(p.ws + WS_MOD) + (size_t)l * 5 * 12288;
    const bf16_t* YS = (const bf16_t*)(p.ws + WS_U + U_YSH);
    const bf16_t* OA = (const bf16_t*)(p.ws + WS_U + U_OASG);
    float* XR = (float*)(p.ws + WS_XRES);
    bf16_t* hb = (bf16_t*)(p.ws + WS_HBUF);
    const int nrows = l == 0 ? NTOK : NLAT;
    for (int r = bid_here() * 8 + wid; r < nrows; r += gridDim.x * 8) {
        const Tok t = tok_of(r);
        f32x4 x[8], y[8]; load_row((const float*)(p.ws + WS_XRES) + (size_t)r * D, x, lane); load_row_bf(YS + (size_t)r * D, y, lane);
        for (int k = 0; k < 8; ++k) {
            const bf16_t* o = OA + ((size_t)r * 8 + k) * D;
#pragma unroll
            for (int i = 0; i < 8; ++i) { const u32x2 w = *(const u32x2*)(o + i * 256 + lane * 4);
                y[i][0] += __uint_as_float(w.x << 16); y[i][1] += __uint_as_float(w.x & 0xFFFF0000u); y[i][2] += __uint_as_float(w.y << 16); y[i][3] += __uint_as_float(w.y & 0xFFFF0000u); }
        }
        const float rstd = rsqrtf(row_sumsq(y) * (1.f / D) + EPS);
        const float* gate = mod + (size_t)t.mrow * 12288 + 5 * D; const float* g = p.g_post_ffn + l * D;
        float* dstrow = l == 0 ? XR + (size_t)r * D : p.out + (size_t)r * D;
#pragma unroll
        for (int i = 0; i < 8; ++i) {
            const int c = i * 256 + lane * 4; const f32x4 gg = *(const f32x4*)(g + c), gt = *(const f32x4*)(gate + c);
#pragma unroll
            for (int j = 0; j < 4; ++j) x[i][j] += gt[j] * (y[i][j] * rstd * gg[j]);
            *(f32x4*)(dstrow + c) = x[i];
        }
        if (l == 0) {
            const float* mod1 = (const float*)(p.ws + WS_MOD) + (size_t)1 * 5 * 12288;
            adaln_store(x, p.g_pre_mix + 1 * D, mod1 + (size_t)t.mrow * 12288 + 0 * D, mod1 + (size_t)t.mrow * 12288 + 1 * D, hb + (size_t)r * D, nullptr, lane);
        }
    }
}

struct GemmUnit {
    const bf16_t* A; long lda; const int* rows; int rowshift;
    const bf16_t* Bt; long ldb;
    int K;
};
constexpr int GS_LD = 72;
struct LaneId { int wr, wc, fr, fq; };
DI LaneId gemm_kloop_simple(char* lds, const GemmUnit& g, f32x4 (&acc)[2][2][4][2]) {
    int tid = threadIdx.x; asm volatile("" : "+v"(tid));
    const int wid = tid >> 6, lane = tid & 63, wr = wid >> 2, wc = wid & 3, fr = lane & 15, fq = lane >> 4;
    bf16_t* As = (bf16_t*)lds; bf16_t* Bs = As + 256 * GS_LD;
#pragma unroll
    for (int a = 0; a < 2; ++a)
#pragma unroll
        for (int b = 0; b < 2; ++b)
#pragma unroll
            for (int m = 0; m < 4; ++m)
#pragma unroll
                for (int n = 0; n < 2; ++n) acc[a][b][m][n] = (f32x4){0.f, 0.f, 0.f, 0.f};
    const int srow = tid >> 3, skc = (tid & 7) * 8;
    const bf16_t* ap[4]; const bf16_t* bp[4];
#pragma unroll
    for (int i = 0; i < 4; ++i) {
        const int r = srow + 64 * i;
        if (g.rows) { const int idx = g.rows[r]; ap[i] = g.A + (size_t)(idx >= 0 ? (idx >> g.rowshift) : 0) * g.lda + skc; }
        else ap[i] = g.A + (size_t)r * g.lda + skc;
        bp[i] = g.Bt + (size_t)r * g.ldb + skc;
    }
    const int nkt = g.K / 64;
    u32x4 ra[4], rb[4];
#pragma unroll
    for (int i = 0; i < 4; ++i) { ra[i] = *(const u32x4*)(ap[i]); rb[i] = *(const u32x4*)(bp[i]); }
    for (int kt = 0; kt < nkt; ++kt) {
        __syncthreads();
#pragma unroll
        for (int i = 0; i < 4; ++i) { *(u32x4*)(As + (srow + 64 * i) * GS_LD + skc) = ra[i]; *(u32x4*)(Bs + (srow + 64 * i) * GS_LD + skc) = rb[i]; }
        __syncthreads();
        if (kt + 1 < nkt) {
#pragma unroll
            for (int i = 0; i < 4; ++i) { ra[i] = *(const u32x4*)(ap[i] + (kt + 1) * 64); rb[i] = *(const u32x4*)(bp[i] + (kt + 1) * 64); }
        }
#pragma unroll
        for (int kk = 0; kk < 2; ++kk) {
            bf16x8 bf[2][2];
#pragma unroll
            for (int bj = 0; bj < 2; ++bj)
#pragma unroll
                for (int n = 0; n < 2; ++n) bf[bj][n] = *(const bf16x8*)(Bs + (128 * bj + 32 * wc + 16 * n + fr) * GS_LD + kk * 32 + fq * 8);
#pragma unroll
            for (int ai = 0; ai < 2; ++ai)
#pragma unroll
                for (int m = 0; m < 4; ++m) {
                    const bf16x8 af = *(const bf16x8*)(As + (128 * ai + 64 * wr + 16 * m + fr) * GS_LD + kk * 32 + fq * 8);
#pragma unroll
                    for (int bj = 0; bj < 2; ++bj)
#pragma unroll
                        for (int n = 0; n < 2; ++n) acc[ai][bj][m][n] = __builtin_amdgcn_mfma_f32_16x16x32_bf16(bf[bj][n], af, acc[ai][bj][m][n], 0, 0, 0);
                }
        }
    }
    __syncthreads();
    LaneId id; id.wr = wr; id.wc = wc; id.fr = fr; id.fq = fq; return id;
}
#define GEMM_ACC f32x4 acc[2][2][4][2]
#define ACC_FOREACH(...) \
    _Pragma("unroll") for (int ai = 0; ai < 2; ++ai) _Pragma("unroll") for (int m = 0; m < 4; ++m) { const int trow = 128 * ai + 64 * wr + 16 * m + fr; \
    _Pragma("unroll") for (int bj = 0; bj < 2; ++bj) _Pragma("unroll") for (int n = 0; n < 2; ++n) { const int tcol = 128 * bj + 32 * wc + 16 * n + 4 * fq; const f32x4 v = acc[ai][bj][m][n]; __VA_ARGS__ } }

struct EpiProj {
    bf16_t* O; int row0, col0;
    DI void operator()(const f32x4 (&acc)[2][2][4][2], int wr, int wc, int fr, int fq) const {
        ACC_FOREACH({ u32x2 w; w.x = pk2(v[0], v[1]); w.y = pk2(v[2], v[3]); *(u32x2*)(O + (size_t)(row0 + trow) * INWP + col0 + tcol) = w; })
    }
};
struct EpiB16 {
    bf16_t* O; int row0, col0, ld;
    DI void operator()(const f32x4 (&acc)[2][2][4][2], int wr, int wc, int fr, int fq) const {
        ACC_FOREACH({ u32x2 w; w.x = pk2(v[0], v[1]); w.y = pk2(v[2], v[3]); *(u32x2*)(O + (size_t)(row0 + trow) * ld + col0 + tcol) = w; })
    }
};
struct EpiF32 {
    float* O; int row0, col0, ld;
    DI void operator()(const f32x4 (&acc)[2][2][4][2], int wr, int wc, int fr, int fq) const {
        ACC_FOREACH({ *(f32x4*)(O + (size_t)(row0 + trow) * ld + col0 + tcol) = v; })
    }
};
struct EpiUq {
    bf16_t* Q; const float2* ropem; int row0, col0;
    DI void operator()(const f32x4 (&acc)[2][2][4][2], int wr, int wc, int fr, int fq) const {
#pragma unroll
        for (int ai = 0; ai < 2; ++ai)
#pragma unroll
            for (int m = 0; m < 4; ++m) {
                const int r = row0 + 128 * ai + 64 * wr + 16 * m + fr; const Tok t = tok_of(r);
#pragma unroll
                for (int bj = 0; bj < 2; ++bj) {
                    const int cbase = col0 + 128 * bj + 32 * wc;
                    if (cbase >= 1152) continue;
                    const int h = cbase / 192, jb = cbase % 192;
                    f32x4 v0 = acc[ai][bj][m][0], v1 = acc[ai][bj][m][1];
                    if (jb >= 128 && !t.isctx) {
                        const int pos = (jb == 128) ? (t.s >> 6) : (t.s & 63);
#pragma unroll
                        for (int i = 0; i < 4; ++i) { const float2 cs = ropem[pos * 16 + 4 * fq + i]; const float x1 = v0[i], x2 = v1[i]; v0[i] = x1 * cs.x - x2 * cs.y; v1[i] = x2 * cs.x + x1 * cs.y; }
                    }
                    bf16_t* dst = Q + (((size_t)t.b * 6 + h) * SKV + t.kvpos) * 192 + jb + 4 * fq;
                    u32x2 w0; w0.x = pk2(v0[0], v0[1]); w0.y = pk2(v0[2], v0[3]); *(u32x2*)(dst) = w0;
                    u32x2 w1; w1.x = pk2(v1[0], v1[1]); w1.y = pk2(v1[2], v1[3]); *(u32x2*)(dst + 16) = w1;
                }
            }
    }
};
struct EpiUkv {
    bf16_t* Km; bf16_t* Vm; int row0, col0;
    DI void operator()(const f32x4 (&acc)[2][2][4][2], int wr, int wc, int fr, int fq) const {
        ACC_FOREACH({ const int r = row0 + trow; const Tok t = tok_of(r); const int c = col0 + tcol, h = c >> 8, j = c & 255;
            u32x2 w; w.x = pk2(v[0], v[1]); w.y = pk2(v[2], v[3]);
            if (j < 128) *(u32x2*)(Km + (((size_t)t.b * 6 + h) * SKV + t.kvpos) * 192 + j) = w;
            else *(u32x2*)(Vm + (((size_t)t.b * 6 + h) * SKV + t.kvpos) * 128 + (j - 128)) = w; })
    }
};
struct EpiMoe1 {
    bf16_t* act; int arow0, hcol0;
    DI void operator()(const f32x4 (&acc)[2][2][4][2], int wr, int wc, int fr, int fq) const {
#pragma unroll
        for (int ai = 0; ai < 2; ++ai)
#pragma unroll
            for (int m = 0; m < 4; ++m) {
                const int trow = 128 * ai + 64 * wr + 16 * m + fr;
#pragma unroll
                for (int n = 0; n < 2; ++n) {
                    const f32x4 a = acc[ai][0][m][n], b = acc[ai][1][m][n]; f32x4 h;
#pragma unroll
                    for (int i = 0; i < 4; ++i) h[i] = silu_f(a[i]) * b[i];
                    u32x2 w; w.x = pk2(h[0], h[1]); w.y = pk2(h[2], h[3]);
                    *(u32x2*)(act + (size_t)(arow0 + trow) * 512 + hcol0 + 32 * wc + 16 * n + 4 * fq) = w;
                }
            }
    }
};
struct EpiMoe2 {
    bf16_t* oasg; const int* sasg; const float* sw; int srow0, col0;
    DI void operator()(const f32x4 (&acc)[2][2][4][2], int wr, int wc, int fr, int fq) const {
        int a[2][4]; float wgt[2][4];
#pragma unroll
        for (int ai = 0; ai < 2; ++ai)
#pragma unroll
            for (int m = 0; m < 4; ++m) { const int trow = 128 * ai + 64 * wr + 16 * m + fr; a[ai][m] = sasg[srow0 + trow]; wgt[ai][m] = sw[srow0 + trow]; }
#pragma unroll
        for (int ai = 0; ai < 2; ++ai)
#pragma unroll
            for (int m = 0; m < 4; ++m) {
                if (a[ai][m] < 0) continue;
#pragma unroll
                for (int bj = 0; bj < 2; ++bj)
#pragma unroll
                    for (int n = 0; n < 2; ++n) { const f32x4 v = acc[ai][bj][m][n] * wgt[ai][m]; u32x2 w; w.x = pk2(v[0], v[1]); w.y = pk2(v[2], v[3]);
                        *(u32x2*)(oasg + (size_t)a[ai][m] * D + col0 + 128 * bj + 32 * wc + 16 * n + 4 * fq) = w; }
            }
    }
};
DI u32x4 pack8(const f32x4& a, const f32x4& b) { u32x4 w; w.x = pk2(a[0], a[1]); w.y = pk2(a[2], a[3]); w.z = pk2(b[0], b[1]); w.w = pk2(b[2], b[3]); return w; }
struct EpiB16P {
    bf16_t* O; int row0, col0, ld;
    DI void operator()(const f32x4 (&acc)[2][2][4][2], int wr, int wc, int fr, int fq) const {
#pragma unroll
        for (int ai = 0; ai < 2; ++ai)
#pragma unroll
            for (int m = 0; m < 4; ++m) { bf16_t* rowp = O + (size_t)(row0 + 128 * ai + 64 * wr + 16 * m + fr) * ld + col0 + 32 * wc + 8 * fq;
#pragma unroll
                for (int bj = 0; bj < 2; ++bj) *(u32x4*)(rowp + 128 * bj) = pack8(acc[ai][bj][m][0], acc[ai][bj][m][1]); }
    }
};
struct EpiMoe1P {
    bf16_t* act; int arow0, hcol0;
    DI void operator()(const f32x4 (&acc)[2][2][4][2], int wr, int wc, int fr, int fq) const {
#pragma unroll
        for (int ai = 0; ai < 2; ++ai)
#pragma unroll
            for (int m = 0; m < 4; ++m) {
                f32x4 h0, h1;
#pragma unroll
                for (int i = 0; i < 4; ++i) { h0[i] = silu_f(acc[ai][0][m][0][i]) * acc[ai][1][m][0][i]; h1[i] = silu_f(acc[ai][0][m][1][i]) * acc[ai][1][m][1][i]; }
                *(u32x4*)(act + (size_t)(arow0 + 128 * ai + 64 * wr + 16 * m + fr) * 512 + hcol0 + 32 * wc + 8 * fq) = pack8(h0, h1);
            }
    }
};
struct EpiMoe2P {
    bf16_t* oasg; const int* sasg; const float* sw; int srow0, col0;
    DI void operator()(const f32x4 (&acc)[2][2][4][2], int wr, int wc, int fr, int fq) const {
        int a[2][4]; float wgt[2][4];
#pragma unroll
        for (int ai = 0; ai < 2; ++ai)
#pragma unroll
            for (int m = 0; m < 4; ++m) { const int trow = 128 * ai + 64 * wr + 16 * m + fr; a[ai][m] = sasg[srow0 + trow]; wgt[ai][m] = sw[srow0 + trow]; }
#pragma unroll
        for (int ai = 0; ai < 2; ++ai)
#pragma unroll
            for (int m = 0; m < 4; ++m) {
                if (a[ai][m] < 0) continue;
                bf16_t* rowp = oasg + (size_t)a[ai][m] * D + col0 + 32 * wc + 8 * fq;
#pragma unroll
                for (int bj = 0; bj < 2; ++bj) *(u32x4*)(rowp + 128 * bj) = pack8(acc[ai][bj][m][0] * wgt[ai][m], acc[ai][bj][m][1] * wgt[ai][m]);
            }
    }
};
DI void phase_postproj_rows(PR p, int l) {
    const int tid_ = tid_here(), lane = tid_ & 63, wid = tid_ >> 6;
    unsigned char* U = p.ws + WS_U;
    const bf16_t* PR = (const bf16_t*)(U + U_PROJ);
    bf16_t* CQN = (bf16_t*)(U + U_CQN); bf16_t* CKVN = (bf16_t*)(U + U_CKVN);
    bf16_t* Km = (bf16_t*)(U + U_KM); bf16_t* Qg = (bf16_t*)(U + U_QG); bf16_t* Kg = (bf16_t*)(U + U_KG); bf16_t* Vg = (bf16_t*)(U + U_VG);
    const float2* ropeg = (const float2*)(p.ws + WS_ROPEG); const float2* ropem = (const float2*)(p.ws + WS_ROPEM);
    const float* gq = p.gqa_g_q + l * 128; const float* gk = p.gqa_g_k + l * 128;
    for (int r = bid_here() * 8 + wid; r < NTOK; r += gridDim.x * 8) {
        const Tok t = tok_of(r);
        const bf16_t* pr = PR + (size_t)r * INWP;
        {
            float v[6], ss = 0.f;
#pragma unroll
            for (int i = 0; i < 6; ++i) { v[i] = bf2f(pr[C_CQ + lane + 64 * i]); ss += v[i] * v[i]; }
            const float rstd = rsqrtf(wave_sum(ss) * (1.f / 384.f) + EPS);
#pragma unroll
            for (int i = 0; i < 6; ++i) CQN[(size_t)r * 512 + lane + 64 * i] = f2bf(v[i] * rstd);
            CQN[(size_t)r * 512 + 384 + lane] = 0; CQN[(size_t)r * 512 + 448 + lane] = 0;
        }
        {
            float v[8], ss = 0.f;
#pragma unroll
            for (int i = 0; i < 8; ++i) { v[i] = bf2f(pr[C_CKV + lane + 64 * i]); ss += v[i] * v[i]; }
            const float rstd = rsqrtf(wave_sum(ss) * (1.f / 512.f) + EPS);
#pragma unroll
            for (int i = 0; i < 8; ++i) CKVN[(size_t)r * 512 + lane + 64 * i] = f2bf(v[i] * rstd);
        }
        {
            float x = bf2f(pr[C_KR + lane]);
            const float other = shx(x, 16, lane);
            if (!t.isctx) {
                const int g = lane >> 5, idx = lane & 31, fi = idx & 15; const bool second = idx >= 16;
                const int pos = g == 0 ? (t.s >> 6) : (t.s & 63);
                const float2 cs = ropem[pos * 16 + fi];
                x = second ? x * cs.x + other * cs.y : x * cs.x - other * cs.y;
            }
            const bf16_t xb = f2bf(x);
#pragma unroll
            for (int h = 0; h < 6; ++h) Km[(((size_t)t.b * 6 + h) * SKV + t.kvpos) * 192 + 128 + lane] = xb;
        }
        const int fi = lane & 31; const bool second = lane >= 32;
        float2 cs0 = make_float2(1.f, 0.f), cs1 = make_float2(1.f, 0.f);
        if (!t.isctx) { cs0 = ropeg[(t.s >> 6) * 32 + fi]; cs1 = ropeg[(t.s & 63) * 32 + fi]; }
#pragma unroll
        for (int hh = 0; hh < 8; ++hh) {
            const bool isq = hh < 6; const int h = isq ? hh : hh - 6; const float* g = isq ? gq : gk;
            const int cb = (isq ? C_AQ : C_AK) + h * 128;
            float e0 = bf2f(pr[cb + lane]), e1 = bf2f(pr[cb + 64 + lane]);
            const float rstd = rsqrtf(wave_sum(e0 * e0 + e1 * e1) * (1.f / 128.f) + EPS);
            e0 = e0 * rstd * g[lane]; e1 = e1 * rstd * g[64 + lane];
            const float o0 = shx(e0, 32, lane), o1 = shx(e1, 32, lane);
            const float r0 = second ? e0 * cs0.x + o0 * cs0.y : e0 * cs0.x - o0 * cs0.y;
            const float r1 = second ? e1 * cs1.x + o1 * cs1.y : e1 * cs1.x - o1 * cs1.y;
            bf16_t* dst = isq ? Qg + (((size_t)t.b * 6 + h) * SKV + t.kvpos) * 128 : Kg + (((size_t)t.b * 2 + h) * SKV + t.kvpos) * 128;
            dst[lane] = f2bf(r0); dst[64 + lane] = f2bf(r1);
        }
#pragma unroll
        for (int h = 0; h < 2; ++h) { bf16_t* dst = Vg + (((size_t)t.b * 2 + h) * SKV + t.kvpos) * 128; dst[lane] = pr[C_AV + h * 128 + lane]; dst[64 + lane] = pr[C_AV + h * 128 + 64 + lane]; }
    }
}

#define SBAR() __builtin_amdgcn_sched_barrier(0)
DI int crow(int r, int hi) { return (r & 3) + 8 * (r >> 2) + 4 * hi; }
DI unsigned cvtpk(float lo, float hi) { unsigned r; asm volatile("v_cvt_pk_bf16_f32 %0, %1, %2" : "=v"(r) : "v"(lo), "v"(hi)); return r; }
constexpr float ATT_THR = 8.f;
template <int DQK> struct AttnCfg {
    static constexpr int KROWB = DQK * 2;
    static constexpr int SHM_V = 64 * 128 * 2, SHM_K = 64 * DQK * 2;
    static constexpr int ND0 = DQK / 16;
    static constexpr int NKCH = DQK / 64;
    static constexpr int NQR = DQK == 128 ? 8 : ATT_NQR_M;
    static constexpr int SHM_Q = 8 * (ND0 - NQR) * 1024;
    static constexpr int SHM_TOTAL = 2 * SHM_V + 2 * SHM_K + 8 * 64 * 4 + SHM_Q;
};
template <int DQK> DI int kswz(int row, int colB) { return row * (DQK * 2) + (colB ^ ((row & 7) << 4)); }
DI void partialSM(f32x16& p0, f32x16& p1, float& m_reg, float& mn, float& alpha, const float SCALE) {
    const float C = SCALE * 1.4426950408889634f;
    float pmax = p0[0];
#pragma unroll
    for (int r = 1; r < 16; ++r) pmax = fmaxf(pmax, p0[r]);
#pragma unroll
    for (int r = 0; r < 16; ++r) pmax = fmaxf(pmax, p1[r]);
    { auto rr = __builtin_amdgcn_permlane32_swap(__float_as_uint(pmax), __float_as_uint(pmax), false, false);
      pmax = fmaxf(__uint_as_float(rr[0]), __uint_as_float(rr[1])); }
    if (__builtin_expect(__all(pmax - m_reg <= ATT_THR / SCALE), 1)) { mn = m_reg; alpha = 1.f; }
    else { mn = fmaxf(m_reg, pmax); alpha = __builtin_amdgcn_exp2f((m_reg - mn) * C); m_reg = mn; }
    const float mnC = -mn * C;
#pragma unroll
    for (int r = 0; r < 16; ++r) p0[r] = fmaf(p0[r], C, mnC);
#pragma unroll
    for (int r = 0; r < 16; ++r) p1[r] = fmaf(p1[r], C, mnC);
#pragma unroll
    for (int r = 0; r < 16; ++r) p0[r] = __builtin_amdgcn_exp2f(p0[r]);
}
DI void finishSM(f32x16& p0, f32x16& p1, float alpha, float& l_reg, bf16x8& pa0, bf16x8& pa1, bf16x8& pa2, bf16x8& pa3) {
#pragma unroll
    for (int r = 0; r < 16; ++r) p1[r] = __builtin_amdgcn_exp2f(p1[r]);
    float ps = 0;
#pragma unroll
    for (int r = 0; r < 16; ++r) ps += p0[r];
#pragma unroll
    for (int r = 0; r < 16; ++r) ps += p1[r];
    { auto rr = __builtin_amdgcn_permlane32_swap(__float_as_uint(ps), __float_as_uint(ps), false, false);
      ps = __uint_as_float(rr[0]) + __uint_as_float(rr[1]); }
    l_reg = l_reg * alpha + ps;
#define PK4(P, BASE, OUT) do { unsigned a0 = cvtpk(P[BASE + 0], P[BASE + 1]), a1 = cvtpk(P[BASE + 2], P[BASE + 3]);   \
    unsigned b0 = cvtpk(P[BASE + 4], P[BASE + 5]), b1 = cvtpk(P[BASE + 6], P[BASE + 7]);                              \
    auto r0 = __builtin_amdgcn_permlane32_swap(a0, b0, false, false); auto r1 = __builtin_amdgcn_permlane32_swap(a1, b1, false, false); \
    u32x4 w = {r0[0], r1[0], r0[1], r1[1]}; OUT = *reinterpret_cast<bf16x8*>(&w); } while (0)
    PK4(p0, 0, pa0); PK4(p0, 8, pa1); PK4(p1, 0, pa2); PK4(p1, 8, pa3);
#undef PK4
}
template <int DQK, int NQR>
DI void qkt(f32x16& p0, f32x16& p1, const int (&kb)[4], int bufoff, const bf16x8* qr, int qs_addr, int r32, int hi) {
    asm volatile("" : "+v"(qs_addr));
    const LAS char* Qs = (const LAS char*)qs_addr;
#pragma unroll
    for (int r = 0; r < 16; ++r) { p0[r] = 0.f; p1[r] = 0.f; }
#pragma unroll
    for (int d0 = 0; d0 < DQK / 16; ++d0) {
        const LAS char* ka = (const LAS char*)(kb[d0 & 3]) + bufoff + 128 * (d0 >> 2);
        const bf16x8 b0 = *(const LAS bf16x8*)(ka);
        const bf16x8 b1 = *(const LAS bf16x8*)(ka + 32 * DQK * 2);
        bf16x8 q;
        if (d0 < NQR) q = qr[d0]; else q = *(const LAS bf16x8*)(Qs + (d0 - NQR) * 1024);
        p0 = __builtin_amdgcn_mfma_f32_32x32x16_bf16(b0, q, p0, 0, 0, 0);
        p1 = __builtin_amdgcn_mfma_f32_32x32x16_bf16(b1, q, p1, 0, 0, 0); }
}
DI int v_st(int k, int c) { const int kk = (k & ~0xC) | ((k & 4) << 1) | ((k & 8) >> 1); return ((kk >> 3) * 4 + (c >> 5)) * 512 + ((kk & 7) * 32 + (c & 31)) * 2; }
DI int v_rd_base(int lane) { return ((lane & 3) << 3) | (((lane >> 2) & 3) << 6) | (((lane >> 4) & 1) << 5) | (((lane >> 5) & 1) << 8); }
constexpr int v_rd_off(int d0, int ks, int half) { return d0 * 512 + ks * 4096 + half * 2048; }
template <int OFF> DI s16x4 tr_read(int vb) { s16x4 r; asm volatile("ds_read_b64_tr_b16 %0, %1 offset:%2" : "=&v"(r) : "v"(vb), "i"(OFF) : "memory"); return r; }
template <int D0> DI void pv_one(f32x16& od, int vb, bf16x8 pa0, bf16x8 pa1, bf16x8 pa2, bf16x8 pa3) {
    const s16x4 l0 = tr_read<v_rd_off(D0, 0, 0)>(vb), h0 = tr_read<v_rd_off(D0, 0, 1)>(vb), l1 = tr_read<v_rd_off(D0, 1, 0)>(vb), h1 = tr_read<v_rd_off(D0, 1, 1)>(vb);
    const s16x4 l2 = tr_read<v_rd_off(D0, 2, 0)>(vb), h2 = tr_read<v_rd_off(D0, 2, 1)>(vb), l3 = tr_read<v_rd_off(D0, 3, 0)>(vb), h3 = tr_read<v_rd_off(D0, 3, 1)>(vb);
    asm volatile("s_waitcnt lgkmcnt(0)" ::: "memory"); SBAR();
#define PKV(L, H) (bf16x8){L[0], L[1], L[2], L[3], H[0], H[1], H[2], H[3]}
    od = __builtin_amdgcn_mfma_f32_32x32x16_bf16(pa0, PKV(l0, h0), od, 0, 0, 0);
    od = __builtin_amdgcn_mfma_f32_32x32x16_bf16(pa1, PKV(l1, h1), od, 0, 0, 0);
    od = __builtin_amdgcn_mfma_f32_32x32x16_bf16(pa2, PKV(l2, h2), od, 0, 0, 0);
    od = __builtin_amdgcn_mfma_f32_32x32x16_bf16(pa3, PKV(l3, h3), od, 0, 0, 0);
#undef PKV
}
DI void pv_d0(f32x16* o, int vb, bf16x8 pa0, bf16x8 pa1, bf16x8 pa2, bf16x8 pa3) {
    pv_one<0>(o[0], vb, pa0, pa1, pa2, pa3); pv_one<1>(o[1], vb, pa0, pa1, pa2, pa3); pv_one<2>(o[2], vb, pa0, pa1, pa2, pa3); pv_one<3>(o[3], vb, pa0, pa1, pa2, pa3);
}
template <int DQK, int SDEPTH>
DI void attn_body(const bf16_t* __restrict__ Qb, const bf16_t* __restrict__ Kh, const bf16_t* __restrict__ Vh, bf16_t* __restrict__ Ob, int ldo, int seq, char* lds, const float SCALE) {
    using Cfg = AttnCfg<DQK>;
    constexpr int SHM_V = Cfg::SHM_V, SHM_K = Cfg::SHM_K, ND0 = Cfg::ND0, NKCH = Cfg::NKCH, KCPR = DQK / 8, NQR = Cfg::NQR;
    int tid = threadIdx.x; asm volatile("" : "+v"(tid));
    const int wid = tid >> 6, lane = tid & 63, r32 = lane & 31, hi = lane >> 5;
    char* V_lds = lds; char* K_lds = lds + 2 * SHM_V;
    float* ws = (float*)(lds + 2 * SHM_V + 2 * SHM_K) + wid * 64; float* li_l = ws; float* al_l = ws + 32;
    float m_reg = -1e30f, l_reg = 0; f32x16 o[4]; bf16x8 qr[NQR > 0 ? NQR : 1];
    char* Qs = lds + 2 * SHM_V + 2 * SHM_K + 8 * 64 * 4 + (wid * (ND0 - NQR) * 64 + lane) * 16;
#pragma unroll
    for (int d = 0; d < 4; ++d)
#pragma unroll
        for (int r = 0; r < 16; ++r) o[d][r] = 0.f;
    const bf16_t* Qw = Qb + (long)(wid * 32 + r32) * DQK + hi * 8;
#pragma unroll
    for (int d0 = 0; d0 < ND0; ++d0) { const bf16x8 qv = *reinterpret_cast<const bf16x8*>(Qw + d0 * 16); if (d0 < NQR) qr[d0] = qv; else *reinterpret_cast<bf16x8*>(Qs + (d0 - NQR) * 1024) = qv; }
    asm volatile("s_waitcnt lgkmcnt(0)" ::: "memory");
    const int sr = tid >> 4, sc = (tid & 15) * 8, vst0 = v_st(sr, sc), vst1 = v_st(32 + sr, sc);
    const int kgo = (tid >> 3) * DQK + (tid & 7) * 8, klo = (tid >> 3) * (DQK * 2) + (((tid & 7) << 4) ^ (((tid >> 3) & 7) << 4));
    const int vb0 = (int)(uintptr_t)V_lds + v_rd_base(lane);
    int kb[4];
#pragma unroll
    for (int m = 0; m < 4; ++m) { kb[m] = (int)(uintptr_t)K_lds + r32 * (DQK * 2) + 16 * (hi ^ (r32 & 1)) + 32 * (m ^ ((r32 >> 1) & 3)); asm volatile("" : "+v"(kb[m])); }
    struct { bf16x8 vs0, vs1, ks[NKCH]; } sr_[SDEPTH];
#define SLOAD(i, k0) do { sr_[i].vs0 = *(const bf16x8*)(&Vh[(long)((k0) + sr) * 128 + sc]); sr_[i].vs1 = *(const bf16x8*)(&Vh[(long)((k0) + 32 + sr) * 128 + sc]); \
    _Pragma("unroll") for (int q_ = 0; q_ < NKCH; ++q_) sr_[i].ks[q_] = *(const bf16x8*)(&Kh[(long)(k0) * DQK + kgo + q_ * 64]); } while (0)
#define SWRITE(b, i) do { *(bf16x8*)(V_lds + (b) * SHM_V + vst0) = sr_[i].vs0; *(bf16x8*)(V_lds + (b) * SHM_V + vst1) = sr_[i].vs1; \
    _Pragma("unroll") for (int q_ = 0; q_ < NKCH; ++q_) *(bf16x8*)(K_lds + (b) * SHM_K + klo + q_ * 128) = sr_[i].ks[q_]; } while (0)
#define SWAIT() do { if constexpr (SDEPTH == 1) asm volatile("s_waitcnt vmcnt(0)" ::: "memory"); else if constexpr (NKCH == 2) asm volatile("s_waitcnt vmcnt(4)" ::: "memory"); else asm volatile("s_waitcnt vmcnt(5)" ::: "memory"); } while (0)
#define RESC(a) do { if (__any((a) < 1.f)) { if (hi == 0) al_l[r32] = (a); asm volatile("s_waitcnt lgkmcnt(0)" ::: "memory"); \
    _Pragma("unroll") for (int d = 0; d < 4; ++d) _Pragma("unroll") for (int r = 0; r < 16; ++r) o[d][r] *= al_l[crow(r, hi)]; } } while (0)
    f32x16 pA0, pA1, pB0, pB1; float mnA, mnB, alA, alB; bf16x8 pa0, pa1, pa2, pa3; const int NT = seq / 64;
    constexpr int SE = 0, SO = SDEPTH - 1;
    SLOAD(SE, 0); asm volatile("s_waitcnt vmcnt(0)" ::: "memory"); SWRITE(0, SE); __syncthreads();
    qkt<DQK, NQR>(pA0, pA1, kb, 0, qr, (int)(uintptr_t)Qs, r32, hi); partialSM(pA0, pA1, m_reg, mnA, alA, SCALE);
    SLOAD(SO, 64); if constexpr (SDEPTH == 2) { if (2 < NT) SLOAD(SE, 2 * 64); }
    SWAIT(); SWRITE(1, SO); __syncthreads();
    for (int j = 1; j + 1 < NT; j += 2) {
        SBAR(); qkt<DQK, NQR>(pB0, pB1, kb, SHM_K, qr, (int)(uintptr_t)Qs, r32, hi);
        finishSM(pA0, pA1, alA, l_reg, pa0, pa1, pa2, pa3); SBAR();
        SLOAD(SO, (j + SDEPTH) * 64); SBAR();
        pv_d0(o, vb0, pa0, pa1, pa2, pa3); partialSM(pB0, pB1, m_reg, mnB, alB, SCALE);
        __syncthreads(); SWAIT(); SWRITE(0, SE);
        RESC(alB); __syncthreads();
        SBAR(); qkt<DQK, NQR>(pA0, pA1, kb, 0, qr, (int)(uintptr_t)Qs, r32, hi);
        finishSM(pB0, pB1, alB, l_reg, pa0, pa1, pa2, pa3); SBAR();
        if (SDEPTH == 1 || j + 3 < NT) SLOAD(SE, (j + 1 + SDEPTH) * 64); SBAR();
        pv_d0(o, vb0 + SHM_V, pa0, pa1, pa2, pa3); partialSM(pA0, pA1, m_reg, mnA, alA, SCALE);
        __syncthreads(); SWAIT(); SWRITE(1, SO);
        RESC(alA); __syncthreads();
    }
    SBAR(); qkt<DQK, NQR>(pB0, pB1, kb, SHM_K, qr, (int)(uintptr_t)Qs, r32, hi);
    finishSM(pA0, pA1, alA, l_reg, pa0, pa1, pa2, pa3); SBAR();
    pv_d0(o, vb0, pa0, pa1, pa2, pa3); partialSM(pB0, pB1, m_reg, mnB, alB, SCALE);
    __syncthreads(); RESC(alB);
    finishSM(pB0, pB1, alB, l_reg, pa0, pa1, pa2, pa3); SBAR();
    pv_d0(o, vb0 + SHM_V, pa0, pa1, pa2, pa3);
    if (hi == 0) li_l[r32] = l_reg; asm volatile("s_waitcnt lgkmcnt(0)" ::: "memory");
    float rli[16];
#pragma unroll
    for (int r = 0; r < 16; ++r) rli[r] = __builtin_amdgcn_rcpf(li_l[crow(r, hi)]);
    bf16_t* Ow = Ob + (long)(wid * 32) * ldo;
#pragma unroll
    for (int r = 0; r < 16; ++r) { const int orow = crow(r, hi);
#pragma unroll
        for (int d0 = 0; d0 < 4; ++d0) Ow[(long)orow * ldo + d0 * 32 + r32] = f2bf(o[d0][r] * rli[r]); }
    __syncthreads();
#undef SLOAD
#undef SWRITE
#undef SWAIT
#undef RESC
}

constexpr int GL_V = 0;
constexpr int GL_K = 16384;
constexpr int GL_Q = GL_K + 9216;
constexpr int GL_ZF = GL_Q + 9216;
constexpr int GL_ZB = GL_ZF + 4096;
constexpr int GL_LF = GL_ZB + 4096;
constexpr int GL_LB = GL_LF + 16640;
constexpr int GL_X0 = GL_LB + 16640;
constexpr int GL_KEF = GL_X0, GL_KEB = GL_X0 + 9216;
constexpr int GL_QD = GL_X0, GL_KI = GL_X0 + 9216;
constexpr int GL_O = GL_X0 + 18432;
static_assert(GL_O + 64 * 132 * 4 <= 160 * 1024 - 256, "GLA LDS");
DI int gla_row0(int b, int c) { return c < 4 ? NLAT + b * CTXL + c * 64 : b * SEQ + (c - 4) * 64; }
DI void gla_prep(PR p, int l, char* lds, int b, int h, int c, bool needq) {
    const int tid = tid_here(), lane = tid & 63, wid = tid >> 6;
    const bf16_t* PR_ = (const bf16_t*)(p.ws + WS_U + U_PROJ);
    const int row0 = gla_row0(b, c);
    {
        const int t = tid >> 3, dg = (tid & 7) * 8; const bf16_t* pr = PR_ + (size_t)(row0 + t) * INWP;
        *(bf16x8*)(lds + GL_K + t * 144 + dg * 2) = *(const bf16x8*)(pr + C_GK + h * 64 + dg);
        if (needq) { const bf16x8 qv = *(const bf16x8*)(pr + C_GQ + h * 64 + dg); u32x4 w;
            w.x = pk2(bf2f((bf16_t)qv[0]) * 0.125f, bf2f((bf16_t)qv[1]) * 0.125f); w.y = pk2(bf2f((bf16_t)qv[2]) * 0.125f, bf2f((bf16_t)qv[3]) * 0.125f);
            w.z = pk2(bf2f((bf16_t)qv[4]) * 0.125f, bf2f((bf16_t)qv[5]) * 0.125f); w.w = pk2(bf2f((bf16_t)qv[6]) * 0.125f, bf2f((bf16_t)qv[7]) * 0.125f);
            *(u32x4*)(lds + GL_Q + t * 144 + dg * 2) = w; }
        const int sr = tid >> 4, sc = (tid & 15) * 8;
        *(bf16x8*)(lds + GL_V + v_st(sr, sc)) = *(const bf16x8*)(PR_ + (size_t)(row0 + sr) * INWP + C_GV + h * 128 + sc);
        *(bf16x8*)(lds + GL_V + v_st(32 + sr, sc)) = *(const bf16x8*)(PR_ + (size_t)(row0 + 32 + sr) * INWP + C_GV + h * 128 + sc);
        if (tid < 256) { const int tt = (tid & 127) >> 1, half = tid & 1, dir = tid >> 7; const bf16x8 zv = *(const bf16x8*)(PR_ + (size_t)(row0 + tt) * INWP + (dir ? C_ZB : C_ZF) + half * 8);
            float* Z = (float*)(lds + (dir ? GL_ZB : GL_ZF)) + tt * 16 + half * 8;
#pragma unroll
            for (int j = 0; j < 8; ++j) Z[j] = bf2f((bf16_t)zv[j]); }
    }
    float wf[16], wb[16];
#pragma unroll
    for (int r = 0; r < 16; ++r) { wf[r] = p.gla_wg2_f[((size_t)l * 16 + r) * 256 + h * 64 + lane]; wb[r] = p.gla_wg2_b[((size_t)l * 16 + r) * 256 + h * 64 + lane]; }
    const float bgf = p.gla_bg_f[l * 256 + h * 64 + lane], bgb = p.gla_bg_b[l * 256 + h * 64 + lane];
    __syncthreads();
#pragma unroll
    for (int i = 0; i < 8; ++i) {
        const int t = wid * 8 + i; const float* ZF = (const float*)(lds + GL_ZF) + t * 16; const float* ZB = (const float*)(lds + GL_ZB) + t * 16;
        float zf = bgf, zb = bgb;
#pragma unroll
        for (int r = 0; r < 16; ++r) { zf += ZF[r] * wf[r]; zb += ZB[r] * wb[r]; }
        const float lf = fminf(zf, 0.f) - __logf(1.f + __expf(-fabsf(zf))), lb = fminf(zb, 0.f) - __logf(1.f + __expf(-fabsf(zb)));
        ((float*)(lds + GL_LF))[t * 65 + lane] = lf * 0.0625f; ((float*)(lds + GL_LB))[t * 65 + lane] = lb * 0.0625f;
    }
    __syncthreads();
#pragma unroll
    for (int i = 0; i < 8; ++i) {
        const int d = wid * 8 + i;
        float* F = (float*)(lds + GL_LF) + lane * 65 + d; float* Bk = (float*)(lds + GL_LB) + lane * 65 + d;
        float f = *F, g = *Bk;
#pragma unroll
        for (int o = 1; o < 64; o <<= 1) {
            const float fu = __int_as_float(__builtin_amdgcn_ds_bpermute(((lane - o) & 63) << 2, __float_as_int(f)));
            const float gu = __int_as_float(__builtin_amdgcn_ds_bpermute(((lane + o) & 63) << 2, __float_as_int(g)));
            if (lane >= o) f += fu; if (lane + o < 64) g += gu;
        }
        *F = f; *Bk = g;
    }
    __syncthreads();
}
DI void gla_phaseA(PR p, int l, char* lds) {
    float* GS = (float*)(p.ws + WS_U + U_GS); float* GD = (float*)(p.ws + WS_GDEC);
    for (int u = bid_here(); u < 16 * 68; u += gridDim.x) {
        const int bh = u / 68, c = u % 68, b = bh >> 2, h = bh & 3;
        gla_prep(p, l, lds, b, h, c, false);
        const int tid = tid_here(), lane = tid & 63, wid = tid >> 6, r32 = lane & 31, hi = lane >> 5;
        {
            const float* LF = (const float*)(lds + GL_LF); const float* LB = (const float*)(lds + GL_LB);
            const float lastf = LF[63 * 65 + lane], lastb = LB[0 * 65 + lane];
            float ef[8], eb[8];
#pragma unroll
            for (int i = 0; i < 8; ++i) { const int t = wid * 8 + i; const float k = bf2f(*(const bf16_t*)(lds + GL_K + t * 144 + lane * 2));
                ef[i] = k * __expf(lastf - LF[t * 65 + lane]); eb[i] = k * __expf(lastb - LB[t * 65 + lane]); }
            u32x4 w; w.x = pk2(ef[0], ef[1]); w.y = pk2(ef[2], ef[3]); w.z = pk2(ef[4], ef[5]); w.w = pk2(ef[6], ef[7]); *(u32x4*)(lds + GL_KEF + lane * 144 + wid * 16) = w;
            w.x = pk2(eb[0], eb[1]); w.y = pk2(eb[2], eb[3]); w.z = pk2(eb[4], eb[5]); w.w = pk2(eb[6], eb[7]); *(u32x4*)(lds + GL_KEB + lane * 144 + wid * 16) = w;
            if (wid == 0) { GD[((size_t)(0 * 16 + bh) * 68 + c) * 64 + lane] = __expf(lastf); GD[((size_t)(1 * 16 + bh) * 68 + c) * 64 + lane] = __expf(lastb); }
        }
        __syncthreads();
        {
            const int rh = wid & 1, cb = wid >> 1;
            const int vb = (int)(uintptr_t)(lds + GL_V) + v_rd_base(lane) + cb * 512;
#pragma unroll
            for (int dir = 0; dir < 2; ++dir) {
                const char* KE = lds + (dir ? GL_KEB : GL_KEF) + (rh * 32 + r32) * 144 + hi * 16;
                const bf16x8 a0 = *(const bf16x8*)(KE), a1 = *(const bf16x8*)(KE + 32), a2 = *(const bf16x8*)(KE + 64), a3 = *(const bf16x8*)(KE + 96);
                f32x16 od;
#pragma unroll
                for (int r = 0; r < 16; ++r) od[r] = 0.f;
                pv_one<0>(od, vb, a0, a1, a2, a3);
                float* dst = GS + ((size_t)(dir * 16 + bh) * 68 + c) * 8192 + (size_t)(cb * 32 + r32) * 64 + rh * 32 + 4 * hi;
#pragma unroll
                for (int g = 0; g < 4; ++g) *(f32x4*)(dst + 8 * g) = (f32x4){od[4 * g], od[4 * g + 1], od[4 * g + 2], od[4 * g + 3]};
            }
        }
        __syncthreads();
    }
}
DI void gla_scan(PR p) {
    const float* GS = (const float*)(p.ws + WS_U + U_GS); const float* GD = (const float*)(p.ws + WS_GDEC); bf16_t* GST = (bf16_t*)(p.ws + WS_U + U_GST);
    const int tid = tid_here();
    for (int u = bid_here(); u < 128; u += gridDim.x) {
        const int e = u * NTHREADS + tid, db = e >> 11, jd4 = e & 2047, d4 = (jd4 & 15) * 4;
        const int dir = db >> 4;
        const float* base = GS + (size_t)db * 68 * 8192 + jd4 * 4; const float* dbase = GD + (size_t)db * 68 * 64 + d4; bf16_t* obase = GST + (size_t)db * 68 * 8192 + jd4 * 4;
#define SC_C(i) (dir == 0 ? (i) : ((i) < 4 ? 3 - (i) : 71 - (i)))
        float z0 = 0.f; asm volatile("" : "+v"(z0));
        f32x4 S = {z0, z0, z0, z0};
        f32x4 cur[4], nxt[4], dc[4], dn[4];
#pragma unroll
        for (int q = 0; q < 4; ++q) { const int c = SC_C(q); cur[q] = *(const f32x4*)(base + (size_t)c * 8192); dc[q] = *(const f32x4*)(dbase + c * 64); }
        for (int i = 0; i < 68; i += 4) {
            if (i + 4 < 68) {
#pragma unroll
                for (int q = 0; q < 4; ++q) { const int c = SC_C(i + 4 + q); nxt[q] = *(const f32x4*)(base + (size_t)c * 8192); dn[q] = *(const f32x4*)(dbase + c * 64); }
            }
#pragma unroll
            for (int q = 0; q < 4; ++q) { const int c = SC_C(i + q); u32x2 w; w.x = pk2(S[0], S[1]); w.y = pk2(S[2], S[3]); *(u32x2*)(obase + (size_t)c * 8192) = w; S = S * dc[q] + cur[q]; }
#pragma unroll
            for (int q = 0; q < 4; ++q) { cur[q] = nxt[q]; dc[q] = dn[q]; }
        }
#undef SC_C
    }
}
DI void gla_phaseC(PR p, int l, char* lds) {
    const bf16_t* GST = (const bf16_t*)(p.ws + WS_U + U_GST);
    const bf16_t* PR_ = (const bf16_t*)(p.ws + WS_U + U_PROJ); bf16_t* MIX = (bf16_t*)(p.ws + WS_U + U_MIX);
    for (int u = bid_here(); u < 16 * 68; u += gridDim.x) {
        const int bh = u / 68, c = u % 68, b = bh >> 2, h = bh & 3;
        if (l == 1 && c < 4) continue;
        gla_prep(p, l, lds, b, h, c, true);
        const int tid = tid_here(), lane = tid & 63, wid = tid >> 6, r32 = lane & 31, hi = lane >> 5, rh = wid & 1, cb = wid >> 1;
        const int vb = (int)(uintptr_t)(lds + GL_V) + v_rd_base(lane) + cb * 512;
        f32x16 o;
#pragma unroll
        for (int r = 0; r < 16; ++r) o[r] = 0.f;
#pragma unroll
        for (int dir = 0; dir < 2; ++dir) {
            {
                const int t = tid >> 3, dg = (tid & 7) * 8; const float* LC = (const float*)(lds + (dir ? GL_LB : GL_LF)) + t * 65 + dg;
                const bf16x8 qv = *(const bf16x8*)(lds + GL_Q + t * 144 + dg * 2), kv = *(const bf16x8*)(lds + GL_K + t * 144 + dg * 2);
                float qd[8], ki[8];
#pragma unroll
                for (int j = 0; j < 8; ++j) { const float bc = LC[j]; qd[j] = bf2f((bf16_t)qv[j]) * __expf(bc); ki[j] = bf2f((bf16_t)kv[j]) * __expf(-bc); }
                u32x4 w; w.x = pk2(qd[0], qd[1]); w.y = pk2(qd[2], qd[3]); w.z = pk2(qd[4], qd[5]); w.w = pk2(qd[6], qd[7]); *(u32x4*)(lds + GL_QD + t * 144 + dg * 2) = w;
                w.x = pk2(ki[0], ki[1]); w.y = pk2(ki[2], ki[3]); w.z = pk2(ki[4], ki[5]); w.w = pk2(ki[6], ki[7]); *(u32x4*)(lds + GL_KI + t * 144 + dg * 2) = w;
            }
            __syncthreads();
            {
                const char* QD = lds + GL_QD + (rh * 32 + r32) * 144 + hi * 16; const char* KI = lds + GL_KI + r32 * 144 + hi * 16;
                bf16x8 qf[4];
#pragma unroll
                for (int d0 = 0; d0 < 4; ++d0) qf[d0] = *(const bf16x8*)(QD + d0 * 32);
                f32x16 p0, p1;
#pragma unroll
                for (int r = 0; r < 16; ++r) { p0[r] = 0.f; p1[r] = 0.f; }
#pragma unroll
                for (int d0 = 0; d0 < 4; ++d0) {
                    const bf16x8 k0 = *(const bf16x8*)(KI + d0 * 32), k1 = *(const bf16x8*)(KI + 32 * 144 + d0 * 32);
                    p0 = __builtin_amdgcn_mfma_f32_32x32x16_bf16(k0, qf[d0], p0, 0, 0, 0);
                    p1 = __builtin_amdgcn_mfma_f32_32x32x16_bf16(k1, qf[d0], p1, 0, 0, 0);
                }
                const int tq = rh * 32 + r32;
#pragma unroll
                for (int r = 0; r < 16; ++r) { const int s0 = crow(r, hi), s1 = 32 + s0;
                    const bool ok0 = dir == 0 ? (s0 <= tq) : (s0 >= tq), ok1 = dir == 0 ? (s1 <= tq) : (s1 >= tq);
                    p0[r] = ok0 ? p0[r] : 0.f; p1[r] = ok1 ? p1[r] : 0.f; }
                bf16x8 pa0, pa1, pa2, pa3;
#define PK4(P, BASE, OUT) do { unsigned a0 = cvtpk(P[BASE + 0], P[BASE + 1]), a1 = cvtpk(P[BASE + 2], P[BASE + 3]);   \
    unsigned b0 = cvtpk(P[BASE + 4], P[BASE + 5]), b1 = cvtpk(P[BASE + 6], P[BASE + 7]);                              \
    auto r0 = __builtin_amdgcn_permlane32_swap(a0, b0, false, false); auto r1 = __builtin_amdgcn_permlane32_swap(a1, b1, false, false); \
    u32x4 w_ = {r0[0], r1[0], r0[1], r1[1]}; OUT = *reinterpret_cast<bf16x8*>(&w_); } while (0)
                PK4(p0, 0, pa0); PK4(p0, 8, pa1); PK4(p1, 0, pa2); PK4(p1, 8, pa3);
#undef PK4
                pv_one<0>(o, vb, pa0, pa1, pa2, pa3);
                const bf16_t* Sg = GST + ((size_t)(dir * 16 + bh) * 68 + c) * 8192 + (size_t)(cb * 32 + r32) * 64 + hi * 8;
                const bf16x8 s0 = *(const bf16x8*)(Sg), s1 = *(const bf16x8*)(Sg + 16), s2 = *(const bf16x8*)(Sg + 32), s3 = *(const bf16x8*)(Sg + 48);
                o = __builtin_amdgcn_mfma_f32_32x32x16_bf16(qf[0], s0, o, 0, 0, 0);
                o = __builtin_amdgcn_mfma_f32_32x32x16_bf16(qf[1], s1, o, 0, 0, 0);
                o = __builtin_amdgcn_mfma_f32_32x32x16_bf16(qf[2], s2, o, 0, 0, 0);
                o = __builtin_amdgcn_mfma_f32_32x32x16_bf16(qf[3], s3, o, 0, 0, 0);
            }
            __syncthreads();
        }
        { float* O = (float*)(lds + GL_O);
#pragma unroll
          for (int r = 0; r < 16; ++r) O[(rh * 32 + crow(r, hi)) * 132 + cb * 32 + r32] = o[r]; }
        __syncthreads();
        {
            const int t = tid >> 3, jg = (tid & 7) * 16; const float* O = (const float*)(lds + GL_O) + t * 132 + jg;
            float v[16], ss = 0.f;
#pragma unroll
            for (int q = 0; q < 4; ++q) { const f32x4 x = *(const f32x4*)(O + 4 * q); v[4 * q] = x[0]; v[4 * q + 1] = x[1]; v[4 * q + 2] = x[2]; v[4 * q + 3] = x[3]; ss += x[0] * x[0] + x[1] * x[1] + x[2] * x[2] + x[3] * x[3]; }
            ss += shx(ss, 1, lane); ss += shx(ss, 2, lane); ss += shx(ss, 4, lane);
            const float rstd = rsqrtf(ss * (1.f / 128.f) + EPS);
            const int row = gla_row0(b, c) + t;
            const bf16_t* gp = PR_ + (size_t)row * INWP + C_GG + h * 128 + jg; const float* go = p.gla_g_out + l * 128 + jg;
            const bf16x8 g0 = *(const bf16x8*)(gp), g1 = *(const bf16x8*)(gp + 8);
            float ov[16];
#pragma unroll
            for (int j = 0; j < 16; ++j) { const float gate = bf2f((bf16_t)(j < 8 ? g0[j] : g1[j - 8])); ov[j] = v[j] * rstd * go[j] * silu_f(gate); }
            u32x4 w0, w1; w0.x = pk2(ov[0], ov[1]); w0.y = pk2(ov[2], ov[3]); w0.z = pk2(ov[4], ov[5]); w0.w = pk2(ov[6], ov[7]); w1.x = pk2(ov[8], ov[9]); w1.y = pk2(ov[10], ov[11]); w1.z = pk2(ov[12], ov[13]); w1.w = pk2(ov[14], ov[15]);
            bf16_t* dst = MIX + (size_t)row * D + h * 128 + jg; *(u32x4*)(dst) = w0; *(u32x4*)(dst + 8) = w1;
        }
        __syncthreads();
    }
}

namespace pg {
constexpr int BK = 64, HALF = 128, HTB = HALF * BK * 2, STAGE_BYTES = 8 * HTB;
DI int lds_byte(int r, int c) { const int st = (r >> 4) * 2 + (c >> 5), rr = r & 15, cc = c & 31, ob = rr * 64 + cc * 2; return st * 1024 + (ob ^ (((ob >> 9) & 1) << 5)); }
DI int perm32(int rho) { const int n = rho >> 4, i = rho & 15; return 8 * (i >> 2) + 4 * n + (i & 3); }
DI void stage_rc(int b, int& R, int& C) { const int st = b / 1024, sb = b % 1024, swz = sb ^ (((sb >> 9) & 1) << 5); R = (st >> 1) * 16 + swz / 64; C = (st & 1) * 32 + (swz % 64) / 2; }
struct XUnit {
    const char* A;
    const char* B;
    int arow0;
    int list;
    int e0, e1, e2, e3;
};
template <class Sched>
DI void gemm_phase(LAS unsigned char* lds, const LAS int* rowlists, const Sched& S) {
    int tid = threadIdx.x; asm volatile("" : "+v"(tid));
    const int wid = __builtin_amdgcn_readfirstlane(tid >> 6), lane = tid & 63, wr = wid >> 2, wc = wid & 3, fr = lane & 15, fq = lane >> 4;
    const int K = S.K, nt = K / BK;
    unsigned voffB[2];
#pragma unroll
    for (int i = 0; i < 2; ++i) { int R_, C_; stage_rc(tid * 16 + i * 8192, R_, C_); if (Sched::PERM) R_ = (R_ & ~31) + perm32(R_ & 31); voffB[i] = (unsigned)R_ * (unsigned)S.ldb + (unsigned)C_ * 2u; }
    const size_t kstep = (size_t)(BK * 2), hstepB = (size_t)HALF * S.ldb;
    const unsigned ldsw = (unsigned)wid * 1024u;
    const int aoff = lds_byte(wr * 64 + fr, fq * 8), boff = lds_byte(wc * 32 + fr, fq * 8);
#define PG_SA(b, h) (((b) * 2 + (h)) * HTB)
#define PG_SB(b, h) ((4 + (b) * 2 + (h)) * HTB)
#define PG_STAGE(bufoff, gbase, voff) do { _Pragma("unroll") for (int _i = 0; _i < 2; ++_i) \
        __builtin_amdgcn_global_load_lds((const unsigned*)((const char*)(gbase) + (voff)[_i]), (LAS unsigned*)(lds + (bufoff) + ldsw + _i * 8192), 16, 0, 0); } while (0)
#define PG_LDA(dst, b, h) do { _Pragma("unroll") for (int m = 0; m < 4; ++m) _Pragma("unroll") for (int k = 0; k < 2; ++k) dst[m][k] = *(const LAS bf16x8*)(lds + PG_SA(b, h) + aoff + m * 2048 + k * 1024); } while (0)
#define PG_LDB(dst, b, h) do { _Pragma("unroll") for (int n = 0; n < 2; ++n) _Pragma("unroll") for (int k = 0; k < 2; ++k) dst[n][k] = *(const LAS bf16x8*)(lds + PG_SB(b, h) + boff + n * 2048 + k * 1024); } while (0)
#define PG_MMA(ai, bj, At, Bt) do { __builtin_amdgcn_s_setprio(1); _Pragma("unroll") for (int m = 0; m < 4; ++m) _Pragma("unroll") for (int n = 0; n < 2; ++n) _Pragma("unroll") for (int k = 0; k < 2; ++k) \
        acc[ai][bj][m][n] = __builtin_amdgcn_mfma_f32_16x16x32_bf16(Bt[n][k], At[m][k], acc[ai][bj][m][n], 0, 0, 0); __builtin_amdgcn_s_setprio(0); } while (0)
#define PG_WAIT_V(n) asm volatile("s_waitcnt vmcnt(" #n ")" ::: "memory")
#define PG_WAIT_L(n) asm volatile("s_waitcnt lgkmcnt(" #n ")" ::: "memory")
#define PG_BAR __builtin_amdgcn_s_barrier()
#define PG_SCHED __builtin_amdgcn_sched_barrier(0)
#define PG_AOFFS(dst, u) do { const int _t = tid_here(); _Pragma("unroll") for (int _i = 0; _i < 2; ++_i) { int _R, _C; stage_rc(_t * 16 + _i * 8192, _R, _C); _Pragma("unroll") for (int _h = 0; _h < 2; ++_h) { \
        unsigned _row; if ((u).list >= 0) { const int _x = rowlists[(u).list + _h * HALF + _R]; _row = _x >= 0 ? (unsigned)(_x >> S.rowshift) : 0u; } else _row = (unsigned)((u).arow0 + _h * HALF + _R); \
        dst[_h][_i] = _row * (unsigned)S.lda + (unsigned)_C * 2u; } } } while (0)
    XUnit cur, nxt; int ui = 0;
    if (!S.next(0, cur)) return;
    f32x4 acc[2][2][4][2];
#pragma unroll
    for (int a = 0; a < 2; ++a)
#pragma unroll
        for (int b = 0; b < 2; ++b)
#pragma unroll
            for (int m = 0; m < 4; ++m)
#pragma unroll
                for (int n = 0; n < 2; ++n) acc[a][b][m][n] = (f32x4){0.f, 0.f, 0.f, 0.f};
    bf16x8 At[4][2], B0[2][2], B1[2][2];
    unsigned ao[2][2];
    PG_AOFFS(ao, cur);
    PG_WAIT_L(0); PG_SCHED;
    const char* cA = cur.A; const char* cB = cur.B;
    PG_STAGE(PG_SB(0, 0), cB, voffB); PG_STAGE(PG_SA(0, 0), cA, ao[0]); PG_STAGE(PG_SB(0, 1), cB + hstepB, voffB); PG_STAGE(PG_SA(0, 1), cA, ao[1]);
    if (wr == 1) PG_BAR;
    PG_WAIT_V(4); PG_BAR;
    PG_STAGE(PG_SB(1, 0), cB + kstep, voffB); PG_STAGE(PG_SA(1, 0), cA + kstep, ao[0]); PG_STAGE(PG_SB(1, 1), cB + hstepB + kstep, voffB);
    PG_WAIT_V(6); PG_BAR;
    for (;;) {
        const bool has_next = S.next(ui + 1, nxt);
        const char* nA = has_next ? nxt.A : cA; const char* nB = has_next ? nxt.B : cB;
        for (int t = 0; t < nt; t += 2) {
            const bool last = (t == nt - 2);
            const char* a1 = cA + (size_t)(t + 1) * kstep;
            const char* a2 = last ? nA : cA + (size_t)(t + 2) * kstep; const char* b2 = last ? nB : cB + (size_t)(t + 2) * kstep;
            const char* a3 = a2 + kstep; const char* b3 = b2 + kstep;
            PG_LDB(B0, 0, 0); PG_SCHED; PG_LDA(At, 0, 0); PG_STAGE(PG_SA(1, 1), a1, ao[1]);
            PG_WAIT_L(8); PG_BAR; PG_WAIT_L(0); PG_MMA(0, 0, At, B0); PG_BAR; PG_SCHED;
            if (last && has_next) { PG_AOFFS(ao, nxt); }
            PG_LDB(B1, 0, 1); PG_STAGE(PG_SB(0, 0), b2, voffB);
            PG_BAR; PG_WAIT_L(0); PG_MMA(0, 1, At, B1); PG_BAR;
            PG_LDA(At, 0, 1); PG_STAGE(PG_SA(0, 0), a2, ao[0]);
            PG_BAR; PG_WAIT_L(0); PG_MMA(1, 0, At, B0); PG_BAR; PG_SCHED;
            PG_STAGE(PG_SB(0, 1), b2 + hstepB, voffB);
            PG_WAIT_V(6); PG_BAR; PG_MMA(1, 1, At, B1); PG_BAR;
            PG_LDB(B0, 1, 0); PG_SCHED; PG_LDA(At, 1, 0); PG_STAGE(PG_SA(0, 1), a2, ao[1]);
            PG_WAIT_L(8); PG_BAR; PG_WAIT_L(0); PG_MMA(0, 0, At, B0); PG_BAR; PG_SCHED;
            PG_LDB(B1, 1, 1); PG_STAGE(PG_SB(1, 0), b3, voffB);
            PG_BAR; PG_WAIT_L(0); PG_MMA(0, 1, At, B1); PG_BAR;
            PG_LDA(At, 1, 1); PG_STAGE(PG_SA(1, 0), a3, ao[0]);
            PG_BAR; PG_WAIT_L(0); PG_MMA(1, 0, At, B0); PG_BAR; PG_SCHED;
            PG_STAGE(PG_SB(1, 1), b3 + hstepB, voffB);
            PG_WAIT_V(6); PG_BAR; PG_MMA(1, 1, At, B1); PG_BAR;
        }
        { const int t2 = tid_here(), w2 = t2 >> 6, l2 = t2 & 63; S.epi(acc, cur, w2 >> 2, w2 & 3, l2 & 15, l2 >> 4); }
        if (!has_next) break;
#pragma unroll
        for (int a = 0; a < 2; ++a)
#pragma unroll
            for (int b = 0; b < 2; ++b)
#pragma unroll
                for (int m = 0; m < 4; ++m)
#pragma unroll
                    for (int n = 0; n < 2; ++n) acc[a][b][m][n] = (f32x4){0.f, 0.f, 0.f, 0.f};
        cur = nxt; cA = nA; cB = nB; ++ui;
    }
    PG_WAIT_V(0);
    if (wr == 0) PG_BAR;
    PG_BAR;
#undef PG_SA
#undef PG_SB
#undef PG_STAGE
#undef PG_LDA
#undef PG_LDB
#undef PG_MMA
#undef PG_WAIT_V
#undef PG_WAIT_L
#undef PG_BAR
#undef PG_SCHED
#undef PG_AOFFS
}
}

DI void phase_router(PR p, int l, char* lds) {
    const int tid = tid_here(), wid = tid >> 6, lane = tid & 63;
    const unsigned char* wl = p.ws + WS_WEIGHTS + (size_t)l * WL_END;
    const bf16_t* WH = (const bf16_t*)(wl + WL_WRH); const bf16_t* WLo = (const bf16_t*)(wl + WL_WRL);
    const bf16_t* HH = (const bf16_t*)(p.ws + WS_HBUF); const bf16_t* HL = (const bf16_t*)(p.ws + WS_U + U_HLO);
    int* EIDX = (int*)(p.ws + WS_EIDX); float* EW = (float*)(p.ws + WS_EW); int* EPOS = (int*)(p.ws + WS_EPOS);
    unsigned* cnt = (unsigned*)(p.ws + WS_CNT) + l * 64;
    const float* rb = p.router_b + l * 64;
    float* SEL = (float*)lds + wid * (2 * 16 * 65);
    float* SCO = SEL + 16 * 65;
    unsigned* LC = (unsigned*)((float*)lds + 8 * (2 * 16 * 65)) + wid * 128; unsigned* LB_ = LC + 64;
    const int ntok = l == 0 ? NTOK : NLAT, ngrp = ntok / 16;
    const int fr = lane & 15, fq = lane >> 4;
    for (int gidx = bid_here() * 8 + wid; gidx < ngrp; gidx += gridDim.x * 8) {
        const int row0 = gidx * 16;
        f32x4 acc[4];
#pragma unroll
        for (int e = 0; e < 4; ++e) acc[e] = (f32x4){0.f, 0.f, 0.f, 0.f};
        const bf16_t* ah = HH + (size_t)(row0 + fr) * D + fq * 8; const bf16_t* al = HL + (size_t)(row0 + fr) * D + fq * 8;
        for (int k0 = 0; k0 < D; k0 += 32) {
            const bf16x8 a_hi = *(const bf16x8*)(ah + k0), a_lo = *(const bf16x8*)(al + k0);
#pragma unroll
            for (int e = 0; e < 4; ++e) {
                const bf16x8 b_hi = *(const bf16x8*)(WH + (size_t)(e * 16 + fr) * D + k0 + fq * 8), b_lo = *(const bf16x8*)(WLo + (size_t)(e * 16 + fr) * D + k0 + fq * 8);
                acc[e] = __builtin_amdgcn_mfma_f32_16x16x32_bf16(a_hi, b_hi, acc[e], 0, 0, 0);
                acc[e] = __builtin_amdgcn_mfma_f32_16x16x32_bf16(a_hi, b_lo, acc[e], 0, 0, 0);
                acc[e] = __builtin_amdgcn_mfma_f32_16x16x32_bf16(a_lo, b_hi, acc[e], 0, 0, 0);
            }
        }
#pragma unroll
        for (int e = 0; e < 4; ++e)
#pragma unroll
            for (int i = 0; i < 4; ++i) { const int ex = e * 16 + fr; const float s = sigmoid_f(acc[e][i]); SCO[(fq * 4 + i) * 65 + ex] = s; SEL[(fq * 4 + i) * 65 + ex] = s + rb[ex]; }
        LC[lane] = 0u;
        asm volatile("s_waitcnt lgkmcnt(0)" ::: "memory");
        __builtin_amdgcn_wave_barrier();
        int erank[8], eik[8];
#pragma unroll
        for (int k = 0; k < 8; ++k) { erank[k] = 0; eik[k] = 0; }
        if (lane < 16) {
            float* sel = SEL + lane * 65; const float* sco = SCO + lane * 65;
            float gs[8];
#pragma unroll
            for (int g = 0; g < 8; ++g) { float m1 = -INFINITY, m2 = -INFINITY;
#pragma unroll
                for (int i = 0; i < 8; ++i) { const float v = sel[g * 8 + i]; if (v > m1) { m2 = m1; m1 = v; } else if (v > m2) m2 = v; }
                gs[g] = m1 + m2; }
            unsigned gmask = 0u;
#pragma unroll
            for (int it = 0; it < 4; ++it) { float best = -INFINITY; int bi = 0;
#pragma unroll
                for (int g = 0; g < 8; ++g) { const bool free_ = ((gmask >> g) & 1u) == 0u; if (free_ && gs[g] > best) { best = gs[g]; bi = g; } }
                gmask |= 1u << bi; }
            int ei[8]; float ew[8]; float wsum = 0.f;
#pragma unroll
            for (int k = 0; k < 8; ++k) { float best = -INFINITY; int bi = 0;
                for (int e = 0; e < 64; ++e) { const float v = sel[e]; if (((gmask >> (e >> 3)) & 1u) && v > best) { best = v; bi = e; } }
                sel[bi] = -INFINITY; ei[k] = bi; ew[k] = sco[bi]; wsum += ew[k]; }
            const float sc = 2.5f / wsum; const int t = row0 + lane;
#pragma unroll
            for (int k = 0; k < 8; ++k) { EIDX[t * 8 + k] = ei[k]; EW[t * 8 + k] = ew[k] * sc; erank[k] = (int)atomicAdd(&LC[ei[k]], 1u); eik[k] = ei[k]; }
        }
        asm volatile("s_waitcnt lgkmcnt(0)" ::: "memory");
        __builtin_amdgcn_wave_barrier();
        { const unsigned cgrp = LC[lane]; const unsigned base = cgrp ? atomicAdd(&cnt[lane], cgrp) : 0u; LB_[lane] = base; }
        asm volatile("s_waitcnt vmcnt(0) lgkmcnt(0)" ::: "memory");
        __builtin_amdgcn_wave_barrier();
        if (lane < 16) { const int t = row0 + lane;
#pragma unroll
            for (int k = 0; k < 8; ++k) EPOS[t * 8 + k] = (int)LB_[eik[k]] + erank[k]; }
        __builtin_amdgcn_wave_barrier();
    }
}
DI void phase_moe_index(PR p, int l, char* lds) {
    const int tid = tid_here();
    int* S = (int*)lds;
    const unsigned* cnt = (const unsigned*)(p.ws + WS_CNT) + l * 64;
    int* META = (int*)(p.ws + WS_META) + l * 1024;
    const int* EIDX = (const int*)(p.ws + WS_EIDX); const float* EW = (const float*)(p.ws + WS_EW); const int* EPOS = (const int*)(p.ws + WS_EPOS);
    int* SASG = (int*)(p.ws + WS_SASG); float* SW = (float*)(p.ws + WS_SW);
    if (tid < 64) S[128 + tid] = (int)cnt[tid];
    __syncthreads();
    if (tid == 0) { int s = 0; for (int e = 0; e < 64; ++e) { S[e] = s; s += (S[128 + e] + 255) / 256 * 256; } S[64] = s; }
    __syncthreads();
    const int ntok = l == 0 ? NTOK : NLAT;
    for (int a = bid_here() * NTHREADS + tid; a < ntok * 8; a += gridDim.x * NTHREADS) { const int e = EIDX[a], pos = S[e] + EPOS[a]; SASG[pos] = a; SW[pos] = EW[a]; }
    for (int i = bid_here() * NTHREADS + tid; i < 64 * 256; i += gridDim.x * NTHREADS) { const int e = i >> 8, q = i & 255, c = S[128 + e]; if (S[e] + c + q < S[e + 1]) { SASG[S[e] + c + q] = -1; SW[S[e] + c + q] = 0.f; } }
    if (blockIdx.x == 0) {
        if (tid == 0) META[0] = S[64] / 256;
        if (tid < 64) { for (int t = S[tid] / 256; t < S[tid + 1] / 256; ++t) META[256 + t] = tid; }
    }
}

struct OrderXcd {
    int nM, nN, nwg;
    DI void init(int nM_, int nN_) { nM = nM_; nN = nN_; nwg = nM_ * nN_; }
    DI bool map(int i, int& pm, int& pn) const {
        const int L = i * (int)gridDim.x + (int)blockIdx.x; if (L >= nwg) return false;
        int wgid = L; { const int q = nwg / 8, r = nwg % 8, xcd = wgid % 8, off = wgid / 8; wgid = (xcd < r ? xcd * (q + 1) : r * (q + 1) + (xcd - r) * q) + off; }
        const int nig = 8 * nN, gid = wgid / nig, fm = gid * 8, gsz = (nM - fm) < 8 ? (nM - fm) : 8;
        pm = fm + ((wgid % nig) % gsz); pn = (wgid % nig) / gsz; return true;
    }
    DI bool lin(int i, int& w) const {
        const int L = i * (int)gridDim.x + (int)blockIdx.x; if (L >= nwg) return false;
        const int q = nwg / 8, r = nwg % 8, xcd = L % 8, off = L / 8; w = (xcd < r ? xcd * (q + 1) : r * (q + 1) + (xcd - r) * q) + off; return true;
    }
};
#define GACC const f32x4 (&acc)[2][2][4][2]
struct SchedInproj {
    static constexpr bool PERM = true;
    int lda, ldb, K, rowshift; const char* A; const char* W; bf16_t* proj; OrderXcd o;
    DI bool next(int i, pg::XUnit& u) const { int pm, pn; if (!o.map(i, pm, pn)) return false; u.A = A; u.B = W + (size_t)pn * 256 * ldb; u.arow0 = pm * 256; u.list = -1; u.e0 = pm * 256; u.e1 = pn * 256; return true; }
    DI void epi(GACC, const pg::XUnit& u, int wr, int wc, int fr, int fq) const { EpiB16P E; E.O = proj; E.row0 = u.e0; E.col0 = u.e1; E.ld = INWP; E(acc, wr, wc, fr, fq); }
};
DI void phase_inproj(PR p, int l, char* lds) {
    SchedInproj S; S.lda = D * 2; S.ldb = D * 2; S.K = D; S.rowshift = 0; S.A = (const char*)(p.ws + WS_HBUF); S.W = (const char*)(p.ws + WS_WEIGHTS + (size_t)l * WL_END + WL_WIN);
    S.proj = (bf16_t*)(p.ws + WS_U + U_PROJ); S.o.init(68, 15);
    pg::gemm_phase((LAS unsigned char*)lds, (const LAS int*)(lds + pg::STAGE_BYTES), S);
}
struct SchedMlaUp {
    static constexpr bool PERM = false;
    int lda, ldb, K, rowshift; const char* CQ; const char* CKV; const char* WQ; const char* WKV; bf16_t* Qm; bf16_t* Km; bf16_t* Vm; const float2* ropem; OrderXcd o;
    DI bool next(int i, pg::XUnit& u) const { int w; if (!o.lin(i, w)) return false; u.list = -1;
        if (w < 340) { const int pm = w / 5, pn = w % 5; u.A = CQ; u.B = WQ + (size_t)pn * 256 * ldb; u.arow0 = pm * 256; u.e0 = pm * 256; u.e1 = pn * 256; u.e3 = 0; }
        else { const int v = w - 340, pm = v / 6, pn = v % 6; u.A = CKV; u.B = WKV + (size_t)pn * 256 * ldb; u.arow0 = pm * 256; u.e0 = pm * 256; u.e1 = pn * 256; u.e3 = 1; }
        return true; }
    DI void epi(GACC, const pg::XUnit& u, int wr, int wc, int fr, int fq) const {
        if (u.e3 == 0) { EpiUq E; E.Q = Qm; E.ropem = ropem; E.row0 = u.e0; E.col0 = u.e1; E(acc, wr, wc, fr, fq); }
        else { EpiUkv E; E.Km = Km; E.Vm = Vm; E.row0 = u.e0; E.col0 = u.e1; E(acc, wr, wc, fr, fq); } }
};
DI void phase_mla_up(PR p, int l, char* lds) {
    unsigned char* U = p.ws + WS_U; const unsigned char* wl = p.ws + WS_WEIGHTS + (size_t)l * WL_END;
    SchedMlaUp S; S.lda = 1024; S.ldb = 1024; S.K = 512; S.rowshift = 0; S.CQ = (const char*)(U + U_CQN); S.CKV = (const char*)(U + U_CKVN); S.WQ = (const char*)(wl + WL_WUQ); S.WKV = (const char*)(wl + WL_WUKV);
    S.Qm = (bf16_t*)(U + U_QM); S.Km = (bf16_t*)(U + U_KM); S.Vm = (bf16_t*)(U + U_VM); S.ropem = (const float2*)(p.ws + WS_ROPEM); S.o.init(748, 1);
    pg::gemm_phase((LAS unsigned char*)lds, (const LAS int*)(lds + pg::STAGE_BYTES), S);
}
struct SchedOutproj {
    static constexpr bool PERM = true;
    int lda, ldb, K, rowshift; const char* A; const char* W; bf16_t* Y; OrderXcd o;
    DI bool next(int i, pg::XUnit& u) const { int pm, pn; if (!o.map(i, pm, pn)) return false; u.A = A; u.B = W + (size_t)pn * 256 * ldb; u.arow0 = pm * 256; u.list = -1; u.e0 = pm * 256; u.e1 = pn * 256; return true; }
    DI void epi(GACC, const pg::XUnit& u, int wr, int wc, int fr, int fq) const { EpiB16P E; E.O = Y; E.row0 = u.e0; E.col0 = u.e1; E.ld = D; E(acc, wr, wc, fr, fq); }
};
DI void phase_outproj(PR p, int l, char* lds) {
    SchedOutproj S; S.lda = D * 2; S.ldb = D * 2; S.K = D; S.rowshift = 0; S.A = (const char*)(p.ws + WS_U + U_MIX); S.W = (const char*)(p.ws + WS_WEIGHTS + (size_t)l * WL_END + WL_WOUT);
    S.Y = (bf16_t*)(p.ws + WS_U + U_Y); S.o.init(l == 0 ? 68 : 64, 8);
    pg::gemm_phase((LAS unsigned char*)lds, (const LAS int*)(lds + pg::STAGE_BYTES), S);
}
struct SchedMoe1 {
    static constexpr bool PERM = true;
    int lda, ldb, K, rowshift; const char* H; const char* W13; bf16_t* act; const LAS int* uexp; int ntiles; OrderXcd o;
    DI bool next(int i, pg::XUnit& u) const { int tile, pn; if (!o.map(i, tile, pn)) return false; u.A = H;
        if (tile < ntiles) { const int e = __builtin_amdgcn_readfirstlane(uexp[i]); u.B = W13 + ((size_t)e * 1024 + pn * 256) * ldb; u.list = i * 256; u.arow0 = 0; u.e0 = tile * 256; }
        else { const int ts = tile - ntiles; u.B = W13 + ((size_t)64 * 1024 + pn * 256) * ldb; u.list = -1; u.arow0 = ts * 256; u.e0 = PMAX + ts * 256; }
        u.e1 = pn * 128; return true; }
    DI void epi(GACC, const pg::XUnit& u, int wr, int wc, int fr, int fq) const { EpiMoe1P E; E.act = act; E.arow0 = u.e0; E.hcol0 = u.e1; E(acc, wr, wc, fr, fq); }
};
DI void phase_moe1(PR p, int l, char* lds) {
    const int* META = (const int*)(p.ws + WS_META) + l * 1024; const int ntiles = __builtin_amdgcn_readfirstlane(META[0]), nsh = l == 0 ? 68 : 64;
    SchedMoe1 S; S.lda = D * 2; S.ldb = D * 2; S.K = D; S.rowshift = 3; S.H = (const char*)(p.ws + WS_HBUF); S.W13 = (const char*)(p.ws + WS_WEIGHTS + (size_t)l * WL_END + WL_W13);
    S.act = (bf16_t*)(p.ws + WS_U + U_ACT); S.uexp = (const LAS int*)(lds + pg::STAGE_BYTES) + 31 * 256; S.ntiles = ntiles; S.o.init(ntiles + nsh, 4);
    { const int tid = tid_here(); LAS int* RL = (LAS int*)(lds + pg::STAGE_BYTES); const int* SASG = (const int*)(p.ws + WS_SASG);
      for (int i = 0; i < 31; ++i) { int tile, pn; if (!S.o.map(i, tile, pn)) break; if (tile < ntiles && tid < 256) RL[i * 256 + tid] = SASG[tile * 256 + tid];
          if (tid == 0) RL[31 * 256 + i] = tile < ntiles ? META[256 + tile] : 64; }
      __syncthreads(); }
    pg::gemm_phase((LAS unsigned char*)lds, (const LAS int*)(lds + pg::STAGE_BYTES), S);
}
struct SchedMoe2 {
    static constexpr bool PERM = true;
    int lda, ldb, K, rowshift; const char* ACT; const char* W2; bf16_t* oasg; const int* sasg; const float* sw; bf16_t* ysh; const LAS int* uexp; int ntiles; OrderXcd o;
    DI bool next(int i, pg::XUnit& u) const { int tile, pn; if (!o.map(i, tile, pn)) return false; u.A = ACT; u.list = -1;
        if (tile < ntiles) { const int e = __builtin_amdgcn_readfirstlane(uexp[i]); u.B = W2 + ((size_t)e * D + pn * 256) * ldb; u.arow0 = tile * 256; u.e0 = tile * 256; u.e3 = 0; }
        else { const int ts = tile - ntiles; u.B = W2 + ((size_t)64 * D + pn * 256) * ldb; u.arow0 = PMAX + ts * 256; u.e0 = ts * 256; u.e3 = 1; }
        u.e1 = pn * 256; return true; }
    DI void epi(GACC, const pg::XUnit& u, int wr, int wc, int fr, int fq) const {
        if (u.e3 == 0) { EpiMoe2P E; E.oasg = oasg; E.sasg = sasg; E.sw = sw; E.srow0 = u.e0; E.col0 = u.e1; E(acc, wr, wc, fr, fq); }
        else { EpiB16P E; E.O = ysh; E.row0 = u.e0; E.col0 = u.e1; E.ld = D; E(acc, wr, wc, fr, fq); } }
};
DI void phase_moe2(PR p, int l, char* lds) {
    const int* META = (const int*)(p.ws + WS_META) + l * 1024; const int ntiles = __builtin_amdgcn_readfirstlane(META[0]), nsh = l == 0 ? 68 : 64;
    SchedMoe2 S; S.lda = 1024; S.ldb = 1024; S.K = 512; S.rowshift = 0; S.ACT = (const char*)(p.ws + WS_U + U_ACT); S.W2 = (const char*)(p.ws + WS_WEIGHTS + (size_t)l * WL_END + WL_W2);
    S.oasg = (bf16_t*)(p.ws + WS_U + U_OASG); S.sasg = (const int*)(p.ws + WS_SASG); S.sw = (const float*)(p.ws + WS_SW); S.ysh = (bf16_t*)(p.ws + WS_U + U_YSH); S.uexp = (const LAS int*)(lds + pg::STAGE_BYTES); S.ntiles = ntiles; S.o.init(ntiles + nsh, 8);
    { const int tid = tid_here(); LAS int* UE = (LAS int*)(lds + pg::STAGE_BYTES);
      if (tid < 64) { int tile, pn; if (S.o.map(tid, tile, pn)) UE[tid] = tile < ntiles ? META[256 + tile] : 64; }
      __syncthreads(); }
    pg::gemm_phase((LAS unsigned char*)lds, (const LAS int*)(lds + pg::STAGE_BYTES), S);
}
DI void phase_attention(PR p, int l, char* lds) {
#define ATT_PTRS unsigned char* U = p.ws + WS_U; asm volatile("" : "+s"(U)); \
    const bf16_t* Qm = (const bf16_t*)(U + U_QM); const bf16_t* Km = (const bf16_t*)(U + U_KM); const bf16_t* Vm = (const bf16_t*)(U + U_VM); \
    const bf16_t* Qg = (const bf16_t*)(U + U_QG); const bf16_t* Kg = (const bf16_t*)(U + U_KG); const bf16_t* Vg = (const bf16_t*)(U + U_VG); bf16_t* MIX = (bf16_t*)(U + U_MIX);
    const int xcd = blockIdx.x & 7, rank = blockIdx.x >> 3, nr = (gridDim.x + 7 - xcd) >> 3;
    const int nloc = 48 + (l == 0 ? 3 : 0);
    if (SUB & 1) for (int v = rank; v < nloc; v += nr) {
        ATT_PTRS; (void)Qg; (void)Kg; (void)Vg;
        int b, h, qt, isctx;
        if (v < 48) { const int bh = xcd * 3 + v / 16; b = bh / 6; h = bh % 6; qt = v & 15; isctx = 0; } else { const int bh = xcd * 3 + (v - 48); b = bh / 6; h = bh % 6; qt = 0; isctx = 1; }
        const int qpos = isctx ? 0 : CTXL + qt * 256, seq = isctx ? CTXL : SKV, orow = isctx ? NLAT + b * CTXL : b * SEQ + qt * 256;
        attn_body<192, ATT_SD_M>(Qm + (((size_t)b * 6 + h) * SKV + qpos) * 192, Km + ((size_t)b * 6 + h) * SKV * 192, Vm + ((size_t)b * 6 + h) * SKV * 128,
                                 MIX + (size_t)orow * D + 512 + h * 128, D, seq, lds, 0.07216878364870322f);
    }
    if (SUB & 2) for (int v = nr - 1 - rank; v < nloc; v += nr) {
        ATT_PTRS; (void)Qm; (void)Km; (void)Vm;
        int b, h, qt, isctx; const int kvh = xcd & 1; b = xcd >> 1;
        if (v < 48) { h = kvh * 3 + v / 16; qt = v & 15; isctx = 0; } else { h = kvh * 3 + (v - 48); qt = 0; isctx = 1; }
        const int qpos = isctx ? 0 : CTXL + qt * 256, seq = isctx ? CTXL : SKV, orow = isctx ? NLAT + b * CTXL : b * SEQ + qt * 256;
        attn_body<128, ATT_SD_G>(Qg + (((size_t)b * 6 + h) * SKV + qpos) * 128, Kg + ((size_t)b * 2 + kvh) * SKV * 128, Vg + ((size_t)b * 2 + kvh) * SKV * 128,
                                 MIX + (size_t)orow * D + 1280 + h * 128, D, seq, lds, 0.08838834764831845f);
    }
#undef ATT_PTRS
    if (SUB & 4) gla_phaseC(p, l, lds);
}

constexpr int NPH_LAYER = 12, NPH = 1 + 2 * NPH_LAYER;
constexpr int LDS_BYTES = 160 * 1024;
__global__ void __launch_bounds__(NTHREADS, 2) fwd(Params p_arg, int ph_lo, int ph_hi) {
    extern __shared__ __attribute__((aligned(16))) char shm[];
    char* lds = shm + 256;
    volatile LAS unsigned* xbw = (volatile LAS unsigned*)shm;
    const bool fused = (ph_hi - ph_lo) > 1;
    XcdBarrier bar; bar.bar = (unsigned*)(p_arg.ws + WS_BAR); bar.x = 0; bar.st = xbw;
    if (fused) {
        if (threadIdx.x == 0) { xbw[0] = 0u; xbw[1] = 0u; xbw[2] = 0u; xbw[3] = 0u; }
        __syncthreads();
        bar = xcd_barrier_post((unsigned*)(p_arg.ws + WS_BAR), xbw);
    }
    const CAS Params* pk = (const CAS Params*)__builtin_amdgcn_kernarg_segment_ptr();
#define PHASE(idx, CALL) do { if (((PH_MASK >> ((idx) == 0 ? 0 : ((idx) - 1) % NPH_LAYER + 1)) & 1) && (idx) >= ph_lo && (idx) < ph_hi) { const CAS Params* q_ = pk; asm volatile("" : "+s"(q_)); PR p = *q_; int probe_pass = 0; (void)probe_pass; CALL; if ((PROBE_MASK >> ((idx) == 0 ? 0 : ((idx) - 1) % NPH_LAYER + 1)) & 1) { probe_pass = 1; CALL; } if (fused && (idx) + 1 < ph_hi) xcd_barrier(bar); } } while (0)
    PHASE(0, phase_prologue(p, lds));
    for (int l = 0; l < 2; ++l) {
        const int b0 = 1 + l * NPH_LAYER;
        if (l == 0) PHASE(b0 + 0, phase_norm1(p, 0));
        PHASE(b0 + 1, phase_inproj(p, l, lds));
        PHASE(b0 + 2, (phase_postproj_rows(p, l), gla_phaseA(p, l, lds)));
        PHASE(b0 + 3, (phase_mla_up(p, l, lds), gla_scan(p)));
        PHASE(b0 + 4, phase_attention(p, l, lds));
        PHASE(b0 + 5, phase_outproj(p, l, lds));
        PHASE(b0 + 6, ((probe_pass && l == 1) ? (void)0 : phase_postmix(p, l)));
        PHASE(b0 + 7, (probe_pass ? (void)0 : phase_router(p, l, lds)));
        PHASE(b0 + 8, phase_moe_index(p, l, lds));
        PHASE(b0 + 9, phase_moe1(p, l, lds));
        PHASE(b0 + 10, phase_moe2(p, l, lds));
        PHASE(b0 + 11, ((probe_pass && l == 0) ? (void)0 : phase_postffn(p, l)));
    }
#undef PHASE
}

extern "C" void kernel_launch(void* const* d_in, const int* in_sizes, int n_in, void* d_out, int out_size, void* d_ws, size_t ws_size, hipStream_t stream) {
    static int grid = 0;
    if (!grid) {
        if (ws_size < WS_TOTAL) { fprintf(stderr, "kernel_launch: workspace too small: %zu < %zu\n", ws_size, (size_t)WS_TOTAL); return; }
        if (hipFuncSetAttribute((const void*)fwd, hipFuncAttributeMaxDynamicSharedMemorySize, LDS_BYTES) != hipSuccess) { fprintf(stderr, "kernel_launch: hipFuncSetAttribute failed\n"); return; }
        int dev = 0, cus = 0, per_cu = 0;
        hipGetDevice(&dev);
        hipDeviceGetAttribute(&cus, hipDeviceAttributeMultiprocessorCount, dev);
        hipOccupancyMaxActiveBlocksPerMultiprocessor(&per_cu, fwd, NTHREADS, LDS_BYTES);
        if (per_cu < 1) { fprintf(stderr, "kernel_launch: occupancy query says %d\n", per_cu); return; }
        grid = cus;
    }
    Params p{};
    const float** f = (const float**)&p;
    for (int i = 0; i < 31; ++i) f[i] = (const float*)d_in[i];
    p.out = (float*)d_out; p.ws = (unsigned char*)d_ws;
    hipMemsetAsync((unsigned char*)d_ws + WS_BAR, 0, XCD_BAR_WORDS * sizeof(unsigned), stream);
#if MK_MULTI
    for (int ph = 0; ph < NPH; ++ph) { if (ph == 1 + NPH_LAYER) continue; hipLaunchKernelGGL(fwd, dim3(grid), dim3(NTHREADS), LDS_BYTES, stream, p, ph, ph + 1); }
#else
    hipLaunchKernelGGL(fwd, dim3(grid), dim3(NTHREADS), LDS_BYTES, stream, p, 0, NPH);
#endif
    const hipError_t le = hipPeekAtLastError();
    if (le != hipSuccess) fprintf(stderr, "kernel_launch: launch failed: %s\n", hipGetErrorName(le));
}
```

```cpp
#include <hip/hip_runtime.h>
#include <stdint.h>
#include <stdio.h>

#ifndef PH_MASK
#define PH_MASK 0x1FFF
#endif
#ifndef SUB
#define SUB 7
#endif
#ifndef ATT_SD_M
#define ATT_SD_M 1
#endif
#ifndef ATT_SD_G
#define ATT_SD_G 2
#endif
#ifndef ATT_NQR_M
#define ATT_NQR_M 12
#endif
#ifndef PROBE_MASK
#define PROBE_MASK 0x0
#endif
#ifndef MK_MULTI
#define MK_MULTI 0
#endif

typedef unsigned short bf16_t;
typedef short bf16x8 __attribute__((ext_vector_type(8)));
typedef short s16x4 __attribute__((ext_vector_type(4)));
typedef float f32x4 __attribute__((ext_vector_type(4)));
typedef float f32x16 __attribute__((ext_vector_type(16)));
typedef unsigned u32x4 __attribute__((ext_vector_type(4)));
typedef unsigned u32x2 __attribute__((ext_vector_type(2)));
#define DI __device__ __forceinline__

constexpr int D = 2048, NB = 4, SEQ = 4096, CTXL = 256, NLAT = NB * SEQ, NCTX = NB * CTXL, NTOK = NLAT + NCTX, SKV = SEQ + CTXL;
constexpr int INW = 3808, INWP = 3840;
constexpr int C_GQ = 0, C_GK = 256, C_GV = 512, C_GG = 1024, C_ZF = 1536, C_ZB = 1552, C_CQ = 1568, C_CKV = 1952, C_KR = 2464, C_AQ = 2528, C_AK = 3296, C_AV = 3552;
constexpr int NE = 64, TOPK = 8, DEXP = 512;
constexpr int PMAX = NTOK * TOPK + NE * 256;
constexpr int NTHREADS = 512;
constexpr float EPS = 1e-6f;

constexpr size_t MiB = 1024ull * 1024ull;
constexpr size_t al256(size_t x) { return (x + 255) / 256 * 256; }
constexpr size_t WS_BAR = 0;
constexpr size_t WS_CTL = 16384;
constexpr size_t WS_CNT = 16384 + 8192;
constexpr size_t WS_META = WS_CNT + 1024;
constexpr size_t WS_MOD = WS_META + 2 * 4096;
constexpr size_t WS_ROPEG = al256(WS_MOD + 2 * 5 * 12288 * 4);
constexpr size_t WS_ROPEM = WS_ROPEG + 64 * 32 * 8;
constexpr size_t WS_ZROW = WS_ROPEM + 64 * 16 * 8;
constexpr size_t WS_GDEC = WS_ZROW + 4096;
constexpr size_t WS_EIDX = al256(WS_GDEC + 2 * 16 * 68 * 64 * 4);
constexpr size_t WS_EW = WS_EIDX + (size_t)NTOK * 8 * 4;
constexpr size_t WS_EPOS = WS_EW + (size_t)NTOK * 8 * 4;
constexpr size_t WS_SASG = WS_EPOS + (size_t)NTOK * 8 * 4;
constexpr size_t WS_SW = al256(WS_SASG + (size_t)PMAX * 4);
constexpr size_t WS_SMALL_END = al256(WS_SW + (size_t)PMAX * 4);
static_assert(WS_SMALL_END <= 8 * MiB, "small region");
constexpr size_t SZ_WIN = (size_t)INWP * D * 2, SZ_WUQ = (size_t)1280 * 512 * 2, SZ_WUKV = (size_t)1536 * 512 * 2, SZ_WOUT = (size_t)D * D * 2, SZ_WR = (size_t)64 * D * 2;
constexpr size_t SZ_W13 = (size_t)65 * 1024 * D * 2, SZ_W2 = (size_t)65 * D * 512 * 2;
constexpr size_t WL_WIN = 0, WL_WUQ = WL_WIN + SZ_WIN, WL_WUKV = WL_WUQ + SZ_WUQ, WL_WOUT = WL_WUKV + SZ_WUKV, WL_WRH = WL_WOUT + SZ_WOUT, WL_WRL = WL_WRH + SZ_WR,
                 WL_W13 = WL_WRL + SZ_WR, WL_W2 = WL_W13 + SZ_W13, WL_END = WL_W2 + SZ_W2;
constexpr size_t WS_WEIGHTS = 8 * MiB;
constexpr size_t WS_XRES = WS_WEIGHTS + 2 * WL_END;
constexpr size_t WS_HBUF = WS_XRES + (size_t)NTOK * D * 4;
constexpr size_t WS_U = WS_HBUF + (size_t)NTOK * D * 2;
constexpr size_t U_Y = 0;
constexpr size_t U_YSH = (size_t)NTOK * D * 2;
constexpr size_t U_PROJ = U_Y + (size_t)NTOK * D * 4;
constexpr size_t U_QM = U_PROJ + (size_t)NTOK * INWP * 2;
constexpr size_t U_KM = U_QM + (size_t)NB * 6 * SKV * 192 * 2;
constexpr size_t U_VM = U_KM + (size_t)NB * 6 * SKV * 192 * 2;
constexpr size_t U_QG = U_VM + (size_t)NB * 6 * SKV * 128 * 2;
constexpr size_t U_KG = U_QG + (size_t)NB * 6 * SKV * 128 * 2;
constexpr size_t U_VG = U_KG + (size_t)NB * 2 * SKV * 128 * 2;
constexpr size_t U_GS = U_VG + (size_t)NB * 2 * SKV * 128 * 2;
constexpr size_t U_MIX = U_GS + (size_t)2 * 16 * 68 * 64 * 128 * 4;
constexpr size_t U_CQN = U_MIX + (size_t)NTOK * D * 2;
constexpr size_t U_CKVN = U_CQN + (size_t)NTOK * 512 * 2;
constexpr size_t U_GST = U_CKVN + (size_t)NTOK * 512 * 2;
constexpr size_t U_MIX_END = U_GST + (size_t)2 * 16 * 68 * 8192 * 2;
constexpr size_t U_HLO = U_PROJ;
constexpr size_t U_ACT = U_HLO + (size_t)NTOK * D * 2;
constexpr size_t U_OASG = U_ACT + (size_t)(PMAX + NTOK) * 512 * 2;
constexpr size_t U_MOE_END = U_OASG + (size_t)NTOK * 8 * D * 2;
constexpr size_t WS_TOTAL = WS_U + (U_MIX_END > U_MOE_END ? U_MIX_END : U_MOE_END);
static_assert(WS_TOTAL <= 2048ull * MiB, "workspace over 2 GiB");

struct Params {
    const float *x, *c, *ctx, *c_ctx, *w_mod, *b_mod, *g_pre_mix, *g_post_mix, *g_pre_ffn, *g_post_ffn, *w_in, *gla_wg2_f, *gla_bg_f, *gla_wg2_b, *gla_bg_b, *gla_g_out,
        *mla_g_q, *mla_w_uq, *mla_g_kv, *mla_w_ukv, *gqa_g_q, *gqa_g_k, *w_out, *router_w, *router_b, *exp_w1, *exp_w3, *exp_w2, *sh_w1, *sh_w3, *sh_w2;
    float* out; unsigned char* ws;
};

extern __shared__ __attribute__((aligned(16))) char shm[];
#define CAS __attribute__((address_space(4)))
typedef const CAS Params& PR;
DI int bid_here() { int b = blockIdx.x; asm volatile("" : "+s"(b)); return b; }
DI int tid_here() { int t = threadIdx.x; asm volatile("" : "+v"(t)); return t; }
DI float bf2f(bf16_t v) { return __uint_as_float(((unsigned)v) << 16); }
DI bf16_t f2bf(float f) { unsigned u = __float_as_uint(f); u += 0x7FFFu + ((u >> 16) & 1u); return (bf16_t)(u >> 16); }
DI unsigned pk2(float lo, float hi) { unsigned r; asm("v_cvt_pk_bf16_f32 %0, %1, %2" : "=v"(r) : "v"(lo), "v"(hi)); return r; }
DI float shx(float v, int o, int lane) { return __int_as_float(__builtin_amdgcn_ds_bpermute((lane ^ o) << 2, __float_as_int(v))); }
DI float wave_sum(float v) {
    const int lane = tid_here() & 63;
#pragma unroll
    for (int o = 32; o > 0; o >>= 1) v += shx(v, o, lane);
    return v;
}
DI float silu_f(float v) { return v / (1.f + __expf(-v)); }
DI float sigmoid_f(float v) { return 1.f / (1.f + __expf(-v)); }
struct Tok { int b, s, isctx, mrow, kvpos; };
DI Tok tok_of(int r) { Tok t; if (r < NLAT) { t.b = r >> 12; t.s = r & 4095; t.isctx = 0; t.mrow = t.b; t.kvpos = CTXL + t.s; } else { const int q = r - NLAT; t.b = q >> 8; t.s = q & 255; t.isctx = 1; t.mrow = 4; t.kvpos = t.s; } return t; }
DI const float* xrow_in(PR p, int l, int r) { if (l == 0) return r < NLAT ? p.x + (size_t)r * D : p.ctx + (size_t)(r - NLAT) * D; return (const float*)(p.ws + WS_XRES) + (size_t)r * D; }

#define XB_TMO      128
#define XB_XCNT(j)  (256  + 64 * (j))
#define XB_XSUB(j)  (1280 + 64 * (j))
#define XB_XGEN(j)  (2304 + 64 * (j))
#define XB_TOP      3328
#define XB_TOPGEN   3392
#define XCD_BAR_WORDS 3456
#define XB_SPIN_CAP (1u << 18)
#define LAS __attribute__((address_space(3)))
__device__ __forceinline__ unsigned xb_ld(unsigned* p)              { return __hip_atomic_load(p, __ATOMIC_RELAXED, __HIP_MEMORY_SCOPE_AGENT); }
__device__ __forceinline__ unsigned xb_add(unsigned* p, unsigned v) { return __hip_atomic_fetch_add(p, v, __ATOMIC_RELAXED, __HIP_MEMORY_SCOPE_AGENT); }
__device__ __forceinline__ unsigned xb_xcc_id() { return (unsigned)__builtin_amdgcn_s_getreg((3 << 11) | 20) & 0xFu; }
#define XB_SPIN(cond, bar) do { unsigned _sp = 0; while (cond) { __builtin_amdgcn_s_sleep(1); \
    if ((++_sp & 255u) == 0u) { if (xb_ld(&(bar)[XB_TMO])) break; if (_sp > XB_SPIN_CAP) { atomicAdd(&(bar)[XB_TMO], 1u); break; } } } } while (0)
struct XcdBarrier { unsigned* bar; unsigned x; volatile LAS unsigned* st; };
__device__ __forceinline__ XcdBarrier xcd_barrier_post(unsigned* bar, volatile LAS unsigned* st) {
    XcdBarrier b; b.bar = bar; b.x = xb_xcc_id(); b.st = st;
    if (threadIdx.x == 0) (void)xb_add(&bar[XB_XCNT(b.x)], 1u);
    return b;
}
__device__ __forceinline__ void xcd_barrier_complete(unsigned* bar, unsigned x, unsigned& nloc, unsigned& nx) {
    const unsigned G = gridDim.x * gridDim.y * gridDim.z;
    unsigned sum, cnt, mine, sp = 0u;
    for (;;) {
        sum = 0u; cnt = 0u; mine = 0u;
#pragma unroll
        for (unsigned j = 0; j < 16; ++j) { const unsigned c = xb_ld(&bar[XB_XCNT(j)]); sum += c; cnt += (c > 0u) ? 1u : 0u; mine = (j == x) ? c : mine; }
        if (sum == G) break;
        __builtin_amdgcn_s_sleep(1);
        if ((++sp & 255u) == 0u) { if (xb_ld(&bar[XB_TMO])) break; if (sp > XB_SPIN_CAP) { atomicAdd(&bar[XB_TMO], 1u); break; } }
    }
    nloc = mine > 0u ? mine : 1u; nx = cnt > 0u ? cnt : 1u;
}
__device__ __forceinline__ void xcd_barrier(const XcdBarrier& b) {
    asm volatile("s_waitcnt vmcnt(0)" ::: "memory");
    __syncthreads();
    if (threadIdx.x == 0) {
        unsigned* bar = b.bar;
        __builtin_amdgcn_s_waitcnt(0);
        unsigned nloc = b.st[0], nx = b.st[1];
        if (nloc == 0u) { xcd_barrier_complete(bar, b.x, nloc, nx); b.st[0] = nloc; b.st[1] = nx; }
        const unsigned old = xb_add(&bar[XB_XSUB(b.x)], 1u);
        const unsigned gen = old / nloc;
        if (old + 1u == (gen + 1u) * nloc) {
            __builtin_amdgcn_fence(__ATOMIC_RELEASE, "agent");
            asm volatile("s_waitcnt vmcnt(0)" ::: "memory");
            const unsigned og = xb_add(&bar[XB_TOP], 1u);
            const unsigned tg = og / nx;
            if (og + 1u == (tg + 1u) * nx) xb_add(&bar[XB_TOPGEN], 1u);
            else XB_SPIN(xb_ld(&bar[XB_TOPGEN]) == tg, bar);
            __builtin_amdgcn_fence(__ATOMIC_ACQUIRE, "agent");
            xb_add(&bar[XB_XGEN(b.x)], 1u);
            asm volatile("s_waitcnt vmcnt(0)" ::: "memory");
        } else {
            XB_SPIN(xb_ld(&bar[XB_XGEN(b.x)]) == gen, bar);
            __builtin_amdgcn_fence(__ATOMIC_ACQUIRE, "agent");
            asm volatile("s_waitcnt vmcnt(0)" ::: "memory");
        }
    }
    __syncthreads();
}

template <int KT>
DI void cvt_tile(char* lds, const float* src, int ldS, int Nvalid, bf16_t* dst, bf16_t* dst_lo, int ldD, int k0, int n0, int drow0, const float* gk) {
    float* T = (float*)lds;
    const int tid = tid_here();
    {
        const int c4 = tid & 15, kr = tid >> 4, n = n0 + c4 * 4;
        f32x4 v[KT / 32];
#pragma unroll
        for (int i = 0; i < KT / 32; ++i) { v[i] = (f32x4){0.f, 0.f, 0.f, 0.f}; if (n < Nvalid) v[i] = *(const f32x4*)(src + (size_t)(k0 + kr + 32 * i) * ldS + n); }
#pragma unroll
        for (int i = 0; i < KT / 32; ++i) { const int k = kr + 32 * i; if (gk) v[i] = v[i] * gk[k0 + k];
            T[k * 65 + c4 * 4 + 0] = v[i][0]; T[k * 65 + c4 * 4 + 1] = v[i][1]; T[k * 65 + c4 * 4 + 2] = v[i][2]; T[k * 65 + c4 * 4 + 3] = v[i][3]; }
    }
    __syncthreads();
    {
        constexpr int KPL = KT / 8;
        const int nl = tid >> 3, kc = (tid & 7) * KPL;
#pragma unroll
        for (int q = 0; q < KPL / 8; ++q) {
            float v[8];
#pragma unroll
            for (int j = 0; j < 8; ++j) v[j] = T[(kc + q * 8 + j) * 65 + nl];
            u32x4 w; w.x = pk2(v[0], v[1]); w.y = pk2(v[2], v[3]); w.z = pk2(v[4], v[5]); w.w = pk2(v[6], v[7]);
            *(u32x4*)(dst + (size_t)(drow0 + nl) * ldD + k0 + kc + q * 8) = w;
            if (dst_lo) {
                float r[8];
#pragma unroll
                for (int j = 0; j < 8; ++j) r[j] = v[j] - bf2f(f2bf(v[j]));
                u32x4 w2; w2.x = pk2(r[0], r[1]); w2.y = pk2(r[2], r[3]); w2.z = pk2(r[4], r[5]); w2.w = pk2(r[6], r[7]);
                *(u32x4*)(dst_lo + (size_t)(drow0 + nl) * ldD + k0 + kc + q * 8) = w2;
            }
        }
    }
    __syncthreads();
}
template <int KT>
DI void cvt_matrix(char* lds, const float* src, int K, int N, int Npad, bf16_t* dst, bf16_t* dst_lo, int mode, const float* gk, int ldD = 0) {
    if (ldD == 0) ldD = K;
    const int nkt = K / KT, nnt = Npad / 64, nt = nkt * nnt;
    for (int t = bid_here(); t < nt; t += gridDim.x) {
        const int kt = t % nkt, ntile = t / nkt, n0 = ntile * 64;
        int drow0 = n0;
        if (mode == 1) drow0 = (n0 >> 7) * 256 + (n0 & 127);
        else if (mode == 2) drow0 = (n0 >> 7) * 256 + 128 + (n0 & 127);
        cvt_tile<KT>(lds, src, N, N, dst, dst_lo, ldD, kt * KT, n0, drow0, gk);
    }
}
constexpr int CHUNKS_PER_LAYER = 65 * 192, CHUNKS_TOTAL = 2 * CHUNKS_PER_LAYER;
DI void cvt_chunk(PR p, char* lds, int g) {
    const int l = g / CHUNKS_PER_LAYER, gg = g % CHUNKS_PER_LAYER;
    unsigned char* wl = p.ws + WS_WEIGHTS + (size_t)l * WL_END;
    const int e = gg / 192, r = gg % 192, m = r >> 6, t = r & 63;
    bf16_t* d13 = (bf16_t*)(wl + WL_W13) + (size_t)e * 1024 * D; bf16_t* d2 = (bf16_t*)(wl + WL_W2) + (size_t)e * D * 512;
    if (m < 2) {
        const float* src = m == 0 ? (e < 64 ? p.exp_w1 + ((size_t)l * 64 + e) * D * 512 : p.sh_w1 + (size_t)l * D * 512) : (e < 64 ? p.exp_w3 + ((size_t)l * 64 + e) * D * 512 : p.sh_w3 + (size_t)l * D * 512);
        const int kt = t & 7, n0 = (t >> 3) * 64, drow0 = (n0 >> 7) * 256 + m * 128 + (n0 & 127);
        cvt_tile<256>(lds, src, 512, 512, d13, nullptr, D, kt * 256, n0, drow0, nullptr);
    } else {
        const float* src = e < 64 ? p.exp_w2 + ((size_t)l * 64 + e) * 512 * D : p.sh_w2 + (size_t)l * 512 * D;
        const int kt = t & 1, n0 = (t >> 1) * 64;
        cvt_tile<256>(lds, src, D, D, d2, nullptr, 512, kt * 256, n0, n0, nullptr);
    }
}
#define CTL_LD(ptr) __hip_atomic_load((ptr), __ATOMIC_RELAXED, __HIP_MEMORY_SCOPE_AGENT)
#define CTL_ADD(ptr, v) __hip_atomic_fetch_add((ptr), (v), __ATOMIC_RELAXED, __HIP_MEMORY_SCOPE_AGENT)
DI void fill_tail(PR p, char* lds, int ph) {
    unsigned* ctl = (unsigned*)(p.ws + WS_CTL);
    volatile LAS int* flag = (volatile LAS int*)(shm + 16);
    const int tid = tid_here();
    __syncthreads();
    if (tid == 0) CTL_ADD(&ctl[64 * (1 + ph)], 1u);
    for (;;) {
        if (tid == 0) {
            int c = -1;
            if (CTL_LD(&ctl[64 * (1 + ph)]) + 8u < gridDim.x && CTL_LD(&ctl[0]) < (unsigned)CHUNKS_TOTAL) { c = (int)CTL_ADD(&ctl[0], 4u); if (c >= CHUNKS_TOTAL) c = -1; }
            *flag = c;
        }
        __syncthreads();
        const int c = __builtin_amdgcn_readfirstlane(*flag);
        __syncthreads();
        if (c < 0) break;
        for (int q = 0; q < 4; ++q) {
            if (c + q < CHUNKS_TOTAL) cvt_chunk(p, lds, c + q);
            if (q < 3 && __builtin_amdgcn_readfirstlane((int)CTL_LD(&ctl[64 * (1 + ph)])) >= (int)gridDim.x) { for (int q2 = q + 1; q2 < 4; ++q2) if (c + q2 < CHUNKS_TOTAL) cvt_chunk(p, lds, c + q2); break; }
        }
    }
}
DI void fill_drain(PR p, char* lds, int limit) {
    unsigned* ctl = (unsigned*)(p.ws + WS_CTL);
    const int h0 = __builtin_amdgcn_readfirstlane((int)CTL_LD(&ctl[0]));
    for (int c = h0 + bid_here(); c < limit; c += gridDim.x) cvt_chunk(p, lds, c);
}
DI void move_head(PR p, int limit) { if (blockIdx.x == 0 && tid_here() == 0) __hip_atomic_fetch_max((unsigned*)(p.ws + WS_CTL), (unsigned)limit, __ATOMIC_RELAXED, __HIP_MEMORY_SCOPE_AGENT); }
DI void phase_prologue(PR p, char* lds) {
    const int tid = tid_here();
    unsigned char* ws = p.ws;
    if (blockIdx.x == 0) {
        unsigned* cnt = (unsigned*)(ws + WS_CNT);
        if (tid < 128) cnt[tid] = 0u;
        unsigned* z = (unsigned*)(ws + WS_ZROW);
        for (int i = tid; i < 1024; i += NTHREADS) z[i] = 0u;
        float2* rg = (float2*)(ws + WS_ROPEG);
        for (int i = tid; i < 64 * 32; i += NTHREADS) { const int pos = i >> 5, f = i & 31; const float inv = powf(10000.f, -(float)(2 * f) / 64.f); float s, c; sincosf((float)pos * inv, &s, &c); rg[i] = make_float2(c, s); }
        float2* rm = (float2*)(ws + WS_ROPEM);
        for (int i = tid; i < 64 * 16; i += NTHREADS) { const int pos = i >> 4, f = i & 15; const float inv = powf(10000.f, -(float)(2 * f) / 32.f); float s, c; sincosf((float)pos * inv, &s, &c); rm[i] = make_float2(c, s); }
    }
    {
        float* sc = (float*)lds;
        float* red = sc + 5 * 2048;
        bool loaded = false;
        for (int u = bid_here(); u < 192; u += gridDim.x) {
            if (!loaded) { for (int i = tid; i < 5 * 2048; i += NTHREADS) { const int r = i >> 11, k = i & 2047; const float v = r < 4 ? p.c[r * 2048 + k] : p.c_ctx[k]; sc[i] = silu_f(v); } loaded = true; __syncthreads(); }
            const int l = u / 96, col0 = (u % 96) * 128;
            const int cg = tid & 31, kp = tid >> 5;
            f32x4 acc[5];
#pragma unroll
            for (int r = 0; r < 5; ++r) acc[r] = (f32x4){0.f, 0.f, 0.f, 0.f};
            const float* wb = p.w_mod + ((size_t)l * 2048) * 12288 + col0 + cg * 4;
            for (int kk = 0; kk < 128; ++kk) {
                const int k = kp * 128 + kk;
                const f32x4 w = *(const f32x4*)(wb + (size_t)k * 12288);
#pragma unroll
                for (int r = 0; r < 5; ++r) acc[r] += w * sc[r * 2048 + k];
            }
#pragma unroll
            for (int r = 0; r < 5; ++r)
#pragma unroll
                for (int j = 0; j < 4; ++j) red[(kp * 5 + r) * 128 + cg * 4 + j] = acc[r][j];
            __syncthreads();
            for (int i = tid; i < 640; i += NTHREADS) {
                const int r = i >> 7, cc = i & 127; float s = p.b_mod[l * 12288 + col0 + cc];
#pragma unroll
                for (int q = 0; q < 16; ++q) s += red[(q * 5 + r) * 128 + cc];
                ((float*)(ws + WS_MOD))[((size_t)l * 5 + r) * 12288 + col0 + cc] = s;
            }
            __syncthreads();
        }
        __syncthreads();
    }
    for (int l = 0; l < 2; ++l) {
        unsigned char* wl = ws + WS_WEIGHTS + (size_t)l * WL_END;
        cvt_matrix<256>(lds, p.w_in + (size_t)l * D * INW, D, INW, INWP, (bf16_t*)(wl + WL_WIN), nullptr, 0, nullptr);
        cvt_matrix<128>(lds, p.mla_w_uq + (size_t)l * 384 * 1152, 384, 1152, 1280, (bf16_t*)(wl + WL_WUQ), nullptr, 0, p.mla_g_q + l * 384, 512);
        for (int i = bid_here() * NTHREADS + tid; i < 1280 * 64; i += gridDim.x * NTHREADS) ((unsigned*)(wl + WL_WUQ))[(size_t)(i >> 6) * 256 + 192 + (i & 63)] = 0u;
        cvt_matrix<256>(lds, p.mla_w_ukv + (size_t)l * 512 * 1536, 512, 1536, 1536, (bf16_t*)(wl + WL_WUKV), nullptr, 0, p.mla_g_kv + l * 512);
        cvt_matrix<256>(lds, p.w_out + (size_t)l * D * D, D, D, D, (bf16_t*)(wl + WL_WOUT), nullptr, 0, nullptr);
        cvt_matrix<256>(lds, p.router_w + (size_t)l * D * 64, D, 64, 64, (bf16_t*)(wl + WL_WRH), (bf16_t*)(wl + WL_WRL), 0, nullptr);
    }
}

#ifndef OASG_FP8_MASK
#define OASG_FP8_MASK 3
#endif
constexpr float OASG_SCALE = 16.f;
DI void load_row(const float* src, f32x4 (&v)[4][2], int c0) {
#pragma unroll
    for (int i = 0; i < 4; ++i) { v[i][0] = *(const f32x4*)(src + i * 512 + c0); v[i][1] = *(const f32x4*)(src + i * 512 + c0 + 4); }
}
DI void unpack8(const u32x4 w, f32x4& a, f32x4& b) {
    a[0] = __uint_as_float(w.x << 16); a[1] = __uint_as_float(w.x & 0xFFFF0000u); a[2] = __uint_as_float(w.y << 16); a[3] = __uint_as_float(w.y & 0xFFFF0000u);
    b[0] = __uint_as_float(w.z << 16); b[1] = __uint_as_float(w.z & 0xFFFF0000u); b[2] = __uint_as_float(w.w << 16); b[3] = __uint_as_float(w.w & 0xFFFF0000u);
}
DI void load_row_bf(const bf16_t* src, f32x4 (&v)[4][2], int c0) {
#pragma unroll
    for (int i = 0; i < 4; ++i) unpack8(*(const u32x4*)(src + i * 512 + c0), v[i][0], v[i][1]);
}
DI void store_row_bf(bf16_t* dst, const f32x4 (&v)[4][2], int c0) {
#pragma unroll
    for (int i = 0; i < 4; ++i) { u32x4 w; w.x = pk2(v[i][0][0], v[i][0][1]); w.y = pk2(v[i][0][2], v[i][0][3]); w.z = pk2(v[i][1][0], v[i][1][1]); w.w = pk2(v[i][1][2], v[i][1][3]); *(u32x4*)(dst + i * 512 + c0) = w; }
}
DI float row_sumsq(const f32x4 (&v)[4][2]) {
    float s = 0.f;
#pragma unroll
    for (int i = 0; i < 4; ++i)
#pragma unroll
        for (int h = 0; h < 2; ++h) s += v[i][h][0] * v[i][h][0] + v[i][h][1] * v[i][h][1] + v[i][h][2] * v[i][h][2] + v[i][h][3] * v[i][h][3];
    return wave_sum(s);
}
DI void adaln_store(const f32x4 (&x)[4][2], const float* g, const float* shift, const float* scale, bf16_t* hi, bf16_t* lo, int c0) {
    const float rstd = rsqrtf(row_sumsq(x) * (1.f / D) + EPS);
#pragma unroll
    for (int i = 0; i < 4; ++i) {
        f32x4 h[2];
#pragma unroll
        for (int q = 0; q < 2; ++q) { const int c = i * 512 + c0 + 4 * q;
            const f32x4 gg = *(const f32x4*)(g + c), sh = *(const f32x4*)(shift + c), sc = *(const f32x4*)(scale + c);
#pragma unroll
            for (int j = 0; j < 4; ++j) h[q][j] = x[i][q][j] * rstd * gg[j] * (1.f + sc[j]) + sh[j]; }
        u32x4 w; w.x = pk2(h[0][0], h[0][1]); w.y = pk2(h[0][2], h[0][3]); w.z = pk2(h[1][0], h[1][1]); w.w = pk2(h[1][2], h[1][3]);
        *(u32x4*)(hi + i * 512 + c0) = w;
        if (lo) { f32x4 a, b; unpack8(w, a, b); u32x4 w2; w2.x = pk2(h[0][0] - a[0], h[0][1] - a[1]); w2.y = pk2(h[0][2] - a[2], h[0][3] - a[3]); w2.z = pk2(h[1][0] - b[0], h[1][1] - b[1]); w2.w = pk2(h[1][2] - b[2], h[1][3] - b[3]);
            *(u32x4*)(lo + i * 512 + c0) = w2; }
    }
}
DI void residual_add(f32x4 (&x)[4][2], const f32x4 (&y)[4][2], const float* g, const float* gate, int c0) {
    const float rstd = rsqrtf(row_sumsq(y) * (1.f / D) + EPS);
#pragma unroll
    for (int i = 0; i < 4; ++i)
#pragma unroll
        for (int q = 0; q < 2; ++q) { const int c = i * 512 + c0 + 4 * q; const f32x4 gg = *(const f32x4*)(g + c), gt = *(const f32x4*)(gate + c);
#pragma unroll
            for (int j = 0; j < 4; ++j) x[i][q][j] += gt[j] * (y[i][q][j] * rstd * gg[j]); }
}
DI void load_xrow(PR p, int l, int r, f32x4 (&x)[4][2], int c0) {
    if (l == 0) load_row(r < NLAT ? p.x + (size_t)r * D : p.ctx + (size_t)(r - NLAT) * D, x, c0);
    else load_row_bf((const bf16_t*)(p.ws + WS_XRES) + (size_t)r * D, x, c0);
}
DI void phase_norm1(PR p, int l) {
    const int tid_ = tid_here(), lane = tid_ & 63, wid = tid_ >> 6;
    const float* mod = (const float*)(p.ws + WS_MOD) + (size_t)l * 5 * 12288;
    bf16_t* hb = (bf16_t*)(p.ws + WS_HBUF);
    for (int r = bid_here() * 8 + wid; r < NTOK; r += gridDim.x * 8) {
        const Tok t = tok_of(r);
        int c0 = lane * 8; asm volatile("" : "+v"(c0));
        f32x4 x[4][2]; load_xrow(p, l, r, x, c0);
        adaln_store(x, p.g_pre_mix + l * D, mod + (size_t)t.mrow * 12288 + 0 * D, mod + (size_t)t.mrow * 12288 + 1 * D, hb + (size_t)r * D, nullptr, c0);
    }
}
DI void phase_postmix(PR p, int l) {
    const int tid_ = tid_here(), lane = tid_ & 63, wid = tid_ >> 6;
    const float* mod = (const float*)(p.ws + WS_MOD) + (size_t)l * 5 * 12288;
    const bf16_t* Y = (const bf16_t*)(p.ws + WS_U + U_Y);
    bf16_t* XR = (bf16_t*)(p.ws + WS_XRES);
    bf16_t* hb = (bf16_t*)(p.ws + WS_HBUF); bf16_t* hl = (bf16_t*)(p.ws + WS_U + U_HLO);
    const int nrows = l == 0 ? NTOK : NLAT;
    for (int r = bid_here() * 8 + wid; r < nrows; r += gridDim.x * 8) {
        const Tok t = tok_of(r);
        int c0 = lane * 8; asm volatile("" : "+v"(c0));
        f32x4 x[4][2], y[4][2]; load_xrow(p, l, r, x, c0); load_row_bf(Y + (size_t)r * D, y, c0);
        residual_add(x, y, p.g_post_mix + l * D, mod + (size_t)t.mrow * 12288 + 2 * D, c0);
        store_row_bf(XR + (size_t)r * D, x, c0);
        adaln_store(x, p.g_pre_ffn + l * D, mod + (size_t)t.mrow * 12288 + 3 * D, mod + (size_t)t.mrow * 12288 + 4 * D, hb + (size_t)r * D, hl + (size_t)r * D, c0);
    }
}
DI void phase_postffn(PR p, int l) {
    const int tid_ = tid_here(), lane = tid_ & 63, wid = tid_ >> 6;
    const float* mod = (const float*)(p.ws + WS_MOD) + (size_t)l * 5 * 12288;
    const bf16_t* YS = (const bf16_t*)(p.ws + WS_U + U_YSH);
    const unsigned char* OA = p.ws + WS_U + U_OASG;
    bf16_t* XR = (bf16_t*)(p.ws + WS_XRES);
    bf16_t* hb = (bf16_t*)(p.ws + WS_HBUF);
    const int nrows = l == 0 ? NTOK : NLAT;
    const bool fp8 = (OASG_FP8_MASK >> l) & 1;
    for (int r = bid_here() * 8 + wid; r < nrows; r += gridDim.x * 8) {
        const Tok t = tok_of(r);
        int c0 = lane * 8; asm volatile("" : "+v"(c0));
        f32x4 x[4][2], y[4][2]; load_row_bf(XR + (size_t)r * D, x, c0); load_row_bf(YS + (size_t)r * D, y, c0);
        if (fp8) {
            f32x4 a[4][2];
#pragma unroll
            for (int i = 0; i < 4; ++i) { a[i][0] = (f32x4){0.f, 0.f, 0.f, 0.f}; a[i][1] = (f32x4){0.f, 0.f, 0.f, 0.f}; }
#pragma unroll 2
            for (int k = 0; k < 8; ++k) {
                const unsigned char* o = OA + ((size_t)r * 8 + k) * D;
#pragma unroll
                for (int i = 0; i < 4; ++i) { const u32x2 w = *(const u32x2*)(o + i * 512 + c0);
                    const auto f0 = __builtin_amdgcn_cvt_pk_f32_fp8(w.x, false), f1 = __builtin_amdgcn_cvt_pk_f32_fp8(w.x, true), f2 = __builtin_amdgcn_cvt_pk_f32_fp8(w.y, false), f3 = __builtin_amdgcn_cvt_pk_f32_fp8(w.y, true);
                    a[i][0][0] += f0[0]; a[i][0][1] += f0[1]; a[i][0][2] += f1[0]; a[i][0][3] += f1[1]; a[i][1][0] += f2[0]; a[i][1][1] += f2[1]; a[i][1][2] += f3[0]; a[i][1][3] += f3[1]; }
            }
#pragma unroll
            for (int i = 0; i < 4; ++i) { y[i][0] += a[i][0] * (1.f / OASG_SCALE); y[i][1] += a[i][1] * (1.f / OASG_SCALE); }
        } else {
#pragma unroll 2
            for (int k = 0; k < 8; ++k) {
                const bf16_t* o = (const bf16_t*)OA + ((size_t)r * 8 + k) * D;
#pragma unroll
                for (int i = 0; i < 4; ++i) { f32x4 a, b; unpack8(*(const u32x4*)(o + i * 512 + c0), a, b); y[i][0] += a; y[i][1] += b; }
            }
        }
        residual_add(x, y, p.g_post_ffn + l * D, mod + (size_t)t.mrow * 12288 + 5 * D, c0);
        if (l == 0) {
            store_row_bf(XR + (size_t)r * D, x, c0);
            const float* mod1 = (const float*)(p.ws + WS_MOD) + (size_t)1 * 5 * 12288;
            adaln_store(x, p.g_pre_mix + 1 * D, mod1 + (size_t)t.mrow * 12288 + 0 * D, mod1 + (size_t)t.mrow * 12288 + 1 * D, hb + (size_t)r * D, nullptr, c0);
        } else {
            float* dstrow = p.out + (size_t)r * D;
#pragma unroll
            for (int i = 0; i < 4; ++i) { *(f32x4*)(dstrow + i * 512 + c0) = x[i][0]; *(f32x4*)(dstrow + i * 512 + c0 + 4) = x[i][1]; }
        }
    }
}

struct GemmUnit {
    const bf16_t* A; long lda; const int* rows; int rowshift;
    const bf16_t* Bt; long ldb;
    int K;
};
constexpr int GS_LD = 72;
struct LaneId { int wr, wc, fr, fq; };
DI LaneId gemm_kloop_simple(char* lds, const GemmUnit& g, f32x4 (&acc)[2][2][4][2]) {
    int tid = threadIdx.x; asm volatile("" : "+v"(tid));
    const int wid = tid >> 6, lane = tid & 63, wr = wid >> 2, wc = wid & 3, fr = lane & 15, fq = lane >> 4;
    bf16_t* As = (bf16_t*)lds; bf16_t* Bs = As + 256 * GS_LD;
#pragma unroll
    for (int a = 0; a < 2; ++a)
#pragma unroll
        for (int b = 0; b < 2; ++b)
#pragma unroll
            for (int m = 0; m < 4; ++m)
#pragma unroll
                for (int n = 0; n < 2; ++n) acc[a][b][m][n] = (f32x4){0.f, 0.f, 0.f, 0.f};
    const int srow = tid >> 3, skc = (tid & 7) * 8;
    const bf16_t* ap[4]; const bf16_t* bp[4];
#pragma unroll
    for (int i = 0; i < 4; ++i) {
        const int r = srow + 64 * i;
        if (g.rows) { const int idx = g.rows[r]; ap[i] = g.A + (size_t)(idx >= 0 ? (idx >> g.rowshift) : 0) * g.lda + skc; }
        else ap[i] = g.A + (size_t)r * g.lda + skc;
        bp[i] = g.Bt + (size_t)r * g.ldb + skc;
    }
    const int nkt = g.K / 64;
    u32x4 ra[4], rb[4];
#pragma unroll
    for (int i = 0; i < 4; ++i) { ra[i] = *(const u32x4*)(ap[i]); rb[i] = *(const u32x4*)(bp[i]); }
    for (int kt = 0; kt < nkt; ++kt) {
        __syncthreads();
#pragma unroll
        for (int i = 0; i < 4; ++i) { *(u32x4*)(As + (srow + 64 * i) * GS_LD + skc) = ra[i]; *(u32x4*)(Bs + (srow + 64 * i) * GS_LD + skc) = rb[i]; }
        __syncthreads();
        if (kt + 1 < nkt) {
#pragma unroll
            for (int i = 0; i < 4; ++i) { ra[i] = *(const u32x4*)(ap[i] + (kt + 1) * 64); rb[i] = *(const u32x4*)(bp[i] + (kt + 1) * 64); }
        }
#pragma unroll
        for (int kk = 0; kk < 2; ++kk) {
            bf16x8 bf[2][2];
#pragma unroll
            for (int bj = 0; bj < 2; ++bj)
#pragma unroll
                for (int n = 0; n < 2; ++n) bf[bj][n] = *(const bf16x8*)(Bs + (128 * bj + 32 * wc + 16 * n + fr) * GS_LD + kk * 32 + fq * 8);
#pragma unroll
            for (int ai = 0; ai < 2; ++ai)
#pragma unroll
                for (int m = 0; m < 4; ++m) {
                    const bf16x8 af = *(const bf16x8*)(As + (128 * ai + 64 * wr + 16 * m + fr) * GS_LD + kk * 32 + fq * 8);
#pragma unroll
                    for (int bj = 0; bj < 2; ++bj)
#pragma unroll
                        for (int n = 0; n < 2; ++n) acc[ai][bj][m][n] = __builtin_amdgcn_mfma_f32_16x16x32_bf16(bf[bj][n], af, acc[ai][bj][m][n], 0, 0, 0);
                }
        }
    }
    __syncthreads();
    LaneId id; id.wr = wr; id.wc = wc; id.fr = fr; id.fq = fq; return id;
}
#define GEMM_ACC f32x4 acc[2][2][4][2]
#define ACC_FOREACH(...) \
    _Pragma("unroll") for (int ai = 0; ai < 2; ++ai) _Pragma("unroll") for (int m = 0; m < 4; ++m) { const int trow = 128 * ai + 64 * wr + 16 * m + fr; \
    _Pragma("unroll") for (int bj = 0; bj < 2; ++bj) _Pragma("unroll") for (int n = 0; n < 2; ++n) { const int tcol = 128 * bj + 32 * wc + 16 * n + 4 * fq; const f32x4 v = acc[ai][bj][m][n]; __VA_ARGS__ } }

struct EpiProj {
    bf16_t* O; int row0, col0;
    DI void operator()(const f32x4 (&acc)[2][2][4][2], int wr, int wc, int fr, int fq) const {
        ACC_FOREACH({ u32x2 w; w.x = pk2(v[0], v[1]); w.y = pk2(v[2], v[3]); *(u32x2*)(O + (size_t)(row0 + trow) * INWP + col0 + tcol) = w; })
    }
};
struct EpiB16 {
    bf16_t* O; int row0, col0, ld;
    DI void operator()(const f32x4 (&acc)[2][2][4][2], int wr, int wc, int fr, int fq) const {
        ACC_FOREACH({ u32x2 w; w.x = pk2(v[0], v[1]); w.y = pk2(v[2], v[3]); *(u32x2*)(O + (size_t)(row0 + trow) * ld + col0 + tcol) = w; })
    }
};
struct EpiF32 {
    float* O; int row0, col0, ld;
    DI void operator()(const f32x4 (&acc)[2][2][4][2], int wr, int wc, int fr, int fq) const {
        ACC_FOREACH({ *(f32x4*)(O + (size_t)(row0 + trow) * ld + col0 + tcol) = v; })
    }
};
struct EpiUq {
    bf16_t* Q; const float2* ropem; int row0, col0;
    DI void operator()(const f32x4 (&acc)[2][2][4][2], int wr, int wc, int fr, int fq) const {
#pragma unroll
        for (int ai = 0; ai < 2; ++ai)
#pragma unroll
            for (int m = 0; m < 4; ++m) {
                const int r = row0 + 128 * ai + 64 * wr + 16 * m + fr; const Tok t = tok_of(r);
#pragma unroll
                for (int bj = 0; bj < 2; ++bj) {
                    const int cbase = col0 + 128 * bj + 32 * wc;
                    if (cbase >= 1152) continue;
                    const int h = cbase / 192, jb = cbase % 192;
                    f32x4 v0 = acc[ai][bj][m][0], v1 = acc[ai][bj][m][1];
                    if (jb >= 128 && !t.isctx) {
                        const int pos = (jb == 128) ? (t.s >> 6) : (t.s & 63);
#pragma unroll
                        for (int i = 0; i < 4; ++i) { const float2 cs = ropem[pos * 16 + 4 * fq + i]; const float x1 = v0[i], x2 = v1[i]; v0[i] = x1 * cs.x - x2 * cs.y; v1[i] = x2 * cs.x + x1 * cs.y; }
                    }
                    bf16_t* dst = Q + (((size_t)t.b * 6 + h) * SKV + t.kvpos) * 192 + jb + 4 * fq;
                    u32x2 w0; w0.x = pk2(v0[0], v0[1]); w0.y = pk2(v0[2], v0[3]); *(u32x2*)(dst) = w0;
                    u32x2 w1; w1.x = pk2(v1[0], v1[1]); w1.y = pk2(v1[2], v1[3]); *(u32x2*)(dst + 16) = w1;
                }
            }
    }
};
struct EpiUkv {
    bf16_t* Km; bf16_t* Vm; int row0, col0;
    DI void operator()(const f32x4 (&acc)[2][2][4][2], int wr, int wc, int fr, int fq) const {
        ACC_FOREACH({ const int r = row0 + trow; const Tok t = tok_of(r); const int c = col0 + tcol, h = c >> 8, j = c & 255;
            u32x2 w; w.x = pk2(v[0], v[1]); w.y = pk2(v[2], v[3]);
            if (j < 128) *(u32x2*)(Km + (((size_t)t.b * 6 + h) * SKV + t.kvpos) * 192 + j) = w;
            else *(u32x2*)(Vm + (((size_t)t.b * 6 + h) * SKV + t.kvpos) * 128 + (j - 128)) = w; })
    }
};
struct EpiMoe1 {
    bf16_t* act; int arow0, hcol0;
    DI void operator()(const f32x4 (&acc)[2][2][4][2], int wr, int wc, int fr, int fq) const {
#pragma unroll
        for (int ai = 0; ai < 2; ++ai)
#pragma unroll
            for (int m = 0; m < 4; ++m) {
                const int trow = 128 * ai + 64 * wr + 16 * m + fr;
#pragma unroll
                for (int n = 0; n < 2; ++n) {
                    const f32x4 a = acc[ai][0][m][n], b = acc[ai][1][m][n]; f32x4 h;
#pragma unroll
                    for (int i = 0; i < 4; ++i) h[i] = silu_f(a[i]) * b[i];
                    u32x2 w; w.x = pk2(h[0], h[1]); w.y = pk2(h[2], h[3]);
                    *(u32x2*)(act + (size_t)(arow0 + trow) * 512 + hcol0 + 32 * wc + 16 * n + 4 * fq) = w;
                }
            }
    }
};
struct EpiMoe2 {
    bf16_t* oasg; const int* sasg; const float* sw; int srow0, col0;
    DI void operator()(const f32x4 (&acc)[2][2][4][2], int wr, int wc, int fr, int fq) const {
        int a[2][4]; float wgt[2][4];
#pragma unroll
        for (int ai = 0; ai < 2; ++ai)
#pragma unroll
            for (int m = 0; m < 4; ++m) { const int trow = 128 * ai + 64 * wr + 16 * m + fr; a[ai][m] = sasg[srow0 + trow]; wgt[ai][m] = sw[srow0 + trow]; }
#pragma unroll
        for (int ai = 0; ai < 2; ++ai)
#pragma unroll
            for (int m = 0; m < 4; ++m) {
                if (a[ai][m] < 0) continue;
#pragma unroll
                for (int bj = 0; bj < 2; ++bj)
#pragma unroll
                    for (int n = 0; n < 2; ++n) { const f32x4 v = acc[ai][bj][m][n] * wgt[ai][m]; u32x2 w; w.x = pk2(v[0], v[1]); w.y = pk2(v[2], v[3]);
                        *(u32x2*)(oasg + (size_t)a[ai][m] * D + col0 + 128 * bj + 32 * wc + 16 * n + 4 * fq) = w; }
            }
    }
};
DI u32x4 pack8(const f32x4& a, const f32x4& b) { u32x4 w; w.x = pk2(a[0], a[1]); w.y = pk2(a[2], a[3]); w.z = pk2(b[0], b[1]); w.w = pk2(b[2], b[3]); return w; }
struct EpiB16P {
    bf16_t* O; int row0, col0, ld;
    DI void operator()(const f32x4 (&acc)[2][2][4][2], int wr, int wc, int fr, int fq) const {
#pragma unroll
        for (int ai = 0; ai < 2; ++ai)
#pragma unroll
            for (int m = 0; m < 4; ++m) { bf16_t* rowp = O + (size_t)(row0 + 128 * ai + 64 * wr + 16 * m + fr) * ld + col0 + 32 * wc + 8 * fq;
#pragma unroll
                for (int bj = 0; bj < 2; ++bj) *(u32x4*)(rowp + 128 * bj) = pack8(acc[ai][bj][m][0], acc[ai][bj][m][1]); }
    }
};
struct EpiMoe1P {
    bf16_t* act; int arow0, hcol0;
    DI void operator()(const f32x4 (&acc)[2][2][4][2], int wr, int wc, int fr, int fq) const {
#pragma unroll
        for (int ai = 0; ai < 2; ++ai)
#pragma unroll
            for (int m = 0; m < 4; ++m) {
                f32x4 h0, h1;
#pragma unroll
                for (int i = 0; i < 4; ++i) { h0[i] = silu_f(acc[ai][0][m][0][i]) * acc[ai][1][m][0][i]; h1[i] = silu_f(acc[ai][0][m][1][i]) * acc[ai][1][m][1][i]; }
                *(u32x4*)(act + (size_t)(arow0 + 128 * ai + 64 * wr + 16 * m + fr) * 512 + hcol0 + 32 * wc + 8 * fq) = pack8(h0, h1);
            }
    }
};
struct EpiMoe2P {
    bf16_t* oasg; const int* sasg; const float* sw; int srow0, col0;
    DI void operator()(const f32x4 (&acc)[2][2][4][2], int wr, int wc, int fr, int fq) const {
        int a[2][4]; float wgt[2][4];
#pragma unroll
        for (int ai = 0; ai < 2; ++ai)
#pragma unroll
            for (int m = 0; m < 4; ++m) { const int trow = 128 * ai + 64 * wr + 16 * m + fr; a[ai][m] = sasg[srow0 + trow]; wgt[ai][m] = sw[srow0 + trow]; }
#pragma unroll
        for (int ai = 0; ai < 2; ++ai)
#pragma unroll
            for (int m = 0; m < 4; ++m) {
                if (a[ai][m] < 0) continue;
                bf16_t* rowp = oasg + (size_t)a[ai][m] * D + col0 + 32 * wc + 8 * fq;
#pragma unroll
                for (int bj = 0; bj < 2; ++bj) *(u32x4*)(rowp + 128 * bj) = pack8(acc[ai][bj][m][0] * wgt[ai][m], acc[ai][bj][m][1] * wgt[ai][m]);
            }
    }
};
struct EpiMoe2F8 {
    unsigned char* oasg; const int* sasg; const float* sw; int srow0, col0;
    DI void operator()(const f32x4 (&acc)[2][2][4][2], int wr, int wc, int fr, int fq) const {
        int a[2][4]; float wgt[2][4];
#pragma unroll
        for (int ai = 0; ai < 2; ++ai)
#pragma unroll
            for (int m = 0; m < 4; ++m) { const int trow = 128 * ai + 64 * wr + 16 * m + fr; a[ai][m] = sasg[srow0 + trow]; wgt[ai][m] = sw[srow0 + trow] * OASG_SCALE; }
#pragma unroll
        for (int ai = 0; ai < 2; ++ai)
#pragma unroll
            for (int m = 0; m < 4; ++m) {
                if (a[ai][m] < 0) continue;
                unsigned char* rowp = oasg + (size_t)a[ai][m] * D + col0 + 32 * wc + 8 * fq;
#pragma unroll
                for (int bj = 0; bj < 2; ++bj) { const f32x4 v0 = acc[ai][bj][m][0] * wgt[ai][m], v1 = acc[ai][bj][m][1] * wgt[ai][m]; u32x2 w;
                    int t0 = __builtin_amdgcn_cvt_pk_fp8_f32(v0[0], v0[1], 0, false); t0 = __builtin_amdgcn_cvt_pk_fp8_f32(v0[2], v0[3], t0, true);
                    int t1 = __builtin_amdgcn_cvt_pk_fp8_f32(v1[0], v1[1], 0, false); t1 = __builtin_amdgcn_cvt_pk_fp8_f32(v1[2], v1[3], t1, true);
                    w.x = (unsigned)t0; w.y = (unsigned)t1; *(u32x2*)(rowp + 128 * bj) = w; }
            }
    }
};
DI void phase_postproj_rows(PR p, int l) {
    const int tid_ = tid_here(), lane = tid_ & 63, wid = tid_ >> 6;
    unsigned char* U = p.ws + WS_U;
    const bf16_t* PR = (const bf16_t*)(U + U_PROJ);
    bf16_t* CQN = (bf16_t*)(U + U_CQN); bf16_t* CKVN = (bf16_t*)(U + U_CKVN);
    bf16_t* Km = (bf16_t*)(U + U_KM); bf16_t* Qg = (bf16_t*)(U + U_QG); bf16_t* Kg = (bf16_t*)(U + U_KG); bf16_t* Vg = (bf16_t*)(U + U_VG);
    const float2* ropeg = (const float2*)(p.ws + WS_ROPEG); const float2* ropem = (const float2*)(p.ws + WS_ROPEM);
    const float* gq = p.gqa_g_q + l * 128; const float* gk = p.gqa_g_k + l * 128;
    for (int r = bid_here() * 8 + wid; r < NTOK; r += gridDim.x * 8) {
        const Tok t = tok_of(r);
        const bf16_t* pr = PR + (size_t)r * INWP;
        {
            float v[6], ss = 0.f;
#pragma unroll
            for (int i = 0; i < 6; ++i) { v[i] = bf2f(pr[C_CQ + lane + 64 * i]); ss += v[i] * v[i]; }
            const float rstd = rsqrtf(wave_sum(ss) * (1.f / 384.f) + EPS);
#pragma unroll
            for (int i = 0; i < 6; ++i) CQN[(size_t)r * 512 + lane + 64 * i] = f2bf(v[i] * rstd);
            CQN[(size_t)r * 512 + 384 + lane] = 0; CQN[(size_t)r * 512 + 448 + lane] = 0;
        }
        {
            float v[8], ss = 0.f;
#pragma unroll
            for (int i = 0; i < 8; ++i) { v[i] = bf2f(pr[C_CKV + lane + 64 * i]); ss += v[i] * v[i]; }
            const float rstd = rsqrtf(wave_sum(ss) * (1.f / 512.f) + EPS);
#pragma unroll
            for (int i = 0; i < 8; ++i) CKVN[(size_t)r * 512 + lane + 64 * i] = f2bf(v[i] * rstd);
        }
        {
            float x = bf2f(pr[C_KR + lane]);
            const float other = shx(x, 16, lane);
            if (!t.isctx) {
                const int g = lane >> 5, idx = lane & 31, fi = idx & 15; const bool second = idx >= 16;
                const int pos = g == 0 ? (t.s >> 6) : (t.s & 63);
                const float2 cs = ropem[pos * 16 + fi];
                x = second ? x * cs.x + other * cs.y : x * cs.x - other * cs.y;
            }
            const bf16_t xb = f2bf(x);
#pragma unroll
            for (int h = 0; h < 6; ++h) Km[(((size_t)t.b * 6 + h) * SKV + t.kvpos) * 192 + 128 + lane] = xb;
        }
        const int fi = lane & 31; const bool second = lane >= 32;
        float2 cs0 = make_float2(1.f, 0.f), cs1 = make_float2(1.f, 0.f);
        if (!t.isctx) { cs0 = ropeg[(t.s >> 6) * 32 + fi]; cs1 = ropeg[(t.s & 63) * 32 + fi]; }
#pragma unroll
        for (int hh = 0; hh < 8; ++hh) {
            const bool isq = hh < 6; const int h = isq ? hh : hh - 6; const float* g = isq ? gq : gk;
            const int cb = (isq ? C_AQ : C_AK) + h * 128;
            float e0 = bf2f(pr[cb + lane]), e1 = bf2f(pr[cb + 64 + lane]);
            const float rstd = rsqrtf(wave_sum(e0 * e0 + e1 * e1) * (1.f / 128.f) + EPS);
            e0 = e0 * rstd * g[lane]; e1 = e1 * rstd * g[64 + lane];
            const float o0 = shx(e0, 32, lane), o1 = shx(e1, 32, lane);
            const float r0 = second ? e0 * cs0.x + o0 * cs0.y : e0 * cs0.x - o0 * cs0.y;
            const float r1 = second ? e1 * cs1.x + o1 * cs1.y : e1 * cs1.x - o1 * cs1.y;
            bf16_t* dst = isq ? Qg + (((size_t)t.b * 6 + h) * SKV + t.kvpos) * 128 : Kg + (((size_t)t.b * 2 + h) * SKV + t.kvpos) * 128;
            dst[lane] = f2bf(r0); dst[64 + lane] = f2bf(r1);
        }
#pragma unroll
        for (int h = 0; h < 2; ++h) { bf16_t* dst = Vg + (((size_t)t.b * 2 + h) * SKV + t.kvpos) * 128; dst[lane] = pr[C_AV + h * 128 + lane]; dst[64 + lane] = pr[C_AV + h * 128 + 64 + lane]; }
    }
}

#define SBAR() __builtin_amdgcn_sched_barrier(0)
DI int crow(int r, int hi) { return (r & 3) + 8 * (r >> 2) + 4 * hi; }
DI unsigned cvtpk(float lo, float hi) { unsigned r; asm volatile("v_cvt_pk_bf16_f32 %0, %1, %2" : "=v"(r) : "v"(lo), "v"(hi)); return r; }
constexpr float ATT_THR = 8.f;
template <int DQK> struct AttnCfg {
    static constexpr int KROWB = DQK * 2;
    static constexpr int SHM_V = 64 * 128 * 2, SHM_K = 64 * DQK * 2;
    static constexpr int ND0 = DQK / 16;
    static constexpr int NKCH = DQK / 64;
    static constexpr int NQR = DQK == 128 ? 8 : ATT_NQR_M;
    static constexpr int SHM_Q = 8 * (ND0 - NQR) * 1024;
    static constexpr int SHM_TOTAL = 2 * SHM_V + 2 * SHM_K + 8 * 64 * 4 + SHM_Q;
};
template <int DQK> DI int kswz(int row, int colB) { return row * (DQK * 2) + (colB ^ ((row & 7) << 4)); }
DI void partialSM(f32x16& p0, f32x16& p1, float& m_reg, float& mn, float& alpha, const float SCALE) {
    const float C = SCALE * 1.4426950408889634f;
    float pmax = p0[0];
#pragma unroll
    for (int r = 1; r < 16; ++r) pmax = fmaxf(pmax, p0[r]);
#pragma unroll
    for (int r = 0; r < 16; ++r) pmax = fmaxf(pmax, p1[r]);
    { auto rr = __builtin_amdgcn_permlane32_swap(__float_as_uint(pmax), __float_as_uint(pmax), false, false);
      pmax = fmaxf(__uint_as_float(rr[0]), __uint_as_float(rr[1])); }
    if (__builtin_expect(__all(pmax - m_reg <= ATT_THR / SCALE), 1)) { mn = m_reg; alpha = 1.f; }
    else { mn = fmaxf(m_reg, pmax); alpha = __builtin_amdgcn_exp2f((m_reg - mn) * C); m_reg = mn; }
    const float mnC = -mn * C;
#pragma unroll
    for (int r = 0; r < 16; ++r) p0[r] = fmaf(p0[r], C, mnC);
#pragma unroll
    for (int r = 0; r < 16; ++r) p1[r] = fmaf(p1[r], C, mnC);
#pragma unroll
    for (int r = 0; r < 16; ++r) p0[r] = __builtin_amdgcn_exp2f(p0[r]);
}
DI void finishSM(f32x16& p0, f32x16& p1, float alpha, float& l_reg, bf16x8& pa0, bf16x8& pa1, bf16x8& pa2, bf16x8& pa3) {
#pragma unroll
    for (int r = 0; r < 16; ++r) p1[r] = __builtin_amdgcn_exp2f(p1[r]);
    float ps = 0;
#pragma unroll
    for (int r = 0; r < 16; ++r) ps += p0[r];
#pragma unroll
    for (int r = 0; r < 16; ++r) ps += p1[r];
    { auto rr = __builtin_amdgcn_permlane32_swap(__float_as_uint(ps), __float_as_uint(ps), false, false);
      ps = __uint_as_float(rr[0]) + __uint_as_float(rr[1]); }
    l_reg = l_reg * alpha + ps;
#define PK4(P, BASE, OUT) do { unsigned a0 = cvtpk(P[BASE + 0], P[BASE + 1]), a1 = cvtpk(P[BASE + 2], P[BASE + 3]);   \
    unsigned b0 = cvtpk(P[BASE + 4], P[BASE + 5]), b1 = cvtpk(P[BASE + 6], P[BASE + 7]);                              \
    auto r0 = __builtin_amdgcn_permlane32_swap(a0, b0, false, false); auto r1 = __builtin_amdgcn_permlane32_swap(a1, b1, false, false); \
    u32x4 w = {r0[0], r1[0], r0[1], r1[1]}; OUT = *reinterpret_cast<bf16x8*>(&w); } while (0)
    PK4(p0, 0, pa0); PK4(p0, 8, pa1); PK4(p1, 0, pa2); PK4(p1, 8, pa3);
#undef PK4
}
template <int DQK, int NQR>
DI void qkt(f32x16& p0, f32x16& p1, const int (&kb)[4], int bufoff, const bf16x8* qr, int qs_addr, int r32, int hi) {
    asm volatile("" : "+v"(qs_addr));
    const LAS char* Qs = (const LAS char*)qs_addr;
#pragma unroll
    for (int r = 0; r < 16; ++r) { p0[r] = 0.f; p1[r] = 0.f; }
#pragma unroll
    for (int d0 = 0; d0 < DQK / 16; ++d0) {
        const LAS char* ka = (const LAS char*)(kb[d0 & 3]) + bufoff + 128 * (d0 >> 2);
        const bf16x8 b0 = *(const LAS bf16x8*)(ka);
        const bf16x8 b1 = *(const LAS bf16x8*)(ka + 32 * DQK * 2);
        bf16x8 q;
        if (d0 < NQR) q = qr[d0]; else q = *(const LAS bf16x8*)(Qs + (d0 - NQR) * 1024);
        p0 = __builtin_amdgcn_mfma_f32_32x32x16_bf16(b0, q, p0, 0, 0, 0);
        p1 = __builtin_amdgcn_mfma_f32_32x32x16_bf16(b1, q, p1, 0, 0, 0); }
}
DI int v_st(int k, int c) { const int kk = (k & ~0xC) | ((k & 4) << 1) | ((k & 8) >> 1); return ((kk >> 3) * 4 + (c >> 5)) * 512 + ((kk & 7) * 32 + (c & 31)) * 2; }
DI int v_rd_base(int lane) { return ((lane & 3) << 3) | (((lane >> 2) & 3) << 6) | (((lane >> 4) & 1) << 5) | (((lane >> 5) & 1) << 8); }
constexpr int v_rd_off(int d0, int ks, int half) { return d0 * 512 + ks * 4096 + half * 2048; }
template <int OFF> DI s16x4 tr_read(int vb) { s16x4 r; asm volatile("ds_read_b64_tr_b16 %0, %1 offset:%2" : "=&v"(r) : "v"(vb), "i"(OFF) : "memory"); return r; }
template <int D0> DI void pv_one(f32x16& od, int vb, bf16x8 pa0, bf16x8 pa1, bf16x8 pa2, bf16x8 pa3) {
    const s16x4 l0 = tr_read<v_rd_off(D0, 0, 0)>(vb), h0 = tr_read<v_rd_off(D0, 0, 1)>(vb), l1 = tr_read<v_rd_off(D0, 1, 0)>(vb), h1 = tr_read<v_rd_off(D0, 1, 1)>(vb);
    const s16x4 l2 = tr_read<v_rd_off(D0, 2, 0)>(vb), h2 = tr_read<v_rd_off(D0, 2, 1)>(vb), l3 = tr_read<v_rd_off(D0, 3, 0)>(vb), h3 = tr_read<v_rd_off(D0, 3, 1)>(vb);
    asm volatile("s_waitcnt lgkmcnt(0)" ::: "memory"); SBAR();
#define PKV(L, H) (bf16x8){L[0], L[1], L[2], L[3], H[0], H[1], H[2], H[3]}
    od = __builtin_amdgcn_mfma_f32_32x32x16_bf16(pa0, PKV(l0, h0), od, 0, 0, 0);
    od = __builtin_amdgcn_mfma_f32_32x32x16_bf16(pa1, PKV(l1, h1), od, 0, 0, 0);
    od = __builtin_amdgcn_mfma_f32_32x32x16_bf16(pa2, PKV(l2, h2), od, 0, 0, 0);
    od = __builtin_amdgcn_mfma_f32_32x32x16_bf16(pa3, PKV(l3, h3), od, 0, 0, 0);
#undef PKV
}
DI void pv_d0(f32x16* o, int vb, bf16x8 pa0, bf16x8 pa1, bf16x8 pa2, bf16x8 pa3) {
    pv_one<0>(o[0], vb, pa0, pa1, pa2, pa3); pv_one<1>(o[1], vb, pa0, pa1, pa2, pa3); pv_one<2>(o[2], vb, pa0, pa1, pa2, pa3); pv_one<3>(o[3], vb, pa0, pa1, pa2, pa3);
}
template <int DQK, int SDEPTH>
DI void attn_body(const bf16_t* __restrict__ Qb, const bf16_t* __restrict__ Kh, const bf16_t* __restrict__ Vh, bf16_t* __restrict__ Ob, int ldo, int seq, char* lds, const float SCALE) {
    using Cfg = AttnCfg<DQK>;
    constexpr int SHM_V = Cfg::SHM_V, SHM_K = Cfg::SHM_K, ND0 = Cfg::ND0, NKCH = Cfg::NKCH, KCPR = DQK / 8, NQR = Cfg::NQR;
    int tid = threadIdx.x; asm volatile("" : "+v"(tid));
    const int wid = tid >> 6, lane = tid & 63, r32 = lane & 31, hi = lane >> 5;
    char* V_lds = lds; char* K_lds = lds + 2 * SHM_V;
    float* ws = (float*)(lds + 2 * SHM_V + 2 * SHM_K) + wid * 64; float* li_l = ws; float* al_l = ws + 32;
    float m_reg = -1e30f, l_reg = 0; f32x16 o[4]; bf16x8 qr[NQR > 0 ? NQR : 1];
    char* Qs = lds + 2 * SHM_V + 2 * SHM_K + 8 * 64 * 4 + (wid * (ND0 - NQR) * 64 + lane) * 16;
#pragma unroll
    for (int d = 0; d < 4; ++d)
#pragma unroll
        for (int r = 0; r < 16; ++r) o[d][r] = 0.f;
    const bf16_t* Qw = Qb + (long)(wid * 32 + r32) * DQK + hi * 8;
#pragma unroll
    for (int d0 = 0; d0 < ND0; ++d0) { const bf16x8 qv = *reinterpret_cast<const bf16x8*>(Qw + d0 * 16); if (d0 < NQR) qr[d0] = qv; else *reinterpret_cast<bf16x8*>(Qs + (d0 - NQR) * 1024) = qv; }
    asm volatile("s_waitcnt lgkmcnt(0)" ::: "memory");
    const int sr = tid >> 4, sc = (tid & 15) * 8, vst0 = v_st(sr, sc), vst1 = v_st(32 + sr, sc);
    const int kgo = (tid >> 3) * DQK + (tid & 7) * 8, klo = (tid >> 3) * (DQK * 2) + (((tid & 7) << 4) ^ (((tid >> 3) & 7) << 4));
    const int vb0 = (int)(uintptr_t)V_lds + v_rd_base(lane);
    int kb[4];
#pragma unroll
    for (int m = 0; m < 4; ++m) { kb[m] = (int)(uintptr_t)K_lds + r32 * (DQK * 2) + 16 * (hi ^ (r32 & 1)) + 32 * (m ^ ((r32 >> 1) & 3)); asm volatile("" : "+v"(kb[m])); }
    struct { bf16x8 vs0, vs1, ks[NKCH]; } sr_[SDEPTH];
#define SLOAD(i, k0) do { sr_[i].vs0 = *(const bf16x8*)(&Vh[(long)((k0) + sr) * 128 + sc]); sr_[i].vs1 = *(const bf16x8*)(&Vh[(long)((k0) + 32 + sr) * 128 + sc]); \
    _Pragma("unroll") for (int q_ = 0; q_ < NKCH; ++q_) sr_[i].ks[q_] = *(const bf16x8*)(&Kh[(long)(k0) * DQK + kgo + q_ * 64]); } while (0)
#define SWRITE(b, i) do { *(bf16x8*)(V_lds + (b) * SHM_V + vst0) = sr_[i].vs0; *(bf16x8*)(V_lds + (b) * SHM_V + vst1) = sr_[i].vs1; \
    _Pragma("unroll") for (int q_ = 0; q_ < NKCH; ++q_) *(bf16x8*)(K_lds + (b) * SHM_K + klo + q_ * 128) = sr_[i].ks[q_]; } while (0)
#define SWAIT() do { if constexpr (SDEPTH == 1) asm volatile("s_waitcnt vmcnt(0)" ::: "memory"); else if constexpr (NKCH == 2) asm volatile("s_waitcnt vmcnt(4)" ::: "memory"); else asm volatile("s_waitcnt vmcnt(5)" ::: "memory"); } while (0)
#define RESC(a) do { if (__any((a) < 1.f)) { if (hi == 0) al_l[r32] = (a); asm volatile("s_waitcnt lgkmcnt(0)" ::: "memory"); \
    _Pragma("unroll") for (int d = 0; d < 4; ++d) _Pragma("unroll") for (int r = 0; r < 16; ++r) o[d][r] *= al_l[crow(r, hi)]; } } while (0)
    f32x16 pA0, pA1, pB0, pB1; float mnA, mnB, alA, alB; bf16x8 pa0, pa1, pa2, pa3; const int NT = seq / 64;
    constexpr int SE = 0, SO = SDEPTH - 1;
    SLOAD(SE, 0); asm volatile("s_waitcnt vmcnt(0)" ::: "memory"); SWRITE(0, SE); __syncthreads();
    qkt<DQK, NQR>(pA0, pA1, kb, 0, qr, (int)(uintptr_t)Qs, r32, hi); partialSM(pA0, pA1, m_reg, mnA, alA, SCALE);
    SLOAD(SO, 64); if constexpr (SDEPTH == 2) { if (2 < NT) SLOAD(SE, 2 * 64); }
    SWAIT(); SWRITE(1, SO); __syncthreads();
    for (int j = 1; j + 1 < NT; j += 2) {
        SBAR(); qkt<DQK, NQR>(pB0, pB1, kb, SHM_K, qr, (int)(uintptr_t)Qs, r32, hi);
        finishSM(pA0, pA1, alA, l_reg, pa0, pa1, pa2, pa3); SBAR();
        SLOAD(SO, (j + SDEPTH) * 64); SBAR();
        pv_d0(o, vb0, pa0, pa1, pa2, pa3); partialSM(pB0, pB1, m_reg, mnB, alB, SCALE);
        __syncthreads(); SWAIT(); SWRITE(0, SE);
        RESC(alB); __syncthreads();
        SBAR(); qkt<DQK, NQR>(pA0, pA1, kb, 0, qr, (int)(uintptr_t)Qs, r32, hi);
        finishSM(pB0, pB1, alB, l_reg, pa0, pa1, pa2, pa3); SBAR();
        if (SDEPTH == 1 || j + 3 < NT) SLOAD(SE, (j + 1 + SDEPTH) * 64); SBAR();
        pv_d0(o, vb0 + SHM_V, pa0, pa1, pa2, pa3); partialSM(pA0, pA1, m_reg, mnA, alA, SCALE);
        __syncthreads(); SWAIT(); SWRITE(1, SO);
        RESC(alA); __syncthreads();
    }
    SBAR(); qkt<DQK, NQR>(pB0, pB1, kb, SHM_K, qr, (int)(uintptr_t)Qs, r32, hi);
    finishSM(pA0, pA1, alA, l_reg, pa0, pa1, pa2, pa3); SBAR();
    pv_d0(o, vb0, pa0, pa1, pa2, pa3); partialSM(pB0, pB1, m_reg, mnB, alB, SCALE);
    __syncthreads(); RESC(alB);
    finishSM(pB0, pB1, alB, l_reg, pa0, pa1, pa2, pa3); SBAR();
    pv_d0(o, vb0 + SHM_V, pa0, pa1, pa2, pa3);
    if (hi == 0) li_l[r32] = l_reg; asm volatile("s_waitcnt lgkmcnt(0)" ::: "memory");
    float rli[16];
#pragma unroll
    for (int r = 0; r < 16; ++r) rli[r] = __builtin_amdgcn_rcpf(li_l[crow(r, hi)]);
    bf16_t* Ow = Ob + (long)(wid * 32) * ldo;
#pragma unroll
    for (int r = 0; r < 16; ++r) { const int orow = crow(r, hi);
#pragma unroll
        for (int d0 = 0; d0 < 4; ++d0) Ow[(long)orow * ldo + d0 * 32 + r32] = f2bf(o[d0][r] * rli[r]); }
    __syncthreads();
#undef SLOAD
#undef SWRITE
#undef SWAIT
#undef RESC
}

constexpr int GL_V = 0;
constexpr int GL_K = 16384;
constexpr int GL_Q = GL_K + 9216;
constexpr int GL_ZF = GL_Q + 9216;
constexpr int GL_ZB = GL_ZF + 4096;
constexpr int GL_LF = GL_ZB + 4096;
constexpr int GL_LB = GL_LF + 16640;
constexpr int GL_X0 = GL_LB + 16640;
constexpr int GL_KEF = GL_X0, GL_KEB = GL_X0 + 9216;
constexpr int GL_QD = GL_X0, GL_KI = GL_X0 + 9216;
constexpr int GL_O = GL_X0 + 18432;
static_assert(GL_O + 64 * 132 * 4 <= 160 * 1024 - 256, "GLA LDS");
DI int gla_row0(int b, int c) { return c < 4 ? NLAT + b * CTXL + c * 64 : b * SEQ + (c - 4) * 64; }
DI void gla_prep(PR p, int l, char* lds, int b, int h, int c, bool needq) {
    const int tid = tid_here(), lane = tid & 63, wid = tid >> 6;
    const bf16_t* PR_ = (const bf16_t*)(p.ws + WS_U + U_PROJ);
    const int row0 = gla_row0(b, c);
    {
        const int t = tid >> 3, dg = (tid & 7) * 8; const bf16_t* pr = PR_ + (size_t)(row0 + t) * INWP;
        *(bf16x8*)(lds + GL_K + t * 144 + dg * 2) = *(const bf16x8*)(pr + C_GK + h * 64 + dg);
        if (needq) { const bf16x8 qv = *(const bf16x8*)(pr + C_GQ + h * 64 + dg); u32x4 w;
            w.x = pk2(bf2f((bf16_t)qv[0]) * 0.125f, bf2f((bf16_t)qv[1]) * 0.125f); w.y = pk2(bf2f((bf16_t)qv[2]) * 0.125f, bf2f((bf16_t)qv[3]) * 0.125f);
            w.z = pk2(bf2f((bf16_t)qv[4]) * 0.125f, bf2f((bf16_t)qv[5]) * 0.125f); w.w = pk2(bf2f((bf16_t)qv[6]) * 0.125f, bf2f((bf16_t)qv[7]) * 0.125f);
            *(u32x4*)(lds + GL_Q + t * 144 + dg * 2) = w; }
        const int sr = tid >> 4, sc = (tid & 15) * 8;
        *(bf16x8*)(lds + GL_V + v_st(sr, sc)) = *(const bf16x8*)(PR_ + (size_t)(row0 + sr) * INWP + C_GV + h * 128 + sc);
        *(bf16x8*)(lds + GL_V + v_st(32 + sr, sc)) = *(const bf16x8*)(PR_ + (size_t)(row0 + 32 + sr) * INWP + C_GV + h * 128 + sc);
        if (tid < 256) { const int tt = (tid & 127) >> 1, half = tid & 1, dir = tid >> 7; const bf16x8 zv = *(const bf16x8*)(PR_ + (size_t)(row0 + tt) * INWP + (dir ? C_ZB : C_ZF) + half * 8);
            float* Z = (float*)(lds + (dir ? GL_ZB : GL_ZF)) + tt * 16 + half * 8;
#pragma unroll
            for (int j = 0; j < 8; ++j) Z[j] = bf2f((bf16_t)zv[j]); }
    }
    float wf[16], wb[16];
#pragma unroll
    for (int r = 0; r < 16; ++r) { wf[r] = p.gla_wg2_f[((size_t)l * 16 + r) * 256 + h * 64 + lane]; wb[r] = p.gla_wg2_b[((size_t)l * 16 + r) * 256 + h * 64 + lane]; }
    const float bgf = p.gla_bg_f[l * 256 + h * 64 + lane], bgb = p.gla_bg_b[l * 256 + h * 64 + lane];
    __syncthreads();
#pragma unroll
    for (int i = 0; i < 8; ++i) {
        const int t = wid * 8 + i; const float* ZF = (const float*)(lds + GL_ZF) + t * 16; const float* ZB = (const float*)(lds + GL_ZB) + t * 16;
        float zf = bgf, zb = bgb;
#pragma unroll
        for (int r = 0; r < 16; ++r) { zf += ZF[r] * wf[r]; zb += ZB[r] * wb[r]; }
        const float lf = fminf(zf, 0.f) - __logf(1.f + __expf(-fabsf(zf))), lb = fminf(zb, 0.f) - __logf(1.f + __expf(-fabsf(zb)));
        ((float*)(lds + GL_LF))[t * 65 + lane] = lf * 0.0625f; ((float*)(lds + GL_LB))[t * 65 + lane] = lb * 0.0625f;
    }
    __syncthreads();
#pragma unroll
    for (int i = 0; i < 8; ++i) {
        const int d = wid * 8 + i;
        float* F = (float*)(lds + GL_LF) + lane * 65 + d; float* Bk = (float*)(lds + GL_LB) + lane * 65 + d;
        float f = *F, g = *Bk;
#pragma unroll
        for (int o = 1; o < 64; o <<= 1) {
            const float fu = __int_as_float(__builtin_amdgcn_ds_bpermute(((lane - o) & 63) << 2, __float_as_int(f)));
            const float gu = __int_as_float(__builtin_amdgcn_ds_bpermute(((lane + o) & 63) << 2, __float_as_int(g)));
            if (lane >= o) f += fu; if (lane + o < 64) g += gu;
        }
        *F = f; *Bk = g;
    }
    __syncthreads();
}
DI void gla_phaseA(PR p, int l, char* lds) {
    float* GS = (float*)(p.ws + WS_U + U_GS); float* GD = (float*)(p.ws + WS_GDEC);
    for (int u = bid_here(); u < 16 * 68; u += gridDim.x) {
        const int bh = u / 68, c = u % 68, b = bh >> 2, h = bh & 3;
        gla_prep(p, l, lds, b, h, c, false);
        const int tid = tid_here(), lane = tid & 63, wid = tid >> 6, r32 = lane & 31, hi = lane >> 5;
        {
            const float* LF = (const float*)(lds + GL_LF); const float* LB = (const float*)(lds + GL_LB);
            const float lastf = LF[63 * 65 + lane], lastb = LB[0 * 65 + lane];
            float ef[8], eb[8];
#pragma unroll
            for (int i = 0; i < 8; ++i) { const int t = wid * 8 + i; const float k = bf2f(*(const bf16_t*)(lds + GL_K + t * 144 + lane * 2));
                ef[i] = k * __expf(lastf - LF[t * 65 + lane]); eb[i] = k * __expf(lastb - LB[t * 65 + lane]); }
            u32x4 w; w.x = pk2(ef[0], ef[1]); w.y = pk2(ef[2], ef[3]); w.z = pk2(ef[4], ef[5]); w.w = pk2(ef[6], ef[7]); *(u32x4*)(lds + GL_KEF + lane * 144 + wid * 16) = w;
            w.x = pk2(eb[0], eb[1]); w.y = pk2(eb[2], eb[3]); w.z = pk2(eb[4], eb[5]); w.w = pk2(eb[6], eb[7]); *(u32x4*)(lds + GL_KEB + lane * 144 + wid * 16) = w;
            if (wid == 0) { GD[((size_t)(0 * 16 + bh) * 68 + c) * 64 + lane] = __expf(lastf); GD[((size_t)(1 * 16 + bh) * 68 + c) * 64 + lane] = __expf(lastb); }
        }
        __syncthreads();
        {
            const int rh = wid & 1, cb = wid >> 1;
            const int vb = (int)(uintptr_t)(lds + GL_V) + v_rd_base(lane) + cb * 512;
#pragma unroll
            for (int dir = 0; dir < 2; ++dir) {
                const char* KE = lds + (dir ? GL_KEB : GL_KEF) + (rh * 32 + r32) * 144 + hi * 16;
                const bf16x8 a0 = *(const bf16x8*)(KE), a1 = *(const bf16x8*)(KE + 32), a2 = *(const bf16x8*)(KE + 64), a3 = *(const bf16x8*)(KE + 96);
                f32x16 od;
#pragma unroll
                for (int r = 0; r < 16; ++r) od[r] = 0.f;
                pv_one<0>(od, vb, a0, a1, a2, a3);
                float* dst = GS + ((size_t)(dir * 16 + bh) * 68 + c) * 8192 + (size_t)(cb * 32 + r32) * 64 + rh * 32 + 4 * hi;
#pragma unroll
                for (int g = 0; g < 4; ++g) *(f32x4*)(dst + 8 * g) = (f32x4){od[4 * g], od[4 * g + 1], od[4 * g + 2], od[4 * g + 3]};
            }
        }
        __syncthreads();
    }
}
DI void gla_scan(PR p) {
    const float* GS = (const float*)(p.ws + WS_U + U_GS); const float* GD = (const float*)(p.ws + WS_GDEC); bf16_t* GST = (bf16_t*)(p.ws + WS_U + U_GST);
    const int tid = tid_here();
    for (int u = bid_here(); u < 128; u += gridDim.x) {
        const int e = u * NTHREADS + tid, db = e >> 11, jd4 = e & 2047, d4 = (jd4 & 15) * 4;
        const int dir = db >> 4;
        const float* base = GS + (size_t)db * 68 * 8192 + jd4 * 4; const float* dbase = GD + (size_t)db * 68 * 64 + d4; bf16_t* obase = GST + (size_t)db * 68 * 8192 + jd4 * 4;
#define SC_C(i) (dir == 0 ? (i) : ((i) < 4 ? 3 - (i) : 71 - (i)))
        float z0 = 0.f; asm volatile("" : "+v"(z0));
        f32x4 S = {z0, z0, z0, z0};
        f32x4 cur[4], nxt[4], dc[4], dn[4];
#pragma unroll
        for (int q = 0; q < 4; ++q) { const int c = SC_C(q); cur[q] = *(const f32x4*)(base + (size_t)c * 8192); dc[q] = *(const f32x4*)(dbase + c * 64); }
        for (int i = 0; i < 68; i += 4) {
            if (i + 4 < 68) {
#pragma unroll
                for (int q = 0; q < 4; ++q) { const int c = SC_C(i + 4 + q); nxt[q] = *(const f32x4*)(base + (size_t)c * 8192); dn[q] = *(const f32x4*)(dbase + c * 64); }
            }
#pragma unroll
            for (int q = 0; q < 4; ++q) { const int c = SC_C(i + q); u32x2 w; w.x = pk2(S[0], S[1]); w.y = pk2(S[2], S[3]); *(u32x2*)(obase + (size_t)c * 8192) = w; S = S * dc[q] + cur[q]; }
#pragma unroll
            for (int q = 0; q < 4; ++q) { cur[q] = nxt[q]; dc[q] = dn[q]; }
        }
#undef SC_C
    }
}
DI void gla_phaseC(PR p, int l, char* lds) {
    const bf16_t* GST = (const bf16_t*)(p.ws + WS_U + U_GST);
    const bf16_t* PR_ = (const bf16_t*)(p.ws + WS_U + U_PROJ); bf16_t* MIX = (bf16_t*)(p.ws + WS_U + U_MIX);
    for (int u = bid_here(); u < 16 * 68; u += gridDim.x) {
        const int bh = u / 68, c = u % 68, b = bh >> 2, h = bh & 3;
        if (l == 1 && c < 4) continue;
        gla_prep(p, l, lds, b, h, c, true);
        const int tid = tid_here(), lane = tid & 63, wid = tid >> 6, r32 = lane & 31, hi = lane >> 5, rh = wid & 1, cb = wid >> 1;
        const int vb = (int)(uintptr_t)(lds + GL_V) + v_rd_base(lane) + cb * 512;
        f32x16 o;
#pragma unroll
        for (int r = 0; r < 16; ++r) o[r] = 0.f;
#pragma unroll
        for (int dir = 0; dir < 2; ++dir) {
            {
                const int t = tid >> 3, dg = (tid & 7) * 8; const float* LC = (const float*)(lds + (dir ? GL_LB : GL_LF)) + t * 65 + dg;
                const bf16x8 qv = *(const bf16x8*)(lds + GL_Q + t * 144 + dg * 2), kv = *(const bf16x8*)(lds + GL_K + t * 144 + dg * 2);
                float qd[8], ki[8];
#pragma unroll
                for (int j = 0; j < 8; ++j) { const float bc = LC[j]; qd[j] = bf2f((bf16_t)qv[j]) * __expf(bc); ki[j] = bf2f((bf16_t)kv[j]) * __expf(-bc); }
                u32x4 w; w.x = pk2(qd[0], qd[1]); w.y = pk2(qd[2], qd[3]); w.z = pk2(qd[4], qd[5]); w.w = pk2(qd[6], qd[7]); *(u32x4*)(lds + GL_QD + t * 144 + dg * 2) = w;
                w.x = pk2(ki[0], ki[1]); w.y = pk2(ki[2], ki[3]); w.z = pk2(ki[4], ki[5]); w.w = pk2(ki[6], ki[7]); *(u32x4*)(lds + GL_KI + t * 144 + dg * 2) = w;
            }
            __syncthreads();
            {
                const char* QD = lds + GL_QD + (rh * 32 + r32) * 144 + hi * 16; const char* KI = lds + GL_KI + r32 * 144 + hi * 16;
                bf16x8 qf[4];
#pragma unroll
                for (int d0 = 0; d0 < 4; ++d0) qf[d0] = *(const bf16x8*)(QD + d0 * 32);
                f32x16 p0, p1;
#pragma unroll
                for (int r = 0; r < 16; ++r) { p0[r] = 0.f; p1[r] = 0.f; }
#pragma unroll
                for (int d0 = 0; d0 < 4; ++d0) {
                    const bf16x8 k0 = *(const bf16x8*)(KI + d0 * 32), k1 = *(const bf16x8*)(KI + 32 * 144 + d0 * 32);
                    p0 = __builtin_amdgcn_mfma_f32_32x32x16_bf16(k0, qf[d0], p0, 0, 0, 0);
                    p1 = __builtin_amdgcn_mfma_f32_32x32x16_bf16(k1, qf[d0], p1, 0, 0, 0);
                }
                const int tq = rh * 32 + r32;
#pragma unroll
                for (int r = 0; r < 16; ++r) { const int s0 = crow(r, hi), s1 = 32 + s0;
                    const bool ok0 = dir == 0 ? (s0 <= tq) : (s0 >= tq), ok1 = dir == 0 ? (s1 <= tq) : (s1 >= tq);
                    p0[r] = ok0 ? p0[r] : 0.f; p1[r] = ok1 ? p1[r] : 0.f; }
                bf16x8 pa0, pa1, pa2, pa3;
#define PK4(P, BASE, OUT) do { unsigned a0 = cvtpk(P[BASE + 0], P[BASE + 1]), a1 = cvtpk(P[BASE + 2], P[BASE + 3]);   \
    unsigned b0 = cvtpk(P[BASE + 4], P[BASE + 5]), b1 = cvtpk(P[BASE + 6], P[BASE + 7]);                              \
    auto r0 = __builtin_amdgcn_permlane32_swap(a0, b0, false, false); auto r1 = __builtin_amdgcn_permlane32_swap(a1, b1, false, false); \
    u32x4 w_ = {r0[0], r1[0], r0[1], r1[1]}; OUT = *reinterpret_cast<bf16x8*>(&w_); } while (0)
                PK4(p0, 0, pa0); PK4(p0, 8, pa1); PK4(p1, 0, pa2); PK4(p1, 8, pa3);
#undef PK4
                pv_one<0>(o, vb, pa0, pa1, pa2, pa3);
                const bf16_t* Sg = GST + ((size_t)(dir * 16 + bh) * 68 + c) * 8192 + (size_t)(cb * 32 + r32) * 64 + hi * 8;
                const bf16x8 s0 = *(const bf16x8*)(Sg), s1 = *(const bf16x8*)(Sg + 16), s2 = *(const bf16x8*)(Sg + 32), s3 = *(const bf16x8*)(Sg + 48);
                o = __builtin_amdgcn_mfma_f32_32x32x16_bf16(qf[0], s0, o, 0, 0, 0);
                o = __builtin_amdgcn_mfma_f32_32x32x16_bf16(qf[1], s1, o, 0, 0, 0);
                o = __builtin_amdgcn_mfma_f32_32x32x16_bf16(qf[2], s2, o, 0, 0, 0);
                o = __builtin_amdgcn_mfma_f32_32x32x16_bf16(qf[3], s3, o, 0, 0, 0);
            }
            __syncthreads();
        }
        { float* O = (float*)(lds + GL_O);
#pragma unroll
          for (int r = 0; r < 16; ++r) O[(rh * 32 + crow(r, hi)) * 132 + cb * 32 + r32] = o[r]; }
        __syncthreads();
        {
            const int t = tid >> 3, jg = (tid & 7) * 16; const float* O = (const float*)(lds + GL_O) + t * 132 + jg;
            float v[16], ss = 0.f;
#pragma unroll
            for (int q = 0; q < 4; ++q) { const f32x4 x = *(const f32x4*)(O + 4 * q); v[4 * q] = x[0]; v[4 * q + 1] = x[1]; v[4 * q + 2] = x[2]; v[4 * q + 3] = x[3]; ss += x[0] * x[0] + x[1] * x[1] + x[2] * x[2] + x[3] * x[3]; }
            ss += shx(ss, 1, lane); ss += shx(ss, 2, lane); ss += shx(ss, 4, lane);
            const float rstd = rsqrtf(ss * (1.f / 128.f) + EPS);
            const int row = gla_row0(b, c) + t;
            const bf16_t* gp = PR_ + (size_t)row * INWP + C_GG + h * 128 + jg; const float* go = p.gla_g_out + l * 128 + jg;
            const bf16x8 g0 = *(const bf16x8*)(gp), g1 = *(const bf16x8*)(gp + 8);
            float ov[16];
#pragma unroll
            for (int j = 0; j < 16; ++j) { const float gate = bf2f((bf16_t)(j < 8 ? g0[j] : g1[j - 8])); ov[j] = v[j] * rstd * go[j] * silu_f(gate); }
            u32x4 w0, w1; w0.x = pk2(ov[0], ov[1]); w0.y = pk2(ov[2], ov[3]); w0.z = pk2(ov[4], ov[5]); w0.w = pk2(ov[6], ov[7]); w1.x = pk2(ov[8], ov[9]); w1.y = pk2(ov[10], ov[11]); w1.z = pk2(ov[12], ov[13]); w1.w = pk2(ov[14], ov[15]);
            bf16_t* dst = MIX + (size_t)row * D + h * 128 + jg; *(u32x4*)(dst) = w0; *(u32x4*)(dst + 8) = w1;
        }
        __syncthreads();
    }
}

namespace pg {
constexpr int BK = 64, HALF = 128, HTB = HALF * BK * 2, STAGE_BYTES = 8 * HTB;
DI int lds_byte(int r, int c) { const int st = (r >> 4) * 2 + (c >> 5), rr = r & 15, cc = c & 31, ob = rr * 64 + cc * 2; return st * 1024 + (ob ^ (((ob >> 9) & 1) << 5)); }
DI int perm32(int rho) { const int n = rho >> 4, i = rho & 15; return 8 * (i >> 2) + 4 * n + (i & 3); }
DI void stage_rc(int b, int& R, int& C) { const int st = b / 1024, sb = b % 1024, swz = sb ^ (((sb >> 9) & 1) << 5); R = (st >> 1) * 16 + swz / 64; C = (st & 1) * 32 + (swz % 64) / 2; }
struct XUnit {
    const char* A;
    const char* B;
    int arow0;
    int list;
    int e0, e1, e2, e3;
};
template <class Sched>
DI void gemm_phase(LAS unsigned char* lds, const LAS int* rowlists, const Sched& S) {
    int tid = threadIdx.x; asm volatile("" : "+v"(tid));
    const int wid = __builtin_amdgcn_readfirstlane(tid >> 6), lane = tid & 63, wr = wid >> 2, wc = wid & 3, fr = lane & 15, fq = lane >> 4;
    const int K = S.K, nt = K / BK;
    unsigned voffB[2];
#pragma unroll
    for (int i = 0; i < 2; ++i) { int R_, C_; stage_rc(tid * 16 + i * 8192, R_, C_); if (Sched::PERM) R_ = (R_ & ~31) + perm32(R_ & 31); voffB[i] = (unsigned)R_ * (unsigned)S.ldb + (unsigned)C_ * 2u; }
    const size_t kstep = (size_t)(BK * 2), hstepB = (size_t)HALF * S.ldb;
    const unsigned ldsw = (unsigned)wid * 1024u;
    const int aoff = lds_byte(wr * 64 + fr, fq * 8), boff = lds_byte(wc * 32 + fr, fq * 8);
#define PG_SA(b, h) (((b) * 2 + (h)) * HTB)
#define PG_SB(b, h) ((4 + (b) * 2 + (h)) * HTB)
#define PG_STAGE(bufoff, gbase, voff) do { _Pragma("unroll") for (int _i = 0; _i < 2; ++_i) \
        __builtin_amdgcn_global_load_lds((const unsigned*)((const char*)(gbase) + (voff)[_i]), (LAS unsigned*)(lds + (bufoff) + ldsw + _i * 8192), 16, 0, 0); } while (0)
#define PG_LDA(dst, b, h) do { _Pragma("unroll") for (int m = 0; m < 4; ++m) _Pragma("unroll") for (int k = 0; k < 2; ++k) dst[m][k] = *(const LAS bf16x8*)(lds + PG_SA(b, h) + aoff + m * 2048 + k * 1024); } while (0)
#define PG_LDB(dst, b, h) do { _Pragma("unroll") for (int n = 0; n < 2; ++n) _Pragma("unroll") for (int k = 0; k < 2; ++k) dst[n][k] = *(const LAS bf16x8*)(lds + PG_SB(b, h) + boff + n * 2048 + k * 1024); } while (0)
#define PG_MMA(ai, bj, At, Bt) do { __builtin_amdgcn_s_setprio(1); _Pragma("unroll") for (int m = 0; m < 4; ++m) _Pragma("unroll") for (int n = 0; n < 2; ++n) _Pragma("unroll") for (int k = 0; k < 2; ++k) \
        acc[ai][bj][m][n] = __builtin_amdgcn_mfma_f32_16x16x32_bf16(Bt[n][k], At[m][k], acc[ai][bj][m][n], 0, 0, 0); __builtin_amdgcn_s_setprio(0); } while (0)
#define PG_WAIT_V(n) asm volatile("s_waitcnt vmcnt(" #n ")" ::: "memory")
#define PG_WAIT_L(n) asm volatile("s_waitcnt lgkmcnt(" #n ")" ::: "memory")
#define PG_BAR __builtin_amdgcn_s_barrier()
#define PG_SCHED __builtin_amdgcn_sched_barrier(0)
#define PG_AOFFS(dst, u) do { const int _t = tid_here(); _Pragma("unroll") for (int _i = 0; _i < 2; ++_i) { int _R, _C; stage_rc(_t * 16 + _i * 8192, _R, _C); _Pragma("unroll") for (int _h = 0; _h < 2; ++_h) { \
        unsigned _row; if ((u).list >= 0) { const int _x = rowlists[(u).list + _h * HALF + _R]; _row = _x >= 0 ? (unsigned)(_x >> S.rowshift) : 0u; } else _row = (unsigned)((u).arow0 + _h * HALF + _R); \
        dst[_h][_i] = _row * (unsigned)S.lda + (unsigned)_C * 2u; } } } while (0)
    XUnit cur, nxt; int ui = 0;
    if (!S.next(0, cur)) return;
    f32x4 acc[2][2][4][2];
#pragma unroll
    for (int a = 0; a < 2; ++a)
#pragma unroll
        for (int b = 0; b < 2; ++b)
#pragma unroll
            for (int m = 0; m < 4; ++m)
#pragma unroll
                for (int n = 0; n < 2; ++n) acc[a][b][m][n] = (f32x4){0.f, 0.f, 0.f, 0.f};
    bf16x8 At[4][2], B0[2][2], B1[2][2];
    unsigned ao[2][2];
    PG_AOFFS(ao, cur);
    PG_WAIT_L(0); PG_SCHED;
    const char* cA = cur.A; const char* cB = cur.B;
    PG_STAGE(PG_SB(0, 0), cB, voffB); PG_STAGE(PG_SA(0, 0), cA, ao[0]); PG_STAGE(PG_SB(0, 1), cB + hstepB, voffB); PG_STAGE(PG_SA(0, 1), cA, ao[1]);
    if (wr == 1) PG_BAR;
    PG_WAIT_V(4); PG_BAR;
    PG_STAGE(PG_SB(1, 0), cB + kstep, voffB); PG_STAGE(PG_SA(1, 0), cA + kstep, ao[0]); PG_STAGE(PG_SB(1, 1), cB + hstepB + kstep, voffB);
    PG_WAIT_V(6); PG_BAR;
    for (;;) {
        const bool has_next = S.next(ui + 1, nxt);
        const char* nA = has_next ? nxt.A : cA; const char* nB = has_next ? nxt.B : cB;
        for (int t = 0; t < nt; t += 2) {
            const bool last = (t == nt - 2);
            const char* a1 = cA + (size_t)(t + 1) * kstep;
            const char* a2 = last ? nA : cA + (size_t)(t + 2) * kstep; const char* b2 = last ? nB : cB + (size_t)(t + 2) * kstep;
            const char* a3 = a2 + kstep; const char* b3 = b2 + kstep;
            PG_LDB(B0, 0, 0); PG_SCHED; PG_LDA(At, 0, 0); PG_STAGE(PG_SA(1, 1), a1, ao[1]);
            PG_WAIT_L(8); PG_BAR; PG_WAIT_L(0); PG_MMA(0, 0, At, B0); PG_BAR; PG_SCHED;
            if (last && has_next) { PG_AOFFS(ao, nxt); }
            PG_LDB(B1, 0, 1); PG_STAGE(PG_SB(0, 0), b2, voffB);
            PG_BAR; PG_WAIT_L(0); PG_MMA(0, 1, At, B1); PG_BAR;
            PG_LDA(At, 0, 1); PG_STAGE(PG_SA(0, 0), a2, ao[0]);
            PG_BAR; PG_WAIT_L(0); PG_MMA(1, 0, At, B0); PG_BAR; PG_SCHED;
            PG_STAGE(PG_SB(0, 1), b2 + hstepB, voffB);
            PG_WAIT_V(6); PG_BAR; PG_MMA(1, 1, At, B1); PG_BAR;
            PG_LDB(B0, 1, 0); PG_SCHED; PG_LDA(At, 1, 0); PG_STAGE(PG_SA(0, 1), a2, ao[1]);
            PG_WAIT_L(8); PG_BAR; PG_WAIT_L(0); PG_MMA(0, 0, At, B0); PG_BAR; PG_SCHED;
            PG_LDB(B1, 1, 1); PG_STAGE(PG_SB(1, 0), b3, voffB);
            PG_BAR; PG_WAIT_L(0); PG_MMA(0, 1, At, B1); PG_BAR;
            PG_LDA(At, 1, 1); PG_STAGE(PG_SA(1, 0), a3, ao[0]);
            PG_BAR; PG_WAIT_L(0); PG_MMA(1, 0, At, B0); PG_BAR; PG_SCHED;
            PG_STAGE(PG_SB(1, 1), b3 + hstepB, voffB);
            PG_WAIT_V(6); PG_BAR; PG_MMA(1, 1, At, B1); PG_BAR;
        }
        { const int t2 = tid_here(), w2 = t2 >> 6, l2 = t2 & 63; S.epi(acc, cur, w2 >> 2, w2 & 3, l2 & 15, l2 >> 4); }
        if (!has_next) break;
#pragma unroll
        for (int a = 0; a < 2; ++a)
#pragma unroll
            for (int b = 0; b < 2; ++b)
#pragma unroll
                for (int m = 0; m < 4; ++m)
#pragma unroll
                    for (int n = 0; n < 2; ++n) acc[a][b][m][n] = (f32x4){0.f, 0.f, 0.f, 0.f};
        cur = nxt; cA = nA; cB = nB; ++ui;
    }
    PG_WAIT_V(0);
    if (wr == 0) PG_BAR;
    PG_BAR;
#undef PG_SA
#undef PG_SB
#undef PG_STAGE
#undef PG_LDA
#undef PG_LDB
#undef PG_MMA
#undef PG_WAIT_V
#undef PG_WAIT_L
#undef PG_BAR
#undef PG_SCHED
#undef PG_AOFFS
}
}

DI void phase_router(PR p, int l, char* lds, bool dry = false) {
    const int tid = tid_here(), wid = tid >> 6, lane = tid & 63;
    const unsigned char* wl = p.ws + WS_WEIGHTS + (size_t)l * WL_END;
    const bf16_t* WH = (const bf16_t*)(wl + WL_WRH); const bf16_t* WLo = (const bf16_t*)(wl + WL_WRL);
    const bf16_t* HH = (const bf16_t*)(p.ws + WS_HBUF); const bf16_t* HL = (const bf16_t*)(p.ws + WS_U + U_HLO);
    int* EIDX = (int*)(p.ws + WS_EIDX); float* EW = (float*)(p.ws + WS_EW); int* EPOS = (int*)(p.ws + WS_EPOS);
    unsigned* cnt = (unsigned*)(p.ws + WS_CNT) + l * 64;
    const float rbias = p.router_b[l * 64 + lane];
    float* LG = (float*)lds + wid * (16 * 65 + 16 * 64);
    int* PKI = (int*)(LG + 16 * 65);
    const int ntok = l == 0 ? NTOK : NLAT, ngrp = ntok / 16;
    const int fr = lane & 15, fq = lane >> 4;
    for (int gidx = bid_here() * 8 + wid; gidx < ngrp; gidx += gridDim.x * 8) {
        const int row0 = gidx * 16;
        f32x4 acc[4];
#pragma unroll
        for (int e = 0; e < 4; ++e) acc[e] = (f32x4){0.f, 0.f, 0.f, 0.f};
        const bf16_t* ah = HH + (size_t)(row0 + fr) * D + fq * 8; const bf16_t* al = HL + (size_t)(row0 + fr) * D + fq * 8;
        const bf16_t* bh = WH + (size_t)fr * D + fq * 8; const bf16_t* bl = WLo + (size_t)fr * D + fq * 8;
        for (int k0 = 0; k0 < D; k0 += 128) {
            bf16x8 a_hi[4], a_lo[4], b_hi[4][4], b_lo[4][4];
#pragma unroll
            for (int j = 0; j < 4; ++j) { a_hi[j] = *(const bf16x8*)(ah + k0 + 32 * j); a_lo[j] = *(const bf16x8*)(al + k0 + 32 * j);
#pragma unroll
                for (int e = 0; e < 4; ++e) { b_hi[j][e] = *(const bf16x8*)(bh + (size_t)e * 16 * D + k0 + 32 * j); b_lo[j][e] = *(const bf16x8*)(bl + (size_t)e * 16 * D + k0 + 32 * j); } }
#pragma unroll
            for (int j = 0; j < 4; ++j)
#pragma unroll
                for (int e = 0; e < 4; ++e) {
                    acc[e] = __builtin_amdgcn_mfma_f32_16x16x32_bf16(a_hi[j], b_hi[j][e], acc[e], 0, 0, 0);
                    acc[e] = __builtin_amdgcn_mfma_f32_16x16x32_bf16(a_hi[j], b_lo[j][e], acc[e], 0, 0, 0);
                    acc[e] = __builtin_amdgcn_mfma_f32_16x16x32_bf16(a_lo[j], b_hi[j][e], acc[e], 0, 0, 0);
                }
        }
#pragma unroll
        for (int e = 0; e < 4; ++e)
#pragma unroll
            for (int i = 0; i < 4; ++i) LG[(fq * 4 + i) * 65 + e * 16 + fr] = acc[e][i];
        asm volatile("s_waitcnt lgkmcnt(0)" ::: "memory");
        __builtin_amdgcn_wave_barrier();
        int mycount = 0;
        for (int t = 0; t < 16; ++t) {
            const float sc = sigmoid_f(LG[t * 65 + lane]), v = sc + rbias;
            float m1 = v, m2 = -INFINITY;
#pragma unroll
            for (int o = 1; o < 8; o <<= 1) { const float b1 = shx(m1, o, lane), b2 = shx(m2, o, lane); const float n1 = fmaxf(m1, b1), n2 = fmaxf(fminf(m1, b1), fmaxf(m2, b2)); m1 = n1; m2 = n2; }
            const float gs = m1 + m2;
            int grank = 0; const int g = lane >> 3;
#pragma unroll
            for (int gg = 0; gg < 8; ++gg) { const float s = __int_as_float(__builtin_amdgcn_readlane(__float_as_int(gs), gg * 8)); grank += (s > gs || (s == gs && gg < g)) ? 1 : 0; }
            const bool gsel = grank < 4;
            const float vs = gsel ? v : -INFINITY;
            int erk = 0;
#pragma unroll 4
            for (int j = 0; j < 64; ++j) { const float s = __int_as_float(__builtin_amdgcn_readlane(__float_as_int(vs), j)); erk += (s > vs || (s == vs && j < lane)) ? 1 : 0; }
            const bool chosen = gsel && erk < 8;
            const float wsum = wave_sum(chosen ? sc : 0.f);
            int pk = -1;
            if (chosen) { const int a = (row0 + t) * 8 + erk; EIDX[a] = lane; EW[a] = sc * (2.5f / wsum); pk = erk | (mycount << 8); ++mycount; }
            PKI[t * 64 + lane] = pk;
        }
        const unsigned base = (mycount && !dry) ? atomicAdd(&cnt[lane], (unsigned)mycount) : 0u;
        if (!dry) {
#pragma unroll
            for (int t = 0; t < 16; ++t) { const int pk = PKI[t * 64 + lane]; if (pk >= 0) EPOS[(row0 + t) * 8 + (pk & 255)] = (int)base + (pk >> 8); }
        }
        asm volatile("s_waitcnt lgkmcnt(0)" ::: "memory");
        __builtin_amdgcn_wave_barrier();
    }
}
DI void phase_moe_index(PR p, int l, char* lds) {
    const int tid = tid_here();
    int* S = (int*)lds;
    const unsigned* cnt = (const unsigned*)(p.ws + WS_CNT) + l * 64;
    int* META = (int*)(p.ws + WS_META) + l * 1024;
    const int* EIDX = (const int*)(p.ws + WS_EIDX); const float* EW = (const float*)(p.ws + WS_EW); const int* EPOS = (const int*)(p.ws + WS_EPOS);
    int* SASG = (int*)(p.ws + WS_SASG); float* SW = (float*)(p.ws + WS_SW);
    if (tid < 64) S[128 + tid] = (int)cnt[tid];
    __syncthreads();
    if (tid == 0) { int s = 0; for (int e = 0; e < 64; ++e) { S[e] = s; s += (S[128 + e] + 255) / 256 * 256; } S[64] = s; }
    __syncthreads();
    const int ntok = l == 0 ? NTOK : NLAT;
    for (int a = bid_here() * NTHREADS + tid; a < ntok * 8; a += gridDim.x * NTHREADS) { const int e = EIDX[a], pos = S[e] + EPOS[a]; SASG[pos] = a; SW[pos] = EW[a]; }
    for (int i = bid_here() * NTHREADS + tid; i < 64 * 256; i += gridDim.x * NTHREADS) { const int e = i >> 8, q = i & 255, c = S[128 + e]; if (S[e] + c + q < S[e + 1]) { SASG[S[e] + c + q] = -1; SW[S[e] + c + q] = 0.f; } }
    if (blockIdx.x == 0) {
        if (tid == 0) META[0] = S[64] / 256;
        if (tid < 64) { for (int t = S[tid] / 256; t < S[tid + 1] / 256; ++t) META[256 + t] = tid; }
    }
}

struct OrderXcd {
    int nM, nN, nwg;
    DI void init(int nM_, int nN_) { nM = nM_; nN = nN_; nwg = nM_ * nN_; }
    DI bool map(int i, int& pm, int& pn) const {
        const int L = i * (int)gridDim.x + (int)blockIdx.x; if (L >= nwg) return false;
        int wgid = L; { const int q = nwg / 8, r = nwg % 8, xcd = wgid % 8, off = wgid / 8; wgid = (xcd < r ? xcd * (q + 1) : r * (q + 1) + (xcd - r) * q) + off; }
        const int nig = 8 * nN, gid = wgid / nig, fm = gid * 8, gsz = (nM - fm) < 8 ? (nM - fm) : 8;
        pm = fm + ((wgid % nig) % gsz); pn = (wgid % nig) / gsz; return true;
    }
    DI bool lin(int i, int& w) const {
        const int L = i * (int)gridDim.x + (int)blockIdx.x; if (L >= nwg) return false;
        const int q = nwg / 8, r = nwg % 8, xcd = L % 8, off = L / 8; w = (xcd < r ? xcd * (q + 1) : r * (q + 1) + (xcd - r) * q) + off; return true;
    }
};
#define GACC const f32x4 (&acc)[2][2][4][2]
struct SchedInproj {
    static constexpr bool PERM = true;
    int lda, ldb, K, rowshift; const char* A; const char* W; bf16_t* proj; OrderXcd o;
    DI bool next(int i, pg::XUnit& u) const { int pm, pn; if (!o.map(i, pm, pn)) return false; u.A = A; u.B = W + (size_t)pn * 256 * ldb; u.arow0 = pm * 256; u.list = -1; u.e0 = pm * 256; u.e1 = pn * 256; return true; }
    DI void epi(GACC, const pg::XUnit& u, int wr, int wc, int fr, int fq) const { EpiB16P E; E.O = proj; E.row0 = u.e0; E.col0 = u.e1; E.ld = INWP; E(acc, wr, wc, fr, fq); }
};
DI void phase_inproj(PR p, int l, char* lds) {
    SchedInproj S; S.lda = D * 2; S.ldb = D * 2; S.K = D; S.rowshift = 0; S.A = (const char*)(p.ws + WS_HBUF); S.W = (const char*)(p.ws + WS_WEIGHTS + (size_t)l * WL_END + WL_WIN);
    S.proj = (bf16_t*)(p.ws + WS_U + U_PROJ); S.o.init(68, 15);
    pg::gemm_phase((LAS unsigned char*)lds, (const LAS int*)(lds + pg::STAGE_BYTES), S);
}
struct SchedMlaUp {
    static constexpr bool PERM = false;
    int lda, ldb, K, rowshift; const char* CQ; const char* CKV; const char* WQ; const char* WKV; bf16_t* Qm; bf16_t* Km; bf16_t* Vm; const float2* ropem; OrderXcd o;
    DI bool next(int i, pg::XUnit& u) const { int w; if (!o.lin(i, w)) return false; u.list = -1;
        if (w < 340) { const int pm = w / 5, pn = w % 5; u.A = CQ; u.B = WQ + (size_t)pn * 256 * ldb; u.arow0 = pm * 256; u.e0 = pm * 256; u.e1 = pn * 256; u.e3 = 0; }
        else { const int v = w - 340, pm = v / 6, pn = v % 6; u.A = CKV; u.B = WKV + (size_t)pn * 256 * ldb; u.arow0 = pm * 256; u.e0 = pm * 256; u.e1 = pn * 256; u.e3 = 1; }
        return true; }
    DI void epi(GACC, const pg::XUnit& u, int wr, int wc, int fr, int fq) const {
        if (u.e3 == 0) { EpiUq E; E.Q = Qm; E.ropem = ropem; E.row0 = u.e0; E.col0 = u.e1; E(acc, wr, wc, fr, fq); }
        else { EpiUkv E; E.Km = Km; E.Vm = Vm; E.row0 = u.e0; E.col0 = u.e1; E(acc, wr, wc, fr, fq); } }
};
DI void phase_mla_up(PR p, int l, char* lds) {
    unsigned char* U = p.ws + WS_U; const unsigned char* wl = p.ws + WS_WEIGHTS + (size_t)l * WL_END;
    SchedMlaUp S; S.lda = 1024; S.ldb = 1024; S.K = 512; S.rowshift = 0; S.CQ = (const char*)(U + U_CQN); S.CKV = (const char*)(U + U_CKVN); S.WQ = (const char*)(wl + WL_WUQ); S.WKV = (const char*)(wl + WL_WUKV);
    S.Qm = (bf16_t*)(U + U_QM); S.Km = (bf16_t*)(U + U_KM); S.Vm = (bf16_t*)(U + U_VM); S.ropem = (const float2*)(p.ws + WS_ROPEM); S.o.init(748, 1);
    pg::gemm_phase((LAS unsigned char*)lds, (const LAS int*)(lds + pg::STAGE_BYTES), S);
}
struct SchedOutproj {
    static constexpr bool PERM = true;
    int lda, ldb, K, rowshift; const char* A; const char* W; bf16_t* Y; OrderXcd o;
    DI bool next(int i, pg::XUnit& u) const { int pm, pn; if (!o.map(i, pm, pn)) return false; u.A = A; u.B = W + (size_t)pn * 256 * ldb; u.arow0 = pm * 256; u.list = -1; u.e0 = pm * 256; u.e1 = pn * 256; return true; }
    DI void epi(GACC, const pg::XUnit& u, int wr, int wc, int fr, int fq) const { EpiB16P E; E.O = Y; E.row0 = u.e0; E.col0 = u.e1; E.ld = D; E(acc, wr, wc, fr, fq); }
};
DI void phase_outproj(PR p, int l, char* lds) {
    SchedOutproj S; S.lda = D * 2; S.ldb = D * 2; S.K = D; S.rowshift = 0; S.A = (const char*)(p.ws + WS_U + U_MIX); S.W = (const char*)(p.ws + WS_WEIGHTS + (size_t)l * WL_END + WL_WOUT);
    S.Y = (bf16_t*)(p.ws + WS_U + U_Y); S.o.init(l == 0 ? 68 : 64, 8);
    pg::gemm_phase((LAS unsigned char*)lds, (const LAS int*)(lds + pg::STAGE_BYTES), S);
}
struct SchedMoe1 {
    static constexpr bool PERM = true;
    int lda, ldb, K, rowshift; const char* H; const char* W13; bf16_t* act; const LAS int* uexp; int ntiles; OrderXcd o;
    DI bool next(int i, pg::XUnit& u) const { int tile, pn; if (!o.map(i, tile, pn)) return false; u.A = H;
        if (tile < ntiles) { const int e = __builtin_amdgcn_readfirstlane(uexp[i]); u.B = W13 + ((size_t)e * 1024 + pn * 256) * ldb; u.list = i * 256; u.arow0 = 0; u.e0 = tile * 256; }
        else { const int ts = tile - ntiles; u.B = W13 + ((size_t)64 * 1024 + pn * 256) * ldb; u.list = -1; u.arow0 = ts * 256; u.e0 = PMAX + ts * 256; }
        u.e1 = pn * 128; return true; }
    DI void epi(GACC, const pg::XUnit& u, int wr, int wc, int fr, int fq) const { EpiMoe1P E; E.act = act; E.arow0 = u.e0; E.hcol0 = u.e1; E(acc, wr, wc, fr, fq); }
};
DI void phase_moe1(PR p, int l, char* lds) {
    const int* META = (const int*)(p.ws + WS_META) + l * 1024; const int ntiles = __builtin_amdgcn_readfirstlane(META[0]), nsh = l == 0 ? 68 : 64;
    SchedMoe1 S; S.lda = D * 2; S.ldb = D * 2; S.K = D; S.rowshift = 3; S.H = (const char*)(p.ws + WS_HBUF); S.W13 = (const char*)(p.ws + WS_WEIGHTS + (size_t)l * WL_END + WL_W13);
    S.act = (bf16_t*)(p.ws + WS_U + U_ACT); S.uexp = (const LAS int*)(lds + pg::STAGE_BYTES) + 31 * 256; S.ntiles = ntiles; S.o.init(ntiles + nsh, 4);
    { const int tid = tid_here(); LAS int* RL = (LAS int*)(lds + pg::STAGE_BYTES); const int* SASG = (const int*)(p.ws + WS_SASG);
      for (int i = 0; i < 31; ++i) { int tile, pn; if (!S.o.map(i, tile, pn)) break; if (tile < ntiles && tid < 256) RL[i * 256 + tid] = SASG[tile * 256 + tid];
          if (tid == 0) RL[31 * 256 + i] = tile < ntiles ? META[256 + tile] : 64; }
      __syncthreads(); }
    pg::gemm_phase((LAS unsigned char*)lds, (const LAS int*)(lds + pg::STAGE_BYTES), S);
}
struct SchedMoe2 {
    static constexpr bool PERM = true;
    int lda, ldb, K, rowshift; const char* ACT; const char* W2; bf16_t* oasg; const int* sasg; const float* sw; bf16_t* ysh; const LAS int* uexp; int ntiles; int fp8; OrderXcd o;
    DI bool next(int i, pg::XUnit& u) const { int tile, pn; if (!o.map(i, tile, pn)) return false; u.A = ACT; u.list = -1;
        if (tile < ntiles) { const int e = __builtin_amdgcn_readfirstlane(uexp[i]); u.B = W2 + ((size_t)e * D + pn * 256) * ldb; u.arow0 = tile * 256; u.e0 = tile * 256; u.e3 = 0; }
        else { const int ts = tile - ntiles; u.B = W2 + ((size_t)64 * D + pn * 256) * ldb; u.arow0 = PMAX + ts * 256; u.e0 = ts * 256; u.e3 = 1; }
        u.e1 = pn * 256; return true; }
    DI void epi(GACC, const pg::XUnit& u, int wr, int wc, int fr, int fq) const {
        if (u.e3 == 0 && fp8) { EpiMoe2F8 E; E.oasg = (unsigned char*)oasg; E.sasg = sasg; E.sw = sw; E.srow0 = u.e0; E.col0 = u.e1; E(acc, wr, wc, fr, fq); }
        else if (u.e3 == 0) { EpiMoe2P E; E.oasg = oasg; E.sasg = sasg; E.sw = sw; E.srow0 = u.e0; E.col0 = u.e1; E(acc, wr, wc, fr, fq); }
        else { EpiB16P E; E.O = ysh; E.row0 = u.e0; E.col0 = u.e1; E.ld = D; E(acc, wr, wc, fr, fq); } }
};
DI void phase_moe2(PR p, int l, char* lds) {
    const int* META = (const int*)(p.ws + WS_META) + l * 1024; const int ntiles = __builtin_amdgcn_readfirstlane(META[0]), nsh = l == 0 ? 68 : 64;
    SchedMoe2 S; S.lda = 1024; S.ldb = 1024; S.K = 512; S.rowshift = 0; S.ACT = (const char*)(p.ws + WS_U + U_ACT); S.W2 = (const char*)(p.ws + WS_WEIGHTS + (size_t)l * WL_END + WL_W2);
    S.oasg = (bf16_t*)(p.ws + WS_U + U_OASG); S.sasg = (const int*)(p.ws + WS_SASG); S.sw = (const float*)(p.ws + WS_SW); S.ysh = (bf16_t*)(p.ws + WS_U + U_YSH); S.uexp = (const LAS int*)(lds + pg::STAGE_BYTES); S.ntiles = ntiles; S.fp8 = (OASG_FP8_MASK >> l) & 1; S.o.init(ntiles + nsh, 8);
    { const int tid = tid_here(); LAS int* UE = (LAS int*)(lds + pg::STAGE_BYTES);
      if (tid < 64) { int tile, pn; if (S.o.map(tid, tile, pn)) UE[tid] = tile < ntiles ? META[256 + tile] : 64; }
      __syncthreads(); }
    pg::gemm_phase((LAS unsigned char*)lds, (const LAS int*)(lds + pg::STAGE_BYTES), S);
}
DI void phase_attention(PR p, int l, char* lds) {
#define ATT_PTRS unsigned char* U = p.ws + WS_U; asm volatile("" : "+s"(U)); \
    const bf16_t* Qm = (const bf16_t*)(U + U_QM); const bf16_t* Km = (const bf16_t*)(U + U_KM); const bf16_t* Vm = (const bf16_t*)(U + U_VM); \
    const bf16_t* Qg = (const bf16_t*)(U + U_QG); const bf16_t* Kg = (const bf16_t*)(U + U_KG); const bf16_t* Vg = (const bf16_t*)(U + U_VG); bf16_t* MIX = (bf16_t*)(U + U_MIX);
    const int xcd = blockIdx.x & 7, rank = blockIdx.x >> 3, nr = (gridDim.x + 7 - xcd) >> 3;
    const int nloc = 48 + (l == 0 ? 3 : 0);
    if (SUB & 1) for (int v = rank; v < nloc; v += nr) {
        ATT_PTRS; (void)Qg; (void)Kg; (void)Vg;
        int b, h, qt, isctx;
        if (v < 48) { const int bh = xcd * 3 + v / 16; b = bh / 6; h = bh % 6; qt = v & 15; isctx = 0; } else { const int bh = xcd * 3 + (v - 48); b = bh / 6; h = bh % 6; qt = 0; isctx = 1; }
        const int qpos = isctx ? 0 : CTXL + qt * 256, seq = isctx ? CTXL : SKV, orow = isctx ? NLAT + b * CTXL : b * SEQ + qt * 256;
        attn_body<192, ATT_SD_M>(Qm + (((size_t)b * 6 + h) * SKV + qpos) * 192, Km + ((size_t)b * 6 + h) * SKV * 192, Vm + ((size_t)b * 6 + h) * SKV * 128,
                                 MIX + (size_t)orow * D + 512 + h * 128, D, seq, lds, 0.07216878364870322f);
    }
    if (SUB & 2) for (int v = nr - 1 - rank; v < nloc; v += nr) {
        ATT_PTRS; (void)Qm; (void)Km; (void)Vm;
        int b, h, qt, isctx; const int kvh = xcd & 1; b = xcd >> 1;
        if (v < 48) { h = kvh * 3 + v / 16; qt = v & 15; isctx = 0; } else { h = kvh * 3 + (v - 48); qt = 0; isctx = 1; }
        const int qpos = isctx ? 0 : CTXL + qt * 256, seq = isctx ? CTXL : SKV, orow = isctx ? NLAT + b * CTXL : b * SEQ + qt * 256;
        attn_body<128, ATT_SD_G>(Qg + (((size_t)b * 6 + h) * SKV + qpos) * 128, Kg + ((size_t)b * 2 + kvh) * SKV * 128, Vg + ((size_t)b * 2 + kvh) * SKV * 128,
                                 MIX + (size_t)orow * D + 1280 + h * 128, D, seq, lds, 0.08838834764831845f);
    }
#undef ATT_PTRS
    if (SUB & 4) gla_phaseC(p, l, lds);
}

constexpr int NPH_LAYER = 12, NPH = 1 + 2 * NPH_LAYER;
constexpr int LDS_BYTES = 160 * 1024;
__global__ void __launch_bounds__(NTHREADS, 2) fwd(Params p_arg, int ph_lo, int ph_hi) {
    char* lds = shm + 256;
    volatile LAS unsigned* xbw = (volatile LAS unsigned*)shm;
    const bool fused = (ph_hi - ph_lo) > 1;
    XcdBarrier bar; bar.bar = (unsigned*)(p_arg.ws + WS_BAR); bar.x = 0; bar.st = xbw;
    if (fused) {
        if (threadIdx.x == 0) { xbw[0] = 0u; xbw[1] = 0u; xbw[2] = 0u; xbw[3] = 0u; }
        __syncthreads();
        bar = xcd_barrier_post((unsigned*)(p_arg.ws + WS_BAR), xbw);
    }
    const CAS Params* pk = (const CAS Params*)__builtin_amdgcn_kernarg_segment_ptr();
#define PHASE(idx, CALL) do { if (((PH_MASK >> ((idx) == 0 ? 0 : ((idx) - 1) % NPH_LAYER + 1)) & 1) && (idx) >= ph_lo && (idx) < ph_hi) { const CAS Params* q_ = pk; asm volatile("" : "+s"(q_)); PR p = *q_; int probe_pass = 0; (void)probe_pass; CALL; if ((PROBE_MASK >> ((idx) == 0 ? 0 : ((idx) - 1) % NPH_LAYER + 1)) & 1) { probe_pass = 1; CALL; } if (fused && (idx) + 1 < ph_hi) xcd_barrier(bar); } } while (0)
#define TAIL(ph) ((fused && !probe_pass) ? fill_tail(p, lds, (ph)) : (void)0)
    PHASE(0, phase_prologue(p, lds));
    for (int l = 0; l < 2; ++l) {
        const int b0 = 1 + l * NPH_LAYER;
        if (l == 0) PHASE(b0 + 0, phase_norm1(p, 0));
        PHASE(b0 + 1, phase_inproj(p, l, lds));
        PHASE(b0 + 2, (phase_postproj_rows(p, l), gla_phaseA(p, l, lds)));
        PHASE(b0 + 3, (phase_mla_up(p, l, lds), gla_scan(p)));
        PHASE(b0 + 4, (phase_attention(p, l, lds), TAIL(b0 + 4)));
        PHASE(b0 + 5, phase_outproj(p, l, lds));
        PHASE(b0 + 6, ((probe_pass && l == 1) ? (void)0 : phase_postmix(p, l)));
        PHASE(b0 + 7, phase_router(p, l, lds, probe_pass != 0));
        PHASE(b0 + 8, (phase_moe_index(p, l, lds), fill_drain(p, lds, (l + 1) * CHUNKS_PER_LAYER)));
        PHASE(b0 + 9, (move_head(p, (l + 1) * CHUNKS_PER_LAYER), phase_moe1(p, l, lds), TAIL(b0 + 9)));
        PHASE(b0 + 10, (phase_moe2(p, l, lds), TAIL(b0 + 10)));
        PHASE(b0 + 11, ((probe_pass && l == 0) ? (void)0 : phase_postffn(p, l)));
    }
#undef PHASE
#undef TAIL
}

extern "C" void kernel_launch(void* const* d_in, const int* in_sizes, int n_in, void* d_out, int out_size, void* d_ws, size_t ws_size, hipStream_t stream) {
    static int grid = 0;
    if (!grid) {
        if (ws_size < WS_TOTAL) { fprintf(stderr, "kernel_launch: workspace too small: %zu < %zu\n", ws_size, (size_t)WS_TOTAL); return; }
        if (hipFuncSetAttribute((const void*)fwd, hipFuncAttributeMaxDynamicSharedMemorySize, LDS_BYTES) != hipSuccess) { fprintf(stderr, "kernel_launch: hipFuncSetAttribute failed\n"); return; }
        int dev = 0, cus = 0, per_cu = 0;
        hipGetDevice(&dev);
        hipDeviceGetAttribute(&cus, hipDeviceAttributeMultiprocessorCount, dev);
        hipOccupancyMaxActiveBlocksPerMultiprocessor(&per_cu, fwd, NTHREADS, LDS_BYTES);
        if (per_cu < 1) { fprintf(stderr, "kernel_launch: occupancy query says %d\n", per_cu); return; }
        grid = cus;
    }
    Params p{};
    const float** f = (const float**)&p;
    for (int i = 0; i < 31; ++i) f[i] = (const float*)d_in[i];
    p.out = (float*)d_out; p.ws = (unsigned char*)d_ws;
    hipMemsetAsync((unsigned char*)d_ws + WS_BAR, 0, WS_CNT, stream);
#if MK_MULTI
    for (int ph = 0; ph < NPH; ++ph) { if (ph == 1 + NPH_LAYER) continue; hipLaunchKernelGGL(fwd, dim3(grid), dim3(NTHREADS), LDS_BYTES, stream, p, ph, ph + 1); }
#else
    hipLaunchKernelGGL(fwd, dim3(grid), dim3(NTHREADS), LDS_BYTES, stream, p, 0, NPH);
#endif
    const hipError_t le = hipPeekAtLastError();
    if (le != hipSuccess) fprintf(stderr, "kernel_launch: launch failed: %s\n", hipGetErrorName(le));
}
```

```cpp
#include <hip/hip_runtime.h>
#include <stdint.h>
#include <stdio.h>

#ifndef PH_MASK
#define PH_MASK 0x1FFF
#endif
#ifndef SUB
#define SUB 7
#endif
#ifndef ATT_SD_M
#define ATT_SD_M 1
#endif
#ifndef ATT_SD_G
#define ATT_SD_G 2
#endif
#ifndef ATT_NQR_M
#define ATT_NQR_M 12
#endif
#ifndef PROBE_MASK
#define PROBE_MASK 0x0
#endif
#ifndef ATT_DMA
#define ATT_DMA 1
#endif
#if ATT_DMA
#define ATT_BODY attn_body2
#else
#define ATT_BODY attn_body_old
#endif
#ifndef MK_MULTI
#define MK_MULTI 0
#endif

typedef unsigned short bf16_t;
typedef short bf16x8 __attribute__((ext_vector_type(8)));
typedef short s16x4 __attribute__((ext_vector_type(4)));
typedef float f32x4 __attribute__((ext_vector_type(4)));
typedef float f32x16 __attribute__((ext_vector_type(16)));
typedef unsigned u32x4 __attribute__((ext_vector_type(4)));
typedef unsigned u32x2 __attribute__((ext_vector_type(2)));
#define DI __device__ __forceinline__

constexpr int D = 2048, NB = 4, SEQ = 4096, CTXL = 256, NLAT = NB * SEQ, NCTX = NB * CTXL, NTOK = NLAT + NCTX, SKV = SEQ + CTXL;
constexpr int INW = 3808, INWP = 3840;
constexpr int C_GQ = 0, C_GK = 256, C_GV = 512, C_GG = 1024, C_ZF = 1536, C_ZB = 1552, C_CQ = 1568, C_CKV = 1952, C_KR = 2464, C_AQ = 2528, C_AK = 3296, C_AV = 3552;
constexpr int NE = 64, TOPK = 8, DEXP = 512;
constexpr int PMAX = NTOK * TOPK + NE * 256;
constexpr int NTHREADS = 512;
constexpr float EPS = 1e-6f;

constexpr size_t MiB = 1024ull * 1024ull;
constexpr size_t al256(size_t x) { return (x + 255) / 256 * 256; }
constexpr size_t WS_BAR = 0;
constexpr size_t WS_CTL = 16384;
constexpr size_t WS_CNT = 16384 + 8192;
constexpr size_t WS_META = WS_CNT + 1024;
constexpr size_t WS_MOD = WS_META + 2 * 4096;
constexpr size_t WS_ROPEG = al256(WS_MOD + 2 * 5 * 12288 * 4);
constexpr size_t WS_ROPEM = WS_ROPEG + 64 * 32 * 8;
constexpr size_t WS_ZROW = WS_ROPEM + 64 * 16 * 8;
constexpr size_t WS_GDEC = WS_ZROW + 4096;
constexpr size_t WS_EIDX = al256(WS_GDEC + 2 * 16 * 68 * 64 * 4);
constexpr size_t WS_EW = WS_EIDX + (size_t)NTOK * 8 * 4;
constexpr size_t WS_EPOS = WS_EW + (size_t)NTOK * 8 * 4;
constexpr size_t WS_SASG = WS_EPOS + (size_t)NTOK * 8 * 4;
constexpr size_t WS_SW = al256(WS_SASG + (size_t)PMAX * 4);
constexpr size_t WS_SMALL_END = al256(WS_SW + (size_t)PMAX * 4);
static_assert(WS_SMALL_END <= 8 * MiB, "small region");
constexpr size_t SZ_WIN = (size_t)INWP * D * 2, SZ_WUQ = (size_t)1280 * 512 * 2, SZ_WUKV = (size_t)1536 * 512 * 2, SZ_WOUT = (size_t)D * D * 2, SZ_WR = (size_t)64 * D * 2;
constexpr size_t SZ_W13 = (size_t)65 * 1024 * D * 2, SZ_W2 = (size_t)65 * D * 512 * 2;
constexpr size_t WL_WIN = 0, WL_WUQ = WL_WIN + SZ_WIN, WL_WUKV = WL_WUQ + SZ_WUQ, WL_WOUT = WL_WUKV + SZ_WUKV, WL_WRH = WL_WOUT + SZ_WOUT, WL_WRL = WL_WRH + SZ_WR,
                 WL_W13 = WL_WRL + SZ_WR, WL_W2 = WL_W13 + SZ_W13, WL_END = WL_W2 + SZ_W2;
constexpr size_t WS_WEIGHTS = 8 * MiB;
constexpr size_t WS_XRES = WS_WEIGHTS + 2 * WL_END;
constexpr size_t WS_HBUF = WS_XRES + (size_t)NTOK * D * 4;
constexpr size_t WS_U = WS_HBUF + (size_t)NTOK * D * 2;
constexpr size_t U_Y = 0;
constexpr size_t U_YSH = (size_t)NTOK * D * 2;
constexpr size_t U_PROJ = U_Y + (size_t)NTOK * D * 4;
constexpr size_t U_QM = U_PROJ + (size_t)NTOK * INWP * 2;
constexpr size_t U_KM = U_QM + (size_t)NB * 6 * SKV * 192 * 2;
constexpr size_t U_VM = U_KM + (size_t)NB * 6 * SKV * 192 * 2;
constexpr size_t U_QG = U_VM + (size_t)NB * 6 * SKV * 128 * 2;
constexpr size_t U_KG = U_QG + (size_t)NB * 6 * SKV * 128 * 2;
constexpr size_t U_VG = U_KG + (size_t)NB * 2 * SKV * 128 * 2;
constexpr size_t U_GS = U_VG + (size_t)NB * 2 * SKV * 128 * 2;
constexpr size_t U_MIX = U_GS + (size_t)2 * 16 * 68 * 64 * 128 * 4;
constexpr size_t U_CQN = U_MIX + (size_t)NTOK * D * 2;
constexpr size_t U_CKVN = U_CQN + (size_t)NTOK * 512 * 2;
constexpr size_t U_GST = U_CKVN + (size_t)NTOK * 512 * 2;
constexpr size_t U_MIX_END = U_GST + (size_t)2 * 16 * 68 * 8192 * 2;
constexpr size_t U_HLO = U_PROJ;
constexpr size_t U_ACT = U_HLO + (size_t)NTOK * D * 2;
constexpr size_t U_OASG = U_ACT + (size_t)(PMAX + NTOK) * 512 * 2;
constexpr size_t U_MOE_END = U_OASG + (size_t)NTOK * 8 * D * 2;
constexpr size_t WS_TOTAL = WS_U + (U_MIX_END > U_MOE_END ? U_MIX_END : U_MOE_END);
static_assert(WS_TOTAL <= 2048ull * MiB, "workspace over 2 GiB");

struct Params {
    const float *x, *c, *ctx, *c_ctx, *w_mod, *b_mod, *g_pre_mix, *g_post_mix, *g_pre_ffn, *g_post_ffn, *w_in, *gla_wg2_f, *gla_bg_f, *gla_wg2_b, *gla_bg_b, *gla_g_out,
        *mla_g_q, *mla_w_uq, *mla_g_kv, *mla_w_ukv, *gqa_g_q, *gqa_g_k, *w_out, *router_w, *router_b, *exp_w1, *exp_w3, *exp_w2, *sh_w1, *sh_w3, *sh_w2;
    float* out; unsigned char* ws;
};

extern __shared__ __attribute__((aligned(16))) char shm[];
#define CAS __attribute__((address_space(4)))
typedef const CAS Params& PR;
DI int bid_here() { int b = blockIdx.x; asm volatile("" : "+s"(b)); return b; }
DI int tid_here() { int t = threadIdx.x; asm volatile("" : "+v"(t)); return t; }
DI float bf2f(bf16_t v) { return __uint_as_float(((unsigned)v) << 16); }
DI bf16_t f2bf(float f) { unsigned u = __float_as_uint(f); u += 0x7FFFu + ((u >> 16) & 1u); return (bf16_t)(u >> 16); }
DI unsigned pk2(float lo, float hi) { unsigned r; asm("v_cvt_pk_bf16_f32 %0, %1, %2" : "=v"(r) : "v"(lo), "v"(hi)); return r; }
DI float shx(float v, int o, int lane) { return __int_as_float(__builtin_amdgcn_ds_bpermute((lane ^ o) << 2, __float_as_int(v))); }
DI float wave_sum(float v) {
    const int lane = tid_here() & 63;
#pragma unroll
    for (int o = 32; o > 0; o >>= 1) v += shx(v, o, lane);
    return v;
}
DI float silu_f(float v) { return v / (1.f + __expf(-v)); }
DI float sigmoid_f(float v) { return 1.f / (1.f + __expf(-v)); }
struct Tok { int b, s, isctx, mrow, kvpos; };
DI Tok tok_of(int r) { Tok t; if (r < NLAT) { t.b = r >> 12; t.s = r & 4095; t.isctx = 0; t.mrow = t.b; t.kvpos = CTXL + t.s; } else { const int q = r - NLAT; t.b = q >> 8; t.s = q & 255; t.isctx = 1; t.mrow = 4; t.kvpos = t.s; } return t; }
DI const float* xrow_in(PR p, int l, int r) { if (l == 0) return r < NLAT ? p.x + (size_t)r * D : p.ctx + (size_t)(r - NLAT) * D; return (const float*)(p.ws + WS_XRES) + (size_t)r * D; }

#define XB_TMO      128
#define XB_XCNT(j)  (256  + 64 * (j))
#define XB_XSUB(j)  (1280 + 64 * (j))
#define XB_XGEN(j)  (2304 + 64 * (j))
#define XB_TOP      3328
#define XB_TOPGEN   3392
#define XCD_BAR_WORDS 3456
#define XB_SPIN_CAP (1u << 18)
#define LAS __attribute__((address_space(3)))
__device__ __forceinline__ unsigned xb_ld(unsigned* p)              { return __hip_atomic_load(p, __ATOMIC_RELAXED, __HIP_MEMORY_SCOPE_AGENT); }
__device__ __forceinline__ unsigned xb_add(unsigned* p, unsigned v) { return __hip_atomic_fetch_add(p, v, __ATOMIC_RELAXED, __HIP_MEMORY_SCOPE_AGENT); }
__device__ __forceinline__ unsigned xb_xcc_id() { return (unsigned)__builtin_amdgcn_s_getreg((3 << 11) | 20) & 0xFu; }
#define XB_SPIN(cond, bar) do { unsigned _sp = 0; while (cond) { __builtin_amdgcn_s_sleep(1); \
    if ((++_sp & 255u) == 0u) { if (xb_ld(&(bar)[XB_TMO])) break; if (_sp > XB_SPIN_CAP) { atomicAdd(&(bar)[XB_TMO], 1u); break; } } } } while (0)
struct XcdBarrier { unsigned* bar; unsigned x; volatile LAS unsigned* st; };
__device__ __forceinline__ XcdBarrier xcd_barrier_post(unsigned* bar, volatile LAS unsigned* st) {
    XcdBarrier b; b.bar = bar; b.x = xb_xcc_id(); b.st = st;
    if (threadIdx.x == 0) (void)xb_add(&bar[XB_XCNT(b.x)], 1u);
    return b;
}
__device__ __forceinline__ void xcd_barrier_complete(unsigned* bar, unsigned x, unsigned& nloc, unsigned& nx) {
    const unsigned G = gridDim.x * gridDim.y * gridDim.z;
    unsigned sum, cnt, mine, sp = 0u;
    for (;;) {
        sum = 0u; cnt = 0u; mine = 0u;
#pragma unroll
        for (unsigned j = 0; j < 16; ++j) { const unsigned c = xb_ld(&bar[XB_XCNT(j)]); sum += c; cnt += (c > 0u) ? 1u : 0u; mine = (j == x) ? c : mine; }
        if (sum == G) break;
        __builtin_amdgcn_s_sleep(1);
        if ((++sp & 255u) == 0u) { if (xb_ld(&bar[XB_TMO])) break; if (sp > XB_SPIN_CAP) { atomicAdd(&bar[XB_TMO], 1u); break; } }
    }
    nloc = mine > 0u ? mine : 1u; nx = cnt > 0u ? cnt : 1u;
}
__device__ __forceinline__ void xcd_barrier(const XcdBarrier& b) {
    asm volatile("s_waitcnt vmcnt(0)" ::: "memory");
    __syncthreads();
    if (threadIdx.x == 0) {
        unsigned* bar = b.bar;
        __builtin_amdgcn_s_waitcnt(0);
        unsigned nloc = b.st[0], nx = b.st[1];
        if (nloc == 0u) { xcd_barrier_complete(bar, b.x, nloc, nx); b.st[0] = nloc; b.st[1] = nx; }
        const unsigned old = xb_add(&bar[XB_XSUB(b.x)], 1u);
        const unsigned gen = old / nloc;
        if (old + 1u == (gen + 1u) * nloc) {
            __builtin_amdgcn_fence(__ATOMIC_RELEASE, "agent");
            asm volatile("s_waitcnt vmcnt(0)" ::: "memory");
            const unsigned og = xb_add(&bar[XB_TOP], 1u);
            const unsigned tg = og / nx;
            if (og + 1u == (tg + 1u) * nx) xb_add(&bar[XB_TOPGEN], 1u);
            else XB_SPIN(xb_ld(&bar[XB_TOPGEN]) == tg, bar);
            __builtin_amdgcn_fence(__ATOMIC_ACQUIRE, "agent");
            xb_add(&bar[XB_XGEN(b.x)], 1u);
            asm volatile("s_waitcnt vmcnt(0)" ::: "memory");
        } else {
            XB_SPIN(xb_ld(&bar[XB_XGEN(b.x)]) == gen, bar);
            __builtin_amdgcn_fence(__ATOMIC_ACQUIRE, "agent");
            asm volatile("s_waitcnt vmcnt(0)" ::: "memory");
        }
    }
    __syncthreads();
}

template <int KT>
DI void cvt_tile(char* lds, const float* src, int ldS, int Nvalid, bf16_t* dst, bf16_t* dst_lo, int ldD, int k0, int n0, int drow0, const float* gk) {
    float* T = (float*)lds;
    const int tid = tid_here();
    {
        const int c4 = tid & 15, kr = tid >> 4, n = n0 + c4 * 4;
        f32x4 v[KT / 32];
#pragma unroll
        for (int i = 0; i < KT / 32; ++i) { v[i] = (f32x4){0.f, 0.f, 0.f, 0.f}; if (n < Nvalid) v[i] = *(const f32x4*)(src + (size_t)(k0 + kr + 32 * i) * ldS + n); }
#pragma unroll
        for (int i = 0; i < KT / 32; ++i) { const int k = kr + 32 * i; if (gk) v[i] = v[i] * gk[k0 + k];
            T[k * 65 + c4 * 4 + 0] = v[i][0]; T[k * 65 + c4 * 4 + 1] = v[i][1]; T[k * 65 + c4 * 4 + 2] = v[i][2]; T[k * 65 + c4 * 4 + 3] = v[i][3]; }
    }
    __syncthreads();
    {
        constexpr int KPL = KT / 8;
        const int nl = tid >> 3, kc = (tid & 7) * KPL;
#pragma unroll
        for (int q = 0; q < KPL / 8; ++q) {
            float v[8];
#pragma unroll
            for (int j = 0; j < 8; ++j) v[j] = T[(kc + q * 8 + j) * 65 + nl];
            u32x4 w; w.x = pk2(v[0], v[1]); w.y = pk2(v[2], v[3]); w.z = pk2(v[4], v[5]); w.w = pk2(v[6], v[7]);
            *(u32x4*)(dst + (size_t)(drow0 + nl) * ldD + k0 + kc + q * 8) = w;
            if (dst_lo) {
                float r[8];
#pragma unroll
                for (int j = 0; j < 8; ++j) r[j] = v[j] - bf2f(f2bf(v[j]));
                u32x4 w2; w2.x = pk2(r[0], r[1]); w2.y = pk2(r[2], r[3]); w2.z = pk2(r[4], r[5]); w2.w = pk2(r[6], r[7]);
                *(u32x4*)(dst_lo + (size_t)(drow0 + nl) * ldD + k0 + kc + q * 8) = w2;
            }
        }
    }
    __syncthreads();
}
template <int KT>
DI void cvt_matrix(char* lds, const float* src, int K, int N, int Npad, bf16_t* dst, bf16_t* dst_lo, int mode, const float* gk, int ldD = 0) {
    if (ldD == 0) ldD = K;
    const int nkt = K / KT, nnt = Npad / 64, nt = nkt * nnt;
    for (int t = bid_here(); t < nt; t += gridDim.x) {
        const int kt = t % nkt, ntile = t / nkt, n0 = ntile * 64;
        int drow0 = n0;
        if (mode == 1) drow0 = (n0 >> 7) * 256 + (n0 & 127);
        else if (mode == 2) drow0 = (n0 >> 7) * 256 + 128 + (n0 & 127);
        cvt_tile<KT>(lds, src, N, N, dst, dst_lo, ldD, kt * KT, n0, drow0, gk);
    }
}
constexpr int CHUNKS_PER_LAYER = 65 * 192, CHUNKS_TOTAL = 2 * CHUNKS_PER_LAYER;
DI void cvt_chunk(PR p, char* lds, int g) {
    const int l = g / CHUNKS_PER_LAYER, gg = g % CHUNKS_PER_LAYER;
    unsigned char* wl = p.ws + WS_WEIGHTS + (size_t)l * WL_END;
    const int e = gg / 192, r = gg % 192, m = r >> 6, t = r & 63;
    bf16_t* d13 = (bf16_t*)(wl + WL_W13) + (size_t)e * 1024 * D; bf16_t* d2 = (bf16_t*)(wl + WL_W2) + (size_t)e * D * 512;
    if (m < 2) {
        const float* src = m == 0 ? (e < 64 ? p.exp_w1 + ((size_t)l * 64 + e) * D * 512 : p.sh_w1 + (size_t)l * D * 512) : (e < 64 ? p.exp_w3 + ((size_t)l * 64 + e) * D * 512 : p.sh_w3 + (size_t)l * D * 512);
        const int kt = t & 7, n0 = (t >> 3) * 64, drow0 = (n0 >> 7) * 256 + m * 128 + (n0 & 127);
        cvt_tile<256>(lds, src, 512, 512, d13, nullptr, D, kt * 256, n0, drow0, nullptr);
    } else {
        const float* src = e < 64 ? p.exp_w2 + ((size_t)l * 64 + e) * 512 * D : p.sh_w2 + (size_t)l * 512 * D;
        const int kt = t & 1, n0 = (t >> 1) * 64;
        cvt_tile<256>(lds, src, D, D, d2, nullptr, 512, kt * 256, n0, n0, nullptr);
    }
}
#define CTL_LD(ptr) __hip_atomic_load((ptr), __ATOMIC_RELAXED, __HIP_MEMORY_SCOPE_AGENT)
#define CTL_ADD(ptr, v) __hip_atomic_fetch_add((ptr), (v), __ATOMIC_RELAXED, __HIP_MEMORY_SCOPE_AGENT)
DI void fill_tail(PR p, char* lds, int ph) {
    unsigned* ctl = (unsigned*)(p.ws + WS_CTL);
    volatile LAS int* flag = (volatile LAS int*)(shm + 16);
    const int tid = tid_here();
    __syncthreads();
    if (tid == 0) CTL_ADD(&ctl[64 * (1 + ph)], 1u);
    for (;;) {
        if (tid == 0) {
            int c = -1;
            if (CTL_LD(&ctl[64 * (1 + ph)]) + 8u < gridDim.x && CTL_LD(&ctl[0]) < (unsigned)CHUNKS_TOTAL) { c = (int)CTL_ADD(&ctl[0], 4u); if (c >= CHUNKS_TOTAL) c = -1; }
            *flag = c;
        }
        __syncthreads();
        const int c = __builtin_amdgcn_readfirstlane(*flag);
        __syncthreads();
        if (c < 0) break;
        for (int q = 0; q < 4; ++q) {
            if (c + q < CHUNKS_TOTAL) cvt_chunk(p, lds, c + q);
            if (q < 3 && __builtin_amdgcn_readfirstlane((int)CTL_LD(&ctl[64 * (1 + ph)])) >= (int)gridDim.x) { for (int q2 = q + 1; q2 < 4; ++q2) if (c + q2 < CHUNKS_TOTAL) cvt_chunk(p, lds, c + q2); break; }
        }
    }
}
DI void fill_drain(PR p, char* lds, int limit) {
    unsigned* ctl = (unsigned*)(p.ws + WS_CTL);
    const int h0 = __builtin_amdgcn_readfirstlane((int)CTL_LD(&ctl[0]));
    for (int c = h0 + bid_here(); c < limit; c += gridDim.x) cvt_chunk(p, lds, c);
}
DI void move_head(PR p, int limit) { if (blockIdx.x == 0 && tid_here() == 0) __hip_atomic_fetch_max((unsigned*)(p.ws + WS_CTL), (unsigned)limit, __ATOMIC_RELAXED, __HIP_MEMORY_SCOPE_AGENT); }
DI void phase_prologue(PR p, char* lds) {
    const int tid = tid_here();
    unsigned char* ws = p.ws;
    if (blockIdx.x == 0) {
        unsigned* cnt = (unsigned*)(ws + WS_CNT);
        if (tid < 128) cnt[tid] = 0u;
        unsigned* z = (unsigned*)(ws + WS_ZROW);
        for (int i = tid; i < 1024; i += NTHREADS) z[i] = 0u;
        float2* rg = (float2*)(ws + WS_ROPEG);
        for (int i = tid; i < 64 * 32; i += NTHREADS) { const int pos = i >> 5, f = i & 31; const float inv = powf(10000.f, -(float)(2 * f) / 64.f); float s, c; sincosf((float)pos * inv, &s, &c); rg[i] = make_float2(c, s); }
        float2* rm = (float2*)(ws + WS_ROPEM);
        for (int i = tid; i < 64 * 16; i += NTHREADS) { const int pos = i >> 4, f = i & 15; const float inv = powf(10000.f, -(float)(2 * f) / 32.f); float s, c; sincosf((float)pos * inv, &s, &c); rm[i] = make_float2(c, s); }
    }
    {
        float* sc = (float*)lds;
        float* red = sc + 5 * 2048;
        bool loaded = false;
        for (int u = bid_here(); u < 192; u += gridDim.x) {
            if (!loaded) { for (int i = tid; i < 5 * 2048; i += NTHREADS) { const int r = i >> 11, k = i & 2047; const float v = r < 4 ? p.c[r * 2048 + k] : p.c_ctx[k]; sc[i] = silu_f(v); } loaded = true; __syncthreads(); }
            const int l = u / 96, col0 = (u % 96) * 128;
            const int cg = tid & 31, kp = tid >> 5;
            f32x4 acc[5];
#pragma unroll
            for (int r = 0; r < 5; ++r) acc[r] = (f32x4){0.f, 0.f, 0.f, 0.f};
            const float* wb = p.w_mod + ((size_t)l * 2048) * 12288 + col0 + cg * 4;
            for (int kk = 0; kk < 128; ++kk) {
                const int k = kp * 128 + kk;
                const f32x4 w = *(const f32x4*)(wb + (size_t)k * 12288);
#pragma unroll
                for (int r = 0; r < 5; ++r) acc[r] += w * sc[r * 2048 + k];
            }
#pragma unroll
            for (int r = 0; r < 5; ++r)
#pragma unroll
                for (int j = 0; j < 4; ++j) red[(kp * 5 + r) * 128 + cg * 4 + j] = acc[r][j];
            __syncthreads();
            for (int i = tid; i < 640; i += NTHREADS) {
                const int r = i >> 7, cc = i & 127; float s = p.b_mod[l * 12288 + col0 + cc];
#pragma unroll
                for (int q = 0; q < 16; ++q) s += red[(q * 5 + r) * 128 + cc];
                ((float*)(ws + WS_MOD))[((size_t)l * 5 + r) * 12288 + col0 + cc] = s;
            }
            __syncthreads();
        }
        __syncthreads();
    }
    for (int l = 0; l < 2; ++l) {
        unsigned char* wl = ws + WS_WEIGHTS + (size_t)l * WL_END;
        cvt_matrix<256>(lds, p.w_in + (size_t)l * D * INW, D, INW, INWP, (bf16_t*)(wl + WL_WIN), nullptr, 0, nullptr);
        cvt_matrix<128>(lds, p.mla_w_uq + (size_t)l * 384 * 1152, 384, 1152, 1280, (bf16_t*)(wl + WL_WUQ), nullptr, 0, p.mla_g_q + l * 384, 512);
        for (int i = bid_here() * NTHREADS + tid; i < 1280 * 64; i += gridDim.x * NTHREADS) ((unsigned*)(wl + WL_WUQ))[(size_t)(i >> 6) * 256 + 192 + (i & 63)] = 0u;
        cvt_matrix<256>(lds, p.mla_w_ukv + (size_t)l * 512 * 1536, 512, 1536, 1536, (bf16_t*)(wl + WL_WUKV), nullptr, 0, p.mla_g_kv + l * 512);
        cvt_matrix<256>(lds, p.w_out + (size_t)l * D * D, D, D, D, (bf16_t*)(wl + WL_WOUT), nullptr, 0, nullptr);
        cvt_matrix<256>(lds, p.router_w + (size_t)l * D * 64, D, 64, 64, (bf16_t*)(wl + WL_WRH), (bf16_t*)(wl + WL_WRL), 0, nullptr);
    }
}

#ifndef OASG_FP8_MASK
#define OASG_FP8_MASK 3
#endif
constexpr float OASG_SCALE = 16.f;
DI void load_row(const float* src, f32x4 (&v)[4][2], int c0) {
#pragma unroll
    for (int i = 0; i < 4; ++i) { v[i][0] = *(const f32x4*)(src + i * 512 + c0); v[i][1] = *(const f32x4*)(src + i * 512 + c0 + 4); }
}
DI void unpack8(const u32x4 w, f32x4& a, f32x4& b) {
    a[0] = __uint_as_float(w.x << 16); a[1] = __uint_as_float(w.x & 0xFFFF0000u); a[2] = __uint_as_float(w.y << 16); a[3] = __uint_as_float(w.y & 0xFFFF0000u);
    b[0] = __uint_as_float(w.z << 16); b[1] = __uint_as_float(w.z & 0xFFFF0000u); b[2] = __uint_as_float(w.w << 16); b[3] = __uint_as_float(w.w & 0xFFFF0000u);
}
DI void load_row_bf(const bf16_t* src, f32x4 (&v)[4][2], int c0) {
#pragma unroll
    for (int i = 0; i < 4; ++i) unpack8(*(const u32x4*)(src + i * 512 + c0), v[i][0], v[i][1]);
}
DI void store_row_bf(bf16_t* dst, const f32x4 (&v)[4][2], int c0) {
#pragma unroll
    for (int i = 0; i < 4; ++i) { u32x4 w; w.x = pk2(v[i][0][0], v[i][0][1]); w.y = pk2(v[i][0][2], v[i][0][3]); w.z = pk2(v[i][1][0], v[i][1][1]); w.w = pk2(v[i][1][2], v[i][1][3]); *(u32x4*)(dst + i * 512 + c0) = w; }
}
DI float row_sumsq(const f32x4 (&v)[4][2]) {
    float s = 0.f;
#pragma unroll
    for (int i = 0; i < 4; ++i)
#pragma unroll
        for (int h = 0; h < 2; ++h) s += v[i][h][0] * v[i][h][0] + v[i][h][1] * v[i][h][1] + v[i][h][2] * v[i][h][2] + v[i][h][3] * v[i][h][3];
    return wave_sum(s);
}
DI void adaln_store(const f32x4 (&x)[4][2], const float* g, const float* shift, const float* scale, bf16_t* hi, bf16_t* lo, int c0) {
    const float rstd = rsqrtf(row_sumsq(x) * (1.f / D) + EPS);
#pragma unroll
    for (int i = 0; i < 4; ++i) {
        f32x4 h[2];
#pragma unroll
        for (int q = 0; q < 2; ++q) { const int c = i * 512 + c0 + 4 * q;
            const f32x4 gg = *(const f32x4*)(g + c), sh = *(const f32x4*)(shift + c), sc = *(const f32x4*)(scale + c);
#pragma unroll
            for (int j = 0; j < 4; ++j) h[q][j] = x[i][q][j] * rstd * gg[j] * (1.f + sc[j]) + sh[j]; }
        u32x4 w; w.x = pk2(h[0][0], h[0][1]); w.y = pk2(h[0][2], h[0][3]); w.z = pk2(h[1][0], h[1][1]); w.w = pk2(h[1][2], h[1][3]);
        *(u32x4*)(hi + i * 512 + c0) = w;
        if (lo) { f32x4 a, b; unpack8(w, a, b); u32x4 w2; w2.x = pk2(h[0][0] - a[0], h[0][1] - a[1]); w2.y = pk2(h[0][2] - a[2], h[0][3] - a[3]); w2.z = pk2(h[1][0] - b[0], h[1][1] - b[1]); w2.w = pk2(h[1][2] - b[2], h[1][3] - b[3]);
            *(u32x4*)(lo + i * 512 + c0) = w2; }
    }
}
DI void residual_add(f32x4 (&x)[4][2], const f32x4 (&y)[4][2], const float* g, const float* gate, int c0) {
    const float rstd = rsqrtf(row_sumsq(y) * (1.f / D) + EPS);
#pragma unroll
    for (int i = 0; i < 4; ++i)
#pragma unroll
        for (int q = 0; q < 2; ++q) { const int c = i * 512 + c0 + 4 * q; const f32x4 gg = *(const f32x4*)(g + c), gt = *(const f32x4*)(gate + c);
#pragma unroll
            for (int j = 0; j < 4; ++j) x[i][q][j] += gt[j] * (y[i][q][j] * rstd * gg[j]); }
}
DI void load_xrow(PR p, int l, int r, f32x4 (&x)[4][2], int c0) {
    if (l == 0) load_row(r < NLAT ? p.x + (size_t)r * D : p.ctx + (size_t)(r - NLAT) * D, x, c0);
    else load_row_bf((const bf16_t*)(p.ws + WS_XRES) + (size_t)r * D, x, c0);
}
DI void phase_norm1(PR p, int l) {
    const int tid_ = tid_here(), lane = tid_ & 63, wid = tid_ >> 6;
    const float* mod = (const float*)(p.ws + WS_MOD) + (size_t)l * 5 * 12288;
    bf16_t* hb = (bf16_t*)(p.ws + WS_HBUF);
    for (int r = bid_here() * 8 + wid; r < NTOK; r += gridDim.x * 8) {
        const Tok t = tok_of(r);
        int c0 = lane * 8; asm volatile("" : "+v"(c0));
        f32x4 x[4][2]; load_xrow(p, l, r, x, c0);
        adaln_store(x, p.g_pre_mix + l * D, mod + (size_t)t.mrow * 12288 + 0 * D, mod + (size_t)t.mrow * 12288 + 1 * D, hb + (size_t)r * D, nullptr, c0);
    }
}
DI void phase_postmix(PR p, int l) {
    const int tid_ = tid_here(), lane = tid_ & 63, wid = tid_ >> 6;
    const float* mod = (const float*)(p.ws + WS_MOD) + (size_t)l * 5 * 12288;
    const bf16_t* Y = (const bf16_t*)(p.ws + WS_U + U_Y);
    bf16_t* XR = (bf16_t*)(p.ws + WS_XRES);
    bf16_t* hb = (bf16_t*)(p.ws + WS_HBUF); bf16_t* hl = (bf16_t*)(p.ws + WS_U + U_HLO);
    const int nrows = l == 0 ? NTOK : NLAT;
    for (int r = bid_here() * 8 + wid; r < nrows; r += gridDim.x * 8) {
        const Tok t = tok_of(r);
        int c0 = lane * 8; asm volatile("" : "+v"(c0));
        f32x4 x[4][2], y[4][2]; load_xrow(p, l, r, x, c0); load_row_bf(Y + (size_t)r * D, y, c0);
        residual_add(x, y, p.g_post_mix + l * D, mod + (size_t)t.mrow * 12288 + 2 * D, c0);
        store_row_bf(XR + (size_t)r * D, x, c0);
        adaln_store(x, p.g_pre_ffn + l * D, mod + (size_t)t.mrow * 12288 + 3 * D, mod + (size_t)t.mrow * 12288 + 4 * D, hb + (size_t)r * D, hl + (size_t)r * D, c0);
    }
}
DI void phase_postffn(PR p, int l) {
    const int tid_ = tid_here(), lane = tid_ & 63, wid = tid_ >> 6;
    const float* mod = (const float*)(p.ws + WS_MOD) + (size_t)l * 5 * 12288;
    const bf16_t* YS = (const bf16_t*)(p.ws + WS_U + U_YSH);
    const unsigned char* OA = p.ws + WS_U + U_OASG;
    bf16_t* XR = (bf16_t*)(p.ws + WS_XRES);
    bf16_t* hb = (bf16_t*)(p.ws + WS_HBUF);
    const int nrows = l == 0 ? NTOK : NLAT;
    const bool fp8 = (OASG_FP8_MASK >> l) & 1;
    for (int r = bid_here() * 8 + wid; r < nrows; r += gridDim.x * 8) {
        const Tok t = tok_of(r);
        int c0 = lane * 8; asm volatile("" : "+v"(c0));
        f32x4 x[4][2], y[4][2]; load_row_bf(XR + (size_t)r * D, x, c0); load_row_bf(YS + (size_t)r * D, y, c0);
        if (fp8) {
            f32x4 a[4][2];
#pragma unroll
            for (int i = 0; i < 4; ++i) { a[i][0] = (f32x4){0.f, 0.f, 0.f, 0.f}; a[i][1] = (f32x4){0.f, 0.f, 0.f, 0.f}; }
#pragma unroll 2
            for (int k = 0; k < 8; ++k) {
                const unsigned char* o = OA + ((size_t)r * 8 + k) * D;
#pragma unroll
                for (int i = 0; i < 4; ++i) { const u32x2 w = *(const u32x2*)(o + i * 512 + c0);
                    const auto f0 = __builtin_amdgcn_cvt_pk_f32_fp8(w.x, false), f1 = __builtin_amdgcn_cvt_pk_f32_fp8(w.x, true), f2 = __builtin_amdgcn_cvt_pk_f32_fp8(w.y, false), f3 = __builtin_amdgcn_cvt_pk_f32_fp8(w.y, true);
                    a[i][0][0] += f0[0]; a[i][0][1] += f0[1]; a[i][0][2] += f1[0]; a[i][0][3] += f1[1]; a[i][1][0] += f2[0]; a[i][1][1] += f2[1]; a[i][1][2] += f3[0]; a[i][1][3] += f3[1]; }
            }
#pragma unroll
            for (int i = 0; i < 4; ++i) { y[i][0] += a[i][0] * (1.f / OASG_SCALE); y[i][1] += a[i][1] * (1.f / OASG_SCALE); }
        } else {
#pragma unroll 2
            for (int k = 0; k < 8; ++k) {
                const bf16_t* o = (const bf16_t*)OA + ((size_t)r * 8 + k) * D;
#pragma unroll
                for (int i = 0; i < 4; ++i) { f32x4 a, b; unpack8(*(const u32x4*)(o + i * 512 + c0), a, b); y[i][0] += a; y[i][1] += b; }
            }
        }
        residual_add(x, y, p.g_post_ffn + l * D, mod + (size_t)t.mrow * 12288 + 5 * D, c0);
        if (l == 0) {
            store_row_bf(XR + (size_t)r * D, x, c0);
            const float* mod1 = (const float*)(p.ws + WS_MOD) + (size_t)1 * 5 * 12288;
            adaln_store(x, p.g_pre_mix + 1 * D, mod1 + (size_t)t.mrow * 12288 + 0 * D, mod1 + (size_t)t.mrow * 12288 + 1 * D, hb + (size_t)r * D, nullptr, c0);
        } else {
            float* dstrow = p.out + (size_t)r * D;
#pragma unroll
            for (int i = 0; i < 4; ++i) { *(f32x4*)(dstrow + i * 512 + c0) = x[i][0]; *(f32x4*)(dstrow + i * 512 + c0 + 4) = x[i][1]; }
        }
    }
}

struct GemmUnit {
    const bf16_t* A; long lda; const int* rows; int rowshift;
    const bf16_t* Bt; long ldb;
    int K;
};
constexpr int GS_LD = 72;
struct LaneId { int wr, wc, fr, fq; };
DI LaneId gemm_kloop_simple(char* lds, const GemmUnit& g, f32x4 (&acc)[2][2][4][2]) {
    int tid = threadIdx.x; asm volatile("" : "+v"(tid));
    const int wid = tid >> 6, lane = tid & 63, wr = wid >> 2, wc = wid & 3, fr = lane & 15, fq = lane >> 4;
    bf16_t* As = (bf16_t*)lds; bf16_t* Bs = As + 256 * GS_LD;
#pragma unroll
    for (int a = 0; a < 2; ++a)
#pragma unroll
        for (int b = 0; b < 2; ++b)
#pragma unroll
            for (int m = 0; m < 4; ++m)
#pragma unroll
                for (int n = 0; n < 2; ++n) acc[a][b][m][n] = (f32x4){0.f, 0.f, 0.f, 0.f};
    const int srow = tid >> 3, skc = (tid & 7) * 8;
    const bf16_t* ap[4]; const bf16_t* bp[4];
#pragma unroll
    for (int i = 0; i < 4; ++i) {
        const int r = srow + 64 * i;
        if (g.rows) { const int idx = g.rows[r]; ap[i] = g.A + (size_t)(idx >= 0 ? (idx >> g.rowshift) : 0) * g.lda + skc; }
        else ap[i] = g.A + (size_t)r * g.lda + skc;
        bp[i] = g.Bt + (size_t)r * g.ldb + skc;
    }
    const int nkt = g.K / 64;
    u32x4 ra[4], rb[4];
#pragma unroll
    for (int i = 0; i < 4; ++i) { ra[i] = *(const u32x4*)(ap[i]); rb[i] = *(const u32x4*)(bp[i]); }
    for (int kt = 0; kt < nkt; ++kt) {
        __syncthreads();
#pragma unroll
        for (int i = 0; i < 4; ++i) { *(u32x4*)(As + (srow + 64 * i) * GS_LD + skc) = ra[i]; *(u32x4*)(Bs + (srow + 64 * i) * GS_LD + skc) = rb[i]; }
        __syncthreads();
        if (kt + 1 < nkt) {
#pragma unroll
            for (int i = 0; i < 4; ++i) { ra[i] = *(const u32x4*)(ap[i] + (kt + 1) * 64); rb[i] = *(const u32x4*)(bp[i] + (kt + 1) * 64); }
        }
#pragma unroll
        for (int kk = 0; kk < 2; ++kk) {
            bf16x8 bf[2][2];
#pragma unroll
            for (int bj = 0; bj < 2; ++bj)
#pragma unroll
                for (int n = 0; n < 2; ++n) bf[bj][n] = *(const bf16x8*)(Bs + (128 * bj + 32 * wc + 16 * n + fr) * GS_LD + kk * 32 + fq * 8);
#pragma unroll
            for (int ai = 0; ai < 2; ++ai)
#pragma unroll
                for (int m = 0; m < 4; ++m) {
                    const bf16x8 af = *(const bf16x8*)(As + (128 * ai + 64 * wr + 16 * m + fr) * GS_LD + kk * 32 + fq * 8);
#pragma unroll
                    for (int bj = 0; bj < 2; ++bj)
#pragma unroll
                        for (int n = 0; n < 2; ++n) acc[ai][bj][m][n] = __builtin_amdgcn_mfma_f32_16x16x32_bf16(bf[bj][n], af, acc[ai][bj][m][n], 0, 0, 0);
                }
        }
    }
    __syncthreads();
    LaneId id; id.wr = wr; id.wc = wc; id.fr = fr; id.fq = fq; return id;
}
#define GEMM_ACC f32x4 acc[2][2][4][2]
#define ACC_FOREACH(...) \
    _Pragma("unroll") for (int ai = 0; ai < 2; ++ai) _Pragma("unroll") for (int m = 0; m < 4; ++m) { const int trow = 128 * ai + 64 * wr + 16 * m + fr; \
    _Pragma("unroll") for (int bj = 0; bj < 2; ++bj) _Pragma("unroll") for (int n = 0; n < 2; ++n) { const int tcol = 128 * bj + 32 * wc + 16 * n + 4 * fq; const f32x4 v = acc[ai][bj][m][n]; __VA_ARGS__ } }

struct EpiProj {
    bf16_t* O; int row0, col0;
    DI void operator()(const f32x4 (&acc)[2][2][4][2], int wr, int wc, int fr, int fq) const {
        ACC_FOREACH({ u32x2 w; w.x = pk2(v[0], v[1]); w.y = pk2(v[2], v[3]); *(u32x2*)(O + (size_t)(row0 + trow) * INWP + col0 + tcol) = w; })
    }
};
struct EpiB16 {
    bf16_t* O; int row0, col0, ld;
    DI void operator()(const f32x4 (&acc)[2][2][4][2], int wr, int wc, int fr, int fq) const {
        ACC_FOREACH({ u32x2 w; w.x = pk2(v[0], v[1]); w.y = pk2(v[2], v[3]); *(u32x2*)(O + (size_t)(row0 + trow) * ld + col0 + tcol) = w; })
    }
};
struct EpiF32 {
    float* O; int row0, col0, ld;
    DI void operator()(const f32x4 (&acc)[2][2][4][2], int wr, int wc, int fr, int fq) const {
        ACC_FOREACH({ *(f32x4*)(O + (size_t)(row0 + trow) * ld + col0 + tcol) = v; })
    }
};
struct EpiUq {
    bf16_t* Q; const float2* ropem; int row0, col0;
    DI void operator()(const f32x4 (&acc)[2][2][4][2], int wr, int wc, int fr, int fq) const {
#pragma unroll
        for (int ai = 0; ai < 2; ++ai)
#pragma unroll
            for (int m = 0; m < 4; ++m) {
                const int r = row0 + 128 * ai + 64 * wr + 16 * m + fr; const Tok t = tok_of(r);
#pragma unroll
                for (int bj = 0; bj < 2; ++bj) {
                    const int cbase = col0 + 128 * bj + 32 * wc;
                    if (cbase >= 1152) continue;
                    const int h = cbase / 192, jb = cbase % 192;
                    f32x4 v0 = acc[ai][bj][m][0], v1 = acc[ai][bj][m][1];
                    if (jb >= 128 && !t.isctx) {
                        const int pos = (jb == 128) ? (t.s >> 6) : (t.s & 63);
#pragma unroll
                        for (int i = 0; i < 4; ++i) { const float2 cs = ropem[pos * 16 + 4 * fq + i]; const float x1 = v0[i], x2 = v1[i]; v0[i] = x1 * cs.x - x2 * cs.y; v1[i] = x2 * cs.x + x1 * cs.y; }
                    }
                    bf16_t* dst = Q + (((size_t)t.b * 6 + h) * SKV + t.kvpos) * 192 + jb + 4 * fq;
                    u32x2 w0; w0.x = pk2(v0[0], v0[1]); w0.y = pk2(v0[2], v0[3]); *(u32x2*)(dst) = w0;
                    u32x2 w1; w1.x = pk2(v1[0], v1[1]); w1.y = pk2(v1[2], v1[3]); *(u32x2*)(dst + 16) = w1;
                }
            }
    }
};
struct EpiUkv {
    bf16_t* Km; bf16_t* Vm; int row0, col0;
    DI void operator()(const f32x4 (&acc)[2][2][4][2], int wr, int wc, int fr, int fq) const {
        ACC_FOREACH({ const int r = row0 + trow; const Tok t = tok_of(r); const int c = col0 + tcol, h = c >> 8, j = c & 255;
            u32x2 w; w.x = pk2(v[0], v[1]); w.y = pk2(v[2], v[3]);
            if (j < 128) *(u32x2*)(Km + (((size_t)t.b * 6 + h) * SKV + t.kvpos) * 192 + j) = w;
            else *(u32x2*)(Vm + (((size_t)t.b * 6 + h) * SKV + t.kvpos) * 128 + (j - 128)) = w; })
    }
};
struct EpiMoe1 {
    bf16_t* act; int arow0, hcol0;
    DI void operator()(const f32x4 (&acc)[2][2][4][2], int wr, int wc, int fr, int fq) const {
#pragma unroll
        for (int ai = 0; ai < 2; ++ai)
#pragma unroll
            for (int m = 0; m < 4; ++m) {
                const int trow = 128 * ai + 64 * wr + 16 * m + fr;
#pragma unroll
                for (int n = 0; n < 2; ++n) {
                    const f32x4 a = acc[ai][0][m][n], b = acc[ai][1][m][n]; f32x4 h;
#pragma unroll
                    for (int i = 0; i < 4; ++i) h[i] = silu_f(a[i]) * b[i];
                    u32x2 w; w.x = pk2(h[0], h[1]); w.y = pk2(h[2], h[3]);
                    *(u32x2*)(act + (size_t)(arow0 + trow) * 512 + hcol0 + 32 * wc + 16 * n + 4 * fq) = w;
                }
            }
    }
};
struct EpiMoe2 {
    bf16_t* oasg; const int* sasg; const float* sw; int srow0, col0;
    DI void operator()(const f32x4 (&acc)[2][2][4][2], int wr, int wc, int fr, int fq) const {
        int a[2][4]; float wgt[2][4];
#pragma unroll
        for (int ai = 0; ai < 2; ++ai)
#pragma unroll
            for (int m = 0; m < 4; ++m) { const int trow = 128 * ai + 64 * wr + 16 * m + fr; a[ai][m] = sasg[srow0 + trow]; wgt[ai][m] = sw[srow0 + trow]; }
#pragma unroll
        for (int ai = 0; ai < 2; ++ai)
#pragma unroll
            for (int m = 0; m < 4; ++m) {
                if (a[ai][m] < 0) continue;
#pragma unroll
                for (int bj = 0; bj < 2; ++bj)
#pragma unroll
                    for (int n = 0; n < 2; ++n) { const f32x4 v = acc[ai][bj][m][n] * wgt[ai][m]; u32x2 w; w.x = pk2(v[0], v[1]); w.y = pk2(v[2], v[3]);
                        *(u32x2*)(oasg + (size_t)a[ai][m] * D + col0 + 128 * bj + 32 * wc + 16 * n + 4 * fq) = w; }
            }
    }
};
DI u32x4 pack8(const f32x4& a, const f32x4& b) { u32x4 w; w.x = pk2(a[0], a[1]); w.y = pk2(a[2], a[3]); w.z = pk2(b[0], b[1]); w.w = pk2(b[2], b[3]); return w; }
struct EpiB16P {
    bf16_t* O; int row0, col0, ld;
    DI void operator()(const f32x4 (&acc)[2][2][4][2], int wr, int wc, int fr, int fq) const {
#pragma unroll
        for (int ai = 0; ai < 2; ++ai)
#pragma unroll
            for (int m = 0; m < 4; ++m) { bf16_t* rowp = O + (size_t)(row0 + 128 * ai + 64 * wr + 16 * m + fr) * ld + col0 + 32 * wc + 8 * fq;
#pragma unroll
                for (int bj = 0; bj < 2; ++bj) *(u32x4*)(rowp + 128 * bj) = pack8(acc[ai][bj][m][0], acc[ai][bj][m][1]); }
    }
};
struct EpiMoe1P {
    bf16_t* act; int arow0, hcol0;
    DI void operator()(const f32x4 (&acc)[2][2][4][2], int wr, int wc, int fr, int fq) const {
#pragma unroll
        for (int ai = 0; ai < 2; ++ai)
#pragma unroll
            for (int m = 0; m < 4; ++m) {
                f32x4 h0, h1;
#pragma unroll
                for (int i = 0; i < 4; ++i) { h0[i] = silu_f(acc[ai][0][m][0][i]) * acc[ai][1][m][0][i]; h1[i] = silu_f(acc[ai][0][m][1][i]) * acc[ai][1][m][1][i]; }
                *(u32x4*)(act + (size_t)(arow0 + 128 * ai + 64 * wr + 16 * m + fr) * 512 + hcol0 + 32 * wc + 8 * fq) = pack8(h0, h1);
            }
    }
};
struct EpiMoe2P {
    bf16_t* oasg; const int* sasg; const float* sw; int srow0, col0;
    DI void operator()(const f32x4 (&acc)[2][2][4][2], int wr, int wc, int fr, int fq) const {
        int a[2][4]; float wgt[2][4];
#pragma unroll
        for (int ai = 0; ai < 2; ++ai)
#pragma unroll
            for (int m = 0; m < 4; ++m) { const int trow = 128 * ai + 64 * wr + 16 * m + fr; a[ai][m] = sasg[srow0 + trow]; wgt[ai][m] = sw[srow0 + trow]; }
#pragma unroll
        for (int ai = 0; ai < 2; ++ai)
#pragma unroll
            for (int m = 0; m < 4; ++m) {
                if (a[ai][m] < 0) continue;
                bf16_t* rowp = oasg + (size_t)a[ai][m] * D + col0 + 32 * wc + 8 * fq;
#pragma unroll
                for (int bj = 0; bj < 2; ++bj) *(u32x4*)(rowp + 128 * bj) = pack8(acc[ai][bj][m][0] * wgt[ai][m], acc[ai][bj][m][1] * wgt[ai][m]);
            }
    }
};
struct EpiMoe2F8 {
    unsigned char* oasg; const int* sasg; const float* sw; int srow0, col0;
    DI void operator()(const f32x4 (&acc)[2][2][4][2], int wr, int wc, int fr, int fq) const {
        int a[2][4]; float wgt[2][4];
#pragma unroll
        for (int ai = 0; ai < 2; ++ai)
#pragma unroll
            for (int m = 0; m < 4; ++m) { const int trow = 128 * ai + 64 * wr + 16 * m + fr; a[ai][m] = sasg[srow0 + trow]; wgt[ai][m] = sw[srow0 + trow] * OASG_SCALE; }
#pragma unroll
        for (int ai = 0; ai < 2; ++ai)
#pragma unroll
            for (int m = 0; m < 4; ++m) {
                if (a[ai][m] < 0) continue;
                unsigned char* rowp = oasg + (size_t)a[ai][m] * D + col0 + 32 * wc + 8 * fq;
#pragma unroll
                for (int bj = 0; bj < 2; ++bj) { const f32x4 v0 = acc[ai][bj][m][0] * wgt[ai][m], v1 = acc[ai][bj][m][1] * wgt[ai][m]; u32x2 w;
                    int t0 = __builtin_amdgcn_cvt_pk_fp8_f32(v0[0], v0[1], 0, false); t0 = __builtin_amdgcn_cvt_pk_fp8_f32(v0[2], v0[3], t0, true);
                    int t1 = __builtin_amdgcn_cvt_pk_fp8_f32(v1[0], v1[1], 0, false); t1 = __builtin_amdgcn_cvt_pk_fp8_f32(v1[2], v1[3], t1, true);
                    w.x = (unsigned)t0; w.y = (unsigned)t1; *(u32x2*)(rowp + 128 * bj) = w; }
            }
    }
};
DI void phase_postproj_rows(PR p, int l) {
    const int tid_ = tid_here(), lane = tid_ & 63, wid = tid_ >> 6;
    unsigned char* U = p.ws + WS_U;
    const bf16_t* PR = (const bf16_t*)(U + U_PROJ);
    bf16_t* CQN = (bf16_t*)(U + U_CQN); bf16_t* CKVN = (bf16_t*)(U + U_CKVN);
    bf16_t* Km = (bf16_t*)(U + U_KM); bf16_t* Qg = (bf16_t*)(U + U_QG); bf16_t* Kg = (bf16_t*)(U + U_KG); bf16_t* Vg = (bf16_t*)(U + U_VG);
    const float2* ropeg = (const float2*)(p.ws + WS_ROPEG); const float2* ropem = (const float2*)(p.ws + WS_ROPEM);
    const float* gq = p.gqa_g_q + l * 128; const float* gk = p.gqa_g_k + l * 128;
    for (int r = bid_here() * 8 + wid; r < NTOK; r += gridDim.x * 8) {
        const Tok t = tok_of(r);
        const bf16_t* pr = PR + (size_t)r * INWP;
        {
            float v[6], ss = 0.f;
#pragma unroll
            for (int i = 0; i < 6; ++i) { v[i] = bf2f(pr[C_CQ + lane + 64 * i]); ss += v[i] * v[i]; }
            const float rstd = rsqrtf(wave_sum(ss) * (1.f / 384.f) + EPS);
#pragma unroll
            for (int i = 0; i < 6; ++i) CQN[(size_t)r * 512 + lane + 64 * i] = f2bf(v[i] * rstd);
            CQN[(size_t)r * 512 + 384 + lane] = 0; CQN[(size_t)r * 512 + 448 + lane] = 0;
        }
        {
            float v[8], ss = 0.f;
#pragma unroll
            for (int i = 0; i < 8; ++i) { v[i] = bf2f(pr[C_CKV + lane + 64 * i]); ss += v[i] * v[i]; }
            const float rstd = rsqrtf(wave_sum(ss) * (1.f / 512.f) + EPS);
#pragma unroll
            for (int i = 0; i < 8; ++i) CKVN[(size_t)r * 512 + lane + 64 * i] = f2bf(v[i] * rstd);
        }
        {
            float x = bf2f(pr[C_KR + lane]);
            const float other = shx(x, 16, lane);
            if (!t.isctx) {
                const int g = lane >> 5, idx = lane & 31, fi = idx & 15; const bool second = idx >= 16;
                const int pos = g == 0 ? (t.s >> 6) : (t.s & 63);
                const float2 cs = ropem[pos * 16 + fi];
                x = second ? x * cs.x + other * cs.y : x * cs.x - other * cs.y;
            }
            const bf16_t xb = f2bf(x);
#pragma unroll
            for (int h = 0; h < 6; ++h) Km[(((size_t)t.b * 6 + h) * SKV + t.kvpos) * 192 + 128 + lane] = xb;
        }
        const int fi = lane & 31; const bool second = lane >= 32;
        float2 cs0 = make_float2(1.f, 0.f), cs1 = make_float2(1.f, 0.f);
        if (!t.isctx) { cs0 = ropeg[(t.s >> 6) * 32 + fi]; cs1 = ropeg[(t.s & 63) * 32 + fi]; }
#pragma unroll
        for (int hh = 0; hh < 8; ++hh) {
            const bool isq = hh < 6; const int h = isq ? hh : hh - 6; const float* g = isq ? gq : gk;
            const int cb = (isq ? C_AQ : C_AK) + h * 128;
            float e0 = bf2f(pr[cb + lane]), e1 = bf2f(pr[cb + 64 + lane]);
            const float rstd = rsqrtf(wave_sum(e0 * e0 + e1 * e1) * (1.f / 128.f) + EPS);
            e0 = e0 * rstd * g[lane]; e1 = e1 * rstd * g[64 + lane];
            const float o0 = shx(e0, 32, lane), o1 = shx(e1, 32, lane);
            const float r0 = second ? e0 * cs0.x + o0 * cs0.y : e0 * cs0.x - o0 * cs0.y;
            const float r1 = second ? e1 * cs1.x + o1 * cs1.y : e1 * cs1.x - o1 * cs1.y;
            bf16_t* dst = isq ? Qg + (((size_t)t.b * 6 + h) * SKV + t.kvpos) * 128 : Kg + (((size_t)t.b * 2 + h) * SKV + t.kvpos) * 128;
            dst[lane] = f2bf(r0); dst[64 + lane] = f2bf(r1);
        }
#pragma unroll
        for (int h = 0; h < 2; ++h) { bf16_t* dst = Vg + (((size_t)t.b * 2 + h) * SKV + t.kvpos) * 128; dst[lane] = pr[C_AV + h * 128 + lane]; dst[64 + lane] = pr[C_AV + h * 128 + 64 + lane]; }
    }
}

#define SBAR() __builtin_amdgcn_sched_barrier(0)
DI int crow(int r, int hi) { return (r & 3) + 8 * (r >> 2) + 4 * hi; }
DI unsigned cvtpk(float lo, float hi) { unsigned r; asm volatile("v_cvt_pk_bf16_f32 %0, %1, %2" : "=v"(r) : "v"(lo), "v"(hi)); return r; }
constexpr float ATT_THR = 8.f;
template <int DQK> struct AttnCfg {
    static constexpr int KROWB = DQK * 2;
    static constexpr int SHM_V = 64 * 128 * 2, SHM_K = 64 * DQK * 2;
    static constexpr int ND0 = DQK / 16;
    static constexpr int NKCH = DQK / 64;
    static constexpr int NQR = DQK == 128 ? 8 : ATT_NQR_M;
    static constexpr int SHM_Q = 8 * (ND0 - NQR) * 1024;
    static constexpr int SHM_TOTAL = 2 * SHM_V + 2 * SHM_K + 8 * 64 * 4 + SHM_Q;
};
template <int DQK> DI int kswz(int row, int colB) { return row * (DQK * 2) + (colB ^ ((row & 7) << 4)); }
DI void partialSM(f32x16& p0, f32x16& p1, float& m_reg, float& mn, float& alpha, const float SCALE) {
    const float C = SCALE * 1.4426950408889634f;
    float pmax = p0[0];
#pragma unroll
    for (int r = 1; r < 16; ++r) pmax = fmaxf(pmax, p0[r]);
#pragma unroll
    for (int r = 0; r < 16; ++r) pmax = fmaxf(pmax, p1[r]);
    { auto rr = __builtin_amdgcn_permlane32_swap(__float_as_uint(pmax), __float_as_uint(pmax), false, false);
      pmax = fmaxf(__uint_as_float(rr[0]), __uint_as_float(rr[1])); }
    if (__builtin_expect(__all(pmax - m_reg <= ATT_THR / SCALE), 1)) { mn = m_reg; alpha = 1.f; }
    else { mn = fmaxf(m_reg, pmax); alpha = __builtin_amdgcn_exp2f((m_reg - mn) * C); m_reg = mn; }
    const float mnC = -mn * C;
#pragma unroll
    for (int r = 0; r < 16; ++r) p0[r] = fmaf(p0[r], C, mnC);
#pragma unroll
    for (int r = 0; r < 16; ++r) p1[r] = fmaf(p1[r], C, mnC);
#pragma unroll
    for (int r = 0; r < 16; ++r) p0[r] = __builtin_amdgcn_exp2f(p0[r]);
}
DI void finishSM(f32x16& p0, f32x16& p1, float alpha, float& l_reg, bf16x8& pa0, bf16x8& pa1, bf16x8& pa2, bf16x8& pa3) {
#pragma unroll
    for (int r = 0; r < 16; ++r) p1[r] = __builtin_amdgcn_exp2f(p1[r]);
    float ps = 0;
#pragma unroll
    for (int r = 0; r < 16; ++r) ps += p0[r];
#pragma unroll
    for (int r = 0; r < 16; ++r) ps += p1[r];
    { auto rr = __builtin_amdgcn_permlane32_swap(__float_as_uint(ps), __float_as_uint(ps), false, false);
      ps = __uint_as_float(rr[0]) + __uint_as_float(rr[1]); }
    l_reg = l_reg * alpha + ps;
#define PK4(P, BASE, OUT) do { unsigned a0 = cvtpk(P[BASE + 0], P[BASE + 1]), a1 = cvtpk(P[BASE + 2], P[BASE + 3]);   \
    unsigned b0 = cvtpk(P[BASE + 4], P[BASE + 5]), b1 = cvtpk(P[BASE + 6], P[BASE + 7]);                              \
    auto r0 = __builtin_amdgcn_permlane32_swap(a0, b0, false, false); auto r1 = __builtin_amdgcn_permlane32_swap(a1, b1, false, false); \
    u32x4 w = {r0[0], r1[0], r0[1], r1[1]}; OUT = *reinterpret_cast<bf16x8*>(&w); } while (0)
    PK4(p0, 0, pa0); PK4(p0, 8, pa1); PK4(p1, 0, pa2); PK4(p1, 8, pa3);
#undef PK4
}
template <int DQK, int NQR>
DI void qkt(f32x16& p0, f32x16& p1, const int (&kb)[4], int bufoff, const bf16x8* qr, int qs_addr, int r32, int hi) {
    asm volatile("" : "+v"(qs_addr));
    const LAS char* Qs = (const LAS char*)qs_addr;
#pragma unroll
    for (int r = 0; r < 16; ++r) { p0[r] = 0.f; p1[r] = 0.f; }
#pragma unroll
    for (int d0 = 0; d0 < DQK / 16; ++d0) {
        const LAS char* ka = (const LAS char*)(kb[d0 & 3]) + bufoff + 128 * (d0 >> 2);
        const bf16x8 b0 = *(const LAS bf16x8*)(ka);
        const bf16x8 b1 = *(const LAS bf16x8*)(ka + 32 * DQK * 2);
        bf16x8 q;
        if (d0 < NQR) q = qr[d0]; else q = *(const LAS bf16x8*)(Qs + (d0 - NQR) * 1024);
        p0 = __builtin_amdgcn_mfma_f32_32x32x16_bf16(b0, q, p0, 0, 0, 0);
        p1 = __builtin_amdgcn_mfma_f32_32x32x16_bf16(b1, q, p1, 0, 0, 0); }
}
DI int v_st(int k, int c) { const int kk = (k & ~0xC) | ((k & 4) << 1) | ((k & 8) >> 1); return ((kk >> 3) * 4 + (c >> 5)) * 512 + ((kk & 7) * 32 + (c & 31)) * 2; }
DI int v_rd_base(int lane) { return ((lane & 3) << 3) | (((lane >> 2) & 3) << 6) | (((lane >> 4) & 1) << 5) | (((lane >> 5) & 1) << 8); }
constexpr int v_rd_off(int d0, int ks, int half) { return d0 * 512 + ks * 4096 + half * 2048; }
template <int OFF> DI s16x4 tr_read(int vb) { s16x4 r; asm volatile("ds_read_b64_tr_b16 %0, %1 offset:%2" : "=&v"(r) : "v"(vb), "i"(OFF) : "memory"); return r; }
template <int D0> DI void pv_one(f32x16& od, int vb, bf16x8 pa0, bf16x8 pa1, bf16x8 pa2, bf16x8 pa3) {
    const s16x4 l0 = tr_read<v_rd_off(D0, 0, 0)>(vb), h0 = tr_read<v_rd_off(D0, 0, 1)>(vb), l1 = tr_read<v_rd_off(D0, 1, 0)>(vb), h1 = tr_read<v_rd_off(D0, 1, 1)>(vb);
    const s16x4 l2 = tr_read<v_rd_off(D0, 2, 0)>(vb), h2 = tr_read<v_rd_off(D0, 2, 1)>(vb), l3 = tr_read<v_rd_off(D0, 3, 0)>(vb), h3 = tr_read<v_rd_off(D0, 3, 1)>(vb);
    asm volatile("s_waitcnt lgkmcnt(0)" ::: "memory"); SBAR();
#define PKV(L, H) (bf16x8){L[0], L[1], L[2], L[3], H[0], H[1], H[2], H[3]}
    od = __builtin_amdgcn_mfma_f32_32x32x16_bf16(pa0, PKV(l0, h0), od, 0, 0, 0);
    od = __builtin_amdgcn_mfma_f32_32x32x16_bf16(pa1, PKV(l1, h1), od, 0, 0, 0);
    od = __builtin_amdgcn_mfma_f32_32x32x16_bf16(pa2, PKV(l2, h2), od, 0, 0, 0);
    od = __builtin_amdgcn_mfma_f32_32x32x16_bf16(pa3, PKV(l3, h3), od, 0, 0, 0);
#undef PKV
}
DI void pv_d0(f32x16* o, int vb, bf16x8 pa0, bf16x8 pa1, bf16x8 pa2, bf16x8 pa3) {
    pv_one<0>(o[0], vb, pa0, pa1, pa2, pa3); pv_one<1>(o[1], vb, pa0, pa1, pa2, pa3); pv_one<2>(o[2], vb, pa0, pa1, pa2, pa3); pv_one<3>(o[3], vb, pa0, pa1, pa2, pa3);
}
template <int DQK, int SDEPTH>
DI void attn_body(const bf16_t* __restrict__ Qb, const bf16_t* __restrict__ Kh, const bf16_t* __restrict__ Vh, bf16_t* __restrict__ Ob, int ldo, int seq, char* lds, const float SCALE) {
    using Cfg = AttnCfg<DQK>;
    constexpr int SHM_V = Cfg::SHM_V, SHM_K = Cfg::SHM_K, ND0 = Cfg::ND0, NKCH = Cfg::NKCH, KCPR = DQK / 8, NQR = Cfg::NQR;
    int tid = threadIdx.x; asm volatile("" : "+v"(tid));
    const int wid = tid >> 6, lane = tid & 63, r32 = lane & 31, hi = lane >> 5;
    char* V_lds = lds; char* K_lds = lds + 2 * SHM_V;
    float* ws = (float*)(lds + 2 * SHM_V + 2 * SHM_K) + wid * 64; float* li_l = ws; float* al_l = ws + 32;
    float m_reg = -1e30f, l_reg = 0; f32x16 o[4]; bf16x8 qr[NQR > 0 ? NQR : 1];
    char* Qs = lds + 2 * SHM_V + 2 * SHM_K + 8 * 64 * 4 + (wid * (ND0 - NQR) * 64 + lane) * 16;
#pragma unroll
    for (int d = 0; d < 4; ++d)
#pragma unroll
        for (int r = 0; r < 16; ++r) o[d][r] = 0.f;
    const bf16_t* Qw = Qb + (long)(wid * 32 + r32) * DQK + hi * 8;
#pragma unroll
    for (int d0 = 0; d0 < ND0; ++d0) { const bf16x8 qv = *reinterpret_cast<const bf16x8*>(Qw + d0 * 16); if (d0 < NQR) qr[d0] = qv; else *reinterpret_cast<bf16x8*>(Qs + (d0 - NQR) * 1024) = qv; }
    asm volatile("s_waitcnt lgkmcnt(0)" ::: "memory");
    const int sr = tid >> 4, sc = (tid & 15) * 8, vst0 = v_st(sr, sc), vst1 = v_st(32 + sr, sc);
    const int kgo = (tid >> 3) * DQK + (tid & 7) * 8, klo = (tid >> 3) * (DQK * 2) + (((tid & 7) << 4) ^ (((tid >> 3) & 7) << 4));
    const int vb0 = (int)(uintptr_t)V_lds + v_rd_base(lane);
    int kb[4];
#pragma unroll
    for (int m = 0; m < 4; ++m) { kb[m] = (int)(uintptr_t)K_lds + r32 * (DQK * 2) + 16 * (hi ^ (r32 & 1)) + 32 * (m ^ ((r32 >> 1) & 3)); asm volatile("" : "+v"(kb[m])); }
    struct { bf16x8 vs0, vs1, ks[NKCH]; } sr_[SDEPTH];
#define SLOAD(i, k0) do { sr_[i].vs0 = *(const bf16x8*)(&Vh[(long)((k0) + sr) * 128 + sc]); sr_[i].vs1 = *(const bf16x8*)(&Vh[(long)((k0) + 32 + sr) * 128 + sc]); \
    _Pragma("unroll") for (int q_ = 0; q_ < NKCH; ++q_) sr_[i].ks[q_] = *(const bf16x8*)(&Kh[(long)(k0) * DQK + kgo + q_ * 64]); } while (0)
#define SWRITE(b, i) do { *(bf16x8*)(V_lds + (b) * SHM_V + vst0) = sr_[i].vs0; *(bf16x8*)(V_lds + (b) * SHM_V + vst1) = sr_[i].vs1; \
    _Pragma("unroll") for (int q_ = 0; q_ < NKCH; ++q_) *(bf16x8*)(K_lds + (b) * SHM_K + klo + q_ * 128) = sr_[i].ks[q_]; } while (0)
#define SWAIT() do { if constexpr (SDEPTH == 1) asm volatile("s_waitcnt vmcnt(0)" ::: "memory"); else if constexpr (NKCH == 2) asm volatile("s_waitcnt vmcnt(4)" ::: "memory"); else asm volatile("s_waitcnt vmcnt(5)" ::: "memory"); } while (0)
#define RESC(a) do { if (__any((a) < 1.f)) { if (hi == 0) al_l[r32] = (a); asm volatile("s_waitcnt lgkmcnt(0)" ::: "memory"); \
    _Pragma("unroll") for (int d = 0; d < 4; ++d) _Pragma("unroll") for (int r = 0; r < 16; ++r) o[d][r] *= al_l[crow(r, hi)]; } } while (0)
    f32x16 pA0, pA1, pB0, pB1; float mnA, mnB, alA, alB; bf16x8 pa0, pa1, pa2, pa3; const int NT = seq / 64;
    constexpr int SE = 0, SO = SDEPTH - 1;
    SLOAD(SE, 0); asm volatile("s_waitcnt vmcnt(0)" ::: "memory"); SWRITE(0, SE); __syncthreads();
    qkt<DQK, NQR>(pA0, pA1, kb, 0, qr, (int)(uintptr_t)Qs, r32, hi); partialSM(pA0, pA1, m_reg, mnA, alA, SCALE);
    SLOAD(SO, 64); if constexpr (SDEPTH == 2) { if (2 < NT) SLOAD(SE, 2 * 64); }
    SWAIT(); SWRITE(1, SO); __syncthreads();
    for (int j = 1; j + 1 < NT; j += 2) {
        SBAR(); qkt<DQK, NQR>(pB0, pB1, kb, SHM_K, qr, (int)(uintptr_t)Qs, r32, hi);
        finishSM(pA0, pA1, alA, l_reg, pa0, pa1, pa2, pa3); SBAR();
        SLOAD(SO, (j + SDEPTH) * 64); SBAR();
        pv_d0(o, vb0, pa0, pa1, pa2, pa3); partialSM(pB0, pB1, m_reg, mnB, alB, SCALE);
        __syncthreads(); SWAIT(); SWRITE(0, SE);
        RESC(alB); __syncthreads();
        SBAR(); qkt<DQK, NQR>(pA0, pA1, kb, 0, qr, (int)(uintptr_t)Qs, r32, hi);
        finishSM(pB0, pB1, alB, l_reg, pa0, pa1, pa2, pa3); SBAR();
        if (SDEPTH == 1 || j + 3 < NT) SLOAD(SE, (j + 1 + SDEPTH) * 64); SBAR();
        pv_d0(o, vb0 + SHM_V, pa0, pa1, pa2, pa3); partialSM(pA0, pA1, m_reg, mnA, alA, SCALE);
        __syncthreads(); SWAIT(); SWRITE(1, SO);
        RESC(alA); __syncthreads();
    }
    SBAR(); qkt<DQK, NQR>(pB0, pB1, kb, SHM_K, qr, (int)(uintptr_t)Qs, r32, hi);
    finishSM(pA0, pA1, alA, l_reg, pa0, pa1, pa2, pa3); SBAR();
    pv_d0(o, vb0, pa0, pa1, pa2, pa3); partialSM(pB0, pB1, m_reg, mnB, alB, SCALE);
    __syncthreads(); RESC(alB);
    finishSM(pB0, pB1, alB, l_reg, pa0, pa1, pa2, pa3); SBAR();
    pv_d0(o, vb0 + SHM_V, pa0, pa1, pa2, pa3);
    if (hi == 0) li_l[r32] = l_reg; asm volatile("s_waitcnt lgkmcnt(0)" ::: "memory");
    float rli[16];
#pragma unroll
    for (int r = 0; r < 16; ++r) rli[r] = __builtin_amdgcn_rcpf(li_l[crow(r, hi)]);
    bf16_t* Ow = Ob + (long)(wid * 32) * ldo;
#pragma unroll
    for (int r = 0; r < 16; ++r) { const int orow = crow(r, hi);
#pragma unroll
        for (int d0 = 0; d0 < 4; ++d0) Ow[(long)orow * ldo + d0 * 32 + r32] = f2bf(o[d0][r] * rli[r]); }
    __syncthreads();
#undef SLOAD
#undef SWRITE
#undef SWAIT
#undef RESC
}

template <int DQK> DI void attn_body_old(const bf16_t* Qb, const bf16_t* Kh, const bf16_t* Vh, bf16_t* Ob, int ldo, int seq, char* lds, const float SCALE) {
    if constexpr (DQK == 192) attn_body<192, ATT_SD_M>(Qb, Kh, Vh, Ob, ldo, seq, lds, SCALE); else attn_body<128, ATT_SD_G>(Qb, Kh, Vh, Ob, ldo, seq, lds, SCALE);
}
template <int DQK>
DI void attn_body2(const bf16_t* __restrict__ Qb, const bf16_t* __restrict__ Kh, const bf16_t* __restrict__ Vh, bf16_t* __restrict__ Ob, int ldo, int seq, char* lds, const float SCALE) {
    constexpr int SHM_V = 64 * 128 * 2, SHM_K = 64 * DQK * 2, ND0 = DQK / 16, KP = SHM_K / 8192, VP = 2, NP = KP + VP;
    constexpr int V_RING = 0, K_RING = 4 * SHM_V, WS_OFF = K_RING + 3 * SHM_K;
    int tid = threadIdx.x; asm volatile("" : "+v"(tid));
    const int wid = __builtin_amdgcn_readfirstlane(tid >> 6), lane = tid & 63, r32 = lane & 31, hi = lane >> 5;
    float* ws = (float*)(lds + WS_OFF) + wid * 64; float* li_l = ws; float* al_l = ws + 32;
    float m_reg = -1e30f, l_reg = 0; f32x16 o[4]; bf16x8 qr[ND0];
#pragma unroll
    for (int d = 0; d < 4; ++d)
#pragma unroll
        for (int r = 0; r < 16; ++r) o[d][r] = 0.f;
    int kgo[KP], vgo[VP];
#pragma unroll
    for (int q = 0; q < KP; ++q) { const int sl = (wid * KP + q) * 64 + lane, row = sl / (DQK / 8), ch = sl % (DQK / 8), gch = (ch & ~7) | ((ch & 7) ^ (row & 7)); kgo[q] = row * DQK + gch * 8; }
#pragma unroll
    for (int q = 0; q < VP; ++q) { const int off = (wid * VP + q) * 1024 + lane * 16, sub = off >> 9, w = off & 511, kk = (sub >> 2) * 8 + (w >> 6), k = (kk & ~0xC) | ((kk & 4) << 1) | ((kk & 8) >> 1), c = (sub & 3) * 32 + ((w & 63) >> 1); vgo[q] = k * 128 + c; }
    LAS unsigned char* L = (LAS unsigned char*)lds;
#define DMA_TILE(t, ks, vs) do { \
    _Pragma("unroll") for (int q_ = 0; q_ < KP; ++q_) __builtin_amdgcn_global_load_lds((const unsigned*)(Kh + (size_t)(t) * 64 * DQK + kgo[q_]), (LAS unsigned*)(L + K_RING + (ks) * SHM_K + (wid * KP + q_) * 1024), 16, 0, 0); \
    _Pragma("unroll") for (int q_ = 0; q_ < VP; ++q_) __builtin_amdgcn_global_load_lds((const unsigned*)(Vh + (size_t)(t) * 64 * 128 + vgo[q_]), (LAS unsigned*)(L + V_RING + (vs) * SHM_V + (wid * VP + q_) * 1024), 16, 0, 0); } while (0)
    const int NT = seq / 64;
    DMA_TILE(0, 0, 0); DMA_TILE(1, 1, 1);
    const bf16_t* Qw = Qb + (long)(wid * 32 + r32) * DQK + hi * 8;
#pragma unroll
    for (int d0 = 0; d0 < ND0; ++d0) qr[d0] = *reinterpret_cast<const bf16x8*>(Qw + d0 * 16);
    const int vb0 = (int)(uintptr_t)(lds + V_RING) + v_rd_base(lane);
    int kb[4];
#pragma unroll
    for (int m = 0; m < 4; ++m) { kb[m] = (int)(uintptr_t)(lds + K_RING) + r32 * (DQK * 2) + 16 * (hi ^ (r32 & 1)) + 32 * (m ^ ((r32 >> 1) & 3)); asm volatile("" : "+v"(kb[m])); }
#define RESC(a) do { if (__any((a) < 1.f)) { if (hi == 0) al_l[r32] = (a); asm volatile("s_waitcnt lgkmcnt(0)" ::: "memory"); \
    _Pragma("unroll") for (int d = 0; d < 4; ++d) _Pragma("unroll") for (int r = 0; r < 16; ++r) o[d][r] *= al_l[crow(r, hi)]; } } while (0)
#define STEP_SYNC(j) do { if ((j) + 1 < NT) { if constexpr (NP == 5) asm volatile("s_waitcnt vmcnt(5)" ::: "memory"); else asm volatile("s_waitcnt vmcnt(4)" ::: "memory"); } else asm volatile("s_waitcnt vmcnt(0)" ::: "memory"); \
    asm volatile("s_waitcnt lgkmcnt(0)" ::: "memory"); __builtin_amdgcn_s_barrier(); asm volatile("" ::: "memory"); } while (0)
    f32x16 pA0, pA1, pB0, pB1; float mnA, mnB, alA, alB; bf16x8 pa0, pa1, pa2, pa3;
    asm volatile("s_waitcnt vmcnt(0)" ::: "memory");
    asm volatile("s_waitcnt lgkmcnt(0)" ::: "memory"); __builtin_amdgcn_s_barrier(); asm volatile("" ::: "memory");
    if (2 < NT) DMA_TILE(2, 2, 2);
    qkt<DQK, ND0>(pA0, pA1, kb, 0, qr, 0, r32, hi); partialSM(pA0, pA1, m_reg, mnA, alA, SCALE);
    int ks = 1, vs = 0;
    for (int j = 1; j + 1 < NT; j += 2) {
        STEP_SYNC(j);
        if (j + 2 < NT) { const int ks2 = ks == 0 ? 2 : ks - 1, vs2 = (vs + 3) & 3; DMA_TILE(j + 2, ks2, vs2); }
        SBAR(); qkt<DQK, ND0>(pB0, pB1, kb, ks * SHM_K, qr, 0, r32, hi);
        finishSM(pA0, pA1, alA, l_reg, pa0, pa1, pa2, pa3); SBAR();
        pv_d0(o, vb0 + vs * SHM_V, pa0, pa1, pa2, pa3); partialSM(pB0, pB1, m_reg, mnB, alB, SCALE);
        RESC(alB);
        ks = ks == 2 ? 0 : ks + 1; vs = (vs + 1) & 3;
        STEP_SYNC(j + 1);
        if (j + 3 < NT) { const int ks2 = ks == 0 ? 2 : ks - 1, vs2 = (vs + 3) & 3; DMA_TILE(j + 3, ks2, vs2); }
        SBAR(); qkt<DQK, ND0>(pA0, pA1, kb, ks * SHM_K, qr, 0, r32, hi);
        finishSM(pB0, pB1, alB, l_reg, pa0, pa1, pa2, pa3); SBAR();
        pv_d0(o, vb0 + vs * SHM_V, pa0, pa1, pa2, pa3); partialSM(pA0, pA1, m_reg, mnA, alA, SCALE);
        RESC(alA);
        ks = ks == 2 ? 0 : ks + 1; vs = (vs + 1) & 3;
    }
    STEP_SYNC(NT - 1);
    SBAR(); qkt<DQK, ND0>(pB0, pB1, kb, ks * SHM_K, qr, 0, r32, hi);
    finishSM(pA0, pA1, alA, l_reg, pa0, pa1, pa2, pa3); SBAR();
    pv_d0(o, vb0 + vs * SHM_V, pa0, pa1, pa2, pa3); partialSM(pB0, pB1, m_reg, mnB, alB, SCALE);
    RESC(alB);
    vs = (vs + 1) & 3;
    finishSM(pB0, pB1, alB, l_reg, pa0, pa1, pa2, pa3); SBAR();
    pv_d0(o, vb0 + vs * SHM_V, pa0, pa1, pa2, pa3);
    if (hi == 0) li_l[r32] = l_reg; asm volatile("s_waitcnt lgkmcnt(0)" ::: "memory");
    float rli[16];
#pragma unroll
    for (int r = 0; r < 16; ++r) rli[r] = __builtin_amdgcn_rcpf(li_l[crow(r, hi)]);
    bf16_t* Ow = Ob + (long)(wid * 32) * ldo;
#pragma unroll
    for (int r = 0; r < 16; ++r) { const int orow = crow(r, hi);
#pragma unroll
        for (int d0 = 0; d0 < 4; ++d0) Ow[(long)orow * ldo + d0 * 32 + r32] = f2bf(o[d0][r] * rli[r]); }
    asm volatile("s_waitcnt lgkmcnt(0)" ::: "memory"); __builtin_amdgcn_s_barrier(); asm volatile("" ::: "memory");
#undef DMA_TILE
#undef RESC
#undef STEP_SYNC
}

constexpr int GL_V = 0;
constexpr int GL_K = 16384;
constexpr int GL_Q = GL_K + 9216;
constexpr int GL_ZF = GL_Q + 9216;
constexpr int GL_ZB = GL_ZF + 4096;
constexpr int GL_LF = GL_ZB + 4096;
constexpr int GL_LB = GL_LF + 16640;
constexpr int GL_X0 = GL_LB + 16640;
constexpr int GL_KEF = GL_X0, GL_KEB = GL_X0 + 9216;
constexpr int GL_QD = GL_X0, GL_KI = GL_X0 + 9216;
constexpr int GL_O = GL_X0 + 18432;
static_assert(GL_O + 64 * 132 * 4 <= 160 * 1024 - 256, "GLA LDS");
DI int gla_row0(int b, int c) { return c < 4 ? NLAT + b * CTXL + c * 64 : b * SEQ + (c - 4) * 64; }
DI void gla_prep(PR p, int l, char* lds, int b, int h, int c, bool needq) {
    const int tid = tid_here(), lane = tid & 63, wid = tid >> 6;
    const bf16_t* PR_ = (const bf16_t*)(p.ws + WS_U + U_PROJ);
    const int row0 = gla_row0(b, c);
    {
        const int t = tid >> 3, dg = (tid & 7) * 8; const bf16_t* pr = PR_ + (size_t)(row0 + t) * INWP;
        *(bf16x8*)(lds + GL_K + t * 144 + dg * 2) = *(const bf16x8*)(pr + C_GK + h * 64 + dg);
        if (needq) { const bf16x8 qv = *(const bf16x8*)(pr + C_GQ + h * 64 + dg); u32x4 w;
            w.x = pk2(bf2f((bf16_t)qv[0]) * 0.125f, bf2f((bf16_t)qv[1]) * 0.125f); w.y = pk2(bf2f((bf16_t)qv[2]) * 0.125f, bf2f((bf16_t)qv[3]) * 0.125f);
            w.z = pk2(bf2f((bf16_t)qv[4]) * 0.125f, bf2f((bf16_t)qv[5]) * 0.125f); w.w = pk2(bf2f((bf16_t)qv[6]) * 0.125f, bf2f((bf16_t)qv[7]) * 0.125f);
            *(u32x4*)(lds + GL_Q + t * 144 + dg * 2) = w; }
        const int sr = tid >> 4, sc = (tid & 15) * 8;
        *(bf16x8*)(lds + GL_V + v_st(sr, sc)) = *(const bf16x8*)(PR_ + (size_t)(row0 + sr) * INWP + C_GV + h * 128 + sc);
        *(bf16x8*)(lds + GL_V + v_st(32 + sr, sc)) = *(const bf16x8*)(PR_ + (size_t)(row0 + 32 + sr) * INWP + C_GV + h * 128 + sc);
        if (tid < 256) { const int tt = (tid & 127) >> 1, half = tid & 1, dir = tid >> 7; const bf16x8 zv = *(const bf16x8*)(PR_ + (size_t)(row0 + tt) * INWP + (dir ? C_ZB : C_ZF) + half * 8);
            float* Z = (float*)(lds + (dir ? GL_ZB : GL_ZF)) + tt * 16 + half * 8;
#pragma unroll
            for (int j = 0; j < 8; ++j) Z[j] = bf2f((bf16_t)zv[j]); }
    }
    float wf[16], wb[16];
#pragma unroll
    for (int r = 0; r < 16; ++r) { wf[r] = p.gla_wg2_f[((size_t)l * 16 + r) * 256 + h * 64 + lane]; wb[r] = p.gla_wg2_b[((size_t)l * 16 + r) * 256 + h * 64 + lane]; }
    const float bgf = p.gla_bg_f[l * 256 + h * 64 + lane], bgb = p.gla_bg_b[l * 256 + h * 64 + lane];
    __syncthreads();
#pragma unroll
    for (int i = 0; i < 8; ++i) {
        const int t = wid * 8 + i; const float* ZF = (const float*)(lds + GL_ZF) + t * 16; const float* ZB = (const float*)(lds + GL_ZB) + t * 16;
        float zf = bgf, zb = bgb;
#pragma unroll
        for (int r = 0; r < 16; ++r) { zf += ZF[r] * wf[r]; zb += ZB[r] * wb[r]; }
        const float lf = fminf(zf, 0.f) - __logf(1.f + __expf(-fabsf(zf))), lb = fminf(zb, 0.f) - __logf(1.f + __expf(-fabsf(zb)));
        ((float*)(lds + GL_LF))[t * 65 + lane] = lf * 0.0625f; ((float*)(lds + GL_LB))[t * 65 + lane] = lb * 0.0625f;
    }
    __syncthreads();
#pragma unroll
    for (int i = 0; i < 8; ++i) {
        const int d = wid * 8 + i;
        float* F = (float*)(lds + GL_LF) + lane * 65 + d; float* Bk = (float*)(lds + GL_LB) + lane * 65 + d;
        float f = *F, g = *Bk;
#pragma unroll
        for (int o = 1; o < 64; o <<= 1) {
            const float fu = __int_as_float(__builtin_amdgcn_ds_bpermute(((lane - o) & 63) << 2, __float_as_int(f)));
            const float gu = __int_as_float(__builtin_amdgcn_ds_bpermute(((lane + o) & 63) << 2, __float_as_int(g)));
            if (lane >= o) f += fu; if (lane + o < 64) g += gu;
        }
        *F = f; *Bk = g;
    }
    __syncthreads();
}
DI void gla_phaseA(PR p, int l, char* lds) {
    float* GS = (float*)(p.ws + WS_U + U_GS); float* GD = (float*)(p.ws + WS_GDEC);
    for (int u = bid_here(); u < 16 * 68; u += gridDim.x) {
        const int bh = u / 68, c = u % 68, b = bh >> 2, h = bh & 3;
        gla_prep(p, l, lds, b, h, c, false);
        const int tid = tid_here(), lane = tid & 63, wid = tid >> 6, r32 = lane & 31, hi = lane >> 5;
        {
            const float* LF = (const float*)(lds + GL_LF); const float* LB = (const float*)(lds + GL_LB);
            const float lastf = LF[63 * 65 + lane], lastb = LB[0 * 65 + lane];
            float ef[8], eb[8];
#pragma unroll
            for (int i = 0; i < 8; ++i) { const int t = wid * 8 + i; const float k = bf2f(*(const bf16_t*)(lds + GL_K + t * 144 + lane * 2));
                ef[i] = k * __expf(lastf - LF[t * 65 + lane]); eb[i] = k * __expf(lastb - LB[t * 65 + lane]); }
            u32x4 w; w.x = pk2(ef[0], ef[1]); w.y = pk2(ef[2], ef[3]); w.z = pk2(ef[4], ef[5]); w.w = pk2(ef[6], ef[7]); *(u32x4*)(lds + GL_KEF + lane * 144 + wid * 16) = w;
            w.x = pk2(eb[0], eb[1]); w.y = pk2(eb[2], eb[3]); w.z = pk2(eb[4], eb[5]); w.w = pk2(eb[6], eb[7]); *(u32x4*)(lds + GL_KEB + lane * 144 + wid * 16) = w;
            if (wid == 0) { GD[((size_t)(0 * 16 + bh) * 68 + c) * 64 + lane] = __expf(lastf); GD[((size_t)(1 * 16 + bh) * 68 + c) * 64 + lane] = __expf(lastb); }
        }
        __syncthreads();
        {
            const int rh = wid & 1, cb = wid >> 1;
            const int vb = (int)(uintptr_t)(lds + GL_V) + v_rd_base(lane) + cb * 512;
#pragma unroll
            for (int dir = 0; dir < 2; ++dir) {
                const char* KE = lds + (dir ? GL_KEB : GL_KEF) + (rh * 32 + r32) * 144 + hi * 16;
                const bf16x8 a0 = *(const bf16x8*)(KE), a1 = *(const bf16x8*)(KE + 32), a2 = *(const bf16x8*)(KE + 64), a3 = *(const bf16x8*)(KE + 96);
                f32x16 od;
#pragma unroll
                for (int r = 0; r < 16; ++r) od[r] = 0.f;
                pv_one<0>(od, vb, a0, a1, a2, a3);
                float* dst = GS + ((size_t)(dir * 16 + bh) * 68 + c) * 8192 + (size_t)(cb * 32 + r32) * 64 + rh * 32 + 4 * hi;
#pragma unroll
                for (int g = 0; g < 4; ++g) *(f32x4*)(dst + 8 * g) = (f32x4){od[4 * g], od[4 * g + 1], od[4 * g + 2], od[4 * g + 3]};
            }
        }
        __syncthreads();
    }
}
DI void gla_scan(PR p) {
    const float* GS = (const float*)(p.ws + WS_U + U_GS); const float* GD = (const float*)(p.ws + WS_GDEC); bf16_t* GST = (bf16_t*)(p.ws + WS_U + U_GST);
    const int tid = tid_here();
    for (int u = bid_here(); u < 128; u += gridDim.x) {
        const int e = u * NTHREADS + tid, db = e >> 11, jd4 = e & 2047, d4 = (jd4 & 15) * 4;
        const int dir = db >> 4;
        const float* base = GS + (size_t)db * 68 * 8192 + jd4 * 4; const float* dbase = GD + (size_t)db * 68 * 64 + d4; bf16_t* obase = GST + (size_t)db * 68 * 8192 + jd4 * 4;
#define SC_C(i) (dir == 0 ? (i) : ((i) < 4 ? 3 - (i) : 71 - (i)))
        float z0 = 0.f; asm volatile("" : "+v"(z0));
        f32x4 S = {z0, z0, z0, z0};
        f32x4 cur[4], nxt[4], dc[4], dn[4];
#pragma unroll
        for (int q = 0; q < 4; ++q) { const int c = SC_C(q); cur[q] = *(const f32x4*)(base + (size_t)c * 8192); dc[q] = *(const f32x4*)(dbase + c * 64); }
        for (int i = 0; i < 68; i += 4) {
            if (i + 4 < 68) {
#pragma unroll
                for (int q = 0; q < 4; ++q) { const int c = SC_C(i + 4 + q); nxt[q] = *(const f32x4*)(base + (size_t)c * 8192); dn[q] = *(const f32x4*)(dbase + c * 64); }
            }
#pragma unroll
            for (int q = 0; q < 4; ++q) { const int c = SC_C(i + q); u32x2 w; w.x = pk2(S[0], S[1]); w.y = pk2(S[2], S[3]); *(u32x2*)(obase + (size_t)c * 8192) = w; S = S * dc[q] + cur[q]; }
#pragma unroll
            for (int q = 0; q < 4; ++q) { cur[q] = nxt[q]; dc[q] = dn[q]; }
        }
#undef SC_C
    }
}
DI void gla_phaseC(PR p, int l, char* lds) {
    const bf16_t* GST = (const bf16_t*)(p.ws + WS_U + U_GST);
    const bf16_t* PR_ = (const bf16_t*)(p.ws + WS_U + U_PROJ); bf16_t* MIX = (bf16_t*)(p.ws + WS_U + U_MIX);
    for (int u = bid_here(); u < 16 * 68; u += gridDim.x) {
        const int bh = u / 68, c = u % 68, b = bh >> 2, h = bh & 3;
        if (l == 1 && c < 4) continue;
        gla_prep(p, l, lds, b, h, c, true);
        const int tid = tid_here(), lane = tid & 63, wid = tid >> 6, r32 = lane & 31, hi = lane >> 5, rh = wid & 1, cb = wid >> 1;
        const int vb = (int)(uintptr_t)(lds + GL_V) + v_rd_base(lane) + cb * 512;
        f32x16 o;
#pragma unroll
        for (int r = 0; r < 16; ++r) o[r] = 0.f;
#pragma unroll
        for (int dir = 0; dir < 2; ++dir) {
            {
                const int t = tid >> 3, dg = (tid & 7) * 8; const float* LC = (const float*)(lds + (dir ? GL_LB : GL_LF)) + t * 65 + dg;
                const bf16x8 qv = *(const bf16x8*)(lds + GL_Q + t * 144 + dg * 2), kv = *(const bf16x8*)(lds + GL_K + t * 144 + dg * 2);
                float qd[8], ki[8];
#pragma unroll
                for (int j = 0; j < 8; ++j) { const float bc = LC[j]; qd[j] = bf2f((bf16_t)qv[j]) * __expf(bc); ki[j] = bf2f((bf16_t)kv[j]) * __expf(-bc); }
                u32x4 w; w.x = pk2(qd[0], qd[1]); w.y = pk2(qd[2], qd[3]); w.z = pk2(qd[4], qd[5]); w.w = pk2(qd[6], qd[7]); *(u32x4*)(lds + GL_QD + t * 144 + dg * 2) = w;
                w.x = pk2(ki[0], ki[1]); w.y = pk2(ki[2], ki[3]); w.z = pk2(ki[4], ki[5]); w.w = pk2(ki[6], ki[7]); *(u32x4*)(lds + GL_KI + t * 144 + dg * 2) = w;
            }
            __syncthreads();
            {
                const char* QD = lds + GL_QD + (rh * 32 + r32) * 144 + hi * 16; const char* KI = lds + GL_KI + r32 * 144 + hi * 16;
                bf16x8 qf[4];
#pragma unroll
                for (int d0 = 0; d0 < 4; ++d0) qf[d0] = *(const bf16x8*)(QD + d0 * 32);
                f32x16 p0, p1;
#pragma unroll
                for (int r = 0; r < 16; ++r) { p0[r] = 0.f; p1[r] = 0.f; }
#pragma unroll
                for (int d0 = 0; d0 < 4; ++d0) {
                    const bf16x8 k0 = *(const bf16x8*)(KI + d0 * 32), k1 = *(const bf16x8*)(KI + 32 * 144 + d0 * 32);
                    p0 = __builtin_amdgcn_mfma_f32_32x32x16_bf16(k0, qf[d0], p0, 0, 0, 0);
                    p1 = __builtin_amdgcn_mfma_f32_32x32x16_bf16(k1, qf[d0], p1, 0, 0, 0);
                }
                const int tq = rh * 32 + r32;
#pragma unroll
                for (int r = 0; r < 16; ++r) { const int s0 = crow(r, hi), s1 = 32 + s0;
                    const bool ok0 = dir == 0 ? (s0 <= tq) : (s0 >= tq), ok1 = dir == 0 ? (s1 <= tq) : (s1 >= tq);
                    p0[r] = ok0 ? p0[r] : 0.f; p1[r] = ok1 ? p1[r] : 0.f; }
                bf16x8 pa0, pa1, pa2, pa3;
#define PK4(P, BASE, OUT) do { unsigned a0 = cvtpk(P[BASE + 0], P[BASE + 1]), a1 = cvtpk(P[BASE + 2], P[BASE + 3]);   \
    unsigned b0 = cvtpk(P[BASE + 4], P[BASE + 5]), b1 = cvtpk(P[BASE + 6], P[BASE + 7]);                              \
    auto r0 = __builtin_amdgcn_permlane32_swap(a0, b0, false, false); auto r1 = __builtin_amdgcn_permlane32_swap(a1, b1, false, false); \
    u32x4 w_ = {r0[0], r1[0], r0[1], r1[1]}; OUT = *reinterpret_cast<bf16x8*>(&w_); } while (0)
                PK4(p0, 0, pa0); PK4(p0, 8, pa1); PK4(p1, 0, pa2); PK4(p1, 8, pa3);
#undef PK4
                pv_one<0>(o, vb, pa0, pa1, pa2, pa3);
                const bf16_t* Sg = GST + ((size_t)(dir * 16 + bh) * 68 + c) * 8192 + (size_t)(cb * 32 + r32) * 64 + hi * 8;
                const bf16x8 s0 = *(const bf16x8*)(Sg), s1 = *(const bf16x8*)(Sg + 16), s2 = *(const bf16x8*)(Sg + 32), s3 = *(const bf16x8*)(Sg + 48);
                o = __builtin_amdgcn_mfma_f32_32x32x16_bf16(qf[0], s0, o, 0, 0, 0);
                o = __builtin_amdgcn_mfma_f32_32x32x16_bf16(qf[1], s1, o, 0, 0, 0);
                o = __builtin_amdgcn_mfma_f32_32x32x16_bf16(qf[2], s2, o, 0, 0, 0);
                o = __builtin_amdgcn_mfma_f32_32x32x16_bf16(qf[3], s3, o, 0, 0, 0);
            }
            __syncthreads();
        }
        { float* O = (float*)(lds + GL_O);
#pragma unroll
          for (int r = 0; r < 16; ++r) O[(rh * 32 + crow(r, hi)) * 132 + cb * 32 + r32] = o[r]; }
        __syncthreads();
        {
            const int t = tid >> 3, jg = (tid & 7) * 16; const float* O = (const float*)(lds + GL_O) + t * 132 + jg;
            float v[16], ss = 0.f;
#pragma unroll
            for (int q = 0; q < 4; ++q) { const f32x4 x = *(const f32x4*)(O + 4 * q); v[4 * q] = x[0]; v[4 * q + 1] = x[1]; v[4 * q + 2] = x[2]; v[4 * q + 3] = x[3]; ss += x[0] * x[0] + x[1] * x[1] + x[2] * x[2] + x[3] * x[3]; }
            ss += shx(ss, 1, lane); ss += shx(ss, 2, lane); ss += shx(ss, 4, lane);
            const float rstd = rsqrtf(ss * (1.f / 128.f) + EPS);
            const int row = gla_row0(b, c) + t;
            const bf16_t* gp = PR_ + (size_t)row * INWP + C_GG + h * 128 + jg; const float* go = p.gla_g_out + l * 128 + jg;
            const bf16x8 g0 = *(const bf16x8*)(gp), g1 = *(const bf16x8*)(gp + 8);
            float ov[16];
#pragma unroll
            for (int j = 0; j < 16; ++j) { const float gate = bf2f((bf16_t)(j < 8 ? g0[j] : g1[j - 8])); ov[j] = v[j] * rstd * go[j] * silu_f(gate); }
            u32x4 w0, w1; w0.x = pk2(ov[0], ov[1]); w0.y = pk2(ov[2], ov[3]); w0.z = pk2(ov[4], ov[5]); w0.w = pk2(ov[6], ov[7]); w1.x = pk2(ov[8], ov[9]); w1.y = pk2(ov[10], ov[11]); w1.z = pk2(ov[12], ov[13]); w1.w = pk2(ov[14], ov[15]);
            bf16_t* dst = MIX + (size_t)row * D + h * 128 + jg; *(u32x4*)(dst) = w0; *(u32x4*)(dst + 8) = w1;
        }
        __syncthreads();
    }
}

namespace pg {
constexpr int BK = 64, HALF = 128, HTB = HALF * BK * 2, STAGE_BYTES = 8 * HTB;
DI int lds_byte(int r, int c) { const int st = (r >> 4) * 2 + (c >> 5), rr = r & 15, cc = c & 31, ob = rr * 64 + cc * 2; return st * 1024 + (ob ^ (((ob >> 9) & 1) << 5)); }
DI int perm32(int rho) { const int n = rho >> 4, i = rho & 15; return 8 * (i >> 2) + 4 * n + (i & 3); }
DI void stage_rc(int b, int& R, int& C) { const int st = b / 1024, sb = b % 1024, swz = sb ^ (((sb >> 9) & 1) << 5); R = (st >> 1) * 16 + swz / 64; C = (st & 1) * 32 + (swz % 64) / 2; }
struct XUnit {
    const char* A;
    const char* B;
    int arow0;
    int list;
    int e0, e1, e2, e3;
};
template <class Sched>
DI void gemm_phase(LAS unsigned char* lds, const LAS int* rowlists, const Sched& S) {
    int tid = threadIdx.x; asm volatile("" : "+v"(tid));
    const int wid = __builtin_amdgcn_readfirstlane(tid >> 6), lane = tid & 63, wr = wid >> 2, wc = wid & 3, fr = lane & 15, fq = lane >> 4;
    const int K = S.K, nt = K / BK;
    unsigned voffB[2];
#pragma unroll
    for (int i = 0; i < 2; ++i) { int R_, C_; stage_rc(tid * 16 + i * 8192, R_, C_); if (Sched::PERM) R_ = (R_ & ~31) + perm32(R_ & 31); voffB[i] = (unsigned)R_ * (unsigned)S.ldb + (unsigned)C_ * 2u; }
    const size_t kstep = (size_t)(BK * 2), hstepB = (size_t)HALF * S.ldb;
    const unsigned ldsw = (unsigned)wid * 1024u;
    const int aoff = lds_byte(wr * 64 + fr, fq * 8), boff = lds_byte(wc * 32 + fr, fq * 8);
#define PG_SA(b, h) (((b) * 2 + (h)) * HTB)
#define PG_SB(b, h) ((4 + (b) * 2 + (h)) * HTB)
#define PG_STAGE(bufoff, gbase, voff) do { _Pragma("unroll") for (int _i = 0; _i < 2; ++_i) \
        __builtin_amdgcn_global_load_lds((const unsigned*)((const char*)(gbase) + (voff)[_i]), (LAS unsigned*)(lds + (bufoff) + ldsw + _i * 8192), 16, 0, 0); } while (0)
#define PG_LDA(dst, b, h) do { _Pragma("unroll") for (int m = 0; m < 4; ++m) _Pragma("unroll") for (int k = 0; k < 2; ++k) dst[m][k] = *(const LAS bf16x8*)(lds + PG_SA(b, h) + aoff + m * 2048 + k * 1024); } while (0)
#define PG_LDB(dst, b, h) do { _Pragma("unroll") for (int n = 0; n < 2; ++n) _Pragma("unroll") for (int k = 0; k < 2; ++k) dst[n][k] = *(const LAS bf16x8*)(lds + PG_SB(b, h) + boff + n * 2048 + k * 1024); } while (0)
#define PG_MMA(ai, bj, At, Bt) do { __builtin_amdgcn_s_setprio(1); _Pragma("unroll") for (int m = 0; m < 4; ++m) _Pragma("unroll") for (int n = 0; n < 2; ++n) _Pragma("unroll") for (int k = 0; k < 2; ++k) \
        acc[ai][bj][m][n] = __builtin_amdgcn_mfma_f32_16x16x32_bf16(Bt[n][k], At[m][k], acc[ai][bj][m][n], 0, 0, 0); __builtin_amdgcn_s_setprio(0); } while (0)
#define PG_WAIT_V(n) asm volatile("s_waitcnt vmcnt(" #n ")" ::: "memory")
#define PG_WAIT_L(n) asm volatile("s_waitcnt lgkmcnt(" #n ")" ::: "memory")
#define PG_BAR __builtin_amdgcn_s_barrier()
#define PG_SCHED __builtin_amdgcn_sched_barrier(0)
#define PG_AOFFS(dst, u) do { const int _t = tid_here(); _Pragma("unroll") for (int _i = 0; _i < 2; ++_i) { int _R, _C; stage_rc(_t * 16 + _i * 8192, _R, _C); _Pragma("unroll") for (int _h = 0; _h < 2; ++_h) { \
        unsigned _row; if ((u).list >= 0) { const int _x = rowlists[(u).list + _h * HALF + _R]; _row = _x >= 0 ? (unsigned)(_x >> S.rowshift) : 0u; } else _row = (unsigned)((u).arow0 + _h * HALF + _R); \
        dst[_h][_i] = _row * (unsigned)S.lda + (unsigned)_C * 2u; } } } while (0)
    XUnit cur, nxt; int ui = 0;
    if (!S.next(0, cur)) return;
    f32x4 acc[2][2][4][2];
#pragma unroll
    for (int a = 0; a < 2; ++a)
#pragma unroll
        for (int b = 0; b < 2; ++b)
#pragma unroll
            for (int m = 0; m < 4; ++m)
#pragma unroll
                for (int n = 0; n < 2; ++n) acc[a][b][m][n] = (f32x4){0.f, 0.f, 0.f, 0.f};
    bf16x8 At[4][2], B0[2][2], B1[2][2];
    unsigned ao[2][2];
    PG_AOFFS(ao, cur);
    PG_WAIT_L(0); PG_SCHED;
    const char* cA = cur.A; const char* cB = cur.B;
    PG_STAGE(PG_SB(0, 0), cB, voffB); PG_STAGE(PG_SA(0, 0), cA, ao[0]); PG_STAGE(PG_SB(0, 1), cB + hstepB, voffB); PG_STAGE(PG_SA(0, 1), cA, ao[1]);
    if (wr == 1) PG_BAR;
    PG_WAIT_V(4); PG_BAR;
    PG_STAGE(PG_SB(1, 0), cB + kstep, voffB); PG_STAGE(PG_SA(1, 0), cA + kstep, ao[0]); PG_STAGE(PG_SB(1, 1), cB + hstepB + kstep, voffB);
    PG_WAIT_V(6); PG_BAR;
    for (;;) {
        const bool has_next = S.next(ui + 1, nxt);
        const char* nA = has_next ? nxt.A : cA; const char* nB = has_next ? nxt.B : cB;
        for (int t = 0; t < nt; t += 2) {
            const bool last = (t == nt - 2);
            const char* a1 = cA + (size_t)(t + 1) * kstep;
            const char* a2 = last ? nA : cA + (size_t)(t + 2) * kstep; const char* b2 = last ? nB : cB + (size_t)(t + 2) * kstep;
            const char* a3 = a2 + kstep; const char* b3 = b2 + kstep;
            PG_LDB(B0, 0, 0); PG_SCHED; PG_LDA(At, 0, 0); PG_STAGE(PG_SA(1, 1), a1, ao[1]);
            PG_WAIT_L(8); PG_BAR; PG_WAIT_L(0); PG_MMA(0, 0, At, B0); PG_BAR; PG_SCHED;
            if (last && has_next) { PG_AOFFS(ao, nxt); }
            PG_LDB(B1, 0, 1); PG_STAGE(PG_SB(0, 0), b2, voffB);
            PG_BAR; PG_WAIT_L(0); PG_MMA(0, 1, At, B1); PG_BAR;
            PG_LDA(At, 0, 1); PG_STAGE(PG_SA(0, 0), a2, ao[0]);
            PG_BAR; PG_WAIT_L(0); PG_MMA(1, 0, At, B0); PG_BAR; PG_SCHED;
            PG_STAGE(PG_SB(0, 1), b2 + hstepB, voffB);
            PG_WAIT_V(6); PG_BAR; PG_MMA(1, 1, At, B1); PG_BAR;
            PG_LDB(B0, 1, 0); PG_SCHED; PG_LDA(At, 1, 0); PG_STAGE(PG_SA(0, 1), a2, ao[1]);
            PG_WAIT_L(8); PG_BAR; PG_WAIT_L(0); PG_MMA(0, 0, At, B0); PG_BAR; PG_SCHED;
            PG_LDB(B1, 1, 1); PG_STAGE(PG_SB(1, 0), b3, voffB);
            PG_BAR; PG_WAIT_L(0); PG_MMA(0, 1, At, B1); PG_BAR;
            PG_LDA(At, 1, 1); PG_STAGE(PG_SA(1, 0), a3, ao[0]);
            PG_BAR; PG_WAIT_L(0); PG_MMA(1, 0, At, B0); PG_BAR; PG_SCHED;
            PG_STAGE(PG_SB(1, 1), b3 + hstepB, voffB);
            PG_WAIT_V(6); PG_BAR; PG_MMA(1, 1, At, B1); PG_BAR;
        }
        { const int t2 = tid_here(), w2 = t2 >> 6, l2 = t2 & 63; S.epi(acc, cur, w2 >> 2, w2 & 3, l2 & 15, l2 >> 4); }
        if (!has_next) break;
#pragma unroll
        for (int a = 0; a < 2; ++a)
#pragma unroll
            for (int b = 0; b < 2; ++b)
#pragma unroll
                for (int m = 0; m < 4; ++m)
#pragma unroll
                    for (int n = 0; n < 2; ++n) acc[a][b][m][n] = (f32x4){0.f, 0.f, 0.f, 0.f};
        cur = nxt; cA = nA; cB = nB; ++ui;
    }
    PG_WAIT_V(0);
    if (wr == 0) PG_BAR;
    PG_BAR;
#undef PG_SA
#undef PG_SB
#undef PG_STAGE
#undef PG_LDA
#undef PG_LDB
#undef PG_MMA
#undef PG_WAIT_V
#undef PG_WAIT_L
#undef PG_BAR
#undef PG_SCHED
#undef PG_AOFFS
}
}

DI void phase_router(PR p, int l, char* lds, bool dry = false) {
    const int tid = tid_here(), wid = tid >> 6, lane = tid & 63;
    const unsigned char* wl = p.ws + WS_WEIGHTS + (size_t)l * WL_END;
    const bf16_t* WH = (const bf16_t*)(wl + WL_WRH); const bf16_t* WLo = (const bf16_t*)(wl + WL_WRL);
    const bf16_t* HH = (const bf16_t*)(p.ws + WS_HBUF); const bf16_t* HL = (const bf16_t*)(p.ws + WS_U + U_HLO);
    int* EIDX = (int*)(p.ws + WS_EIDX); float* EW = (float*)(p.ws + WS_EW); int* EPOS = (int*)(p.ws + WS_EPOS);
    unsigned* cnt = (unsigned*)(p.ws + WS_CNT) + l * 64;
    const float rbias = p.router_b[l * 64 + lane];
    float* LG = (float*)lds + wid * (16 * 65 + 16 * 64);
    int* PKI = (int*)(LG + 16 * 65);
    const int ntok = l == 0 ? NTOK : NLAT, ngrp = ntok / 16;
    const int fr = lane & 15, fq = lane >> 4;
    for (int gidx = bid_here() * 8 + wid; gidx < ngrp; gidx += gridDim.x * 8) {
        const int row0 = gidx * 16;
        f32x4 acc[4];
#pragma unroll
        for (int e = 0; e < 4; ++e) acc[e] = (f32x4){0.f, 0.f, 0.f, 0.f};
        const bf16_t* ah = HH + (size_t)(row0 + fr) * D + fq * 8; const bf16_t* al = HL + (size_t)(row0 + fr) * D + fq * 8;
        const bf16_t* bh = WH + (size_t)fr * D + fq * 8; const bf16_t* bl = WLo + (size_t)fr * D + fq * 8;
        for (int k0 = 0; k0 < D; k0 += 128) {
            bf16x8 a_hi[4], a_lo[4], b_hi[4][4], b_lo[4][4];
#pragma unroll
            for (int j = 0; j < 4; ++j) { a_hi[j] = *(const bf16x8*)(ah + k0 + 32 * j); a_lo[j] = *(const bf16x8*)(al + k0 + 32 * j);
#pragma unroll
                for (int e = 0; e < 4; ++e) { b_hi[j][e] = *(const bf16x8*)(bh + (size_t)e * 16 * D + k0 + 32 * j); b_lo[j][e] = *(const bf16x8*)(bl + (size_t)e * 16 * D + k0 + 32 * j); } }
#pragma unroll
            for (int j = 0; j < 4; ++j)
#pragma unroll
                for (int e = 0; e < 4; ++e) {
                    acc[e] = __builtin_amdgcn_mfma_f32_16x16x32_bf16(a_hi[j], b_hi[j][e], acc[e], 0, 0, 0);
                    acc[e] = __builtin_amdgcn_mfma_f32_16x16x32_bf16(a_hi[j], b_lo[j][e], acc[e], 0, 0, 0);
                    acc[e] = __builtin_amdgcn_mfma_f32_16x16x32_bf16(a_lo[j], b_hi[j][e], acc[e], 0, 0, 0);
                }
        }
#pragma unroll
        for (int e = 0; e < 4; ++e)
#pragma unroll
            for (int i = 0; i < 4; ++i) LG[(fq * 4 + i) * 65 + e * 16 + fr] = acc[e][i];
        asm volatile("s_waitcnt lgkmcnt(0)" ::: "memory");
        __builtin_amdgcn_wave_barrier();
        int mycount = 0;
        for (int t = 0; t < 16; ++t) {
            const float sc = sigmoid_f(LG[t * 65 + lane]), v = sc + rbias;
            float m1 = v, m2 = -INFINITY;
#pragma unroll
            for (int o = 1; o < 8; o <<= 1) { const float b1 = shx(m1, o, lane), b2 = shx(m2, o, lane); const float n1 = fmaxf(m1, b1), n2 = fmaxf(fminf(m1, b1), fmaxf(m2, b2)); m1 = n1; m2 = n2; }
            const float gs = m1 + m2;
            int grank = 0; const int g = lane >> 3;
#pragma unroll
            for (int gg = 0; gg < 8; ++gg) { const float s = __int_as_float(__builtin_amdgcn_readlane(__float_as_int(gs), gg * 8)); grank += (s > gs || (s == gs && gg < g)) ? 1 : 0; }
            const bool gsel = grank < 4;
            const float vs = gsel ? v : -INFINITY;
            int erk = 0;
#pragma unroll 4
            for (int j = 0; j < 64; ++j) { const float s = __int_as_float(__builtin_amdgcn_readlane(__float_as_int(vs), j)); erk += (s > vs || (s == vs && j < lane)) ? 1 : 0; }
            const bool chosen = gsel && erk < 8;
            const float wsum = wave_sum(chosen ? sc : 0.f);
            int pk = -1;
            if (chosen) { const int a = (row0 + t) * 8 + erk; EIDX[a] = lane; EW[a] = sc * (2.5f / wsum); pk = erk | (mycount << 8); ++mycount; }
            PKI[t * 64 + lane] = pk;
        }
        const unsigned base = (mycount && !dry) ? atomicAdd(&cnt[lane], (unsigned)mycount) : 0u;
        if (!dry) {
#pragma unroll
            for (int t = 0; t < 16; ++t) { const int pk = PKI[t * 64 + lane]; if (pk >= 0) EPOS[(row0 + t) * 8 + (pk & 255)] = (int)base + (pk >> 8); }
        }
        asm volatile("s_waitcnt lgkmcnt(0)" ::: "memory");
        __builtin_amdgcn_wave_barrier();
    }
}
DI void phase_moe_index(PR p, int l, char* lds) {
    const int tid = tid_here();
    int* S = (int*)lds;
    const unsigned* cnt = (const unsigned*)(p.ws + WS_CNT) + l * 64;
    int* META = (int*)(p.ws + WS_META) + l * 1024;
    const int* EIDX = (const int*)(p.ws + WS_EIDX); const float* EW = (const float*)(p.ws + WS_EW); const int* EPOS = (const int*)(p.ws + WS_EPOS);
    int* SASG = (int*)(p.ws + WS_SASG); float* SW = (float*)(p.ws + WS_SW);
    if (tid < 64) S[128 + tid] = (int)cnt[tid];
    __syncthreads();
    if (tid == 0) { int s = 0; for (int e = 0; e < 64; ++e) { S[e] = s; s += (S[128 + e] + 255) / 256 * 256; } S[64] = s; }
    __syncthreads();
    const int ntok = l == 0 ? NTOK : NLAT;
    for (int a = bid_here() * NTHREADS + tid; a < ntok * 8; a += gridDim.x * NTHREADS) { const int e = EIDX[a], pos = S[e] + EPOS[a]; SASG[pos] = a; SW[pos] = EW[a]; }
    for (int i = bid_here() * NTHREADS + tid; i < 64 * 256; i += gridDim.x * NTHREADS) { const int e = i >> 8, q = i & 255, c = S[128 + e]; if (S[e] + c + q < S[e + 1]) { SASG[S[e] + c + q] = -1; SW[S[e] + c + q] = 0.f; } }
    if (blockIdx.x == 0) {
        if (tid == 0) META[0] = S[64] / 256;
        if (tid < 64) { for (int t = S[tid] / 256; t < S[tid + 1] / 256; ++t) META[256 + t] = tid; }
    }
}

struct OrderXcd {
    int nM, nN, nwg;
    DI void init(int nM_, int nN_) { nM = nM_; nN = nN_; nwg = nM_ * nN_; }
    DI bool map(int i, int& pm, int& pn) const {
        const int L = i * (int)gridDim.x + (int)blockIdx.x; if (L >= nwg) return false;
        int wgid = L; { const int q = nwg / 8, r = nwg % 8, xcd = wgid % 8, off = wgid / 8; wgid = (xcd < r ? xcd * (q + 1) : r * (q + 1) + (xcd - r) * q) + off; }
        const int nig = 8 * nN, gid = wgid / nig, fm = gid * 8, gsz = (nM - fm) < 8 ? (nM - fm) : 8;
        pm = fm + ((wgid % nig) % gsz); pn = (wgid % nig) / gsz; return true;
    }
    DI bool lin(int i, int& w) const {
        const int L = i * (int)gridDim.x + (int)blockIdx.x; if (L >= nwg) return false;
        const int q = nwg / 8, r = nwg % 8, xcd = L % 8, off = L / 8; w = (xcd < r ? xcd * (q + 1) : r * (q + 1) + (xcd - r) * q) + off; return true;
    }
};
#define GACC const f32x4 (&acc)[2][2][4][2]
struct SchedInproj {
    static constexpr bool PERM = true;
    int lda, ldb, K, rowshift; const char* A; const char* W; bf16_t* proj; OrderXcd o;
    DI bool next(int i, pg::XUnit& u) const { int pm, pn; if (!o.map(i, pm, pn)) return false; u.A = A; u.B = W + (size_t)pn * 256 * ldb; u.arow0 = pm * 256; u.list = -1; u.e0 = pm * 256; u.e1 = pn * 256; return true; }
    DI void epi(GACC, const pg::XUnit& u, int wr, int wc, int fr, int fq) const { EpiB16P E; E.O = proj; E.row0 = u.e0; E.col0 = u.e1; E.ld = INWP; E(acc, wr, wc, fr, fq); }
};
DI void phase_inproj(PR p, int l, char* lds) {
    SchedInproj S; S.lda = D * 2; S.ldb = D * 2; S.K = D; S.rowshift = 0; S.A = (const char*)(p.ws + WS_HBUF); S.W = (const char*)(p.ws + WS_WEIGHTS + (size_t)l * WL_END + WL_WIN);
    S.proj = (bf16_t*)(p.ws + WS_U + U_PROJ); S.o.init(68, 15);
    pg::gemm_phase((LAS unsigned char*)lds, (const LAS int*)(lds + pg::STAGE_BYTES), S);
}
struct SchedMlaUp {
    static constexpr bool PERM = false;
    int lda, ldb, K, rowshift; const char* CQ; const char* CKV; const char* WQ; const char* WKV; bf16_t* Qm; bf16_t* Km; bf16_t* Vm; const float2* ropem; OrderXcd o;
    DI bool next(int i, pg::XUnit& u) const { int w; if (!o.lin(i, w)) return false; u.list = -1;
        if (w < 340) { const int pm = w / 5, pn = w % 5; u.A = CQ; u.B = WQ + (size_t)pn * 256 * ldb; u.arow0 = pm * 256; u.e0 = pm * 256; u.e1 = pn * 256; u.e3 = 0; }
        else { const int v = w - 340, pm = v / 6, pn = v % 6; u.A = CKV; u.B = WKV + (size_t)pn * 256 * ldb; u.arow0 = pm * 256; u.e0 = pm * 256; u.e1 = pn * 256; u.e3 = 1; }
        return true; }
    DI void epi(GACC, const pg::XUnit& u, int wr, int wc, int fr, int fq) const {
        if (u.e3 == 0) { EpiUq E; E.Q = Qm; E.ropem = ropem; E.row0 = u.e0; E.col0 = u.e1; E(acc, wr, wc, fr, fq); }
        else { EpiUkv E; E.Km = Km; E.Vm = Vm; E.row0 = u.e0; E.col0 = u.e1; E(acc, wr, wc, fr, fq); } }
};
DI void phase_mla_up(PR p, int l, char* lds) {
    unsigned char* U = p.ws + WS_U; const unsigned char* wl = p.ws + WS_WEIGHTS + (size_t)l * WL_END;
    SchedMlaUp S; S.lda = 1024; S.ldb = 1024; S.K = 512; S.rowshift = 0; S.CQ = (const char*)(U + U_CQN); S.CKV = (const char*)(U + U_CKVN); S.WQ = (const char*)(wl + WL_WUQ); S.WKV = (const char*)(wl + WL_WUKV);
    S.Qm = (bf16_t*)(U + U_QM); S.Km = (bf16_t*)(U + U_KM); S.Vm = (bf16_t*)(U + U_VM); S.ropem = (const float2*)(p.ws + WS_ROPEM); S.o.init(748, 1);
    pg::gemm_phase((LAS unsigned char*)lds, (const LAS int*)(lds + pg::STAGE_BYTES), S);
}
struct SchedOutproj {
    static constexpr bool PERM = true;
    int lda, ldb, K, rowshift; const char* A; const char* W; bf16_t* Y; OrderXcd o;
    DI bool next(int i, pg::XUnit& u) const { int pm, pn; if (!o.map(i, pm, pn)) return false; u.A = A; u.B = W + (size_t)pn * 256 * ldb; u.arow0 = pm * 256; u.list = -1; u.e0 = pm * 256; u.e1 = pn * 256; return true; }
    DI void epi(GACC, const pg::XUnit& u, int wr, int wc, int fr, int fq) const { EpiB16P E; E.O = Y; E.row0 = u.e0; E.col0 = u.e1; E.ld = D; E(acc, wr, wc, fr, fq); }
};
DI void phase_outproj(PR p, int l, char* lds) {
    SchedOutproj S; S.lda = D * 2; S.ldb = D * 2; S.K = D; S.rowshift = 0; S.A = (const char*)(p.ws + WS_U + U_MIX); S.W = (const char*)(p.ws + WS_WEIGHTS + (size_t)l * WL_END + WL_WOUT);
    S.Y = (bf16_t*)(p.ws + WS_U + U_Y); S.o.init(l == 0 ? 68 : 64, 8);
    pg::gemm_phase((LAS unsigned char*)lds, (const LAS int*)(lds + pg::STAGE_BYTES), S);
}
struct SchedMoe1 {
    static constexpr bool PERM = true;
    int lda, ldb, K, rowshift; const char* H; const char* W13; bf16_t* act; const LAS int* uexp; int ntiles; OrderXcd o;
    DI bool next(int i, pg::XUnit& u) const { int tile, pn; if (!o.map(i, tile, pn)) return false; u.A = H;
        if (tile < ntiles) { const int e = __builtin_amdgcn_readfirstlane(uexp[i]); u.B = W13 + ((size_t)e * 1024 + pn * 256) * ldb; u.list = i * 256; u.arow0 = 0; u.e0 = tile * 256; }
        else { const int ts = tile - ntiles; u.B = W13 + ((size_t)64 * 1024 + pn * 256) * ldb; u.list = -1; u.arow0 = ts * 256; u.e0 = PMAX + ts * 256; }
        u.e1 = pn * 128; return true; }
    DI void epi(GACC, const pg::XUnit& u, int wr, int wc, int fr, int fq) const { EpiMoe1P E; E.act = act; E.arow0 = u.e0; E.hcol0 = u.e1; E(acc, wr, wc, fr, fq); }
};
DI void phase_moe1(PR p, int l, char* lds) {
    const int* META = (const int*)(p.ws + WS_META) + l * 1024; const int ntiles = __builtin_amdgcn_readfirstlane(META[0]), nsh = l == 0 ? 68 : 64;
    SchedMoe1 S; S.lda = D * 2; S.ldb = D * 2; S.K = D; S.rowshift = 3; S.H = (const char*)(p.ws + WS_HBUF); S.W13 = (const char*)(p.ws + WS_WEIGHTS + (size_t)l * WL_END + WL_W13);
    S.act = (bf16_t*)(p.ws + WS_U + U_ACT); S.uexp = (const LAS int*)(lds + pg::STAGE_BYTES) + 31 * 256; S.ntiles = ntiles; S.o.init(ntiles + nsh, 4);
    { const int tid = tid_here(); LAS int* RL = (LAS int*)(lds + pg::STAGE_BYTES); const int* SASG = (const int*)(p.ws + WS_SASG);
      for (int i = 0; i < 31; ++i) { int tile, pn; if (!S.o.map(i, tile, pn)) break; if (tile < ntiles && tid < 256) RL[i * 256 + tid] = SASG[tile * 256 + tid];
          if (tid == 0) RL[31 * 256 + i] = tile < ntiles ? META[256 + tile] : 64; }
      __syncthreads(); }
    pg::gemm_phase((LAS unsigned char*)lds, (const LAS int*)(lds + pg::STAGE_BYTES), S);
}
struct SchedMoe2 {
    static constexpr bool PERM = true;
    int lda, ldb, K, rowshift; const char* ACT; const char* W2; bf16_t* oasg; const int* sasg; const float* sw; bf16_t* ysh; const LAS int* uexp; int ntiles; int fp8; OrderXcd o;
    DI bool next(int i, pg::XUnit& u) const { int tile, pn; if (!o.map(i, tile, pn)) return false; u.A = ACT; u.list = -1;
        if (tile < ntiles) { const int e = __builtin_amdgcn_readfirstlane(uexp[i]); u.B = W2 + ((size_t)e * D + pn * 256) * ldb; u.arow0 = tile * 256; u.e0 = tile * 256; u.e3 = 0; }
        else { const int ts = tile - ntiles; u.B = W2 + ((size_t)64 * D + pn * 256) * ldb; u.arow0 = PMAX + ts * 256; u.e0 = ts * 256; u.e3 = 1; }
        u.e1 = pn * 256; return true; }
    DI void epi(GACC, const pg::XUnit& u, int wr, int wc, int fr, int fq) const {
        if (u.e3 == 0 && fp8) { EpiMoe2F8 E; E.oasg = (unsigned char*)oasg; E.sasg = sasg; E.sw = sw; E.srow0 = u.e0; E.col0 = u.e1; E(acc, wr, wc, fr, fq); }
        else if (u.e3 == 0) { EpiMoe2P E; E.oasg = oasg; E.sasg = sasg; E.sw = sw; E.srow0 = u.e0; E.col0 = u.e1; E(acc, wr, wc, fr, fq); }
        else { EpiB16P E; E.O = ysh; E.row0 = u.e0; E.col0 = u.e1; E.ld = D; E(acc, wr, wc, fr, fq); } }
};
DI void phase_moe2(PR p, int l, char* lds) {
    const int* META = (const int*)(p.ws + WS_META) + l * 1024; const int ntiles = __builtin_amdgcn_readfirstlane(META[0]), nsh = l == 0 ? 68 : 64;
    SchedMoe2 S; S.lda = 1024; S.ldb = 1024; S.K = 512; S.rowshift = 0; S.ACT = (const char*)(p.ws + WS_U + U_ACT); S.W2 = (const char*)(p.ws + WS_WEIGHTS + (size_t)l * WL_END + WL_W2);
    S.oasg = (bf16_t*)(p.ws + WS_U + U_OASG); S.sasg = (const int*)(p.ws + WS_SASG); S.sw = (const float*)(p.ws + WS_SW); S.ysh = (bf16_t*)(p.ws + WS_U + U_YSH); S.uexp = (const LAS int*)(lds + pg::STAGE_BYTES); S.ntiles = ntiles; S.fp8 = (OASG_FP8_MASK >> l) & 1; S.o.init(ntiles + nsh, 8);
    { const int tid = tid_here(); LAS int* UE = (LAS int*)(lds + pg::STAGE_BYTES);
      if (tid < 64) { int tile, pn; if (S.o.map(tid, tile, pn)) UE[tid] = tile < ntiles ? META[256 + tile] : 64; }
      __syncthreads(); }
    pg::gemm_phase((LAS unsigned char*)lds, (const LAS int*)(lds + pg::STAGE_BYTES), S);
}
DI void phase_attention(PR p, int l, char* lds) {
#define ATT_PTRS unsigned char* U = p.ws + WS_U; asm volatile("" : "+s"(U)); \
    const bf16_t* Qm = (const bf16_t*)(U + U_QM); const bf16_t* Km = (const bf16_t*)(U + U_KM); const bf16_t* Vm = (const bf16_t*)(U + U_VM); \
    const bf16_t* Qg = (const bf16_t*)(U + U_QG); const bf16_t* Kg = (const bf16_t*)(U + U_KG); const bf16_t* Vg = (const bf16_t*)(U + U_VG); bf16_t* MIX = (bf16_t*)(U + U_MIX);
    const int xcd = blockIdx.x & 7, rank = blockIdx.x >> 3, nr = (gridDim.x + 7 - xcd) >> 3;
    const int nloc = 48 + (l == 0 ? 3 : 0);
    if (SUB & 1) for (int v = rank; v < nloc; v += nr) {
        ATT_PTRS; (void)Qg; (void)Kg; (void)Vg;
        int b, h, qt, isctx;
        if (v < 48) { const int bh = xcd * 3 + v / 16; b = bh / 6; h = bh % 6; qt = v & 15; isctx = 0; } else { const int bh = xcd * 3 + (v - 48); b = bh / 6; h = bh % 6; qt = 0; isctx = 1; }
        const int qpos = isctx ? 0 : CTXL + qt * 256, seq = isctx ? CTXL : SKV, orow = isctx ? NLAT + b * CTXL : b * SEQ + qt * 256;
        ATT_BODY<192>(Qm + (((size_t)b * 6 + h) * SKV + qpos) * 192, Km + ((size_t)b * 6 + h) * SKV * 192, Vm + ((size_t)b * 6 + h) * SKV * 128,
                                 MIX + (size_t)orow * D + 512 + h * 128, D, seq, lds, 0.07216878364870322f);
    }
    if (SUB & 2) for (int v = nr - 1 - rank; v < nloc; v += nr) {
        ATT_PTRS; (void)Qm; (void)Km; (void)Vm;
        int b, h, qt, isctx; const int kvh = xcd & 1; b = xcd >> 1;
        if (v < 48) { h = kvh * 3 + v / 16; qt = v & 15; isctx = 0; } else { h = kvh * 3 + (v - 48); qt = 0; isctx = 1; }
        const int qpos = isctx ? 0 : CTXL + qt * 256, seq = isctx ? CTXL : SKV, orow = isctx ? NLAT + b * CTXL : b * SEQ + qt * 256;
        ATT_BODY<128>(Qg + (((size_t)b * 6 + h) * SKV + qpos) * 128, Kg + ((size_t)b * 2 + kvh) * SKV * 128, Vg + ((size_t)b * 2 + kvh) * SKV * 128,
                                 MIX + (size_t)orow * D + 1280 + h * 128, D, seq, lds, 0.08838834764831845f);
    }
#undef ATT_PTRS
    if (SUB & 4) gla_phaseC(p, l, lds);
}

constexpr int NPH_LAYER = 12, NPH = 1 + 2 * NPH_LAYER;
constexpr int LDS_BYTES = 160 * 1024;
__global__ void __launch_bounds__(NTHREADS, 2) fwd(Params p_arg, int ph_lo, int ph_hi) {
    char* lds = shm + 256;
    volatile LAS unsigned* xbw = (volatile LAS unsigned*)shm;
    const bool fused = (ph_hi - ph_lo) > 1;
    XcdBarrier bar; bar.bar = (unsigned*)(p_arg.ws + WS_BAR); bar.x = 0; bar.st = xbw;
    if (fused) {
        if (threadIdx.x == 0) { xbw[0] = 0u; xbw[1] = 0u; xbw[2] = 0u; xbw[3] = 0u; }
        __syncthreads();
        bar = xcd_barrier_post((unsigned*)(p_arg.ws + WS_BAR), xbw);
    }
    const CAS Params* pk = (const CAS Params*)__builtin_amdgcn_kernarg_segment_ptr();
#define PHASE(idx, CALL) do { if (((PH_MASK >> ((idx) == 0 ? 0 : ((idx) - 1) % NPH_LAYER + 1)) & 1) && (idx) >= ph_lo && (idx) < ph_hi) { const CAS Params* q_ = pk; asm volatile("" : "+s"(q_)); PR p = *q_; int probe_pass = 0; (void)probe_pass; CALL; if ((PROBE_MASK >> ((idx) == 0 ? 0 : ((idx) - 1) % NPH_LAYER + 1)) & 1) { probe_pass = 1; CALL; } if (fused && (idx) + 1 < ph_hi) xcd_barrier(bar); } } while (0)
#define TAIL(ph) ((fused && !probe_pass) ? fill_tail(p, lds, (ph)) : (void)0)
    PHASE(0, phase_prologue(p, lds));
    for (int l = 0; l < 2; ++l) {
        const int b0 = 1 + l * NPH_LAYER;
        if (l == 0) PHASE(b0 + 0, phase_norm1(p, 0));
        PHASE(b0 + 1, phase_inproj(p, l, lds));
        PHASE(b0 + 2, (phase_postproj_rows(p, l), gla_phaseA(p, l, lds)));
        PHASE(b0 + 3, (phase_mla_up(p, l, lds), gla_scan(p)));
        PHASE(b0 + 4, (phase_attention(p, l, lds), TAIL(b0 + 4)));
        PHASE(b0 + 5, phase_outproj(p, l, lds));
        PHASE(b0 + 6, ((probe_pass && l == 1) ? (void)0 : phase_postmix(p, l)));
        PHASE(b0 + 7, phase_router(p, l, lds, probe_pass != 0));
        PHASE(b0 + 8, (phase_moe_index(p, l, lds), fill_drain(p, lds, (l + 1) * CHUNKS_PER_LAYER)));
        PHASE(b0 + 9, (move_head(p, (l + 1) * CHUNKS_PER_LAYER), phase_moe1(p, l, lds), TAIL(b0 + 9)));
        PHASE(b0 + 10, (phase_moe2(p, l, lds), TAIL(b0 + 10)));
        PHASE(b0 + 11, ((probe_pass && l == 0) ? (void)0 : phase_postffn(p, l)));
    }
#undef PHASE
#undef TAIL
}

extern "C" void kernel_launch(void* const* d_in, const int* in_sizes, int n_in, void* d_out, int out_size, void* d_ws, size_t ws_size, hipStream_t stream) {
    static int grid = 0;
    if (!grid) {
        if (ws_size < WS_TOTAL) { fprintf(stderr, "kernel_launch: workspace too small: %zu < %zu\n", ws_size, (size_t)WS_TOTAL); return; }
        if (hipFuncSetAttribute((const void*)fwd, hipFuncAttributeMaxDynamicSharedMemorySize, LDS_BYTES) != hipSuccess) { fprintf(stderr, "kernel_launch: hipFuncSetAttribute failed\n"); return; }
        int dev = 0, cus = 0, per_cu = 0;
        hipGetDevice(&dev);
        hipDeviceGetAttribute(&cus, hipDeviceAttributeMultiprocessorCount, dev);
        hipOccupancyMaxActiveBlocksPerMultiprocessor(&per_cu, fwd, NTHREADS, LDS_BYTES);
        if (per_cu < 1) { fprintf(stderr, "kernel_launch: occupancy query says %d\n", per_cu); return; }
        grid = cus;
    }
    Params p{};
    const float** f = (const float**)&p;
    for (int i = 0; i < 31; ++i) f[i] = (const float*)d_in[i];
    p.out = (float*)d_out; p.ws = (unsigned char*)d_ws;
    hipMemsetAsync((unsigned char*)d_ws + WS_BAR, 0, WS_CNT, stream);
#if MK_MULTI
    for (int ph = 0; ph < NPH; ++ph) { if (ph == 1 + NPH_LAYER) continue; hipLaunchKernelGGL(fwd, dim3(grid), dim3(NTHREADS), LDS_BYTES, stream, p, ph, ph + 1); }
#else
    hipLaunchKernelGGL(fwd, dim3(grid), dim3(NTHREADS), LDS_BYTES, stream, p, 0, NPH);
#endif
    const hipError_t le = hipPeekAtLastError();
    if (le != hipSuccess) fprintf(stderr, "kernel_launch: launch failed: %s\n", hipGetErrorName(le));
}
```

```cpp
#include <hip/hip_runtime.h>
#include <stdint.h>
#include <stdio.h>

#ifndef PH_MASK
#define PH_MASK 0x1FFF
#endif
#ifndef SUB
#define SUB 7
#endif
#ifndef ATT_SD_M
#define ATT_SD_M 1
#endif
#ifndef ATT_SD_G
#define ATT_SD_G 2
#endif
#ifndef ATT_NQR_M
#define ATT_NQR_M 12
#endif
#ifndef PROBE_MASK
#define PROBE_MASK 0x0
#endif
#ifndef ATT_DMA
#define ATT_DMA 1
#endif
#if ATT_DMA
#define ATT_BODY attn_body2
#else
#define ATT_BODY attn_body_old
#endif
#ifndef ROUTER_SPLIT
#define ROUTER_SPLIT 0
#endif
#ifndef MK_MULTI
#define MK_MULTI 0
#endif

typedef unsigned short bf16_t;
typedef short bf16x8 __attribute__((ext_vector_type(8)));
typedef short s16x4 __attribute__((ext_vector_type(4)));
typedef float f32x4 __attribute__((ext_vector_type(4)));
typedef float f32x16 __attribute__((ext_vector_type(16)));
typedef unsigned u32x4 __attribute__((ext_vector_type(4)));
typedef unsigned u32x2 __attribute__((ext_vector_type(2)));
#define DI __device__ __forceinline__

constexpr int D = 2048, NB = 4, SEQ = 4096, CTXL = 256, NLAT = NB * SEQ, NCTX = NB * CTXL, NTOK = NLAT + NCTX, SKV = SEQ + CTXL;
constexpr int INW = 3808, INWP = 3840;
constexpr int C_GQ = 0, C_GK = 256, C_GV = 512, C_GG = 1024, C_ZF = 1536, C_ZB = 1552, C_CQ = 1568, C_CKV = 1952, C_KR = 2464, C_AQ = 2528, C_AK = 3296, C_AV = 3552;
constexpr int NE = 64, TOPK = 8, DEXP = 512;
constexpr int PMAX = NTOK * TOPK + NE * 256;
constexpr int NTHREADS = 512;
constexpr float EPS = 1e-6f;

constexpr size_t MiB = 1024ull * 1024ull;
constexpr size_t al256(size_t x) { return (x + 255) / 256 * 256; }
constexpr size_t WS_BAR = 0;
constexpr size_t WS_CTL = 16384;
constexpr size_t WS_CNT = 16384 + 8192;
constexpr size_t WS_META = WS_CNT + 1024;
constexpr size_t WS_MOD = WS_META + 2 * 4096;
constexpr size_t WS_ROPEG = al256(WS_MOD + 2 * 5 * 12288 * 4);
constexpr size_t WS_ROPEM = WS_ROPEG + 64 * 32 * 8;
constexpr size_t WS_ZROW = WS_ROPEM + 64 * 16 * 8;
constexpr size_t WS_GDEC = WS_ZROW + 4096;
constexpr size_t WS_EIDX = al256(WS_GDEC + 2 * 16 * 68 * 64 * 4);
constexpr size_t WS_EW = WS_EIDX + (size_t)NTOK * 8 * 4;
constexpr size_t WS_EPOS = WS_EW + (size_t)NTOK * 8 * 4;
constexpr size_t WS_SASG = WS_EPOS + (size_t)NTOK * 8 * 4;
constexpr size_t WS_SW = al256(WS_SASG + (size_t)PMAX * 4);
constexpr size_t WS_SMALL_END = al256(WS_SW + (size_t)PMAX * 4);
static_assert(WS_SMALL_END <= 8 * MiB, "small region");
constexpr size_t SZ_WIN = (size_t)INWP * D * 2, SZ_WUQ = (size_t)1280 * 512 * 2, SZ_WUKV = (size_t)1536 * 512 * 2, SZ_WOUT = (size_t)D * D * 2, SZ_WR = (size_t)64 * D * 2;
constexpr size_t SZ_W13 = (size_t)65 * 1024 * D * 2, SZ_W2 = (size_t)65 * D * 512 * 2;
constexpr size_t WL_WIN = 0, WL_WUQ = WL_WIN + SZ_WIN, WL_WUKV = WL_WUQ + SZ_WUQ, WL_WOUT = WL_WUKV + SZ_WUKV, WL_WRH = WL_WOUT + SZ_WOUT, WL_WRL = WL_WRH + SZ_WR,
                 WL_W13 = WL_WRL + SZ_WR, WL_W2 = WL_W13 + SZ_W13, WL_END = WL_W2 + SZ_W2;
constexpr size_t WS_WEIGHTS = 8 * MiB;
constexpr size_t WS_XRES = WS_WEIGHTS + 2 * WL_END;
constexpr size_t WS_HBUF = WS_XRES + (size_t)NTOK * D * 4;
constexpr size_t WS_U = WS_HBUF + (size_t)NTOK * D * 2;
constexpr size_t U_Y = 0;
constexpr size_t U_YSH = (size_t)NTOK * D * 2;
constexpr size_t U_PROJ = U_Y + (size_t)NTOK * D * 4;
constexpr size_t U_QM = U_PROJ + (size_t)NTOK * INWP * 2;
constexpr size_t U_KM = U_QM + (size_t)NB * 6 * SKV * 192 * 2;
constexpr size_t U_VM = U_KM + (size_t)NB * 6 * SKV * 192 * 2;
constexpr size_t U_QG = U_VM + (size_t)NB * 6 * SKV * 128 * 2;
constexpr size_t U_KG = U_QG + (size_t)NB * 6 * SKV * 128 * 2;
constexpr size_t U_VG = U_KG + (size_t)NB * 2 * SKV * 128 * 2;
constexpr size_t U_GS = U_VG + (size_t)NB * 2 * SKV * 128 * 2;
constexpr size_t U_MIX = U_GS + (size_t)2 * 16 * 68 * 64 * 128 * 4;
constexpr size_t U_CQN = U_MIX + (size_t)NTOK * D * 2;
constexpr size_t U_CKVN = U_CQN + (size_t)NTOK * 512 * 2;
constexpr size_t U_GST = U_CKVN + (size_t)NTOK * 512 * 2;
constexpr size_t U_MIX_END = U_GST + (size_t)2 * 16 * 68 * 8192 * 2;
constexpr size_t U_HLO = U_PROJ;
constexpr size_t U_ACT = U_HLO + (size_t)NTOK * D * 2;
constexpr size_t U_OASG = U_ACT + (size_t)(PMAX + NTOK) * 512 * 2;
constexpr size_t U_MOE_END = U_OASG + (size_t)NTOK * 8 * D * 2;
constexpr size_t WS_TOTAL = WS_U + (U_MIX_END > U_MOE_END ? U_MIX_END : U_MOE_END);
static_assert(WS_TOTAL <= 2048ull * MiB, "workspace over 2 GiB");

struct Params {
    const float *x, *c, *ctx, *c_ctx, *w_mod, *b_mod, *g_pre_mix, *g_post_mix, *g_pre_ffn, *g_post_ffn, *w_in, *gla_wg2_f, *gla_bg_f, *gla_wg2_b, *gla_bg_b, *gla_g_out,
        *mla_g_q, *mla_w_uq, *mla_g_kv, *mla_w_ukv, *gqa_g_q, *gqa_g_k, *w_out, *router_w, *router_b, *exp_w1, *exp_w3, *exp_w2, *sh_w1, *sh_w3, *sh_w2;
    float* out; unsigned char* ws;
};

extern __shared__ __attribute__((aligned(16))) char shm[];
#define CAS __attribute__((address_space(4)))
typedef const CAS Params& PR;
DI int bid_here() { int b = blockIdx.x; asm volatile("" : "+s"(b)); return b; }
DI int tid_here() { int t = threadIdx.x; asm volatile("" : "+v"(t)); return t; }
DI float bf2f(bf16_t v) { return __uint_as_float(((unsigned)v) << 16); }
DI bf16_t f2bf(float f) { unsigned u = __float_as_uint(f); u += 0x7FFFu + ((u >> 16) & 1u); return (bf16_t)(u >> 16); }
DI unsigned pk2(float lo, float hi) { unsigned r; asm("v_cvt_pk_bf16_f32 %0, %1, %2" : "=v"(r) : "v"(lo), "v"(hi)); return r; }
DI float shx(float v, int o, int lane) { return __int_as_float(__builtin_amdgcn_ds_bpermute((lane ^ o) << 2, __float_as_int(v))); }
DI float wave_sum(float v) {
    const int lane = tid_here() & 63;
#pragma unroll
    for (int o = 32; o > 0; o >>= 1) v += shx(v, o, lane);
    return v;
}
DI float silu_f(float v) { return v / (1.f + __expf(-v)); }
DI float sigmoid_f(float v) { return 1.f / (1.f + __expf(-v)); }
struct Tok { int b, s, isctx, mrow, kvpos; };
DI Tok tok_of(int r) { Tok t; if (r < NLAT) { t.b = r >> 12; t.s = r & 4095; t.isctx = 0; t.mrow = t.b; t.kvpos = CTXL + t.s; } else { const int q = r - NLAT; t.b = q >> 8; t.s = q & 255; t.isctx = 1; t.mrow = 4; t.kvpos = t.s; } return t; }
DI const float* xrow_in(PR p, int l, int r) { if (l == 0) return r < NLAT ? p.x + (size_t)r * D : p.ctx + (size_t)(r - NLAT) * D; return (const float*)(p.ws + WS_XRES) + (size_t)r * D; }

#define XB_TMO      128
#define XB_XCNT(j)  (256  + 64 * (j))
#define XB_XSUB(j)  (1280 + 64 * (j))
#define XB_XGEN(j)  (2304 + 64 * (j))
#define XB_TOP      3328
#define XB_TOPGEN   3392
#define XCD_BAR_WORDS 3456
#define XB_SPIN_CAP (1u << 18)
#define LAS __attribute__((address_space(3)))
__device__ __forceinline__ unsigned xb_ld(unsigned* p)              { return __hip_atomic_load(p, __ATOMIC_RELAXED, __HIP_MEMORY_SCOPE_AGENT); }
__device__ __forceinline__ unsigned xb_add(unsigned* p, unsigned v) { return __hip_atomic_fetch_add(p, v, __ATOMIC_RELAXED, __HIP_MEMORY_SCOPE_AGENT); }
__device__ __forceinline__ unsigned xb_xcc_id() { return (unsigned)__builtin_amdgcn_s_getreg((3 << 11) | 20) & 0xFu; }
#define XB_SPIN(cond, bar) do { unsigned _sp = 0; while (cond) { __builtin_amdgcn_s_sleep(1); \
    if ((++_sp & 255u) == 0u) { if (xb_ld(&(bar)[XB_TMO])) break; if (_sp > XB_SPIN_CAP) { atomicAdd(&(bar)[XB_TMO], 1u); break; } } } } while (0)
struct XcdBarrier { unsigned* bar; unsigned x; volatile LAS unsigned* st; };
__device__ __forceinline__ XcdBarrier xcd_barrier_post(unsigned* bar, volatile LAS unsigned* st) {
    XcdBarrier b; b.bar = bar; b.x = xb_xcc_id(); b.st = st;
    if (threadIdx.x == 0) (void)xb_add(&bar[XB_XCNT(b.x)], 1u);
    return b;
}
__device__ __forceinline__ void xcd_barrier_complete(unsigned* bar, unsigned x, unsigned& nloc, unsigned& nx) {
    const unsigned G = gridDim.x * gridDim.y * gridDim.z;
    unsigned sum, cnt, mine, sp = 0u;
    for (;;) {
        sum = 0u; cnt = 0u; mine = 0u;
#pragma unroll
        for (unsigned j = 0; j < 16; ++j) { const unsigned c = xb_ld(&bar[XB_XCNT(j)]); sum += c; cnt += (c > 0u) ? 1u : 0u; mine = (j == x) ? c : mine; }
        if (sum == G) break;
        __builtin_amdgcn_s_sleep(1);
        if ((++sp & 255u) == 0u) { if (xb_ld(&bar[XB_TMO])) break; if (sp > XB_SPIN_CAP) { atomicAdd(&bar[XB_TMO], 1u); break; } }
    }
    nloc = mine > 0u ? mine : 1u; nx = cnt > 0u ? cnt : 1u;
}
__device__ __forceinline__ void xcd_barrier(const XcdBarrier& b) {
    asm volatile("s_waitcnt vmcnt(0)" ::: "memory");
    __syncthreads();
    if (threadIdx.x == 0) {
        unsigned* bar = b.bar;
        __builtin_amdgcn_s_waitcnt(0);
        unsigned nloc = b.st[0], nx = b.st[1];
        if (nloc == 0u) { xcd_barrier_complete(bar, b.x, nloc, nx); b.st[0] = nloc; b.st[1] = nx; }
        const unsigned old = xb_add(&bar[XB_XSUB(b.x)], 1u);
        const unsigned gen = old / nloc;
        if (old + 1u == (gen + 1u) * nloc) {
            __builtin_amdgcn_fence(__ATOMIC_RELEASE, "agent");
            asm volatile("s_waitcnt vmcnt(0)" ::: "memory");
            const unsigned og = xb_add(&bar[XB_TOP], 1u);
            const unsigned tg = og / nx;
            if (og + 1u == (tg + 1u) * nx) xb_add(&bar[XB_TOPGEN], 1u);
            else XB_SPIN(xb_ld(&bar[XB_TOPGEN]) == tg, bar);
            __builtin_amdgcn_fence(__ATOMIC_ACQUIRE, "agent");
            xb_add(&bar[XB_XGEN(b.x)], 1u);
            asm volatile("s_waitcnt vmcnt(0)" ::: "memory");
        } else {
            XB_SPIN(xb_ld(&bar[XB_XGEN(b.x)]) == gen, bar);
            __builtin_amdgcn_fence(__ATOMIC_ACQUIRE, "agent");
            asm volatile("s_waitcnt vmcnt(0)" ::: "memory");
        }
    }
    __syncthreads();
}

template <int KT>
DI void cvt_tile(char* lds, const float* src, int ldS, int Nvalid, bf16_t* dst, bf16_t* dst_lo, int ldD, int k0, int n0, int drow0, const float* gk) {
    float* T = (float*)lds;
    const int tid = tid_here();
    {
        const int c4 = tid & 15, kr = tid >> 4, n = n0 + c4 * 4;
        f32x4 v[KT / 32];
#pragma unroll
        for (int i = 0; i < KT / 32; ++i) { v[i] = (f32x4){0.f, 0.f, 0.f, 0.f}; if (n < Nvalid) v[i] = *(const f32x4*)(src + (size_t)(k0 + kr + 32 * i) * ldS + n); }
#pragma unroll
        for (int i = 0; i < KT / 32; ++i) { const int k = kr + 32 * i; if (gk) v[i] = v[i] * gk[k0 + k];
            T[k * 65 + c4 * 4 + 0] = v[i][0]; T[k * 65 + c4 * 4 + 1] = v[i][1]; T[k * 65 + c4 * 4 + 2] = v[i][2]; T[k * 65 + c4 * 4 + 3] = v[i][3]; }
    }
    __syncthreads();
    {
        constexpr int KPL = KT / 8;
        const int nl = tid >> 3, kc = (tid & 7) * KPL;
#pragma unroll
        for (int q = 0; q < KPL / 8; ++q) {
            float v[8];
#pragma unroll
            for (int j = 0; j < 8; ++j) v[j] = T[(kc + q * 8 + j) * 65 + nl];
            u32x4 w; w.x = pk2(v[0], v[1]); w.y = pk2(v[2], v[3]); w.z = pk2(v[4], v[5]); w.w = pk2(v[6], v[7]);
            *(u32x4*)(dst + (size_t)(drow0 + nl) * ldD + k0 + kc + q * 8) = w;
            if (dst_lo) {
                float r[8];
#pragma unroll
                for (int j = 0; j < 8; ++j) r[j] = v[j] - bf2f(f2bf(v[j]));
                u32x4 w2; w2.x = pk2(r[0], r[1]); w2.y = pk2(r[2], r[3]); w2.z = pk2(r[4], r[5]); w2.w = pk2(r[6], r[7]);
                *(u32x4*)(dst_lo + (size_t)(drow0 + nl) * ldD + k0 + kc + q * 8) = w2;
            }
        }
    }
    __syncthreads();
}
template <int KT>
DI void cvt_matrix(char* lds, const float* src, int K, int N, int Npad, bf16_t* dst, bf16_t* dst_lo, int mode, const float* gk, int ldD = 0) {
    if (ldD == 0) ldD = K;
    const int nkt = K / KT, nnt = Npad / 64, nt = nkt * nnt;
    for (int t = bid_here(); t < nt; t += gridDim.x) {
        const int kt = t % nkt, ntile = t / nkt, n0 = ntile * 64;
        int drow0 = n0;
        if (mode == 1) drow0 = (n0 >> 7) * 256 + (n0 & 127);
        else if (mode == 2) drow0 = (n0 >> 7) * 256 + 128 + (n0 & 127);
        cvt_tile<KT>(lds, src, N, N, dst, dst_lo, ldD, kt * KT, n0, drow0, gk);
    }
}
constexpr int CHUNKS_PER_LAYER = 65 * 192, CHUNKS_TOTAL = 2 * CHUNKS_PER_LAYER;
DI void cvt_chunk(PR p, char* lds, int g) {
    const int l = g / CHUNKS_PER_LAYER, gg = g % CHUNKS_PER_LAYER;
    unsigned char* wl = p.ws + WS_WEIGHTS + (size_t)l * WL_END;
    const int e = gg / 192, r = gg % 192, m = r >> 6, t = r & 63;
    bf16_t* d13 = (bf16_t*)(wl + WL_W13) + (size_t)e * 1024 * D; bf16_t* d2 = (bf16_t*)(wl + WL_W2) + (size_t)e * D * 512;
    if (m < 2) {
        const float* src = m == 0 ? (e < 64 ? p.exp_w1 + ((size_t)l * 64 + e) * D * 512 : p.sh_w1 + (size_t)l * D * 512) : (e < 64 ? p.exp_w3 + ((size_t)l * 64 + e) * D * 512 : p.sh_w3 + (size_t)l * D * 512);
        const int kt = t & 7, n0 = (t >> 3) * 64, drow0 = (n0 >> 7) * 256 + m * 128 + (n0 & 127);
        cvt_tile<256>(lds, src, 512, 512, d13, nullptr, D, kt * 256, n0, drow0, nullptr);
    } else {
        const float* src = e < 64 ? p.exp_w2 + ((size_t)l * 64 + e) * 512 * D : p.sh_w2 + (size_t)l * 512 * D;
        const int kt = t & 1, n0 = (t >> 1) * 64;
        cvt_tile<256>(lds, src, D, D, d2, nullptr, 512, kt * 256, n0, n0, nullptr);
    }
}
#define CTL_LD(ptr) __hip_atomic_load((ptr), __ATOMIC_RELAXED, __HIP_MEMORY_SCOPE_AGENT)
#define CTL_ADD(ptr, v) __hip_atomic_fetch_add((ptr), (v), __ATOMIC_RELAXED, __HIP_MEMORY_SCOPE_AGENT)
DI void fill_tail(PR p, char* lds, int ph) {
    unsigned* ctl = (unsigned*)(p.ws + WS_CTL);
    volatile LAS int* flag = (volatile LAS int*)(shm + 16);
    const int tid = tid_here();
    __syncthreads();
    if (tid == 0) CTL_ADD(&ctl[64 * (1 + ph)], 1u);
    for (;;) {
        if (tid == 0) {
            int c = -1;
            if (CTL_LD(&ctl[64 * (1 + ph)]) + 8u < gridDim.x && CTL_LD(&ctl[0]) < (unsigned)CHUNKS_TOTAL) { c = (int)CTL_ADD(&ctl[0], 4u); if (c >= CHUNKS_TOTAL) c = -1; }
            *flag = c;
        }
        __syncthreads();
        const int c = __builtin_amdgcn_readfirstlane(*flag);
        __syncthreads();
        if (c < 0) break;
        for (int q = 0; q < 4; ++q) {
            if (c + q < CHUNKS_TOTAL) cvt_chunk(p, lds, c + q);
            if (q < 3 && __builtin_amdgcn_readfirstlane((int)CTL_LD(&ctl[64 * (1 + ph)])) >= (int)gridDim.x) { for (int q2 = q + 1; q2 < 4; ++q2) if (c + q2 < CHUNKS_TOTAL) cvt_chunk(p, lds, c + q2); break; }
        }
    }
}
DI void fill_drain(PR p, char* lds, int limit) {
    unsigned* ctl = (unsigned*)(p.ws + WS_CTL);
    const int h0 = __builtin_amdgcn_readfirstlane((int)CTL_LD(&ctl[0]));
    for (int c = h0 + bid_here(); c < limit; c += gridDim.x) cvt_chunk(p, lds, c);
}
DI void move_head(PR p, int limit) { if (blockIdx.x == 0 && tid_here() == 0) __hip_atomic_fetch_max((unsigned*)(p.ws + WS_CTL), (unsigned)limit, __ATOMIC_RELAXED, __HIP_MEMORY_SCOPE_AGENT); }
DI void phase_prologue(PR p, char* lds) {
    const int tid = tid_here();
    unsigned char* ws = p.ws;
    if (blockIdx.x == 0) {
        unsigned* cnt = (unsigned*)(ws + WS_CNT);
        if (tid < 128) cnt[tid] = 0u;
        unsigned* z = (unsigned*)(ws + WS_ZROW);
        for (int i = tid; i < 1024; i += NTHREADS) z[i] = 0u;
        float2* rg = (float2*)(ws + WS_ROPEG);
        for (int i = tid; i < 64 * 32; i += NTHREADS) { const int pos = i >> 5, f = i & 31; const float inv = powf(10000.f, -(float)(2 * f) / 64.f); float s, c; sincosf((float)pos * inv, &s, &c); rg[i] = make_float2(c, s); }
        float2* rm = (float2*)(ws + WS_ROPEM);
        for (int i = tid; i < 64 * 16; i += NTHREADS) { const int pos = i >> 4, f = i & 15; const float inv = powf(10000.f, -(float)(2 * f) / 32.f); float s, c; sincosf((float)pos * inv, &s, &c); rm[i] = make_float2(c, s); }
    }
    {
        float* sc = (float*)lds;
        float* red = sc + 5 * 2048;
        bool loaded = false;
        for (int u = bid_here(); u < 192; u += gridDim.x) {
            if (!loaded) { for (int i = tid; i < 5 * 2048; i += NTHREADS) { const int r = i >> 11, k = i & 2047; const float v = r < 4 ? p.c[r * 2048 + k] : p.c_ctx[k]; sc[i] = silu_f(v); } loaded = true; __syncthreads(); }
            const int l = u / 96, col0 = (u % 96) * 128;
            const int cg = tid & 31, kp = tid >> 5;
            f32x4 acc[5];
#pragma unroll
            for (int r = 0; r < 5; ++r) acc[r] = (f32x4){0.f, 0.f, 0.f, 0.f};
            const float* wb = p.w_mod + ((size_t)l * 2048) * 12288 + col0 + cg * 4;
            for (int kk = 0; kk < 128; ++kk) {
                const int k = kp * 128 + kk;
                const f32x4 w = *(const f32x4*)(wb + (size_t)k * 12288);
#pragma unroll
                for (int r = 0; r < 5; ++r) acc[r] += w * sc[r * 2048 + k];
            }
#pragma unroll
            for (int r = 0; r < 5; ++r)
#pragma unroll
                for (int j = 0; j < 4; ++j) red[(kp * 5 + r) * 128 + cg * 4 + j] = acc[r][j];
            __syncthreads();
            for (int i = tid; i < 640; i += NTHREADS) {
                const int r = i >> 7, cc = i & 127; float s = p.b_mod[l * 12288 + col0 + cc];
#pragma unroll
                for (int q = 0; q < 16; ++q) s += red[(q * 5 + r) * 128 + cc];
                ((float*)(ws + WS_MOD))[((size_t)l * 5 + r) * 12288 + col0 + cc] = s;
            }
            __syncthreads();
        }
        __syncthreads();
    }
    for (int l = 0; l < 2; ++l) {
        unsigned char* wl = ws + WS_WEIGHTS + (size_t)l * WL_END;
        cvt_matrix<256>(lds, p.w_in + (size_t)l * D * INW, D, INW, INWP, (bf16_t*)(wl + WL_WIN), nullptr, 0, nullptr);
        cvt_matrix<128>(lds, p.mla_w_uq + (size_t)l * 384 * 1152, 384, 1152, 1280, (bf16_t*)(wl + WL_WUQ), nullptr, 0, p.mla_g_q + l * 384, 512);
        for (int i = bid_here() * NTHREADS + tid; i < 1280 * 64; i += gridDim.x * NTHREADS) ((unsigned*)(wl + WL_WUQ))[(size_t)(i >> 6) * 256 + 192 + (i & 63)] = 0u;
        cvt_matrix<256>(lds, p.mla_w_ukv + (size_t)l * 512 * 1536, 512, 1536, 1536, (bf16_t*)(wl + WL_WUKV), nullptr, 0, p.mla_g_kv + l * 512);
        cvt_matrix<256>(lds, p.w_out + (size_t)l * D * D, D, D, D, (bf16_t*)(wl + WL_WOUT), nullptr, 0, nullptr);
        cvt_matrix<256>(lds, p.router_w + (size_t)l * D * 64, D, 64, 64, (bf16_t*)(wl + WL_WRH), (bf16_t*)(wl + WL_WRL), 0, nullptr);
    }
}

#ifndef OASG_FP8_MASK
#define OASG_FP8_MASK 3
#endif
constexpr float OASG_SCALE = 16.f;
DI void load_row(const float* src, f32x4 (&v)[4][2], int c0) {
#pragma unroll
    for (int i = 0; i < 4; ++i) { v[i][0] = *(const f32x4*)(src + i * 512 + c0); v[i][1] = *(const f32x4*)(src + i * 512 + c0 + 4); }
}
DI void unpack8(const u32x4 w, f32x4& a, f32x4& b) {
    a[0] = __uint_as_float(w.x << 16); a[1] = __uint_as_float(w.x & 0xFFFF0000u); a[2] = __uint_as_float(w.y << 16); a[3] = __uint_as_float(w.y & 0xFFFF0000u);
    b[0] = __uint_as_float(w.z << 16); b[1] = __uint_as_float(w.z & 0xFFFF0000u); b[2] = __uint_as_float(w.w << 16); b[3] = __uint_as_float(w.w & 0xFFFF0000u);
}
DI void load_row_bf(const bf16_t* src, f32x4 (&v)[4][2], int c0) {
#pragma unroll
    for (int i = 0; i < 4; ++i) unpack8(*(const u32x4*)(src + i * 512 + c0), v[i][0], v[i][1]);
}
DI void store_row_bf(bf16_t* dst, const f32x4 (&v)[4][2], int c0) {
#pragma unroll
    for (int i = 0; i < 4; ++i) { u32x4 w; w.x = pk2(v[i][0][0], v[i][0][1]); w.y = pk2(v[i][0][2], v[i][0][3]); w.z = pk2(v[i][1][0], v[i][1][1]); w.w = pk2(v[i][1][2], v[i][1][3]); *(u32x4*)(dst + i * 512 + c0) = w; }
}
DI float row_sumsq(const f32x4 (&v)[4][2]) {
    float s = 0.f;
#pragma unroll
    for (int i = 0; i < 4; ++i)
#pragma unroll
        for (int h = 0; h < 2; ++h) s += v[i][h][0] * v[i][h][0] + v[i][h][1] * v[i][h][1] + v[i][h][2] * v[i][h][2] + v[i][h][3] * v[i][h][3];
    return wave_sum(s);
}
DI void adaln_store(const f32x4 (&x)[4][2], const float* g, const float* shift, const float* scale, bf16_t* hi, bf16_t* lo, int c0) {
    const float rstd = rsqrtf(row_sumsq(x) * (1.f / D) + EPS);
#pragma unroll
    for (int i = 0; i < 4; ++i) {
        f32x4 h[2];
#pragma unroll
        for (int q = 0; q < 2; ++q) { const int c = i * 512 + c0 + 4 * q;
            const f32x4 gg = *(const f32x4*)(g + c), sh = *(const f32x4*)(shift + c), sc = *(const f32x4*)(scale + c);
#pragma unroll
            for (int j = 0; j < 4; ++j) h[q][j] = x[i][q][j] * rstd * gg[j] * (1.f + sc[j]) + sh[j]; }
        u32x4 w; w.x = pk2(h[0][0], h[0][1]); w.y = pk2(h[0][2], h[0][3]); w.z = pk2(h[1][0], h[1][1]); w.w = pk2(h[1][2], h[1][3]);
        *(u32x4*)(hi + i * 512 + c0) = w;
        if (lo) { f32x4 a, b; unpack8(w, a, b); u32x4 w2; w2.x = pk2(h[0][0] - a[0], h[0][1] - a[1]); w2.y = pk2(h[0][2] - a[2], h[0][3] - a[3]); w2.z = pk2(h[1][0] - b[0], h[1][1] - b[1]); w2.w = pk2(h[1][2] - b[2], h[1][3] - b[3]);
            *(u32x4*)(lo + i * 512 + c0) = w2; }
    }
}
DI void residual_add(f32x4 (&x)[4][2], const f32x4 (&y)[4][2], const float* g, const float* gate, int c0) {
    const float rstd = rsqrtf(row_sumsq(y) * (1.f / D) + EPS);
#pragma unroll
    for (int i = 0; i < 4; ++i)
#pragma unroll
        for (int q = 0; q < 2; ++q) { const int c = i * 512 + c0 + 4 * q; const f32x4 gg = *(const f32x4*)(g + c), gt = *(const f32x4*)(gate + c);
#pragma unroll
            for (int j = 0; j < 4; ++j) x[i][q][j] += gt[j] * (y[i][q][j] * rstd * gg[j]); }
}
DI void load_xrow(PR p, int l, int r, f32x4 (&x)[4][2], int c0) {
    if (l == 0) load_row(r < NLAT ? p.x + (size_t)r * D : p.ctx + (size_t)(r - NLAT) * D, x, c0);
    else load_row_bf((const bf16_t*)(p.ws + WS_XRES) + (size_t)r * D, x, c0);
}
DI void phase_norm1(PR p, int l) {
    const int tid_ = tid_here(), lane = tid_ & 63, wid = tid_ >> 6;
    const float* mod = (const float*)(p.ws + WS_MOD) + (size_t)l * 5 * 12288;
    bf16_t* hb = (bf16_t*)(p.ws + WS_HBUF);
    for (int r = bid_here() * 8 + wid; r < NTOK; r += gridDim.x * 8) {
        const Tok t = tok_of(r);
        int c0 = lane * 8; asm volatile("" : "+v"(c0));
        f32x4 x[4][2]; load_xrow(p, l, r, x, c0);
        adaln_store(x, p.g_pre_mix + l * D, mod + (size_t)t.mrow * 12288 + 0 * D, mod + (size_t)t.mrow * 12288 + 1 * D, hb + (size_t)r * D, nullptr, c0);
    }
}
DI void phase_postmix(PR p, int l) {
    const int tid_ = tid_here(), lane = tid_ & 63, wid = tid_ >> 6;
    const float* mod = (const float*)(p.ws + WS_MOD) + (size_t)l * 5 * 12288;
    const bf16_t* Y = (const bf16_t*)(p.ws + WS_U + U_Y);
    bf16_t* XR = (bf16_t*)(p.ws + WS_XRES);
    bf16_t* hb = (bf16_t*)(p.ws + WS_HBUF); bf16_t* hl = (bf16_t*)(p.ws + WS_U + U_HLO);
    const int nrows = l == 0 ? NTOK : NLAT;
    for (int r = bid_here() * 8 + wid; r < nrows; r += gridDim.x * 8) {
        const Tok t = tok_of(r);
        int c0 = lane * 8; asm volatile("" : "+v"(c0));
        f32x4 x[4][2], y[4][2]; load_xrow(p, l, r, x, c0); load_row_bf(Y + (size_t)r * D, y, c0);
        residual_add(x, y, p.g_post_mix + l * D, mod + (size_t)t.mrow * 12288 + 2 * D, c0);
        store_row_bf(XR + (size_t)r * D, x, c0);
        adaln_store(x, p.g_pre_ffn + l * D, mod + (size_t)t.mrow * 12288 + 3 * D, mod + (size_t)t.mrow * 12288 + 4 * D, hb + (size_t)r * D, ROUTER_SPLIT ? hl + (size_t)r * D : nullptr, c0);
    }
}
DI void phase_postffn(PR p, int l) {
    const int tid_ = tid_here(), lane = tid_ & 63, wid = tid_ >> 6;
    const float* mod = (const float*)(p.ws + WS_MOD) + (size_t)l * 5 * 12288;
    const bf16_t* YS = (const bf16_t*)(p.ws + WS_U + U_YSH);
    const unsigned char* OA = p.ws + WS_U + U_OASG;
    bf16_t* XR = (bf16_t*)(p.ws + WS_XRES);
    bf16_t* hb = (bf16_t*)(p.ws + WS_HBUF);
    const int nrows = l == 0 ? NTOK : NLAT;
    const bool fp8 = (OASG_FP8_MASK >> l) & 1;
    for (int r = bid_here() * 8 + wid; r < nrows; r += gridDim.x * 8) {
        const Tok t = tok_of(r);
        int c0 = lane * 8; asm volatile("" : "+v"(c0));
        f32x4 x[4][2], y[4][2]; load_row_bf(XR + (size_t)r * D, x, c0); load_row_bf(YS + (size_t)r * D, y, c0);
        if (fp8) {
            f32x4 a[4][2];
#pragma unroll
            for (int i = 0; i < 4; ++i) { a[i][0] = (f32x4){0.f, 0.f, 0.f, 0.f}; a[i][1] = (f32x4){0.f, 0.f, 0.f, 0.f}; }
#pragma unroll 2
            for (int k = 0; k < 8; ++k) {
                const unsigned char* o = OA + ((size_t)r * 8 + k) * D;
#pragma unroll
                for (int i = 0; i < 4; ++i) { const u32x2 w = *(const u32x2*)(o + i * 512 + c0);
                    const auto f0 = __builtin_amdgcn_cvt_pk_f32_fp8(w.x, false), f1 = __builtin_amdgcn_cvt_pk_f32_fp8(w.x, true), f2 = __builtin_amdgcn_cvt_pk_f32_fp8(w.y, false), f3 = __builtin_amdgcn_cvt_pk_f32_fp8(w.y, true);
                    a[i][0][0] += f0[0]; a[i][0][1] += f0[1]; a[i][0][2] += f1[0]; a[i][0][3] += f1[1]; a[i][1][0] += f2[0]; a[i][1][1] += f2[1]; a[i][1][2] += f3[0]; a[i][1][3] += f3[1]; }
            }
#pragma unroll
            for (int i = 0; i < 4; ++i) { y[i][0] += a[i][0] * (1.f / OASG_SCALE); y[i][1] += a[i][1] * (1.f / OASG_SCALE); }
        } else {
#pragma unroll 2
            for (int k = 0; k < 8; ++k) {
                const bf16_t* o = (const bf16_t*)OA + ((size_t)r * 8 + k) * D;
#pragma unroll
                for (int i = 0; i < 4; ++i) { f32x4 a, b; unpack8(*(const u32x4*)(o + i * 512 + c0), a, b); y[i][0] += a; y[i][1] += b; }
            }
        }
        residual_add(x, y, p.g_post_ffn + l * D, mod + (size_t)t.mrow * 12288 + 5 * D, c0);
        if (l == 0) {
            store_row_bf(XR + (size_t)r * D, x, c0);
            const float* mod1 = (const float*)(p.ws + WS_MOD) + (size_t)1 * 5 * 12288;
            adaln_store(x, p.g_pre_mix + 1 * D, mod1 + (size_t)t.mrow * 12288 + 0 * D, mod1 + (size_t)t.mrow * 12288 + 1 * D, hb + (size_t)r * D, nullptr, c0);
        } else {
            float* dstrow = p.out + (size_t)r * D;
#pragma unroll
            for (int i = 0; i < 4; ++i) { *(f32x4*)(dstrow + i * 512 + c0) = x[i][0]; *(f32x4*)(dstrow + i * 512 + c0 + 4) = x[i][1]; }
        }
    }
}

struct GemmUnit {
    const bf16_t* A; long lda; const int* rows; int rowshift;
    const bf16_t* Bt; long ldb;
    int K;
};
constexpr int GS_LD = 72;
struct LaneId { int wr, wc, fr, fq; };
DI LaneId gemm_kloop_simple(char* lds, const GemmUnit& g, f32x4 (&acc)[2][2][4][2]) {
    int tid = threadIdx.x; asm volatile("" : "+v"(tid));
    const int wid = tid >> 6, lane = tid & 63, wr = wid >> 2, wc = wid & 3, fr = lane & 15, fq = lane >> 4;
    bf16_t* As = (bf16_t*)lds; bf16_t* Bs = As + 256 * GS_LD;
#pragma unroll
    for (int a = 0; a < 2; ++a)
#pragma unroll
        for (int b = 0; b < 2; ++b)
#pragma unroll
            for (int m = 0; m < 4; ++m)
#pragma unroll
                for (int n = 0; n < 2; ++n) acc[a][b][m][n] = (f32x4){0.f, 0.f, 0.f, 0.f};
    const int srow = tid >> 3, skc = (tid & 7) * 8;
    const bf16_t* ap[4]; const bf16_t* bp[4];
#pragma unroll
    for (int i = 0; i < 4; ++i) {
        const int r = srow + 64 * i;
        if (g.rows) { const int idx = g.rows[r]; ap[i] = g.A + (size_t)(idx >= 0 ? (idx >> g.rowshift) : 0) * g.lda + skc; }
        else ap[i] = g.A + (size_t)r * g.lda + skc;
        bp[i] = g.Bt + (size_t)r * g.ldb + skc;
    }
    const int nkt = g.K / 64;
    u32x4 ra[4], rb[4];
#pragma unroll
    for (int i = 0; i < 4; ++i) { ra[i] = *(const u32x4*)(ap[i]); rb[i] = *(const u32x4*)(bp[i]); }
    for (int kt = 0; kt < nkt; ++kt) {
        __syncthreads();
#pragma unroll
        for (int i = 0; i < 4; ++i) { *(u32x4*)(As + (srow + 64 * i) * GS_LD + skc) = ra[i]; *(u32x4*)(Bs + (srow + 64 * i) * GS_LD + skc) = rb[i]; }
        __syncthreads();
        if (kt + 1 < nkt) {
#pragma unroll
            for (int i = 0; i < 4; ++i) { ra[i] = *(const u32x4*)(ap[i] + (kt + 1) * 64); rb[i] = *(const u32x4*)(bp[i] + (kt + 1) * 64); }
        }
#pragma unroll
        for (int kk = 0; kk < 2; ++kk) {
            bf16x8 bf[2][2];
#pragma unroll
            for (int bj = 0; bj < 2; ++bj)
#pragma unroll
                for (int n = 0; n < 2; ++n) bf[bj][n] = *(const bf16x8*)(Bs + (128 * bj + 32 * wc + 16 * n + fr) * GS_LD + kk * 32 + fq * 8);
#pragma unroll
            for (int ai = 0; ai < 2; ++ai)
#pragma unroll
                for (int m = 0; m < 4; ++m) {
                    const bf16x8 af = *(const bf16x8*)(As + (128 * ai + 64 * wr + 16 * m + fr) * GS_LD + kk * 32 + fq * 8);
#pragma unroll
                    for (int bj = 0; bj < 2; ++bj)
#pragma unroll
                        for (int n = 0; n < 2; ++n) acc[ai][bj][m][n] = __builtin_amdgcn_mfma_f32_16x16x32_bf16(bf[bj][n], af, acc[ai][bj][m][n], 0, 0, 0);
                }
        }
    }
    __syncthreads();
    LaneId id; id.wr = wr; id.wc = wc; id.fr = fr; id.fq = fq; return id;
}
#define GEMM_ACC f32x4 acc[2][2][4][2]
#define ACC_FOREACH(...) \
    _Pragma("unroll") for (int ai = 0; ai < 2; ++ai) _Pragma("unroll") for (int m = 0; m < 4; ++m) { const int trow = 128 * ai + 64 * wr + 16 * m + fr; \
    _Pragma("unroll") for (int bj = 0; bj < 2; ++bj) _Pragma("unroll") for (int n = 0; n < 2; ++n) { const int tcol = 128 * bj + 32 * wc + 16 * n + 4 * fq; const f32x4 v = acc[ai][bj][m][n]; __VA_ARGS__ } }

struct EpiProj {
    bf16_t* O; int row0, col0;
    DI void operator()(const f32x4 (&acc)[2][2][4][2], int wr, int wc, int fr, int fq) const {
        ACC_FOREACH({ u32x2 w; w.x = pk2(v[0], v[1]); w.y = pk2(v[2], v[3]); *(u32x2*)(O + (size_t)(row0 + trow) * INWP + col0 + tcol) = w; })
    }
};
struct EpiB16 {
    bf16_t* O; int row0, col0, ld;
    DI void operator()(const f32x4 (&acc)[2][2][4][2], int wr, int wc, int fr, int fq) const {
        ACC_FOREACH({ u32x2 w; w.x = pk2(v[0], v[1]); w.y = pk2(v[2], v[3]); *(u32x2*)(O + (size_t)(row0 + trow) * ld + col0 + tcol) = w; })
    }
};
struct EpiF32 {
    float* O; int row0, col0, ld;
    DI void operator()(const f32x4 (&acc)[2][2][4][2], int wr, int wc, int fr, int fq) const {
        ACC_FOREACH({ *(f32x4*)(O + (size_t)(row0 + trow) * ld + col0 + tcol) = v; })
    }
};
struct EpiUq {
    bf16_t* Q; const float2* ropem; int row0, col0;
    DI void operator()(const f32x4 (&acc)[2][2][4][2], int wr, int wc, int fr, int fq) const {
#pragma unroll
        for (int ai = 0; ai < 2; ++ai)
#pragma unroll
            for (int m = 0; m < 4; ++m) {
                const int r = row0 + 128 * ai + 64 * wr + 16 * m + fr; const Tok t = tok_of(r);
#pragma unroll
                for (int bj = 0; bj < 2; ++bj) {
                    const int cbase = col0 + 128 * bj + 32 * wc;
                    if (cbase >= 1152) continue;
                    const int h = cbase / 192, jb = cbase % 192;
                    f32x4 v0 = acc[ai][bj][m][0], v1 = acc[ai][bj][m][1];
                    if (jb >= 128 && !t.isctx) {
                        const int pos = (jb == 128) ? (t.s >> 6) : (t.s & 63);
#pragma unroll
                        for (int i = 0; i < 4; ++i) { const float2 cs = ropem[pos * 16 + 4 * fq + i]; const float x1 = v0[i], x2 = v1[i]; v0[i] = x1 * cs.x - x2 * cs.y; v1[i] = x2 * cs.x + x1 * cs.y; }
                    }
                    bf16_t* dst = Q + (((size_t)t.b * 6 + h) * SKV + t.kvpos) * 192 + jb + 4 * fq;
                    u32x2 w0; w0.x = pk2(v0[0], v0[1]); w0.y = pk2(v0[2], v0[3]); *(u32x2*)(dst) = w0;
                    u32x2 w1; w1.x = pk2(v1[0], v1[1]); w1.y = pk2(v1[2], v1[3]); *(u32x2*)(dst + 16) = w1;
                }
            }
    }
};
struct EpiUkv {
    bf16_t* Km; bf16_t* Vm; int row0, col0;
    DI void operator()(const f32x4 (&acc)[2][2][4][2], int wr, int wc, int fr, int fq) const {
        ACC_FOREACH({ const int r = row0 + trow; const Tok t = tok_of(r); const int c = col0 + tcol, h = c >> 8, j = c & 255;
            u32x2 w; w.x = pk2(v[0], v[1]); w.y = pk2(v[2], v[3]);
            if (j < 128) *(u32x2*)(Km + (((size_t)t.b * 6 + h) * SKV + t.kvpos) * 192 + j) = w;
            else *(u32x2*)(Vm + (((size_t)t.b * 6 + h) * SKV + t.kvpos) * 128 + (j - 128)) = w; })
    }
};
struct EpiMoe1 {
    bf16_t* act; int arow0, hcol0;
    DI void operator()(const f32x4 (&acc)[2][2][4][2], int wr, int wc, int fr, int fq) const {
#pragma unroll
        for (int ai = 0; ai < 2; ++ai)
#pragma unroll
            for (int m = 0; m < 4; ++m) {
                const int trow = 128 * ai + 64 * wr + 16 * m + fr;
#pragma unroll
                for (int n = 0; n < 2; ++n) {
                    const f32x4 a = acc[ai][0][m][n], b = acc[ai][1][m][n]; f32x4 h;
#pragma unroll
                    for (int i = 0; i < 4; ++i) h[i] = silu_f(a[i]) * b[i];
                    u32x2 w; w.x = pk2(h[0], h[1]); w.y = pk2(h[2], h[3]);
                    *(u32x2*)(act + (size_t)(arow0 + trow) * 512 + hcol0 + 32 * wc + 16 * n + 4 * fq) = w;
                }
            }
    }
};
struct EpiMoe2 {
    bf16_t* oasg; const int* sasg; const float* sw; int srow0, col0;
    DI void operator()(const f32x4 (&acc)[2][2][4][2], int wr, int wc, int fr, int fq) const {
        int a[2][4]; float wgt[2][4];
#pragma unroll
        for (int ai = 0; ai < 2; ++ai)
#pragma unroll
            for (int m = 0; m < 4; ++m) { const int trow = 128 * ai + 64 * wr + 16 * m + fr; a[ai][m] = sasg[srow0 + trow]; wgt[ai][m] = sw[srow0 + trow]; }
#pragma unroll
        for (int ai = 0; ai < 2; ++ai)
#pragma unroll
            for (int m = 0; m < 4; ++m) {
                if (a[ai][m] < 0) continue;
#pragma unroll
                for (int bj = 0; bj < 2; ++bj)
#pragma unroll
                    for (int n = 0; n < 2; ++n) { const f32x4 v = acc[ai][bj][m][n] * wgt[ai][m]; u32x2 w; w.x = pk2(v[0], v[1]); w.y = pk2(v[2], v[3]);
                        *(u32x2*)(oasg + (size_t)a[ai][m] * D + col0 + 128 * bj + 32 * wc + 16 * n + 4 * fq) = w; }
            }
    }
};
DI u32x4 pack8(const f32x4& a, const f32x4& b) { u32x4 w; w.x = pk2(a[0], a[1]); w.y = pk2(a[2], a[3]); w.z = pk2(b[0], b[1]); w.w = pk2(b[2], b[3]); return w; }
struct EpiB16P {
    bf16_t* O; int row0, col0, ld;
    DI void operator()(const f32x4 (&acc)[2][2][4][2], int wr, int wc, int fr, int fq) const {
#pragma unroll
        for (int ai = 0; ai < 2; ++ai)
#pragma unroll
            for (int m = 0; m < 4; ++m) { bf16_t* rowp = O + (size_t)(row0 + 128 * ai + 64 * wr + 16 * m + fr) * ld + col0 + 32 * wc + 8 * fq;
#pragma unroll
                for (int bj = 0; bj < 2; ++bj) *(u32x4*)(rowp + 128 * bj) = pack8(acc[ai][bj][m][0], acc[ai][bj][m][1]); }
    }
};
struct EpiMoe1P {
    bf16_t* act; int arow0, hcol0;
    DI void operator()(const f32x4 (&acc)[2][2][4][2], int wr, int wc, int fr, int fq) const {
#pragma unroll
        for (int ai = 0; ai < 2; ++ai)
#pragma unroll
            for (int m = 0; m < 4; ++m) {
                f32x4 h0, h1;
#pragma unroll
                for (int i = 0; i < 4; ++i) { h0[i] = silu_f(acc[ai][0][m][0][i]) * acc[ai][1][m][0][i]; h1[i] = silu_f(acc[ai][0][m][1][i]) * acc[ai][1][m][1][i]; }
                *(u32x4*)(act + (size_t)(arow0 + 128 * ai + 64 * wr + 16 * m + fr) * 512 + hcol0 + 32 * wc + 8 * fq) = pack8(h0, h1);
            }
    }
};
struct EpiMoe2P {
    bf16_t* oasg; const int* sasg; const float* sw; int srow0, col0;
    DI void operator()(const f32x4 (&acc)[2][2][4][2], int wr, int wc, int fr, int fq) const {
        int a[2][4]; float wgt[2][4];
#pragma unroll
        for (int ai = 0; ai < 2; ++ai)
#pragma unroll
            for (int m = 0; m < 4; ++m) { const int trow = 128 * ai + 64 * wr + 16 * m + fr; a[ai][m] = sasg[srow0 + trow]; wgt[ai][m] = sw[srow0 + trow]; }
#pragma unroll
        for (int ai = 0; ai < 2; ++ai)
#pragma unroll
            for (int m = 0; m < 4; ++m) {
                if (a[ai][m] < 0) continue;
                bf16_t* rowp = oasg + (size_t)a[ai][m] * D + col0 + 32 * wc + 8 * fq;
#pragma unroll
                for (int bj = 0; bj < 2; ++bj) *(u32x4*)(rowp + 128 * bj) = pack8(acc[ai][bj][m][0] * wgt[ai][m], acc[ai][bj][m][1] * wgt[ai][m]);
            }
    }
};
struct EpiMoe2F8 {
    unsigned char* oasg; const int* sasg; const float* sw; int srow0, col0;
    DI void operator()(const f32x4 (&acc)[2][2][4][2], int wr, int wc, int fr, int fq) const {
        int a[2][4]; float wgt[2][4];
#pragma unroll
        for (int ai = 0; ai < 2; ++ai)
#pragma unroll
            for (int m = 0; m < 4; ++m) { const int trow = 128 * ai + 64 * wr + 16 * m + fr; a[ai][m] = sasg[srow0 + trow]; wgt[ai][m] = sw[srow0 + trow] * OASG_SCALE; }
#pragma unroll
        for (int ai = 0; ai < 2; ++ai)
#pragma unroll
            for (int m = 0; m < 4; ++m) {
                if (a[ai][m] < 0) continue;
                unsigned char* rowp = oasg + (size_t)a[ai][m] * D + col0 + 32 * wc + 8 * fq;
#pragma unroll
                for (int bj = 0; bj < 2; ++bj) { const f32x4 v0 = acc[ai][bj][m][0] * wgt[ai][m], v1 = acc[ai][bj][m][1] * wgt[ai][m]; u32x2 w;
                    int t0 = __builtin_amdgcn_cvt_pk_fp8_f32(v0[0], v0[1], 0, false); t0 = __builtin_amdgcn_cvt_pk_fp8_f32(v0[2], v0[3], t0, true);
                    int t1 = __builtin_amdgcn_cvt_pk_fp8_f32(v1[0], v1[1], 0, false); t1 = __builtin_amdgcn_cvt_pk_fp8_f32(v1[2], v1[3], t1, true);
                    w.x = (unsigned)t0; w.y = (unsigned)t1; *(u32x2*)(rowp + 128 * bj) = w; }
            }
    }
};
DI void phase_postproj_rows(PR p, int l) {
    const int tid_ = tid_here(), lane = tid_ & 63, wid = tid_ >> 6;
    unsigned char* U = p.ws + WS_U;
    const bf16_t* PR = (const bf16_t*)(U + U_PROJ);
    bf16_t* CQN = (bf16_t*)(U + U_CQN); bf16_t* CKVN = (bf16_t*)(U + U_CKVN);
    bf16_t* Km = (bf16_t*)(U + U_KM); bf16_t* Qg = (bf16_t*)(U + U_QG); bf16_t* Kg = (bf16_t*)(U + U_KG); bf16_t* Vg = (bf16_t*)(U + U_VG);
    const float2* ropeg = (const float2*)(p.ws + WS_ROPEG); const float2* ropem = (const float2*)(p.ws + WS_ROPEM);
    const float* gq = p.gqa_g_q + l * 128; const float* gk = p.gqa_g_k + l * 128;
    for (int r = bid_here() * 8 + wid; r < NTOK; r += gridDim.x * 8) {
        const Tok t = tok_of(r);
        const bf16_t* pr = PR + (size_t)r * INWP;
        {
            float v[6], ss = 0.f;
#pragma unroll
            for (int i = 0; i < 6; ++i) { v[i] = bf2f(pr[C_CQ + lane + 64 * i]); ss += v[i] * v[i]; }
            const float rstd = rsqrtf(wave_sum(ss) * (1.f / 384.f) + EPS);
#pragma unroll
            for (int i = 0; i < 6; ++i) CQN[(size_t)r * 512 + lane + 64 * i] = f2bf(v[i] * rstd);
            CQN[(size_t)r * 512 + 384 + lane] = 0; CQN[(size_t)r * 512 + 448 + lane] = 0;
        }
        {
            float v[8], ss = 0.f;
#pragma unroll
            for (int i = 0; i < 8; ++i) { v[i] = bf2f(pr[C_CKV + lane + 64 * i]); ss += v[i] * v[i]; }
            const float rstd = rsqrtf(wave_sum(ss) * (1.f / 512.f) + EPS);
#pragma unroll
            for (int i = 0; i < 8; ++i) CKVN[(size_t)r * 512 + lane + 64 * i] = f2bf(v[i] * rstd);
        }
        {
            float x = bf2f(pr[C_KR + lane]);
            const float other = shx(x, 16, lane);
            if (!t.isctx) {
                const int g = lane >> 5, idx = lane & 31, fi = idx & 15; const bool second = idx >= 16;
                const int pos = g == 0 ? (t.s >> 6) : (t.s & 63);
                const float2 cs = ropem[pos * 16 + fi];
                x = second ? x * cs.x + other * cs.y : x * cs.x - other * cs.y;
            }
            const bf16_t xb = f2bf(x);
#pragma unroll
            for (int h = 0; h < 6; ++h) Km[(((size_t)t.b * 6 + h) * SKV + t.kvpos) * 192 + 128 + lane] = xb;
        }
        const int fi = lane & 31; const bool second = lane >= 32;
        float2 cs0 = make_float2(1.f, 0.f), cs1 = make_float2(1.f, 0.f);
        if (!t.isctx) { cs0 = ropeg[(t.s >> 6) * 32 + fi]; cs1 = ropeg[(t.s & 63) * 32 + fi]; }
#pragma unroll
        for (int hh = 0; hh < 8; ++hh) {
            const bool isq = hh < 6; const int h = isq ? hh : hh - 6; const float* g = isq ? gq : gk;
            const int cb = (isq ? C_AQ : C_AK) + h * 128;
            float e0 = bf2f(pr[cb + lane]), e1 = bf2f(pr[cb + 64 + lane]);
            const float rstd = rsqrtf(wave_sum(e0 * e0 + e1 * e1) * (1.f / 128.f) + EPS);
            e0 = e0 * rstd * g[lane]; e1 = e1 * rstd * g[64 + lane];
            const float o0 = shx(e0, 32, lane), o1 = shx(e1, 32, lane);
            const float r0 = second ? e0 * cs0.x + o0 * cs0.y : e0 * cs0.x - o0 * cs0.y;
            const float r1 = second ? e1 * cs1.x + o1 * cs1.y : e1 * cs1.x - o1 * cs1.y;
            bf16_t* dst = isq ? Qg + (((size_t)t.b * 6 + h) * SKV + t.kvpos) * 128 : Kg + (((size_t)t.b * 2 + h) * SKV + t.kvpos) * 128;
            dst[lane] = f2bf(r0); dst[64 + lane] = f2bf(r1);
        }
#pragma unroll
        for (int h = 0; h < 2; ++h) { bf16_t* dst = Vg + (((size_t)t.b * 2 + h) * SKV + t.kvpos) * 128; dst[lane] = pr[C_AV + h * 128 + lane]; dst[64 + lane] = pr[C_AV + h * 128 + 64 + lane]; }
    }
}

#define SBAR() __builtin_amdgcn_sched_barrier(0)
DI int crow(int r, int hi) { return (r & 3) + 8 * (r >> 2) + 4 * hi; }
DI unsigned cvtpk(float lo, float hi) { unsigned r; asm volatile("v_cvt_pk_bf16_f32 %0, %1, %2" : "=v"(r) : "v"(lo), "v"(hi)); return r; }
constexpr float ATT_THR = 8.f;
template <int DQK> struct AttnCfg {
    static constexpr int KROWB = DQK * 2;
    static constexpr int SHM_V = 64 * 128 * 2, SHM_K = 64 * DQK * 2;
    static constexpr int ND0 = DQK / 16;
    static constexpr int NKCH = DQK / 64;
    static constexpr int NQR = DQK == 128 ? 8 : ATT_NQR_M;
    static constexpr int SHM_Q = 8 * (ND0 - NQR) * 1024;
    static constexpr int SHM_TOTAL = 2 * SHM_V + 2 * SHM_K + 8 * 64 * 4 + SHM_Q;
};
template <int DQK> DI int kswz(int row, int colB) { return row * (DQK * 2) + (colB ^ ((row & 7) << 4)); }
DI void partialSM(f32x16& p0, f32x16& p1, float& m_reg, float& mn, float& alpha, const float SCALE) {
    const float C = SCALE * 1.4426950408889634f;
    float pmax = p0[0];
#pragma unroll
    for (int r = 1; r < 16; ++r) pmax = fmaxf(pmax, p0[r]);
#pragma unroll
    for (int r = 0; r < 16; ++r) pmax = fmaxf(pmax, p1[r]);
    { auto rr = __builtin_amdgcn_permlane32_swap(__float_as_uint(pmax), __float_as_uint(pmax), false, false);
      pmax = fmaxf(__uint_as_float(rr[0]), __uint_as_float(rr[1])); }
    if (__builtin_expect(__all(pmax - m_reg <= ATT_THR / SCALE), 1)) { mn = m_reg; alpha = 1.f; }
    else { mn = fmaxf(m_reg, pmax); alpha = __builtin_amdgcn_exp2f((m_reg - mn) * C); m_reg = mn; }
    const float mnC = -mn * C;
#pragma unroll
    for (int r = 0; r < 16; ++r) p0[r] = fmaf(p0[r], C, mnC);
#pragma unroll
    for (int r = 0; r < 16; ++r) p1[r] = fmaf(p1[r], C, mnC);
#pragma unroll
    for (int r = 0; r < 16; ++r) p0[r] = __builtin_amdgcn_exp2f(p0[r]);
}
DI void finishSM(f32x16& p0, f32x16& p1, float alpha, float& l_reg, bf16x8& pa0, bf16x8& pa1, bf16x8& pa2, bf16x8& pa3) {
#pragma unroll
    for (int r = 0; r < 16; ++r) p1[r] = __builtin_amdgcn_exp2f(p1[r]);
    float ps = 0;
#pragma unroll
    for (int r = 0; r < 16; ++r) ps += p0[r];
#pragma unroll
    for (int r = 0; r < 16; ++r) ps += p1[r];
    { auto rr = __builtin_amdgcn_permlane32_swap(__float_as_uint(ps), __float_as_uint(ps), false, false);
      ps = __uint_as_float(rr[0]) + __uint_as_float(rr[1]); }
    l_reg = l_reg * alpha + ps;
#define PK4(P, BASE, OUT) do { unsigned a0 = cvtpk(P[BASE + 0], P[BASE + 1]), a1 = cvtpk(P[BASE + 2], P[BASE + 3]);   \
    unsigned b0 = cvtpk(P[BASE + 4], P[BASE + 5]), b1 = cvtpk(P[BASE + 6], P[BASE + 7]);                              \
    auto r0 = __builtin_amdgcn_permlane32_swap(a0, b0, false, false); auto r1 = __builtin_amdgcn_permlane32_swap(a1, b1, false, false); \
    u32x4 w = {r0[0], r1[0], r0[1], r1[1]}; OUT = *reinterpret_cast<bf16x8*>(&w); } while (0)
    PK4(p0, 0, pa0); PK4(p0, 8, pa1); PK4(p1, 0, pa2); PK4(p1, 8, pa3);
#undef PK4
}
template <int DQK, int NQR>
DI void qkt(f32x16& p0, f32x16& p1, const int (&kb)[4], int bufoff, const bf16x8* qr, int qs_addr, int r32, int hi) {
    asm volatile("" : "+v"(qs_addr));
    const LAS char* Qs = (const LAS char*)qs_addr;
#pragma unroll
    for (int r = 0; r < 16; ++r) { p0[r] = 0.f; p1[r] = 0.f; }
#pragma unroll
    for (int d0 = 0; d0 < DQK / 16; ++d0) {
        const LAS char* ka = (const LAS char*)(kb[d0 & 3]) + bufoff + 128 * (d0 >> 2);
        const bf16x8 b0 = *(const LAS bf16x8*)(ka);
        const bf16x8 b1 = *(const LAS bf16x8*)(ka + 32 * DQK * 2);
        bf16x8 q;
        if (d0 < NQR) q = qr[d0]; else q = *(const LAS bf16x8*)(Qs + (d0 - NQR) * 1024);
        p0 = __builtin_amdgcn_mfma_f32_32x32x16_bf16(b0, q, p0, 0, 0, 0);
        p1 = __builtin_amdgcn_mfma_f32_32x32x16_bf16(b1, q, p1, 0, 0, 0); }
}
DI int v_st(int k, int c) { const int kk = (k & ~0xC) | ((k & 4) << 1) | ((k & 8) >> 1); return ((kk >> 3) * 4 + (c >> 5)) * 512 + ((kk & 7) * 32 + (c & 31)) * 2; }
DI int v_rd_base(int lane) { return ((lane & 3) << 3) | (((lane >> 2) & 3) << 6) | (((lane >> 4) & 1) << 5) | (((lane >> 5) & 1) << 8); }
constexpr int v_rd_off(int d0, int ks, int half) { return d0 * 512 + ks * 4096 + half * 2048; }
template <int OFF> DI s16x4 tr_read(int vb) { s16x4 r; asm volatile("ds_read_b64_tr_b16 %0, %1 offset:%2" : "=&v"(r) : "v"(vb), "i"(OFF) : "memory"); return r; }
template <int D0> DI void pv_one(f32x16& od, int vb, bf16x8 pa0, bf16x8 pa1, bf16x8 pa2, bf16x8 pa3) {
    const s16x4 l0 = tr_read<v_rd_off(D0, 0, 0)>(vb), h0 = tr_read<v_rd_off(D0, 0, 1)>(vb), l1 = tr_read<v_rd_off(D0, 1, 0)>(vb), h1 = tr_read<v_rd_off(D0, 1, 1)>(vb);
    const s16x4 l2 = tr_read<v_rd_off(D0, 2, 0)>(vb), h2 = tr_read<v_rd_off(D0, 2, 1)>(vb), l3 = tr_read<v_rd_off(D0, 3, 0)>(vb), h3 = tr_read<v_rd_off(D0, 3, 1)>(vb);
    asm volatile("s_waitcnt lgkmcnt(0)" ::: "memory"); SBAR();
#define PKV(L, H) (bf16x8){L[0], L[1], L[2], L[3], H[0], H[1], H[2], H[3]}
    od = __builtin_amdgcn_mfma_f32_32x32x16_bf16(pa0, PKV(l0, h0), od, 0, 0, 0);
    od = __builtin_amdgcn_mfma_f32_32x32x16_bf16(pa1, PKV(l1, h1), od, 0, 0, 0);
    od = __builtin_amdgcn_mfma_f32_32x32x16_bf16(pa2, PKV(l2, h2), od, 0, 0, 0);
    od = __builtin_amdgcn_mfma_f32_32x32x16_bf16(pa3, PKV(l3, h3), od, 0, 0, 0);
#undef PKV
}
DI void pv_d0(f32x16* o, int vb, bf16x8 pa0, bf16x8 pa1, bf16x8 pa2, bf16x8 pa3) {
    pv_one<0>(o[0], vb, pa0, pa1, pa2, pa3); pv_one<1>(o[1], vb, pa0, pa1, pa2, pa3); pv_one<2>(o[2], vb, pa0, pa1, pa2, pa3); pv_one<3>(o[3], vb, pa0, pa1, pa2, pa3);
}
template <int DQK, int SDEPTH>
DI void attn_body(const bf16_t* __restrict__ Qb, const bf16_t* __restrict__ Kh, const bf16_t* __restrict__ Vh, bf16_t* __restrict__ Ob, int ldo, int seq, char* lds, const float SCALE) {
    using Cfg = AttnCfg<DQK>;
    constexpr int SHM_V = Cfg::SHM_V, SHM_K = Cfg::SHM_K, ND0 = Cfg::ND0, NKCH = Cfg::NKCH, KCPR = DQK / 8, NQR = Cfg::NQR;
    int tid = threadIdx.x; asm volatile("" : "+v"(tid));
    const int wid = tid >> 6, lane = tid & 63, r32 = lane & 31, hi = lane >> 5;
    char* V_lds = lds; char* K_lds = lds + 2 * SHM_V;
    float* ws = (float*)(lds + 2 * SHM_V + 2 * SHM_K) + wid * 64; float* li_l = ws; float* al_l = ws + 32;
    float m_reg = -1e30f, l_reg = 0; f32x16 o[4]; bf16x8 qr[NQR > 0 ? NQR : 1];
    char* Qs = lds + 2 * SHM_V + 2 * SHM_K + 8 * 64 * 4 + (wid * (ND0 - NQR) * 64 + lane) * 16;
#pragma unroll
    for (int d = 0; d < 4; ++d)
#pragma unroll
        for (int r = 0; r < 16; ++r) o[d][r] = 0.f;
    const bf16_t* Qw = Qb + (long)(wid * 32 + r32) * DQK + hi * 8;
#pragma unroll
    for (int d0 = 0; d0 < ND0; ++d0) { const bf16x8 qv = *reinterpret_cast<const bf16x8*>(Qw + d0 * 16); if (d0 < NQR) qr[d0] = qv; else *reinterpret_cast<bf16x8*>(Qs + (d0 - NQR) * 1024) = qv; }
    asm volatile("s_waitcnt lgkmcnt(0)" ::: "memory");
    const int sr = tid >> 4, sc = (tid & 15) * 8, vst0 = v_st(sr, sc), vst1 = v_st(32 + sr, sc);
    const int kgo = (tid >> 3) * DQK + (tid & 7) * 8, klo = (tid >> 3) * (DQK * 2) + (((tid & 7) << 4) ^ (((tid >> 3) & 7) << 4));
    const int vb0 = (int)(uintptr_t)V_lds + v_rd_base(lane);
    int kb[4];
#pragma unroll
    for (int m = 0; m < 4; ++m) { kb[m] = (int)(uintptr_t)K_lds + r32 * (DQK * 2) + 16 * (hi ^ (r32 & 1)) + 32 * (m ^ ((r32 >> 1) & 3)); asm volatile("" : "+v"(kb[m])); }
    struct { bf16x8 vs0, vs1, ks[NKCH]; } sr_[SDEPTH];
#define SLOAD(i, k0) do { sr_[i].vs0 = *(const bf16x8*)(&Vh[(long)((k0) + sr) * 128 + sc]); sr_[i].vs1 = *(const bf16x8*)(&Vh[(long)((k0) + 32 + sr) * 128 + sc]); \
    _Pragma("unroll") for (int q_ = 0; q_ < NKCH; ++q_) sr_[i].ks[q_] = *(const bf16x8*)(&Kh[(long)(k0) * DQK + kgo + q_ * 64]); } while (0)
#define SWRITE(b, i) do { *(bf16x8*)(V_lds + (b) * SHM_V + vst0) = sr_[i].vs0; *(bf16x8*)(V_lds + (b) * SHM_V + vst1) = sr_[i].vs1; \
    _Pragma("unroll") for (int q_ = 0; q_ < NKCH; ++q_) *(bf16x8*)(K_lds + (b) * SHM_K + klo + q_ * 128) = sr_[i].ks[q_]; } while (0)
#define SWAIT() do { if constexpr (SDEPTH == 1) asm volatile("s_waitcnt vmcnt(0)" ::: "memory"); else if constexpr (NKCH == 2) asm volatile("s_waitcnt vmcnt(4)" ::: "memory"); else asm volatile("s_waitcnt vmcnt(5)" ::: "memory"); } while (0)
#define RESC(a) do { if (__any((a) < 1.f)) { if (hi == 0) al_l[r32] = (a); asm volatile("s_waitcnt lgkmcnt(0)" ::: "memory"); \
    _Pragma("unroll") for (int d = 0; d < 4; ++d) _Pragma("unroll") for (int r = 0; r < 16; ++r) o[d][r] *= al_l[crow(r, hi)]; } } while (0)
    f32x16 pA0, pA1, pB0, pB1; float mnA, mnB, alA, alB; bf16x8 pa0, pa1, pa2, pa3; const int NT = seq / 64;
    constexpr int SE = 0, SO = SDEPTH - 1;
    SLOAD(SE, 0); asm volatile("s_waitcnt vmcnt(0)" ::: "memory"); SWRITE(0, SE); __syncthreads();
    qkt<DQK, NQR>(pA0, pA1, kb, 0, qr, (int)(uintptr_t)Qs, r32, hi); partialSM(pA0, pA1, m_reg, mnA, alA, SCALE);
    SLOAD(SO, 64); if constexpr (SDEPTH == 2) { if (2 < NT) SLOAD(SE, 2 * 64); }
    SWAIT(); SWRITE(1, SO); __syncthreads();
    for (int j = 1; j + 1 < NT; j += 2) {
        SBAR(); qkt<DQK, NQR>(pB0, pB1, kb, SHM_K, qr, (int)(uintptr_t)Qs, r32, hi);
        finishSM(pA0, pA1, alA, l_reg, pa0, pa1, pa2, pa3); SBAR();
        SLOAD(SO, (j + SDEPTH) * 64); SBAR();
        pv_d0(o, vb0, pa0, pa1, pa2, pa3); partialSM(pB0, pB1, m_reg, mnB, alB, SCALE);
        __syncthreads(); SWAIT(); SWRITE(0, SE);
        RESC(alB); __syncthreads();
        SBAR(); qkt<DQK, NQR>(pA0, pA1, kb, 0, qr, (int)(uintptr_t)Qs, r32, hi);
        finishSM(pB0, pB1, alB, l_reg, pa0, pa1, pa2, pa3); SBAR();
        if (SDEPTH == 1 || j + 3 < NT) SLOAD(SE, (j + 1 + SDEPTH) * 64); SBAR();
        pv_d0(o, vb0 + SHM_V, pa0, pa1, pa2, pa3); partialSM(pA0, pA1, m_reg, mnA, alA, SCALE);
        __syncthreads(); SWAIT(); SWRITE(1, SO);
        RESC(alA); __syncthreads();
    }
    SBAR(); qkt<DQK, NQR>(pB0, pB1, kb, SHM_K, qr, (int)(uintptr_t)Qs, r32, hi);
    finishSM(pA0, pA1, alA, l_reg, pa0, pa1, pa2, pa3); SBAR();
    pv_d0(o, vb0, pa0, pa1, pa2, pa3); partialSM(pB0, pB1, m_reg, mnB, alB, SCALE);
    __syncthreads(); RESC(alB);
    finishSM(pB0, pB1, alB, l_reg, pa0, pa1, pa2, pa3); SBAR();
    pv_d0(o, vb0 + SHM_V, pa0, pa1, pa2, pa3);
    if (hi == 0) li_l[r32] = l_reg; asm volatile("s_waitcnt lgkmcnt(0)" ::: "memory");
    float rli[16];
#pragma unroll
    for (int r = 0; r < 16; ++r) rli[r] = __builtin_amdgcn_rcpf(li_l[crow(r, hi)]);
    bf16_t* Ow = Ob + (long)(wid * 32) * ldo;
#pragma unroll
    for (int r = 0; r < 16; ++r) { const int orow = crow(r, hi);
#pragma unroll
        for (int d0 = 0; d0 < 4; ++d0) Ow[(long)orow * ldo + d0 * 32 + r32] = f2bf(o[d0][r] * rli[r]); }
    __syncthreads();
#undef SLOAD
#undef SWRITE
#undef SWAIT
#undef RESC
}

template <int DQK> DI void attn_body_old(const bf16_t* Qb, const bf16_t* Kh, const bf16_t* Vh, bf16_t* Ob, int ldo, int seq, char* lds, const float SCALE) {
    if constexpr (DQK == 192) attn_body<192, ATT_SD_M>(Qb, Kh, Vh, Ob, ldo, seq, lds, SCALE); else attn_body<128, ATT_SD_G>(Qb, Kh, Vh, Ob, ldo, seq, lds, SCALE);
}
template <int DQK>
DI void attn_body2(const bf16_t* __restrict__ Qb, const bf16_t* __restrict__ Kh, const bf16_t* __restrict__ Vh, bf16_t* __restrict__ Ob, int ldo, int seq, char* lds, const float SCALE) {
    constexpr int SHM_V = 64 * 128 * 2, SHM_K = 64 * DQK * 2, ND0 = DQK / 16, KP = SHM_K / 8192, VP = 2, NP = KP + VP;
    constexpr int V_RING = 0, K_RING = 4 * SHM_V, WS_OFF = K_RING + 3 * SHM_K;
    int tid = threadIdx.x; asm volatile("" : "+v"(tid));
    const int wid = __builtin_amdgcn_readfirstlane(tid >> 6), lane = tid & 63, r32 = lane & 31, hi = lane >> 5;
    float* ws = (float*)(lds + WS_OFF) + wid * 64; float* li_l = ws; float* al_l = ws + 32;
    float m_reg = -1e30f, l_reg = 0; f32x16 o[4]; bf16x8 qr[ND0];
#pragma unroll
    for (int d = 0; d < 4; ++d)
#pragma unroll
        for (int r = 0; r < 16; ++r) o[d][r] = 0.f;
    int kgo[KP], vgo[VP];
#pragma unroll
    for (int q = 0; q < KP; ++q) { const int sl = (wid * KP + q) * 64 + lane, row = sl / (DQK / 8), ch = sl % (DQK / 8), gch = (ch & ~7) | ((ch & 7) ^ (row & 7)); kgo[q] = row * DQK + gch * 8; }
#pragma unroll
    for (int q = 0; q < VP; ++q) { const int off = (wid * VP + q) * 1024 + lane * 16, sub = off >> 9, w = off & 511, kk = (sub >> 2) * 8 + (w >> 6), k = (kk & ~0xC) | ((kk & 4) << 1) | ((kk & 8) >> 1), c = (sub & 3) * 32 + ((w & 63) >> 1); vgo[q] = k * 128 + c; }
    LAS unsigned char* L = (LAS unsigned char*)lds;
#define DMA_TILE(t, ks, vs) do { \
    _Pragma("unroll") for (int q_ = 0; q_ < KP; ++q_) __builtin_amdgcn_global_load_lds((const unsigned*)(Kh + (size_t)(t) * 64 * DQK + kgo[q_]), (LAS unsigned*)(L + K_RING + (ks) * SHM_K + (wid * KP + q_) * 1024), 16, 0, 0); \
    _Pragma("unroll") for (int q_ = 0; q_ < VP; ++q_) __builtin_amdgcn_global_load_lds((const unsigned*)(Vh + (size_t)(t) * 64 * 128 + vgo[q_]), (LAS unsigned*)(L + V_RING + (vs) * SHM_V + (wid * VP + q_) * 1024), 16, 0, 0); } while (0)
    const int NT = seq / 64;
    DMA_TILE(0, 0, 0); DMA_TILE(1, 1, 1);
    const bf16_t* Qw = Qb + (long)(wid * 32 + r32) * DQK + hi * 8;
#pragma unroll
    for (int d0 = 0; d0 < ND0; ++d0) qr[d0] = *reinterpret_cast<const bf16x8*>(Qw + d0 * 16);
    const int vb0 = (int)(uintptr_t)(lds + V_RING) + v_rd_base(lane);
    int kb[4];
#pragma unroll
    for (int m = 0; m < 4; ++m) { kb[m] = (int)(uintptr_t)(lds + K_RING) + r32 * (DQK * 2) + 16 * (hi ^ (r32 & 1)) + 32 * (m ^ ((r32 >> 1) & 3)); asm volatile("" : "+v"(kb[m])); }
#define RESC(a) do { if (__any((a) < 1.f)) { if (hi == 0) al_l[r32] = (a); asm volatile("s_waitcnt lgkmcnt(0)" ::: "memory"); \
    _Pragma("unroll") for (int d = 0; d < 4; ++d) _Pragma("unroll") for (int r = 0; r < 16; ++r) o[d][r] *= al_l[crow(r, hi)]; } } while (0)
#define STEP_SYNC(j) do { if ((j) + 1 < NT) { if constexpr (NP == 5) asm volatile("s_waitcnt vmcnt(5)" ::: "memory"); else asm volatile("s_waitcnt vmcnt(4)" ::: "memory"); } else asm volatile("s_waitcnt vmcnt(0)" ::: "memory"); \
    asm volatile("s_waitcnt lgkmcnt(0)" ::: "memory"); __builtin_amdgcn_s_barrier(); asm volatile("" ::: "memory"); } while (0)
    f32x16 pA0, pA1, pB0, pB1; float mnA, mnB, alA, alB; bf16x8 pa0, pa1, pa2, pa3;
    asm volatile("s_waitcnt vmcnt(0)" ::: "memory");
    asm volatile("s_waitcnt lgkmcnt(0)" ::: "memory"); __builtin_amdgcn_s_barrier(); asm volatile("" ::: "memory");
    if (2 < NT) DMA_TILE(2, 2, 2);
    qkt<DQK, ND0>(pA0, pA1, kb, 0, qr, 0, r32, hi); partialSM(pA0, pA1, m_reg, mnA, alA, SCALE);
    int ks = 1, vs = 0;
    for (int j = 1; j + 1 < NT; j += 2) {
        STEP_SYNC(j);
        if (j + 2 < NT) { const int ks2 = ks == 0 ? 2 : ks - 1, vs2 = (vs + 3) & 3; DMA_TILE(j + 2, ks2, vs2); }
        SBAR(); qkt<DQK, ND0>(pB0, pB1, kb, ks * SHM_K, qr, 0, r32, hi);
        finishSM(pA0, pA1, alA, l_reg, pa0, pa1, pa2, pa3); SBAR();
        pv_d0(o, vb0 + vs * SHM_V, pa0, pa1, pa2, pa3); partialSM(pB0, pB1, m_reg, mnB, alB, SCALE);
        RESC(alB);
        ks = ks == 2 ? 0 : ks + 1; vs = (vs + 1) & 3;
        STEP_SYNC(j + 1);
        if (j + 3 < NT) { const int ks2 = ks == 0 ? 2 : ks - 1, vs2 = (vs + 3) & 3; DMA_TILE(j + 3, ks2, vs2); }
        SBAR(); qkt<DQK, ND0>(pA0, pA1, kb, ks * SHM_K, qr, 0, r32, hi);
        finishSM(pB0, pB1, alB, l_reg, pa0, pa1, pa2, pa3); SBAR();
        pv_d0(o, vb0 + vs * SHM_V, pa0, pa1, pa2, pa3); partialSM(pA0, pA1, m_reg, mnA, alA, SCALE);
        RESC(alA);
        ks = ks == 2 ? 0 : ks + 1; vs = (vs + 1) & 3;
    }
    STEP_SYNC(NT - 1);
    SBAR(); qkt<DQK, ND0>(pB0, pB1, kb, ks * SHM_K, qr, 0, r32, hi);
    finishSM(pA0, pA1, alA, l_reg, pa0, pa1, pa2, pa3); SBAR();
    pv_d0(o, vb0 + vs * SHM_V, pa0, pa1, pa2, pa3); partialSM(pB0, pB1, m_reg, mnB, alB, SCALE);
    RESC(alB);
    vs = (vs + 1) & 3;
    finishSM(pB0, pB1, alB, l_reg, pa0, pa1, pa2, pa3); SBAR();
    pv_d0(o, vb0 + vs * SHM_V, pa0, pa1, pa2, pa3);
    if (hi == 0) li_l[r32] = l_reg; asm volatile("s_waitcnt lgkmcnt(0)" ::: "memory");
    float rli[16];
#pragma unroll
    for (int r = 0; r < 16; ++r) rli[r] = __builtin_amdgcn_rcpf(li_l[crow(r, hi)]);
    bf16_t* Ow = Ob + (long)(wid * 32) * ldo;
#pragma unroll
    for (int r = 0; r < 16; ++r) { const int orow = crow(r, hi);
#pragma unroll
        for (int d0 = 0; d0 < 4; ++d0) Ow[(long)orow * ldo + d0 * 32 + r32] = f2bf(o[d0][r] * rli[r]); }
    asm volatile("s_waitcnt lgkmcnt(0)" ::: "memory"); __builtin_amdgcn_s_barrier(); asm volatile("" ::: "memory");
#undef DMA_TILE
#undef RESC
#undef STEP_SYNC
}

constexpr int GL_V = 0;
constexpr int GL_K = 16384;
constexpr int GL_Q = GL_K + 9216;
constexpr int GL_ZF = GL_Q + 9216;
constexpr int GL_ZB = GL_ZF + 4096;
constexpr int GL_LF = GL_ZB + 4096;
constexpr int GL_LB = GL_LF + 16640;
constexpr int GL_X0 = GL_LB + 16640;
constexpr int GL_KEF = GL_X0, GL_KEB = GL_X0 + 9216;
constexpr int GL_QD = GL_X0, GL_KI = GL_X0 + 9216;
constexpr int GL_O = GL_X0 + 18432;
static_assert(GL_O + 64 * 132 * 4 <= 160 * 1024 - 256, "GLA LDS");
DI int gla_row0(int b, int c) { return c < 4 ? NLAT + b * CTXL + c * 64 : b * SEQ + (c - 4) * 64; }
DI void gla_prep(PR p, int l, char* lds, int b, int h, int c, bool needq) {
    const int tid = tid_here(), lane = tid & 63, wid = tid >> 6;
    const bf16_t* PR_ = (const bf16_t*)(p.ws + WS_U + U_PROJ);
    const int row0 = gla_row0(b, c);
    {
        const int t = tid >> 3, dg = (tid & 7) * 8; const bf16_t* pr = PR_ + (size_t)(row0 + t) * INWP;
        *(bf16x8*)(lds + GL_K + t * 144 + dg * 2) = *(const bf16x8*)(pr + C_GK + h * 64 + dg);
        if (needq) { const bf16x8 qv = *(const bf16x8*)(pr + C_GQ + h * 64 + dg); u32x4 w;
            w.x = pk2(bf2f((bf16_t)qv[0]) * 0.125f, bf2f((bf16_t)qv[1]) * 0.125f); w.y = pk2(bf2f((bf16_t)qv[2]) * 0.125f, bf2f((bf16_t)qv[3]) * 0.125f);
            w.z = pk2(bf2f((bf16_t)qv[4]) * 0.125f, bf2f((bf16_t)qv[5]) * 0.125f); w.w = pk2(bf2f((bf16_t)qv[6]) * 0.125f, bf2f((bf16_t)qv[7]) * 0.125f);
            *(u32x4*)(lds + GL_Q + t * 144 + dg * 2) = w; }
        const int sr = tid >> 4, sc = (tid & 15) * 8;
        *(bf16x8*)(lds + GL_V + v_st(sr, sc)) = *(const bf16x8*)(PR_ + (size_t)(row0 + sr) * INWP + C_GV + h * 128 + sc);
        *(bf16x8*)(lds + GL_V + v_st(32 + sr, sc)) = *(const bf16x8*)(PR_ + (size_t)(row0 + 32 + sr) * INWP + C_GV + h * 128 + sc);
        if (tid < 256) { const int tt = (tid & 127) >> 1, half = tid & 1, dir = tid >> 7; const bf16x8 zv = *(const bf16x8*)(PR_ + (size_t)(row0 + tt) * INWP + (dir ? C_ZB : C_ZF) + half * 8);
            float* Z = (float*)(lds + (dir ? GL_ZB : GL_ZF)) + tt * 16 + half * 8;
#pragma unroll
            for (int j = 0; j < 8; ++j) Z[j] = bf2f((bf16_t)zv[j]); }
    }
    float wf[16], wb[16];
#pragma unroll
    for (int r = 0; r < 16; ++r) { wf[r] = p.gla_wg2_f[((size_t)l * 16 + r) * 256 + h * 64 + lane]; wb[r] = p.gla_wg2_b[((size_t)l * 16 + r) * 256 + h * 64 + lane]; }
    const float bgf = p.gla_bg_f[l * 256 + h * 64 + lane], bgb = p.gla_bg_b[l * 256 + h * 64 + lane];
    __syncthreads();
#pragma unroll
    for (int i = 0; i < 8; ++i) {
        const int t = wid * 8 + i; const float* ZF = (const float*)(lds + GL_ZF) + t * 16; const float* ZB = (const float*)(lds + GL_ZB) + t * 16;
        float zf = bgf, zb = bgb;
#pragma unroll
        for (int r = 0; r < 16; ++r) { zf += ZF[r] * wf[r]; zb += ZB[r] * wb[r]; }
        const float lf = fminf(zf, 0.f) - __logf(1.f + __expf(-fabsf(zf))), lb = fminf(zb, 0.f) - __logf(1.f + __expf(-fabsf(zb)));
        ((float*)(lds + GL_LF))[t * 65 + lane] = lf * 0.0625f; ((float*)(lds + GL_LB))[t * 65 + lane] = lb * 0.0625f;
    }
    __syncthreads();
#pragma unroll
    for (int i = 0; i < 8; ++i) {
        const int d = wid * 8 + i;
        float* F = (float*)(lds + GL_LF) + lane * 65 + d; float* Bk = (float*)(lds + GL_LB) + lane * 65 + d;
        float f = *F, g = *Bk;
#pragma unroll
        for (int o = 1; o < 64; o <<= 1) {
            const float fu = __int_as_float(__builtin_amdgcn_ds_bpermute(((lane - o) & 63) << 2, __float_as_int(f)));
            const float gu = __int_as_float(__builtin_amdgcn_ds_bpermute(((lane + o) & 63) << 2, __float_as_int(g)));
            if (lane >= o) f += fu; if (lane + o < 64) g += gu;
        }
        *F = f; *Bk = g;
    }
    __syncthreads();
}
DI void gla_phaseA(PR p, int l, char* lds) {
    float* GS = (float*)(p.ws + WS_U + U_GS); float* GD = (float*)(p.ws + WS_GDEC);
    for (int u = bid_here(); u < 16 * 68; u += gridDim.x) {
        const int bh = u / 68, c = u % 68, b = bh >> 2, h = bh & 3;
        gla_prep(p, l, lds, b, h, c, false);
        const int tid = tid_here(), lane = tid & 63, wid = tid >> 6, r32 = lane & 31, hi = lane >> 5;
        {
            const float* LF = (const float*)(lds + GL_LF); const float* LB = (const float*)(lds + GL_LB);
            const float lastf = LF[63 * 65 + lane], lastb = LB[0 * 65 + lane];
            float ef[8], eb[8];
#pragma unroll
            for (int i = 0; i < 8; ++i) { const int t = wid * 8 + i; const float k = bf2f(*(const bf16_t*)(lds + GL_K + t * 144 + lane * 2));
                ef[i] = k * __expf(lastf - LF[t * 65 + lane]); eb[i] = k * __expf(lastb - LB[t * 65 + lane]); }
            u32x4 w; w.x = pk2(ef[0], ef[1]); w.y = pk2(ef[2], ef[3]); w.z = pk2(ef[4], ef[5]); w.w = pk2(ef[6], ef[7]); *(u32x4*)(lds + GL_KEF + lane * 144 + wid * 16) = w;
            w.x = pk2(eb[0], eb[1]); w.y = pk2(eb[2], eb[3]); w.z = pk2(eb[4], eb[5]); w.w = pk2(eb[6], eb[7]); *(u32x4*)(lds + GL_KEB + lane * 144 + wid * 16) = w;
            if (wid == 0) { GD[((size_t)(0 * 16 + bh) * 68 + c) * 64 + lane] = __expf(lastf); GD[((size_t)(1 * 16 + bh) * 68 + c) * 64 + lane] = __expf(lastb); }
        }
        __syncthreads();
        {
            const int rh = wid & 1, cb = wid >> 1;
            const int vb = (int)(uintptr_t)(lds + GL_V) + v_rd_base(lane) + cb * 512;
#pragma unroll
            for (int dir = 0; dir < 2; ++dir) {
                const char* KE = lds + (dir ? GL_KEB : GL_KEF) + (rh * 32 + r32) * 144 + hi * 16;
                const bf16x8 a0 = *(const bf16x8*)(KE), a1 = *(const bf16x8*)(KE + 32), a2 = *(const bf16x8*)(KE + 64), a3 = *(const bf16x8*)(KE + 96);
                f32x16 od;
#pragma unroll
                for (int r = 0; r < 16; ++r) od[r] = 0.f;
                pv_one<0>(od, vb, a0, a1, a2, a3);
                float* dst = GS + ((size_t)(dir * 16 + bh) * 68 + c) * 8192 + (size_t)(cb * 32 + r32) * 64 + rh * 32 + 4 * hi;
#pragma unroll
                for (int g = 0; g < 4; ++g) *(f32x4*)(dst + 8 * g) = (f32x4){od[4 * g], od[4 * g + 1], od[4 * g + 2], od[4 * g + 3]};
            }
        }
        __syncthreads();
    }
}
DI void gla_scan(PR p) {
    const float* GS = (const float*)(p.ws + WS_U + U_GS); const float* GD = (const float*)(p.ws + WS_GDEC); bf16_t* GST = (bf16_t*)(p.ws + WS_U + U_GST);
    const int tid = tid_here();
    for (int u = bid_here(); u < 128; u += gridDim.x) {
        const int e = u * NTHREADS + tid, db = e >> 11, jd4 = e & 2047, d4 = (jd4 & 15) * 4;
        const int dir = db >> 4;
        const float* base = GS + (size_t)db * 68 * 8192 + jd4 * 4; const float* dbase = GD + (size_t)db * 68 * 64 + d4; bf16_t* obase = GST + (size_t)db * 68 * 8192 + jd4 * 4;
#define SC_C(i) (dir == 0 ? (i) : ((i) < 4 ? 3 - (i) : 71 - (i)))
        float z0 = 0.f; asm volatile("" : "+v"(z0));
        f32x4 S = {z0, z0, z0, z0};
        f32x4 cur[4], nxt[4], dc[4], dn[4];
#pragma unroll
        for (int q = 0; q < 4; ++q) { const int c = SC_C(q); cur[q] = *(const f32x4*)(base + (size_t)c * 8192); dc[q] = *(const f32x4*)(dbase + c * 64); }
        for (int i = 0; i < 68; i += 4) {
            if (i + 4 < 68) {
#pragma unroll
                for (int q = 0; q < 4; ++q) { const int c = SC_C(i + 4 + q); nxt[q] = *(const f32x4*)(base + (size_t)c * 8192); dn[q] = *(const f32x4*)(dbase + c * 64); }
            }
#pragma unroll
            for (int q = 0; q < 4; ++q) { const int c = SC_C(i + q); u32x2 w; w.x = pk2(S[0], S[1]); w.y = pk2(S[2], S[3]); *(u32x2*)(obase + (size_t)c * 8192) = w; S = S * dc[q] + cur[q]; }
#pragma unroll
            for (int q = 0; q < 4; ++q) { cur[q] = nxt[q]; dc[q] = dn[q]; }
        }
#undef SC_C
    }
}
DI void gla_phaseC(PR p, int l, char* lds) {
    const bf16_t* GST = (const bf16_t*)(p.ws + WS_U + U_GST);
    const bf16_t* PR_ = (const bf16_t*)(p.ws + WS_U + U_PROJ); bf16_t* MIX = (bf16_t*)(p.ws + WS_U + U_MIX);
    for (int u = bid_here(); u < 16 * 68; u += gridDim.x) {
        const int bh = u / 68, c = u % 68, b = bh >> 2, h = bh & 3;
        if (l == 1 && c < 4) continue;
        gla_prep(p, l, lds, b, h, c, true);
        const int tid = tid_here(), lane = tid & 63, wid = tid >> 6, r32 = lane & 31, hi = lane >> 5, rh = wid & 1, cb = wid >> 1;
        const int vb = (int)(uintptr_t)(lds + GL_V) + v_rd_base(lane) + cb * 512;
        f32x16 o;
#pragma unroll
        for (int r = 0; r < 16; ++r) o[r] = 0.f;
#pragma unroll
        for (int dir = 0; dir < 2; ++dir) {
            {
                const int t = tid >> 3, dg = (tid & 7) * 8; const float* LC = (const float*)(lds + (dir ? GL_LB : GL_LF)) + t * 65 + dg;
                const bf16x8 qv = *(const bf16x8*)(lds + GL_Q + t * 144 + dg * 2), kv = *(const bf16x8*)(lds + GL_K + t * 144 + dg * 2);
                float qd[8], ki[8];
#pragma unroll
                for (int j = 0; j < 8; ++j) { const float bc = LC[j]; qd[j] = bf2f((bf16_t)qv[j]) * __expf(bc); ki[j] = bf2f((bf16_t)kv[j]) * __expf(-bc); }
                u32x4 w; w.x = pk2(qd[0], qd[1]); w.y = pk2(qd[2], qd[3]); w.z = pk2(qd[4], qd[5]); w.w = pk2(qd[6], qd[7]); *(u32x4*)(lds + GL_QD + t * 144 + dg * 2) = w;
                w.x = pk2(ki[0], ki[1]); w.y = pk2(ki[2], ki[3]); w.z = pk2(ki[4], ki[5]); w.w = pk2(ki[6], ki[7]); *(u32x4*)(lds + GL_KI + t * 144 + dg * 2) = w;
            }
            __syncthreads();
            {
                const char* QD = lds + GL_QD + (rh * 32 + r32) * 144 + hi * 16; const char* KI = lds + GL_KI + r32 * 144 + hi * 16;
                bf16x8 qf[4];
#pragma unroll
                for (int d0 = 0; d0 < 4; ++d0) qf[d0] = *(const bf16x8*)(QD + d0 * 32);
                f32x16 p0, p1;
#pragma unroll
                for (int r = 0; r < 16; ++r) { p0[r] = 0.f; p1[r] = 0.f; }
#pragma unroll
                for (int d0 = 0; d0 < 4; ++d0) {
                    const bf16x8 k0 = *(const bf16x8*)(KI + d0 * 32), k1 = *(const bf16x8*)(KI + 32 * 144 + d0 * 32);
                    p0 = __builtin_amdgcn_mfma_f32_32x32x16_bf16(k0, qf[d0], p0, 0, 0, 0);
                    p1 = __builtin_amdgcn_mfma_f32_32x32x16_bf16(k1, qf[d0], p1, 0, 0, 0);
                }
                const int tq = rh * 32 + r32;
#pragma unroll
                for (int r = 0; r < 16; ++r) { const int s0 = crow(r, hi), s1 = 32 + s0;
                    const bool ok0 = dir == 0 ? (s0 <= tq) : (s0 >= tq), ok1 = dir == 0 ? (s1 <= tq) : (s1 >= tq);
                    p0[r] = ok0 ? p0[r] : 0.f; p1[r] = ok1 ? p1[r] : 0.f; }
                bf16x8 pa0, pa1, pa2, pa3;
#define PK4(P, BASE, OUT) do { unsigned a0 = cvtpk(P[BASE + 0], P[BASE + 1]), a1 = cvtpk(P[BASE + 2], P[BASE + 3]);   \
    unsigned b0 = cvtpk(P[BASE + 4], P[BASE + 5]), b1 = cvtpk(P[BASE + 6], P[BASE + 7]);                              \
    auto r0 = __builtin_amdgcn_permlane32_swap(a0, b0, false, false); auto r1 = __builtin_amdgcn_permlane32_swap(a1, b1, false, false); \
    u32x4 w_ = {r0[0], r1[0], r0[1], r1[1]}; OUT = *reinterpret_cast<bf16x8*>(&w_); } while (0)
                PK4(p0, 0, pa0); PK4(p0, 8, pa1); PK4(p1, 0, pa2); PK4(p1, 8, pa3);
#undef PK4
                pv_one<0>(o, vb, pa0, pa1, pa2, pa3);
                const bf16_t* Sg = GST + ((size_t)(dir * 16 + bh) * 68 + c) * 8192 + (size_t)(cb * 32 + r32) * 64 + hi * 8;
                const bf16x8 s0 = *(const bf16x8*)(Sg), s1 = *(const bf16x8*)(Sg + 16), s2 = *(const bf16x8*)(Sg + 32), s3 = *(const bf16x8*)(Sg + 48);
                o = __builtin_amdgcn_mfma_f32_32x32x16_bf16(qf[0], s0, o, 0, 0, 0);
                o = __builtin_amdgcn_mfma_f32_32x32x16_bf16(qf[1], s1, o, 0, 0, 0);
                o = __builtin_amdgcn_mfma_f32_32x32x16_bf16(qf[2], s2, o, 0, 0, 0);
                o = __builtin_amdgcn_mfma_f32_32x32x16_bf16(qf[3], s3, o, 0, 0, 0);
            }
            __syncthreads();
        }
        { float* O = (float*)(lds + GL_O);
#pragma unroll
          for (int r = 0; r < 16; ++r) O[(rh * 32 + crow(r, hi)) * 132 + cb * 32 + r32] = o[r]; }
        __syncthreads();
        {
            const int t = tid >> 3, jg = (tid & 7) * 16; const float* O = (const float*)(lds + GL_O) + t * 132 + jg;
            float v[16], ss = 0.f;
#pragma unroll
            for (int q = 0; q < 4; ++q) { const f32x4 x = *(const f32x4*)(O + 4 * q); v[4 * q] = x[0]; v[4 * q + 1] = x[1]; v[4 * q + 2] = x[2]; v[4 * q + 3] = x[3]; ss += x[0] * x[0] + x[1] * x[1] + x[2] * x[2] + x[3] * x[3]; }
            ss += shx(ss, 1, lane); ss += shx(ss, 2, lane); ss += shx(ss, 4, lane);
            const float rstd = rsqrtf(ss * (1.f / 128.f) + EPS);
            const int row = gla_row0(b, c) + t;
            const bf16_t* gp = PR_ + (size_t)row * INWP + C_GG + h * 128 + jg; const float* go = p.gla_g_out + l * 128 + jg;
            const bf16x8 g0 = *(const bf16x8*)(gp), g1 = *(const bf16x8*)(gp + 8);
            float ov[16];
#pragma unroll
            for (int j = 0; j < 16; ++j) { const float gate = bf2f((bf16_t)(j < 8 ? g0[j] : g1[j - 8])); ov[j] = v[j] * rstd * go[j] * silu_f(gate); }
            u32x4 w0, w1; w0.x = pk2(ov[0], ov[1]); w0.y = pk2(ov[2], ov[3]); w0.z = pk2(ov[4], ov[5]); w0.w = pk2(ov[6], ov[7]); w1.x = pk2(ov[8], ov[9]); w1.y = pk2(ov[10], ov[11]); w1.z = pk2(ov[12], ov[13]); w1.w = pk2(ov[14], ov[15]);
            bf16_t* dst = MIX + (size_t)row * D + h * 128 + jg; *(u32x4*)(dst) = w0; *(u32x4*)(dst + 8) = w1;
        }
        __syncthreads();
    }
}

namespace pg {
constexpr int BK = 64, HALF = 128, HTB = HALF * BK * 2, STAGE_BYTES = 8 * HTB;
DI int lds_byte(int r, int c) { const int st = (r >> 4) * 2 + (c >> 5), rr = r & 15, cc = c & 31, ob = rr * 64 + cc * 2; return st * 1024 + (ob ^ (((ob >> 9) & 1) << 5)); }
DI int perm32(int rho) { const int n = rho >> 4, i = rho & 15; return 8 * (i >> 2) + 4 * n + (i & 3); }
DI void stage_rc(int b, int& R, int& C) { const int st = b / 1024, sb = b % 1024, swz = sb ^ (((sb >> 9) & 1) << 5); R = (st >> 1) * 16 + swz / 64; C = (st & 1) * 32 + (swz % 64) / 2; }
struct XUnit {
    const char* A;
    const char* B;
    int arow0;
    int list;
    int e0, e1, e2, e3;
};
template <class Sched>
DI void gemm_phase(LAS unsigned char* lds, const LAS int* rowlists, const Sched& S) {
    int tid = threadIdx.x; asm volatile("" : "+v"(tid));
    const int wid = __builtin_amdgcn_readfirstlane(tid >> 6), lane = tid & 63, wr = wid >> 2, wc = wid & 3, fr = lane & 15, fq = lane >> 4;
    const int K = S.K, nt = K / BK;
    unsigned voffB[2];
#pragma unroll
    for (int i = 0; i < 2; ++i) { int R_, C_; stage_rc(tid * 16 + i * 8192, R_, C_); if (Sched::PERM) R_ = (R_ & ~31) + perm32(R_ & 31); voffB[i] = (unsigned)R_ * (unsigned)S.ldb + (unsigned)C_ * 2u; }
    const size_t kstep = (size_t)(BK * 2), hstepB = (size_t)HALF * S.ldb;
    const unsigned ldsw = (unsigned)wid * 1024u;
    const int aoff = lds_byte(wr * 64 + fr, fq * 8), boff = lds_byte(wc * 32 + fr, fq * 8);
#define PG_SA(b, h) (((b) * 2 + (h)) * HTB)
#define PG_SB(b, h) ((4 + (b) * 2 + (h)) * HTB)
#define PG_STAGE(bufoff, gbase, voff) do { _Pragma("unroll") for (int _i = 0; _i < 2; ++_i) \
        __builtin_amdgcn_global_load_lds((const unsigned*)((const char*)(gbase) + (voff)[_i]), (LAS unsigned*)(lds + (bufoff) + ldsw + _i * 8192), 16, 0, 0); } while (0)
#define PG_LDA(dst, b, h) do { _Pragma("unroll") for (int m = 0; m < 4; ++m) _Pragma("unroll") for (int k = 0; k < 2; ++k) dst[m][k] = *(const LAS bf16x8*)(lds + PG_SA(b, h) + aoff + m * 2048 + k * 1024); } while (0)
#define PG_LDB(dst, b, h) do { _Pragma("unroll") for (int n = 0; n < 2; ++n) _Pragma("unroll") for (int k = 0; k < 2; ++k) dst[n][k] = *(const LAS bf16x8*)(lds + PG_SB(b, h) + boff + n * 2048 + k * 1024); } while (0)
#define PG_MMA(ai, bj, At, Bt) do { __builtin_amdgcn_s_setprio(1); _Pragma("unroll") for (int m = 0; m < 4; ++m) _Pragma("unroll") for (int n = 0; n < 2; ++n) _Pragma("unroll") for (int k = 0; k < 2; ++k) \
        acc[ai][bj][m][n] = __builtin_amdgcn_mfma_f32_16x16x32_bf16(Bt[n][k], At[m][k], acc[ai][bj][m][n], 0, 0, 0); __builtin_amdgcn_s_setprio(0); } while (0)
#define PG_WAIT_V(n) asm volatile("s_waitcnt vmcnt(" #n ")" ::: "memory")
#define PG_WAIT_L(n) asm volatile("s_waitcnt lgkmcnt(" #n ")" ::: "memory")
#define PG_BAR __builtin_amdgcn_s_barrier()
#define PG_SCHED __builtin_amdgcn_sched_barrier(0)
#define PG_AOFFS(dst, u) do { const int _t = tid_here(); _Pragma("unroll") for (int _i = 0; _i < 2; ++_i) { int _R, _C; stage_rc(_t * 16 + _i * 8192, _R, _C); _Pragma("unroll") for (int _h = 0; _h < 2; ++_h) { \
        unsigned _row; if ((u).list >= 0) { const int _x = rowlists[(u).list + _h * HALF + _R]; _row = _x >= 0 ? (unsigned)(_x >> S.rowshift) : 0u; } else _row = (unsigned)((u).arow0 + _h * HALF + _R); \
        dst[_h][_i] = _row * (unsigned)S.lda + (unsigned)_C * 2u; } } } while (0)
    XUnit cur, nxt; int ui = 0;
    if (!S.next(0, cur)) return;
    f32x4 acc[2][2][4][2];
#pragma unroll
    for (int a = 0; a < 2; ++a)
#pragma unroll
        for (int b = 0; b < 2; ++b)
#pragma unroll
            for (int m = 0; m < 4; ++m)
#pragma unroll
                for (int n = 0; n < 2; ++n) acc[a][b][m][n] = (f32x4){0.f, 0.f, 0.f, 0.f};
    bf16x8 At[4][2], B0[2][2], B1[2][2];
    unsigned ao[2][2];
    PG_AOFFS(ao, cur);
    PG_WAIT_L(0); PG_SCHED;
    const char* cA = cur.A; const char* cB = cur.B;
    PG_STAGE(PG_SB(0, 0), cB, voffB); PG_STAGE(PG_SA(0, 0), cA, ao[0]); PG_STAGE(PG_SB(0, 1), cB + hstepB, voffB); PG_STAGE(PG_SA(0, 1), cA, ao[1]);
    if (wr == 1) PG_BAR;
    PG_WAIT_V(4); PG_BAR;
    PG_STAGE(PG_SB(1, 0), cB + kstep, voffB); PG_STAGE(PG_SA(1, 0), cA + kstep, ao[0]); PG_STAGE(PG_SB(1, 1), cB + hstepB + kstep, voffB);
    PG_WAIT_V(6); PG_BAR;
    for (;;) {
        const bool has_next = S.next(ui + 1, nxt);
        const char* nA = has_next ? nxt.A : cA; const char* nB = has_next ? nxt.B : cB;
        for (int t = 0; t < nt; t += 2) {
            const bool last = (t == nt - 2);
            const char* a1 = cA + (size_t)(t + 1) * kstep;
            const char* a2 = last ? nA : cA + (size_t)(t + 2) * kstep; const char* b2 = last ? nB : cB + (size_t)(t + 2) * kstep;
            const char* a3 = a2 + kstep; const char* b3 = b2 + kstep;
            PG_LDB(B0, 0, 0); PG_SCHED; PG_LDA(At, 0, 0); PG_STAGE(PG_SA(1, 1), a1, ao[1]);
            PG_WAIT_L(8); PG_BAR; PG_WAIT_L(0); PG_MMA(0, 0, At, B0); PG_BAR; PG_SCHED;
            if (last && has_next) { PG_AOFFS(ao, nxt); }
            PG_LDB(B1, 0, 1); PG_STAGE(PG_SB(0, 0), b2, voffB);
            PG_BAR; PG_WAIT_L(0); PG_MMA(0, 1, At, B1); PG_BAR;
            PG_LDA(At, 0, 1); PG_STAGE(PG_SA(0, 0), a2, ao[0]);
            PG_BAR; PG_WAIT_L(0); PG_MMA(1, 0, At, B0); PG_BAR; PG_SCHED;
            PG_STAGE(PG_SB(0, 1), b2 + hstepB, voffB);
            PG_WAIT_V(6); PG_BAR; PG_MMA(1, 1, At, B1); PG_BAR;
            PG_LDB(B0, 1, 0); PG_SCHED; PG_LDA(At, 1, 0); PG_STAGE(PG_SA(0, 1), a2, ao[1]);
            PG_WAIT_L(8); PG_BAR; PG_WAIT_L(0); PG_MMA(0, 0, At, B0); PG_BAR; PG_SCHED;
            PG_LDB(B1, 1, 1); PG_STAGE(PG_SB(1, 0), b3, voffB);
            PG_BAR; PG_WAIT_L(0); PG_MMA(0, 1, At, B1); PG_BAR;
            PG_LDA(At, 1, 1); PG_STAGE(PG_SA(1, 0), a3, ao[0]);
            PG_BAR; PG_WAIT_L(0); PG_MMA(1, 0, At, B0); PG_BAR; PG_SCHED;
            PG_STAGE(PG_SB(1, 1), b3 + hstepB, voffB);
            PG_WAIT_V(6); PG_BAR; PG_MMA(1, 1, At, B1); PG_BAR;
        }
        { const int t2 = tid_here(), w2 = t2 >> 6, l2 = t2 & 63; S.epi(acc, cur, w2 >> 2, w2 & 3, l2 & 15, l2 >> 4); }
        if (!has_next) break;
#pragma unroll
        for (int a = 0; a < 2; ++a)
#pragma unroll
            for (int b = 0; b < 2; ++b)
#pragma unroll
                for (int m = 0; m < 4; ++m)
#pragma unroll
                    for (int n = 0; n < 2; ++n) acc[a][b][m][n] = (f32x4){0.f, 0.f, 0.f, 0.f};
        cur = nxt; cA = nA; cB = nB; ++ui;
    }
    PG_WAIT_V(0);
    if (wr == 0) PG_BAR;
    PG_BAR;
#undef PG_SA
#undef PG_SB
#undef PG_STAGE
#undef PG_LDA
#undef PG_LDB
#undef PG_MMA
#undef PG_WAIT_V
#undef PG_WAIT_L
#undef PG_BAR
#undef PG_SCHED
#undef PG_AOFFS
}
}

DI void phase_router(PR p, int l, char* lds, bool dry = false) {
    const int tid = tid_here(), wid = tid >> 6, lane = tid & 63;
    const unsigned char* wl = p.ws + WS_WEIGHTS + (size_t)l * WL_END;
    const bf16_t* WH = (const bf16_t*)(wl + WL_WRH); const bf16_t* WLo = (const bf16_t*)(wl + WL_WRL);
    const bf16_t* HH = (const bf16_t*)(p.ws + WS_HBUF); const bf16_t* HL = (const bf16_t*)(p.ws + WS_U + U_HLO);
    int* EIDX = (int*)(p.ws + WS_EIDX); float* EW = (float*)(p.ws + WS_EW); int* EPOS = (int*)(p.ws + WS_EPOS);
    unsigned* cnt = (unsigned*)(p.ws + WS_CNT) + l * 64;
    const float rbias = p.router_b[l * 64 + lane];
    float* LG = (float*)lds + wid * (16 * 65 + 16 * 64);
    int* PKI = (int*)(LG + 16 * 65);
    const int ntok = l == 0 ? NTOK : NLAT, ngrp = ntok / 16;
    const int fr = lane & 15, fq = lane >> 4;
    for (int gidx = bid_here() * 8 + wid; gidx < ngrp; gidx += gridDim.x * 8) {
        const int row0 = gidx * 16;
        f32x4 acc[4];
#pragma unroll
        for (int e = 0; e < 4; ++e) acc[e] = (f32x4){0.f, 0.f, 0.f, 0.f};
        const bf16_t* ah = HH + (size_t)(row0 + fr) * D + fq * 8; const bf16_t* al = HL + (size_t)(row0 + fr) * D + fq * 8;
        const bf16_t* bh = WH + (size_t)fr * D + fq * 8; const bf16_t* bl = WLo + (size_t)fr * D + fq * 8;
#pragma unroll 1
        for (int k0 = 0; k0 < D; k0 += 128) {
            bf16x8 a_hi[4], a_lo[4], b_hi[4][4], b_lo[4][4];
#pragma unroll
            for (int j = 0; j < 4; ++j) { a_hi[j] = *(const bf16x8*)(ah + k0 + 32 * j); if (ROUTER_SPLIT) a_lo[j] = *(const bf16x8*)(al + k0 + 32 * j);
#pragma unroll
                for (int e = 0; e < 4; ++e) { b_hi[j][e] = *(const bf16x8*)(bh + (size_t)e * 16 * D + k0 + 32 * j); if (ROUTER_SPLIT) b_lo[j][e] = *(const bf16x8*)(bl + (size_t)e * 16 * D + k0 + 32 * j); } }
#pragma unroll
            for (int j = 0; j < 4; ++j)
#pragma unroll
                for (int e = 0; e < 4; ++e) {
                    acc[e] = __builtin_amdgcn_mfma_f32_16x16x32_bf16(a_hi[j], b_hi[j][e], acc[e], 0, 0, 0);
                    if (ROUTER_SPLIT) { acc[e] = __builtin_amdgcn_mfma_f32_16x16x32_bf16(a_hi[j], b_lo[j][e], acc[e], 0, 0, 0);
                                        acc[e] = __builtin_amdgcn_mfma_f32_16x16x32_bf16(a_lo[j], b_hi[j][e], acc[e], 0, 0, 0); }
                }
        }
#pragma unroll
        for (int e = 0; e < 4; ++e)
#pragma unroll
            for (int i = 0; i < 4; ++i) LG[(fq * 4 + i) * 65 + e * 16 + fr] = acc[e][i];
        asm volatile("s_waitcnt lgkmcnt(0)" ::: "memory");
        __builtin_amdgcn_wave_barrier();
        int mycount = 0;
        for (int t = 0; t < 16; ++t) {
            const float sc = sigmoid_f(LG[t * 65 + lane]), v = sc + rbias;
            float m1 = v, m2 = -INFINITY;
#pragma unroll
            for (int o = 1; o < 8; o <<= 1) { const float b1 = shx(m1, o, lane), b2 = shx(m2, o, lane); const float n1 = fmaxf(m1, b1), n2 = fmaxf(fminf(m1, b1), fmaxf(m2, b2)); m1 = n1; m2 = n2; }
            const float gs = m1 + m2;
            int grank = 0; const int g = lane >> 3;
#pragma unroll
            for (int gg = 0; gg < 8; ++gg) { const float s = __int_as_float(__builtin_amdgcn_readlane(__float_as_int(gs), gg * 8)); grank += (s > gs || (s == gs && gg < g)) ? 1 : 0; }
            const bool gsel = grank < 4;
            const float vs = gsel ? v : -INFINITY;
            int erk = 0;
#pragma unroll 4
            for (int j = 0; j < 64; ++j) { const float s = __int_as_float(__builtin_amdgcn_readlane(__float_as_int(vs), j)); erk += (s > vs || (s == vs && j < lane)) ? 1 : 0; }
            const bool chosen = gsel && erk < 8;
            const float wsum = wave_sum(chosen ? sc : 0.f);
            int pk = -1;
            if (chosen) { const int a = (row0 + t) * 8 + erk; EIDX[a] = lane; EW[a] = sc * (2.5f / wsum); pk = erk | (mycount << 8); ++mycount; }
            PKI[t * 64 + lane] = pk;
        }
        const unsigned base = (mycount && !dry) ? atomicAdd(&cnt[lane], (unsigned)mycount) : 0u;
        if (!dry) {
#pragma unroll
            for (int t = 0; t < 16; ++t) { const int pk = PKI[t * 64 + lane]; if (pk >= 0) EPOS[(row0 + t) * 8 + (pk & 255)] = (int)base + (pk >> 8); }
        }
        asm volatile("s_waitcnt lgkmcnt(0)" ::: "memory");
        __builtin_amdgcn_wave_barrier();
    }
}
DI void phase_moe_index(PR p, int l, char* lds) {
    const int tid = tid_here();
    int* S = (int*)lds;
    const unsigned* cnt = (const unsigned*)(p.ws + WS_CNT) + l * 64;
    int* META = (int*)(p.ws + WS_META) + l * 1024;
    const int* EIDX = (const int*)(p.ws + WS_EIDX); const float* EW = (const float*)(p.ws + WS_EW); const int* EPOS = (const int*)(p.ws + WS_EPOS);
    int* SASG = (int*)(p.ws + WS_SASG); float* SW = (float*)(p.ws + WS_SW);
    if (tid < 64) S[128 + tid] = (int)cnt[tid];
    __syncthreads();
    if (tid == 0) { int s = 0; for (int e = 0; e < 64; ++e) { S[e] = s; s += (S[128 + e] + 255) / 256 * 256; } S[64] = s; }
    __syncthreads();
    const int ntok = l == 0 ? NTOK : NLAT;
    for (int a = bid_here() * NTHREADS + tid; a < ntok * 8; a += gridDim.x * NTHREADS) { const int e = EIDX[a], pos = S[e] + EPOS[a]; SASG[pos] = a; SW[pos] = EW[a]; }
    for (int i = bid_here() * NTHREADS + tid; i < 64 * 256; i += gridDim.x * NTHREADS) { const int e = i >> 8, q = i & 255, c = S[128 + e]; if (S[e] + c + q < S[e + 1]) { SASG[S[e] + c + q] = -1; SW[S[e] + c + q] = 0.f; } }
    if (blockIdx.x == 0) {
        if (tid == 0) META[0] = S[64] / 256;
        if (tid < 64) { for (int t = S[tid] / 256; t < S[tid + 1] / 256; ++t) META[256 + t] = tid; }
    }
}

struct OrderXcd {
    int nM, nN, nwg;
    DI void init(int nM_, int nN_) { nM = nM_; nN = nN_; nwg = nM_ * nN_; }
    DI bool map(int i, int& pm, int& pn) const {
        const int L = i * (int)gridDim.x + (int)blockIdx.x; if (L >= nwg) return false;
        int wgid = L; { const int q = nwg / 8, r = nwg % 8, xcd = wgid % 8, off = wgid / 8; wgid = (xcd < r ? xcd * (q + 1) : r * (q + 1) + (xcd - r) * q) + off; }
        const int nig = 8 * nN, gid = wgid / nig, fm = gid * 8, gsz = (nM - fm) < 8 ? (nM - fm) : 8;
        pm = fm + ((wgid % nig) % gsz); pn = (wgid % nig) / gsz; return true;
    }
    DI bool lin(int i, int& w) const {
        const int L = i * (int)gridDim.x + (int)blockIdx.x; if (L >= nwg) return false;
        const int q = nwg / 8, r = nwg % 8, xcd = L % 8, off = L / 8; w = (xcd < r ? xcd * (q + 1) : r * (q + 1) + (xcd - r) * q) + off; return true;
    }
};
#define GACC const f32x4 (&acc)[2][2][4][2]
struct SchedInproj {
    static constexpr bool PERM = true;
    int lda, ldb, K, rowshift; const char* A; const char* W; bf16_t* proj; OrderXcd o;
    DI bool next(int i, pg::XUnit& u) const { int pm, pn; if (!o.map(i, pm, pn)) return false; u.A = A; u.B = W + (size_t)pn * 256 * ldb; u.arow0 = pm * 256; u.list = -1; u.e0 = pm * 256; u.e1 = pn * 256; return true; }
    DI void epi(GACC, const pg::XUnit& u, int wr, int wc, int fr, int fq) const { EpiB16P E; E.O = proj; E.row0 = u.e0; E.col0 = u.e1; E.ld = INWP; E(acc, wr, wc, fr, fq); }
};
DI void phase_inproj(PR p, int l, char* lds) {
    SchedInproj S; S.lda = D * 2; S.ldb = D * 2; S.K = D; S.rowshift = 0; S.A = (const char*)(p.ws + WS_HBUF); S.W = (const char*)(p.ws + WS_WEIGHTS + (size_t)l * WL_END + WL_WIN);
    S.proj = (bf16_t*)(p.ws + WS_U + U_PROJ); S.o.init(68, 15);
    pg::gemm_phase((LAS unsigned char*)lds, (const LAS int*)(lds + pg::STAGE_BYTES), S);
}
struct SchedMlaUp {
    static constexpr bool PERM = false;
    int lda, ldb, K, rowshift; const char* CQ; const char* CKV; const char* WQ; const char* WKV; bf16_t* Qm; bf16_t* Km; bf16_t* Vm; const float2* ropem; OrderXcd o;
    DI bool next(int i, pg::XUnit& u) const { int w; if (!o.lin(i, w)) return false; u.list = -1;
        if (w < 340) { const int pm = w / 5, pn = w % 5; u.A = CQ; u.B = WQ + (size_t)pn * 256 * ldb; u.arow0 = pm * 256; u.e0 = pm * 256; u.e1 = pn * 256; u.e3 = 0; }
        else { const int v = w - 340, pm = v / 6, pn = v % 6; u.A = CKV; u.B = WKV + (size_t)pn * 256 * ldb; u.arow0 = pm * 256; u.e0 = pm * 256; u.e1 = pn * 256; u.e3 = 1; }
        return true; }
    DI void epi(GACC, const pg::XUnit& u, int wr, int wc, int fr, int fq) const {
        if (u.e3 == 0) { EpiUq E; E.Q = Qm; E.ropem = ropem; E.row0 = u.e0; E.col0 = u.e1; E(acc, wr, wc, fr, fq); }
        else { EpiUkv E; E.Km = Km; E.Vm = Vm; E.row0 = u.e0; E.col0 = u.e1; E(acc, wr, wc, fr, fq); } }
};
DI void phase_mla_up(PR p, int l, char* lds) {
    unsigned char* U = p.ws + WS_U; const unsigned char* wl = p.ws + WS_WEIGHTS + (size_t)l * WL_END;
    SchedMlaUp S; S.lda = 1024; S.ldb = 1024; S.K = 512; S.rowshift = 0; S.CQ = (const char*)(U + U_CQN); S.CKV = (const char*)(U + U_CKVN); S.WQ = (const char*)(wl + WL_WUQ); S.WKV = (const char*)(wl + WL_WUKV);
    S.Qm = (bf16_t*)(U + U_QM); S.Km = (bf16_t*)(U + U_KM); S.Vm = (bf16_t*)(U + U_VM); S.ropem = (const float2*)(p.ws + WS_ROPEM); S.o.init(748, 1);
    pg::gemm_phase((LAS unsigned char*)lds, (const LAS int*)(lds + pg::STAGE_BYTES), S);
}
struct SchedOutproj {
    static constexpr bool PERM = true;
    int lda, ldb, K, rowshift; const char* A; const char* W; bf16_t* Y; OrderXcd o;
    DI bool next(int i, pg::XUnit& u) const { int pm, pn; if (!o.map(i, pm, pn)) return false; u.A = A; u.B = W + (size_t)pn * 256 * ldb; u.arow0 = pm * 256; u.list = -1; u.e0 = pm * 256; u.e1 = pn * 256; return true; }
    DI void epi(GACC, const pg::XUnit& u, int wr, int wc, int fr, int fq) const { EpiB16P E; E.O = Y; E.row0 = u.e0; E.col0 = u.e1; E.ld = D; E(acc, wr, wc, fr, fq); }
};
DI void phase_outproj(PR p, int l, char* lds) {
    SchedOutproj S; S.lda = D * 2; S.ldb = D * 2; S.K = D; S.rowshift = 0; S.A = (const char*)(p.ws + WS_U + U_MIX); S.W = (const char*)(p.ws + WS_WEIGHTS + (size_t)l * WL_END + WL_WOUT);
    S.Y = (bf16_t*)(p.ws + WS_U + U_Y); S.o.init(l == 0 ? 68 : 64, 8);
    pg::gemm_phase((LAS unsigned char*)lds, (const LAS int*)(lds + pg::STAGE_BYTES), S);
}
struct SchedMoe1 {
    static constexpr bool PERM = true;
    int lda, ldb, K, rowshift; const char* H; const char* W13; bf16_t* act; const LAS int* uexp; int ntiles; OrderXcd o;
    DI bool next(int i, pg::XUnit& u) const { int tile, pn; if (!o.map(i, tile, pn)) return false; u.A = H;
        if (tile < ntiles) { const int e = __builtin_amdgcn_readfirstlane(uexp[i]); u.B = W13 + ((size_t)e * 1024 + pn * 256) * ldb; u.list = i * 256; u.arow0 = 0; u.e0 = tile * 256; }
        else { const int ts = tile - ntiles; u.B = W13 + ((size_t)64 * 1024 + pn * 256) * ldb; u.list = -1; u.arow0 = ts * 256; u.e0 = PMAX + ts * 256; }
        u.e1 = pn * 128; return true; }
    DI void epi(GACC, const pg::XUnit& u, int wr, int wc, int fr, int fq) const { EpiMoe1P E; E.act = act; E.arow0 = u.e0; E.hcol0 = u.e1; E(acc, wr, wc, fr, fq); }
};
DI void phase_moe1(PR p, int l, char* lds) {
    const int* META = (const int*)(p.ws + WS_META) + l * 1024; const int ntiles = __builtin_amdgcn_readfirstlane(META[0]), nsh = l == 0 ? 68 : 64;
    SchedMoe1 S; S.lda = D * 2; S.ldb = D * 2; S.K = D; S.rowshift = 3; S.H = (const char*)(p.ws + WS_HBUF); S.W13 = (const char*)(p.ws + WS_WEIGHTS + (size_t)l * WL_END + WL_W13);
    S.act = (bf16_t*)(p.ws + WS_U + U_ACT); S.uexp = (const LAS int*)(lds + pg::STAGE_BYTES) + 31 * 256; S.ntiles = ntiles; S.o.init(ntiles + nsh, 4);
    { const int tid = tid_here(); LAS int* RL = (LAS int*)(lds + pg::STAGE_BYTES); const int* SASG = (const int*)(p.ws + WS_SASG);
      for (int i = 0; i < 31; ++i) { int tile, pn; if (!S.o.map(i, tile, pn)) break; if (tile < ntiles && tid < 256) RL[i * 256 + tid] = SASG[tile * 256 + tid];
          if (tid == 0) RL[31 * 256 + i] = tile < ntiles ? META[256 + tile] : 64; }
      __syncthreads(); }
    pg::gemm_phase((LAS unsigned char*)lds, (const LAS int*)(lds + pg::STAGE_BYTES), S);
}
struct SchedMoe2 {
    static constexpr bool PERM = true;
    int lda, ldb, K, rowshift; const char* ACT; const char* W2; bf16_t* oasg; const int* sasg; const float* sw; bf16_t* ysh; const LAS int* uexp; int ntiles; int fp8; OrderXcd o;
    DI bool next(int i, pg::XUnit& u) const { int tile, pn; if (!o.map(i, tile, pn)) return false; u.A = ACT; u.list = -1;
        if (tile < ntiles) { const int e = __builtin_amdgcn_readfirstlane(uexp[i]); u.B = W2 + ((size_t)e * D + pn * 256) * ldb; u.arow0 = tile * 256; u.e0 = tile * 256; u.e3 = 0; }
        else { const int ts = tile - ntiles; u.B = W2 + ((size_t)64 * D + pn * 256) * ldb; u.arow0 = PMAX + ts * 256; u.e0 = ts * 256; u.e3 = 1; }
        u.e1 = pn * 256; return true; }
    DI void epi(GACC, const pg::XUnit& u, int wr, int wc, int fr, int fq) const {
        if (u.e3 == 0 && fp8) { EpiMoe2F8 E; E.oasg = (unsigned char*)oasg; E.sasg = sasg; E.sw = sw; E.srow0 = u.e0; E.col0 = u.e1; E(acc, wr, wc, fr, fq); }
        else if (u.e3 == 0) { EpiMoe2P E; E.oasg = oasg; E.sasg = sasg; E.sw = sw; E.srow0 = u.e0; E.col0 = u.e1; E(acc, wr, wc, fr, fq); }
        else { EpiB16P E; E.O = ysh; E.row0 = u.e0; E.col0 = u.e1; E.ld = D; E(acc, wr, wc, fr, fq); } }
};
DI void phase_moe2(PR p, int l, char* lds) {
    const int* META = (const int*)(p.ws + WS_META) + l * 1024; const int ntiles = __builtin_amdgcn_readfirstlane(META[0]), nsh = l == 0 ? 68 : 64;
    SchedMoe2 S; S.lda = 1024; S.ldb = 1024; S.K = 512; S.rowshift = 0; S.ACT = (const char*)(p.ws + WS_U + U_ACT); S.W2 = (const char*)(p.ws + WS_WEIGHTS + (size_t)l * WL_END + WL_W2);
    S.oasg = (bf16_t*)(p.ws + WS_U + U_OASG); S.sasg = (const int*)(p.ws + WS_SASG); S.sw = (const float*)(p.ws + WS_SW); S.ysh = (bf16_t*)(p.ws + WS_U + U_YSH); S.uexp = (const LAS int*)(lds + pg::STAGE_BYTES); S.ntiles = ntiles; S.fp8 = (OASG_FP8_MASK >> l) & 1; S.o.init(ntiles + nsh, 8);
    { const int tid = tid_here(); LAS int* UE = (LAS int*)(lds + pg::STAGE_BYTES);
      if (tid < 64) { int tile, pn; if (S.o.map(tid, tile, pn)) UE[tid] = tile < ntiles ? META[256 + tile] : 64; }
      __syncthreads(); }
    pg::gemm_phase((LAS unsigned char*)lds, (const LAS int*)(lds + pg::STAGE_BYTES), S);
}
DI void phase_attention(PR p, int l, char* lds) {
#define ATT_PTRS unsigned char* U = p.ws + WS_U; asm volatile("" : "+s"(U)); \
    const bf16_t* Qm = (const bf16_t*)(U + U_QM); const bf16_t* Km = (const bf16_t*)(U + U_KM); const bf16_t* Vm = (const bf16_t*)(U + U_VM); \
    const bf16_t* Qg = (const bf16_t*)(U + U_QG); const bf16_t* Kg = (const bf16_t*)(U + U_KG); const bf16_t* Vg = (const bf16_t*)(U + U_VG); bf16_t* MIX = (bf16_t*)(U + U_MIX);
    const int xcd = blockIdx.x & 7, rank = blockIdx.x >> 3, nr = (gridDim.x + 7 - xcd) >> 3;
    const int nloc = 48 + (l == 0 ? 3 : 0);
    if (SUB & 1) for (int v = rank; v < nloc; v += nr) {
        ATT_PTRS; (void)Qg; (void)Kg; (void)Vg;
        int b, h, qt, isctx;
        if (v < 48) { const int bh = xcd * 3 + v / 16; b = bh / 6; h = bh % 6; qt = v & 15; isctx = 0; } else { const int bh = xcd * 3 + (v - 48); b = bh / 6; h = bh % 6; qt = 0; isctx = 1; }
        const int qpos = isctx ? 0 : CTXL + qt * 256, seq = isctx ? CTXL : SKV, orow = isctx ? NLAT + b * CTXL : b * SEQ + qt * 256;
        ATT_BODY<192>(Qm + (((size_t)b * 6 + h) * SKV + qpos) * 192, Km + ((size_t)b * 6 + h) * SKV * 192, Vm + ((size_t)b * 6 + h) * SKV * 128,
                                 MIX + (size_t)orow * D + 512 + h * 128, D, seq, lds, 0.07216878364870322f);
    }
    if (SUB & 2) for (int v = nr - 1 - rank; v < nloc; v += nr) {
        ATT_PTRS; (void)Qm; (void)Km; (void)Vm;
        int b, h, qt, isctx; const int kvh = xcd & 1; b = xcd >> 1;
        if (v < 48) { h = kvh * 3 + v / 16; qt = v & 15; isctx = 0; } else { h = kvh * 3 + (v - 48); qt = 0; isctx = 1; }
        const int qpos = isctx ? 0 : CTXL + qt * 256, seq = isctx ? CTXL : SKV, orow = isctx ? NLAT + b * CTXL : b * SEQ + qt * 256;
        ATT_BODY<128>(Qg + (((size_t)b * 6 + h) * SKV + qpos) * 128, Kg + ((size_t)b * 2 + kvh) * SKV * 128, Vg + ((size_t)b * 2 + kvh) * SKV * 128,
                                 MIX + (size_t)orow * D + 1280 + h * 128, D, seq, lds, 0.08838834764831845f);
    }
#undef ATT_PTRS
    if (SUB & 4) gla_phaseC(p, l, lds);
}

constexpr int NPH_LAYER = 12, NPH = 1 + 2 * NPH_LAYER;
constexpr int LDS_BYTES = 160 * 1024;
__global__ void __launch_bounds__(NTHREADS, 2) fwd(Params p_arg, int ph_lo, int ph_hi) {
    char* lds = shm + 256;
    volatile LAS unsigned* xbw = (volatile LAS unsigned*)shm;
    const bool fused = (ph_hi - ph_lo) > 1;
    XcdBarrier bar; bar.bar = (unsigned*)(p_arg.ws + WS_BAR); bar.x = 0; bar.st = xbw;
    if (fused) {
        if (threadIdx.x == 0) { xbw[0] = 0u; xbw[1] = 0u; xbw[2] = 0u; xbw[3] = 0u; }
        __syncthreads();
        bar = xcd_barrier_post((unsigned*)(p_arg.ws + WS_BAR), xbw);
    }
    const CAS Params* pk = (const CAS Params*)__builtin_amdgcn_kernarg_segment_ptr();
#define PHASE(idx, CALL) do { if (((PH_MASK >> ((idx) == 0 ? 0 : ((idx) - 1) % NPH_LAYER + 1)) & 1) && (idx) >= ph_lo && (idx) < ph_hi) { const CAS Params* q_ = pk; asm volatile("" : "+s"(q_)); PR p = *q_; int probe_pass = 0; (void)probe_pass; CALL; if ((PROBE_MASK >> ((idx) == 0 ? 0 : ((idx) - 1) % NPH_LAYER + 1)) & 1) { probe_pass = 1; CALL; } if (fused && (idx) + 1 < ph_hi) xcd_barrier(bar); } } while (0)
#define TAIL(ph) ((fused && !probe_pass) ? fill_tail(p, lds, (ph)) : (void)0)
    PHASE(0, phase_prologue(p, lds));
    for (int l = 0; l < 2; ++l) {
        const int b0 = 1 + l * NPH_LAYER;
        if (l == 0) PHASE(b0 + 0, phase_norm1(p, 0));
        PHASE(b0 + 1, phase_inproj(p, l, lds));
        PHASE(b0 + 2, (phase_postproj_rows(p, l), gla_phaseA(p, l, lds)));
        PHASE(b0 + 3, (phase_mla_up(p, l, lds), gla_scan(p)));
        PHASE(b0 + 4, (phase_attention(p, l, lds), TAIL(b0 + 4)));
        PHASE(b0 + 5, phase_outproj(p, l, lds));
        PHASE(b0 + 6, ((probe_pass && l == 1) ? (void)0 : phase_postmix(p, l)));
        PHASE(b0 + 7, phase_router(p, l, lds, probe_pass != 0));
        PHASE(b0 + 8, (phase_moe_index(p, l, lds), fill_drain(p, lds, (l + 1) * CHUNKS_PER_LAYER)));
        PHASE(b0 + 9, (move_head(p, (l + 1) * CHUNKS_PER_LAYER), phase_moe1(p, l, lds), TAIL(b0 + 9)));
        PHASE(b0 + 10, (phase_moe2(p, l, lds), TAIL(b0 + 10)));
        PHASE(b0 + 11, ((probe_pass && l == 0) ? (void)0 : phase_postffn(p, l)));
    }
#undef PHASE
#undef TAIL
}

extern "C" void kernel_launch(void* const* d_in, const int* in_sizes, int n_in, void* d_out, int out_size, void* d_ws, size_t ws_size, hipStream_t stream) {
    static int grid = 0;
    if (!grid) {
        if (ws_size < WS_TOTAL) { fprintf(stderr, "kernel_launch: workspace too small: %zu < %zu\n", ws_size, (size_t)WS_TOTAL); return; }
        if (hipFuncSetAttribute((const void*)fwd, hipFuncAttributeMaxDynamicSharedMemorySize, LDS_BYTES) != hipSuccess) { fprintf(stderr, "kernel_launch: hipFuncSetAttribute failed\n"); return; }
        int dev = 0, cus = 0, per_cu = 0;
        hipGetDevice(&dev);
        hipDeviceGetAttribute(&cus, hipDeviceAttributeMultiprocessorCount, dev);
        hipOccupancyMaxActiveBlocksPerMultiprocessor(&per_cu, fwd, NTHREADS, LDS_BYTES);
        if (per_cu < 1) { fprintf(stderr, "kernel_launch: occupancy query says %d\n", per_cu); return; }
        grid = cus;
    }
    Params p{};
    const float** f = (const float**)&p;
    for (int i = 0; i < 31; ++i) f[i] = (const float*)d_in[i];
    p.out = (float*)d_out; p.ws = (unsigned char*)d_ws;
    hipMemsetAsync((unsigned char*)d_ws + WS_BAR, 0, WS_CNT, stream);
#if MK_MULTI
    for (int ph = 0; ph < NPH; ++ph) { if (ph == 1 + NPH_LAYER) continue; hipLaunchKernelGGL(fwd, dim3(grid), dim3(NTHREADS), LDS_BYTES, stream, p, ph, ph + 1); }
#else
    hipLaunchKernelGGL(fwd, dim3(grid), dim3(NTHREADS), LDS_BYTES, stream, p, 0, NPH);
#endif
    const hipError_t le = hipPeekAtLastError();
    if (le != hipSuccess) fprintf(stderr, "kernel_launch: launch failed: %s\n", hipGetErrorName(le));
}
```

```cpp
#include <hip/hip_runtime.h>
#include <stdint.h>
#include <stdio.h>

#ifndef PH_MASK
#define PH_MASK 0x1FFF
#endif
#ifndef SUB
#define SUB 7
#endif
#ifndef ATT_SD_M
#define ATT_SD_M 1
#endif
#ifndef ATT_SD_G
#define ATT_SD_G 2
#endif
#ifndef ATT_NQR_M
#define ATT_NQR_M 12
#endif
#ifndef PROBE_MASK
#define PROBE_MASK 0x0
#endif
#ifndef ATT_DMA
#define ATT_DMA 1
#endif
#if ATT_DMA
#define ATT_BODY attn_body2
#else
#define ATT_BODY attn_body_old
#endif
#ifndef ROUTER_SPLIT
#define ROUTER_SPLIT 0
#endif
#ifndef FUSE_ROUTER
#define FUSE_ROUTER 0
#endif
#ifndef MK_MULTI
#define MK_MULTI 0
#endif

typedef unsigned short bf16_t;
typedef short bf16x8 __attribute__((ext_vector_type(8)));
typedef short s16x4 __attribute__((ext_vector_type(4)));
typedef float f32x4 __attribute__((ext_vector_type(4)));
typedef float f32x16 __attribute__((ext_vector_type(16)));
typedef unsigned u32x4 __attribute__((ext_vector_type(4)));
typedef unsigned u32x2 __attribute__((ext_vector_type(2)));
#define DI __device__ __forceinline__

constexpr int D = 2048, NB = 4, SEQ = 4096, CTXL = 256, NLAT = NB * SEQ, NCTX = NB * CTXL, NTOK = NLAT + NCTX, SKV = SEQ + CTXL;
constexpr int INW = 3808, INWP = 3840;
constexpr int C_GQ = 0, C_GK = 256, C_GV = 512, C_GG = 1024, C_ZF = 1536, C_ZB = 1552, C_CQ = 1568, C_CKV = 1952, C_KR = 2464, C_AQ = 2528, C_AK = 3296, C_AV = 3552;
constexpr int NE = 64, TOPK = 8, DEXP = 512;
constexpr int PMAX = NTOK * TOPK + NE * 256;
constexpr int NTHREADS = 512;
constexpr float EPS = 1e-6f;

constexpr size_t MiB = 1024ull * 1024ull;
constexpr size_t al256(size_t x) { return (x + 255) / 256 * 256; }
constexpr size_t WS_BAR = 0;
constexpr size_t WS_CTL = 16384;
constexpr size_t WS_CNT = 16384 + 8192;
constexpr size_t WS_META = WS_CNT + 1024;
constexpr size_t WS_MOD = WS_META + 2 * 4096;
constexpr size_t WS_ROPEG = al256(WS_MOD + 2 * 5 * 12288 * 4);
constexpr size_t WS_ROPEM = WS_ROPEG + 64 * 32 * 8;
constexpr size_t WS_ZROW = WS_ROPEM + 64 * 16 * 8;
constexpr size_t WS_GDEC = WS_ZROW + 4096;
constexpr size_t WS_EIDX = al256(WS_GDEC + 2 * 16 * 68 * 64 * 4);
constexpr size_t WS_EW = WS_EIDX + (size_t)NTOK * 8 * 4;
constexpr size_t WS_EPOS = WS_EW + (size_t)NTOK * 8 * 4;
constexpr size_t WS_SASG = WS_EPOS + (size_t)NTOK * 8 * 4;
constexpr size_t WS_SW = al256(WS_SASG + (size_t)PMAX * 4);
constexpr size_t WS_SMALL_END = al256(WS_SW + (size_t)PMAX * 4);
static_assert(WS_SMALL_END <= 8 * MiB, "small region");
constexpr size_t SZ_WIN = (size_t)INWP * D * 2, SZ_WUQ = (size_t)1280 * 512 * 2, SZ_WUKV = (size_t)1536 * 512 * 2, SZ_WOUT = (size_t)D * D * 2, SZ_WR = (size_t)64 * D * 2;
constexpr size_t SZ_W13 = (size_t)65 * 1024 * D * 2, SZ_W2 = (size_t)65 * D * 512 * 2;
constexpr size_t WL_WIN = 0, WL_WUQ = WL_WIN + SZ_WIN, WL_WUKV = WL_WUQ + SZ_WUQ, WL_WOUT = WL_WUKV + SZ_WUKV, WL_WRH = WL_WOUT + SZ_WOUT, WL_WRL = WL_WRH + SZ_WR,
                 WL_W13 = WL_WRL + SZ_WR, WL_W2 = WL_W13 + SZ_W13, WL_END = WL_W2 + SZ_W2;
constexpr size_t WS_WEIGHTS = 8 * MiB;
constexpr size_t WS_XRES = WS_WEIGHTS + 2 * WL_END;
constexpr size_t WS_HBUF = WS_XRES + (size_t)NTOK * D * 4;
constexpr size_t WS_U = WS_HBUF + (size_t)NTOK * D * 2;
constexpr size_t U_Y = 0;
constexpr size_t U_YSH = (size_t)NTOK * D * 2;
constexpr size_t U_PROJ = U_Y + (size_t)NTOK * D * 4;
constexpr size_t U_QM = U_PROJ + (size_t)NTOK * INWP * 2;
constexpr size_t U_KM = U_QM + (size_t)NB * 6 * SKV * 192 * 2;
constexpr size_t U_VM = U_KM + (size_t)NB * 6 * SKV * 192 * 2;
constexpr size_t U_QG = U_VM + (size_t)NB * 6 * SKV * 128 * 2;
constexpr size_t U_KG = U_QG + (size_t)NB * 6 * SKV * 128 * 2;
constexpr size_t U_VG = U_KG + (size_t)NB * 2 * SKV * 128 * 2;
constexpr size_t U_GS = U_VG + (size_t)NB * 2 * SKV * 128 * 2;
constexpr size_t U_MIX = U_GS + (size_t)2 * 16 * 68 * 64 * 128 * 4;
constexpr size_t U_CQN = U_MIX + (size_t)NTOK * D * 2;
constexpr size_t U_CKVN = U_CQN + (size_t)NTOK * 512 * 2;
constexpr size_t U_GST = U_CKVN + (size_t)NTOK * 512 * 2;
constexpr size_t U_MIX_END = U_GST + (size_t)2 * 16 * 68 * 8192 * 2;
constexpr size_t U_HLO = U_PROJ;
constexpr size_t U_ACT = U_HLO + (size_t)NTOK * D * 2;
constexpr size_t U_OASG = U_ACT + (size_t)(PMAX + NTOK) * 512 * 2;
constexpr size_t U_MOE_END = U_OASG + (size_t)NTOK * 8 * D * 2;
constexpr size_t WS_TOTAL = WS_U + (U_MIX_END > U_MOE_END ? U_MIX_END : U_MOE_END);
static_assert(WS_TOTAL <= 2048ull * MiB, "workspace over 2 GiB");

struct Params {
    const float *x, *c, *ctx, *c_ctx, *w_mod, *b_mod, *g_pre_mix, *g_post_mix, *g_pre_ffn, *g_post_ffn, *w_in, *gla_wg2_f, *gla_bg_f, *gla_wg2_b, *gla_bg_b, *gla_g_out,
        *mla_g_q, *mla_w_uq, *mla_g_kv, *mla_w_ukv, *gqa_g_q, *gqa_g_k, *w_out, *router_w, *router_b, *exp_w1, *exp_w3, *exp_w2, *sh_w1, *sh_w3, *sh_w2;
    float* out; unsigned char* ws;
};

extern __shared__ __attribute__((aligned(16))) char shm[];
#define CAS __attribute__((address_space(4)))
typedef const CAS Params& PR;
DI int bid_here() { int b = blockIdx.x; asm volatile("" : "+s"(b)); return b; }
DI int tid_here() { int t = threadIdx.x; asm volatile("" : "+v"(t)); return t; }
DI float bf2f(bf16_t v) { return __uint_as_float(((unsigned)v) << 16); }
DI bf16_t f2bf(float f) { unsigned u = __float_as_uint(f); u += 0x7FFFu + ((u >> 16) & 1u); return (bf16_t)(u >> 16); }
DI unsigned pk2(float lo, float hi) { unsigned r; asm("v_cvt_pk_bf16_f32 %0, %1, %2" : "=v"(r) : "v"(lo), "v"(hi)); return r; }
DI float shx(float v, int o, int lane) { return __int_as_float(__builtin_amdgcn_ds_bpermute((lane ^ o) << 2, __float_as_int(v))); }
#define DPP_ADD(v, ctrl) (v) += __int_as_float(__builtin_amdgcn_update_dpp(0, __float_as_int(v), (ctrl), 0xF, 0xF, true))
DI float wave_sum(float v) {
    const int lane = tid_here() & 63;
    DPP_ADD(v, 0xB1);
    DPP_ADD(v, 0x4E);
    DPP_ADD(v, 0x141);
    DPP_ADD(v, 0x140);
    v += shx(v, 16, lane);
    { auto rr = __builtin_amdgcn_permlane32_swap(__float_as_uint(v), __float_as_uint(v), false, false); v = __uint_as_float(rr[0]) + __uint_as_float(rr[1]); }
    return v;
}
DI float silu_f(float v) { return v / (1.f + __expf(-v)); }
DI float sigmoid_f(float v) { return 1.f / (1.f + __expf(-v)); }
struct Tok { int b, s, isctx, mrow, kvpos; };
DI Tok tok_of(int r) { Tok t; if (r < NLAT) { t.b = r >> 12; t.s = r & 4095; t.isctx = 0; t.mrow = t.b; t.kvpos = CTXL + t.s; } else { const int q = r - NLAT; t.b = q >> 8; t.s = q & 255; t.isctx = 1; t.mrow = 4; t.kvpos = t.s; } return t; }
DI const float* xrow_in(PR p, int l, int r) { if (l == 0) return r < NLAT ? p.x + (size_t)r * D : p.ctx + (size_t)(r - NLAT) * D; return (const float*)(p.ws + WS_XRES) + (size_t)r * D; }

#define XB_TMO      128
#define XB_XCNT(j)  (256  + 64 * (j))
#define XB_XSUB(j)  (1280 + 64 * (j))
#define XB_XGEN(j)  (2304 + 64 * (j))
#define XB_TOP      3328
#define XB_TOPGEN   3392
#define XCD_BAR_WORDS 3456
#define XB_SPIN_CAP (1u << 18)
#define LAS __attribute__((address_space(3)))
__device__ __forceinline__ unsigned xb_ld(unsigned* p)              { return __hip_atomic_load(p, __ATOMIC_RELAXED, __HIP_MEMORY_SCOPE_AGENT); }
__device__ __forceinline__ unsigned xb_add(unsigned* p, unsigned v) { return __hip_atomic_fetch_add(p, v, __ATOMIC_RELAXED, __HIP_MEMORY_SCOPE_AGENT); }
__device__ __forceinline__ unsigned xb_xcc_id() { return (unsigned)__builtin_amdgcn_s_getreg((3 << 11) | 20) & 0xFu; }
#define XB_SPIN(cond, bar) do { unsigned _sp = 0; while (cond) { __builtin_amdgcn_s_sleep(1); \
    if ((++_sp & 255u) == 0u) { if (xb_ld(&(bar)[XB_TMO])) break; if (_sp > XB_SPIN_CAP) { atomicAdd(&(bar)[XB_TMO], 1u); break; } } } } while (0)
struct XcdBarrier { unsigned* bar; unsigned x; volatile LAS unsigned* st; };
__device__ __forceinline__ XcdBarrier xcd_barrier_post(unsigned* bar, volatile LAS unsigned* st) {
    XcdBarrier b; b.bar = bar; b.x = xb_xcc_id(); b.st = st;
    if (threadIdx.x == 0) (void)xb_add(&bar[XB_XCNT(b.x)], 1u);
    return b;
}
__device__ __forceinline__ void xcd_barrier_complete(unsigned* bar, unsigned x, unsigned& nloc, unsigned& nx) {
    const unsigned G = gridDim.x * gridDim.y * gridDim.z;
    unsigned sum, cnt, mine, sp = 0u;
    for (;;) {
        sum = 0u; cnt = 0u; mine = 0u;
#pragma unroll
        for (unsigned j = 0; j < 16; ++j) { const unsigned c = xb_ld(&bar[XB_XCNT(j)]); sum += c; cnt += (c > 0u) ? 1u : 0u; mine = (j == x) ? c : mine; }
        if (sum == G) break;
        __builtin_amdgcn_s_sleep(1);
        if ((++sp & 255u) == 0u) { if (xb_ld(&bar[XB_TMO])) break; if (sp > XB_SPIN_CAP) { atomicAdd(&bar[XB_TMO], 1u); break; } }
    }
    nloc = mine > 0u ? mine : 1u; nx = cnt > 0u ? cnt : 1u;
}
__device__ __forceinline__ void xcd_barrier(const XcdBarrier& b) {
    asm volatile("s_waitcnt vmcnt(0)" ::: "memory");
    __syncthreads();
    if (threadIdx.x == 0) {
        unsigned* bar = b.bar;
        __builtin_amdgcn_s_waitcnt(0);
        unsigned nloc = b.st[0], nx = b.st[1];
        if (nloc == 0u) { xcd_barrier_complete(bar, b.x, nloc, nx); b.st[0] = nloc; b.st[1] = nx; }
        const unsigned old = xb_add(&bar[XB_XSUB(b.x)], 1u);
        const unsigned gen = old / nloc;
        if (old + 1u == (gen + 1u) * nloc) {
            __builtin_amdgcn_fence(__ATOMIC_RELEASE, "agent");
            asm volatile("s_waitcnt vmcnt(0)" ::: "memory");
            const unsigned og = xb_add(&bar[XB_TOP], 1u);
            const unsigned tg = og / nx;
            if (og + 1u == (tg + 1u) * nx) xb_add(&bar[XB_TOPGEN], 1u);
            else XB_SPIN(xb_ld(&bar[XB_TOPGEN]) == tg, bar);
            __builtin_amdgcn_fence(__ATOMIC_ACQUIRE, "agent");
            xb_add(&bar[XB_XGEN(b.x)], 1u);
            asm volatile("s_waitcnt vmcnt(0)" ::: "memory");
        } else {
            XB_SPIN(xb_ld(&bar[XB_XGEN(b.x)]) == gen, bar);
            __builtin_amdgcn_fence(__ATOMIC_ACQUIRE, "agent");
            asm volatile("s_waitcnt vmcnt(0)" ::: "memory");
        }
    }
    __syncthreads();
}

template <int KT>
DI void cvt_tile(char* lds, const float* src, int ldS, int Nvalid, bf16_t* dst, bf16_t* dst_lo, int ldD, int k0, int n0, int drow0, const float* gk) {
    float* T = (float*)lds;
    const int tid = tid_here();
    {
        const int c4 = tid & 15, kr = tid >> 4, n = n0 + c4 * 4;
        f32x4 v[KT / 32];
#pragma unroll
        for (int i = 0; i < KT / 32; ++i) { v[i] = (f32x4){0.f, 0.f, 0.f, 0.f}; if (n < Nvalid) v[i] = __builtin_nontemporal_load((const f32x4*)(src + (size_t)(k0 + kr + 32 * i) * ldS + n)); }
#pragma unroll
        for (int i = 0; i < KT / 32; ++i) { const int k = kr + 32 * i; if (gk) v[i] = v[i] * gk[k0 + k];
            T[k * 65 + c4 * 4 + 0] = v[i][0]; T[k * 65 + c4 * 4 + 1] = v[i][1]; T[k * 65 + c4 * 4 + 2] = v[i][2]; T[k * 65 + c4 * 4 + 3] = v[i][3]; }
    }
    __syncthreads();
    {
        constexpr int KPL = KT / 8;
        const int nl = tid >> 3, kc = (tid & 7) * KPL;
#pragma unroll
        for (int q = 0; q < KPL / 8; ++q) {
            float v[8];
#pragma unroll
            for (int j = 0; j < 8; ++j) v[j] = T[(kc + q * 8 + j) * 65 + nl];
            u32x4 w; w.x = pk2(v[0], v[1]); w.y = pk2(v[2], v[3]); w.z = pk2(v[4], v[5]); w.w = pk2(v[6], v[7]);
            *(u32x4*)(dst + (size_t)(drow0 + nl) * ldD + k0 + kc + q * 8) = w;
            if (dst_lo) {
                float r[8];
#pragma unroll
                for (int j = 0; j < 8; ++j) r[j] = v[j] - bf2f(f2bf(v[j]));
                u32x4 w2; w2.x = pk2(r[0], r[1]); w2.y = pk2(r[2], r[3]); w2.z = pk2(r[4], r[5]); w2.w = pk2(r[6], r[7]);
                *(u32x4*)(dst_lo + (size_t)(drow0 + nl) * ldD + k0 + kc + q * 8) = w2;
            }
        }
    }
    __syncthreads();
}
template <int KT>
DI void cvt_matrix(char* lds, const float* src, int K, int N, int Npad, bf16_t* dst, bf16_t* dst_lo, int mode, const float* gk, int ldD = 0) {
    if (ldD == 0) ldD = K;
    const int nkt = K / KT, nnt = Npad / 64, nt = nkt * nnt;
    for (int t = bid_here(); t < nt; t += gridDim.x) {
        const int kt = t % nkt, ntile = t / nkt, n0 = ntile * 64;
        int drow0 = n0;
        if (mode == 1) drow0 = (n0 >> 7) * 256 + (n0 & 127);
        else if (mode == 2) drow0 = (n0 >> 7) * 256 + 128 + (n0 & 127);
        cvt_tile<KT>(lds, src, N, N, dst, dst_lo, ldD, kt * KT, n0, drow0, gk);
    }
}
constexpr int CHUNKS_PER_LAYER = 65 * 192, CHUNKS_TOTAL = 2 * CHUNKS_PER_LAYER;
DI void cvt_chunk(PR p, char* lds, int g) {
    const int l = g / CHUNKS_PER_LAYER, gg = g % CHUNKS_PER_LAYER;
    unsigned char* wl = p.ws + WS_WEIGHTS + (size_t)l * WL_END;
    const int e = gg / 192, r = gg % 192, m = r >> 6, t = r & 63;
    bf16_t* d13 = (bf16_t*)(wl + WL_W13) + (size_t)e * 1024 * D; bf16_t* d2 = (bf16_t*)(wl + WL_W2) + (size_t)e * D * 512;
    if (m < 2) {
        const float* src = m == 0 ? (e < 64 ? p.exp_w1 + ((size_t)l * 64 + e) * D * 512 : p.sh_w1 + (size_t)l * D * 512) : (e < 64 ? p.exp_w3 + ((size_t)l * 64 + e) * D * 512 : p.sh_w3 + (size_t)l * D * 512);
        const int kt = t & 7, n0 = (t >> 3) * 64, drow0 = (n0 >> 7) * 256 + m * 128 + (n0 & 127);
        cvt_tile<256>(lds, src, 512, 512, d13, nullptr, D, kt * 256, n0, drow0, nullptr);
    } else {
        const float* src = e < 64 ? p.exp_w2 + ((size_t)l * 64 + e) * 512 * D : p.sh_w2 + (size_t)l * 512 * D;
        const int kt = t & 1, n0 = (t >> 1) * 64;
        cvt_tile<256>(lds, src, D, D, d2, nullptr, 512, kt * 256, n0, n0, nullptr);
    }
}
#define CTL_LD(ptr) __hip_atomic_load((ptr), __ATOMIC_RELAXED, __HIP_MEMORY_SCOPE_AGENT)
#define CTL_ADD(ptr, v) __hip_atomic_fetch_add((ptr), (v), __ATOMIC_RELAXED, __HIP_MEMORY_SCOPE_AGENT)
DI void fill_tail(PR p, char* lds, int ph) {
    unsigned* ctl = (unsigned*)(p.ws + WS_CTL);
    volatile LAS int* flag = (volatile LAS int*)(shm + 16);
    const int tid = tid_here();
    __syncthreads();
    if (tid == 0) CTL_ADD(&ctl[64 * (1 + ph)], 1u);
    for (;;) {
        if (tid == 0) {
            int c = -1;
            if (CTL_LD(&ctl[64 * (1 + ph)]) + 8u < gridDim.x && CTL_LD(&ctl[0]) < (unsigned)CHUNKS_TOTAL) { c = (int)CTL_ADD(&ctl[0], 4u); if (c >= CHUNKS_TOTAL) c = -1; }
            *flag = c;
        }
        __syncthreads();
        const int c = __builtin_amdgcn_readfirstlane(*flag);
        __syncthreads();
        if (c < 0) break;
        for (int q = 0; q < 4; ++q) {
            if (c + q < CHUNKS_TOTAL) cvt_chunk(p, lds, c + q);
            if (q < 3 && __builtin_amdgcn_readfirstlane((int)CTL_LD(&ctl[64 * (1 + ph)])) >= (int)gridDim.x) { for (int q2 = q + 1; q2 < 4; ++q2) if (c + q2 < CHUNKS_TOTAL) cvt_chunk(p, lds, c + q2); break; }
        }
    }
}
DI void fill_drain(PR p, char* lds, int limit) {
    unsigned* ctl = (unsigned*)(p.ws + WS_CTL);
    const int h0 = __builtin_amdgcn_readfirstlane((int)CTL_LD(&ctl[0]));
    for (int c = h0 + bid_here(); c < limit; c += gridDim.x) cvt_chunk(p, lds, c);
}
DI void move_head(PR p, int limit) { if (blockIdx.x == 0 && tid_here() == 0) __hip_atomic_fetch_max((unsigned*)(p.ws + WS_CTL), (unsigned)limit, __ATOMIC_RELAXED, __HIP_MEMORY_SCOPE_AGENT); }
DI void phase_prologue(PR p, char* lds) {
    const int tid = tid_here();
    unsigned char* ws = p.ws;
    if (blockIdx.x == 0) {
        unsigned* cnt = (unsigned*)(ws + WS_CNT);
        if (tid < 128) cnt[tid] = 0u;
        unsigned* z = (unsigned*)(ws + WS_ZROW);
        for (int i = tid; i < 1024; i += NTHREADS) z[i] = 0u;
        float2* rg = (float2*)(ws + WS_ROPEG);
        for (int i = tid; i < 64 * 32; i += NTHREADS) { const int pos = i >> 5, f = i & 31; const float inv = powf(10000.f, -(float)(2 * f) / 64.f); float s, c; sincosf((float)pos * inv, &s, &c); rg[i] = make_float2(c, s); }
        float2* rm = (float2*)(ws + WS_ROPEM);
        for (int i = tid; i < 64 * 16; i += NTHREADS) { const int pos = i >> 4, f = i & 15; const float inv = powf(10000.f, -(float)(2 * f) / 32.f); float s, c; sincosf((float)pos * inv, &s, &c); rm[i] = make_float2(c, s); }
    }
    {
        float* sc = (float*)lds;
        float* red = sc + 5 * 2048;
        bool loaded = false;
        for (int u = bid_here(); u < 192; u += gridDim.x) {
            if (!loaded) { for (int i = tid; i < 5 * 2048; i += NTHREADS) { const int r = i >> 11, k = i & 2047; const float v = r < 4 ? p.c[r * 2048 + k] : p.c_ctx[k]; sc[i] = silu_f(v); } loaded = true; __syncthreads(); }
            const int l = u / 96, col0 = (u % 96) * 128;
            const int cg = tid & 31, kp = tid >> 5;
            f32x4 acc[5];
#pragma unroll
            for (int r = 0; r < 5; ++r) acc[r] = (f32x4){0.f, 0.f, 0.f, 0.f};
            const float* wb = p.w_mod + ((size_t)l * 2048) * 12288 + col0 + cg * 4;
            for (int kk = 0; kk < 128; ++kk) {
                const int k = kp * 128 + kk;
                const f32x4 w = *(const f32x4*)(wb + (size_t)k * 12288);
#pragma unroll
                for (int r = 0; r < 5; ++r) acc[r] += w * sc[r * 2048 + k];
            }
#pragma unroll
            for (int r = 0; r < 5; ++r)
#pragma unroll
                for (int j = 0; j < 4; ++j) red[(kp * 5 + r) * 128 + cg * 4 + j] = acc[r][j];
            __syncthreads();
            for (int i = tid; i < 640; i += NTHREADS) {
                const int r = i >> 7, cc = i & 127; float s = p.b_mod[l * 12288 + col0 + cc];
#pragma unroll
                for (int q = 0; q < 16; ++q) s += red[(q * 5 + r) * 128 + cc];
                ((float*)(ws + WS_MOD))[((size_t)l * 5 + r) * 12288 + col0 + cc] = s;
            }
            __syncthreads();
        }
        __syncthreads();
    }
    for (int l = 0; l < 2; ++l) {
        unsigned char* wl = ws + WS_WEIGHTS + (size_t)l * WL_END;
        cvt_matrix<256>(lds, p.w_in + (size_t)l * D * INW, D, INW, INWP, (bf16_t*)(wl + WL_WIN), nullptr, 0, nullptr);
        cvt_matrix<128>(lds, p.mla_w_uq + (size_t)l * 384 * 1152, 384, 1152, 1280, (bf16_t*)(wl + WL_WUQ), nullptr, 0, p.mla_g_q + l * 384, 512);
        for (int i = bid_here() * NTHREADS + tid; i < 1280 * 64; i += gridDim.x * NTHREADS) ((unsigned*)(wl + WL_WUQ))[(size_t)(i >> 6) * 256 + 192 + (i & 63)] = 0u;
        cvt_matrix<256>(lds, p.mla_w_ukv + (size_t)l * 512 * 1536, 512, 1536, 1536, (bf16_t*)(wl + WL_WUKV), nullptr, 0, p.mla_g_kv + l * 512);
        cvt_matrix<256>(lds, p.w_out + (size_t)l * D * D, D, D, D, (bf16_t*)(wl + WL_WOUT), nullptr, 0, nullptr);
        cvt_matrix<256>(lds, p.router_w + (size_t)l * D * 64, D, 64, 64, (bf16_t*)(wl + WL_WRH), (bf16_t*)(wl + WL_WRL), 0, nullptr);
    }
}

DI void router_group(PR p, int l, float* LG, int row0, bool dry);
#ifndef OASG_FP8_MASK
#define OASG_FP8_MASK 3
#endif
constexpr float OASG_SCALE = 16.f;
DI void load_row(const float* src, f32x4 (&v)[4][2], int c0) {
#pragma unroll
    for (int i = 0; i < 4; ++i) { v[i][0] = *(const f32x4*)(src + i * 512 + c0); v[i][1] = *(const f32x4*)(src + i * 512 + c0 + 4); }
}
DI void unpack8(const u32x4 w, f32x4& a, f32x4& b) {
    a[0] = __uint_as_float(w.x << 16); a[1] = __uint_as_float(w.x & 0xFFFF0000u); a[2] = __uint_as_float(w.y << 16); a[3] = __uint_as_float(w.y & 0xFFFF0000u);
    b[0] = __uint_as_float(w.z << 16); b[1] = __uint_as_float(w.z & 0xFFFF0000u); b[2] = __uint_as_float(w.w << 16); b[3] = __uint_as_float(w.w & 0xFFFF0000u);
}
DI void load_row_bf(const bf16_t* src, f32x4 (&v)[4][2], int c0) {
#pragma unroll
    for (int i = 0; i < 4; ++i) unpack8(*(const u32x4*)(src + i * 512 + c0), v[i][0], v[i][1]);
}
DI void store_row_bf(bf16_t* dst, const f32x4 (&v)[4][2], int c0) {
#pragma unroll
    for (int i = 0; i < 4; ++i) { u32x4 w; w.x = pk2(v[i][0][0], v[i][0][1]); w.y = pk2(v[i][0][2], v[i][0][3]); w.z = pk2(v[i][1][0], v[i][1][1]); w.w = pk2(v[i][1][2], v[i][1][3]); *(u32x4*)(dst + i * 512 + c0) = w; }
}
DI float row_sumsq(const f32x4 (&v)[4][2]) {
    float s = 0.f;
#pragma unroll
    for (int i = 0; i < 4; ++i)
#pragma unroll
        for (int h = 0; h < 2; ++h) s += v[i][h][0] * v[i][h][0] + v[i][h][1] * v[i][h][1] + v[i][h][2] * v[i][h][2] + v[i][h][3] * v[i][h][3];
    return wave_sum(s);
}
DI void adaln_store(const f32x4 (&x)[4][2], const float* g, const float* shift, const float* scale, bf16_t* hi, bf16_t* lo, int c0) {
    const float rstd = rsqrtf(row_sumsq(x) * (1.f / D) + EPS);
#pragma unroll
    for (int i = 0; i < 4; ++i) {
        f32x4 h[2];
#pragma unroll
        for (int q = 0; q < 2; ++q) { const int c = i * 512 + c0 + 4 * q;
            const f32x4 gg = *(const f32x4*)(g + c), sh = *(const f32x4*)(shift + c), sc = *(const f32x4*)(scale + c);
#pragma unroll
            for (int j = 0; j < 4; ++j) h[q][j] = x[i][q][j] * rstd * gg[j] * (1.f + sc[j]) + sh[j]; }
        u32x4 w; w.x = pk2(h[0][0], h[0][1]); w.y = pk2(h[0][2], h[0][3]); w.z = pk2(h[1][0], h[1][1]); w.w = pk2(h[1][2], h[1][3]);
        *(u32x4*)(hi + i * 512 + c0) = w;
        if (lo) { f32x4 a, b; unpack8(w, a, b); u32x4 w2; w2.x = pk2(h[0][0] - a[0], h[0][1] - a[1]); w2.y = pk2(h[0][2] - a[2], h[0][3] - a[3]); w2.z = pk2(h[1][0] - b[0], h[1][1] - b[1]); w2.w = pk2(h[1][2] - b[2], h[1][3] - b[3]);
            *(u32x4*)(lo + i * 512 + c0) = w2; }
    }
}
DI void residual_add(f32x4 (&x)[4][2], const f32x4 (&y)[4][2], const float* g, const float* gate, int c0) {
    const float rstd = rsqrtf(row_sumsq(y) * (1.f / D) + EPS);
#pragma unroll
    for (int i = 0; i < 4; ++i)
#pragma unroll
        for (int q = 0; q < 2; ++q) { const int c = i * 512 + c0 + 4 * q; const f32x4 gg = *(const f32x4*)(g + c), gt = *(const f32x4*)(gate + c);
#pragma unroll
            for (int j = 0; j < 4; ++j) x[i][q][j] += gt[j] * (y[i][q][j] * rstd * gg[j]); }
}
DI void load_xrow(PR p, int l, int r, f32x4 (&x)[4][2], int c0) {
    if (l == 0) load_row(r < NLAT ? p.x + (size_t)r * D : p.ctx + (size_t)(r - NLAT) * D, x, c0);
    else load_row_bf((const bf16_t*)(p.ws + WS_XRES) + (size_t)r * D, x, c0);
}
DI void phase_norm1(PR p, int l) {
    const int tid_ = tid_here(), lane = tid_ & 63, wid = tid_ >> 6;
    const float* mod = (const float*)(p.ws + WS_MOD) + (size_t)l * 5 * 12288;
    bf16_t* hb = (bf16_t*)(p.ws + WS_HBUF);
    for (int r = bid_here() * 8 + wid; r < NTOK; r += gridDim.x * 8) {
        const Tok t = tok_of(r);
        int c0 = lane * 8; asm volatile("" : "+v"(c0));
        f32x4 x[4][2]; load_xrow(p, l, r, x, c0);
        adaln_store(x, p.g_pre_mix + l * D, mod + (size_t)t.mrow * 12288 + 0 * D, mod + (size_t)t.mrow * 12288 + 1 * D, hb + (size_t)r * D, nullptr, c0);
    }
}
DI void postmix_row(PR p, int l, int r, int lane) {
    const float* mod = (const float*)(p.ws + WS_MOD) + (size_t)l * 5 * 12288;
    const bf16_t* Y = (const bf16_t*)(p.ws + WS_U + U_Y);
    bf16_t* XR = (bf16_t*)(p.ws + WS_XRES);
    bf16_t* hb = (bf16_t*)(p.ws + WS_HBUF); bf16_t* hl = (bf16_t*)(p.ws + WS_U + U_HLO);
    const Tok t = tok_of(r);
    int c0 = lane * 8; asm volatile("" : "+v"(c0));
    f32x4 x[4][2], y[4][2]; load_xrow(p, l, r, x, c0); load_row_bf(Y + (size_t)r * D, y, c0);
    residual_add(x, y, p.g_post_mix + l * D, mod + (size_t)t.mrow * 12288 + 2 * D, c0);
    store_row_bf(XR + (size_t)r * D, x, c0);
    adaln_store(x, p.g_pre_ffn + l * D, mod + (size_t)t.mrow * 12288 + 3 * D, mod + (size_t)t.mrow * 12288 + 4 * D, hb + (size_t)r * D, ROUTER_SPLIT ? hl + (size_t)r * D : nullptr, c0);
}
DI void phase_postmix(PR p, int l, char* lds, bool with_router) {
    const int tid_ = tid_here(), lane = tid_ & 63, wid = tid_ >> 6;
    const int nrows = l == 0 ? NTOK : NLAT, ngrp = nrows / 16;
    if (!with_router) { for (int r = bid_here() * 8 + wid; r < nrows; r += gridDim.x * 8) postmix_row(p, l, r, lane); return; }
    for (int g = wid * (int)gridDim.x + bid_here(); g < ngrp; g += 8 * (int)gridDim.x) {
#pragma unroll 1
        for (int i = 0; i < 16; ++i) postmix_row(p, l, g * 16 + i, lane);
        if (with_router) { asm volatile("s_waitcnt vmcnt(0)" ::: "memory"); router_group(p, l, (float*)lds + wid * (16 * 65 + 16 * 64), g * 16, false); }
    }
}
DI void phase_postffn(PR p, int l) {
    const int tid_ = tid_here(), lane = tid_ & 63, wid = tid_ >> 6;
    const float* mod = (const float*)(p.ws + WS_MOD) + (size_t)l * 5 * 12288;
    const bf16_t* YS = (const bf16_t*)(p.ws + WS_U + U_YSH);
    const unsigned char* OA = p.ws + WS_U + U_OASG;
    bf16_t* XR = (bf16_t*)(p.ws + WS_XRES);
    bf16_t* hb = (bf16_t*)(p.ws + WS_HBUF);
    const int nrows = l == 0 ? NTOK : NLAT;
    const bool fp8 = (OASG_FP8_MASK >> l) & 1;
    for (int r = bid_here() * 8 + wid; r < nrows; r += gridDim.x * 8) {
        const Tok t = tok_of(r);
        int c0 = lane * 8; asm volatile("" : "+v"(c0));
        f32x4 x[4][2], y[4][2]; load_row_bf(XR + (size_t)r * D, x, c0); load_row_bf(YS + (size_t)r * D, y, c0);
        if (fp8) {
            f32x4 a[4][2];
#pragma unroll
            for (int i = 0; i < 4; ++i) { a[i][0] = (f32x4){0.f, 0.f, 0.f, 0.f}; a[i][1] = (f32x4){0.f, 0.f, 0.f, 0.f}; }
#pragma unroll 2
            for (int k = 0; k < 8; ++k) {
                const unsigned char* o = OA + ((size_t)r * 8 + k) * D;
#pragma unroll
                for (int i = 0; i < 4; ++i) { const u32x2 w = *(const u32x2*)(o + i * 512 + c0);
                    const auto f0 = __builtin_amdgcn_cvt_pk_f32_fp8(w.x, false), f1 = __builtin_amdgcn_cvt_pk_f32_fp8(w.x, true), f2 = __builtin_amdgcn_cvt_pk_f32_fp8(w.y, false), f3 = __builtin_amdgcn_cvt_pk_f32_fp8(w.y, true);
                    a[i][0][0] += f0[0]; a[i][0][1] += f0[1]; a[i][0][2] += f1[0]; a[i][0][3] += f1[1]; a[i][1][0] += f2[0]; a[i][1][1] += f2[1]; a[i][1][2] += f3[0]; a[i][1][3] += f3[1]; }
            }
#pragma unroll
            for (int i = 0; i < 4; ++i) { y[i][0] += a[i][0] * (1.f / OASG_SCALE); y[i][1] += a[i][1] * (1.f / OASG_SCALE); }
        } else {
#pragma unroll 2
            for (int k = 0; k < 8; ++k) {
                const bf16_t* o = (const bf16_t*)OA + ((size_t)r * 8 + k) * D;
#pragma unroll
                for (int i = 0; i < 4; ++i) { f32x4 a, b; unpack8(*(const u32x4*)(o + i * 512 + c0), a, b); y[i][0] += a; y[i][1] += b; }
            }
        }
        residual_add(x, y, p.g_post_ffn + l * D, mod + (size_t)t.mrow * 12288 + 5 * D, c0);
        if (l == 0) {
            store_row_bf(XR + (size_t)r * D, x, c0);
            const float* mod1 = (const float*)(p.ws + WS_MOD) + (size_t)1 * 5 * 12288;
            adaln_store(x, p.g_pre_mix + 1 * D, mod1 + (size_t)t.mrow * 12288 + 0 * D, mod1 + (size_t)t.mrow * 12288 + 1 * D, hb + (size_t)r * D, nullptr, c0);
        } else {
            float* dstrow = p.out + (size_t)r * D;
#pragma unroll
            for (int i = 0; i < 4; ++i) { *(f32x4*)(dstrow + i * 512 + c0) = x[i][0]; *(f32x4*)(dstrow + i * 512 + c0 + 4) = x[i][1]; }
        }
    }
}

struct GemmUnit {
    const bf16_t* A; long lda; const int* rows; int rowshift;
    const bf16_t* Bt; long ldb;
    int K;
};
constexpr int GS_LD = 72;
struct LaneId { int wr, wc, fr, fq; };
DI LaneId gemm_kloop_simple(char* lds, const GemmUnit& g, f32x4 (&acc)[2][2][4][2]) {
    int tid = threadIdx.x; asm volatile("" : "+v"(tid));
    const int wid = tid >> 6, lane = tid & 63, wr = wid >> 2, wc = wid & 3, fr = lane & 15, fq = lane >> 4;
    bf16_t* As = (bf16_t*)lds; bf16_t* Bs = As + 256 * GS_LD;
#pragma unroll
    for (int a = 0; a < 2; ++a)
#pragma unroll
        for (int b = 0; b < 2; ++b)
#pragma unroll
            for (int m = 0; m < 4; ++m)
#pragma unroll
                for (int n = 0; n < 2; ++n) acc[a][b][m][n] = (f32x4){0.f, 0.f, 0.f, 0.f};
    const int srow = tid >> 3, skc = (tid & 7) * 8;
    const bf16_t* ap[4]; const bf16_t* bp[4];
#pragma unroll
    for (int i = 0; i < 4; ++i) {
        const int r = srow + 64 * i;
        if (g.rows) { const int idx = g.rows[r]; ap[i] = g.A + (size_t)(idx >= 0 ? (idx >> g.rowshift) : 0) * g.lda + skc; }
        else ap[i] = g.A + (size_t)r * g.lda + skc;
        bp[i] = g.Bt + (size_t)r * g.ldb + skc;
    }
    const int nkt = g.K / 64;
    u32x4 ra[4], rb[4];
#pragma unroll
    for (int i = 0; i < 4; ++i) { ra[i] = *(const u32x4*)(ap[i]); rb[i] = *(const u32x4*)(bp[i]); }
    for (int kt = 0; kt < nkt; ++kt) {
        __syncthreads();
#pragma unroll
        for (int i = 0; i < 4; ++i) { *(u32x4*)(As + (srow + 64 * i) * GS_LD + skc) = ra[i]; *(u32x4*)(Bs + (srow + 64 * i) * GS_LD + skc) = rb[i]; }
        __syncthreads();
        if (kt + 1 < nkt) {
#pragma unroll
            for (int i = 0; i < 4; ++i) { ra[i] = *(const u32x4*)(ap[i] + (kt + 1) * 64); rb[i] = *(const u32x4*)(bp[i] + (kt + 1) * 64); }
        }
#pragma unroll
        for (int kk = 0; kk < 2; ++kk) {
            bf16x8 bf[2][2];
#pragma unroll
            for (int bj = 0; bj < 2; ++bj)
#pragma unroll
                for (int n = 0; n < 2; ++n) bf[bj][n] = *(const bf16x8*)(Bs + (128 * bj + 32 * wc + 16 * n + fr) * GS_LD + kk * 32 + fq * 8);
#pragma unroll
            for (int ai = 0; ai < 2; ++ai)
#pragma unroll
                for (int m = 0; m < 4; ++m) {
                    const bf16x8 af = *(const bf16x8*)(As + (128 * ai + 64 * wr + 16 * m + fr) * GS_LD + kk * 32 + fq * 8);
#pragma unroll
                    for (int bj = 0; bj < 2; ++bj)
#pragma unroll
                        for (int n = 0; n < 2; ++n) acc[ai][bj][m][n] = __builtin_amdgcn_mfma_f32_16x16x32_bf16(bf[bj][n], af, acc[ai][bj][m][n], 0, 0, 0);
                }
        }
    }
    __syncthreads();
    LaneId id; id.wr = wr; id.wc = wc; id.fr = fr; id.fq = fq; return id;
}
#define GEMM_ACC f32x4 acc[2][2][4][2]
#define ACC_FOREACH(...) \
    _Pragma("unroll") for (int ai = 0; ai < 2; ++ai) _Pragma("unroll") for (int m = 0; m < 4; ++m) { const int trow = 128 * ai + 64 * wr + 16 * m + fr; \
    _Pragma("unroll") for (int bj = 0; bj < 2; ++bj) _Pragma("unroll") for (int n = 0; n < 2; ++n) { const int tcol = 128 * bj + 32 * wc + 16 * n + 4 * fq; const f32x4 v = acc[ai][bj][m][n]; __VA_ARGS__ } }

struct EpiProj {
    bf16_t* O; int row0, col0;
    DI void operator()(const f32x4 (&acc)[2][2][4][2], int wr, int wc, int fr, int fq) const {
        ACC_FOREACH({ u32x2 w; w.x = pk2(v[0], v[1]); w.y = pk2(v[2], v[3]); *(u32x2*)(O + (size_t)(row0 + trow) * INWP + col0 + tcol) = w; })
    }
};
struct EpiB16 {
    bf16_t* O; int row0, col0, ld;
    DI void operator()(const f32x4 (&acc)[2][2][4][2], int wr, int wc, int fr, int fq) const {
        ACC_FOREACH({ u32x2 w; w.x = pk2(v[0], v[1]); w.y = pk2(v[2], v[3]); *(u32x2*)(O + (size_t)(row0 + trow) * ld + col0 + tcol) = w; })
    }
};
struct EpiF32 {
    float* O; int row0, col0, ld;
    DI void operator()(const f32x4 (&acc)[2][2][4][2], int wr, int wc, int fr, int fq) const {
        ACC_FOREACH({ *(f32x4*)(O + (size_t)(row0 + trow) * ld + col0 + tcol) = v; })
    }
};
struct EpiUq {
    bf16_t* Q; const float2* ropem; int row0, col0;
    DI void operator()(const f32x4 (&acc)[2][2][4][2], int wr, int wc, int fr, int fq) const {
#pragma unroll
        for (int bj = 0; bj < 2; ++bj) {
            const int cbase = col0 + 128 * bj + 32 * wc;
            if (cbase >= 1152) continue;
            const int h = cbase / 192, jb = cbase % 192;
            float2 cs[2][4][4]; Tok tk[2][4];
#pragma unroll
            for (int ai = 0; ai < 2; ++ai)
#pragma unroll
                for (int m = 0; m < 4; ++m) { tk[ai][m] = tok_of(row0 + 128 * ai + 64 * wr + 16 * m + fr); const Tok t = tk[ai][m];
                    const int pos = (jb == 128) ? (t.s >> 6) : (t.s & 63); const bool rot = jb >= 128 && !t.isctx;
#pragma unroll
                    for (int i = 0; i < 4; ++i) cs[ai][m][i] = rot ? ropem[pos * 16 + 4 * fq + i] : make_float2(1.f, 0.f); }
#pragma unroll
            for (int ai = 0; ai < 2; ++ai)
#pragma unroll
                for (int m = 0; m < 4; ++m) { const Tok t = tk[ai][m];
                    f32x4 v0 = acc[ai][bj][m][0], v1 = acc[ai][bj][m][1];
#pragma unroll
                    for (int i = 0; i < 4; ++i) { const float2 c = cs[ai][m][i]; const float x1 = v0[i], x2 = v1[i]; v0[i] = x1 * c.x - x2 * c.y; v1[i] = x2 * c.x + x1 * c.y; }
                    bf16_t* dst = Q + (((size_t)t.b * 6 + h) * SKV + t.kvpos) * 192 + jb + 4 * fq;
                    u32x2 w0; w0.x = pk2(v0[0], v0[1]); w0.y = pk2(v0[2], v0[3]); *(u32x2*)(dst) = w0;
                    u32x2 w1; w1.x = pk2(v1[0], v1[1]); w1.y = pk2(v1[2], v1[3]); *(u32x2*)(dst + 16) = w1; }
        }
    }
};
struct EpiUkv {
    bf16_t* Km; bf16_t* Vm; int row0, col0;
    DI void operator()(const f32x4 (&acc)[2][2][4][2], int wr, int wc, int fr, int fq) const {
        ACC_FOREACH({ const int r = row0 + trow; const Tok t = tok_of(r); const int c = col0 + tcol, h = c >> 8, j = c & 255;
            u32x2 w; w.x = pk2(v[0], v[1]); w.y = pk2(v[2], v[3]);
            if (j < 128) *(u32x2*)(Km + (((size_t)t.b * 6 + h) * SKV + t.kvpos) * 192 + j) = w;
            else *(u32x2*)(Vm + (((size_t)t.b * 6 + h) * SKV + t.kvpos) * 128 + (j - 128)) = w; })
    }
};
struct EpiMoe1 {
    bf16_t* act; int arow0, hcol0;
    DI void operator()(const f32x4 (&acc)[2][2][4][2], int wr, int wc, int fr, int fq) const {
#pragma unroll
        for (int ai = 0; ai < 2; ++ai)
#pragma unroll
            for (int m = 0; m < 4; ++m) {
                const int trow = 128 * ai + 64 * wr + 16 * m + fr;
#pragma unroll
                for (int n = 0; n < 2; ++n) {
                    const f32x4 a = acc[ai][0][m][n], b = acc[ai][1][m][n]; f32x4 h;
#pragma unroll
                    for (int i = 0; i < 4; ++i) h[i] = silu_f(a[i]) * b[i];
                    u32x2 w; w.x = pk2(h[0], h[1]); w.y = pk2(h[2], h[3]);
                    *(u32x2*)(act + (size_t)(arow0 + trow) * 512 + hcol0 + 32 * wc + 16 * n + 4 * fq) = w;
                }
            }
    }
};
struct EpiMoe2 {
    bf16_t* oasg; const int* sasg; const float* sw; int srow0, col0;
    DI void operator()(const f32x4 (&acc)[2][2][4][2], int wr, int wc, int fr, int fq) const {
        int a[2][4]; float wgt[2][4];
#pragma unroll
        for (int ai = 0; ai < 2; ++ai)
#pragma unroll
            for (int m = 0; m < 4; ++m) { const int trow = 128 * ai + 64 * wr + 16 * m + fr; a[ai][m] = sasg[srow0 + trow]; wgt[ai][m] = sw[srow0 + trow]; }
#pragma unroll
        for (int ai = 0; ai < 2; ++ai)
#pragma unroll
            for (int m = 0; m < 4; ++m) {
                if (a[ai][m] < 0) continue;
#pragma unroll
                for (int bj = 0; bj < 2; ++bj)
#pragma unroll
                    for (int n = 0; n < 2; ++n) { const f32x4 v = acc[ai][bj][m][n] * wgt[ai][m]; u32x2 w; w.x = pk2(v[0], v[1]); w.y = pk2(v[2], v[3]);
                        *(u32x2*)(oasg + (size_t)a[ai][m] * D + col0 + 128 * bj + 32 * wc + 16 * n + 4 * fq) = w; }
            }
    }
};
DI u32x4 pack8(const f32x4& a, const f32x4& b) { u32x4 w; w.x = pk2(a[0], a[1]); w.y = pk2(a[2], a[3]); w.z = pk2(b[0], b[1]); w.w = pk2(b[2], b[3]); return w; }
struct EpiB16P {
    bf16_t* O; int row0, col0, ld;
    DI void operator()(const f32x4 (&acc)[2][2][4][2], int wr, int wc, int fr, int fq) const {
#pragma unroll
        for (int ai = 0; ai < 2; ++ai)
#pragma unroll
            for (int m = 0; m < 4; ++m) { bf16_t* rowp = O + (size_t)(row0 + 128 * ai + 64 * wr + 16 * m + fr) * ld + col0 + 32 * wc + 8 * fq;
#pragma unroll
                for (int bj = 0; bj < 2; ++bj) *(u32x4*)(rowp + 128 * bj) = pack8(acc[ai][bj][m][0], acc[ai][bj][m][1]); }
    }
};
struct EpiMoe1P {
    bf16_t* act; int arow0, hcol0;
    DI void operator()(const f32x4 (&acc)[2][2][4][2], int wr, int wc, int fr, int fq) const {
#pragma unroll
        for (int ai = 0; ai < 2; ++ai)
#pragma unroll
            for (int m = 0; m < 4; ++m) {
                f32x4 h0, h1;
#pragma unroll
                for (int i = 0; i < 4; ++i) { h0[i] = silu_f(acc[ai][0][m][0][i]) * acc[ai][1][m][0][i]; h1[i] = silu_f(acc[ai][0][m][1][i]) * acc[ai][1][m][1][i]; }
                *(u32x4*)(act + (size_t)(arow0 + 128 * ai + 64 * wr + 16 * m + fr) * 512 + hcol0 + 32 * wc + 8 * fq) = pack8(h0, h1);
            }
    }
};
struct EpiMoe2P {
    bf16_t* oasg; const int* sasg; const float* sw; int srow0, col0;
    DI void operator()(const f32x4 (&acc)[2][2][4][2], int wr, int wc, int fr, int fq) const {
        int a[2][4]; float wgt[2][4];
#pragma unroll
        for (int ai = 0; ai < 2; ++ai)
#pragma unroll
            for (int m = 0; m < 4; ++m) { const int trow = 128 * ai + 64 * wr + 16 * m + fr; a[ai][m] = sasg[srow0 + trow]; wgt[ai][m] = sw[srow0 + trow]; }
#pragma unroll
        for (int ai = 0; ai < 2; ++ai)
#pragma unroll
            for (int m = 0; m < 4; ++m) {
                if (a[ai][m] < 0) continue;
                bf16_t* rowp = oasg + (size_t)a[ai][m] * D + col0 + 32 * wc + 8 * fq;
#pragma unroll
                for (int bj = 0; bj < 2; ++bj) *(u32x4*)(rowp + 128 * bj) = pack8(acc[ai][bj][m][0] * wgt[ai][m], acc[ai][bj][m][1] * wgt[ai][m]);
            }
    }
};
struct EpiMoe2F8 {
    unsigned char* oasg; const int* sasg; const float* sw; int srow0, col0;
    DI void operator()(const f32x4 (&acc)[2][2][4][2], int wr, int wc, int fr, int fq) const {
        int a[2][4]; float wgt[2][4];
#pragma unroll
        for (int ai = 0; ai < 2; ++ai)
#pragma unroll
            for (int m = 0; m < 4; ++m) { const int trow = 128 * ai + 64 * wr + 16 * m + fr; a[ai][m] = sasg[srow0 + trow]; wgt[ai][m] = sw[srow0 + trow] * OASG_SCALE; }
#pragma unroll
        for (int ai = 0; ai < 2; ++ai)
#pragma unroll
            for (int m = 0; m < 4; ++m) {
                if (a[ai][m] < 0) continue;
                unsigned char* rowp = oasg + (size_t)a[ai][m] * D + col0 + 32 * wc + 8 * fq;
#pragma unroll
                for (int bj = 0; bj < 2; ++bj) { const f32x4 v0 = acc[ai][bj][m][0] * wgt[ai][m], v1 = acc[ai][bj][m][1] * wgt[ai][m]; u32x2 w;
                    int t0 = __builtin_amdgcn_cvt_pk_fp8_f32(v0[0], v0[1], 0, false); t0 = __builtin_amdgcn_cvt_pk_fp8_f32(v0[2], v0[3], t0, true);
                    int t1 = __builtin_amdgcn_cvt_pk_fp8_f32(v1[0], v1[1], 0, false); t1 = __builtin_amdgcn_cvt_pk_fp8_f32(v1[2], v1[3], t1, true);
                    w.x = (unsigned)t0; w.y = (unsigned)t1; *(u32x2*)(rowp + 128 * bj) = w; }
            }
    }
};
DI void phase_postproj_rows(PR p, int l) {
    const int tid_ = tid_here(), lane = tid_ & 63, wid = tid_ >> 6;
    unsigned char* U = p.ws + WS_U;
    const bf16_t* PR_ = (const bf16_t*)(U + U_PROJ);
    bf16_t* CQN = (bf16_t*)(U + U_CQN); bf16_t* CKVN = (bf16_t*)(U + U_CKVN);
    bf16_t* Km = (bf16_t*)(U + U_KM); bf16_t* Qg = (bf16_t*)(U + U_QG); bf16_t* Kg = (bf16_t*)(U + U_KG); bf16_t* Vg = (bf16_t*)(U + U_VG);
    const float2* ropeg = (const float2*)(p.ws + WS_ROPEG); const float2* ropem = (const float2*)(p.ws + WS_ROPEM);
    const float gq0 = p.gqa_g_q[l * 128 + 2 * lane], gq1 = p.gqa_g_q[l * 128 + 2 * lane + 1], gk0 = p.gqa_g_k[l * 128 + 2 * lane], gk1 = p.gqa_g_k[l * 128 + 2 * lane + 1];
    for (int r = bid_here() * 8 + wid; r < NTOK; r += gridDim.x * 8) {
        const Tok t = tok_of(r);
        const bf16_t* pr = PR_ + (size_t)r * INWP;
        {
            const unsigned* src = (const unsigned*)(pr + C_CQ + 6 * lane); const unsigned w0 = src[0], w1 = src[1], w2 = src[2];
            float v[6] = {__uint_as_float(w0 << 16), __uint_as_float(w0 & 0xFFFF0000u), __uint_as_float(w1 << 16), __uint_as_float(w1 & 0xFFFF0000u), __uint_as_float(w2 << 16), __uint_as_float(w2 & 0xFFFF0000u)};
            float ss = 0.f;
#pragma unroll
            for (int i = 0; i < 6; ++i) ss += v[i] * v[i];
            const float rstd = rsqrtf(wave_sum(ss) * (1.f / 384.f) + EPS);
            unsigned* dst = (unsigned*)(CQN + (size_t)r * 512 + 6 * lane); dst[0] = pk2(v[0] * rstd, v[1] * rstd); dst[1] = pk2(v[2] * rstd, v[3] * rstd); dst[2] = pk2(v[4] * rstd, v[5] * rstd);
            *(unsigned*)(CQN + (size_t)r * 512 + 384 + 2 * lane) = 0u;
        }
        {
            f32x4 a, b; unpack8(*(const u32x4*)(pr + C_CKV + 8 * lane), a, b);
            const float ss = a[0] * a[0] + a[1] * a[1] + a[2] * a[2] + a[3] * a[3] + b[0] * b[0] + b[1] * b[1] + b[2] * b[2] + b[3] * b[3];
            const float rstd = rsqrtf(wave_sum(ss) * (1.f / 512.f) + EPS);
            u32x4 w; w.x = pk2(a[0] * rstd, a[1] * rstd); w.y = pk2(a[2] * rstd, a[3] * rstd); w.z = pk2(b[0] * rstd, b[1] * rstd); w.w = pk2(b[2] * rstd, b[3] * rstd);
            *(u32x4*)(CKVN + (size_t)r * 512 + 8 * lane) = w;
        }
        {
            float x = bf2f(pr[C_KR + lane]);
            const float other = shx(x, 16, lane);
            if (!t.isctx) {
                const int g = lane >> 5, idx = lane & 31, fi = idx & 15; const bool second = idx >= 16;
                const int pos = g == 0 ? (t.s >> 6) : (t.s & 63);
                const float2 cs = ropem[pos * 16 + fi];
                x = second ? x * cs.x + other * cs.y : x * cs.x - other * cs.y;
            }
            const bf16_t xb = f2bf(x);
#pragma unroll
            for (int h = 0; h < 6; ++h) Km[(((size_t)t.b * 6 + h) * SKV + t.kvpos) * 192 + 128 + lane] = xb;
        }
        const int f0 = (2 * lane) & 31; const bool second = (lane & 16) != 0;
        float2 csa = make_float2(1.f, 0.f), csb = make_float2(1.f, 0.f);
        if (!t.isctx) { const int pos = lane < 32 ? (t.s >> 6) : (t.s & 63); csa = ropeg[pos * 32 + f0]; csb = ropeg[pos * 32 + f0 + 1]; }
#pragma unroll
        for (int hh = 0; hh < 8; ++hh) {
            const bool isq = hh < 6; const int h = isq ? hh : hh - 6;
            const unsigned wv = *(const unsigned*)(pr + (isq ? C_AQ : C_AK) + h * 128 + 2 * lane);
            float e0 = __uint_as_float(wv << 16), e1 = __uint_as_float(wv & 0xFFFF0000u);
            const float rstd = rsqrtf(wave_sum(e0 * e0 + e1 * e1) * (1.f / 128.f) + EPS);
            e0 = e0 * rstd * (isq ? gq0 : gk0); e1 = e1 * rstd * (isq ? gq1 : gk1);
            const float o0 = shx(e0, 16, lane), o1 = shx(e1, 16, lane);
            const float r0 = second ? e0 * csa.x + o0 * csa.y : e0 * csa.x - o0 * csa.y;
            const float r1 = second ? e1 * csb.x + o1 * csb.y : e1 * csb.x - o1 * csb.y;
            bf16_t* dst = isq ? Qg + (((size_t)t.b * 6 + h) * SKV + t.kvpos) * 128 : Kg + (((size_t)t.b * 2 + h) * SKV + t.kvpos) * 128;
            *(unsigned*)(dst + 2 * lane) = pk2(r0, r1);
        }
        {
            const u32x2 wv = *(const u32x2*)(pr + C_AV + 4 * lane);
            *(u32x2*)(Vg + (((size_t)t.b * 2 + (lane >> 5)) * SKV + t.kvpos) * 128 + 4 * (lane & 31)) = wv;
        }
    }
}

#define SBAR() __builtin_amdgcn_sched_barrier(0)
DI int crow(int r, int hi) { return (r & 3) + 8 * (r >> 2) + 4 * hi; }
DI unsigned cvtpk(float lo, float hi) { unsigned r; asm volatile("v_cvt_pk_bf16_f32 %0, %1, %2" : "=v"(r) : "v"(lo), "v"(hi)); return r; }
constexpr float ATT_THR = 8.f;
template <int DQK> struct AttnCfg {
    static constexpr int KROWB = DQK * 2;
    static constexpr int SHM_V = 64 * 128 * 2, SHM_K = 64 * DQK * 2;
    static constexpr int ND0 = DQK / 16;
    static constexpr int NKCH = DQK / 64;
    static constexpr int NQR = DQK == 128 ? 8 : ATT_NQR_M;
    static constexpr int SHM_Q = 8 * (ND0 - NQR) * 1024;
    static constexpr int SHM_TOTAL = 2 * SHM_V + 2 * SHM_K + 8 * 64 * 4 + SHM_Q;
};
template <int DQK> DI int kswz(int row, int colB) { return row * (DQK * 2) + (colB ^ ((row & 7) << 4)); }
DI void partialSM(f32x16& p0, f32x16& p1, float& m_reg, float& mn, float& alpha, const float SCALE) {
    const float C = SCALE * 1.4426950408889634f;
    float pmax = p0[0];
#pragma unroll
    for (int r = 1; r < 16; ++r) pmax = fmaxf(pmax, p0[r]);
#pragma unroll
    for (int r = 0; r < 16; ++r) pmax = fmaxf(pmax, p1[r]);
    { auto rr = __builtin_amdgcn_permlane32_swap(__float_as_uint(pmax), __float_as_uint(pmax), false, false);
      pmax = fmaxf(__uint_as_float(rr[0]), __uint_as_float(rr[1])); }
    if (__builtin_expect(__all(pmax - m_reg <= ATT_THR / SCALE), 1)) { mn = m_reg; alpha = 1.f; }
    else { mn = fmaxf(m_reg, pmax); alpha = __builtin_amdgcn_exp2f((m_reg - mn) * C); m_reg = mn; }
    const float mnC = -mn * C;
#pragma unroll
    for (int r = 0; r < 16; ++r) p0[r] = fmaf(p0[r], C, mnC);
#pragma unroll
    for (int r = 0; r < 16; ++r) p1[r] = fmaf(p1[r], C, mnC);
#pragma unroll
    for (int r = 0; r < 16; ++r) p0[r] = __builtin_amdgcn_exp2f(p0[r]);
}
DI void finishSM(f32x16& p0, f32x16& p1, float alpha, float& l_reg, bf16x8& pa0, bf16x8& pa1, bf16x8& pa2, bf16x8& pa3) {
#pragma unroll
    for (int r = 0; r < 16; ++r) p1[r] = __builtin_amdgcn_exp2f(p1[r]);
    float ps = 0;
#pragma unroll
    for (int r = 0; r < 16; ++r) ps += p0[r];
#pragma unroll
    for (int r = 0; r < 16; ++r) ps += p1[r];
    { auto rr = __builtin_amdgcn_permlane32_swap(__float_as_uint(ps), __float_as_uint(ps), false, false);
      ps = __uint_as_float(rr[0]) + __uint_as_float(rr[1]); }
    l_reg = l_reg * alpha + ps;
#define PK4(P, BASE, OUT) do { unsigned a0 = cvtpk(P[BASE + 0], P[BASE + 1]), a1 = cvtpk(P[BASE + 2], P[BASE + 3]);   \
    unsigned b0 = cvtpk(P[BASE + 4], P[BASE + 5]), b1 = cvtpk(P[BASE + 6], P[BASE + 7]);                              \
    auto r0 = __builtin_amdgcn_permlane32_swap(a0, b0, false, false); auto r1 = __builtin_amdgcn_permlane32_swap(a1, b1, false, false); \
    u32x4 w = {r0[0], r1[0], r0[1], r1[1]}; OUT = *reinterpret_cast<bf16x8*>(&w); } while (0)
    PK4(p0, 0, pa0); PK4(p0, 8, pa1); PK4(p1, 0, pa2); PK4(p1, 8, pa3);
#undef PK4
}
template <int DQK, int NQR>
DI void qkt(f32x16& p0, f32x16& p1, const int (&kb)[4], int bufoff, const bf16x8* qr, int qs_addr, int r32, int hi) {
    asm volatile("" : "+v"(qs_addr));
    const LAS char* Qs = (const LAS char*)qs_addr;
#pragma unroll
    for (int r = 0; r < 16; ++r) { p0[r] = 0.f; p1[r] = 0.f; }
#pragma unroll
    for (int d0 = 0; d0 < DQK / 16; ++d0) {
        const LAS char* ka = (const LAS char*)(kb[d0 & 3]) + bufoff + 128 * (d0 >> 2);
        const bf16x8 b0 = *(const LAS bf16x8*)(ka);
        const bf16x8 b1 = *(const LAS bf16x8*)(ka + 32 * DQK * 2);
        bf16x8 q;
        if (d0 < NQR) q = qr[d0]; else q = *(const LAS bf16x8*)(Qs + (d0 - NQR) * 1024);
        p0 = __builtin_amdgcn_mfma_f32_32x32x16_bf16(b0, q, p0, 0, 0, 0);
        p1 = __builtin_amdgcn_mfma_f32_32x32x16_bf16(b1, q, p1, 0, 0, 0); }
}
DI int v_st(int k, int c) { const int kk = (k & ~0xC) | ((k & 4) << 1) | ((k & 8) >> 1); return ((kk >> 3) * 4 + (c >> 5)) * 512 + ((kk & 7) * 32 + (c & 31)) * 2; }
DI int v_rd_base(int lane) { return ((lane & 3) << 3) | (((lane >> 2) & 3) << 6) | (((lane >> 4) & 1) << 5) | (((lane >> 5) & 1) << 8); }
constexpr int v_rd_off(int d0, int ks, int half) { return d0 * 512 + ks * 4096 + half * 2048; }
template <int OFF> DI s16x4 tr_read(int vb) { s16x4 r; asm volatile("ds_read_b64_tr_b16 %0, %1 offset:%2" : "=&v"(r) : "v"(vb), "i"(OFF) : "memory"); return r; }
template <int D0> DI void pv_one(f32x16& od, int vb, bf16x8 pa0, bf16x8 pa1, bf16x8 pa2, bf16x8 pa3) {
    const s16x4 l0 = tr_read<v_rd_off(D0, 0, 0)>(vb), h0 = tr_read<v_rd_off(D0, 0, 1)>(vb), l1 = tr_read<v_rd_off(D0, 1, 0)>(vb), h1 = tr_read<v_rd_off(D0, 1, 1)>(vb);
    const s16x4 l2 = tr_read<v_rd_off(D0, 2, 0)>(vb), h2 = tr_read<v_rd_off(D0, 2, 1)>(vb), l3 = tr_read<v_rd_off(D0, 3, 0)>(vb), h3 = tr_read<v_rd_off(D0, 3, 1)>(vb);
    asm volatile("s_waitcnt lgkmcnt(0)" ::: "memory"); SBAR();
#define PKV(L, H) (bf16x8){L[0], L[1], L[2], L[3], H[0], H[1], H[2], H[3]}
    od = __builtin_amdgcn_mfma_f32_32x32x16_bf16(pa0, PKV(l0, h0), od, 0, 0, 0);
    od = __builtin_amdgcn_mfma_f32_32x32x16_bf16(pa1, PKV(l1, h1), od, 0, 0, 0);
    od = __builtin_amdgcn_mfma_f32_32x32x16_bf16(pa2, PKV(l2, h2), od, 0, 0, 0);
    od = __builtin_amdgcn_mfma_f32_32x32x16_bf16(pa3, PKV(l3, h3), od, 0, 0, 0);
#undef PKV
}
DI void pv_d0(f32x16* o, int vb, bf16x8 pa0, bf16x8 pa1, bf16x8 pa2, bf16x8 pa3) {
    pv_one<0>(o[0], vb, pa0, pa1, pa2, pa3); pv_one<1>(o[1], vb, pa0, pa1, pa2, pa3); pv_one<2>(o[2], vb, pa0, pa1, pa2, pa3); pv_one<3>(o[3], vb, pa0, pa1, pa2, pa3);
}
template <int DQK, int SDEPTH>
DI void attn_body(const bf16_t* __restrict__ Qb, const bf16_t* __restrict__ Kh, const bf16_t* __restrict__ Vh, bf16_t* __restrict__ Ob, int ldo, int seq, char* lds, const float SCALE) {
    using Cfg = AttnCfg<DQK>;
    constexpr int SHM_V = Cfg::SHM_V, SHM_K = Cfg::SHM_K, ND0 = Cfg::ND0, NKCH = Cfg::NKCH, KCPR = DQK / 8, NQR = Cfg::NQR;
    int tid = threadIdx.x; asm volatile("" : "+v"(tid));
    const int wid = tid >> 6, lane = tid & 63, r32 = lane & 31, hi = lane >> 5;
    char* V_lds = lds; char* K_lds = lds + 2 * SHM_V;
    float* ws = (float*)(lds + 2 * SHM_V + 2 * SHM_K) + wid * 64; float* li_l = ws; float* al_l = ws + 32;
    float m_reg = -1e30f, l_reg = 0; f32x16 o[4]; bf16x8 qr[NQR > 0 ? NQR : 1];
    char* Qs = lds + 2 * SHM_V + 2 * SHM_K + 8 * 64 * 4 + (wid * (ND0 - NQR) * 64 + lane) * 16;
#pragma unroll
    for (int d = 0; d < 4; ++d)
#pragma unroll
        for (int r = 0; r < 16; ++r) o[d][r] = 0.f;
    const bf16_t* Qw = Qb + (long)(wid * 32 + r32) * DQK + hi * 8;
#pragma unroll
    for (int d0 = 0; d0 < ND0; ++d0) { const bf16x8 qv = *reinterpret_cast<const bf16x8*>(Qw + d0 * 16); if (d0 < NQR) qr[d0] = qv; else *reinterpret_cast<bf16x8*>(Qs + (d0 - NQR) * 1024) = qv; }
    asm volatile("s_waitcnt lgkmcnt(0)" ::: "memory");
    const int sr = tid >> 4, sc = (tid & 15) * 8, vst0 = v_st(sr, sc), vst1 = v_st(32 + sr, sc);
    const int kgo = (tid >> 3) * DQK + (tid & 7) * 8, klo = (tid >> 3) * (DQK * 2) + (((tid & 7) << 4) ^ (((tid >> 3) & 7) << 4));
    const int vb0 = (int)(uintptr_t)V_lds + v_rd_base(lane);
    int kb[4];
#pragma unroll
    for (int m = 0; m < 4; ++m) { kb[m] = (int)(uintptr_t)K_lds + r32 * (DQK * 2) + 16 * (hi ^ (r32 & 1)) + 32 * (m ^ ((r32 >> 1) & 3)); asm volatile("" : "+v"(kb[m])); }
    struct { bf16x8 vs0, vs1, ks[NKCH]; } sr_[SDEPTH];
#define SLOAD(i, k0) do { sr_[i].vs0 = *(const bf16x8*)(&Vh[(long)((k0) + sr) * 128 + sc]); sr_[i].vs1 = *(const bf16x8*)(&Vh[(long)((k0) + 32 + sr) * 128 + sc]); \
    _Pragma("unroll") for (int q_ = 0; q_ < NKCH; ++q_) sr_[i].ks[q_] = *(const bf16x8*)(&Kh[(long)(k0) * DQK + kgo + q_ * 64]); } while (0)
#define SWRITE(b, i) do { *(bf16x8*)(V_lds + (b) * SHM_V + vst0) = sr_[i].vs0; *(bf16x8*)(V_lds + (b) * SHM_V + vst1) = sr_[i].vs1; \
    _Pragma("unroll") for (int q_ = 0; q_ < NKCH; ++q_) *(bf16x8*)(K_lds + (b) * SHM_K + klo + q_ * 128) = sr_[i].ks[q_]; } while (0)
#define SWAIT() do { if constexpr (SDEPTH == 1) asm volatile("s_waitcnt vmcnt(0)" ::: "memory"); else if constexpr (NKCH == 2) asm volatile("s_waitcnt vmcnt(4)" ::: "memory"); else asm volatile("s_waitcnt vmcnt(5)" ::: "memory"); } while (0)
#define RESC(a) do { if (__any((a) < 1.f)) { if (hi == 0) al_l[r32] = (a); asm volatile("s_waitcnt lgkmcnt(0)" ::: "memory"); \
    _Pragma("unroll") for (int d = 0; d < 4; ++d) _Pragma("unroll") for (int r = 0; r < 16; ++r) o[d][r] *= al_l[crow(r, hi)]; } } while (0)
    f32x16 pA0, pA1, pB0, pB1; float mnA, mnB, alA, alB; bf16x8 pa0, pa1, pa2, pa3; const int NT = seq / 64;
    constexpr int SE = 0, SO = SDEPTH - 1;
    SLOAD(SE, 0); asm volatile("s_waitcnt vmcnt(0)" ::: "memory"); SWRITE(0, SE); __syncthreads();
    qkt<DQK, NQR>(pA0, pA1, kb, 0, qr, (int)(uintptr_t)Qs, r32, hi); partialSM(pA0, pA1, m_reg, mnA, alA, SCALE);
    SLOAD(SO, 64); if constexpr (SDEPTH == 2) { if (2 < NT) SLOAD(SE, 2 * 64); }
    SWAIT(); SWRITE(1, SO); __syncthreads();
    for (int j = 1; j + 1 < NT; j += 2) {
        SBAR(); qkt<DQK, NQR>(pB0, pB1, kb, SHM_K, qr, (int)(uintptr_t)Qs, r32, hi);
        finishSM(pA0, pA1, alA, l_reg, pa0, pa1, pa2, pa3); SBAR();
        SLOAD(SO, (j + SDEPTH) * 64); SBAR();
        pv_d0(o, vb0, pa0, pa1, pa2, pa3); partialSM(pB0, pB1, m_reg, mnB, alB, SCALE);
        __syncthreads(); SWAIT(); SWRITE(0, SE);
        RESC(alB); __syncthreads();
        SBAR(); qkt<DQK, NQR>(pA0, pA1, kb, 0, qr, (int)(uintptr_t)Qs, r32, hi);
        finishSM(pB0, pB1, alB, l_reg, pa0, pa1, pa2, pa3); SBAR();
        if (SDEPTH == 1 || j + 3 < NT) SLOAD(SE, (j + 1 + SDEPTH) * 64); SBAR();
        pv_d0(o, vb0 + SHM_V, pa0, pa1, pa2, pa3); partialSM(pA0, pA1, m_reg, mnA, alA, SCALE);
        __syncthreads(); SWAIT(); SWRITE(1, SO);
        RESC(alA); __syncthreads();
    }
    SBAR(); qkt<DQK, NQR>(pB0, pB1, kb, SHM_K, qr, (int)(uintptr_t)Qs, r32, hi);
    finishSM(pA0, pA1, alA, l_reg, pa0, pa1, pa2, pa3); SBAR();
    pv_d0(o, vb0, pa0, pa1, pa2, pa3); partialSM(pB0, pB1, m_reg, mnB, alB, SCALE);
    __syncthreads(); RESC(alB);
    finishSM(pB0, pB1, alB, l_reg, pa0, pa1, pa2, pa3); SBAR();
    pv_d0(o, vb0 + SHM_V, pa0, pa1, pa2, pa3);
    if (hi == 0) li_l[r32] = l_reg; asm volatile("s_waitcnt lgkmcnt(0)" ::: "memory");
    float rli[16];
#pragma unroll
    for (int r = 0; r < 16; ++r) rli[r] = __builtin_amdgcn_rcpf(li_l[crow(r, hi)]);
    bf16_t* Ow = Ob + (long)(wid * 32) * ldo;
#pragma unroll
    for (int r = 0; r < 16; ++r) { const int orow = crow(r, hi);
#pragma unroll
        for (int d0 = 0; d0 < 4; ++d0) Ow[(long)orow * ldo + d0 * 32 + r32] = f2bf(o[d0][r] * rli[r]); }
    __syncthreads();
#undef SLOAD
#undef SWRITE
#undef SWAIT
#undef RESC
}

template <int DQK> DI void attn_body_old(const bf16_t* Qb, const bf16_t* Kh, const bf16_t* Vh, bf16_t* Ob, int ldo, int seq, char* lds, const float SCALE) {
    if constexpr (DQK == 192) attn_body<192, ATT_SD_M>(Qb, Kh, Vh, Ob, ldo, seq, lds, SCALE); else attn_body<128, ATT_SD_G>(Qb, Kh, Vh, Ob, ldo, seq, lds, SCALE);
}
template <int DQK>
DI void attn_body2(const bf16_t* __restrict__ Qb, const bf16_t* __restrict__ Kh, const bf16_t* __restrict__ Vh, bf16_t* __restrict__ Ob, int ldo, int seq, char* lds, const float SCALE) {
    constexpr int SHM_V = 64 * 128 * 2, SHM_K = 64 * DQK * 2, ND0 = DQK / 16, KP = SHM_K / 8192, VP = 2, NP = KP + VP;
    constexpr int V_RING = 0, K_RING = 4 * SHM_V, WS_OFF = K_RING + 3 * SHM_K;
    int tid = threadIdx.x; asm volatile("" : "+v"(tid));
    const int wid = __builtin_amdgcn_readfirstlane(tid >> 6), lane = tid & 63, r32 = lane & 31, hi = lane >> 5;
    float* ws = (float*)(lds + WS_OFF) + wid * 64; float* li_l = ws; float* al_l = ws + 32;
    float m_reg = -1e30f, l_reg = 0; f32x16 o[4]; bf16x8 qr[ND0];
#pragma unroll
    for (int d = 0; d < 4; ++d)
#pragma unroll
        for (int r = 0; r < 16; ++r) o[d][r] = 0.f;
    int kgo[KP], vgo[VP];
#pragma unroll
    for (int q = 0; q < KP; ++q) { const int sl = (wid * KP + q) * 64 + lane, row = sl / (DQK / 8), ch = sl % (DQK / 8), gch = (ch & ~7) | ((ch & 7) ^ (row & 7)); kgo[q] = row * DQK + gch * 8; }
#pragma unroll
    for (int q = 0; q < VP; ++q) { const int off = (wid * VP + q) * 1024 + lane * 16, sub = off >> 9, w = off & 511, kk = (sub >> 2) * 8 + (w >> 6), k = (kk & ~0xC) | ((kk & 4) << 1) | ((kk & 8) >> 1), c = (sub & 3) * 32 + ((w & 63) >> 1); vgo[q] = k * 128 + c; }
    LAS unsigned char* L = (LAS unsigned char*)lds;
#define DMA_TILE(t, ks, vs) do { \
    _Pragma("unroll") for (int q_ = 0; q_ < KP; ++q_) __builtin_amdgcn_global_load_lds((const unsigned*)(Kh + (size_t)(t) * 64 * DQK + kgo[q_]), (LAS unsigned*)(L + K_RING + (ks) * SHM_K + (wid * KP + q_) * 1024), 16, 0, 0); \
    _Pragma("unroll") for (int q_ = 0; q_ < VP; ++q_) __builtin_amdgcn_global_load_lds((const unsigned*)(Vh + (size_t)(t) * 64 * 128 + vgo[q_]), (LAS unsigned*)(L + V_RING + (vs) * SHM_V + (wid * VP + q_) * 1024), 16, 0, 0); } while (0)
    const int NT = seq / 64;
    DMA_TILE(0, 0, 0); DMA_TILE(1, 1, 1);
    const bf16_t* Qw = Qb + (long)(wid * 32 + r32) * DQK + hi * 8;
#pragma unroll
    for (int d0 = 0; d0 < ND0; ++d0) qr[d0] = *reinterpret_cast<const bf16x8*>(Qw + d0 * 16);
    const int vb0 = (int)(uintptr_t)(lds + V_RING) + v_rd_base(lane);
    int kb[4];
#pragma unroll
    for (int m = 0; m < 4; ++m) { kb[m] = (int)(uintptr_t)(lds + K_RING) + r32 * (DQK * 2) + 16 * (hi ^ (r32 & 1)) + 32 * (m ^ ((r32 >> 1) & 3)); asm volatile("" : "+v"(kb[m])); }
#define RESC(a) do { if (__any((a) < 1.f)) { if (hi == 0) al_l[r32] = (a); asm volatile("s_waitcnt lgkmcnt(0)" ::: "memory"); \
    _Pragma("unroll") for (int d = 0; d < 4; ++d) _Pragma("unroll") for (int r = 0; r < 16; ++r) o[d][r] *= al_l[crow(r, hi)]; } } while (0)
#define STEP_SYNC(j) do { if ((j) + 1 < NT) { if constexpr (NP == 5) asm volatile("s_waitcnt vmcnt(5)" ::: "memory"); else asm volatile("s_waitcnt vmcnt(4)" ::: "memory"); } else asm volatile("s_waitcnt vmcnt(0)" ::: "memory"); \
    asm volatile("s_waitcnt lgkmcnt(0)" ::: "memory"); __builtin_amdgcn_s_barrier(); asm volatile("" ::: "memory"); } while (0)
    f32x16 pA0, pA1, pB0, pB1; float mnA, mnB, alA, alB; bf16x8 pa0, pa1, pa2, pa3;
    asm volatile("s_waitcnt vmcnt(0)" ::: "memory");
    asm volatile("s_waitcnt lgkmcnt(0)" ::: "memory"); __builtin_amdgcn_s_barrier(); asm volatile("" ::: "memory");
    if (2 < NT) DMA_TILE(2, 2, 2);
    qkt<DQK, ND0>(pA0, pA1, kb, 0, qr, 0, r32, hi); partialSM(pA0, pA1, m_reg, mnA, alA, SCALE);
    int ks = 1, vs = 0;
    for (int j = 1; j + 1 < NT; j += 2) {
        STEP_SYNC(j);
        if (j + 2 < NT) { const int ks2 = ks == 0 ? 2 : ks - 1, vs2 = (vs + 3) & 3; DMA_TILE(j + 2, ks2, vs2); }
        SBAR(); qkt<DQK, ND0>(pB0, pB1, kb, ks * SHM_K, qr, 0, r32, hi);
        finishSM(pA0, pA1, alA, l_reg, pa0, pa1, pa2, pa3); SBAR();
        pv_d0(o, vb0 + vs * SHM_V, pa0, pa1, pa2, pa3); partialSM(pB0, pB1, m_reg, mnB, alB, SCALE);
        RESC(alB);
        ks = ks == 2 ? 0 : ks + 1; vs = (vs + 1) & 3;
        STEP_SYNC(j + 1);
        if (j + 3 < NT) { const int ks2 = ks == 0 ? 2 : ks - 1, vs2 = (vs + 3) & 3; DMA_TILE(j + 3, ks2, vs2); }
        SBAR(); qkt<DQK, ND0>(pA0, pA1, kb, ks * SHM_K, qr, 0, r32, hi);
        finishSM(pB0, pB1, alB, l_reg, pa0, pa1, pa2, pa3); SBAR();
        pv_d0(o, vb0 + vs * SHM_V, pa0, pa1, pa2, pa3); partialSM(pA0, pA1, m_reg, mnA, alA, SCALE);
        RESC(alA);
        ks = ks == 2 ? 0 : ks + 1; vs = (vs + 1) & 3;
    }
    STEP_SYNC(NT - 1);
    SBAR(); qkt<DQK, ND0>(pB0, pB1, kb, ks * SHM_K, qr, 0, r32, hi);
    finishSM(pA0, pA1, alA, l_reg, pa0, pa1, pa2, pa3); SBAR();
    pv_d0(o, vb0 + vs * SHM_V, pa0, pa1, pa2, pa3); partialSM(pB0, pB1, m_reg, mnB, alB, SCALE);
    RESC(alB);
    vs = (vs + 1) & 3;
    finishSM(pB0, pB1, alB, l_reg, pa0, pa1, pa2, pa3); SBAR();
    pv_d0(o, vb0 + vs * SHM_V, pa0, pa1, pa2, pa3);
    if (hi == 0) li_l[r32] = l_reg; asm volatile("s_waitcnt lgkmcnt(0)" ::: "memory");
    float rli[16];
#pragma unroll
    for (int r = 0; r < 16; ++r) rli[r] = __builtin_amdgcn_rcpf(li_l[crow(r, hi)]);
    bf16_t* Ow = Ob + (long)(wid * 32) * ldo;
#pragma unroll
    for (int r = 0; r < 16; ++r) { const int orow = crow(r, hi);
#pragma unroll
        for (int d0 = 0; d0 < 4; ++d0) Ow[(long)orow * ldo + d0 * 32 + r32] = f2bf(o[d0][r] * rli[r]); }
    asm volatile("s_waitcnt lgkmcnt(0)" ::: "memory"); __builtin_amdgcn_s_barrier(); asm volatile("" ::: "memory");
#undef DMA_TILE
#undef RESC
#undef STEP_SYNC
}

constexpr int GL_V = 0;
constexpr int GL_K = 16384;
constexpr int GL_Q = GL_K + 9216;
constexpr int GL_ZF = GL_Q + 9216;
constexpr int GL_ZB = GL_ZF + 4096;
constexpr int GL_LF = GL_ZB + 4096;
constexpr int GL_LB = GL_LF + 16640;
constexpr int GL_X0 = GL_LB + 16640;
constexpr int GL_KEF = GL_X0, GL_KEB = GL_X0 + 9216;
constexpr int GL_QD = GL_X0, GL_KI = GL_X0 + 9216;
constexpr int GL_O = GL_X0 + 18432;
static_assert(GL_O + 64 * 132 * 4 <= 160 * 1024 - 256, "GLA LDS");
DI int gla_row0(int b, int c) { return c < 4 ? NLAT + b * CTXL + c * 64 : b * SEQ + (c - 4) * 64; }
DI void gla_prep(PR p, int l, char* lds, int b, int h, int c, bool needq) {
    const int tid = tid_here(), lane = tid & 63, wid = tid >> 6;
    const bf16_t* PR_ = (const bf16_t*)(p.ws + WS_U + U_PROJ);
    const int row0 = gla_row0(b, c);
    {
        const int t = tid >> 3, dg = (tid & 7) * 8; const bf16_t* pr = PR_ + (size_t)(row0 + t) * INWP;
        *(bf16x8*)(lds + GL_K + t * 144 + dg * 2) = *(const bf16x8*)(pr + C_GK + h * 64 + dg);
        if (needq) { const bf16x8 qv = *(const bf16x8*)(pr + C_GQ + h * 64 + dg); u32x4 w;
            w.x = pk2(bf2f((bf16_t)qv[0]) * 0.125f, bf2f((bf16_t)qv[1]) * 0.125f); w.y = pk2(bf2f((bf16_t)qv[2]) * 0.125f, bf2f((bf16_t)qv[3]) * 0.125f);
            w.z = pk2(bf2f((bf16_t)qv[4]) * 0.125f, bf2f((bf16_t)qv[5]) * 0.125f); w.w = pk2(bf2f((bf16_t)qv[6]) * 0.125f, bf2f((bf16_t)qv[7]) * 0.125f);
            *(u32x4*)(lds + GL_Q + t * 144 + dg * 2) = w; }
        const int sr = tid >> 4, sc = (tid & 15) * 8;
        *(bf16x8*)(lds + GL_V + v_st(sr, sc)) = *(const bf16x8*)(PR_ + (size_t)(row0 + sr) * INWP + C_GV + h * 128 + sc);
        *(bf16x8*)(lds + GL_V + v_st(32 + sr, sc)) = *(const bf16x8*)(PR_ + (size_t)(row0 + 32 + sr) * INWP + C_GV + h * 128 + sc);
        if (tid < 256) { const int tt = (tid & 127) >> 1, half = tid & 1, dir = tid >> 7; const bf16x8 zv = *(const bf16x8*)(PR_ + (size_t)(row0 + tt) * INWP + (dir ? C_ZB : C_ZF) + half * 8);
            float* Z = (float*)(lds + (dir ? GL_ZB : GL_ZF)) + tt * 16 + half * 8;
#pragma unroll
            for (int j = 0; j < 8; ++j) Z[j] = bf2f((bf16_t)zv[j]); }
    }
    float wf[16], wb[16];
#pragma unroll
    for (int r = 0; r < 16; ++r) { wf[r] = p.gla_wg2_f[((size_t)l * 16 + r) * 256 + h * 64 + lane]; wb[r] = p.gla_wg2_b[((size_t)l * 16 + r) * 256 + h * 64 + lane]; }
    const float bgf = p.gla_bg_f[l * 256 + h * 64 + lane], bgb = p.gla_bg_b[l * 256 + h * 64 + lane];
    __syncthreads();
#pragma unroll
    for (int i = 0; i < 8; ++i) {
        const int t = wid * 8 + i; const float* ZF = (const float*)(lds + GL_ZF) + t * 16; const float* ZB = (const float*)(lds + GL_ZB) + t * 16;
        float zf = bgf, zb = bgb;
#pragma unroll
        for (int r = 0; r < 16; ++r) { zf += ZF[r] * wf[r]; zb += ZB[r] * wb[r]; }
        const float lf = fminf(zf, 0.f) - __logf(1.f + __expf(-fabsf(zf))), lb = fminf(zb, 0.f) - __logf(1.f + __expf(-fabsf(zb)));
        ((float*)(lds + GL_LF))[t * 65 + lane] = lf * 0.0625f; ((float*)(lds + GL_LB))[t * 65 + lane] = lb * 0.0625f;
    }
    __syncthreads();
#pragma unroll
    for (int i = 0; i < 8; ++i) {
        const int d = wid * 8 + i;
        float* F = (float*)(lds + GL_LF) + lane * 65 + d; float* Bk = (float*)(lds + GL_LB) + lane * 65 + d;
        float f = *F, g = *Bk;
#pragma unroll
        for (int o = 1; o < 64; o <<= 1) {
            const float fu = __int_as_float(__builtin_amdgcn_ds_bpermute(((lane - o) & 63) << 2, __float_as_int(f)));
            const float gu = __int_as_float(__builtin_amdgcn_ds_bpermute(((lane + o) & 63) << 2, __float_as_int(g)));
            if (lane >= o) f += fu; if (lane + o < 64) g += gu;
        }
        *F = f; *Bk = g;
    }
    __syncthreads();
}
DI void gla_phaseA(PR p, int l, char* lds) {
    float* GS = (float*)(p.ws + WS_U + U_GS); float* GD = (float*)(p.ws + WS_GDEC);
    for (int u = bid_here(); u < 16 * 68; u += gridDim.x) {
        const int bh = u / 68, c = u % 68, b = bh >> 2, h = bh & 3;
        gla_prep(p, l, lds, b, h, c, false);
        const int tid = tid_here(), lane = tid & 63, wid = tid >> 6, r32 = lane & 31, hi = lane >> 5;
        {
            const float* LF = (const float*)(lds + GL_LF); const float* LB = (const float*)(lds + GL_LB);
            const float lastf = LF[63 * 65 + lane], lastb = LB[0 * 65 + lane];
            float ef[8], eb[8];
#pragma unroll
            for (int i = 0; i < 8; ++i) { const int t = wid * 8 + i; const float k = bf2f(*(const bf16_t*)(lds + GL_K + t * 144 + lane * 2));
                ef[i] = k * __expf(lastf - LF[t * 65 + lane]); eb[i] = k * __expf(lastb - LB[t * 65 + lane]); }
            u32x4 w; w.x = pk2(ef[0], ef[1]); w.y = pk2(ef[2], ef[3]); w.z = pk2(ef[4], ef[5]); w.w = pk2(ef[6], ef[7]); *(u32x4*)(lds + GL_KEF + lane * 144 + wid * 16) = w;
            w.x = pk2(eb[0], eb[1]); w.y = pk2(eb[2], eb[3]); w.z = pk2(eb[4], eb[5]); w.w = pk2(eb[6], eb[7]); *(u32x4*)(lds + GL_KEB + lane * 144 + wid * 16) = w;
            if (wid == 0) { GD[((size_t)(0 * 16 + bh) * 68 + c) * 64 + lane] = __expf(lastf); GD[((size_t)(1 * 16 + bh) * 68 + c) * 64 + lane] = __expf(lastb); }
        }
        __syncthreads();
        {
            const int rh = wid & 1, cb = wid >> 1;
            const int vb = (int)(uintptr_t)(lds + GL_V) + v_rd_base(lane) + cb * 512;
#pragma unroll
            for (int dir = 0; dir < 2; ++dir) {
                const char* KE = lds + (dir ? GL_KEB : GL_KEF) + (rh * 32 + r32) * 144 + hi * 16;
                const bf16x8 a0 = *(const bf16x8*)(KE), a1 = *(const bf16x8*)(KE + 32), a2 = *(const bf16x8*)(KE + 64), a3 = *(const bf16x8*)(KE + 96);
                f32x16 od;
#pragma unroll
                for (int r = 0; r < 16; ++r) od[r] = 0.f;
                pv_one<0>(od, vb, a0, a1, a2, a3);
                float* dst = GS + ((size_t)(dir * 16 + bh) * 68 + c) * 8192 + (size_t)(cb * 32 + r32) * 64 + rh * 32 + 4 * hi;
#pragma unroll
                for (int g = 0; g < 4; ++g) *(f32x4*)(dst + 8 * g) = (f32x4){od[4 * g], od[4 * g + 1], od[4 * g + 2], od[4 * g + 3]};
            }
        }
        __syncthreads();
    }
}
DI void gla_scan(PR p) {
    const float* GS = (const float*)(p.ws + WS_U + U_GS); const float* GD = (const float*)(p.ws + WS_GDEC); bf16_t* GST = (bf16_t*)(p.ws + WS_U + U_GST);
    typedef float f32x2_ __attribute__((ext_vector_type(2)));
    const int tid = tid_here();
    for (int u = bid_here(); u < 256; u += gridDim.x) {
        const int e = u * NTHREADS + tid, db = e >> 12, jd2 = e & 4095, d2 = (jd2 & 31) * 2;
        const int dir = db >> 4;
        const float* base = GS + (size_t)db * 68 * 8192 + jd2 * 2; const float* dbase = GD + (size_t)db * 68 * 64 + d2; bf16_t* obase = GST + (size_t)db * 68 * 8192 + jd2 * 2;
#define SC_C(i) (dir == 0 ? (i) : ((i) < 4 ? 3 - (i) : 71 - (i)))
        float z0 = 0.f; asm volatile("" : "+v"(z0));
        f32x2_ S = {z0, z0};
        f32x2_ cur[4], nxt[4], dc[4], dn[4];
#pragma unroll
        for (int q = 0; q < 4; ++q) { const int c = SC_C(q); cur[q] = *(const f32x2_*)(base + (size_t)c * 8192); dc[q] = *(const f32x2_*)(dbase + c * 64); }
        for (int i = 0; i < 68; i += 4) {
            if (i + 4 < 68) {
#pragma unroll
                for (int q = 0; q < 4; ++q) { const int c = SC_C(i + 4 + q); nxt[q] = *(const f32x2_*)(base + (size_t)c * 8192); dn[q] = *(const f32x2_*)(dbase + c * 64); }
            }
#pragma unroll
            for (int q = 0; q < 4; ++q) { const int c = SC_C(i + q); *(unsigned*)(obase + (size_t)c * 8192) = pk2(S[0], S[1]); S = S * dc[q] + cur[q]; }
#pragma unroll
            for (int q = 0; q < 4; ++q) { cur[q] = nxt[q]; dc[q] = dn[q]; }
        }
#undef SC_C
    }
}
DI void gla_phaseC(PR p, int l, char* lds) {
    const bf16_t* GST = (const bf16_t*)(p.ws + WS_U + U_GST);
    const bf16_t* PR_ = (const bf16_t*)(p.ws + WS_U + U_PROJ); bf16_t* MIX = (bf16_t*)(p.ws + WS_U + U_MIX);
    unsigned* qctr = (unsigned*)(p.ws + WS_CTL) + 64 * (28 + l);
    const int nunits = l == 0 ? 16 * 68 : 16 * 64;
    for (;;) {
        volatile LAS int* flag = (volatile LAS int*)(shm + 32);
        __syncthreads();
        if (tid_here() == 0) *flag = (int)CTL_ADD(qctr, 1u);
        __syncthreads();
        const int u = __builtin_amdgcn_readfirstlane(*flag);
        if (u >= nunits) break;
        const int bh = l == 0 ? u / 68 : u >> 6, c = l == 0 ? u % 68 : 4 + (u & 63), b = bh >> 2, h = bh & 3;
        gla_prep(p, l, lds, b, h, c, true);
        const int tid = tid_here(), lane = tid & 63, wid = tid >> 6, r32 = lane & 31, hi = lane >> 5, rh = wid & 1, cb = wid >> 1;
        const int vb = (int)(uintptr_t)(lds + GL_V) + v_rd_base(lane) + cb * 512;
        f32x16 o;
#pragma unroll
        for (int r = 0; r < 16; ++r) o[r] = 0.f;
#pragma unroll
        for (int dir = 0; dir < 2; ++dir) {
            {
                const int t = tid >> 3, dg = (tid & 7) * 8; const float* LC = (const float*)(lds + (dir ? GL_LB : GL_LF)) + t * 65 + dg;
                const bf16x8 qv = *(const bf16x8*)(lds + GL_Q + t * 144 + dg * 2), kv = *(const bf16x8*)(lds + GL_K + t * 144 + dg * 2);
                float qd[8], ki[8];
#pragma unroll
                for (int j = 0; j < 8; ++j) { const float bc = LC[j]; qd[j] = bf2f((bf16_t)qv[j]) * __expf(bc); ki[j] = bf2f((bf16_t)kv[j]) * __expf(-bc); }
                u32x4 w; w.x = pk2(qd[0], qd[1]); w.y = pk2(qd[2], qd[3]); w.z = pk2(qd[4], qd[5]); w.w = pk2(qd[6], qd[7]); *(u32x4*)(lds + GL_QD + t * 144 + dg * 2) = w;
                w.x = pk2(ki[0], ki[1]); w.y = pk2(ki[2], ki[3]); w.z = pk2(ki[4], ki[5]); w.w = pk2(ki[6], ki[7]); *(u32x4*)(lds + GL_KI + t * 144 + dg * 2) = w;
            }
            __syncthreads();
            {
                const char* QD = lds + GL_QD + (rh * 32 + r32) * 144 + hi * 16; const char* KI = lds + GL_KI + r32 * 144 + hi * 16;
                bf16x8 qf[4];
#pragma unroll
                for (int d0 = 0; d0 < 4; ++d0) qf[d0] = *(const bf16x8*)(QD + d0 * 32);
                f32x16 p0, p1;
#pragma unroll
                for (int r = 0; r < 16; ++r) { p0[r] = 0.f; p1[r] = 0.f; }
#pragma unroll
                for (int d0 = 0; d0 < 4; ++d0) {
                    const bf16x8 k0 = *(const bf16x8*)(KI + d0 * 32), k1 = *(const bf16x8*)(KI + 32 * 144 + d0 * 32);
                    p0 = __builtin_amdgcn_mfma_f32_32x32x16_bf16(k0, qf[d0], p0, 0, 0, 0);
                    p1 = __builtin_amdgcn_mfma_f32_32x32x16_bf16(k1, qf[d0], p1, 0, 0, 0);
                }
                const int tq = rh * 32 + r32;
#pragma unroll
                for (int r = 0; r < 16; ++r) { const int s0 = crow(r, hi), s1 = 32 + s0;
                    const bool ok0 = dir == 0 ? (s0 <= tq) : (s0 >= tq), ok1 = dir == 0 ? (s1 <= tq) : (s1 >= tq);
                    p0[r] = ok0 ? p0[r] : 0.f; p1[r] = ok1 ? p1[r] : 0.f; }
                bf16x8 pa0, pa1, pa2, pa3;
#define PK4(P, BASE, OUT) do { unsigned a0 = cvtpk(P[BASE + 0], P[BASE + 1]), a1 = cvtpk(P[BASE + 2], P[BASE + 3]);   \
    unsigned b0 = cvtpk(P[BASE + 4], P[BASE + 5]), b1 = cvtpk(P[BASE + 6], P[BASE + 7]);                              \
    auto r0 = __builtin_amdgcn_permlane32_swap(a0, b0, false, false); auto r1 = __builtin_amdgcn_permlane32_swap(a1, b1, false, false); \
    u32x4 w_ = {r0[0], r1[0], r0[1], r1[1]}; OUT = *reinterpret_cast<bf16x8*>(&w_); } while (0)
                PK4(p0, 0, pa0); PK4(p0, 8, pa1); PK4(p1, 0, pa2); PK4(p1, 8, pa3);
#undef PK4
                pv_one<0>(o, vb, pa0, pa1, pa2, pa3);
                const bf16_t* Sg = GST + ((size_t)(dir * 16 + bh) * 68 + c) * 8192 + (size_t)(cb * 32 + r32) * 64 + hi * 8;
                const bf16x8 s0 = *(const bf16x8*)(Sg), s1 = *(const bf16x8*)(Sg + 16), s2 = *(const bf16x8*)(Sg + 32), s3 = *(const bf16x8*)(Sg + 48);
                o = __builtin_amdgcn_mfma_f32_32x32x16_bf16(qf[0], s0, o, 0, 0, 0);
                o = __builtin_amdgcn_mfma_f32_32x32x16_bf16(qf[1], s1, o, 0, 0, 0);
                o = __builtin_amdgcn_mfma_f32_32x32x16_bf16(qf[2], s2, o, 0, 0, 0);
                o = __builtin_amdgcn_mfma_f32_32x32x16_bf16(qf[3], s3, o, 0, 0, 0);
            }
            __syncthreads();
        }
        { float* O = (float*)(lds + GL_O);
#pragma unroll
          for (int r = 0; r < 16; ++r) O[(rh * 32 + crow(r, hi)) * 132 + cb * 32 + r32] = o[r]; }
        __syncthreads();
        {
            const int t = tid >> 3, jg = (tid & 7) * 16; const float* O = (const float*)(lds + GL_O) + t * 132 + jg;
            float v[16], ss = 0.f;
#pragma unroll
            for (int q = 0; q < 4; ++q) { const f32x4 x = *(const f32x4*)(O + 4 * q); v[4 * q] = x[0]; v[4 * q + 1] = x[1]; v[4 * q + 2] = x[2]; v[4 * q + 3] = x[3]; ss += x[0] * x[0] + x[1] * x[1] + x[2] * x[2] + x[3] * x[3]; }
            ss += shx(ss, 1, lane); ss += shx(ss, 2, lane); ss += shx(ss, 4, lane);
            const float rstd = rsqrtf(ss * (1.f / 128.f) + EPS);
            const int row = gla_row0(b, c) + t;
            const bf16_t* gp = PR_ + (size_t)row * INWP + C_GG + h * 128 + jg; const float* go = p.gla_g_out + l * 128 + jg;
            const bf16x8 g0 = *(const bf16x8*)(gp), g1 = *(const bf16x8*)(gp + 8);
            float ov[16];
#pragma unroll
            for (int j = 0; j < 16; ++j) { const float gate = bf2f((bf16_t)(j < 8 ? g0[j] : g1[j - 8])); ov[j] = v[j] * rstd * go[j] * silu_f(gate); }
            u32x4 w0, w1; w0.x = pk2(ov[0], ov[1]); w0.y = pk2(ov[2], ov[3]); w0.z = pk2(ov[4], ov[5]); w0.w = pk2(ov[6], ov[7]); w1.x = pk2(ov[8], ov[9]); w1.y = pk2(ov[10], ov[11]); w1.z = pk2(ov[12], ov[13]); w1.w = pk2(ov[14], ov[15]);
            bf16_t* dst = MIX + (size_t)row * D + h * 128 + jg; *(u32x4*)(dst) = w0; *(u32x4*)(dst + 8) = w1;
        }
        __syncthreads();
    }
}

namespace pg {
constexpr int BK = 64, HALF = 128, HTB = HALF * BK * 2, STAGE_BYTES = 8 * HTB;
DI int lds_byte(int r, int c) { const int st = (r >> 4) * 2 + (c >> 5), rr = r & 15, cc = c & 31, ob = rr * 64 + cc * 2; return st * 1024 + (ob ^ (((ob >> 9) & 1) << 5)); }
DI int perm32(int rho) { const int n = rho >> 4, i = rho & 15; return 8 * (i >> 2) + 4 * n + (i & 3); }
DI void stage_rc(int b, int& R, int& C) { const int st = b / 1024, sb = b % 1024, swz = sb ^ (((sb >> 9) & 1) << 5); R = (st >> 1) * 16 + swz / 64; C = (st & 1) * 32 + (swz % 64) / 2; }
struct XUnit {
    const char* A;
    const char* B;
    int arow0;
    int list;
    int e0, e1, e2, e3;
};
template <class Sched>
DI void gemm_phase(LAS unsigned char* lds, const LAS int* rowlists, const Sched& S) {
    int tid = threadIdx.x; asm volatile("" : "+v"(tid));
    const int wid = __builtin_amdgcn_readfirstlane(tid >> 6), lane = tid & 63, wr = wid >> 2, wc = wid & 3, fr = lane & 15, fq = lane >> 4;
    const int K = S.K, nt = K / BK;
    unsigned voffB[2];
#pragma unroll
    for (int i = 0; i < 2; ++i) { int R_, C_; stage_rc(tid * 16 + i * 8192, R_, C_); if (Sched::PERM) R_ = (R_ & ~31) + perm32(R_ & 31); voffB[i] = (unsigned)R_ * (unsigned)S.ldb + (unsigned)C_ * 2u; }
    const size_t kstep = (size_t)(BK * 2), hstepB = (size_t)HALF * S.ldb;
    const unsigned ldsw = (unsigned)wid * 1024u;
    const int aoff = lds_byte(wr * 64 + fr, fq * 8), boff = lds_byte(wc * 32 + fr, fq * 8);
#define PG_SA(b, h) (((b) * 2 + (h)) * HTB)
#define PG_SB(b, h) ((4 + (b) * 2 + (h)) * HTB)
#define PG_STAGE(bufoff, gbase, voff) do { _Pragma("unroll") for (int _i = 0; _i < 2; ++_i) \
        __builtin_amdgcn_global_load_lds((const unsigned*)((const char*)(gbase) + (voff)[_i]), (LAS unsigned*)(lds + (bufoff) + ldsw + _i * 8192), 16, 0, 0); } while (0)
#define PG_LDA(dst, b, h) do { _Pragma("unroll") for (int m = 0; m < 4; ++m) _Pragma("unroll") for (int k = 0; k < 2; ++k) dst[m][k] = *(const LAS bf16x8*)(lds + PG_SA(b, h) + aoff + m * 2048 + k * 1024); } while (0)
#define PG_LDB(dst, b, h) do { _Pragma("unroll") for (int n = 0; n < 2; ++n) _Pragma("unroll") for (int k = 0; k < 2; ++k) dst[n][k] = *(const LAS bf16x8*)(lds + PG_SB(b, h) + boff + n * 2048 + k * 1024); } while (0)
#define PG_MMA(ai, bj, At, Bt) do { __builtin_amdgcn_s_setprio(1); _Pragma("unroll") for (int m = 0; m < 4; ++m) _Pragma("unroll") for (int n = 0; n < 2; ++n) _Pragma("unroll") for (int k = 0; k < 2; ++k) \
        acc[ai][bj][m][n] = __builtin_amdgcn_mfma_f32_16x16x32_bf16(Bt[n][k], At[m][k], acc[ai][bj][m][n], 0, 0, 0); __builtin_amdgcn_s_setprio(0); } while (0)
#define PG_WAIT_V(n) asm volatile("s_waitcnt vmcnt(" #n ")" ::: "memory")
#define PG_WAIT_L(n) asm volatile("s_waitcnt lgkmcnt(" #n ")" ::: "memory")
#define PG_BAR __builtin_amdgcn_s_barrier()
#define PG_SCHED __builtin_amdgcn_sched_barrier(0)
#define PG_AOFFS(dst, u) do { const int _t = tid_here(); _Pragma("unroll") for (int _i = 0; _i < 2; ++_i) { int _R, _C; stage_rc(_t * 16 + _i * 8192, _R, _C); _Pragma("unroll") for (int _h = 0; _h < 2; ++_h) { \
        unsigned _row; if ((u).list >= 0) { const int _x = rowlists[(u).list + _h * HALF + _R]; _row = _x >= 0 ? (unsigned)(_x >> S.rowshift) : 0u; } else _row = (unsigned)((u).arow0 + _h * HALF + _R); \
        dst[_h][_i] = _row * (unsigned)S.lda + (unsigned)_C * 2u; } } } while (0)
    XUnit cur, nxt; int ui = 0;
    if (!S.next(0, cur)) return;
    f32x4 acc[2][2][4][2];
#pragma unroll
    for (int a = 0; a < 2; ++a)
#pragma unroll
        for (int b = 0; b < 2; ++b)
#pragma unroll
            for (int m = 0; m < 4; ++m)
#pragma unroll
                for (int n = 0; n < 2; ++n) acc[a][b][m][n] = (f32x4){0.f, 0.f, 0.f, 0.f};
    bf16x8 At[4][2], B0[2][2], B1[2][2];
    unsigned ao[2][2];
    PG_AOFFS(ao, cur);
    PG_WAIT_L(0); PG_SCHED;
    const char* cA = cur.A; const char* cB = cur.B;
    PG_STAGE(PG_SB(0, 0), cB, voffB); PG_STAGE(PG_SA(0, 0), cA, ao[0]); PG_STAGE(PG_SB(0, 1), cB + hstepB, voffB); PG_STAGE(PG_SA(0, 1), cA, ao[1]);
    if (wr == 1) PG_BAR;
    PG_WAIT_V(4); PG_BAR;
    PG_STAGE(PG_SB(1, 0), cB + kstep, voffB); PG_STAGE(PG_SA(1, 0), cA + kstep, ao[0]); PG_STAGE(PG_SB(1, 1), cB + hstepB + kstep, voffB);
    PG_WAIT_V(6); PG_BAR;
    for (;;) {
        const bool has_next = S.next(ui + 1, nxt);
        const char* nA = has_next ? nxt.A : cA; const char* nB = has_next ? nxt.B : cB;
        for (int t = 0; t < nt; t += 2) {
            const bool last = (t == nt - 2);
            const char* a1 = cA + (size_t)(t + 1) * kstep;
            const char* a2 = last ? nA : cA + (size_t)(t + 2) * kstep; const char* b2 = last ? nB : cB + (size_t)(t + 2) * kstep;
            const char* a3 = a2 + kstep; const char* b3 = b2 + kstep;
            PG_LDB(B0, 0, 0); PG_SCHED; PG_LDA(At, 0, 0); PG_STAGE(PG_SA(1, 1), a1, ao[1]);
            PG_WAIT_L(8); PG_BAR; PG_WAIT_L(0); PG_MMA(0, 0, At, B0); PG_BAR; PG_SCHED;
            if (last && has_next) { PG_AOFFS(ao, nxt); }
            PG_LDB(B1, 0, 1); PG_STAGE(PG_SB(0, 0), b2, voffB);
            PG_BAR; PG_WAIT_L(0); PG_MMA(0, 1, At, B1); PG_BAR;
            PG_LDA(At, 0, 1); PG_STAGE(PG_SA(0, 0), a2, ao[0]);
            PG_BAR; PG_WAIT_L(0); PG_MMA(1, 0, At, B0); PG_BAR; PG_SCHED;
            PG_STAGE(PG_SB(0, 1), b2 + hstepB, voffB);
            PG_WAIT_V(6); PG_BAR; PG_MMA(1, 1, At, B1); PG_BAR;
            PG_LDB(B0, 1, 0); PG_SCHED; PG_LDA(At, 1, 0); PG_STAGE(PG_SA(0, 1), a2, ao[1]);
            PG_WAIT_L(8); PG_BAR; PG_WAIT_L(0); PG_MMA(0, 0, At, B0); PG_BAR; PG_SCHED;
            PG_LDB(B1, 1, 1); PG_STAGE(PG_SB(1, 0), b3, voffB);
            PG_BAR; PG_WAIT_L(0); PG_MMA(0, 1, At, B1); PG_BAR;
            PG_LDA(At, 1, 1); PG_STAGE(PG_SA(1, 0), a3, ao[0]);
            PG_BAR; PG_WAIT_L(0); PG_MMA(1, 0, At, B0); PG_BAR; PG_SCHED;
            PG_STAGE(PG_SB(1, 1), b3 + hstepB, voffB);
            PG_WAIT_V(6); PG_BAR; PG_MMA(1, 1, At, B1); PG_BAR;
        }
        { const int t2 = tid_here(), w2 = t2 >> 6, l2 = t2 & 63; S.epi(acc, cur, w2 >> 2, w2 & 3, l2 & 15, l2 >> 4); }
        if (!has_next) break;
#pragma unroll
        for (int a = 0; a < 2; ++a)
#pragma unroll
            for (int b = 0; b < 2; ++b)
#pragma unroll
                for (int m = 0; m < 4; ++m)
#pragma unroll
                    for (int n = 0; n < 2; ++n) acc[a][b][m][n] = (f32x4){0.f, 0.f, 0.f, 0.f};
        cur = nxt; cA = nA; cB = nB; ++ui;
    }
    PG_WAIT_V(0);
    if (wr == 0) PG_BAR;
    PG_BAR;
#undef PG_SA
#undef PG_SB
#undef PG_STAGE
#undef PG_LDA
#undef PG_LDB
#undef PG_MMA
#undef PG_WAIT_V
#undef PG_WAIT_L
#undef PG_BAR
#undef PG_SCHED
#undef PG_AOFFS
}
}

DI void router_group(PR p, int l, float* LG, int row0, bool dry) {
    const int lane = tid_here() & 63;
    const unsigned char* wl = p.ws + WS_WEIGHTS + (size_t)l * WL_END;
    const bf16_t* WH = (const bf16_t*)(wl + WL_WRH); const bf16_t* WLo = (const bf16_t*)(wl + WL_WRL);
    const bf16_t* HH = (const bf16_t*)(p.ws + WS_HBUF); const bf16_t* HL = (const bf16_t*)(p.ws + WS_U + U_HLO);
    int* EIDX = (int*)(p.ws + WS_EIDX); float* EW = (float*)(p.ws + WS_EW); int* EPOS = (int*)(p.ws + WS_EPOS);
    unsigned* cnt = (unsigned*)(p.ws + WS_CNT) + l * 64;
    const float rbias = p.router_b[l * 64 + lane];
    int* PKI = (int*)(LG + 16 * 65);
    const int fr = lane & 15, fq = lane >> 4;
    {
        f32x4 acc[4];
#pragma unroll
        for (int e = 0; e < 4; ++e) acc[e] = (f32x4){0.f, 0.f, 0.f, 0.f};
        const bf16_t* ah = HH + (size_t)(row0 + fr) * D + fq * 8; const bf16_t* al = HL + (size_t)(row0 + fr) * D + fq * 8;
        const bf16_t* bh = WH + (size_t)fr * D + fq * 8; const bf16_t* bl = WLo + (size_t)fr * D + fq * 8;
#pragma unroll 1
        for (int k0 = 0; k0 < D; k0 += 128) {
            bf16x8 a_hi[4], a_lo[4], b_hi[4][4], b_lo[4][4];
#pragma unroll
            for (int j = 0; j < 4; ++j) { a_hi[j] = *(const bf16x8*)(ah + k0 + 32 * j); if (ROUTER_SPLIT) a_lo[j] = *(const bf16x8*)(al + k0 + 32 * j);
#pragma unroll
                for (int e = 0; e < 4; ++e) { b_hi[j][e] = *(const bf16x8*)(bh + (size_t)e * 16 * D + k0 + 32 * j); if (ROUTER_SPLIT) b_lo[j][e] = *(const bf16x8*)(bl + (size_t)e * 16 * D + k0 + 32 * j); } }
#pragma unroll
            for (int j = 0; j < 4; ++j)
#pragma unroll
                for (int e = 0; e < 4; ++e) {
                    acc[e] = __builtin_amdgcn_mfma_f32_16x16x32_bf16(a_hi[j], b_hi[j][e], acc[e], 0, 0, 0);
                    if (ROUTER_SPLIT) { acc[e] = __builtin_amdgcn_mfma_f32_16x16x32_bf16(a_hi[j], b_lo[j][e], acc[e], 0, 0, 0);
                                        acc[e] = __builtin_amdgcn_mfma_f32_16x16x32_bf16(a_lo[j], b_hi[j][e], acc[e], 0, 0, 0); }
                }
        }
#pragma unroll
        for (int e = 0; e < 4; ++e)
#pragma unroll
            for (int i = 0; i < 4; ++i) LG[(fq * 4 + i) * 65 + e * 16 + fr] = acc[e][i];
        asm volatile("s_waitcnt lgkmcnt(0)" ::: "memory");
        __builtin_amdgcn_wave_barrier();
        int mycount = 0;
        for (int t = 0; t < 16; ++t) {
            const float sc = sigmoid_f(LG[t * 65 + lane]), v = sc + rbias;
            float m1 = v, m2 = -INFINITY;
#pragma unroll
            for (int o = 1; o < 8; o <<= 1) { const float b1 = shx(m1, o, lane), b2 = shx(m2, o, lane); const float n1 = fmaxf(m1, b1), n2 = fmaxf(fminf(m1, b1), fmaxf(m2, b2)); m1 = n1; m2 = n2; }
            const float gs = m1 + m2;
            int grank = 0; const int g = lane >> 3;
#pragma unroll
            for (int gg = 0; gg < 8; ++gg) { const float s = __int_as_float(__builtin_amdgcn_readlane(__float_as_int(gs), gg * 8)); grank += (s > gs || (s == gs && gg < g)) ? 1 : 0; }
            const bool gsel = grank < 4;
            const float vs = gsel ? v : -INFINITY;
            int erk = 0;
#pragma unroll 4
            for (int j = 0; j < 64; ++j) { const float s = __int_as_float(__builtin_amdgcn_readlane(__float_as_int(vs), j)); erk += (s > vs || (s == vs && j < lane)) ? 1 : 0; }
            const bool chosen = gsel && erk < 8;
            const float wsum = wave_sum(chosen ? sc : 0.f);
            int pk = -1;
            if (chosen) { const int a = (row0 + t) * 8 + erk; EIDX[a] = lane; EW[a] = sc * (2.5f / wsum); pk = erk | (mycount << 8); ++mycount; }
            PKI[t * 64 + lane] = pk;
        }
        const unsigned base = (mycount && !dry) ? atomicAdd(&cnt[lane], (unsigned)mycount) : 0u;
        if (!dry) {
#pragma unroll
            for (int t = 0; t < 16; ++t) { const int pk = PKI[t * 64 + lane]; if (pk >= 0) EPOS[(row0 + t) * 8 + (pk & 255)] = (int)base + (pk >> 8); }
        }
        asm volatile("s_waitcnt lgkmcnt(0)" ::: "memory");
        __builtin_amdgcn_wave_barrier();
    }
}
DI void phase_router(PR p, int l, char* lds, bool dry = false) {
    const int tid = tid_here(), wid = tid >> 6;
    const int ntok = l == 0 ? NTOK : NLAT, ngrp = ntok / 16;
    for (int gidx = bid_here() * 8 + wid; gidx < ngrp; gidx += gridDim.x * 8) router_group(p, l, (float*)lds + wid * (16 * 65 + 16 * 64), gidx * 16, dry);
}
DI void phase_moe_index(PR p, int l, char* lds) {
    const int tid = tid_here();
    int* S = (int*)lds;
    const unsigned* cnt = (const unsigned*)(p.ws + WS_CNT) + l * 64;
    int* META = (int*)(p.ws + WS_META) + l * 1024;
    const int* EIDX = (const int*)(p.ws + WS_EIDX); const float* EW = (const float*)(p.ws + WS_EW); const int* EPOS = (const int*)(p.ws + WS_EPOS);
    int* SASG = (int*)(p.ws + WS_SASG); float* SW = (float*)(p.ws + WS_SW);
    if (tid < 64) S[128 + tid] = (int)cnt[tid];
    __syncthreads();
    if (tid == 0) { int s = 0; for (int e = 0; e < 64; ++e) { S[e] = s; s += (S[128 + e] + 255) / 256 * 256; } S[64] = s; }
    __syncthreads();
    const int ntok = l == 0 ? NTOK : NLAT;
    for (int a = bid_here() * NTHREADS + tid; a < ntok * 8; a += gridDim.x * NTHREADS) { const int e = EIDX[a], pos = S[e] + EPOS[a]; SASG[pos] = a; SW[pos] = EW[a]; }
    for (int i = bid_here() * NTHREADS + tid; i < 64 * 256; i += gridDim.x * NTHREADS) { const int e = i >> 8, q = i & 255, c = S[128 + e]; if (S[e] + c + q < S[e + 1]) { SASG[S[e] + c + q] = -1; SW[S[e] + c + q] = 0.f; } }
    if (blockIdx.x == 0) {
        if (tid == 0) META[0] = S[64] / 256;
        if (tid < 64) { for (int t = S[tid] / 256; t < S[tid + 1] / 256; ++t) META[256 + t] = tid; }
    }
}

struct OrderXcd {
    int nM, nN, nwg;
    DI void init(int nM_, int nN_) { nM = nM_; nN = nN_; nwg = nM_ * nN_; }
    DI bool map(int i, int& pm, int& pn) const {
        const int L = i * (int)gridDim.x + (int)blockIdx.x; if (L >= nwg) return false;
        int wgid = L; { const int q = nwg / 8, r = nwg % 8, xcd = wgid % 8, off = wgid / 8; wgid = (xcd < r ? xcd * (q + 1) : r * (q + 1) + (xcd - r) * q) + off; }
        const int nig = 8 * nN, gid = wgid / nig, fm = gid * 8, gsz = (nM - fm) < 8 ? (nM - fm) : 8;
        pm = fm + ((wgid % nig) % gsz); pn = (wgid % nig) / gsz; return true;
    }
    DI bool lin(int i, int& w) const {
        const int L = i * (int)gridDim.x + (int)blockIdx.x; if (L >= nwg) return false;
        const int q = nwg / 8, r = nwg % 8, xcd = L % 8, off = L / 8; w = (xcd < r ? xcd * (q + 1) : r * (q + 1) + (xcd - r) * q) + off; return true;
    }
};
#define GACC const f32x4 (&acc)[2][2][4][2]
struct SchedInproj {
    static constexpr bool PERM = true;
    int lda, ldb, K, rowshift; const char* A; const char* W; bf16_t* proj; OrderXcd o;
    DI bool next(int i, pg::XUnit& u) const { int pm, pn; if (!o.map(i, pm, pn)) return false; u.A = A; u.B = W + (size_t)pn * 256 * ldb; u.arow0 = pm * 256; u.list = -1; u.e0 = pm * 256; u.e1 = pn * 256; return true; }
    DI void epi(GACC, const pg::XUnit& u, int wr, int wc, int fr, int fq) const { EpiB16P E; E.O = proj; E.row0 = u.e0; E.col0 = u.e1; E.ld = INWP; E(acc, wr, wc, fr, fq); }
};
DI void phase_inproj(PR p, int l, char* lds) {
    SchedInproj S; S.lda = D * 2; S.ldb = D * 2; S.K = D; S.rowshift = 0; S.A = (const char*)(p.ws + WS_HBUF); S.W = (const char*)(p.ws + WS_WEIGHTS + (size_t)l * WL_END + WL_WIN);
    S.proj = (bf16_t*)(p.ws + WS_U + U_PROJ); S.o.init(68, 15);
    pg::gemm_phase((LAS unsigned char*)lds, (const LAS int*)(lds + pg::STAGE_BYTES), S);
}
struct SchedMlaUp {
    static constexpr bool PERM = false;
    int lda, ldb, K, rowshift; const char* CQ; const char* CKV; const char* WQ; const char* WKV; bf16_t* Qm; bf16_t* Km; bf16_t* Vm; const float2* ropem; OrderXcd o;
    DI bool next(int i, pg::XUnit& u) const { int w; if (!o.lin(i, w)) return false; u.list = -1;
        if (w < 340) { const int pm = w / 5, pn = w % 5; u.A = CQ; u.B = WQ + (size_t)pn * 256 * ldb; u.arow0 = pm * 256; u.e0 = pm * 256; u.e1 = pn * 256; u.e3 = 0; }
        else { const int v = w - 340, pm = v / 6, pn = v % 6; u.A = CKV; u.B = WKV + (size_t)pn * 256 * ldb; u.arow0 = pm * 256; u.e0 = pm * 256; u.e1 = pn * 256; u.e3 = 1; }
        return true; }
    DI void epi(GACC, const pg::XUnit& u, int wr, int wc, int fr, int fq) const {
        if (u.e3 == 0) { EpiUq E; E.Q = Qm; E.ropem = ropem; E.row0 = u.e0; E.col0 = u.e1; E(acc, wr, wc, fr, fq); }
        else { EpiUkv E; E.Km = Km; E.Vm = Vm; E.row0 = u.e0; E.col0 = u.e1; E(acc, wr, wc, fr, fq); } }
};
DI void phase_mla_up(PR p, int l, char* lds) {
    unsigned char* U = p.ws + WS_U; const unsigned char* wl = p.ws + WS_WEIGHTS + (size_t)l * WL_END;
    SchedMlaUp S; S.lda = 1024; S.ldb = 1024; S.K = 512; S.rowshift = 0; S.CQ = (const char*)(U + U_CQN); S.CKV = (const char*)(U + U_CKVN); S.WQ = (const char*)(wl + WL_WUQ); S.WKV = (const char*)(wl + WL_WUKV);
    S.Qm = (bf16_t*)(U + U_QM); S.Km = (bf16_t*)(U + U_KM); S.Vm = (bf16_t*)(U + U_VM); S.ropem = (const float2*)(p.ws + WS_ROPEM); S.o.init(748, 1);
    pg::gemm_phase((LAS unsigned char*)lds, (const LAS int*)(lds + pg::STAGE_BYTES), S);
}
struct SchedOutproj {
    static constexpr bool PERM = true;
    int lda, ldb, K, rowshift; const char* A; const char* W; bf16_t* Y; OrderXcd o;
    DI bool next(int i, pg::XUnit& u) const { int pm, pn; if (!o.map(i, pm, pn)) return false; u.A = A; u.B = W + (size_t)pn * 256 * ldb; u.arow0 = pm * 256; u.list = -1; u.e0 = pm * 256; u.e1 = pn * 256; return true; }
    DI void epi(GACC, const pg::XUnit& u, int wr, int wc, int fr, int fq) const { EpiB16P E; E.O = Y; E.row0 = u.e0; E.col0 = u.e1; E.ld = D; E(acc, wr, wc, fr, fq); }
};
DI void phase_outproj(PR p, int l, char* lds) {
    SchedOutproj S; S.lda = D * 2; S.ldb = D * 2; S.K = D; S.rowshift = 0; S.A = (const char*)(p.ws + WS_U + U_MIX); S.W = (const char*)(p.ws + WS_WEIGHTS + (size_t)l * WL_END + WL_WOUT);
    S.Y = (bf16_t*)(p.ws + WS_U + U_Y); S.o.init(l == 0 ? 68 : 64, 8);
    pg::gemm_phase((LAS unsigned char*)lds, (const LAS int*)(lds + pg::STAGE_BYTES), S);
}
struct SchedMoe1 {
    static constexpr bool PERM = true;
    int lda, ldb, K, rowshift; const char* H; const char* W13; bf16_t* act; const LAS int* uexp; int ntiles; OrderXcd o;
    DI bool next(int i, pg::XUnit& u) const { int tile, pn; if (!o.map(i, tile, pn)) return false; u.A = H;
        if (tile < ntiles) { const int e = __builtin_amdgcn_readfirstlane(uexp[i]); u.B = W13 + ((size_t)e * 1024 + pn * 256) * ldb; u.list = i * 256; u.arow0 = 0; u.e0 = tile * 256; }
        else { const int ts = tile - ntiles; u.B = W13 + ((size_t)64 * 1024 + pn * 256) * ldb; u.list = -1; u.arow0 = ts * 256; u.e0 = PMAX + ts * 256; }
        u.e1 = pn * 128; return true; }
    DI void epi(GACC, const pg::XUnit& u, int wr, int wc, int fr, int fq) const { EpiMoe1P E; E.act = act; E.arow0 = u.e0; E.hcol0 = u.e1; E(acc, wr, wc, fr, fq); }
};
DI void phase_moe1(PR p, int l, char* lds) {
    const int* META = (const int*)(p.ws + WS_META) + l * 1024; const int ntiles = __builtin_amdgcn_readfirstlane(META[0]), nsh = l == 0 ? 68 : 64;
    SchedMoe1 S; S.lda = D * 2; S.ldb = D * 2; S.K = D; S.rowshift = 3; S.H = (const char*)(p.ws + WS_HBUF); S.W13 = (const char*)(p.ws + WS_WEIGHTS + (size_t)l * WL_END + WL_W13);
    S.act = (bf16_t*)(p.ws + WS_U + U_ACT); S.uexp = (const LAS int*)(lds + pg::STAGE_BYTES) + 31 * 256; S.ntiles = ntiles; S.o.init(ntiles + nsh, 4);
    { const int tid = tid_here(); LAS int* RL = (LAS int*)(lds + pg::STAGE_BYTES); const int* SASG = (const int*)(p.ws + WS_SASG);
      for (int i = 0; i < 31; ++i) { int tile, pn; if (!S.o.map(i, tile, pn)) break; if (tile < ntiles && tid < 256) RL[i * 256 + tid] = SASG[tile * 256 + tid];
          if (tid == 0) RL[31 * 256 + i] = tile < ntiles ? META[256 + tile] : 64; }
      __syncthreads(); }
    pg::gemm_phase((LAS unsigned char*)lds, (const LAS int*)(lds + pg::STAGE_BYTES), S);
}
struct SchedMoe2 {
    static constexpr bool PERM = true;
    int lda, ldb, K, rowshift; const char* ACT; const char* W2; bf16_t* oasg; const int* sasg; const float* sw; bf16_t* ysh; const LAS int* uexp; int ntiles; int fp8; OrderXcd o;
    DI bool next(int i, pg::XUnit& u) const { int tile, pn; if (!o.map(i, tile, pn)) return false; u.A = ACT; u.list = -1;
        if (tile < ntiles) { const int e = __builtin_amdgcn_readfirstlane(uexp[i]); u.B = W2 + ((size_t)e * D + pn * 256) * ldb; u.arow0 = tile * 256; u.e0 = tile * 256; u.e3 = 0; }
        else { const int ts = tile - ntiles; u.B = W2 + ((size_t)64 * D + pn * 256) * ldb; u.arow0 = PMAX + ts * 256; u.e0 = ts * 256; u.e3 = 1; }
        u.e1 = pn * 256; return true; }
    DI void epi(GACC, const pg::XUnit& u, int wr, int wc, int fr, int fq) const {
        if (u.e3 == 0 && fp8) { EpiMoe2F8 E; E.oasg = (unsigned char*)oasg; E.sasg = sasg; E.sw = sw; E.srow0 = u.e0; E.col0 = u.e1; E(acc, wr, wc, fr, fq); }
        else if (u.e3 == 0) { EpiMoe2P E; E.oasg = oasg; E.sasg = sasg; E.sw = sw; E.srow0 = u.e0; E.col0 = u.e1; E(acc, wr, wc, fr, fq); }
        else { EpiB16P E; E.O = ysh; E.row0 = u.e0; E.col0 = u.e1; E.ld = D; E(acc, wr, wc, fr, fq); } }
};
DI void phase_moe2(PR p, int l, char* lds) {
    const int* META = (const int*)(p.ws + WS_META) + l * 1024; const int ntiles = __builtin_amdgcn_readfirstlane(META[0]), nsh = l == 0 ? 68 : 64;
    SchedMoe2 S; S.lda = 1024; S.ldb = 1024; S.K = 512; S.rowshift = 0; S.ACT = (const char*)(p.ws + WS_U + U_ACT); S.W2 = (const char*)(p.ws + WS_WEIGHTS + (size_t)l * WL_END + WL_W2);
    S.oasg = (bf16_t*)(p.ws + WS_U + U_OASG); S.sasg = (const int*)(p.ws + WS_SASG); S.sw = (const float*)(p.ws + WS_SW); S.ysh = (bf16_t*)(p.ws + WS_U + U_YSH); S.uexp = (const LAS int*)(lds + pg::STAGE_BYTES); S.ntiles = ntiles; S.fp8 = (OASG_FP8_MASK >> l) & 1; S.o.init(ntiles + nsh, 8);
    { const int tid = tid_here(); LAS int* UE = (LAS int*)(lds + pg::STAGE_BYTES);
      if (tid < 64) { int tile, pn; if (S.o.map(tid, tile, pn)) UE[tid] = tile < ntiles ? META[256 + tile] : 64; }
      __syncthreads(); }
    pg::gemm_phase((LAS unsigned char*)lds, (const LAS int*)(lds + pg::STAGE_BYTES), S);
}
DI void phase_attention(PR p, int l, char* lds) {
#define ATT_PTRS unsigned char* U = p.ws + WS_U; asm volatile("" : "+s"(U)); \
    const bf16_t* Qm = (const bf16_t*)(U + U_QM); const bf16_t* Km = (const bf16_t*)(U + U_KM); const bf16_t* Vm = (const bf16_t*)(U + U_VM); \
    const bf16_t* Qg = (const bf16_t*)(U + U_QG); const bf16_t* Kg = (const bf16_t*)(U + U_KG); const bf16_t* Vg = (const bf16_t*)(U + U_VG); bf16_t* MIX = (bf16_t*)(U + U_MIX);
    const int xcd = blockIdx.x & 7, rank = blockIdx.x >> 3, nr = (gridDim.x + 7 - xcd) >> 3;
    const int nloc = 48 + (l == 0 ? 3 : 0);
    if (SUB & 1) for (int v = rank; v < nloc; v += nr) {
        ATT_PTRS; (void)Qg; (void)Kg; (void)Vg;
        int b, h, qt, isctx;
        if (v < 48) { const int bh = xcd * 3 + v / 16; b = bh / 6; h = bh % 6; qt = v & 15; isctx = 0; } else { const int bh = xcd * 3 + (v - 48); b = bh / 6; h = bh % 6; qt = 0; isctx = 1; }
        const int qpos = isctx ? 0 : CTXL + qt * 256, seq = isctx ? CTXL : SKV, orow = isctx ? NLAT + b * CTXL : b * SEQ + qt * 256;
        ATT_BODY<192>(Qm + (((size_t)b * 6 + h) * SKV + qpos) * 192, Km + ((size_t)b * 6 + h) * SKV * 192, Vm + ((size_t)b * 6 + h) * SKV * 128,
                                 MIX + (size_t)orow * D + 512 + h * 128, D, seq, lds, 0.07216878364870322f);
    }
    if (SUB & 2) for (int v = nr - 1 - rank; v < nloc; v += nr) {
        ATT_PTRS; (void)Qm; (void)Km; (void)Vm;
        int b, h, qt, isctx; const int kvh = xcd & 1; b = xcd >> 1;
        if (v < 48) { h = kvh * 3 + v / 16; qt = v & 15; isctx = 0; } else { h = kvh * 3 + (v - 48); qt = 0; isctx = 1; }
        const int qpos = isctx ? 0 : CTXL + qt * 256, seq = isctx ? CTXL : SKV, orow = isctx ? NLAT + b * CTXL : b * SEQ + qt * 256;
        ATT_BODY<128>(Qg + (((size_t)b * 6 + h) * SKV + qpos) * 128, Kg + ((size_t)b * 2 + kvh) * SKV * 128, Vg + ((size_t)b * 2 + kvh) * SKV * 128,
                                 MIX + (size_t)orow * D + 1280 + h * 128, D, seq, lds, 0.08838834764831845f);
    }
#undef ATT_PTRS
    if (SUB & 4) gla_phaseC(p, l, lds);
}

constexpr int NPH_LAYER = 12, NPH = 1 + 2 * NPH_LAYER;
constexpr int LDS_BYTES = 160 * 1024;
__global__ void __launch_bounds__(NTHREADS, 2) fwd(Params p_arg, int ph_lo, int ph_hi) {
    char* lds = shm + 256;
    volatile LAS unsigned* xbw = (volatile LAS unsigned*)shm;
    const bool fused = (ph_hi - ph_lo) > 1;
    XcdBarrier bar; bar.bar = (unsigned*)(p_arg.ws + WS_BAR); bar.x = 0; bar.st = xbw;
    if (fused) {
        if (threadIdx.x == 0) { xbw[0] = 0u; xbw[1] = 0u; xbw[2] = 0u; xbw[3] = 0u; }
        __syncthreads();
        bar = xcd_barrier_post((unsigned*)(p_arg.ws + WS_BAR), xbw);
    }
    const CAS Params* pk = (const CAS Params*)__builtin_amdgcn_kernarg_segment_ptr();
#define PHASE(idx, CALL) do { if (((PH_MASK >> ((idx) == 0 ? 0 : ((idx) - 1) % NPH_LAYER + 1)) & 1) && (idx) >= ph_lo && (idx) < ph_hi) { const CAS Params* q_ = pk; asm volatile("" : "+s"(q_)); PR p = *q_; int probe_pass = 0; (void)probe_pass; CALL; if ((PROBE_MASK >> ((idx) == 0 ? 0 : ((idx) - 1) % NPH_LAYER + 1)) & 1) { probe_pass = 1; CALL; } if (fused && (idx) + 1 < ph_hi) xcd_barrier(bar); } } while (0)
#define TAIL(ph) ((fused && !probe_pass) ? fill_tail(p, lds, (ph)) : (void)0)
    PHASE(0, phase_prologue(p, lds));
    for (int l = 0; l < 2; ++l) {
        const int b0 = 1 + l * NPH_LAYER;
        if (l == 0) PHASE(b0 + 0, phase_norm1(p, 0));
        PHASE(b0 + 1, phase_inproj(p, l, lds));
        PHASE(b0 + 2, (phase_postproj_rows(p, l), gla_phaseA(p, l, lds)));
        PHASE(b0 + 3, (phase_mla_up(p, l, lds), gla_scan(p)));
        PHASE(b0 + 4, (phase_attention(p, l, lds), TAIL(b0 + 4)));
        PHASE(b0 + 5, phase_outproj(p, l, lds));
        PHASE(b0 + 6, ((probe_pass && l == 1) ? (void)0 : phase_postmix(p, l, lds, FUSE_ROUTER && !probe_pass)));
        if (!FUSE_ROUTER) PHASE(b0 + 7, phase_router(p, l, lds, probe_pass != 0));
        PHASE(b0 + 8, (phase_moe_index(p, l, lds), fill_drain(p, lds, (l + 1) * CHUNKS_PER_LAYER)));
        PHASE(b0 + 9, (move_head(p, (l + 1) * CHUNKS_PER_LAYER), phase_moe1(p, l, lds), TAIL(b0 + 9)));
        PHASE(b0 + 10, (phase_moe2(p, l, lds), TAIL(b0 + 10)));
        PHASE(b0 + 11, ((probe_pass && l == 0) ? (void)0 : phase_postffn(p, l)));
    }
#undef PHASE
#undef TAIL
}

extern "C" void kernel_launch(void* const* d_in, const int* in_sizes, int n_in, void* d_out, int out_size, void* d_ws, size_t ws_size, hipStream_t stream) {
    static int grid = 0;
    if (!grid) {
        if (ws_size < WS_TOTAL) { fprintf(stderr, "kernel_launch: workspace too small: %zu < %zu\n", ws_size, (size_t)WS_TOTAL); return; }
        if (hipFuncSetAttribute((const void*)fwd, hipFuncAttributeMaxDynamicSharedMemorySize, LDS_BYTES) != hipSuccess) { fprintf(stderr, "kernel_launch: hipFuncSetAttribute failed\n"); return; }
        int dev = 0, cus = 0, per_cu = 0;
        hipGetDevice(&dev);
        hipDeviceGetAttribute(&cus, hipDeviceAttributeMultiprocessorCount, dev);
        hipOccupancyMaxActiveBlocksPerMultiprocessor(&per_cu, fwd, NTHREADS, LDS_BYTES);
        if (per_cu < 1) { fprintf(stderr, "kernel_launch: occupancy query says %d\n", per_cu); return; }
        grid = cus;
    }
    Params p{};
    const float** f = (const float**)&p;
    for (int i = 0; i < 31; ++i) f[i] = (const float*)d_in[i];
    p.out = (float*)d_out; p.ws = (unsigned char*)d_ws;
    hipMemsetAsync((unsigned char*)d_ws + WS_BAR, 0, WS_CNT, stream);
#if MK_MULTI
    for (int ph = 0; ph < NPH; ++ph) { if (ph == 1 + NPH_LAYER) continue; hipLaunchKernelGGL(fwd, dim3(grid), dim3(NTHREADS), LDS_BYTES, stream, p, ph, ph + 1); }
#else
    hipLaunchKernelGGL(fwd, dim3(grid), dim3(NTHREADS), LDS_BYTES, stream, p, 0, NPH);
#endif
    const hipError_t le = hipPeekAtLastError();
    if (le != hipSuccess) fprintf(stderr, "kernel_launch: launch failed: %s\n", hipGetErrorName(le));
}
```

```cpp
#include <hip/hip_runtime.h>
#include <stdint.h>
#include <stdio.h>

#ifndef PH_MASK
#define PH_MASK 0x1FFF
#endif
#ifndef SUB
#define SUB 7
#endif
#ifndef ATT_SD_M
#define ATT_SD_M 1
#endif
#ifndef ATT_SD_G
#define ATT_SD_G 2
#endif
#ifndef ATT_NQR_M
#define ATT_NQR_M 12
#endif
#ifndef PROBE_MASK
#define PROBE_MASK 0x0
#endif
#ifndef PROBE_SUB
#define PROBE_SUB 7
#endif
#ifndef PROBE_SIDE
#define PROBE_SIDE 0
#endif
#ifndef PROBE_SIDE_DRY
#define PROBE_SIDE_DRY 0
#endif
#ifndef PROBE_DRY
#define PROBE_DRY 0
#endif
#ifndef ATT_DMA
#define ATT_DMA 1
#endif
#if ATT_DMA
#define ATT_BODY attn_body2_sel
#else
#define ATT_BODY attn_body_old
#endif
#ifndef ROUTER_SPLIT
#define ROUTER_SPLIT 0
#endif
#ifndef FUSE_ROUTER
#define FUSE_ROUTER 0
#endif
#ifndef STAG_MOE1
#define STAG_MOE1 0
#endif
#ifndef STAG_MOE2
#define STAG_MOE2 0
#endif
#ifndef CVT_IN_ATT
#define CVT_IN_ATT 0
#endif
#ifndef SIDE_STREAM
#define SIDE_STREAM 1
#endif
#ifndef MOE_FP8
#define MOE_FP8 1
#endif
#ifndef INPROJ_FP8
#define INPROJ_FP8 1
#endif
#ifndef OUTPROJ_FP8
#define OUTPROJ_FP8 1
#endif
#ifndef MK_MULTI
#define MK_MULTI 0
#endif

typedef unsigned short bf16_t;
typedef short bf16x8 __attribute__((ext_vector_type(8)));
typedef short s16x4 __attribute__((ext_vector_type(4)));
typedef float f32x4 __attribute__((ext_vector_type(4)));
typedef float f32x16 __attribute__((ext_vector_type(16)));
typedef unsigned u32x4 __attribute__((ext_vector_type(4)));
typedef unsigned u32x2 __attribute__((ext_vector_type(2)));
#define DI __device__ __forceinline__

constexpr float F8_SH = 8.f, F8_SW13 = 512.f, F8_SACT = 8.f, F8_SW2 = 16.f;
constexpr float F8_INV1 = 1.f / (F8_SH * F8_SW13), F8_INV2 = 1.f / (F8_SACT * F8_SW2);
constexpr float F8_SMIX = 16.f, F8_INV3 = 1.f / (F8_SMIX * F8_SW13);
DI unsigned f8pack4(float a, float b, float c, float d) {
    a = __builtin_amdgcn_fmed3f(a, -440.f, 440.f); b = __builtin_amdgcn_fmed3f(b, -440.f, 440.f); c = __builtin_amdgcn_fmed3f(c, -440.f, 440.f); d = __builtin_amdgcn_fmed3f(d, -440.f, 440.f);
    int t = __builtin_amdgcn_cvt_pk_fp8_f32(a, b, 0, false); t = __builtin_amdgcn_cvt_pk_fp8_f32(c, d, t, true); return (unsigned)t; }
constexpr int D = 2048, NB = 4, SEQ = 4096, CTXL = 256, NLAT = NB * SEQ, NCTX = NB * CTXL, NTOK = NLAT + NCTX, SKV = SEQ + CTXL;
constexpr int INW = 3808, INWP = 3840;
constexpr int C_GQ = 0, C_GK = 256, C_GV = 512, C_GG = 1024, C_ZF = 1536, C_ZB = 1552, C_CQ = 1568, C_CKV = 1952, C_KR = 2464, C_AQ = 2528, C_AK = 3296, C_AV = 3552;
constexpr int NE = 64, TOPK = 8, DEXP = 512;
constexpr int PMAX = NTOK * TOPK + NE * 256;
constexpr int NTHREADS = 512;
constexpr float EPS = 1e-6f;

constexpr size_t MiB = 1024ull * 1024ull;
constexpr size_t al256(size_t x) { return (x + 255) / 256 * 256; }
constexpr size_t WS_BAR = 0;
constexpr size_t WS_CTL = 16384;
constexpr size_t WS_CNT = 16384 + 8192;
constexpr size_t WS_META = WS_CNT + 1024;
constexpr size_t WS_MOD = WS_META + 2 * 4096;
constexpr size_t WS_ROPEG = al256(WS_MOD + 2 * 5 * 12288 * 4);
constexpr size_t WS_ROPEM = WS_ROPEG + 64 * 32 * 8;
constexpr size_t WS_ZROW = WS_ROPEM + 64 * 16 * 8;
constexpr size_t WS_GDEC = WS_ZROW + 4096;
constexpr size_t WS_EIDX = al256(WS_GDEC + 2 * 16 * 68 * 64 * 4);
constexpr size_t WS_EW = WS_EIDX + (size_t)NTOK * 8 * 4;
constexpr size_t WS_EPOS = WS_EW + (size_t)NTOK * 8 * 4;
constexpr size_t WS_SASG = WS_EPOS + (size_t)NTOK * 8 * 4;
constexpr size_t WS_SW = al256(WS_SASG + (size_t)PMAX * 4);
constexpr size_t WS_SMALL_END = al256(WS_SW + (size_t)PMAX * 4);
static_assert(WS_SMALL_END <= 8 * MiB, "small region");
constexpr size_t SZ_WIN = (size_t)INWP * D * 2, SZ_WUQ = (size_t)1280 * 512 * 2, SZ_WUKV = (size_t)1536 * 512 * 2, SZ_WOUT = (size_t)D * D * 2, SZ_WR = (size_t)64 * D * 2;
constexpr size_t SZ_W13 = (size_t)65 * 1024 * D * 2, SZ_W2 = (size_t)65 * D * 512 * 2;
constexpr size_t WL_WIN = 0, WL_WUQ = WL_WIN + SZ_WIN, WL_WUKV = WL_WUQ + SZ_WUQ, WL_WOUT = WL_WUKV + SZ_WUKV, WL_WRH = WL_WOUT + SZ_WOUT, WL_WRL = WL_WRH + SZ_WR,
                 WL_W13 = WL_WRL + SZ_WR, WL_W2 = WL_W13 + SZ_W13, WL_END = WL_W2 + SZ_W2;
constexpr size_t WS_WEIGHTS = 8 * MiB;
constexpr size_t WS_XRES = WS_WEIGHTS + 2 * WL_END;
constexpr size_t WS_HBUF = WS_XRES + (size_t)NTOK * D * 4;
constexpr size_t WS_U = WS_HBUF + (size_t)NTOK * D * 2;
constexpr size_t U_Y = 0;
constexpr size_t U_YSH = (size_t)NTOK * D * 2;
constexpr size_t U_PROJ = U_Y + (size_t)NTOK * D * 4;
constexpr size_t U_QM = U_PROJ + (size_t)NTOK * INWP * 2;
constexpr size_t U_KM = U_QM + (size_t)NB * 6 * SKV * 192 * 2;
constexpr size_t U_VM = U_KM + (size_t)NB * 6 * SKV * 192 * 2;
constexpr size_t U_QG = U_VM + (size_t)NB * 6 * SKV * 128 * 2;
constexpr size_t U_KG = U_QG + (size_t)NB * 6 * SKV * 128 * 2;
constexpr size_t U_VG = U_KG + (size_t)NB * 2 * SKV * 128 * 2;
constexpr size_t U_GS = U_VG + (size_t)NB * 2 * SKV * 128 * 2;
constexpr size_t U_MIX = U_GS + (size_t)2 * 16 * 68 * 64 * 128 * 4;
constexpr size_t U_CQN = U_MIX + (size_t)NTOK * D * 2;
constexpr size_t U_CKVN = U_CQN + (size_t)NTOK * 512 * 2;
constexpr size_t U_GST = U_CKVN + (size_t)NTOK * 512 * 2;
constexpr size_t U_MIX_END = U_GST + (size_t)2 * 16 * 68 * 8192 * 2;
constexpr size_t U_HLO = U_PROJ;
constexpr size_t U_ACT = U_HLO + (size_t)NTOK * D * 2;
constexpr size_t U_OASG = U_ACT + (size_t)(PMAX + NTOK) * 512 * 2;
constexpr size_t U_MOE_END = U_OASG + (size_t)NTOK * 8 * D * 2;
constexpr size_t WS_TOTAL = WS_U + (U_MIX_END > U_MOE_END ? U_MIX_END : U_MOE_END);
static_assert(WS_TOTAL <= 2048ull * MiB, "workspace over 2 GiB");
static_assert(!(MOE_FP8 && ROUTER_SPLIT), "U_HLO holds either the router's lo part or the fp8 copy of the FFN input");
static_assert(MOE_FP8 && SIDE_STREAM && !CVT_IN_ATT, "the fp8 expert weights are produced by the attention side stream only");

struct Params {
    const float *x, *c, *ctx, *c_ctx, *w_mod, *b_mod, *g_pre_mix, *g_post_mix, *g_pre_ffn, *g_post_ffn, *w_in, *gla_wg2_f, *gla_bg_f, *gla_wg2_b, *gla_bg_b, *gla_g_out,
        *mla_g_q, *mla_w_uq, *mla_g_kv, *mla_w_ukv, *gqa_g_q, *gqa_g_k, *w_out, *router_w, *router_b, *exp_w1, *exp_w3, *exp_w2, *sh_w1, *sh_w3, *sh_w2;
    float* out; unsigned char* ws;
};

extern __shared__ __attribute__((aligned(16))) char shm[];
#define CAS __attribute__((address_space(4)))
typedef const CAS Params& PR;
DI int bid_here() { int b = blockIdx.x; asm volatile("" : "+s"(b)); return b; }
DI int tid_here() { int t = threadIdx.x; asm volatile("" : "+v"(t)); return t; }
DI float bf2f(bf16_t v) { return __uint_as_float(((unsigned)v) << 16); }
DI bf16_t f2bf(float f) { unsigned u = __float_as_uint(f); u += 0x7FFFu + ((u >> 16) & 1u); return (bf16_t)(u >> 16); }
DI unsigned pk2(float lo, float hi) { unsigned r; asm("v_cvt_pk_bf16_f32 %0, %1, %2" : "=v"(r) : "v"(lo), "v"(hi)); return r; }
DI float shx(float v, int o, int lane) { return __int_as_float(__builtin_amdgcn_ds_bpermute((lane ^ o) << 2, __float_as_int(v))); }
#define DPP_ADD(v, ctrl) (v) += __int_as_float(__builtin_amdgcn_update_dpp(0, __float_as_int(v), (ctrl), 0xF, 0xF, true))
DI float wave_sum(float v) {
    const int lane = tid_here() & 63;
    DPP_ADD(v, 0xB1);
    DPP_ADD(v, 0x4E);
    DPP_ADD(v, 0x141);
    DPP_ADD(v, 0x140);
    v += shx(v, 16, lane);
    { auto rr = __builtin_amdgcn_permlane32_swap(__float_as_uint(v), __float_as_uint(v), false, false); v = __uint_as_float(rr[0]) + __uint_as_float(rr[1]); }
    return v;
}
DI float silu_f(float v) { return v * __builtin_amdgcn_rcpf(1.f + __expf(-v)); }
DI float sigmoid_f(float v) { return __builtin_amdgcn_rcpf(1.f + __expf(-v)); }
struct Tok { int b, s, isctx, mrow, kvpos; };
DI Tok tok_of(int r) { Tok t; if (r < NLAT) { t.b = r >> 12; t.s = r & 4095; t.isctx = 0; t.mrow = t.b; t.kvpos = CTXL + t.s; } else { const int q = r - NLAT; t.b = q >> 8; t.s = q & 255; t.isctx = 1; t.mrow = 4; t.kvpos = t.s; } return t; }
DI const float* xrow_in(PR p, int l, int r) { if (l == 0) return r < NLAT ? p.x + (size_t)r * D : p.ctx + (size_t)(r - NLAT) * D; return (const float*)(p.ws + WS_XRES) + (size_t)r * D; }

#define XB_TMO      128
#define XB_XCNT(j)  (256  + 64 * (j))
#define XB_XSUB(j)  (1280 + 64 * (j))
#define XB_XGEN(j)  (2304 + 64 * (j))
#define XB_TOP      3328
#define XB_TOPGEN   3392
#define XCD_BAR_WORDS 3456
#define XB_SPIN_CAP (1u << 18)
#define LAS __attribute__((address_space(3)))
__device__ __forceinline__ unsigned xb_ld(unsigned* p)              { return __hip_atomic_load(p, __ATOMIC_RELAXED, __HIP_MEMORY_SCOPE_AGENT); }
__device__ __forceinline__ unsigned xb_add(unsigned* p, unsigned v) { return __hip_atomic_fetch_add(p, v, __ATOMIC_RELAXED, __HIP_MEMORY_SCOPE_AGENT); }
__device__ __forceinline__ unsigned xb_xcc_id() { return (unsigned)__builtin_amdgcn_s_getreg((3 << 11) | 20) & 0xFu; }
#define XB_SPIN(cond, bar) do { unsigned _sp = 0; while (cond) { __builtin_amdgcn_s_sleep(1); \
    if ((++_sp & 255u) == 0u) { if (xb_ld(&(bar)[XB_TMO])) break; if (_sp > XB_SPIN_CAP) { atomicAdd(&(bar)[XB_TMO], 1u); break; } } } } while (0)
struct XcdBarrier { unsigned* bar; unsigned x; volatile LAS unsigned* st; };
__device__ __forceinline__ XcdBarrier xcd_barrier_post(unsigned* bar, volatile LAS unsigned* st) {
    XcdBarrier b; b.bar = bar; b.x = xb_xcc_id(); b.st = st;
    if (threadIdx.x == 0) (void)xb_add(&bar[XB_XCNT(b.x)], 1u);
    return b;
}
__device__ __forceinline__ void xcd_barrier_complete(unsigned* bar, unsigned x, unsigned& nloc, unsigned& nx) {
    const unsigned G = gridDim.x * gridDim.y * gridDim.z;
    unsigned sum, cnt, mine, sp = 0u;
    for (;;) {
        sum = 0u; cnt = 0u; mine = 0u;
#pragma unroll
        for (unsigned j = 0; j < 16; ++j) { const unsigned c = xb_ld(&bar[XB_XCNT(j)]); sum += c; cnt += (c > 0u) ? 1u : 0u; mine = (j == x) ? c : mine; }
        if (sum == G) break;
        __builtin_amdgcn_s_sleep(1);
        if ((++sp & 255u) == 0u) { if (xb_ld(&bar[XB_TMO])) break; if (sp > XB_SPIN_CAP) { atomicAdd(&bar[XB_TMO], 1u); break; } }
    }
    nloc = mine > 0u ? mine : 1u; nx = cnt > 0u ? cnt : 1u;
}
__device__ __forceinline__ void xcd_barrier(const XcdBarrier& b) {
    asm volatile("s_waitcnt vmcnt(0)" ::: "memory");
    __syncthreads();
    if (threadIdx.x == 0) {
        unsigned* bar = b.bar;
        __builtin_amdgcn_s_waitcnt(0);
        unsigned nloc = b.st[0], nx = b.st[1];
        if (nloc == 0u) { xcd_barrier_complete(bar, b.x, nloc, nx); b.st[0] = nloc; b.st[1] = nx; }
        const unsigned old = xb_add(&bar[XB_XSUB(b.x)], 1u);
        const unsigned gen = old / nloc;
        if (old + 1u == (gen + 1u) * nloc) {
            __builtin_amdgcn_fence(__ATOMIC_RELEASE, "agent");
            asm volatile("s_waitcnt vmcnt(0)" ::: "memory");
            const unsigned og = xb_add(&bar[XB_TOP], 1u);
            const unsigned tg = og / nx;
            if (og + 1u == (tg + 1u) * nx) xb_add(&bar[XB_TOPGEN], 1u);
            else XB_SPIN(xb_ld(&bar[XB_TOPGEN]) == tg, bar);
            __builtin_amdgcn_fence(__ATOMIC_ACQUIRE, "agent");
            xb_add(&bar[XB_XGEN(b.x)], 1u);
            asm volatile("s_waitcnt vmcnt(0)" ::: "memory");
        } else {
            XB_SPIN(xb_ld(&bar[XB_XGEN(b.x)]) == gen, bar);
            __builtin_amdgcn_fence(__ATOMIC_ACQUIRE, "agent");
            asm volatile("s_waitcnt vmcnt(0)" ::: "memory");
        }
    }
    __syncthreads();
}

template <int KT>
DI void cvt_tile(char* lds, const float* src, int ldS, int Nvalid, bf16_t* dst, bf16_t* dst_lo, int ldD, int k0, int n0, int drow0, const float* gk, float f8scale = 0.f) {
    float* T = (float*)lds;
    const int tid = tid_here();
    {
        const int c4 = tid & 15, kr = tid >> 4, n = n0 + c4 * 4;
        f32x4 v[KT / 32];
#pragma unroll
        for (int i = 0; i < KT / 32; ++i) { v[i] = (f32x4){0.f, 0.f, 0.f, 0.f}; if (n < Nvalid) v[i] = __builtin_nontemporal_load((const f32x4*)(src + (size_t)(k0 + kr + 32 * i) * ldS + n)); }
#pragma unroll
        for (int i = 0; i < KT / 32; ++i) { const int k = kr + 32 * i; if (gk) v[i] = v[i] * gk[k0 + k];
            T[k * 65 + c4 * 4 + 0] = v[i][0]; T[k * 65 + c4 * 4 + 1] = v[i][1]; T[k * 65 + c4 * 4 + 2] = v[i][2]; T[k * 65 + c4 * 4 + 3] = v[i][3]; }
    }
    __syncthreads();
    {
        constexpr int KPL = KT / 8;
        const int nl = tid >> 3, kc = (tid & 7) * KPL;
#pragma unroll
        for (int q = 0; q < KPL / 8; ++q) {
            float v[8];
#pragma unroll
            for (int j = 0; j < 8; ++j) v[j] = T[(kc + q * 8 + j) * 65 + nl];
            if (f8scale != 0.f) {
                u32x2 w8; w8.x = f8pack4(v[0] * f8scale, v[1] * f8scale, v[2] * f8scale, v[3] * f8scale); w8.y = f8pack4(v[4] * f8scale, v[5] * f8scale, v[6] * f8scale, v[7] * f8scale);
                *(u32x2*)((unsigned char*)dst + (size_t)(drow0 + nl) * ldD + k0 + kc + q * 8) = w8; continue; }
            u32x4 w; w.x = pk2(v[0], v[1]); w.y = pk2(v[2], v[3]); w.z = pk2(v[4], v[5]); w.w = pk2(v[6], v[7]);
            *(u32x4*)(dst + (size_t)(drow0 + nl) * ldD + k0 + kc + q * 8) = w;
            if (dst_lo) {
                float r[8];
#pragma unroll
                for (int j = 0; j < 8; ++j) r[j] = v[j] - bf2f(f2bf(v[j]));
                u32x4 w2; w2.x = pk2(r[0], r[1]); w2.y = pk2(r[2], r[3]); w2.z = pk2(r[4], r[5]); w2.w = pk2(r[6], r[7]);
                *(u32x4*)(dst_lo + (size_t)(drow0 + nl) * ldD + k0 + kc + q * 8) = w2;
            }
        }
    }
    __syncthreads();
}
template <int KT>
DI void cvt_matrix(char* lds, const float* src, int K, int N, int Npad, bf16_t* dst, bf16_t* dst_lo, int mode, const float* gk, int ldD = 0, float f8scale = 0.f) {
    if (ldD == 0) ldD = K;
    const int nkt = K / KT, nnt = Npad / 64, nt = nkt * nnt;
    for (int t = bid_here(); t < nt; t += gridDim.x) {
        const int kt = t % nkt, ntile = t / nkt, n0 = ntile * 64;
        int drow0 = n0;
        if (mode == 1) drow0 = (n0 >> 7) * 256 + (n0 & 127);
        else if (mode == 2) drow0 = (n0 >> 7) * 256 + 128 + (n0 & 127);
        cvt_tile<KT>(lds, src, N, N, dst, dst_lo, ldD, kt * KT, n0, drow0, gk, f8scale);
    }
}
constexpr int CHUNKS_PER_LAYER = 65 * 192, CHUNKS_TOTAL = 2 * CHUNKS_PER_LAYER;
DI void cvt_chunk(PR p, char* lds, int g) {
    const int l = g / CHUNKS_PER_LAYER, gg = g % CHUNKS_PER_LAYER;
    unsigned char* wl = p.ws + WS_WEIGHTS + (size_t)l * WL_END;
    const int e = gg / 192, r = gg % 192, m = r >> 6, t = r & 63;
    bf16_t* d13 = (bf16_t*)(wl + WL_W13) + (size_t)e * 1024 * D; bf16_t* d2 = (bf16_t*)(wl + WL_W2) + (size_t)e * D * 512;
    if (m < 2) {
        const float* src = m == 0 ? (e < 64 ? p.exp_w1 + ((size_t)l * 64 + e) * D * 512 : p.sh_w1 + (size_t)l * D * 512) : (e < 64 ? p.exp_w3 + ((size_t)l * 64 + e) * D * 512 : p.sh_w3 + (size_t)l * D * 512);
        const int kt = t & 7, n0 = (t >> 3) * 64, drow0 = (n0 >> 7) * 256 + m * 128 + (n0 & 127);
        cvt_tile<256>(lds, src, 512, 512, d13, nullptr, D, kt * 256, n0, drow0, nullptr);
    } else {
        const float* src = e < 64 ? p.exp_w2 + ((size_t)l * 64 + e) * 512 * D : p.sh_w2 + (size_t)l * 512 * D;
        const int kt = t & 1, n0 = (t >> 1) * 64;
        cvt_tile<256>(lds, src, D, D, d2, nullptr, 512, kt * 256, n0, n0, nullptr);
    }
}
struct CvtDesc { const float* src; bf16_t* dst; int ldS, ldD, k0, n0, drow0; };
struct SideCvt { int rem, l, e, r, sub, de, dr, dry; };
DI CvtDesc chunk_desc(PR p, int g) {
    CvtDesc d; const int l = g / CHUNKS_PER_LAYER, gg = g % CHUNKS_PER_LAYER;
    unsigned char* wl = p.ws + WS_WEIGHTS + (size_t)l * WL_END;
    const int e = gg / 192, r = gg % 192, m = r >> 6, t = r & 63;
    if (m < 2) { d.src = m == 0 ? (e < 64 ? p.exp_w1 + ((size_t)l * 64 + e) * D * 512 : p.sh_w1 + (size_t)l * D * 512) : (e < 64 ? p.exp_w3 + ((size_t)l * 64 + e) * D * 512 : p.sh_w3 + (size_t)l * D * 512);
        d.dst = MOE_FP8 ? (bf16_t*)(wl + WL_W13 + (size_t)e * 1024 * D) : (bf16_t*)(wl + WL_W13) + (size_t)e * 1024 * D; d.ldS = 512; d.ldD = D; d.k0 = (t & 7) * 256; d.n0 = (t >> 3) * 64; d.drow0 = (d.n0 >> 7) * 256 + m * 128 + (d.n0 & 127); }
    else { d.src = e < 64 ? p.exp_w2 + ((size_t)l * 64 + e) * 512 * D : p.sh_w2 + (size_t)l * 512 * D;
        d.dst = MOE_FP8 ? (bf16_t*)(wl + WL_W2 + (size_t)e * D * 512) : (bf16_t*)(wl + WL_W2) + (size_t)e * D * 512; d.ldS = D; d.ldD = 512; d.k0 = (t & 1) * 256; d.n0 = (t >> 1) * 64; d.drow0 = d.n0; }
    return d;
}
DI void cvt_load(const CvtDesc& d, f32x4 (&v)[8], int tid) {
    const int c4 = tid & 15, kr = tid >> 4;
#pragma unroll
    for (int i = 0; i < 8; ++i) v[i] = __builtin_nontemporal_load((const f32x4*)(d.src + (size_t)(d.k0 + kr + 32 * i) * d.ldS + d.n0 + c4 * 4));
}
DI void cvt_finish(char* lds, const CvtDesc& d, const f32x4 (&v)[8], int tid) {
    float* T = (float*)lds;
    { const int c4 = tid & 15, kr = tid >> 4;
#pragma unroll
      for (int i = 0; i < 8; ++i) { const int k = kr + 32 * i; T[k * 65 + c4 * 4 + 0] = v[i][0]; T[k * 65 + c4 * 4 + 1] = v[i][1]; T[k * 65 + c4 * 4 + 2] = v[i][2]; T[k * 65 + c4 * 4 + 3] = v[i][3]; } }
    __syncthreads();
    { const int nl = tid >> 3, kc = (tid & 7) * 32;
#pragma unroll
      for (int q = 0; q < 4; ++q) { float x[8];
#pragma unroll
          for (int j = 0; j < 8; ++j) x[j] = T[(kc + q * 8 + j) * 65 + nl];
          u32x4 w; w.x = pk2(x[0], x[1]); w.y = pk2(x[2], x[3]); w.z = pk2(x[4], x[5]); w.w = pk2(x[6], x[7]);
          *(u32x4*)(d.dst + (size_t)(d.drow0 + nl) * d.ldD + d.k0 + kc + q * 8) = w; } }
    __syncthreads();
}
DI void cvt_static(PR p, char* lds, int l) {
    const int tid = tid_here(), G = (int)gridDim.x, base = l * CHUNKS_PER_LAYER, lim = base + CHUNKS_PER_LAYER;
    for (int c = base + bid_here(); c < lim; c += 4 * G) {
        const bool h1 = c + G < lim, h2 = c + 2 * G < lim, h3 = c + 3 * G < lim;
        const CvtDesc d0 = chunk_desc(p, c), d1 = chunk_desc(p, h1 ? c + G : c), d2 = chunk_desc(p, h2 ? c + 2 * G : c), d3 = chunk_desc(p, h3 ? c + 3 * G : c);
        f32x4 v0[8], v1[8], v2[8], v3[8];
        cvt_load(d0, v0, tid); if (h1) cvt_load(d1, v1, tid); if (h2) cvt_load(d2, v2, tid); if (h3) cvt_load(d3, v3, tid);
        cvt_finish(lds, d0, v0, tid); if (h1) cvt_finish(lds, d1, v1, tid); if (h2) cvt_finish(lds, d2, v2, tid); if (h3) cvt_finish(lds, d3, v3, tid);
    }
}
#define CTL_LD(ptr) __hip_atomic_load((ptr), __ATOMIC_RELAXED, __HIP_MEMORY_SCOPE_AGENT)
#define CTL_ADD(ptr, v) __hip_atomic_fetch_add((ptr), (v), __ATOMIC_RELAXED, __HIP_MEMORY_SCOPE_AGENT)
DI void fill_tail(PR p, char* lds, int ph) {
    unsigned* ctl = (unsigned*)(p.ws + WS_CTL);
    volatile LAS int* flag = (volatile LAS int*)(shm + 16);
    const int tid = tid_here();
    __syncthreads();
    if (tid == 0) CTL_ADD(&ctl[64 * (1 + ph)], 1u);
    for (;;) {
        if (tid == 0) {
            int c = -1;
            if (CTL_LD(&ctl[64 * (1 + ph)]) + 8u < gridDim.x && CTL_LD(&ctl[0]) < (unsigned)CHUNKS_TOTAL) { c = (int)CTL_ADD(&ctl[0], 4u); if (c >= CHUNKS_TOTAL) c = -1; }
            *flag = c;
        }
        __syncthreads();
        const int c = __builtin_amdgcn_readfirstlane(*flag);
        __syncthreads();
        if (c < 0) break;
        for (int q = 0; q < 4; ++q) {
            if (c + q < CHUNKS_TOTAL) cvt_chunk(p, lds, c + q);
            if (q < 3 && __builtin_amdgcn_readfirstlane((int)CTL_LD(&ctl[64 * (1 + ph)])) >= (int)gridDim.x) { for (int q2 = q + 1; q2 < 4; ++q2) if (c + q2 < CHUNKS_TOTAL) cvt_chunk(p, lds, c + q2); break; }
        }
    }
}
DI void fill_drain(PR p, char* lds, int limit) {
    unsigned* ctl = (unsigned*)(p.ws + WS_CTL);
    const int h0 = __builtin_amdgcn_readfirstlane((int)CTL_LD(&ctl[0]));
    for (int c = h0 + bid_here(); c < limit; c += gridDim.x) cvt_chunk(p, lds, c);
}
DI void move_head(PR p, int limit) { if (blockIdx.x == 0 && tid_here() == 0) __hip_atomic_fetch_max((unsigned*)(p.ws + WS_CTL), (unsigned)limit, __ATOMIC_RELAXED, __HIP_MEMORY_SCOPE_AGENT); }
DI void phase_prologue(PR p, char* lds) {
    const int tid = tid_here();
    unsigned char* ws = p.ws;
    if (blockIdx.x == 0) {
        unsigned* cnt = (unsigned*)(ws + WS_CNT);
        if (tid < 128) cnt[tid] = 0u;
        unsigned* z = (unsigned*)(ws + WS_ZROW);
        for (int i = tid; i < 1024; i += NTHREADS) z[i] = 0u;
        float2* rg = (float2*)(ws + WS_ROPEG);
        for (int i = tid; i < 64 * 32; i += NTHREADS) { const int pos = i >> 5, f = i & 31; const float inv = powf(10000.f, -(float)(2 * f) / 64.f); float s, c; sincosf((float)pos * inv, &s, &c); rg[i] = make_float2(c, s); }
        float2* rm = (float2*)(ws + WS_ROPEM);
        for (int i = tid; i < 64 * 16; i += NTHREADS) { const int pos = i >> 4, f = i & 15; const float inv = powf(10000.f, -(float)(2 * f) / 32.f); float s, c; sincosf((float)pos * inv, &s, &c); rm[i] = make_float2(c, s); }
    }
    {
        float* sc = (float*)lds;
        float* red = sc + 5 * 2048;
        bool loaded = false;
        for (int u = bid_here(); u < 192; u += gridDim.x) {
            if (!loaded) { for (int i = tid; i < 5 * 2048; i += NTHREADS) { const int r = i >> 11, k = i & 2047; const float v = r < 4 ? p.c[r * 2048 + k] : p.c_ctx[k]; sc[i] = silu_f(v); } loaded = true; __syncthreads(); }
            const int l = u / 96, col0 = (u % 96) * 128;
            const int cg = tid & 31, kp = tid >> 5;
            f32x4 acc[5];
#pragma unroll
            for (int r = 0; r < 5; ++r) acc[r] = (f32x4){0.f, 0.f, 0.f, 0.f};
            const float* wb = p.w_mod + ((size_t)l * 2048) * 12288 + col0 + cg * 4;
#pragma unroll 8
            for (int kk = 0; kk < 128; ++kk) {
                const int k = kp * 128 + kk;
                const f32x4 w = *(const f32x4*)(wb + (size_t)k * 12288);
#pragma unroll
                for (int r = 0; r < 5; ++r) acc[r] += w * sc[r * 2048 + k];
            }
#pragma unroll
            for (int r = 0; r < 5; ++r)
#pragma unroll
                for (int j = 0; j < 4; ++j) red[(kp * 5 + r) * 128 + cg * 4 + j] = acc[r][j];
            __syncthreads();
            for (int i = tid; i < 640; i += NTHREADS) {
                const int r = i >> 7, cc = i & 127; float s = p.b_mod[l * 12288 + col0 + cc];
#pragma unroll
                for (int q = 0; q < 16; ++q) s += red[(q * 5 + r) * 128 + cc];
                ((float*)(ws + WS_MOD))[((size_t)l * 5 + r) * 12288 + col0 + cc] = s;
            }
            __syncthreads();
        }
        __syncthreads();
    }
    for (int l = 0; l < 2; ++l) {
        unsigned char* wl = ws + WS_WEIGHTS + (size_t)l * WL_END;
        cvt_matrix<256>(lds, p.w_in + (size_t)l * D * INW, D, INW, INWP, (bf16_t*)(wl + WL_WIN), nullptr, 0, nullptr, 0, INPROJ_FP8 ? F8_SW13 : 0.f);
        cvt_matrix<128>(lds, p.mla_w_uq + (size_t)l * 384 * 1152, 384, 1152, 1280, (bf16_t*)(wl + WL_WUQ), nullptr, 0, p.mla_g_q + l * 384, 512);
        for (int i = bid_here() * NTHREADS + tid; i < 1280 * 64; i += gridDim.x * NTHREADS) ((unsigned*)(wl + WL_WUQ))[(size_t)(i >> 6) * 256 + 192 + (i & 63)] = 0u;
        cvt_matrix<256>(lds, p.mla_w_ukv + (size_t)l * 512 * 1536, 512, 1536, 1536, (bf16_t*)(wl + WL_WUKV), nullptr, 0, p.mla_g_kv + l * 512);
        cvt_matrix<256>(lds, p.w_out + (size_t)l * D * D, D, D, D, (bf16_t*)(wl + WL_WOUT), nullptr, 0, nullptr, 0, OUTPROJ_FP8 ? F8_SW13 : 0.f);
        cvt_matrix<256>(lds, p.router_w + (size_t)l * D * 64, D, 64, 64, (bf16_t*)(wl + WL_WRH), (bf16_t*)(wl + WL_WRL), 0, nullptr);
    }
}

DI void router_group(PR p, int l, float* LG, int row0, bool dry);
DI u32x4 pack8(const f32x4& a, const f32x4& b) { u32x4 w; w.x = pk2(a[0], a[1]); w.y = pk2(a[2], a[3]); w.z = pk2(b[0], b[1]); w.w = pk2(b[2], b[3]); return w; }
#ifndef OASG_FP8_MASK
#define OASG_FP8_MASK 3
#endif
constexpr float OASG_SCALE = 128.f;
static_assert(!MOE_FP8 || OASG_SCALE * F8_INV2 == 1.f, "the routed fp8 epilogue stores the accumulators as they are");
static_assert(OASG_FP8_MASK == 3, "SchedMoe2::EPI_STORES counts the fp8 epilogue's stores (the bf16 one skips padding rows)");
DI void load_row(const float* src, f32x4 (&v)[4][2], int c0) {
#pragma unroll
    for (int i = 0; i < 4; ++i) { v[i][0] = *(const f32x4*)(src + i * 512 + c0); v[i][1] = *(const f32x4*)(src + i * 512 + c0 + 4); }
}
DI void unpack8(const u32x4 w, f32x4& a, f32x4& b) {
    a[0] = __uint_as_float(w.x << 16); a[1] = __uint_as_float(w.x & 0xFFFF0000u); a[2] = __uint_as_float(w.y << 16); a[3] = __uint_as_float(w.y & 0xFFFF0000u);
    b[0] = __uint_as_float(w.z << 16); b[1] = __uint_as_float(w.z & 0xFFFF0000u); b[2] = __uint_as_float(w.w << 16); b[3] = __uint_as_float(w.w & 0xFFFF0000u);
}
DI void load_row_bf(const bf16_t* src, f32x4 (&v)[4][2], int c0) {
#pragma unroll
    for (int i = 0; i < 4; ++i) unpack8(*(const u32x4*)(src + i * 512 + c0), v[i][0], v[i][1]);
}
DI void store_row_bf(bf16_t* dst, const f32x4 (&v)[4][2], int c0) {
#pragma unroll
    for (int i = 0; i < 4; ++i) { u32x4 w; w.x = pk2(v[i][0][0], v[i][0][1]); w.y = pk2(v[i][0][2], v[i][0][3]); w.z = pk2(v[i][1][0], v[i][1][1]); w.w = pk2(v[i][1][2], v[i][1][3]); *(u32x4*)(dst + i * 512 + c0) = w; }
}
DI float row_sumsq(const f32x4 (&v)[4][2]) {
    float s = 0.f;
#pragma unroll
    for (int i = 0; i < 4; ++i)
#pragma unroll
        for (int h = 0; h < 2; ++h) s += v[i][h][0] * v[i][h][0] + v[i][h][1] * v[i][h][1] + v[i][h][2] * v[i][h][2] + v[i][h][3] * v[i][h][3];
    return wave_sum(s);
}
DI void adaln_store(const f32x4 (&x)[4][2], const float* g, const float* shift, const float* scale, bf16_t* hi, bf16_t* lo, int c0, unsigned char* h8 = nullptr) {
    const float rstd = rsqrtf(row_sumsq(x) * (1.f / D) + EPS);
#pragma unroll
    for (int i = 0; i < 4; ++i) {
        f32x4 h[2];
#pragma unroll
        for (int q = 0; q < 2; ++q) { const int c = i * 512 + c0 + 4 * q;
            const f32x4 gg = *(const f32x4*)(g + c), sh = *(const f32x4*)(shift + c), sc = *(const f32x4*)(scale + c);
#pragma unroll
            for (int j = 0; j < 4; ++j) h[q][j] = x[i][q][j] * rstd * gg[j] * (1.f + sc[j]) + sh[j]; }
        u32x4 w; w.x = pk2(h[0][0], h[0][1]); w.y = pk2(h[0][2], h[0][3]); w.z = pk2(h[1][0], h[1][1]); w.w = pk2(h[1][2], h[1][3]);
        if (hi) *(u32x4*)(hi + i * 512 + c0) = w;
        if (h8) { u32x2 w8; w8.x = f8pack4(h[0][0] * F8_SH, h[0][1] * F8_SH, h[0][2] * F8_SH, h[0][3] * F8_SH); w8.y = f8pack4(h[1][0] * F8_SH, h[1][1] * F8_SH, h[1][2] * F8_SH, h[1][3] * F8_SH); *(u32x2*)(h8 + i * 512 + c0) = w8; }
        if (lo) { f32x4 a, b; unpack8(w, a, b); u32x4 w2; w2.x = pk2(h[0][0] - a[0], h[0][1] - a[1]); w2.y = pk2(h[0][2] - a[2], h[0][3] - a[3]); w2.z = pk2(h[1][0] - b[0], h[1][1] - b[1]); w2.w = pk2(h[1][2] - b[2], h[1][3] - b[3]);
            *(u32x4*)(lo + i * 512 + c0) = w2; }
    }
}
DI void residual_add(f32x4 (&x)[4][2], const f32x4 (&y)[4][2], const float* g, const float* gate, int c0) {
    const float rstd = rsqrtf(row_sumsq(y) * (1.f / D) + EPS);
#pragma unroll
    for (int i = 0; i < 4; ++i)
#pragma unroll
        for (int q = 0; q < 2; ++q) { const int c = i * 512 + c0 + 4 * q; const f32x4 gg = *(const f32x4*)(g + c), gt = *(const f32x4*)(gate + c);
#pragma unroll
            for (int j = 0; j < 4; ++j) x[i][q][j] += gt[j] * (y[i][q][j] * rstd * gg[j]); }
}
DI void load_xrow(PR p, int l, int r, f32x4 (&x)[4][2], int c0) {
    if (l == 0) load_row(r < NLAT ? p.x + (size_t)r * D : p.ctx + (size_t)(r - NLAT) * D, x, c0);
    else load_row_bf((const bf16_t*)(p.ws + WS_XRES) + (size_t)r * D, x, c0);
}
DI void phase_norm1(PR p, int l) {
    const int tid_ = tid_here(), lane = tid_ & 63, wid = tid_ >> 6;
    const float* mod = (const float*)(p.ws + WS_MOD) + (size_t)l * 5 * 12288;
    bf16_t* hb = (bf16_t*)(p.ws + WS_HBUF);
    for (int r = bid_here() * 8 + wid; r < NTOK; r += gridDim.x * 8) {
        const Tok t = tok_of(r);
        int c0 = lane * 8; asm volatile("" : "+v"(c0));
        f32x4 x[4][2]; load_xrow(p, l, r, x, c0);
        adaln_store(x, p.g_pre_mix + l * D, mod + (size_t)t.mrow * 12288 + 0 * D, mod + (size_t)t.mrow * 12288 + 1 * D, INPROJ_FP8 ? nullptr : hb + (size_t)r * D, nullptr, c0,
                    INPROJ_FP8 ? p.ws + WS_U + U_Y + (size_t)r * D : nullptr);
    }
}
DI void postmix_load(PR p, int l, int r, f32x4 (&x)[4][2], f32x4 (&y)[4][2], int c0) {
    load_xrow(p, l, r, x, c0); load_row_bf((const bf16_t*)(p.ws + WS_U + U_Y) + (size_t)r * D, y, c0);
}
DI void postmix_finish(PR p, int l, int r, f32x4 (&x)[4][2], const f32x4 (&y)[4][2], int c0) {
    const float* mod = (const float*)(p.ws + WS_MOD) + (size_t)l * 5 * 12288;
    bf16_t* XR = (bf16_t*)(p.ws + WS_XRES);
    bf16_t* hb = (bf16_t*)(p.ws + WS_HBUF); bf16_t* hl = (bf16_t*)(p.ws + WS_U + U_HLO);
    const Tok t = tok_of(r);
    residual_add(x, y, p.g_post_mix + l * D, mod + (size_t)t.mrow * 12288 + 2 * D, c0);
    store_row_bf(XR + (size_t)r * D, x, c0);
    adaln_store(x, p.g_pre_ffn + l * D, mod + (size_t)t.mrow * 12288 + 3 * D, mod + (size_t)t.mrow * 12288 + 4 * D, hb + (size_t)r * D, ROUTER_SPLIT ? hl + (size_t)r * D : nullptr, c0,
                MOE_FP8 ? (unsigned char*)hl + (size_t)r * D : nullptr);
}
DI void postmix_row(PR p, int l, int r, int lane) {
    int c0 = lane * 8; asm volatile("" : "+v"(c0));
    f32x4 x[4][2], y[4][2]; postmix_load(p, l, r, x, y, c0); postmix_finish(p, l, r, x, y, c0);
}
DI void phase_postmix(PR p, int l, char* lds, bool with_router) {
    const int tid_ = tid_here(), lane = tid_ & 63, wid = tid_ >> 6;
    const int nrows = l == 0 ? NTOK : NLAT, ngrp = nrows / 16;
    if (!with_router) {
        const int stride = (int)gridDim.x * 8; int r = bid_here() * 8 + wid;
        f32x4 xn[4][2], yn[4][2]; int c0 = lane * 8; asm volatile("" : "+v"(c0));
        if (r < nrows) postmix_load(p, l, r, xn, yn, c0);
        for (; r < nrows; r += stride) {
            f32x4 x[4][2], y[4][2];
#pragma unroll
            for (int i = 0; i < 4; ++i) { x[i][0] = xn[i][0]; x[i][1] = xn[i][1]; y[i][0] = yn[i][0]; y[i][1] = yn[i][1]; }
            asm volatile("" : "+v"(c0));
            if (r + stride < nrows) postmix_load(p, l, r + stride, xn, yn, c0);
            postmix_finish(p, l, r, x, y, c0);
        }
        return; }
    for (int g = wid * (int)gridDim.x + bid_here(); g < ngrp; g += 8 * (int)gridDim.x) {
#pragma unroll 1
        for (int i = 0; i < 16; ++i) postmix_row(p, l, g * 16 + i, lane);
        if (with_router) { asm volatile("s_waitcnt vmcnt(0)" ::: "memory"); router_group(p, l, (float*)lds + wid * (16 * 65 + 16 * 64), g * 16, false); }
    }
}
DI float row_sumsq16(const f32x4 (&v)[2][4]) {
    float s = 0.f;
#pragma unroll
    for (int i = 0; i < 2; ++i)
#pragma unroll
        for (int q = 0; q < 4; ++q) s += v[i][q][0] * v[i][q][0] + v[i][q][1] * v[i][q][1] + v[i][q][2] * v[i][q][2] + v[i][q][3] * v[i][q][3];
    return wave_sum(s);
}
DI void load_row_bf16(const bf16_t* src, f32x4 (&v)[2][4], int c0) {
#pragma unroll
    for (int i = 0; i < 2; ++i) { unpack8(*(const u32x4*)(src + i * 1024 + c0), v[i][0], v[i][1]); unpack8(*(const u32x4*)(src + i * 1024 + c0 + 8), v[i][2], v[i][3]); }
}
DI void store_row_bf16(bf16_t* dst, const f32x4 (&v)[2][4], int c0) {
#pragma unroll
    for (int i = 0; i < 2; ++i) { *(u32x4*)(dst + i * 1024 + c0) = pack8(v[i][0], v[i][1]); *(u32x4*)(dst + i * 1024 + c0 + 8) = pack8(v[i][2], v[i][3]); }
}
DI void phase_postffn(PR p, int l, char* lds) {
    const int tid_ = tid_here(), lane = tid_ & 63, wid = __builtin_amdgcn_readfirstlane(tid_ >> 6);
    const float* mod = (const float*)(p.ws + WS_MOD) + (size_t)l * 5 * 12288;
    const bf16_t* YS = (const bf16_t*)(p.ws + WS_U + U_YSH);
    const unsigned char* OA = p.ws + WS_U + U_OASG;
    bf16_t* XR = (bf16_t*)(p.ws + WS_XRES);
    bf16_t* hb = (bf16_t*)(p.ws + WS_HBUF);
    const int nrows = l == 0 ? NTOK : NLAT;
    const bool fp8 = (OASG_FP8_MASK >> l) & 1;
    const int* EPOS = (const int*)(p.ws + WS_EPOS); const float* EW = (const float*)(p.ws + WS_EW);
    LAS unsigned char* LB = (LAS unsigned char*)lds + wid * 16384;
    const int stride = (int)gridDim.x * 8;
#define PF_DMA(pe_) do { _Pragma("unroll 1") for (int kk = 0; kk < 8; ++kk) { const unsigned char* rowp_ = OA + (size_t)__builtin_amdgcn_readlane((pe_), kk) * D + lane * 16; \
        _Pragma("unroll") for (int i = 0; i < 2; ++i) __builtin_amdgcn_global_load_lds((const unsigned*)(rowp_ + i * 1024), (LAS unsigned*)(LB + kk * 2048 + i * 1024), 16, 0, 0); } } while (0)
#define PF_NEXT() do { if (fp8) { const int rn_ = r + stride; if (rn_ < nrows) PF_DMA(pe_n); we = we_n; \
        if (rn_ + stride < nrows) { pe_n = EPOS[(size_t)(rn_ + stride) * 8 + (lane & 7)]; we_n = EW[(size_t)(rn_ + stride) * 8 + (lane & 7)]; } } } while (0)
    int pe_n = 0; float we = 0.f, we_n = 0.f;
    { const int r0 = bid_here() * 8 + wid;
      if (fp8 && r0 < nrows) { const int pe0 = EPOS[(size_t)r0 * 8 + (lane & 7)]; we = EW[(size_t)r0 * 8 + (lane & 7)]; PF_DMA(pe0); }
      if (fp8 && r0 + stride < nrows) { pe_n = EPOS[(size_t)(r0 + stride) * 8 + (lane & 7)]; we_n = EW[(size_t)(r0 + stride) * 8 + (lane & 7)]; } }
    for (int r = bid_here() * 8 + wid; r < nrows; r += stride) {
        const Tok t = tok_of(r);
        int c0 = lane * 16; asm volatile("" : "+v"(c0));
        f32x4 x[2][4], y[2][4]; load_row_bf16(XR + (size_t)r * D, x, c0); load_row_bf16(YS + (size_t)r * D, y, c0);
        if (fp8) {
            const float wsc = we * (1.f / OASG_SCALE);
#pragma unroll 2
            for (int kk = 0; kk < 8; ++kk) { const float wk = __int_as_float(__builtin_amdgcn_readlane(__float_as_int(wsc), kk));
#pragma unroll
                for (int i = 0; i < 2; ++i) { const u32x4 w = *(const LAS u32x4*)(LB + kk * 2048 + i * 1024 + lane * 16);
#pragma unroll
                    for (int q = 0; q < 4; ++q) { const unsigned ww = q == 0 ? w.x : q == 1 ? w.y : q == 2 ? w.z : w.w;
                        const auto f0 = __builtin_amdgcn_cvt_pk_f32_fp8(ww, false), f1 = __builtin_amdgcn_cvt_pk_f32_fp8(ww, true);
                        y[i][q][0] += f0[0] * wk; y[i][q][1] += f0[1] * wk; y[i][q][2] += f1[0] * wk; y[i][q][3] += f1[1] * wk; } } }
            asm volatile("s_waitcnt lgkmcnt(0)" ::: "memory");
        } else {
#pragma unroll 2
            for (int k = 0; k < 8; ++k) {
                const bf16_t* o = (const bf16_t*)OA + ((size_t)r * 8 + k) * D;
#pragma unroll
                for (int i = 0; i < 2; ++i) { f32x4 a, b; unpack8(*(const u32x4*)(o + i * 1024 + c0), a, b); y[i][0] += a; y[i][1] += b; unpack8(*(const u32x4*)(o + i * 1024 + c0 + 8), a, b); y[i][2] += a; y[i][3] += b; }
            }
        }
        {
            const float rstd = rsqrtf(row_sumsq16(y) * (1.f / D) + EPS); const float* g = p.g_post_ffn + l * D; const float* gate = mod + (size_t)t.mrow * 12288 + 5 * D;
#pragma unroll
            for (int i = 0; i < 2; ++i)
#pragma unroll
                for (int q = 0; q < 4; ++q) { const int c = i * 1024 + c0 + 4 * q; const f32x4 gg = *(const f32x4*)(g + c), gt = *(const f32x4*)(gate + c);
#pragma unroll
                    for (int j = 0; j < 4; ++j) x[i][q][j] += gt[j] * (y[i][q][j] * rstd * gg[j]); }
        }
        if (l == 0) {
            store_row_bf16(XR + (size_t)r * D, x, c0);
            const float* mod1 = (const float*)(p.ws + WS_MOD) + (size_t)1 * 5 * 12288;
            const float* g = p.g_pre_mix + 1 * D; const float* shift = mod1 + (size_t)t.mrow * 12288 + 0 * D; const float* scale = mod1 + (size_t)t.mrow * 12288 + 1 * D;
            const float rstd = rsqrtf(row_sumsq16(x) * (1.f / D) + EPS);
            f32x4 h[2][4];
#pragma unroll
            for (int i = 0; i < 2; ++i)
#pragma unroll
                for (int q = 0; q < 4; ++q) { const int c = i * 1024 + c0 + 4 * q; const f32x4 gg = *(const f32x4*)(g + c), sh = *(const f32x4*)(shift + c), sc = *(const f32x4*)(scale + c);
#pragma unroll
                    for (int j = 0; j < 4; ++j) h[i][q][j] = x[i][q][j] * rstd * gg[j] * (1.f + sc[j]) + sh[j]; }
            PF_NEXT();
            if (!INPROJ_FP8) store_row_bf16(hb + (size_t)r * D, h, c0);
            if (INPROJ_FP8) { unsigned char* h8 = p.ws + WS_U + U_Y + (size_t)r * D;
#pragma unroll
                for (int i = 0; i < 2; ++i) { u32x4 w8;
                    w8.x = f8pack4(h[i][0][0] * F8_SH, h[i][0][1] * F8_SH, h[i][0][2] * F8_SH, h[i][0][3] * F8_SH); w8.y = f8pack4(h[i][1][0] * F8_SH, h[i][1][1] * F8_SH, h[i][1][2] * F8_SH, h[i][1][3] * F8_SH);
                    w8.z = f8pack4(h[i][2][0] * F8_SH, h[i][2][1] * F8_SH, h[i][2][2] * F8_SH, h[i][2][3] * F8_SH); w8.w = f8pack4(h[i][3][0] * F8_SH, h[i][3][1] * F8_SH, h[i][3][2] * F8_SH, h[i][3][3] * F8_SH);
                    *(u32x4*)(h8 + i * 1024 + c0) = w8; } }
        } else {
            PF_NEXT();
            float* dstrow = p.out + (size_t)r * D;
#pragma unroll
            for (int i = 0; i < 2; ++i)
#pragma unroll
                for (int q = 0; q < 4; ++q) *(f32x4*)(dstrow + i * 1024 + c0 + 4 * q) = x[i][q];
        }
    }
}

#undef PF_DMA
#undef PF_NEXT
struct GemmUnit {
    const bf16_t* A; long lda; const int* rows; int rowshift;
    const bf16_t* Bt; long ldb;
    int K;
};
constexpr int GS_LD = 72;
struct LaneId { int wr, wc, fr, fq; };
DI LaneId gemm_kloop_simple(char* lds, const GemmUnit& g, f32x4 (&acc)[2][2][4][2]) {
    int tid = threadIdx.x; asm volatile("" : "+v"(tid));
    const int wid = tid >> 6, lane = tid & 63, wr = wid >> 2, wc = wid & 3, fr = lane & 15, fq = lane >> 4;
    bf16_t* As = (bf16_t*)lds; bf16_t* Bs = As + 256 * GS_LD;
#pragma unroll
    for (int a = 0; a < 2; ++a)
#pragma unroll
        for (int b = 0; b < 2; ++b)
#pragma unroll
            for (int m = 0; m < 4; ++m)
#pragma unroll
                for (int n = 0; n < 2; ++n) acc[a][b][m][n] = (f32x4){0.f, 0.f, 0.f, 0.f};
    const int srow = tid >> 3, skc = (tid & 7) * 8;
    const bf16_t* ap[4]; const bf16_t* bp[4];
#pragma unroll
    for (int i = 0; i < 4; ++i) {
        const int r = srow + 64 * i;
        if (g.rows) { const int idx = g.rows[r]; ap[i] = g.A + (size_t)(idx >= 0 ? (idx >> g.rowshift) : 0) * g.lda + skc; }
        else ap[i] = g.A + (size_t)r * g.lda + skc;
        bp[i] = g.Bt + (size_t)r * g.ldb + skc;
    }
    const int nkt = g.K / 64;
    u32x4 ra[4], rb[4];
#pragma unroll
    for (int i = 0; i < 4; ++i) { ra[i] = *(const u32x4*)(ap[i]); rb[i] = *(const u32x4*)(bp[i]); }
    for (int kt = 0; kt < nkt; ++kt) {
        __syncthreads();
#pragma unroll
        for (int i = 0; i < 4; ++i) { *(u32x4*)(As + (srow + 64 * i) * GS_LD + skc) = ra[i]; *(u32x4*)(Bs + (srow + 64 * i) * GS_LD + skc) = rb[i]; }
        __syncthreads();
        if (kt + 1 < nkt) {
#pragma unroll
            for (int i = 0; i < 4; ++i) { ra[i] = *(const u32x4*)(ap[i] + (kt + 1) * 64); rb[i] = *(const u32x4*)(bp[i] + (kt + 1) * 64); }
        }
#pragma unroll
        for (int kk = 0; kk < 2; ++kk) {
            bf16x8 bf[2][2];
#pragma unroll
            for (int bj = 0; bj < 2; ++bj)
#pragma unroll
                for (int n = 0; n < 2; ++n) bf[bj][n] = *(const bf16x8*)(Bs + (128 * bj + 32 * wc + 16 * n + fr) * GS_LD + kk * 32 + fq * 8);
#pragma unroll
            for (int ai = 0; ai < 2; ++ai)
#pragma unroll
                for (int m = 0; m < 4; ++m) {
                    const bf16x8 af = *(const bf16x8*)(As + (128 * ai + 64 * wr + 16 * m + fr) * GS_LD + kk * 32 + fq * 8);
#pragma unroll
                    for (int bj = 0; bj < 2; ++bj)
#pragma unroll
                        for (int n = 0; n < 2; ++n) acc[ai][bj][m][n] = __builtin_amdgcn_mfma_f32_16x16x32_bf16(bf[bj][n], af, acc[ai][bj][m][n], 0, 0, 0);
                }
        }
    }
    __syncthreads();
    LaneId id; id.wr = wr; id.wc = wc; id.fr = fr; id.fq = fq; return id;
}
#define GEMM_ACC f32x4 acc[2][2][4][2]
#define ACC_FOREACH(...) \
    _Pragma("unroll") for (int ai = 0; ai < 2; ++ai) _Pragma("unroll") for (int m = 0; m < 4; ++m) { const int trow = 128 * ai + 64 * wr + 16 * m + fr; \
    _Pragma("unroll") for (int bj = 0; bj < 2; ++bj) _Pragma("unroll") for (int n = 0; n < 2; ++n) { const int tcol = 128 * bj + 32 * wc + 16 * n + 4 * fq; const f32x4 v = acc[ai][bj][m][n]; __VA_ARGS__ } }

struct EpiProj {
    bf16_t* O; int row0, col0;
    DI void operator()(const f32x4 (&acc)[2][2][4][2], int wr, int wc, int fr, int fq) const {
        ACC_FOREACH({ u32x2 w; w.x = pk2(v[0], v[1]); w.y = pk2(v[2], v[3]); *(u32x2*)(O + (size_t)(row0 + trow) * INWP + col0 + tcol) = w; })
    }
};
struct EpiB16 {
    bf16_t* O; int row0, col0, ld;
    DI void operator()(const f32x4 (&acc)[2][2][4][2], int wr, int wc, int fr, int fq) const {
        ACC_FOREACH({ u32x2 w; w.x = pk2(v[0], v[1]); w.y = pk2(v[2], v[3]); *(u32x2*)(O + (size_t)(row0 + trow) * ld + col0 + tcol) = w; })
    }
};
struct EpiF32 {
    float* O; int row0, col0, ld;
    DI void operator()(const f32x4 (&acc)[2][2][4][2], int wr, int wc, int fr, int fq) const {
        ACC_FOREACH({ *(f32x4*)(O + (size_t)(row0 + trow) * ld + col0 + tcol) = v; })
    }
};
struct EpiUq {
    bf16_t* Q; const float2* ropem; int row0, col0;
    DI void operator()(const f32x4 (&acc)[2][2][4][2], int wr, int wc, int fr, int fq) const {
#pragma unroll
        for (int bj = 0; bj < 2; ++bj) {
            const int cbase = col0 + 128 * bj + 32 * wc;
            if (cbase >= 1152) continue;
            const int h = cbase / 192, jb = cbase % 192;
            float2 cs[2][4][4]; Tok tk[2][4];
#pragma unroll
            for (int ai = 0; ai < 2; ++ai)
#pragma unroll
                for (int m = 0; m < 4; ++m) { tk[ai][m] = tok_of(row0 + 128 * ai + 64 * wr + 16 * m + fr); const Tok t = tk[ai][m];
                    const int pos = (jb == 128) ? (t.s >> 6) : (t.s & 63); const bool rot = jb >= 128 && !t.isctx;
#pragma unroll
                    for (int i = 0; i < 4; ++i) cs[ai][m][i] = rot ? ropem[pos * 16 + 4 * fq + i] : make_float2(1.f, 0.f); }
#pragma unroll
            for (int ai = 0; ai < 2; ++ai)
#pragma unroll
                for (int m = 0; m < 4; ++m) { const Tok t = tk[ai][m];
                    f32x4 v0 = acc[ai][bj][m][0], v1 = acc[ai][bj][m][1];
#pragma unroll
                    for (int i = 0; i < 4; ++i) { const float2 c = cs[ai][m][i]; const float x1 = v0[i], x2 = v1[i]; v0[i] = x1 * c.x - x2 * c.y; v1[i] = x2 * c.x + x1 * c.y; }
                    bf16_t* dst = Q + (((size_t)t.b * 6 + h) * SKV + t.kvpos) * 192 + jb + 4 * fq;
                    u32x2 w0; w0.x = pk2(v0[0], v0[1]); w0.y = pk2(v0[2], v0[3]); *(u32x2*)(dst) = w0;
                    u32x2 w1; w1.x = pk2(v1[0], v1[1]); w1.y = pk2(v1[2], v1[3]); *(u32x2*)(dst + 16) = w1; }
        }
    }
};
struct EpiUkv {
    bf16_t* Km; bf16_t* Vm; int row0, col0;
    DI void operator()(const f32x4 (&acc)[2][2][4][2], int wr, int wc, int fr, int fq) const {
        ACC_FOREACH({ const int r = row0 + trow; const Tok t = tok_of(r); const int c = col0 + tcol, h = c >> 8, j = c & 255;
            u32x2 w; w.x = pk2(v[0], v[1]); w.y = pk2(v[2], v[3]);
            if (j < 128) *(u32x2*)(Km + (((size_t)t.b * 6 + h) * SKV + t.kvpos) * 192 + j) = w;
            else *(u32x2*)(Vm + (((size_t)t.b * 6 + h) * SKV + t.kvpos) * 128 + (j - 128)) = w; })
    }
};
struct EpiMoe1 {
    bf16_t* act; int arow0, hcol0;
    DI void operator()(const f32x4 (&acc)[2][2][4][2], int wr, int wc, int fr, int fq) const {
#pragma unroll
        for (int ai = 0; ai < 2; ++ai)
#pragma unroll
            for (int m = 0; m < 4; ++m) {
                const int trow = 128 * ai + 64 * wr + 16 * m + fr;
#pragma unroll
                for (int n = 0; n < 2; ++n) {
                    const f32x4 a = acc[ai][0][m][n], b = acc[ai][1][m][n]; f32x4 h;
#pragma unroll
                    for (int i = 0; i < 4; ++i) h[i] = silu_f(a[i]) * b[i];
                    u32x2 w; w.x = pk2(h[0], h[1]); w.y = pk2(h[2], h[3]);
                    *(u32x2*)(act + (size_t)(arow0 + trow) * 512 + hcol0 + 32 * wc + 16 * n + 4 * fq) = w;
                }
            }
    }
};
struct EpiMoe2 {
    bf16_t* oasg; const int* sasg; const float* sw; int srow0, col0;
    DI void operator()(const f32x4 (&acc)[2][2][4][2], int wr, int wc, int fr, int fq) const {
        int a[2][4]; float wgt[2][4];
#pragma unroll
        for (int ai = 0; ai < 2; ++ai)
#pragma unroll
            for (int m = 0; m < 4; ++m) { const int trow = 128 * ai + 64 * wr + 16 * m + fr; a[ai][m] = sasg[srow0 + trow]; wgt[ai][m] = sw[srow0 + trow]; }
#pragma unroll
        for (int ai = 0; ai < 2; ++ai)
#pragma unroll
            for (int m = 0; m < 4; ++m) {
                if (a[ai][m] < 0) continue;
#pragma unroll
                for (int bj = 0; bj < 2; ++bj)
#pragma unroll
                    for (int n = 0; n < 2; ++n) { const f32x4 v = acc[ai][bj][m][n] * wgt[ai][m]; u32x2 w; w.x = pk2(v[0], v[1]); w.y = pk2(v[2], v[3]);
                        *(u32x2*)(oasg + (size_t)a[ai][m] * D + col0 + 128 * bj + 32 * wc + 16 * n + 4 * fq) = w; }
            }
    }
};
struct EpiB16P {
    bf16_t* O; int row0, col0, ld; float mul;
    DI void operator()(const f32x4 (&acc)[2][2][4][2], int wr, int wc, int fr, int fq) const {
#pragma unroll
        for (int ai = 0; ai < 2; ++ai)
#pragma unroll
            for (int m = 0; m < 4; ++m) { bf16_t* rowp = O + (size_t)(row0 + 128 * ai + 64 * wr + 16 * m + fr) * ld + col0 + 32 * wc + 8 * fq;
#pragma unroll
                for (int bj = 0; bj < 2; ++bj) *(u32x4*)(rowp + 128 * bj) = pack8(acc[ai][bj][m][0] * mul, acc[ai][bj][m][1] * mul); }
    }
};
struct EpiMoe1P {
    bf16_t* act; int arow0, hcol0;
    DI void operator()(const f32x4 (&acc)[2][2][4][2], int wr, int wc, int fr, int fq) const {
#pragma unroll
        for (int ai = 0; ai < 2; ++ai)
#pragma unroll
            for (int m = 0; m < 4; ++m) {
                f32x4 h0, h1;
#pragma unroll
                for (int i = 0; i < 4; ++i) { h0[i] = silu_f(acc[ai][0][m][0][i]) * acc[ai][1][m][0][i]; h1[i] = silu_f(acc[ai][0][m][1][i]) * acc[ai][1][m][1][i]; }
                *(u32x4*)(act + (size_t)(arow0 + 128 * ai + 64 * wr + 16 * m + fr) * 512 + hcol0 + 32 * wc + 8 * fq) = pack8(h0, h1);
            }
    }
};
DI float swiglu_scaled(float a0, float a1) {
    constexpr float C2 = F8_INV1 * F8_INV1 * F8_SACT, K1 = -F8_INV1 * 1.4426950408889634f, K0 = 21.f;
    static_assert(C2 == 1.f / 2097152.f, "K0 = -log2(C2)");
    const float t = __builtin_amdgcn_exp2f(__builtin_fmaf(a0, K1, K0));
    return (a0 * a1) * __builtin_amdgcn_rcpf((1.f / C2) + t);
}
struct EpiMoe1F8 {
    unsigned char* act; int arow0, hcol0;
    DI void operator()(const f32x4 (&acc)[2][2][4][2], int wr, int wc, int fr, int fq) const {
#pragma unroll
        for (int ai = 0; ai < 2; ++ai)
#pragma unroll
            for (int m = 0; m < 4; ++m) {
                f32x4 h0, h1;
#pragma unroll
                for (int i = 0; i < 4; ++i) { h0[i] = swiglu_scaled(acc[ai][0][m][0][i], acc[ai][1][m][0][i]); h1[i] = swiglu_scaled(acc[ai][0][m][1][i], acc[ai][1][m][1][i]); }
                u32x2 w; w.x = f8pack4(h0[0], h0[1], h0[2], h0[3]); w.y = f8pack4(h1[0], h1[1], h1[2], h1[3]);
                *(u32x2*)(act + (size_t)(arow0 + 128 * ai + 64 * wr + 16 * m + fr) * 512 + hcol0 + 32 * wc + 8 * fq) = w;
            }
    }
};
struct EpiMoe2P {
    bf16_t* oasg; const int* sasg; const float* sw; int srow0, col0;
    DI void operator()(const f32x4 (&acc)[2][2][4][2], int wr, int wc, int fr, int fq) const {
        int a[2][4]; float wgt[2][4];
#pragma unroll
        for (int ai = 0; ai < 2; ++ai)
#pragma unroll
            for (int m = 0; m < 4; ++m) { const int trow = 128 * ai + 64 * wr + 16 * m + fr; a[ai][m] = sasg[srow0 + trow]; wgt[ai][m] = sw[srow0 + trow]; }
#pragma unroll
        for (int ai = 0; ai < 2; ++ai)
#pragma unroll
            for (int m = 0; m < 4; ++m) {
                if (a[ai][m] < 0) continue;
                bf16_t* rowp = oasg + (size_t)a[ai][m] * D + col0 + 32 * wc + 8 * fq;
#pragma unroll
                for (int bj = 0; bj < 2; ++bj) *(u32x4*)(rowp + 128 * bj) = pack8(acc[ai][bj][m][0] * wgt[ai][m], acc[ai][bj][m][1] * wgt[ai][m]);
            }
    }
};
struct EpiMoe2F8 {
    unsigned char* oasg; const int* sasg; const float* sw; int srow0, col0;
    DI void operator()(const f32x4 (&acc)[2][2][4][2], int wr, int wc, int fr, int fq) const {
        int a[2][4]; float wgt[2][4];
#pragma unroll
        for (int ai = 0; ai < 2; ++ai)
#pragma unroll
            for (int m = 0; m < 4; ++m) { const int trow = 128 * ai + 64 * wr + 16 * m + fr; a[ai][m] = sasg[srow0 + trow]; wgt[ai][m] = sw[srow0 + trow] * OASG_SCALE; }
#pragma unroll
        for (int ai = 0; ai < 2; ++ai)
#pragma unroll
            for (int m = 0; m < 4; ++m) {
                if (a[ai][m] < 0) continue;
                unsigned char* rowp = oasg + (size_t)a[ai][m] * D + col0 + 32 * wc + 8 * fq;
#pragma unroll
                for (int bj = 0; bj < 2; ++bj) { f32x4 v0 = acc[ai][bj][m][0] * wgt[ai][m], v1 = acc[ai][bj][m][1] * wgt[ai][m]; u32x2 w;
#pragma unroll
                    for (int i = 0; i < 4; ++i) { v0[i] = __builtin_amdgcn_fmed3f(v0[i], -440.f, 440.f); v1[i] = __builtin_amdgcn_fmed3f(v1[i], -440.f, 440.f); }
                    int t0 = __builtin_amdgcn_cvt_pk_fp8_f32(v0[0], v0[1], 0, false); t0 = __builtin_amdgcn_cvt_pk_fp8_f32(v0[2], v0[3], t0, true);
                    int t1 = __builtin_amdgcn_cvt_pk_fp8_f32(v1[0], v1[1], 0, false); t1 = __builtin_amdgcn_cvt_pk_fp8_f32(v1[2], v1[3], t1, true);
                    w.x = (unsigned)t0; w.y = (unsigned)t1; *(u32x2*)(rowp + 128 * bj) = w; }
            }
    }
};
struct EpiMoe2F8W {
    unsigned char* oasg; int srow0, col0;
    DI void operator()(const f32x4 (&acc)[2][2][4][2], int wr, int wc, int fr, int fq) const {
        constexpr float mul = OASG_SCALE * (MOE_FP8 ? F8_INV2 : 1.f);
#pragma unroll
        for (int ai = 0; ai < 2; ++ai)
#pragma unroll
            for (int m = 0; m < 4; ++m) {
                u32x4 w;
                w.x = f8pack4(acc[ai][0][m][0][0] * mul, acc[ai][0][m][0][1] * mul, acc[ai][0][m][0][2] * mul, acc[ai][0][m][0][3] * mul);
                w.y = f8pack4(acc[ai][0][m][1][0] * mul, acc[ai][0][m][1][1] * mul, acc[ai][0][m][1][2] * mul, acc[ai][0][m][1][3] * mul);
                w.z = f8pack4(acc[ai][1][m][0][0] * mul, acc[ai][1][m][0][1] * mul, acc[ai][1][m][0][2] * mul, acc[ai][1][m][0][3] * mul);
                w.w = f8pack4(acc[ai][1][m][1][0] * mul, acc[ai][1][m][1][1] * mul, acc[ai][1][m][1][2] * mul, acc[ai][1][m][1][3] * mul);
                *(u32x4*)(oasg + (size_t)(srow0 + 128 * ai + 64 * wr + 16 * m + fr) * D + col0 + 64 * wc + 16 * fq) = w;
            }
    }
};
struct EpiB16W {
    bf16_t* O; int row0, col0, ld;
    DI void operator()(const f32x4 (&acc)[2][2][4][2], int wr, int wc, int fr, int fq) const {
        constexpr float mul = MOE_FP8 ? F8_INV2 : 1.f;
#pragma unroll
        for (int ai = 0; ai < 2; ++ai)
#pragma unroll
            for (int m = 0; m < 4; ++m) { bf16_t* rowp = O + (size_t)(row0 + 128 * ai + 64 * wr + 16 * m + fr) * ld + col0 + 64 * wc + 16 * fq;
                *(u32x4*)(rowp) = pack8(acc[ai][0][m][0] * mul, acc[ai][0][m][1] * mul); *(u32x4*)(rowp + 8) = pack8(acc[ai][1][m][0] * mul, acc[ai][1][m][1] * mul); }
    }
};
struct EpiMoe2W {
    bf16_t* oasg; const int* sasg; const float* sw; int srow0, col0;
    DI void operator()(const f32x4 (&acc)[2][2][4][2], int wr, int wc, int fr, int fq) const {
        int a[2][4]; float wgt[2][4];
#pragma unroll
        for (int ai = 0; ai < 2; ++ai)
#pragma unroll
            for (int m = 0; m < 4; ++m) { const int trow = 128 * ai + 64 * wr + 16 * m + fr; a[ai][m] = sasg[srow0 + trow]; wgt[ai][m] = (a[ai][m] >= 0 ? sw[a[ai][m]] : 0.f) * (MOE_FP8 ? F8_INV2 : 1.f); }
#pragma unroll
        for (int ai = 0; ai < 2; ++ai)
#pragma unroll
            for (int m = 0; m < 4; ++m) {
                if (a[ai][m] < 0) continue;
                bf16_t* rowp = oasg + (size_t)a[ai][m] * D + col0 + 64 * wc + 16 * fq;
                *(u32x4*)(rowp) = pack8(acc[ai][0][m][0] * wgt[ai][m], acc[ai][0][m][1] * wgt[ai][m]); *(u32x4*)(rowp + 8) = pack8(acc[ai][1][m][0] * wgt[ai][m], acc[ai][1][m][1] * wgt[ai][m]);
            }
    }
};
DI void phase_postproj_rows(PR p, int l) {
    const int tid_ = tid_here(), lane = tid_ & 63, wid = tid_ >> 6;
    unsigned char* U = p.ws + WS_U;
    const bf16_t* PR_ = (const bf16_t*)(U + U_PROJ);
    bf16_t* CQN = (bf16_t*)(U + U_CQN); bf16_t* CKVN = (bf16_t*)(U + U_CKVN);
    bf16_t* Km = (bf16_t*)(U + U_KM); bf16_t* Qg = (bf16_t*)(U + U_QG); bf16_t* Kg = (bf16_t*)(U + U_KG); bf16_t* Vg = (bf16_t*)(U + U_VG);
    const float2* ropeg = (const float2*)(p.ws + WS_ROPEG); const float2* ropem = (const float2*)(p.ws + WS_ROPEM);
    const float gq0 = p.gqa_g_q[l * 128 + 2 * lane], gq1 = p.gqa_g_q[l * 128 + 2 * lane + 1], gk0 = p.gqa_g_k[l * 128 + 2 * lane], gk1 = p.gqa_g_k[l * 128 + 2 * lane + 1];
    struct RowRaw { unsigned cq0, cq1, cq2; u32x4 ckv; bf16_t kr; unsigned qk[8]; u32x2 v; };
#define ROW_LOAD(R, row) do { const bf16_t* pr_ = PR_ + (size_t)(row) * INWP; const unsigned* s_ = (const unsigned*)(pr_ + C_CQ + 6 * lane); R.cq0 = s_[0]; R.cq1 = s_[1]; R.cq2 = s_[2]; \
        R.ckv = *(const u32x4*)(pr_ + C_CKV + 8 * lane); R.kr = pr_[C_KR + lane]; \
        _Pragma("unroll") for (int hh_ = 0; hh_ < 8; ++hh_) R.qk[hh_] = *(const unsigned*)(pr_ + (hh_ < 6 ? C_AQ + hh_ * 128 : C_AK + (hh_ - 6) * 128) + 2 * lane); \
        R.v = *(const u32x2*)(pr_ + C_AV + 4 * lane); } while (0)
    const int stride_ = (int)gridDim.x * 8; int r = bid_here() * 8 + wid;
    RowRaw nx; if (r < NTOK) ROW_LOAD(nx, r);
    for (; r < NTOK; r += stride_) {
        const Tok t = tok_of(r);
        const RowRaw cu = nx;
        if (r + stride_ < NTOK) ROW_LOAD(nx, r + stride_);
        {
            const unsigned w0 = cu.cq0, w1 = cu.cq1, w2 = cu.cq2;
            float v[6] = {__uint_as_float(w0 << 16), __uint_as_float(w0 & 0xFFFF0000u), __uint_as_float(w1 << 16), __uint_as_float(w1 & 0xFFFF0000u), __uint_as_float(w2 << 16), __uint_as_float(w2 & 0xFFFF0000u)};
            float ss = 0.f;
#pragma unroll
            for (int i = 0; i < 6; ++i) ss += v[i] * v[i];
            const float rstd = rsqrtf(wave_sum(ss) * (1.f / 384.f) + EPS);
            unsigned* dst = (unsigned*)(CQN + (size_t)r * 512 + 6 * lane); dst[0] = pk2(v[0] * rstd, v[1] * rstd); dst[1] = pk2(v[2] * rstd, v[3] * rstd); dst[2] = pk2(v[4] * rstd, v[5] * rstd);
            *(unsigned*)(CQN + (size_t)r * 512 + 384 + 2 * lane) = 0u;
        }
        {
            f32x4 a, b; unpack8(cu.ckv, a, b);
            const float ss = a[0] * a[0] + a[1] * a[1] + a[2] * a[2] + a[3] * a[3] + b[0] * b[0] + b[1] * b[1] + b[2] * b[2] + b[3] * b[3];
            const float rstd = rsqrtf(wave_sum(ss) * (1.f / 512.f) + EPS);
            u32x4 w; w.x = pk2(a[0] * rstd, a[1] * rstd); w.y = pk2(a[2] * rstd, a[3] * rstd); w.z = pk2(b[0] * rstd, b[1] * rstd); w.w = pk2(b[2] * rstd, b[3] * rstd);
            *(u32x4*)(CKVN + (size_t)r * 512 + 8 * lane) = w;
        }
        {
            float x = bf2f(cu.kr);
            const float other = shx(x, 16, lane);
            if (!t.isctx) {
                const int g = lane >> 5, idx = lane & 31, fi = idx & 15; const bool second = idx >= 16;
                const int pos = g == 0 ? (t.s >> 6) : (t.s & 63);
                const float2 cs = ropem[pos * 16 + fi];
                x = second ? x * cs.x + other * cs.y : x * cs.x - other * cs.y;
            }
            const bf16_t xb = f2bf(x);
#pragma unroll
            for (int h = 0; h < 6; ++h) Km[(((size_t)t.b * 6 + h) * SKV + t.kvpos) * 192 + 128 + lane] = xb;
        }
        const int f0 = (2 * lane) & 31; const bool second = (lane & 16) != 0;
        float2 csa = make_float2(1.f, 0.f), csb = make_float2(1.f, 0.f);
        if (!t.isctx) { const int pos = lane < 32 ? (t.s >> 6) : (t.s & 63); csa = ropeg[pos * 32 + f0]; csb = ropeg[pos * 32 + f0 + 1]; }
#pragma unroll
        for (int hh = 0; hh < 8; ++hh) {
            const bool isq = hh < 6; const int h = isq ? hh : hh - 6;
            const unsigned wv = cu.qk[hh];
            float e0 = __uint_as_float(wv << 16), e1 = __uint_as_float(wv & 0xFFFF0000u);
            const float rstd = rsqrtf(wave_sum(e0 * e0 + e1 * e1) * (1.f / 128.f) + EPS);
            e0 = e0 * rstd * (isq ? gq0 : gk0); e1 = e1 * rstd * (isq ? gq1 : gk1);
            const float o0 = shx(e0, 16, lane), o1 = shx(e1, 16, lane);
            const float r0 = second ? e0 * csa.x + o0 * csa.y : e0 * csa.x - o0 * csa.y;
            const float r1 = second ? e1 * csb.x + o1 * csb.y : e1 * csb.x - o1 * csb.y;
            bf16_t* dst = isq ? Qg + (((size_t)t.b * 6 + h) * SKV + t.kvpos) * 128 : Kg + (((size_t)t.b * 2 + h) * SKV + t.kvpos) * 128;
            *(unsigned*)(dst + 2 * lane) = pk2(r0, r1);
        }
        *(u32x2*)(Vg + (((size_t)t.b * 2 + (lane >> 5)) * SKV + t.kvpos) * 128 + 4 * (lane & 31)) = cu.v;
    }
#undef ROW_LOAD
}

#define SBAR() __builtin_amdgcn_sched_barrier(0)
DI int crow(int r, int hi) { return (r & 3) + 8 * (r >> 2) + 4 * hi; }
DI unsigned cvtpk(float lo, float hi) { unsigned r; asm volatile("v_cvt_pk_bf16_f32 %0, %1, %2" : "=v"(r) : "v"(lo), "v"(hi)); return r; }
constexpr float ATT_THR = 8.f;
template <int DQK> struct AttnCfg {
    static constexpr int KROWB = DQK * 2;
    static constexpr int SHM_V = 64 * 128 * 2, SHM_K = 64 * DQK * 2;
    static constexpr int ND0 = DQK / 16;
    static constexpr int NKCH = DQK / 64;
    static constexpr int NQR = DQK == 128 ? 8 : ATT_NQR_M;
    static constexpr int SHM_Q = 8 * (ND0 - NQR) * 1024;
    static constexpr int SHM_TOTAL = 2 * SHM_V + 2 * SHM_K + 8 * 64 * 4 + SHM_Q;
};
template <int DQK> DI int kswz(int row, int colB) { return row * (DQK * 2) + (colB ^ ((row & 7) << 4)); }
DI void partialSM(f32x16& p0, f32x16& p1, float& m_reg, float& mn, float& alpha, const float SCALE) {
    const float C = SCALE * 1.4426950408889634f;
    float pmax = p0[0];
#pragma unroll
    for (int r = 1; r < 16; ++r) pmax = fmaxf(pmax, p0[r]);
#pragma unroll
    for (int r = 0; r < 16; ++r) pmax = fmaxf(pmax, p1[r]);
    { auto rr = __builtin_amdgcn_permlane32_swap(__float_as_uint(pmax), __float_as_uint(pmax), false, false);
      pmax = fmaxf(__uint_as_float(rr[0]), __uint_as_float(rr[1])); }
    if (__builtin_expect(__all(pmax - m_reg <= ATT_THR / SCALE), 1)) { mn = m_reg; alpha = 1.f; }
    else { mn = fmaxf(m_reg, pmax); alpha = __builtin_amdgcn_exp2f((m_reg - mn) * C); m_reg = mn; }
    const float mnC = -mn * C;
#pragma unroll
    for (int r = 0; r < 16; ++r) p0[r] = fmaf(p0[r], C, mnC);
#pragma unroll
    for (int r = 0; r < 16; ++r) p1[r] = fmaf(p1[r], C, mnC);
#pragma unroll
    for (int r = 0; r < 16; ++r) p0[r] = __builtin_amdgcn_exp2f(p0[r]);
}
DI void finishSM(f32x16& p0, f32x16& p1, float alpha, float& l_reg, bf16x8& pa0, bf16x8& pa1, bf16x8& pa2, bf16x8& pa3) {
#pragma unroll
    for (int r = 0; r < 16; ++r) p1[r] = __builtin_amdgcn_exp2f(p1[r]);
    float ps = 0;
#pragma unroll
    for (int r = 0; r < 16; ++r) ps += p0[r];
#pragma unroll
    for (int r = 0; r < 16; ++r) ps += p1[r];
    { auto rr = __builtin_amdgcn_permlane32_swap(__float_as_uint(ps), __float_as_uint(ps), false, false);
      ps = __uint_as_float(rr[0]) + __uint_as_float(rr[1]); }
    l_reg = l_reg * alpha + ps;
#define PK4(P, BASE, OUT) do { unsigned a0 = cvtpk(P[BASE + 0], P[BASE + 1]), a1 = cvtpk(P[BASE + 2], P[BASE + 3]);   \
    unsigned b0 = cvtpk(P[BASE + 4], P[BASE + 5]), b1 = cvtpk(P[BASE + 6], P[BASE + 7]);                              \
    auto r0 = __builtin_amdgcn_permlane32_swap(a0, b0, false, false); auto r1 = __builtin_amdgcn_permlane32_swap(a1, b1, false, false); \
    u32x4 w = {r0[0], r1[0], r0[1], r1[1]}; OUT = *reinterpret_cast<bf16x8*>(&w); } while (0)
    PK4(p0, 0, pa0); PK4(p0, 8, pa1); PK4(p1, 0, pa2); PK4(p1, 8, pa3);
#undef PK4
}
DI void partialSM2(f32x16& p0, f32x16& p1, float& M, const float Mused, float& alpha) {
    float pmax = p0[0];
#pragma unroll
    for (int r = 1; r < 16; ++r) pmax = fmaxf(pmax, p0[r]);
#pragma unroll
    for (int r = 0; r < 16; ++r) pmax = fmaxf(pmax, p1[r]);
    { auto rr = __builtin_amdgcn_permlane32_swap(__float_as_uint(pmax), __float_as_uint(pmax), false, false);
      pmax = fmaxf(__uint_as_float(rr[0]), __uint_as_float(rr[1])); }
    if (__builtin_expect(__all((pmax + Mused) - M <= ATT_THR * 1.4426950408889634f), 1)) { alpha = 1.f; }
    else { const float Mn = fmaxf(M, pmax + Mused), sh = Mused - Mn; alpha = __builtin_amdgcn_exp2f(M - Mn); M = Mn;
#pragma unroll
        for (int r = 0; r < 16; ++r) { p0[r] += sh; p1[r] += sh; } }
#pragma unroll
    for (int r = 0; r < 16; ++r) p0[r] = __builtin_amdgcn_exp2f(p0[r]);
}
template <int DQK>
DI void qkt2(f32x16& p0, f32x16& p1, const int (&kb)[4], int bufoff, const bf16x8* qr, const float init) {
#pragma unroll
    for (int r = 0; r < 16; ++r) { p0[r] = init; p1[r] = init; }
#pragma unroll
    for (int d0 = 0; d0 < DQK / 16; ++d0) {
        const LAS char* ka = (const LAS char*)(kb[d0 & 3]) + bufoff + 128 * (d0 >> 2);
        const bf16x8 b0 = *(const LAS bf16x8*)(ka);
        const bf16x8 b1 = *(const LAS bf16x8*)(ka + 32 * DQK * 2);
        p0 = __builtin_amdgcn_mfma_f32_32x32x16_bf16(b0, qr[d0], p0, 0, 0, 0);
        p1 = __builtin_amdgcn_mfma_f32_32x32x16_bf16(b1, qr[d0], p1, 0, 0, 0); }
}
template <int DQK, int NQR>
DI void qkt(f32x16& p0, f32x16& p1, const int (&kb)[4], int bufoff, const bf16x8* qr, int qs_addr, int r32, int hi) {
    asm volatile("" : "+v"(qs_addr));
    const LAS char* Qs = (const LAS char*)qs_addr;
#pragma unroll
    for (int r = 0; r < 16; ++r) { p0[r] = 0.f; p1[r] = 0.f; }
#pragma unroll
    for (int d0 = 0; d0 < DQK / 16; ++d0) {
        const LAS char* ka = (const LAS char*)(kb[d0 & 3]) + bufoff + 128 * (d0 >> 2);
        const bf16x8 b0 = *(const LAS bf16x8*)(ka);
        const bf16x8 b1 = *(const LAS bf16x8*)(ka + 32 * DQK * 2);
        bf16x8 q;
        if (d0 < NQR) q = qr[d0]; else q = *(const LAS bf16x8*)(Qs + (d0 - NQR) * 1024);
        p0 = __builtin_amdgcn_mfma_f32_32x32x16_bf16(b0, q, p0, 0, 0, 0);
        p1 = __builtin_amdgcn_mfma_f32_32x32x16_bf16(b1, q, p1, 0, 0, 0); }
}
DI int v_st(int k, int c) { const int kk = (k & ~0xC) | ((k & 4) << 1) | ((k & 8) >> 1); return ((kk >> 3) * 4 + (c >> 5)) * 512 + ((kk & 7) * 32 + (c & 31)) * 2; }
DI int v_rd_base(int lane) { return ((lane & 3) << 3) | (((lane >> 2) & 3) << 6) | (((lane >> 4) & 1) << 5) | (((lane >> 5) & 1) << 8); }
constexpr int v_rd_off(int d0, int ks, int half) { return d0 * 512 + ks * 4096 + half * 2048; }
template <int OFF> DI s16x4 tr_read(int vb) { s16x4 r; asm volatile("ds_read_b64_tr_b16 %0, %1 offset:%2" : "=&v"(r) : "v"(vb), "i"(OFF) : "memory"); return r; }
template <int D0> DI void pv_one(f32x16& od, int vb, bf16x8 pa0, bf16x8 pa1, bf16x8 pa2, bf16x8 pa3) {
    const s16x4 l0 = tr_read<v_rd_off(D0, 0, 0)>(vb), h0 = tr_read<v_rd_off(D0, 0, 1)>(vb), l1 = tr_read<v_rd_off(D0, 1, 0)>(vb), h1 = tr_read<v_rd_off(D0, 1, 1)>(vb);
    const s16x4 l2 = tr_read<v_rd_off(D0, 2, 0)>(vb), h2 = tr_read<v_rd_off(D0, 2, 1)>(vb), l3 = tr_read<v_rd_off(D0, 3, 0)>(vb), h3 = tr_read<v_rd_off(D0, 3, 1)>(vb);
    asm volatile("s_waitcnt lgkmcnt(0)" ::: "memory"); SBAR();
#define PKV(L, H) (bf16x8){L[0], L[1], L[2], L[3], H[0], H[1], H[2], H[3]}
    od = __builtin_amdgcn_mfma_f32_32x32x16_bf16(pa0, PKV(l0, h0), od, 0, 0, 0);
    od = __builtin_amdgcn_mfma_f32_32x32x16_bf16(pa1, PKV(l1, h1), od, 0, 0, 0);
    od = __builtin_amdgcn_mfma_f32_32x32x16_bf16(pa2, PKV(l2, h2), od, 0, 0, 0);
    od = __builtin_amdgcn_mfma_f32_32x32x16_bf16(pa3, PKV(l3, h3), od, 0, 0, 0);
#undef PKV
}
DI void pv_d0(f32x16* o, int vb, bf16x8 pa0, bf16x8 pa1, bf16x8 pa2, bf16x8 pa3) {
    pv_one<0>(o[0], vb, pa0, pa1, pa2, pa3); pv_one<1>(o[1], vb, pa0, pa1, pa2, pa3); pv_one<2>(o[2], vb, pa0, pa1, pa2, pa3); pv_one<3>(o[3], vb, pa0, pa1, pa2, pa3);
}
template <int DQK, int SDEPTH>
DI void attn_body(const bf16_t* __restrict__ Qb, const bf16_t* __restrict__ Kh, const bf16_t* __restrict__ Vh, bf16_t* __restrict__ Ob, int ldo, int seq, char* lds, const float SCALE) {
    using Cfg = AttnCfg<DQK>;
    constexpr int SHM_V = Cfg::SHM_V, SHM_K = Cfg::SHM_K, ND0 = Cfg::ND0, NKCH = Cfg::NKCH, KCPR = DQK / 8, NQR = Cfg::NQR;
    int tid = threadIdx.x; asm volatile("" : "+v"(tid));
    const int wid = tid >> 6, lane = tid & 63, r32 = lane & 31, hi = lane >> 5;
    char* V_lds = lds; char* K_lds = lds + 2 * SHM_V;
    float* ws = (float*)(lds + 2 * SHM_V + 2 * SHM_K) + wid * 64; float* li_l = ws; float* al_l = ws + 32;
    float m_reg = -1e30f, l_reg = 0; f32x16 o[4]; bf16x8 qr[NQR > 0 ? NQR : 1];
    char* Qs = lds + 2 * SHM_V + 2 * SHM_K + 8 * 64 * 4 + (wid * (ND0 - NQR) * 64 + lane) * 16;
#pragma unroll
    for (int d = 0; d < 4; ++d)
#pragma unroll
        for (int r = 0; r < 16; ++r) o[d][r] = 0.f;
    const bf16_t* Qw = Qb + (long)(wid * 32 + r32) * DQK + hi * 8;
#pragma unroll
    for (int d0 = 0; d0 < ND0; ++d0) { const bf16x8 qv = *reinterpret_cast<const bf16x8*>(Qw + d0 * 16); if (d0 < NQR) qr[d0] = qv; else *reinterpret_cast<bf16x8*>(Qs + (d0 - NQR) * 1024) = qv; }
    asm volatile("s_waitcnt lgkmcnt(0)" ::: "memory");
    const int sr = tid >> 4, sc = (tid & 15) * 8, vst0 = v_st(sr, sc), vst1 = v_st(32 + sr, sc);
    const int kgo = (tid >> 3) * DQK + (tid & 7) * 8, klo = (tid >> 3) * (DQK * 2) + (((tid & 7) << 4) ^ (((tid >> 3) & 7) << 4));
    const int vb0 = (int)(uintptr_t)V_lds + v_rd_base(lane);
    int kb[4];
#pragma unroll
    for (int m = 0; m < 4; ++m) { kb[m] = (int)(uintptr_t)K_lds + r32 * (DQK * 2) + 16 * (hi ^ (r32 & 1)) + 32 * (m ^ ((r32 >> 1) & 3)); asm volatile("" : "+v"(kb[m])); }
    struct { bf16x8 vs0, vs1, ks[NKCH]; } sr_[SDEPTH];
#define SLOAD(i, k0) do { sr_[i].vs0 = *(const bf16x8*)(&Vh[(long)((k0) + sr) * 128 + sc]); sr_[i].vs1 = *(const bf16x8*)(&Vh[(long)((k0) + 32 + sr) * 128 + sc]); \
    _Pragma("unroll") for (int q_ = 0; q_ < NKCH; ++q_) sr_[i].ks[q_] = *(const bf16x8*)(&Kh[(long)(k0) * DQK + kgo + q_ * 64]); } while (0)
#define SWRITE(b, i) do { *(bf16x8*)(V_lds + (b) * SHM_V + vst0) = sr_[i].vs0; *(bf16x8*)(V_lds + (b) * SHM_V + vst1) = sr_[i].vs1; \
    _Pragma("unroll") for (int q_ = 0; q_ < NKCH; ++q_) *(bf16x8*)(K_lds + (b) * SHM_K + klo + q_ * 128) = sr_[i].ks[q_]; } while (0)
#define SWAIT() do { if constexpr (SDEPTH == 1) asm volatile("s_waitcnt vmcnt(0)" ::: "memory"); else if constexpr (NKCH == 2) asm volatile("s_waitcnt vmcnt(4)" ::: "memory"); else asm volatile("s_waitcnt vmcnt(5)" ::: "memory"); } while (0)
#define RESC(a) do { if (__any((a) < 1.f)) { if (hi == 0) al_l[r32] = (a); asm volatile("s_waitcnt lgkmcnt(0)" ::: "memory"); \
    _Pragma("unroll") for (int d = 0; d < 4; ++d) _Pragma("unroll") for (int r = 0; r < 16; ++r) o[d][r] *= al_l[crow(r, hi)]; } } while (0)
    f32x16 pA0, pA1, pB0, pB1; float mnA, mnB, alA, alB; bf16x8 pa0, pa1, pa2, pa3; const int NT = seq / 64;
    constexpr int SE = 0, SO = SDEPTH - 1;
    SLOAD(SE, 0); asm volatile("s_waitcnt vmcnt(0)" ::: "memory"); SWRITE(0, SE); __syncthreads();
    qkt<DQK, NQR>(pA0, pA1, kb, 0, qr, (int)(uintptr_t)Qs, r32, hi); partialSM(pA0, pA1, m_reg, mnA, alA, SCALE);
    SLOAD(SO, 64); if constexpr (SDEPTH == 2) { if (2 < NT) SLOAD(SE, 2 * 64); }
    SWAIT(); SWRITE(1, SO); __syncthreads();
    for (int j = 1; j + 1 < NT; j += 2) {
        SBAR(); qkt<DQK, NQR>(pB0, pB1, kb, SHM_K, qr, (int)(uintptr_t)Qs, r32, hi);
        finishSM(pA0, pA1, alA, l_reg, pa0, pa1, pa2, pa3); SBAR();
        SLOAD(SO, (j + SDEPTH) * 64); SBAR();
        pv_d0(o, vb0, pa0, pa1, pa2, pa3); partialSM(pB0, pB1, m_reg, mnB, alB, SCALE);
        __syncthreads(); SWAIT(); SWRITE(0, SE);
        RESC(alB); __syncthreads();
        SBAR(); qkt<DQK, NQR>(pA0, pA1, kb, 0, qr, (int)(uintptr_t)Qs, r32, hi);
        finishSM(pB0, pB1, alB, l_reg, pa0, pa1, pa2, pa3); SBAR();
        if (SDEPTH == 1 || j + 3 < NT) SLOAD(SE, (j + 1 + SDEPTH) * 64); SBAR();
        pv_d0(o, vb0 + SHM_V, pa0, pa1, pa2, pa3); partialSM(pA0, pA1, m_reg, mnA, alA, SCALE);
        __syncthreads(); SWAIT(); SWRITE(1, SO);
        RESC(alA); __syncthreads();
    }
    SBAR(); qkt<DQK, NQR>(pB0, pB1, kb, SHM_K, qr, (int)(uintptr_t)Qs, r32, hi);
    finishSM(pA0, pA1, alA, l_reg, pa0, pa1, pa2, pa3); SBAR();
    pv_d0(o, vb0, pa0, pa1, pa2, pa3); partialSM(pB0, pB1, m_reg, mnB, alB, SCALE);
    __syncthreads(); RESC(alB);
    finishSM(pB0, pB1, alB, l_reg, pa0, pa1, pa2, pa3); SBAR();
    pv_d0(o, vb0 + SHM_V, pa0, pa1, pa2, pa3);
    if (hi == 0) li_l[r32] = l_reg; asm volatile("s_waitcnt lgkmcnt(0)" ::: "memory");
    float rli[16];
#pragma unroll
    for (int r = 0; r < 16; ++r) rli[r] = __builtin_amdgcn_rcpf(li_l[crow(r, hi)]);
    bf16_t* Ow = Ob + (long)(wid * 32) * ldo;
#pragma unroll
    for (int r = 0; r < 16; ++r) { const int orow = crow(r, hi);
#pragma unroll
        for (int d0 = 0; d0 < 4; ++d0) Ow[(long)orow * ldo + d0 * 32 + r32] = f2bf(o[d0][r] * rli[r]); }
    __syncthreads();
#undef SLOAD
#undef SWRITE
#undef SWAIT
#undef RESC
}

template <int DQK> DI void attn_body_old(const bf16_t* Qb, const bf16_t* Kh, const bf16_t* Vh, bf16_t* Ob, int ldo, int seq, char* lds, const float SCALE, PR p, SideCvt& sc) {
    if constexpr (DQK == 192) attn_body<192, ATT_SD_M>(Qb, Kh, Vh, Ob, ldo, seq, lds, SCALE); else attn_body<128, ATT_SD_G>(Qb, Kh, Vh, Ob, ldo, seq, lds, SCALE);
}
#if MOE_FP8
DI CvtDesc side_desc(PR p, int l, int e, int r) {
    CvtDesc d; unsigned char* wl = p.ws + WS_WEIGHTS + (size_t)l * WL_END; const int m = r >> 6, t = r & 63, sp = (t & 48) | ((t & 3) << 2) | ((t >> 2) & 3); const bool sh = e >= 64; const size_t eo = sh ? (size_t)l : (size_t)(l * 64 + e);
    d.drow0 = m;
    if (m < 2) { const float* b_ = m == 0 ? (sh ? p.sh_w1 : p.exp_w1) : (sh ? p.sh_w3 : p.exp_w3); d.src = b_ + (eo << 20);
        d.dst = (bf16_t*)(wl + WL_W13 + ((size_t)e << 21)); d.ldS = 512; d.ldD = D; d.k0 = 32 * sp; d.n0 = 0; }
    else { d.src = (sh ? p.sh_w2 : p.exp_w2) + (eo << 20);
        d.dst = (bf16_t*)(wl + WL_W2 + ((size_t)e << 20)); d.ldS = D; d.ldD = 512; d.k0 = 32 * (sp & 15); d.n0 = 512 * (sp >> 4); }
    return d;
}
DI void side_advance(SideCvt& sc) { --sc.rem; sc.e += sc.de; sc.r += sc.dr; if (sc.r >= 192) { sc.r -= 192; ++sc.e; } }
template <int NQ> struct SideV { typedef f32x4 T; };
template <> struct SideV<2> { typedef float __attribute__((ext_vector_type(2))) T; };
template <int NQ>
DI void side_load(PR p, const SideCvt& sc, int h, typename SideV<NQ>::T (&v)[4], unsigned char*& dstp, int& ldd, float& scl, int lane) {
    const CvtDesc d = side_desc(p, sc.l, sc.e, sc.r); const int kg = lane >> 3, ng = lane & 7, nnb = 32 * sc.sub, nl = NQ == 4 ? 4 * ng : 16 * h + 2 * ng;
    const int k0 = d.k0 + 4 * kg, nn = d.n0 + nnb + nl;
    const int drow = d.drow0 < 2 ? ((nnb >> 7) << 8) + d.drow0 * 128 + (nnb & 127) + nl : nn;
    const float* s0 = d.src + (size_t)k0 * d.ldS + nn;
#pragma unroll
    for (int i = 0; i < 4; ++i) { const float* a_ = s0 + (size_t)i * d.ldS;
        if constexpr (NQ == 4) asm volatile("global_load_dwordx4 %0, %1, off nt" : "=v"(v[i]) : "v"(a_) : "memory");
        else asm volatile("global_load_dwordx2 %0, %1, off nt" : "=v"(v[i]) : "v"(a_) : "memory"); }
    dstp = (unsigned char*)d.dst + (size_t)drow * d.ldD + k0; ldd = d.ldD;
    scl = d.ldD == D ? F8_SW13 : F8_SW2;
}
template <int NQ>
DI void side_finish(const typename SideV<NQ>::T (&v)[4], unsigned char* dstp, int ldd, float scl) {
#pragma unroll
    for (int q = 0; q < NQ; ++q) *(unsigned*)(dstp + (size_t)q * ldd) = f8pack4(v[0][q] * scl, v[1][q] * scl, v[2][q] * scl, v[3][q] * scl);
}
DI void side_cleanup(PR p, SideCvt& sc, int lane) {
    while (sc.rem > 0) { f32x4 v[4]; unsigned char* dp; int ldd; float scl; side_load<4>(p, sc, 0, v, dp, ldd, scl, lane);
        asm volatile("s_waitcnt vmcnt(0)" : "+v"(v[0]), "+v"(v[1]), "+v"(v[2]), "+v"(v[3]) :: "memory"); side_finish<4>(v, dp, ldd, scl); side_advance(sc); }
}
#endif
template <int DQK, int SIDE> DI void attn_body2(const bf16_t* __restrict__ Qb, const bf16_t* __restrict__ Kh, const bf16_t* __restrict__ Vh, bf16_t* __restrict__ Ob, int ldo, int seq, char* lds, const float SCALE, PR p, SideCvt& sc);
template <int DQK> DI void attn_body2_sel(const bf16_t* Qb, const bf16_t* Kh, const bf16_t* Vh, bf16_t* Ob, int ldo, int seq, char* lds, const float SCALE, PR p, SideCvt& sc) {
    attn_body2<DQK, (SIDE_STREAM == 0) ? 0 : (DQK == 128 ? 1 : 2)>(Qb, Kh, Vh, Ob, ldo, seq, lds, SCALE, p, sc);
}
template <int DQK, int SIDE>
DI void attn_body2(const bf16_t* __restrict__ Qb, const bf16_t* __restrict__ Kh, const bf16_t* __restrict__ Vh, bf16_t* __restrict__ Ob, int ldo, int seq, char* lds, const float SCALE, PR p, SideCvt& sc) {
    constexpr int SHM_V = 64 * 128 * 2, SHM_K = 64 * DQK * 2, ND0 = DQK / 16, KP = SHM_K / 8192, VP = 2, NP = KP + VP;
    constexpr int V_RING = 0, K_RING = 4 * SHM_V, WS_OFF = K_RING + 3 * SHM_K;
    int tid = threadIdx.x; asm volatile("" : "+v"(tid));
    const int wid = __builtin_amdgcn_readfirstlane(tid >> 6), lane = tid & 63, r32 = lane & 31, hi = lane >> 5;
    float* ws = (float*)(lds + WS_OFF) + wid * 64; float* li_l = ws; float* al_l = ws + 32;
    float m_reg = -1e30f, l_reg = 0; f32x16 o[4]; bf16x8 qr[ND0];
#pragma unroll
    for (int d = 0; d < 4; ++d)
#pragma unroll
        for (int r = 0; r < 16; ++r) o[d][r] = 0.f;
    int kgo[KP], vgo[VP];
#pragma unroll
    for (int q = 0; q < KP; ++q) { const int sl = (wid * KP + q) * 64 + lane, row = sl / (DQK / 8), ch = sl % (DQK / 8), gch = (ch & ~7) | ((ch & 7) ^ (row & 7)); kgo[q] = row * DQK + gch * 8; }
#pragma unroll
    for (int q = 0; q < VP; ++q) { const int off = (wid * VP + q) * 1024 + lane * 16, sub = off >> 9, w = off & 511, kk = (sub >> 2) * 8 + (w >> 6), k = (kk & ~0xC) | ((kk & 4) << 1) | ((kk & 8) >> 1), c = (sub & 3) * 32 + ((w & 63) >> 1); vgo[q] = k * 128 + c; }
    LAS unsigned char* L = (LAS unsigned char*)lds;
#define DMA_TILE(t, ks, vs) do { \
    _Pragma("unroll") for (int q_ = 0; q_ < KP; ++q_) __builtin_amdgcn_global_load_lds((const unsigned*)(Kh + (size_t)(t) * 64 * DQK + kgo[q_]), (LAS unsigned*)(L + K_RING + (ks) * SHM_K + (wid * KP + q_) * 1024), 16, 0, 0); \
    _Pragma("unroll") for (int q_ = 0; q_ < VP; ++q_) __builtin_amdgcn_global_load_lds((const unsigned*)(Vh + (size_t)(t) * 64 * 128 + vgo[q_]), (LAS unsigned*)(L + V_RING + (vs) * SHM_V + (wid * VP + q_) * 1024), 16, 0, 0); } while (0)
    const int NT = seq / 64;
    DMA_TILE(0, 0, 0); DMA_TILE(1, 1, 1);
    typedef __attribute__((address_space(1))) const bf16x8 gq_t; typedef __attribute__((address_space(1))) bf16_t go_t;
    const bf16_t* Qw = Qb + (long)(wid * 32 + r32) * DQK + hi * 8;
#pragma unroll
    for (int d0 = 0; d0 < ND0; ++d0) qr[d0] = *(gq_t*)(Qw + d0 * 16);
    const int vb0 = (int)(uintptr_t)(lds + V_RING) + v_rd_base(lane);
    int kb[4];
#pragma unroll
    for (int m = 0; m < 4; ++m) { kb[m] = (int)(uintptr_t)(lds + K_RING) + r32 * (DQK * 2) + 16 * (hi ^ (r32 & 1)) + 32 * (m ^ ((r32 >> 1) & 3)); asm volatile("" : "+v"(kb[m])); }
#define RESC(a) do { if (__any((a) < 1.f)) { if (hi == 0) al_l[r32] = (a); asm volatile("s_waitcnt lgkmcnt(0)" ::: "memory"); \
    _Pragma("unroll") for (int d = 0; d < 4; ++d) _Pragma("unroll") for (int r = 0; r < 16; ++r) o[d][r] *= al_l[crow(r, hi)]; } } while (0)
    const int NTs = seq / 64;
    int jmax; { const int rem = sc.rem; if (SIDE == 1) jmax = rem < NTs - 2 ? rem : NTs - 2; else if (SIDE == 2) { const int cap = (NTs - 2) & ~1; jmax = 2 * rem < cap ? 2 * rem : cap; } else jmax = 0; }
#define ACT(j) (SIDE != 0 && (j) >= 0 && (j) < jmax)
#define WAITV_IMM(n) asm volatile("s_waitcnt vmcnt(" #n ")" ::: "memory")
#define STEP_SYNC(j) do { if ((j) + 1 < NT) { if (ACT((j) - 1) && ACT((j) - 2)) { if constexpr (SIDE == 1) { if constexpr (NP == 5) WAITV_IMM(17); else WAITV_IMM(16); } else { if constexpr (NP == 5) WAITV_IMM(13); else WAITV_IMM(12); } } \
        else { if constexpr (NP == 5) WAITV_IMM(5); else WAITV_IMM(4); } } else WAITV_IMM(0); \
    asm volatile("s_waitcnt lgkmcnt(0)" ::: "memory"); __builtin_amdgcn_s_barrier(); asm volatile("" ::: "memory"); } while (0)
    constexpr int SNQ = SIDE == 2 ? 2 : 4;
#define SIDE_TOP(j) const bool sa_ = ACT(j); const int sh_ = SIDE == 2 ? ((j) & 1) : 0; typename SideV<SNQ>::T sv_[4]; unsigned char* sdp_ = nullptr; int sld_ = 0; float ssc_ = 0.f; if (sa_) side_load<SNQ>(p, sc, sh_, sv_, sdp_, sld_, ssc_, lane)
#define SIDE_WAIT() asm volatile("s_waitcnt vmcnt(%4)" : "+v"(sv_[0]), "+v"(sv_[1]), "+v"(sv_[2]), "+v"(sv_[3]) : "n"(NP) : "memory")
#define SIDE_END() do { if (sa_) { SIDE_WAIT(); if (!(PROBE_SIDE_DRY && sc.dry)) side_finish<SNQ>(sv_, sdp_, sld_, ssc_); if (SIDE == 1 || sh_ == 1) side_advance(sc); } } while (0)
    f32x16 pA0, pA1, pB0, pB1; float alA, alB; bf16x8 pa0, pa1, pa2, pa3;
    asm volatile("s_waitcnt vmcnt(0)" ::: "memory");
    { const float C = SCALE * 1.4426950408889634f;
#pragma unroll
      for (int d0 = 0; d0 < ND0; ++d0) { bf16x8 v = qr[d0]; u32x4 w;
          w.x = pk2(bf2f((bf16_t)v[0]) * C, bf2f((bf16_t)v[1]) * C); w.y = pk2(bf2f((bf16_t)v[2]) * C, bf2f((bf16_t)v[3]) * C); w.z = pk2(bf2f((bf16_t)v[4]) * C, bf2f((bf16_t)v[5]) * C); w.w = pk2(bf2f((bf16_t)v[6]) * C, bf2f((bf16_t)v[7]) * C);
          qr[d0] = *reinterpret_cast<bf16x8*>(&w); } }
    asm volatile("s_waitcnt lgkmcnt(0)" ::: "memory"); __builtin_amdgcn_s_barrier(); asm volatile("" ::: "memory");
    { SIDE_TOP(0);
      if (2 < NT) DMA_TILE(2, 2, 2);
      qkt2<DQK>(pA0, pA1, kb, 0, qr, 0.f); partialSM2(pA0, pA1, m_reg, 0.f, alA);
      SIDE_END(); }
    int ks = 1, vs = 0;
    for (int j = 1; j + 1 < NT; j += 2) {
        STEP_SYNC(j);
        { SIDE_TOP(j);
        if (j + 2 < NT) { const int ks2 = ks == 0 ? 2 : ks - 1, vs2 = (vs + 3) & 3; DMA_TILE(j + 2, ks2, vs2); }
        SBAR(); qkt2<DQK>(pB0, pB1, kb, ks * SHM_K, qr, -m_reg);
        finishSM(pA0, pA1, alA, l_reg, pa0, pa1, pa2, pa3); SBAR();
        pv_d0(o, vb0 + vs * SHM_V, pa0, pa1, pa2, pa3); partialSM2(pB0, pB1, m_reg, m_reg, alB);
        RESC(alB);
        SIDE_END(); }
        ks = ks == 2 ? 0 : ks + 1; vs = (vs + 1) & 3;
        STEP_SYNC(j + 1);
        { SIDE_TOP(j + 1);
        if (j + 3 < NT) { const int ks2 = ks == 0 ? 2 : ks - 1, vs2 = (vs + 3) & 3; DMA_TILE(j + 3, ks2, vs2); }
        SBAR(); qkt2<DQK>(pA0, pA1, kb, ks * SHM_K, qr, -m_reg);
        finishSM(pB0, pB1, alB, l_reg, pa0, pa1, pa2, pa3); SBAR();
        pv_d0(o, vb0 + vs * SHM_V, pa0, pa1, pa2, pa3); partialSM2(pA0, pA1, m_reg, m_reg, alA);
        RESC(alA);
        SIDE_END(); }
        ks = ks == 2 ? 0 : ks + 1; vs = (vs + 1) & 3;
    }
    STEP_SYNC(NT - 1);
    SBAR(); qkt2<DQK>(pB0, pB1, kb, ks * SHM_K, qr, -m_reg);
    finishSM(pA0, pA1, alA, l_reg, pa0, pa1, pa2, pa3); SBAR();
    pv_d0(o, vb0 + vs * SHM_V, pa0, pa1, pa2, pa3); partialSM2(pB0, pB1, m_reg, m_reg, alB);
    RESC(alB);
    vs = (vs + 1) & 3;
    finishSM(pB0, pB1, alB, l_reg, pa0, pa1, pa2, pa3); SBAR();
    pv_d0(o, vb0 + vs * SHM_V, pa0, pa1, pa2, pa3);
    if (hi == 0) li_l[r32] = l_reg; asm volatile("s_waitcnt lgkmcnt(0)" ::: "memory");
    float rli[16];
#pragma unroll
    for (int r = 0; r < 16; ++r) rli[r] = __builtin_amdgcn_rcpf(li_l[crow(r, hi)]) * (OUTPROJ_FP8 ? F8_SMIX : 1.f);
    go_t* Ow = OUTPROJ_FP8 ? (go_t*)((unsigned char*)Ob + (long)(wid * 32) * ldo) : (go_t*)(Ob + (long)(wid * 32) * ldo);
#pragma unroll
    for (int r = 0; r < 16; ++r) { const int orow = crow(r, hi);
#pragma unroll
        for (int d0 = 0; d0 < 4; ++d0) {
            if (OUTPROJ_FP8) ((__attribute__((address_space(1))) unsigned char*)Ow)[(long)orow * ldo + d0 * 32 + r32] = (unsigned char)(f8pack4(o[d0][r] * rli[r], 0.f, 0.f, 0.f) & 0xFFu);
            else Ow[(long)orow * ldo + d0 * 32 + r32] = f2bf(o[d0][r] * rli[r]); } }
    asm volatile("s_waitcnt lgkmcnt(0)" ::: "memory"); __builtin_amdgcn_s_barrier(); asm volatile("" ::: "memory");
#undef DMA_TILE
#undef RESC
#undef STEP_SYNC
#undef ACT
#undef WAITV_IMM
#undef SIDE_TOP
#undef SIDE_END
#undef SIDE_WAIT
}

constexpr int GL_V = 0;
constexpr int GL_K = 16384;
constexpr int GL_Q = GL_K + 9216;
constexpr int GL_ZF = GL_Q + 9216;
constexpr int GL_ZB = GL_ZF + 4096;
constexpr int GL_LF = GL_ZB + 4096;
constexpr int GL_LB = GL_LF + 16640;
constexpr int GL_X0 = GL_LB + 16640;
constexpr int GL_KEF = GL_X0, GL_KEB = GL_X0 + 9216;
constexpr int GL_QD = GL_X0, GL_KI = GL_X0 + 9216;
constexpr int GL_O = GL_X0 + 18432;
static_assert(GL_O + 64 * 132 * 4 <= 160 * 1024 - 256, "GLA LDS");
DI int gla_row0(int b, int c) { return c < 4 ? NLAT + b * CTXL + c * 64 : b * SEQ + (c - 4) * 64; }
DI void gla_prep(PR p, int l, char* lds, int b, int h, int c, bool needq) {
    const int tid = tid_here(), lane = tid & 63, wid = tid >> 6;
    const bf16_t* PR_ = (const bf16_t*)(p.ws + WS_U + U_PROJ);
    const int row0 = gla_row0(b, c);
    {
        const int t = tid >> 3, dg = (tid & 7) * 8; const bf16_t* pr = PR_ + (size_t)(row0 + t) * INWP;
        *(bf16x8*)(lds + GL_K + t * 144 + dg * 2) = *(const bf16x8*)(pr + C_GK + h * 64 + dg);
        if (needq) { const bf16x8 qv = *(const bf16x8*)(pr + C_GQ + h * 64 + dg); u32x4 w;
            w.x = pk2(bf2f((bf16_t)qv[0]) * 0.125f, bf2f((bf16_t)qv[1]) * 0.125f); w.y = pk2(bf2f((bf16_t)qv[2]) * 0.125f, bf2f((bf16_t)qv[3]) * 0.125f);
            w.z = pk2(bf2f((bf16_t)qv[4]) * 0.125f, bf2f((bf16_t)qv[5]) * 0.125f); w.w = pk2(bf2f((bf16_t)qv[6]) * 0.125f, bf2f((bf16_t)qv[7]) * 0.125f);
            *(u32x4*)(lds + GL_Q + t * 144 + dg * 2) = w; }
        const int sr = tid >> 4, sc = (tid & 15) * 8;
        *(bf16x8*)(lds + GL_V + v_st(sr, sc)) = *(const bf16x8*)(PR_ + (size_t)(row0 + sr) * INWP + C_GV + h * 128 + sc);
        *(bf16x8*)(lds + GL_V + v_st(32 + sr, sc)) = *(const bf16x8*)(PR_ + (size_t)(row0 + 32 + sr) * INWP + C_GV + h * 128 + sc);
        if (tid < 256) { const int tt = (tid & 127) >> 1, half = tid & 1, dir = tid >> 7; const bf16x8 zv = *(const bf16x8*)(PR_ + (size_t)(row0 + tt) * INWP + (dir ? C_ZB : C_ZF) + half * 8);
            float* Z = (float*)(lds + (dir ? GL_ZB : GL_ZF)) + tt * 16 + half * 8;
#pragma unroll
            for (int j = 0; j < 8; ++j) Z[j] = bf2f((bf16_t)zv[j]); }
    }
    float wf[16], wb[16];
#pragma unroll
    for (int r = 0; r < 16; ++r) { wf[r] = p.gla_wg2_f[((size_t)l * 16 + r) * 256 + h * 64 + lane]; wb[r] = p.gla_wg2_b[((size_t)l * 16 + r) * 256 + h * 64 + lane]; }
    const float bgf = p.gla_bg_f[l * 256 + h * 64 + lane], bgb = p.gla_bg_b[l * 256 + h * 64 + lane];
    __syncthreads();
#pragma unroll
    for (int i = 0; i < 8; ++i) {
        const int t = wid * 8 + i; const float* ZF = (const float*)(lds + GL_ZF) + t * 16; const float* ZB = (const float*)(lds + GL_ZB) + t * 16;
        float zf = bgf, zb = bgb;
#pragma unroll
        for (int r = 0; r < 16; ++r) { zf += ZF[r] * wf[r]; zb += ZB[r] * wb[r]; }
        const float lf = fminf(zf, 0.f) - __logf(1.f + __expf(-fabsf(zf))), lb = fminf(zb, 0.f) - __logf(1.f + __expf(-fabsf(zb)));
        ((float*)(lds + GL_LF))[t * 65 + lane] = lf * 0.0625f; ((float*)(lds + GL_LB))[t * 65 + lane] = lb * 0.0625f;
    }
    __syncthreads();
#pragma unroll
    for (int i = 0; i < 8; ++i) {
        const int d = wid * 8 + i;
        float* F = (float*)(lds + GL_LF) + lane * 65 + d; float* Bk = (float*)(lds + GL_LB) + lane * 65 + d;
        float f = *F, g = *Bk;
#pragma unroll
        for (int o = 1; o < 64; o <<= 1) {
            const float fu = __int_as_float(__builtin_amdgcn_ds_bpermute(((lane - o) & 63) << 2, __float_as_int(f)));
            const float gu = __int_as_float(__builtin_amdgcn_ds_bpermute(((lane + o) & 63) << 2, __float_as_int(g)));
            if (lane >= o) f += fu; if (lane + o < 64) g += gu;
        }
        *F = f; *Bk = g;
    }
    __syncthreads();
}
DI void gla_phaseA(PR p, int l, char* lds) {
    float* GS = (float*)(p.ws + WS_U + U_GS); float* GD = (float*)(p.ws + WS_GDEC);
    for (int u = bid_here(); u < 16 * 68; u += gridDim.x) {
        const int h = u & 3, t2_ = u >> 2, c = t2_ % 68, b = t2_ / 68, bh = b * 4 + h;
        gla_prep(p, l, lds, b, h, c, false);
        const int tid = tid_here(), lane = tid & 63, wid = tid >> 6, r32 = lane & 31, hi = lane >> 5;
        {
            const float* LF = (const float*)(lds + GL_LF); const float* LB = (const float*)(lds + GL_LB);
            const float lastf = LF[63 * 65 + lane], lastb = LB[0 * 65 + lane];
            float ef[8], eb[8];
#pragma unroll
            for (int i = 0; i < 8; ++i) { const int t = wid * 8 + i; const float k = bf2f(*(const bf16_t*)(lds + GL_K + t * 144 + lane * 2));
                ef[i] = k * __expf(lastf - LF[t * 65 + lane]); eb[i] = k * __expf(lastb - LB[t * 65 + lane]); }
            u32x4 w; w.x = pk2(ef[0], ef[1]); w.y = pk2(ef[2], ef[3]); w.z = pk2(ef[4], ef[5]); w.w = pk2(ef[6], ef[7]); *(u32x4*)(lds + GL_KEF + lane * 144 + wid * 16) = w;
            w.x = pk2(eb[0], eb[1]); w.y = pk2(eb[2], eb[3]); w.z = pk2(eb[4], eb[5]); w.w = pk2(eb[6], eb[7]); *(u32x4*)(lds + GL_KEB + lane * 144 + wid * 16) = w;
            if (wid == 0) { GD[((size_t)(0 * 16 + bh) * 68 + c) * 64 + lane] = __expf(lastf); GD[((size_t)(1 * 16 + bh) * 68 + c) * 64 + lane] = __expf(lastb); }
        }
        __syncthreads();
        {
            const int rh = wid & 1, cb = wid >> 1;
            const int vb = (int)(uintptr_t)(lds + GL_V) + v_rd_base(lane) + cb * 512;
#pragma unroll
            for (int dir = 0; dir < 2; ++dir) {
                const char* KE = lds + (dir ? GL_KEB : GL_KEF) + (rh * 32 + r32) * 144 + hi * 16;
                const bf16x8 a0 = *(const bf16x8*)(KE), a1 = *(const bf16x8*)(KE + 32), a2 = *(const bf16x8*)(KE + 64), a3 = *(const bf16x8*)(KE + 96);
                f32x16 od;
#pragma unroll
                for (int r = 0; r < 16; ++r) od[r] = 0.f;
                pv_one<0>(od, vb, a0, a1, a2, a3);
                float* dst = GS + ((size_t)(dir * 16 + bh) * 68 + c) * 8192 + (size_t)(cb * 32 + r32) * 64 + rh * 32 + 4 * hi;
#pragma unroll
                for (int g = 0; g < 4; ++g) *(f32x4*)(dst + 8 * g) = (f32x4){od[4 * g], od[4 * g + 1], od[4 * g + 2], od[4 * g + 3]};
            }
        }
        __syncthreads();
    }
}
DI void gla_scan(PR p) {
    const float* GS = (const float*)(p.ws + WS_U + U_GS); const float* GD = (const float*)(p.ws + WS_GDEC); bf16_t* GST = (bf16_t*)(p.ws + WS_U + U_GST);
    const int tid = tid_here();
    if (tid >= 256) return;
    for (int u = bid_here(); u < 256; u += gridDim.x) {
        const int e = u * 256 + tid, db = e >> 11, jd4 = e & 2047, d4 = (jd4 & 15) * 4;
        const int dir = db >> 4;
        const float* base = GS + (size_t)db * 68 * 8192 + jd4 * 4; const float* dbase = GD + (size_t)db * 68 * 64 + d4; bf16_t* obase = GST + (size_t)db * 68 * 8192 + jd4 * 4;
#define SC_C(i) (dir == 0 ? (i) : ((i) < 4 ? 3 - (i) : 71 - (i)))
        float z0 = 0.f; asm volatile("" : "+v"(z0));
        f32x4 S = {z0, z0, z0, z0};
        f32x4 cur[4], nxt[4], dc[4], dn[4];
#pragma unroll
        for (int q = 0; q < 4; ++q) { const int c = SC_C(q); cur[q] = *(const f32x4*)(base + (size_t)c * 8192); dc[q] = *(const f32x4*)(dbase + c * 64); }
        for (int i = 0; i < 68; i += 4) {
            if (i + 4 < 68) {
#pragma unroll
                for (int q = 0; q < 4; ++q) { const int c = SC_C(i + 4 + q); nxt[q] = *(const f32x4*)(base + (size_t)c * 8192); dn[q] = *(const f32x4*)(dbase + c * 64); }
            }
#pragma unroll
            for (int q = 0; q < 4; ++q) { const int c = SC_C(i + q); u32x2 w; w.x = pk2(S[0], S[1]); w.y = pk2(S[2], S[3]); *(u32x2*)(obase + (size_t)c * 8192) = w; S = S * dc[q] + cur[q]; }
#pragma unroll
            for (int q = 0; q < 4; ++q) { cur[q] = nxt[q]; dc[q] = dn[q]; }
        }
#undef SC_C
    }
}
DI void gla_phaseC(PR p, int l, char* lds, int qsel = 0) {
    const bf16_t* GST = (const bf16_t*)(p.ws + WS_U + U_GST);
    const bf16_t* PR_ = (const bf16_t*)(p.ws + WS_U + U_PROJ); bf16_t* MIX = (bf16_t*)(p.ws + WS_U + U_MIX);
    unsigned* qctr = (unsigned*)(p.ws + WS_CTL) + 64 * (28 + l + 2 * qsel);
    const int nunits = l == 0 ? 16 * 68 : 16 * 64;
    for (;;) {
        volatile LAS int* flag = (volatile LAS int*)(shm + 32);
        __syncthreads();
        if (tid_here() == 0) *flag = (int)CTL_ADD(qctr, 1u);
        __syncthreads();
        const int u = __builtin_amdgcn_readfirstlane(*flag);
        if (u >= nunits) break;
        const int bh = l == 0 ? u / 68 : u >> 6, c = l == 0 ? u % 68 : 4 + (u & 63), b = bh >> 2, h = bh & 3;
        gla_prep(p, l, lds, b, h, c, true);
        const int tid = tid_here(), lane = tid & 63, wid = tid >> 6, r32 = lane & 31, hi = lane >> 5, rh = wid & 1, cb = wid >> 1;
        const int vb = (int)(uintptr_t)(lds + GL_V) + v_rd_base(lane) + cb * 512;
        f32x16 o;
#pragma unroll
        for (int r = 0; r < 16; ++r) o[r] = 0.f;
#pragma unroll
        for (int dir = 0; dir < 2; ++dir) {
            {
                const int t = tid >> 3, dg = (tid & 7) * 8; const float* LC = (const float*)(lds + (dir ? GL_LB : GL_LF)) + t * 65 + dg;
                const bf16x8 qv = *(const bf16x8*)(lds + GL_Q + t * 144 + dg * 2), kv = *(const bf16x8*)(lds + GL_K + t * 144 + dg * 2);
                float qd[8], ki[8];
#pragma unroll
                for (int j = 0; j < 8; ++j) { const float bc = LC[j]; qd[j] = bf2f((bf16_t)qv[j]) * __expf(bc); ki[j] = bf2f((bf16_t)kv[j]) * __expf(-bc); }
                u32x4 w; w.x = pk2(qd[0], qd[1]); w.y = pk2(qd[2], qd[3]); w.z = pk2(qd[4], qd[5]); w.w = pk2(qd[6], qd[7]); *(u32x4*)(lds + GL_QD + t * 144 + dg * 2) = w;
                w.x = pk2(ki[0], ki[1]); w.y = pk2(ki[2], ki[3]); w.z = pk2(ki[4], ki[5]); w.w = pk2(ki[6], ki[7]); *(u32x4*)(lds + GL_KI + t * 144 + dg * 2) = w;
            }
            __syncthreads();
            {
                const char* QD = lds + GL_QD + (rh * 32 + r32) * 144 + hi * 16; const char* KI = lds + GL_KI + r32 * 144 + hi * 16;
                bf16x8 qf[4];
#pragma unroll
                for (int d0 = 0; d0 < 4; ++d0) qf[d0] = *(const bf16x8*)(QD + d0 * 32);
                f32x16 p0, p1;
#pragma unroll
                for (int r = 0; r < 16; ++r) { p0[r] = 0.f; p1[r] = 0.f; }
#pragma unroll
                for (int d0 = 0; d0 < 4; ++d0) {
                    const bf16x8 k0 = *(const bf16x8*)(KI + d0 * 32), k1 = *(const bf16x8*)(KI + 32 * 144 + d0 * 32);
                    p0 = __builtin_amdgcn_mfma_f32_32x32x16_bf16(k0, qf[d0], p0, 0, 0, 0);
                    p1 = __builtin_amdgcn_mfma_f32_32x32x16_bf16(k1, qf[d0], p1, 0, 0, 0);
                }
                const int tq = rh * 32 + r32;
#pragma unroll
                for (int r = 0; r < 16; ++r) { const int s0 = crow(r, hi), s1 = 32 + s0;
                    const bool ok0 = dir == 0 ? (s0 <= tq) : (s0 >= tq), ok1 = dir == 0 ? (s1 <= tq) : (s1 >= tq);
                    p0[r] = ok0 ? p0[r] : 0.f; p1[r] = ok1 ? p1[r] : 0.f; }
                bf16x8 pa0, pa1, pa2, pa3;
#define PK4(P, BASE, OUT) do { unsigned a0 = cvtpk(P[BASE + 0], P[BASE + 1]), a1 = cvtpk(P[BASE + 2], P[BASE + 3]);   \
    unsigned b0 = cvtpk(P[BASE + 4], P[BASE + 5]), b1 = cvtpk(P[BASE + 6], P[BASE + 7]);                              \
    auto r0 = __builtin_amdgcn_permlane32_swap(a0, b0, false, false); auto r1 = __builtin_amdgcn_permlane32_swap(a1, b1, false, false); \
    u32x4 w_ = {r0[0], r1[0], r0[1], r1[1]}; OUT = *reinterpret_cast<bf16x8*>(&w_); } while (0)
                PK4(p0, 0, pa0); PK4(p0, 8, pa1); PK4(p1, 0, pa2); PK4(p1, 8, pa3);
#undef PK4
                pv_one<0>(o, vb, pa0, pa1, pa2, pa3);
                const bf16_t* Sg = GST + ((size_t)(dir * 16 + bh) * 68 + c) * 8192 + (size_t)(cb * 32 + r32) * 64 + hi * 8;
                const bf16x8 s0 = *(const bf16x8*)(Sg), s1 = *(const bf16x8*)(Sg + 16), s2 = *(const bf16x8*)(Sg + 32), s3 = *(const bf16x8*)(Sg + 48);
                o = __builtin_amdgcn_mfma_f32_32x32x16_bf16(qf[0], s0, o, 0, 0, 0);
                o = __builtin_amdgcn_mfma_f32_32x32x16_bf16(qf[1], s1, o, 0, 0, 0);
                o = __builtin_amdgcn_mfma_f32_32x32x16_bf16(qf[2], s2, o, 0, 0, 0);
                o = __builtin_amdgcn_mfma_f32_32x32x16_bf16(qf[3], s3, o, 0, 0, 0);
            }
            __syncthreads();
        }
        { float* O = (float*)(lds + GL_O);
#pragma unroll
          for (int r = 0; r < 16; ++r) O[(rh * 32 + crow(r, hi)) * 132 + cb * 32 + r32] = o[r]; }
        __syncthreads();
        {
            const int t = tid >> 3, jg = (tid & 7) * 16; const float* O = (const float*)(lds + GL_O) + t * 132 + jg;
            float v[16], ss = 0.f;
#pragma unroll
            for (int q = 0; q < 4; ++q) { const f32x4 x = *(const f32x4*)(O + 4 * q); v[4 * q] = x[0]; v[4 * q + 1] = x[1]; v[4 * q + 2] = x[2]; v[4 * q + 3] = x[3]; ss += x[0] * x[0] + x[1] * x[1] + x[2] * x[2] + x[3] * x[3]; }
            ss += shx(ss, 1, lane); ss += shx(ss, 2, lane); ss += shx(ss, 4, lane);
            const float rstd = rsqrtf(ss * (1.f / 128.f) + EPS);
            const int row = gla_row0(b, c) + t;
            const bf16_t* gp = PR_ + (size_t)row * INWP + C_GG + h * 128 + jg; const float* go = p.gla_g_out + l * 128 + jg;
            const bf16x8 g0 = *(const bf16x8*)(gp), g1 = *(const bf16x8*)(gp + 8);
            float ov[16];
#pragma unroll
            for (int j = 0; j < 16; ++j) { const float gate = bf2f((bf16_t)(j < 8 ? g0[j] : g1[j - 8])); ov[j] = v[j] * rstd * go[j] * silu_f(gate); }
            u32x4 w0, w1; w0.x = pk2(ov[0], ov[1]); w0.y = pk2(ov[2], ov[3]); w0.z = pk2(ov[4], ov[5]); w0.w = pk2(ov[6], ov[7]); w1.x = pk2(ov[8], ov[9]); w1.y = pk2(ov[10], ov[11]); w1.z = pk2(ov[12], ov[13]); w1.w = pk2(ov[14], ov[15]);
            if (OUTPROJ_FP8) { u32x4 w8; w8.x = f8pack4(ov[0] * F8_SMIX, ov[1] * F8_SMIX, ov[2] * F8_SMIX, ov[3] * F8_SMIX); w8.y = f8pack4(ov[4] * F8_SMIX, ov[5] * F8_SMIX, ov[6] * F8_SMIX, ov[7] * F8_SMIX);
                w8.z = f8pack4(ov[8] * F8_SMIX, ov[9] * F8_SMIX, ov[10] * F8_SMIX, ov[11] * F8_SMIX); w8.w = f8pack4(ov[12] * F8_SMIX, ov[13] * F8_SMIX, ov[14] * F8_SMIX, ov[15] * F8_SMIX);
                *(u32x4*)((unsigned char*)MIX + (size_t)row * D + h * 128 + jg) = w8; }
            else { bf16_t* dst = MIX + (size_t)row * D + h * 128 + jg; *(u32x4*)(dst) = w0; *(u32x4*)(dst + 8) = w1; }
        }
        __syncthreads();
    }
}

namespace pg {
constexpr int BK = 64, HALF = 128, HTB = HALF * BK * 2, STAGE_BYTES = 8 * HTB;
DI int lds_byte(int r, int c) { const int st = (r >> 4) * 2 + (c >> 5), rr = r & 15, cc = c & 31, ob = rr * 64 + cc * 2; return st * 1024 + (ob ^ (((ob >> 9) & 1) << 5)); }
DI int perm32(int rho) { const int n = rho >> 4, i = rho & 15; return 8 * (i >> 2) + 4 * n + (i & 3); }
DI void stage_rc(int b, int& R, int& C) { const int st = b / 1024, sb = b % 1024, swz = sb ^ (((sb >> 9) & 1) << 5); R = (st >> 1) * 16 + swz / 64; C = (st & 1) * 32 + (swz % 64) / 2; }
typedef int i32x4_t __attribute__((ext_vector_type(4))); typedef int i32x8_t __attribute__((ext_vector_type(8)));
DI i32x8_t cat8(const bf16x8& lo, const bf16x8& hi) { const i32x4_t a = __builtin_bit_cast(i32x4_t, lo), b = __builtin_bit_cast(i32x4_t, hi); return __builtin_shufflevector(a, b, 0, 1, 2, 3, 4, 5, 6, 7); }
struct XUnit {
    const char* A;
    const char* B;
    int arow0;
    int list;
    int e0, e1, e2, e3;
};
template <class Sched>
DI void gemm_phase(LAS unsigned char* lds, const LAS int* rowlists, const Sched& S) {
    int tid = threadIdx.x; asm volatile("" : "+v"(tid));
    const int wid = __builtin_amdgcn_readfirstlane(tid >> 6), lane = tid & 63, wr = wid >> 2, wc = wid & 3, fr = lane & 15, fq = lane >> 4;
    const int K = S.K, nt = K / BK;
    unsigned voffB[2], voffB1[2];
#pragma unroll
    for (int i = 0; i < 2; ++i) { int R_, C_; stage_rc(tid * 16 + i * 8192, R_, C_);
        if (Sched::PERM == 2) { const int wc_ = R_ >> 5, n_ = (R_ >> 4) & 1, fq_ = (R_ >> 2) & 3, k_ = R_ & 3, row0_ = wc_ * 64 + fq_ * 16 + n_ * 4 + k_;
            voffB[i] = (unsigned)row0_ * (unsigned)S.ldb + (unsigned)C_ * 2u; voffB1[i] = (unsigned)(row0_ + 8) * (unsigned)S.ldb + (unsigned)C_ * 2u; }
        else { if (Sched::PERM == 1) R_ = (R_ & ~31) + perm32(R_ & 31); voffB[i] = (unsigned)R_ * (unsigned)S.ldb + (unsigned)C_ * 2u; voffB1[i] = voffB[i] + (unsigned)HALF * (unsigned)S.ldb; } }
    const size_t kstep = (size_t)(BK * 2);
    const unsigned ldsw = (unsigned)wid * 1024u;
    const int aoff = lds_byte(wr * 64 + fr, fq * 8), boff = lds_byte(wc * 32 + fr, fq * 8);
#define PG_SA(b, h) (((b) * 2 + (h)) * HTB)
#define PG_SB(b, h) ((4 + (b) * 2 + (h)) * HTB)
#define PG_STAGE(bufoff, gbase, voff) do { _Pragma("unroll") for (int _i = 0; _i < 2; ++_i) \
        __builtin_amdgcn_global_load_lds((const unsigned*)((const char*)(gbase) + (voff)[_i]), (LAS unsigned*)(lds + (bufoff) + ldsw + _i * 8192), 16, 0, 0); } while (0)
#define PG_LDA(dst, b, h) do { _Pragma("unroll") for (int m = 0; m < 4; ++m) _Pragma("unroll") for (int k = 0; k < 2; ++k) dst[m][k] = *(const LAS bf16x8*)(lds + PG_SA(b, h) + aoff + m * 2048 + k * 1024); } while (0)
#define PG_LDB(dst, b, h) do { _Pragma("unroll") for (int n = 0; n < 2; ++n) _Pragma("unroll") for (int k = 0; k < 2; ++k) dst[n][k] = *(const LAS bf16x8*)(lds + PG_SB(b, h) + boff + n * 2048 + k * 1024); } while (0)
#define PG_MMA(ai, bj, At, Bt) do { __builtin_amdgcn_s_setprio(1); _Pragma("unroll") for (int m = 0; m < 4; ++m) _Pragma("unroll") for (int n = 0; n < 2; ++n) { \
        if constexpr (Sched::F8) acc[ai][bj][m][n] = __builtin_amdgcn_mfma_scale_f32_16x16x128_f8f6f4(cat8(Bt[n][0], Bt[n][1]), cat8(At[m][0], At[m][1]), acc[ai][bj][m][n], 0, 0, 0, 0, 0, 0); \
        else { _Pragma("unroll") for (int k = 0; k < 2; ++k) acc[ai][bj][m][n] = __builtin_amdgcn_mfma_f32_16x16x32_bf16(Bt[n][k], At[m][k], acc[ai][bj][m][n], 0, 0, 0); } } __builtin_amdgcn_s_setprio(0); } while (0)
#define PG_WAIT_V(n) asm volatile("s_waitcnt vmcnt(" #n ")" ::: "memory")
#define PG_WAIT_L(n) asm volatile("s_waitcnt lgkmcnt(" #n ")" ::: "memory")
#define PG_BAR __builtin_amdgcn_s_barrier()
#define PG_SCHED __builtin_amdgcn_sched_barrier(0)
#define PG_AOFFS(dst, u) do { const int _t = tid_here(); _Pragma("unroll") for (int _i = 0; _i < 2; ++_i) { int _R, _C; stage_rc(_t * 16 + _i * 8192, _R, _C); _Pragma("unroll") for (int _h = 0; _h < 2; ++_h) { \
        unsigned _row; if ((u).list >= 0) { const int _x = rowlists[(u).list + _h * HALF + _R]; _row = _x >= 0 ? (unsigned)(_x >> S.rowshift) : 0u; } else _row = (unsigned)((u).arow0 + _h * HALF + _R); \
        dst[_h][_i] = _row * (unsigned)S.lda + (unsigned)_C * 2u; } } } while (0)
    XUnit cur, nxt; int ui = 0;
    if (!S.next(0, cur)) return;
    if (Sched::STAGGER > 0) { const unsigned long long t0 = __builtin_amdgcn_s_memrealtime(); const unsigned long long dl = (unsigned long long)((blockIdx.x & 7) * Sched::STAGGER); while (__builtin_amdgcn_s_memrealtime() - t0 < dl) __builtin_amdgcn_s_sleep(4); }
    f32x4 acc[2][2][4][2];
#pragma unroll
    for (int a = 0; a < 2; ++a)
#pragma unroll
        for (int b = 0; b < 2; ++b)
#pragma unroll
            for (int m = 0; m < 4; ++m)
#pragma unroll
                for (int n = 0; n < 2; ++n) acc[a][b][m][n] = (f32x4){0.f, 0.f, 0.f, 0.f};
    bf16x8 At[4][2], B0[2][2], B1[2][2];
    unsigned ao[2][2];
    PG_AOFFS(ao, cur);
    PG_WAIT_L(0); PG_SCHED;
    const char* cA = cur.A; const char* cB = cur.B;
    PG_STAGE(PG_SB(0, 0), cB, voffB); PG_STAGE(PG_SA(0, 0), cA, ao[0]); PG_STAGE(PG_SB(0, 1), cB, voffB1); PG_STAGE(PG_SA(0, 1), cA, ao[1]);
    if (wr == 1) PG_BAR;
    PG_WAIT_V(4); PG_BAR;
    PG_STAGE(PG_SB(1, 0), cB + kstep, voffB); PG_STAGE(PG_SA(1, 0), cA + kstep, ao[0]); PG_STAGE(PG_SB(1, 1), cB + kstep, voffB1); PG_STAGE(PG_SA(1, 1), cA + kstep, ao[1]);
    PG_WAIT_V(8); PG_BAR;
    for (;;) {
        const bool has_next = S.next(ui + 1, nxt);
        const char* nA = has_next ? nxt.A : cA; const char* nB = has_next ? nxt.B : cB;
        const bool fast = ui > 0 && Sched::EPI_STORES > 0 && S.fast_first();
        for (int t = 0; t < nt; t += 2) {
            const bool last = (t == nt - 2);
            const char* a2 = last ? nA : cA + (size_t)(t + 2) * kstep; const char* b2 = last ? nB : cB + (size_t)(t + 2) * kstep;
            const char* a3 = a2 + kstep; const char* b3 = b2 + kstep;
            PG_LDB(B0, 0, 0); PG_SCHED; PG_LDA(At, 0, 0);
            PG_WAIT_L(8); PG_BAR; PG_WAIT_L(0); PG_MMA(0, 0, At, B0); PG_BAR; PG_SCHED;
            if (last && has_next) { PG_AOFFS(ao, nxt); }
            PG_LDB(B1, 0, 1); PG_STAGE(PG_SB(0, 0), b2, voffB);
            PG_BAR; PG_WAIT_L(0); PG_MMA(0, 1, At, B1); PG_BAR;
            PG_LDA(At, 0, 1); PG_STAGE(PG_SA(0, 0), a2, ao[0]);
            PG_BAR; PG_WAIT_L(0); PG_MMA(1, 0, At, B0); PG_BAR; PG_SCHED;
            PG_STAGE(PG_SB(0, 1), b2, voffB1);
            { const int relax_ = (t == 0 && fast) ? 1 : 0;
              asm volatile("v_cmp_ne_u32_e32 vcc, 0, %0\n\ts_cbranch_vccnz .Lrelax_a%=\n\ts_waitcnt vmcnt(6)\n\ts_branch .Lrelax_b%=\n.Lrelax_a%=:\n\ts_waitcnt vmcnt(%1)\n.Lrelax_b%=:" :: "v"(relax_), "n"(6 + Sched::EPI_STORES) : "memory", "vcc"); }
            PG_BAR; PG_MMA(1, 1, At, B1); PG_BAR;
            PG_LDB(B0, 1, 0); PG_SCHED; PG_LDA(At, 1, 0); PG_STAGE(PG_SA(0, 1), a2, ao[1]);
            PG_WAIT_L(8); PG_BAR; PG_WAIT_L(0); PG_MMA(0, 0, At, B0); PG_BAR; PG_SCHED;
            PG_LDB(B1, 1, 1); PG_STAGE(PG_SB(1, 0), b3, voffB);
            PG_BAR; PG_WAIT_L(0); PG_MMA(0, 1, At, B1); PG_BAR;
            PG_LDA(At, 1, 1); PG_STAGE(PG_SA(1, 0), a3, ao[0]);
            PG_BAR; PG_WAIT_L(0); PG_MMA(1, 0, At, B0); PG_BAR; PG_SCHED;
            PG_STAGE(PG_SB(1, 1), b3, voffB1);
            PG_WAIT_V(6); PG_BAR; PG_STAGE(PG_SA(1, 1), a3, ao[1]); PG_MMA(1, 1, At, B1); PG_BAR;
        }
        { const int t2 = tid_here(), w2 = t2 >> 6, l2 = t2 & 63; S.epi(acc, cur, w2 >> 2, w2 & 3, l2 & 15, l2 >> 4); }
        if (!has_next) break;
#pragma unroll
        for (int a = 0; a < 2; ++a)
#pragma unroll
            for (int b = 0; b < 2; ++b)
#pragma unroll
                for (int m = 0; m < 4; ++m)
#pragma unroll
                    for (int n = 0; n < 2; ++n) acc[a][b][m][n] = (f32x4){0.f, 0.f, 0.f, 0.f};
        cur = nxt; cA = nA; cB = nB; ++ui;
    }
    PG_WAIT_V(0);
    if (wr == 0) PG_BAR;
    PG_BAR;
#undef PG_SA
#undef PG_SB
#undef PG_STAGE
#undef PG_LDA
#undef PG_LDB
#undef PG_MMA
#undef PG_WAIT_V
#undef PG_WAIT_L
#undef PG_BAR
#undef PG_SCHED
#undef PG_AOFFS
}
}

DI float wave_max(float v, int lane) {
#define DPP_MAX(v, ctrl) (v) = fmaxf((v), __int_as_float(__builtin_amdgcn_update_dpp(0, __float_as_int(v), (ctrl), 0xF, 0xF, true)))
    DPP_MAX(v, 0xB1); DPP_MAX(v, 0x4E); DPP_MAX(v, 0x141); DPP_MAX(v, 0x140);
#undef DPP_MAX
    v = fmaxf(v, shx(v, 16, lane));
    { auto rr = __builtin_amdgcn_permlane32_swap(__float_as_uint(v), __float_as_uint(v), false, false); v = fmaxf(__uint_as_float(rr[0]), __uint_as_float(rr[1])); }
    return v;
}
DI void router_group(PR p, int l, float* LG, int row0, bool dry) {
    const int lane = tid_here() & 63;
    const unsigned char* wl = p.ws + WS_WEIGHTS + (size_t)l * WL_END;
    const bf16_t* WH = (const bf16_t*)(wl + WL_WRH);
    const bf16_t* HH = (const bf16_t*)(p.ws + WS_HBUF);
    int* EIDX = (int*)(p.ws + WS_EIDX); float* EW = (float*)(p.ws + WS_EW); int* EPOS = (int*)(p.ws + WS_EPOS);
    unsigned* cnt = (unsigned*)(p.ws + WS_CNT) + l * 64;
    const float rbias = p.router_b[l * 64 + lane];
    int* PKI = (int*)(LG + 16 * 65);
    const int fr = lane & 15, fq = lane >> 4;
    {
        f32x4 acc[4];
#pragma unroll
        for (int e = 0; e < 4; ++e) acc[e] = (f32x4){0.f, 0.f, 0.f, 0.f};
        const bf16_t* ah = HH + (size_t)(row0 + fr) * D + fq * 8;
        const bf16_t* bh = WH + (size_t)fr * D + fq * 8;
        bf16x8 aA[4], bA[4][4], aB[4], bB[4][4];
#define RT_LOAD(a_, b_, k0_) do { _Pragma("unroll") for (int j = 0; j < 4; ++j) { a_[j] = *(const bf16x8*)(ah + (k0_) + 32 * j); \
        _Pragma("unroll") for (int e = 0; e < 4; ++e) b_[j][e] = *(const bf16x8*)(bh + (size_t)e * 16 * D + (k0_) + 32 * j); } } while (0)
#define RT_MMA(a_, b_) do { _Pragma("unroll") for (int j = 0; j < 4; ++j) _Pragma("unroll") for (int e = 0; e < 4; ++e) acc[e] = __builtin_amdgcn_mfma_f32_16x16x32_bf16(a_[j], b_[j][e], acc[e], 0, 0, 0); } while (0)
        RT_LOAD(aA, bA, 0);
#pragma unroll 1
        for (int k0 = 0; k0 < D; k0 += 256) {
            RT_LOAD(aB, bB, k0 + 128);
            RT_MMA(aA, bA);
            if (k0 + 256 < D) RT_LOAD(aA, bA, k0 + 256);
            RT_MMA(aB, bB);
        }
#undef RT_LOAD
#undef RT_MMA
#pragma unroll
        for (int e = 0; e < 4; ++e)
#pragma unroll
            for (int i = 0; i < 4; ++i) LG[(fq * 4 + i) * 65 + e * 16 + fr] = acc[e][i];
        asm volatile("s_waitcnt lgkmcnt(0)" ::: "memory");
        __builtin_amdgcn_wave_barrier();
        int mycount = 0;
        constexpr int RT_TU = 4;
        for (int t0 = 0; t0 < 16; t0 += RT_TU) {
            float sc[RT_TU], v[RT_TU], cand[RT_TU]; int erk[RT_TU];
#pragma unroll
            for (int u = 0; u < RT_TU; ++u) { sc[u] = sigmoid_f(LG[(t0 + u) * 65 + lane]); v[u] = sc[u] + rbias; }
            float m1[RT_TU], m2[RT_TU];
#pragma unroll
            for (int u = 0; u < RT_TU; ++u) { m1[u] = v[u]; m2[u] = -INFINITY; }
#pragma unroll
            for (int o = 1; o < 8; o <<= 1) {
#pragma unroll
                for (int u = 0; u < RT_TU; ++u) { const float b1 = shx(m1[u], o, lane), b2 = shx(m2[u], o, lane); const float n1 = fmaxf(m1[u], b1), n2 = fmaxf(fminf(m1[u], b1), fmaxf(m2[u], b2)); m1[u] = n1; m2[u] = n2; } }
            const int g = lane >> 3;
#pragma unroll
            for (int u = 0; u < RT_TU; ++u) { const float gs = m1[u] + m2[u]; int grank = 0;
#pragma unroll
                for (int gg = 0; gg < 8; ++gg) { const float s_ = __int_as_float(__builtin_amdgcn_readlane(__float_as_int(gs), gg * 8)); grank += (s_ > gs || (s_ == gs && gg < g)) ? 1 : 0; }
                cand[u] = grank < 4 ? v[u] : -INFINITY; erk[u] = -1; }
#pragma unroll 1
            for (int k = 0; k < 8; ++k) {
                float m[RT_TU];
#pragma unroll
                for (int u = 0; u < RT_TU; ++u) m[u] = wave_max(cand[u], lane);
#pragma unroll
                for (int u = 0; u < RT_TU; ++u) { const unsigned long long bal = __ballot(cand[u] == m[u]); const int win = __builtin_amdgcn_readfirstlane((int)__builtin_ctzll(bal));
                    if (lane == win) { erk[u] = k; cand[u] = -INFINITY; } }
            }
#pragma unroll
            for (int u = 0; u < RT_TU; ++u) { const int t = t0 + u;
                const bool chosen = erk[u] >= 0;
                const float wsum = wave_sum(chosen ? sc[u] : 0.f);
                int pk = -1;
                if (chosen) { const int a = (row0 + t) * 8 + erk[u]; EIDX[a] = lane; EW[a] = sc[u] * (2.5f / wsum); pk = erk[u] | (mycount << 8); ++mycount; }
                PKI[t * 64 + lane] = pk; }
        }
        const unsigned base = (mycount && !dry) ? atomicAdd(&cnt[lane], (unsigned)mycount) : 0u;
        if (!dry) {
#pragma unroll
            for (int t = 0; t < 16; ++t) { const int pk = PKI[t * 64 + lane]; if (pk >= 0) EPOS[(row0 + t) * 8 + (pk & 255)] = (int)base + (pk >> 8); }
        }
        asm volatile("s_waitcnt lgkmcnt(0)" ::: "memory");
        __builtin_amdgcn_wave_barrier();
    }
}
DI void phase_router(PR p, int l, char* lds, bool dry = false) {
    const int tid = tid_here(), wid = tid >> 6;
    const int ntok = l == 0 ? NTOK : NLAT, ngrp = ntok / 16;
    for (int gidx = wid * (int)gridDim.x + bid_here(); gidx < ngrp; gidx += gridDim.x * 8) router_group(p, l, (float*)lds + wid * (16 * 65 + 16 * 64), gidx * 16, dry);
}
DI void phase_moe_index(PR p, int l, char* lds) {
    const int tid = tid_here();
    int* S = (int*)lds;
    const unsigned* cnt = (const unsigned*)(p.ws + WS_CNT) + l * 64;
    int* META = (int*)(p.ws + WS_META) + l * 1024;
    const int* EIDX = (const int*)(p.ws + WS_EIDX); int* EPOS = (int*)(p.ws + WS_EPOS);
    int* SASG = (int*)(p.ws + WS_SASG);
    if (tid < 64) S[128 + tid] = (int)cnt[tid];
    __syncthreads();
    if (tid == 0) { int s = 0; for (int e = 0; e < 64; ++e) { S[e] = s; s += (S[128 + e] + 255) / 256 * 256; } S[64] = s; }
    __syncthreads();
    const int ntok = l == 0 ? NTOK : NLAT;
    for (int a = bid_here() * NTHREADS + tid; a < ntok * 8; a += gridDim.x * NTHREADS) { const int e = EIDX[a], pos = S[e] + EPOS[a]; SASG[pos] = a; EPOS[a] = pos; }
    for (int i = bid_here() * NTHREADS + tid; i < 64 * 256; i += gridDim.x * NTHREADS) { const int e = i >> 8, q = i & 255, c = S[128 + e]; if (S[e] + c + q < S[e + 1]) SASG[S[e] + c + q] = -1; }
    if (blockIdx.x == 0) {
        if (tid == 0) META[0] = S[64] / 256;
        if (tid < 64) { for (int t = S[tid] / 256; t < S[tid + 1] / 256; ++t) META[256 + t] = tid; }
    }
}

struct OrderXcd {
    int nM, nN, nwg;
    DI void init(int nM_, int nN_) { nM = nM_; nN = nN_; nwg = nM_ * nN_; }
    DI bool map(int i, int& pm, int& pn) const {
        const int L = i * (int)gridDim.x + (int)blockIdx.x; if (L >= nwg) return false;
        int wgid = L; { const int q = nwg / 8, r = nwg % 8, xcd = wgid % 8, off = wgid / 8; wgid = (xcd < r ? xcd * (q + 1) : r * (q + 1) + (xcd - r) * q) + off; }
        const int nig = 8 * nN, gid = wgid / nig, fm = gid * 8, gsz = (nM - fm) < 8 ? (nM - fm) : 8;
        pm = fm + ((wgid % nig) % gsz); pn = (wgid % nig) / gsz; return true;
    }
    DI bool lin(int i, int& w) const {
        const int L = i * (int)gridDim.x + (int)blockIdx.x; if (L >= nwg) return false;
        const int q = nwg / 8, r = nwg % 8, xcd = L % 8, off = L / 8; w = (xcd < r ? xcd * (q + 1) : r * (q + 1) + (xcd - r) * q) + off; return true;
    }
};
#define GACC const f32x4 (&acc)[2][2][4][2]
struct SchedInproj {
    static constexpr int PERM = 1; static constexpr int F8 = INPROJ_FP8; static constexpr int EPI_STORES = 16; DI bool fast_first() const { return true; } static constexpr int STAGGER = 0;
    int lda, ldb, K, rowshift; const char* A; const char* W; bf16_t* proj; OrderXcd o;
    DI bool next(int i, pg::XUnit& u) const { int pm, pn; if (!o.map(i, pm, pn)) return false; u.A = A; u.B = W + (size_t)pn * 256 * ldb; u.arow0 = pm * 256; u.list = -1; u.e0 = pm * 256; u.e1 = pn * 256; return true; }
    DI void epi(GACC, const pg::XUnit& u, int wr, int wc, int fr, int fq) const { EpiB16P E; E.O = proj; E.row0 = u.e0; E.col0 = u.e1; E.ld = INWP; E.mul = INPROJ_FP8 ? F8_INV1 : 1.f; E(acc, wr, wc, fr, fq); }
};
DI void phase_inproj(PR p, int l, char* lds) {
    SchedInproj S; S.lda = INPROJ_FP8 ? D : D * 2; S.ldb = S.lda; S.K = INPROJ_FP8 ? D / 2 : D; S.rowshift = 0; S.A = INPROJ_FP8 ? (const char*)(p.ws + WS_U + U_Y) : (const char*)(p.ws + WS_HBUF); S.W = (const char*)(p.ws + WS_WEIGHTS + (size_t)l * WL_END + WL_WIN);
    S.proj = (bf16_t*)(p.ws + WS_U + U_PROJ); S.o.init(68, 15);
    pg::gemm_phase((LAS unsigned char*)lds, (const LAS int*)(lds + pg::STAGE_BYTES), S);
}
struct SchedMlaUp {
    static constexpr int PERM = 0; static constexpr int F8 = 0; static constexpr int EPI_STORES = 0; DI bool fast_first() const { return false; } static constexpr int STAGGER = 0;
    int lda, ldb, K, rowshift; const char* CQ; const char* CKV; const char* WQ; const char* WKV; bf16_t* Qm; bf16_t* Km; bf16_t* Vm; const float2* ropem; OrderXcd o;
    DI bool next(int i, pg::XUnit& u) const { int w; if (!o.lin(i, w)) return false; u.list = -1;
        if (w < 340) { const int pm = w / 5, pn = w % 5; u.A = CQ; u.B = WQ + (size_t)pn * 256 * ldb; u.arow0 = pm * 256; u.e0 = pm * 256; u.e1 = pn * 256; u.e3 = 0; }
        else { const int v = w - 340, pm = v / 6, pn = v % 6; u.A = CKV; u.B = WKV + (size_t)pn * 256 * ldb; u.arow0 = pm * 256; u.e0 = pm * 256; u.e1 = pn * 256; u.e3 = 1; }
        return true; }
    DI void epi(GACC, const pg::XUnit& u, int wr, int wc, int fr, int fq) const {
        if (u.e3 == 0) { EpiUq E; E.Q = Qm; E.ropem = ropem; E.row0 = u.e0; E.col0 = u.e1; E(acc, wr, wc, fr, fq); }
        else { EpiUkv E; E.Km = Km; E.Vm = Vm; E.row0 = u.e0; E.col0 = u.e1; E(acc, wr, wc, fr, fq); } }
};
DI void phase_mla_up(PR p, int l, char* lds) {
    unsigned char* U = p.ws + WS_U; const unsigned char* wl = p.ws + WS_WEIGHTS + (size_t)l * WL_END;
    SchedMlaUp S; S.lda = 1024; S.ldb = 1024; S.K = 512; S.rowshift = 0; S.CQ = (const char*)(U + U_CQN); S.CKV = (const char*)(U + U_CKVN); S.WQ = (const char*)(wl + WL_WUQ); S.WKV = (const char*)(wl + WL_WUKV);
    S.Qm = (bf16_t*)(U + U_QM); S.Km = (bf16_t*)(U + U_KM); S.Vm = (bf16_t*)(U + U_VM); S.ropem = (const float2*)(p.ws + WS_ROPEM); S.o.init(748, 1);
    pg::gemm_phase((LAS unsigned char*)lds, (const LAS int*)(lds + pg::STAGE_BYTES), S);
}
struct SchedOutproj {
    static constexpr int PERM = 1; static constexpr int F8 = OUTPROJ_FP8; static constexpr int EPI_STORES = 16; DI bool fast_first() const { return true; } static constexpr int STAGGER = 0;
    int lda, ldb, K, rowshift; const char* A; const char* W; bf16_t* Y; OrderXcd o;
    DI bool next(int i, pg::XUnit& u) const { int pm, pn; if (!o.map(i, pm, pn)) return false; u.A = A; u.B = W + (size_t)pn * 256 * ldb; u.arow0 = pm * 256; u.list = -1; u.e0 = pm * 256; u.e1 = pn * 256; return true; }
    DI void epi(GACC, const pg::XUnit& u, int wr, int wc, int fr, int fq) const { EpiB16P E; E.O = Y; E.row0 = u.e0; E.col0 = u.e1; E.ld = D; E.mul = OUTPROJ_FP8 ? F8_INV3 : 1.f; E(acc, wr, wc, fr, fq); }
};
DI void phase_outproj(PR p, int l, char* lds) {
    SchedOutproj S; S.lda = OUTPROJ_FP8 ? D : D * 2; S.ldb = S.lda; S.K = OUTPROJ_FP8 ? D / 2 : D; S.rowshift = 0; S.A = (const char*)(p.ws + WS_U + U_MIX); S.W = (const char*)(p.ws + WS_WEIGHTS + (size_t)l * WL_END + WL_WOUT);
    S.Y = (bf16_t*)(p.ws + WS_U + U_Y); S.o.init(l == 0 ? 68 : 64, 8);
    pg::gemm_phase((LAS unsigned char*)lds, (const LAS int*)(lds + pg::STAGE_BYTES), S);
}
struct SchedMoe1 {
    static constexpr int PERM = 1; static constexpr int F8 = MOE_FP8; static constexpr int EPI_STORES = 8; DI bool fast_first() const { return !dry; } static constexpr int STAGGER = STAG_MOE1;
    int lda, ldb, K, rowshift; const char* H; const char* W13; bf16_t* act; const LAS int* uexp; int ntiles; int dry; OrderXcd o;
    DI bool next(int i, pg::XUnit& u) const { int tile, pn; if (!o.map(i, tile, pn)) return false; u.A = H;
        if (tile < ntiles) { const int e = __builtin_amdgcn_readfirstlane(uexp[i]); u.B = W13 + ((size_t)e * 1024 + pn * 256) * ldb; u.list = i * 256; u.arow0 = 0; u.e0 = tile * 256; }
        else { const int ts = tile - ntiles; u.B = W13 + ((size_t)64 * 1024 + pn * 256) * ldb; u.list = -1; u.arow0 = ts * 256; u.e0 = PMAX + ts * 256; }
        u.e1 = pn * 128; return true; }
    DI void epi(GACC, const pg::XUnit& u, int wr, int wc, int fr, int fq) const {
        if (dry) { _Pragma("unroll") for (int a_ = 0; a_ < 2; ++a_) _Pragma("unroll") for (int b_ = 0; b_ < 2; ++b_) _Pragma("unroll") for (int m_ = 0; m_ < 4; ++m_) asm volatile("" :: "v"(acc[a_][b_][m_][0]), "v"(acc[a_][b_][m_][1])); return; }
        if constexpr (MOE_FP8) { EpiMoe1F8 E; E.act = (unsigned char*)act; E.arow0 = u.e0; E.hcol0 = u.e1; E(acc, wr, wc, fr, fq); }
        else { EpiMoe1P E; E.act = act; E.arow0 = u.e0; E.hcol0 = u.e1; E(acc, wr, wc, fr, fq); } }
};
DI void phase_moe1(PR p, int l, char* lds, int dry = 0) {
    const int* META = (const int*)(p.ws + WS_META) + l * 1024; const int ntiles = __builtin_amdgcn_readfirstlane(META[0]), nsh = l == 0 ? 68 : 64;
    SchedMoe1 S; S.lda = MOE_FP8 ? D : D * 2; S.ldb = S.lda; S.K = MOE_FP8 ? D / 2 : D; S.rowshift = 3; S.H = MOE_FP8 ? (const char*)(p.ws + WS_U + U_HLO) : (const char*)(p.ws + WS_HBUF);
    S.W13 = (const char*)(p.ws + WS_WEIGHTS + (size_t)l * WL_END + WL_W13);
    S.act = (bf16_t*)(p.ws + WS_U + U_ACT); S.uexp = (const LAS int*)(lds + pg::STAGE_BYTES) + 31 * 256; S.ntiles = ntiles; S.dry = dry; S.o.init(ntiles + nsh, 4);
    { const int tid = tid_here(); LAS int* RL = (LAS int*)(lds + pg::STAGE_BYTES); const int* SASG = (const int*)(p.ws + WS_SASG);
      for (int i = 0; i < 31; ++i) { int tile, pn; if (!S.o.map(i, tile, pn)) break; if (tile < ntiles && tid < 256) RL[i * 256 + tid] = SASG[tile * 256 + tid];
          if (tid == 0) RL[31 * 256 + i] = tile < ntiles ? META[256 + tile] : 64; }
      __syncthreads(); }
    pg::gemm_phase((LAS unsigned char*)lds, (const LAS int*)(lds + pg::STAGE_BYTES), S);
}
struct SchedMoe2 {
    static constexpr int PERM = 2; static constexpr int F8 = MOE_FP8; static constexpr int EPI_STORES = 8; DI bool fast_first() const { return !dry; } static constexpr int STAGGER = STAG_MOE2;
    int lda, ldb, K, rowshift; const char* ACT; const char* W2; bf16_t* oasg; const int* sasg; const float* sw; bf16_t* ysh; const LAS int* uexp; int ntiles; int fp8; int dry; OrderXcd o;
    DI bool next(int i, pg::XUnit& u) const { int tile, pn; if (!o.map(i, tile, pn)) return false; u.A = ACT; u.list = -1;
        if (tile < ntiles) { const int e = __builtin_amdgcn_readfirstlane(uexp[i]); u.B = W2 + ((size_t)e * D + pn * 256) * ldb; u.arow0 = tile * 256; u.e0 = tile * 256; u.e3 = 0; }
        else { const int ts = tile - ntiles; u.B = W2 + ((size_t)64 * D + pn * 256) * ldb; u.arow0 = PMAX + ts * 256; u.e0 = ts * 256; u.e3 = 1; }
        u.e1 = pn * 256; return true; }
    DI void epi(GACC, const pg::XUnit& u, int wr, int wc, int fr, int fq) const {
        if (dry) { _Pragma("unroll") for (int a_ = 0; a_ < 2; ++a_) _Pragma("unroll") for (int b_ = 0; b_ < 2; ++b_) _Pragma("unroll") for (int m_ = 0; m_ < 4; ++m_) asm volatile("" :: "v"(acc[a_][b_][m_][0]), "v"(acc[a_][b_][m_][1])); return; }
        if (u.e3 == 0 && fp8) { EpiMoe2F8W E; E.oasg = (unsigned char*)oasg; E.srow0 = u.e0; E.col0 = u.e1; E(acc, wr, wc, fr, fq); }
        else if (u.e3 == 0) { EpiMoe2W E; E.oasg = oasg; E.sasg = sasg; E.sw = sw; E.srow0 = u.e0; E.col0 = u.e1; E(acc, wr, wc, fr, fq); }
        else { EpiB16W E; E.O = ysh; E.row0 = u.e0; E.col0 = u.e1; E.ld = D; E(acc, wr, wc, fr, fq); } }
};
DI void phase_moe2(PR p, int l, char* lds, int dry = 0) {
    const int* META = (const int*)(p.ws + WS_META) + l * 1024; const int ntiles = __builtin_amdgcn_readfirstlane(META[0]), nsh = l == 0 ? 68 : 64;
    SchedMoe2 S; S.lda = MOE_FP8 ? 512 : 1024; S.ldb = S.lda; S.K = MOE_FP8 ? 256 : 512; S.rowshift = 0; S.ACT = (const char*)(p.ws + WS_U + U_ACT); S.W2 = (const char*)(p.ws + WS_WEIGHTS + (size_t)l * WL_END + WL_W2);
    S.oasg = (bf16_t*)(p.ws + WS_U + U_OASG); S.sasg = (const int*)(p.ws + WS_SASG); S.sw = (const float*)(p.ws + WS_EW); S.ysh = (bf16_t*)(p.ws + WS_U + U_YSH); S.uexp = (const LAS int*)(lds + pg::STAGE_BYTES); S.ntiles = ntiles; S.fp8 = (OASG_FP8_MASK >> l) & 1; S.dry = dry; S.o.init(ntiles + nsh, 8);
    { const int tid = tid_here(); LAS int* UE = (LAS int*)(lds + pg::STAGE_BYTES);
      if (tid < 64) { int tile, pn; if (S.o.map(tid, tile, pn)) UE[tid] = tile < ntiles ? META[256 + tile] : 64; }
      __syncthreads(); }
    pg::gemm_phase((LAS unsigned char*)lds, (const LAS int*)(lds + pg::STAGE_BYTES), S);
}
DI void phase_attention(PR p, int l, char* lds, int sub = SUB, int side_on = 1, int qsel = 0) {
#define ATT_PTRS unsigned char* U = p.ws + WS_U; asm volatile("" : "+s"(U)); \
    const bf16_t* Qm = (const bf16_t*)(U + U_QM); const bf16_t* Km = (const bf16_t*)(U + U_KM); const bf16_t* Vm = (const bf16_t*)(U + U_VM); \
    const bf16_t* Qg = (const bf16_t*)(U + U_QG); const bf16_t* Kg = (const bf16_t*)(U + U_KG); const bf16_t* Vg = (const bf16_t*)(U + U_VG); bf16_t* MIX = (bf16_t*)(U + U_MIX);
    const int xcd = blockIdx.x & 7, rank = blockIdx.x >> 3, nr = (gridDim.x + 7 - xcd) >> 3;
    const int nloc = 48 + (l == 0 ? 3 : 0);
    SideCvt sc; { const int wid_ = __builtin_amdgcn_readfirstlane(tid_here() >> 6), G = (int)gridDim.x, mt0 = (int)blockIdx.x * 8 + wid_, total = CHUNKS_PER_LAYER * 16, stride = 8 * G, c0 = mt0 >> 4, cstep = stride >> 4;
        sc.l = l; sc.sub = mt0 & 15; sc.e = c0 / 192; sc.r = c0 % 192; sc.de = cstep / 192; sc.dr = cstep % 192; sc.dry = qsel;
        sc.rem = (SIDE_STREAM && side_on && mt0 < total) ? (total - mt0 + stride - 1) / stride : 0; }
    const int cslot = CVT_IN_ATT ? (int)((blockIdx.x >> 3) & 3) : -1;
    if (cslot == 0) cvt_static(p, lds, l);
    if (sub & 1) for (int v = rank; v < nloc; v += nr) {
        ATT_PTRS; (void)Qg; (void)Kg; (void)Vg;
        int b, h, qt, isctx;
        if (v < 48) { const int bh = xcd * 3 + v / 16; b = bh / 6; h = bh % 6; qt = v & 15; isctx = 0; } else { const int bh = xcd * 3 + (v - 48); b = bh / 6; h = bh % 6; qt = 0; isctx = 1; }
        const int qpos = isctx ? 0 : CTXL + qt * 256, seq = isctx ? CTXL : SKV, orow = isctx ? NLAT + b * CTXL : b * SEQ + qt * 256;
        ATT_BODY<192>(Qm + (((size_t)b * 6 + h) * SKV + qpos) * 192, Km + ((size_t)b * 6 + h) * SKV * 192, Vm + ((size_t)b * 6 + h) * SKV * 128,
                                 OUTPROJ_FP8 ? (bf16_t*)((unsigned char*)MIX + (size_t)orow * D + 512 + h * 128) : MIX + (size_t)orow * D + 512 + h * 128, D, seq, lds, 0.07216878364870322f, p, sc);
    }
    if (cslot == 1) cvt_static(p, lds, l);
    if (sub & 2) for (int v = nr - 1 - rank; v < nloc; v += nr) {
        ATT_PTRS; (void)Qm; (void)Km; (void)Vm;
        int b, h, qt, isctx; const int kvh = xcd & 1; b = xcd >> 1;
        if (v < 48) { h = kvh * 3 + v / 16; qt = v & 15; isctx = 0; } else { h = kvh * 3 + (v - 48); qt = 0; isctx = 1; }
        const int qpos = isctx ? 0 : CTXL + qt * 256, seq = isctx ? CTXL : SKV, orow = isctx ? NLAT + b * CTXL : b * SEQ + qt * 256;
        ATT_BODY<128>(Qg + (((size_t)b * 6 + h) * SKV + qpos) * 128, Kg + ((size_t)b * 2 + kvh) * SKV * 128, Vg + ((size_t)b * 2 + kvh) * SKV * 128,
                                 OUTPROJ_FP8 ? (bf16_t*)((unsigned char*)MIX + (size_t)orow * D + 1280 + h * 128) : MIX + (size_t)orow * D + 1280 + h * 128, D, seq, lds, 0.08838834764831845f, p, sc);
    }
#undef ATT_PTRS
    if (cslot == 2) cvt_static(p, lds, l);
    if (SIDE_STREAM) { const int t_ = tid_here(); side_cleanup(p, sc, t_ & 63); __syncthreads(); }
    if (sub & 4) gla_phaseC(p, l, lds, qsel);
    if (cslot == 3) cvt_static(p, lds, l);
}

constexpr int NPH_LAYER = 12, NPH = 1 + 2 * NPH_LAYER;
constexpr int LDS_BYTES = 160 * 1024;
__global__ void __launch_bounds__(NTHREADS, 2) fwd(Params p_arg, int ph_lo, int ph_hi) {
    char* lds = shm + 256;
    volatile LAS unsigned* xbw = (volatile LAS unsigned*)shm;
    const bool fused = (ph_hi - ph_lo) > 1;
    XcdBarrier bar; bar.bar = (unsigned*)(p_arg.ws + WS_BAR); bar.x = 0; bar.st = xbw;
    if (fused) {
        if (threadIdx.x == 0) { xbw[0] = 0u; xbw[1] = 0u; xbw[2] = 0u; xbw[3] = 0u; }
        __syncthreads();
        bar = xcd_barrier_post((unsigned*)(p_arg.ws + WS_BAR), xbw);
    }
    const CAS Params* pk = (const CAS Params*)__builtin_amdgcn_kernarg_segment_ptr();
#define PHASE(idx, CALL) do { if (((PH_MASK >> ((idx) == 0 ? 0 : ((idx) - 1) % NPH_LAYER + 1)) & 1) && (idx) >= ph_lo && (idx) < ph_hi) { const CAS Params* q_ = pk; asm volatile("" : "+s"(q_)); PR p = *q_; int probe_pass = 0; (void)probe_pass; CALL; if ((PROBE_MASK >> ((idx) == 0 ? 0 : ((idx) - 1) % NPH_LAYER + 1)) & 1) { probe_pass = 1; CALL; } if (fused && (idx) + 1 < ph_hi) xcd_barrier(bar); } } while (0)
#define TAIL(ph) ((!CVT_IN_ATT && !SIDE_STREAM && fused && !probe_pass) ? fill_tail(p, lds, (ph)) : (void)0)
    PHASE(0, phase_prologue(p, lds));
    for (int l = 0; l < 2; ++l) {
        const int b0 = 1 + l * NPH_LAYER;
        if (l == 0) PHASE(b0 + 0, phase_norm1(p, 0));
        PHASE(b0 + 1, phase_inproj(p, l, lds));
        PHASE(b0 + 2, (phase_postproj_rows(p, l), gla_phaseA(p, l, lds)));
        PHASE(b0 + 3, (phase_mla_up(p, l, lds), gla_scan(p)));
        PHASE(b0 + 4, (phase_attention(p, l, lds, probe_pass ? PROBE_SUB : SUB, probe_pass ? PROBE_SIDE : 1, probe_pass), TAIL(b0 + 4)));
        PHASE(b0 + 5, phase_outproj(p, l, lds));
        PHASE(b0 + 6, ((probe_pass && l == 1) ? (void)0 : phase_postmix(p, l, lds, FUSE_ROUTER && !probe_pass)));
        if (!FUSE_ROUTER) PHASE(b0 + 7, phase_router(p, l, lds, probe_pass != 0));
        PHASE(b0 + 8, (phase_moe_index(p, l, lds), ((CVT_IN_ATT || SIDE_STREAM) ? (void)0 : fill_drain(p, lds, (l + 1) * CHUNKS_PER_LAYER))));
        PHASE(b0 + 9, (((CVT_IN_ATT || SIDE_STREAM) ? (void)0 : move_head(p, (l + 1) * CHUNKS_PER_LAYER)), phase_moe1(p, l, lds, PROBE_DRY && probe_pass), TAIL(b0 + 9)));
        PHASE(b0 + 10, (phase_moe2(p, l, lds, PROBE_DRY && probe_pass), TAIL(b0 + 10)));
        PHASE(b0 + 11, ((probe_pass && l == 0) ? (void)0 : phase_postffn(p, l, lds)));
    }
#undef PHASE
#undef TAIL
}

extern "C" void kernel_launch(void* const* d_in, const int* in_sizes, int n_in, void* d_out, int out_size, void* d_ws, size_t ws_size, hipStream_t stream) {
    static int grid = 0;
    if (!grid) {
        if (ws_size < WS_TOTAL) { fprintf(stderr, "kernel_launch: workspace too small: %zu < %zu\n", ws_size, (size_t)WS_TOTAL); return; }
        if (hipFuncSetAttribute((const void*)fwd, hipFuncAttributeMaxDynamicSharedMemorySize, LDS_BYTES) != hipSuccess) { fprintf(stderr, "kernel_launch: hipFuncSetAttribute failed\n"); return; }
        int dev = 0, cus = 0, per_cu = 0;
        hipGetDevice(&dev);
        hipDeviceGetAttribute(&cus, hipDeviceAttributeMultiprocessorCount, dev);
        hipOccupancyMaxActiveBlocksPerMultiprocessor(&per_cu, fwd, NTHREADS, LDS_BYTES);
        if (per_cu < 1) { fprintf(stderr, "kernel_launch: occupancy query says %d\n", per_cu); return; }
        grid = cus & ~1;
    }
    Params p{};
    const float** f = (const float**)&p;
    for (int i = 0; i < 31; ++i) f[i] = (const float*)d_in[i];
    p.out = (float*)d_out; p.ws = (unsigned char*)d_ws;
    hipMemsetAsync((unsigned char*)d_ws + WS_BAR, 0, WS_CNT, stream);
#if MK_MULTI
    for (int ph = 0; ph < NPH; ++ph) { if (ph == 1 + NPH_LAYER) continue; hipLaunchKernelGGL(fwd, dim3(grid), dim3(NTHREADS), LDS_BYTES, stream, p, ph, ph + 1); }
#else
    hipLaunchKernelGGL(fwd, dim3(grid), dim3(NTHREADS), LDS_BYTES, stream, p, 0, NPH);
#endif
    const hipError_t le = hipPeekAtLastError();
    if (le != hipSuccess) fprintf(stderr, "kernel_launch: launch failed: %s\n", hipGetErrorName(le));
}
```

```cpp
#include <hip/hip_runtime.h>
#include <stdint.h>
#include <stdio.h>

#ifndef PH_MASK
#define PH_MASK 0x1FFF
#endif
#ifndef SUB
#define SUB 7
#endif
#ifndef ATT_SD_M
#define ATT_SD_M 1
#endif
#ifndef ATT_SD_G
#define ATT_SD_G 2
#endif
#ifndef ATT_NQR_M
#define ATT_NQR_M 12
#endif
#ifndef PROBE_MASK
#define PROBE_MASK 0x0
#endif
#ifndef PROBE_SUB
#define PROBE_SUB 7
#endif
#ifndef PROBE_SIDE
#define PROBE_SIDE 0
#endif
#ifndef PROBE_SIDE_DRY
#define PROBE_SIDE_DRY 0
#endif
#ifndef PROBE_DRY
#define PROBE_DRY 0
#endif
#ifndef ATT_DMA
#define ATT_DMA 1
#endif
#if ATT_DMA
#define ATT_BODY attn_body2_sel
#else
#define ATT_BODY attn_body_old
#endif
#ifndef ROUTER_SPLIT
#define ROUTER_SPLIT 0
#endif
#ifndef FUSE_ROUTER
#define FUSE_ROUTER 0
#endif
#ifndef STAG_MOE1
#define STAG_MOE1 0
#endif
#ifndef STAG_MOE2
#define STAG_MOE2 0
#endif
#ifndef CVT_IN_ATT
#define CVT_IN_ATT 0
#endif
#ifndef SIDE_STREAM
#define SIDE_STREAM 1
#endif
#ifndef MOE_FP8
#define MOE_FP8 1
#endif
#ifndef INPROJ_FP8
#define INPROJ_FP8 1
#endif
#ifndef OUTPROJ_FP8
#define OUTPROJ_FP8 1
#endif
#ifndef MK_MULTI
#define MK_MULTI 0
#endif

typedef unsigned short bf16_t;
typedef short bf16x8 __attribute__((ext_vector_type(8)));
typedef short s16x4 __attribute__((ext_vector_type(4)));
typedef float f32x4 __attribute__((ext_vector_type(4)));
typedef float f32x16 __attribute__((ext_vector_type(16)));
typedef unsigned u32x4 __attribute__((ext_vector_type(4)));
typedef unsigned u32x2 __attribute__((ext_vector_type(2)));
#define DI __device__ __forceinline__

constexpr float F8_SH = 8.f, F8_SW13 = 512.f, F8_SACT = 8.f, F8_SW2 = 16.f;
constexpr float F8_INV1 = 1.f / (F8_SH * F8_SW13), F8_INV2 = 1.f / (F8_SACT * F8_SW2);
constexpr float F8_SMIX = 16.f, F8_INV3 = 1.f / (F8_SMIX * F8_SW13);
DI unsigned f8pack4(float a, float b, float c, float d) {
    a = __builtin_amdgcn_fmed3f(a, -440.f, 440.f); b = __builtin_amdgcn_fmed3f(b, -440.f, 440.f); c = __builtin_amdgcn_fmed3f(c, -440.f, 440.f); d = __builtin_amdgcn_fmed3f(d, -440.f, 440.f);
    int t = __builtin_amdgcn_cvt_pk_fp8_f32(a, b, 0, false); t = __builtin_amdgcn_cvt_pk_fp8_f32(c, d, t, true); return (unsigned)t; }
constexpr int D = 2048, NB = 4, SEQ = 4096, CTXL = 256, NLAT = NB * SEQ, NCTX = NB * CTXL, NTOK = NLAT + NCTX, SKV = SEQ + CTXL;
constexpr int INW = 3808, INWP = 3840;
constexpr int C_GQ = 0, C_GK = 256, C_GV = 512, C_GG = 1024, C_ZF = 1536, C_ZB = 1552, C_CQ = 1568, C_CKV = 1952, C_KR = 2464, C_AQ = 2528, C_AK = 3296, C_AV = 3552;
constexpr int NE = 64, TOPK = 8, DEXP = 512;
constexpr int PMAX = NTOK * TOPK + NE * 256;
constexpr int NTHREADS = 512;
constexpr float EPS = 1e-6f;

constexpr size_t MiB = 1024ull * 1024ull;
constexpr size_t al256(size_t x) { return (x + 255) / 256 * 256; }
constexpr size_t WS_BAR = 0;
constexpr size_t WS_CTL = 16384;
constexpr size_t WS_CNT = 16384 + 8192;
constexpr size_t WS_META = WS_CNT + 1024;
constexpr size_t WS_MOD = WS_META + 2 * 4096;
constexpr size_t WS_ROPEG = al256(WS_MOD + 2 * 5 * 12288 * 4);
constexpr size_t WS_ROPEM = WS_ROPEG + 64 * 32 * 8;
constexpr size_t WS_ZROW = WS_ROPEM + 64 * 16 * 8;
constexpr size_t WS_GDEC = WS_ZROW + 4096;
constexpr size_t WS_EIDX = al256(WS_GDEC + 2 * 16 * 68 * 64 * 4);
constexpr size_t WS_EW = WS_EIDX + (size_t)NTOK * 8 * 4;
constexpr size_t WS_EPOS = WS_EW + (size_t)NTOK * 8 * 4;
constexpr size_t WS_SASG = WS_EPOS + (size_t)NTOK * 8 * 4;
constexpr size_t WS_SW = al256(WS_SASG + (size_t)PMAX * 4);
constexpr size_t WS_SMALL_END = al256(WS_SW + (size_t)PMAX * 4);
static_assert(WS_SMALL_END <= 8 * MiB, "small region");
constexpr size_t SZ_WIN = (size_t)INWP * D * 2, SZ_WUQ = (size_t)1280 * 512 * 2, SZ_WUKV = (size_t)1536 * 512 * 2, SZ_WOUT = (size_t)D * D * 2, SZ_WR = (size_t)64 * D * 2;
constexpr size_t SZ_W13 = (size_t)65 * 1024 * D * 2, SZ_W2 = (size_t)65 * D * 512 * 2;
constexpr size_t WL_WIN = 0, WL_WUQ = WL_WIN + SZ_WIN, WL_WUKV = WL_WUQ + SZ_WUQ, WL_WOUT = WL_WUKV + SZ_WUKV, WL_WRH = WL_WOUT + SZ_WOUT, WL_WRL = WL_WRH + SZ_WR,
                 WL_W13 = WL_WRL + SZ_WR, WL_W2 = WL_W13 + SZ_W13, WL_END = WL_W2 + SZ_W2;
constexpr size_t WS_WEIGHTS = 8 * MiB;
constexpr size_t WS_XRES = WS_WEIGHTS + 2 * WL_END;
constexpr size_t WS_HBUF = WS_XRES + (size_t)NTOK * D * 4;
constexpr size_t WS_U = WS_HBUF + (size_t)NTOK * D * 2;
constexpr size_t U_Y = 0;
constexpr size_t U_YSH = (size_t)NTOK * D * 2;
constexpr size_t U_PROJ = U_Y + (size_t)NTOK * D * 4;
constexpr size_t U_QM = U_PROJ + (size_t)NTOK * INWP * 2;
constexpr size_t U_KM = U_QM + (size_t)NB * 6 * SKV * 192 * 2;
constexpr size_t U_VM = U_KM + (size_t)NB * 6 * SKV * 192 * 2;
constexpr size_t U_QG = U_VM + (size_t)NB * 6 * SKV * 128 * 2;
constexpr size_t U_KG = U_QG + (size_t)NB * 6 * SKV * 128 * 2;
constexpr size_t U_VG = U_KG + (size_t)NB * 2 * SKV * 128 * 2;
constexpr size_t U_GS = U_VG + (size_t)NB * 2 * SKV * 128 * 2;
constexpr size_t U_MIX = U_GS + (size_t)2 * 16 * 68 * 64 * 128 * 4;
constexpr size_t U_CQN = U_MIX + (size_t)NTOK * D * 2;
constexpr size_t U_CKVN = U_CQN + (size_t)NTOK * 512 * 2;
constexpr size_t U_GST = U_CKVN + (size_t)NTOK * 512 * 2;
constexpr size_t U_MIX_END = U_GST + (size_t)2 * 16 * 68 * 8192 * 2;
constexpr size_t U_HLO = U_PROJ;
constexpr size_t U_ACT = U_HLO + (size_t)NTOK * D * 2;
constexpr size_t U_OASG = U_ACT + (size_t)(PMAX + NTOK) * 512 * 2;
constexpr size_t U_MOE_END = U_OASG + (size_t)NTOK * 8 * D * 2;
constexpr size_t U_GLC = U_MIX_END;
static_assert(U_GLC + (size_t)16 * 68 * 2 * 4096 * 4 <= U_MOE_END, "the gate cache lies inside the (then dead) expert-output slot of the MoE view");
constexpr size_t WS_TOTAL = WS_U + (U_MIX_END > U_MOE_END ? U_MIX_END : U_MOE_END);
static_assert(WS_TOTAL <= 2048ull * MiB, "workspace over 2 GiB");
static_assert(!(MOE_FP8 && ROUTER_SPLIT), "U_HLO holds either the router's lo part or the fp8 copy of the FFN input");
static_assert(MOE_FP8 && SIDE_STREAM && !CVT_IN_ATT, "the fp8 expert weights are produced by the attention side stream only");

struct Params {
    const float *x, *c, *ctx, *c_ctx, *w_mod, *b_mod, *g_pre_mix, *g_post_mix, *g_pre_ffn, *g_post_ffn, *w_in, *gla_wg2_f, *gla_bg_f, *gla_wg2_b, *gla_bg_b, *gla_g_out,
        *mla_g_q, *mla_w_uq, *mla_g_kv, *mla_w_ukv, *gqa_g_q, *gqa_g_k, *w_out, *router_w, *router_b, *exp_w1, *exp_w3, *exp_w2, *sh_w1, *sh_w3, *sh_w2;
    float* out; unsigned char* ws;
};

extern __shared__ __attribute__((aligned(16))) char shm[];
#define CAS __attribute__((address_space(4)))
typedef const CAS Params& PR;
DI int bid_here() { int b = blockIdx.x; asm volatile("" : "+s"(b)); return b; }
DI int tid_here() { int t = threadIdx.x; asm volatile("" : "+v"(t)); return t; }
DI float bf2f(bf16_t v) { return __uint_as_float(((unsigned)v) << 16); }
DI bf16_t f2bf(float f) { unsigned u = __float_as_uint(f); u += 0x7FFFu + ((u >> 16) & 1u); return (bf16_t)(u >> 16); }
DI unsigned pk2(float lo, float hi) { unsigned r; asm("v_cvt_pk_bf16_f32 %0, %1, %2" : "=v"(r) : "v"(lo), "v"(hi)); return r; }
DI float shx(float v, int o, int lane) { return __int_as_float(__builtin_amdgcn_ds_bpermute((lane ^ o) << 2, __float_as_int(v))); }
#define DPP_ADD(v, ctrl) (v) += __int_as_float(__builtin_amdgcn_update_dpp(0, __float_as_int(v), (ctrl), 0xF, 0xF, true))
DI float wave_sum(float v) {
    const int lane = tid_here() & 63;
    DPP_ADD(v, 0xB1);
    DPP_ADD(v, 0x4E);
    DPP_ADD(v, 0x141);
    DPP_ADD(v, 0x140);
    v += shx(v, 16, lane);
    { auto rr = __builtin_amdgcn_permlane32_swap(__float_as_uint(v), __float_as_uint(v), false, false); v = __uint_as_float(rr[0]) + __uint_as_float(rr[1]); }
    return v;
}
DI float wave_scan_incl(float v) {
#define DPP_SCAN(ctrl, rmask, bc) v += __int_as_float(__builtin_amdgcn_update_dpp(0, __float_as_int(v), (ctrl), (rmask), 0xF, (bc)))
    DPP_SCAN(0x111, 0xF, true); DPP_SCAN(0x112, 0xF, true); DPP_SCAN(0x114, 0xF, true); DPP_SCAN(0x118, 0xF, true);
    DPP_SCAN(0x142, 0xA, false);
    DPP_SCAN(0x143, 0xC, false);
#undef DPP_SCAN
    return v;
}
DI float silu_f(float v) { return v * __builtin_amdgcn_rcpf(1.f + __expf(-v)); }
DI float sigmoid_f(float v) { return __builtin_amdgcn_rcpf(1.f + __expf(-v)); }
struct Tok { int b, s, isctx, mrow, kvpos; };
DI Tok tok_of(int r) { Tok t; if (r < NLAT) { t.b = r >> 12; t.s = r & 4095; t.isctx = 0; t.mrow = t.b; t.kvpos = CTXL + t.s; } else { const int q = r - NLAT; t.b = q >> 8; t.s = q & 255; t.isctx = 1; t.mrow = 4; t.kvpos = t.s; } return t; }
DI const float* xrow_in(PR p, int l, int r) { if (l == 0) return r < NLAT ? p.x + (size_t)r * D : p.ctx + (size_t)(r - NLAT) * D; return (const float*)(p.ws + WS_XRES) + (size_t)r * D; }

#define XB_TMO      128
#define XB_XCNT(j)  (256  + 64 * (j))
#define XB_XSUB(j)  (1280 + 64 * (j))
#define XB_XGEN(j)  (2304 + 64 * (j))
#define XB_TOP      3328
#define XB_TOPGEN   3392
#define XCD_BAR_WORDS 3456
#define XB_SPIN_CAP (1u << 18)
#define LAS __attribute__((address_space(3)))
__device__ __forceinline__ unsigned xb_ld(unsigned* p)              { return __hip_atomic_load(p, __ATOMIC_RELAXED, __HIP_MEMORY_SCOPE_AGENT); }
__device__ __forceinline__ unsigned xb_add(unsigned* p, unsigned v) { return __hip_atomic_fetch_add(p, v, __ATOMIC_RELAXED, __HIP_MEMORY_SCOPE_AGENT); }
__device__ __forceinline__ unsigned xb_xcc_id() { return (unsigned)__builtin_amdgcn_s_getreg((3 << 11) | 20) & 0xFu; }
#define XB_SPIN(cond, bar) do { unsigned _sp = 0; while (cond) { __builtin_amdgcn_s_sleep(1); \
    if ((++_sp & 255u) == 0u) { if (xb_ld(&(bar)[XB_TMO])) break; if (_sp > XB_SPIN_CAP) { atomicAdd(&(bar)[XB_TMO], 1u); break; } } } } while (0)
struct XcdBarrier { unsigned* bar; unsigned x; volatile LAS unsigned* st; };
__device__ __forceinline__ XcdBarrier xcd_barrier_post(unsigned* bar, volatile LAS unsigned* st) {
    XcdBarrier b; b.bar = bar; b.x = xb_xcc_id(); b.st = st;
    if (threadIdx.x == 0) (void)xb_add(&bar[XB_XCNT(b.x)], 1u);
    return b;
}
__device__ __forceinline__ void xcd_barrier_complete(unsigned* bar, unsigned x, unsigned& nloc, unsigned& nx) {
    const unsigned G = gridDim.x * gridDim.y * gridDim.z;
    unsigned sum, cnt, mine, sp = 0u;
    for (;;) {
        sum = 0u; cnt = 0u; mine = 0u;
#pragma unroll
        for (unsigned j = 0; j < 16; ++j) { const unsigned c = xb_ld(&bar[XB_XCNT(j)]); sum += c; cnt += (c > 0u) ? 1u : 0u; mine = (j == x) ? c : mine; }
        if (sum == G) break;
        __builtin_amdgcn_s_sleep(1);
        if ((++sp & 255u) == 0u) { if (xb_ld(&bar[XB_TMO])) break; if (sp > XB_SPIN_CAP) { atomicAdd(&bar[XB_TMO], 1u); break; } }
    }
    nloc = mine > 0u ? mine : 1u; nx = cnt > 0u ? cnt : 1u;
}
__device__ __forceinline__ void xcd_barrier(const XcdBarrier& b) {
    asm volatile("s_waitcnt vmcnt(0)" ::: "memory");
    __syncthreads();
    if (threadIdx.x == 0) {
        unsigned* bar = b.bar;
        __builtin_amdgcn_s_waitcnt(0);
        unsigned nloc = b.st[0], nx = b.st[1];
        if (nloc == 0u) { xcd_barrier_complete(bar, b.x, nloc, nx); b.st[0] = nloc; b.st[1] = nx; }
        const unsigned old = xb_add(&bar[XB_XSUB(b.x)], 1u);
        const unsigned gen = old / nloc;
        if (old + 1u == (gen + 1u) * nloc) {
            __builtin_amdgcn_fence(__ATOMIC_RELEASE, "agent");
            asm volatile("s_waitcnt vmcnt(0)" ::: "memory");
            const unsigned og = xb_add(&bar[XB_TOP], 1u);
            const unsigned tg = og / nx;
            if (og + 1u == (tg + 1u) * nx) xb_add(&bar[XB_TOPGEN], 1u);
            else XB_SPIN(xb_ld(&bar[XB_TOPGEN]) == tg, bar);
            __builtin_amdgcn_fence(__ATOMIC_ACQUIRE, "agent");
            xb_add(&bar[XB_XGEN(b.x)], 1u);
            asm volatile("s_waitcnt vmcnt(0)" ::: "memory");
        } else {
            XB_SPIN(xb_ld(&bar[XB_XGEN(b.x)]) == gen, bar);
            __builtin_amdgcn_fence(__ATOMIC_ACQUIRE, "agent");
            asm volatile("s_waitcnt vmcnt(0)" ::: "memory");
        }
    }
    __syncthreads();
}

template <int KT>
DI void cvt_tile(char* lds, const float* src, int ldS, int Nvalid, bf16_t* dst, bf16_t* dst_lo, int ldD, int k0, int n0, int drow0, const float* gk, float f8scale = 0.f) {
    float* T = (float*)lds;
    const int tid = tid_here();
    {
        const int c4 = tid & 15, kr = tid >> 4, n = n0 + c4 * 4;
        f32x4 v[KT / 32];
#pragma unroll
        for (int i = 0; i < KT / 32; ++i) { v[i] = (f32x4){0.f, 0.f, 0.f, 0.f}; if (n < Nvalid) v[i] = __builtin_nontemporal_load((const f32x4*)(src + (size_t)(k0 + kr + 32 * i) * ldS + n)); }
#pragma unroll
        for (int i = 0; i < KT / 32; ++i) { const int k = kr + 32 * i; if (gk) v[i] = v[i] * gk[k0 + k];
            T[k * 65 + c4 * 4 + 0] = v[i][0]; T[k * 65 + c4 * 4 + 1] = v[i][1]; T[k * 65 + c4 * 4 + 2] = v[i][2]; T[k * 65 + c4 * 4 + 3] = v[i][3]; }
    }
    __syncthreads();
    {
        constexpr int KPL = KT / 8;
        const int nl = tid >> 3, kc = (tid & 7) * KPL;
#pragma unroll
        for (int q = 0; q < KPL / 8; ++q) {
            float v[8];
#pragma unroll
            for (int j = 0; j < 8; ++j) v[j] = T[(kc + q * 8 + j) * 65 + nl];
            if (f8scale != 0.f) {
                u32x2 w8; w8.x = f8pack4(v[0] * f8scale, v[1] * f8scale, v[2] * f8scale, v[3] * f8scale); w8.y = f8pack4(v[4] * f8scale, v[5] * f8scale, v[6] * f8scale, v[7] * f8scale);
                *(u32x2*)((unsigned char*)dst + (size_t)(drow0 + nl) * ldD + k0 + kc + q * 8) = w8; continue; }
            u32x4 w; w.x = pk2(v[0], v[1]); w.y = pk2(v[2], v[3]); w.z = pk2(v[4], v[5]); w.w = pk2(v[6], v[7]);
            *(u32x4*)(dst + (size_t)(drow0 + nl) * ldD + k0 + kc + q * 8) = w;
            if (dst_lo) {
                float r[8];
#pragma unroll
                for (int j = 0; j < 8; ++j) r[j] = v[j] - bf2f(f2bf(v[j]));
                u32x4 w2; w2.x = pk2(r[0], r[1]); w2.y = pk2(r[2], r[3]); w2.z = pk2(r[4], r[5]); w2.w = pk2(r[6], r[7]);
                *(u32x4*)(dst_lo + (size_t)(drow0 + nl) * ldD + k0 + kc + q * 8) = w2;
            }
        }
    }
    __syncthreads();
}
template <int KT>
DI void cvt_matrix(char* lds, const float* src, int K, int N, int Npad, bf16_t* dst, bf16_t* dst_lo, int mode, const float* gk, int ldD = 0, float f8scale = 0.f) {
    if (ldD == 0) ldD = K;
    const int nkt = K / KT, nnt = Npad / 64, nt = nkt * nnt;
    for (int t = bid_here(); t < nt; t += gridDim.x) {
        const int kt = t % nkt, ntile = t / nkt, n0 = ntile * 64;
        int drow0 = n0;
        if (mode == 1) drow0 = (n0 >> 7) * 256 + (n0 & 127);
        else if (mode == 2) drow0 = (n0 >> 7) * 256 + 128 + (n0 & 127);
        cvt_tile<KT>(lds, src, N, N, dst, dst_lo, ldD, kt * KT, n0, drow0, gk, f8scale);
    }
}
constexpr int CHUNKS_PER_LAYER = 65 * 192, CHUNKS_TOTAL = 2 * CHUNKS_PER_LAYER;
DI void cvt_chunk(PR p, char* lds, int g) {
    const int l = g / CHUNKS_PER_LAYER, gg = g % CHUNKS_PER_LAYER;
    unsigned char* wl = p.ws + WS_WEIGHTS + (size_t)l * WL_END;
    const int e = gg / 192, r = gg % 192, m = r >> 6, t = r & 63;
    bf16_t* d13 = (bf16_t*)(wl + WL_W13) + (size_t)e * 1024 * D; bf16_t* d2 = (bf16_t*)(wl + WL_W2) + (size_t)e * D * 512;
    if (m < 2) {
        const float* src = m == 0 ? (e < 64 ? p.exp_w1 + ((size_t)l * 64 + e) * D * 512 : p.sh_w1 + (size_t)l * D * 512) : (e < 64 ? p.exp_w3 + ((size_t)l * 64 + e) * D * 512 : p.sh_w3 + (size_t)l * D * 512);
        const int kt = t & 7, n0 = (t >> 3) * 64, drow0 = (n0 >> 7) * 256 + m * 128 + (n0 & 127);
        cvt_tile<256>(lds, src, 512, 512, d13, nullptr, D, kt * 256, n0, drow0, nullptr);
    } else {
        const float* src = e < 64 ? p.exp_w2 + ((size_t)l * 64 + e) * 512 * D : p.sh_w2 + (size_t)l * 512 * D;
        const int kt = t & 1, n0 = (t >> 1) * 64;
        cvt_tile<256>(lds, src, D, D, d2, nullptr, 512, kt * 256, n0, n0, nullptr);
    }
}
struct CvtDesc { const float* src; bf16_t* dst; int ldS, ldD, k0, n0, drow0; };
struct SideCvt { int rem, l, e, r, sub, de, dr, dry; };
DI CvtDesc chunk_desc(PR p, int g) {
    CvtDesc d; const int l = g / CHUNKS_PER_LAYER, gg = g % CHUNKS_PER_LAYER;
    unsigned char* wl = p.ws + WS_WEIGHTS + (size_t)l * WL_END;
    const int e = gg / 192, r = gg % 192, m = r >> 6, t = r & 63;
    if (m < 2) { d.src = m == 0 ? (e < 64 ? p.exp_w1 + ((size_t)l * 64 + e) * D * 512 : p.sh_w1 + (size_t)l * D * 512) : (e < 64 ? p.exp_w3 + ((size_t)l * 64 + e) * D * 512 : p.sh_w3 + (size_t)l * D * 512);
        d.dst = MOE_FP8 ? (bf16_t*)(wl + WL_W13 + (size_t)e * 1024 * D) : (bf16_t*)(wl + WL_W13) + (size_t)e * 1024 * D; d.ldS = 512; d.ldD = D; d.k0 = (t & 7) * 256; d.n0 = (t >> 3) * 64; d.drow0 = (d.n0 >> 7) * 256 + m * 128 + (d.n0 & 127); }
    else { d.src = e < 64 ? p.exp_w2 + ((size_t)l * 64 + e) * 512 * D : p.sh_w2 + (size_t)l * 512 * D;
        d.dst = MOE_FP8 ? (bf16_t*)(wl + WL_W2 + (size_t)e * D * 512) : (bf16_t*)(wl + WL_W2) + (size_t)e * D * 512; d.ldS = D; d.ldD = 512; d.k0 = (t & 1) * 256; d.n0 = (t >> 1) * 64; d.drow0 = d.n0; }
    return d;
}
DI void cvt_load(const CvtDesc& d, f32x4 (&v)[8], int tid) {
    const int c4 = tid & 15, kr = tid >> 4;
#pragma unroll
    for (int i = 0; i < 8; ++i) v[i] = __builtin_nontemporal_load((const f32x4*)(d.src + (size_t)(d.k0 + kr + 32 * i) * d.ldS + d.n0 + c4 * 4));
}
DI void cvt_finish(char* lds, const CvtDesc& d, const f32x4 (&v)[8], int tid) {
    float* T = (float*)lds;
    { const int c4 = tid & 15, kr = tid >> 4;
#pragma unroll
      for (int i = 0; i < 8; ++i) { const int k = kr + 32 * i; T[k * 65 + c4 * 4 + 0] = v[i][0]; T[k * 65 + c4 * 4 + 1] = v[i][1]; T[k * 65 + c4 * 4 + 2] = v[i][2]; T[k * 65 + c4 * 4 + 3] = v[i][3]; } }
    __syncthreads();
    { const int nl = tid >> 3, kc = (tid & 7) * 32;
#pragma unroll
      for (int q = 0; q < 4; ++q) { float x[8];
#pragma unroll
          for (int j = 0; j < 8; ++j) x[j] = T[(kc + q * 8 + j) * 65 + nl];
          u32x4 w; w.x = pk2(x[0], x[1]); w.y = pk2(x[2], x[3]); w.z = pk2(x[4], x[5]); w.w = pk2(x[6], x[7]);
          *(u32x4*)(d.dst + (size_t)(d.drow0 + nl) * d.ldD + d.k0 + kc + q * 8) = w; } }
    __syncthreads();
}
DI void cvt_static(PR p, char* lds, int l) {
    const int tid = tid_here(), G = (int)gridDim.x, base = l * CHUNKS_PER_LAYER, lim = base + CHUNKS_PER_LAYER;
    for (int c = base + bid_here(); c < lim; c += 4 * G) {
        const bool h1 = c + G < lim, h2 = c + 2 * G < lim, h3 = c + 3 * G < lim;
        const CvtDesc d0 = chunk_desc(p, c), d1 = chunk_desc(p, h1 ? c + G : c), d2 = chunk_desc(p, h2 ? c + 2 * G : c), d3 = chunk_desc(p, h3 ? c + 3 * G : c);
        f32x4 v0[8], v1[8], v2[8], v3[8];
        cvt_load(d0, v0, tid); if (h1) cvt_load(d1, v1, tid); if (h2) cvt_load(d2, v2, tid); if (h3) cvt_load(d3, v3, tid);
        cvt_finish(lds, d0, v0, tid); if (h1) cvt_finish(lds, d1, v1, tid); if (h2) cvt_finish(lds, d2, v2, tid); if (h3) cvt_finish(lds, d3, v3, tid);
    }
}
#define CTL_LD(ptr) __hip_atomic_load((ptr), __ATOMIC_RELAXED, __HIP_MEMORY_SCOPE_AGENT)
#define CTL_ADD(ptr, v) __hip_atomic_fetch_add((ptr), (v), __ATOMIC_RELAXED, __HIP_MEMORY_SCOPE_AGENT)
DI void fill_tail(PR p, char* lds, int ph) {
    unsigned* ctl = (unsigned*)(p.ws + WS_CTL);
    volatile LAS int* flag = (volatile LAS int*)(shm + 16);
    const int tid = tid_here();
    __syncthreads();
    if (tid == 0) CTL_ADD(&ctl[64 * (1 + ph)], 1u);
    for (;;) {
        if (tid == 0) {
            int c = -1;
            if (CTL_LD(&ctl[64 * (1 + ph)]) + 8u < gridDim.x && CTL_LD(&ctl[0]) < (unsigned)CHUNKS_TOTAL) { c = (int)CTL_ADD(&ctl[0], 4u); if (c >= CHUNKS_TOTAL) c = -1; }
            *flag = c;
        }
        __syncthreads();
        const int c = __builtin_amdgcn_readfirstlane(*flag);
        __syncthreads();
        if (c < 0) break;
        for (int q = 0; q < 4; ++q) {
            if (c + q < CHUNKS_TOTAL) cvt_chunk(p, lds, c + q);
            if (q < 3 && __builtin_amdgcn_readfirstlane((int)CTL_LD(&ctl[64 * (1 + ph)])) >= (int)gridDim.x) { for (int q2 = q + 1; q2 < 4; ++q2) if (c + q2 < CHUNKS_TOTAL) cvt_chunk(p, lds, c + q2); break; }
        }
    }
}
DI void fill_drain(PR p, char* lds, int limit) {
    unsigned* ctl = (unsigned*)(p.ws + WS_CTL);
    const int h0 = __builtin_amdgcn_readfirstlane((int)CTL_LD(&ctl[0]));
    for (int c = h0 + bid_here(); c < limit; c += gridDim.x) cvt_chunk(p, lds, c);
}
DI void move_head(PR p, int limit) { if (blockIdx.x == 0 && tid_here() == 0) __hip_atomic_fetch_max((unsigned*)(p.ws + WS_CTL), (unsigned)limit, __ATOMIC_RELAXED, __HIP_MEMORY_SCOPE_AGENT); }
DI void phase_prologue(PR p, char* lds) {
    const int tid = tid_here();
    unsigned char* ws = p.ws;
    if (blockIdx.x == 0) {
        unsigned* cnt = (unsigned*)(ws + WS_CNT);
        if (tid < 128) cnt[tid] = 0u;
        unsigned* z = (unsigned*)(ws + WS_ZROW);
        for (int i = tid; i < 1024; i += NTHREADS) z[i] = 0u;
        float2* rg = (float2*)(ws + WS_ROPEG);
        for (int i = tid; i < 64 * 32; i += NTHREADS) { const int pos = i >> 5, f = i & 31; const float inv = powf(10000.f, -(float)(2 * f) / 64.f); float s, c; sincosf((float)pos * inv, &s, &c); rg[i] = make_float2(c, s); }
        float2* rm = (float2*)(ws + WS_ROPEM);
        for (int i = tid; i < 64 * 16; i += NTHREADS) { const int pos = i >> 4, f = i & 15; const float inv = powf(10000.f, -(float)(2 * f) / 32.f); float s, c; sincosf((float)pos * inv, &s, &c); rm[i] = make_float2(c, s); }
    }
    {
        float* sc = (float*)lds;
        float* red = sc + 5 * 2048;
        bool loaded = false;
        struct F3 { float a, b, c; };
        for (int u = bid_here(); u < 256; u += gridDim.x) {
            if (!loaded) { for (int i = tid; i < 5 * 2048; i += NTHREADS) { const int r = i >> 11, k = i & 2047; const float v = r < 4 ? p.c[r * 2048 + k] : p.c_ctx[k]; sc[i] = silu_f(v); } loaded = true; __syncthreads(); }
            const int l = u >> 7, col0 = (u & 127) * 96;
            const int cg = tid & 31, kp = tid >> 5;
            float acc[5][3];
#pragma unroll
            for (int r = 0; r < 5; ++r) { acc[r][0] = 0.f; acc[r][1] = 0.f; acc[r][2] = 0.f; }
            const float* wb = p.w_mod + ((size_t)l * 2048) * 12288 + col0 + cg * 3;
#pragma unroll 8
            for (int kk = 0; kk < 128; ++kk) {
                const int k = kp * 128 + kk;
                const F3 w = *(const F3*)(wb + (size_t)k * 12288);
#pragma unroll
                for (int r = 0; r < 5; ++r) { const float s_ = sc[r * 2048 + k]; acc[r][0] += w.a * s_; acc[r][1] += w.b * s_; acc[r][2] += w.c * s_; }
            }
#pragma unroll
            for (int r = 0; r < 5; ++r)
#pragma unroll
                for (int j = 0; j < 3; ++j) red[(kp * 5 + r) * 96 + cg * 3 + j] = acc[r][j];
            __syncthreads();
            for (int i = tid; i < 480; i += NTHREADS) {
                const int r = i / 96, cc = i % 96; float s = p.b_mod[l * 12288 + col0 + cc];
#pragma unroll
                for (int q = 0; q < 16; ++q) s += red[(q * 5 + r) * 96 + cc];
                ((float*)(ws + WS_MOD))[((size_t)l * 5 + r) * 12288 + col0 + cc] = s;
            }
            __syncthreads();
        }
        __syncthreads();
    }
    for (int l = 0; l < 2; ++l) {
        unsigned char* wl = ws + WS_WEIGHTS + (size_t)l * WL_END;
        cvt_matrix<256>(lds, p.w_in + (size_t)l * D * INW, D, INW, INWP, (bf16_t*)(wl + WL_WIN), nullptr, 0, nullptr, 0, INPROJ_FP8 ? F8_SW13 : 0.f);
        cvt_matrix<128>(lds, p.mla_w_uq + (size_t)l * 384 * 1152, 384, 1152, 1280, (bf16_t*)(wl + WL_WUQ), nullptr, 0, p.mla_g_q + l * 384, 512);
        for (int i = bid_here() * NTHREADS + tid; i < 1280 * 64; i += gridDim.x * NTHREADS) ((unsigned*)(wl + WL_WUQ))[(size_t)(i >> 6) * 256 + 192 + (i & 63)] = 0u;
        cvt_matrix<256>(lds, p.mla_w_ukv + (size_t)l * 512 * 1536, 512, 1536, 1536, (bf16_t*)(wl + WL_WUKV), nullptr, 0, p.mla_g_kv + l * 512);
        cvt_matrix<256>(lds, p.w_out + (size_t)l * D * D, D, D, D, (bf16_t*)(wl + WL_WOUT), nullptr, 0, nullptr, 0, OUTPROJ_FP8 ? F8_SW13 : 0.f);
        cvt_matrix<256>(lds, p.router_w + (size_t)l * D * 64, D, 64, 64, (bf16_t*)(wl + WL_WRH), (bf16_t*)(wl + WL_WRL), 0, nullptr);
    }
}

DI void router_group(PR p, int l, float* LG, int row0, bool dry, int stage = 0, int* count_out = nullptr, unsigned base_in = 0u);
DI u32x4 pack8(const f32x4& a, const f32x4& b) { u32x4 w; w.x = pk2(a[0], a[1]); w.y = pk2(a[2], a[3]); w.z = pk2(b[0], b[1]); w.w = pk2(b[2], b[3]); return w; }
#ifndef OASG_FP8_MASK
#define OASG_FP8_MASK 3
#endif
constexpr float OASG_SCALE = 128.f;
static_assert(!MOE_FP8 || OASG_SCALE * F8_INV2 == 1.f, "the routed fp8 epilogue stores the accumulators as they are");
static_assert(OASG_FP8_MASK == 3, "SchedMoe2::EPI_STORES counts the fp8 epilogue's stores (the bf16 one skips padding rows)");
DI void load_row(const float* src, f32x4 (&v)[4][2], int c0) {
#pragma unroll
    for (int i = 0; i < 4; ++i) { v[i][0] = *(const f32x4*)(src + i * 512 + c0); v[i][1] = *(const f32x4*)(src + i * 512 + c0 + 4); }
}
DI void unpack8(const u32x4 w, f32x4& a, f32x4& b) {
    a[0] = __uint_as_float(w.x << 16); a[1] = __uint_as_float(w.x & 0xFFFF0000u); a[2] = __uint_as_float(w.y << 16); a[3] = __uint_as_float(w.y & 0xFFFF0000u);
    b[0] = __uint_as_float(w.z << 16); b[1] = __uint_as_float(w.z & 0xFFFF0000u); b[2] = __uint_as_float(w.w << 16); b[3] = __uint_as_float(w.w & 0xFFFF0000u);
}
DI void load_row_bf(const bf16_t* src, f32x4 (&v)[4][2], int c0) {
#pragma unroll
    for (int i = 0; i < 4; ++i) unpack8(*(const u32x4*)(src + i * 512 + c0), v[i][0], v[i][1]);
}
DI void store_row_bf(bf16_t* dst, const f32x4 (&v)[4][2], int c0) {
#pragma unroll
    for (int i = 0; i < 4; ++i) { u32x4 w; w.x = pk2(v[i][0][0], v[i][0][1]); w.y = pk2(v[i][0][2], v[i][0][3]); w.z = pk2(v[i][1][0], v[i][1][1]); w.w = pk2(v[i][1][2], v[i][1][3]); *(u32x4*)(dst + i * 512 + c0) = w; }
}
DI float row_sumsq(const f32x4 (&v)[4][2]) {
    float s = 0.f;
#pragma unroll
    for (int i = 0; i < 4; ++i)
#pragma unroll
        for (int h = 0; h < 2; ++h) s += v[i][h][0] * v[i][h][0] + v[i][h][1] * v[i][h][1] + v[i][h][2] * v[i][h][2] + v[i][h][3] * v[i][h][3];
    return wave_sum(s);
}
DI void adaln_store(const f32x4 (&x)[4][2], const float* g, const float* shift, const float* scale, bf16_t* hi, bf16_t* lo, int c0, unsigned char* h8 = nullptr) {
    const float rstd = rsqrtf(row_sumsq(x) * (1.f / D) + EPS);
#pragma unroll
    for (int i = 0; i < 4; ++i) {
        f32x4 h[2];
#pragma unroll
        for (int q = 0; q < 2; ++q) { const int c = i * 512 + c0 + 4 * q;
            const f32x4 gg = *(const f32x4*)(g + c), sh = *(const f32x4*)(shift + c), sc = *(const f32x4*)(scale + c);
#pragma unroll
            for (int j = 0; j < 4; ++j) h[q][j] = x[i][q][j] * rstd * gg[j] * (1.f + sc[j]) + sh[j]; }
        u32x4 w; w.x = pk2(h[0][0], h[0][1]); w.y = pk2(h[0][2], h[0][3]); w.z = pk2(h[1][0], h[1][1]); w.w = pk2(h[1][2], h[1][3]);
        if (hi) *(u32x4*)(hi + i * 512 + c0) = w;
        if (h8) { u32x2 w8; w8.x = f8pack4(h[0][0] * F8_SH, h[0][1] * F8_SH, h[0][2] * F8_SH, h[0][3] * F8_SH); w8.y = f8pack4(h[1][0] * F8_SH, h[1][1] * F8_SH, h[1][2] * F8_SH, h[1][3] * F8_SH); *(u32x2*)(h8 + i * 512 + c0) = w8; }
        if (lo) { f32x4 a, b; unpack8(w, a, b); u32x4 w2; w2.x = pk2(h[0][0] - a[0], h[0][1] - a[1]); w2.y = pk2(h[0][2] - a[2], h[0][3] - a[3]); w2.z = pk2(h[1][0] - b[0], h[1][1] - b[1]); w2.w = pk2(h[1][2] - b[2], h[1][3] - b[3]);
            *(u32x4*)(lo + i * 512 + c0) = w2; }
    }
}
DI void residual_add(f32x4 (&x)[4][2], const f32x4 (&y)[4][2], const float* g, const float* gate, int c0) {
    const float rstd = rsqrtf(row_sumsq(y) * (1.f / D) + EPS);
#pragma unroll
    for (int i = 0; i < 4; ++i)
#pragma unroll
        for (int q = 0; q < 2; ++q) { const int c = i * 512 + c0 + 4 * q; const f32x4 gg = *(const f32x4*)(g + c), gt = *(const f32x4*)(gate + c);
#pragma unroll
            for (int j = 0; j < 4; ++j) x[i][q][j] += gt[j] * (y[i][q][j] * rstd * gg[j]); }
}
DI void load_xrow(PR p, int l, int r, f32x4 (&x)[4][2], int c0) {
    if (l == 0) load_row(r < NLAT ? p.x + (size_t)r * D : p.ctx + (size_t)(r - NLAT) * D, x, c0);
    else load_row_bf((const bf16_t*)(p.ws + WS_XRES) + (size_t)r * D, x, c0);
}
DI void phase_norm1(PR p, int l) {
    const int tid_ = tid_here(), lane = tid_ & 63, wid = tid_ >> 6;
    const float* mod = (const float*)(p.ws + WS_MOD) + (size_t)l * 5 * 12288;
    bf16_t* hb = (bf16_t*)(p.ws + WS_HBUF);
    const int stride = (int)gridDim.x * 8; int r = bid_here() * 8 + wid;
    f32x4 xn[4][2]; { int c0 = lane * 8; asm volatile("" : "+v"(c0)); if (r < NTOK) load_xrow(p, l, r, xn, c0); }
    for (; r < NTOK; r += stride) {
        const Tok t = tok_of(r);
        int c0 = lane * 8; asm volatile("" : "+v"(c0));
        f32x4 x[4][2];
#pragma unroll
        for (int i = 0; i < 4; ++i) { x[i][0] = xn[i][0]; x[i][1] = xn[i][1]; }
        if (r + stride < NTOK) load_xrow(p, l, r + stride, xn, c0);
        adaln_store(x, p.g_pre_mix + l * D, mod + (size_t)t.mrow * 12288 + 0 * D, mod + (size_t)t.mrow * 12288 + 1 * D, INPROJ_FP8 ? nullptr : hb + (size_t)r * D, nullptr, c0,
                    INPROJ_FP8 ? p.ws + WS_U + U_Y + (size_t)r * D : nullptr);
    }
}
DI void postmix_load(PR p, int l, int r, f32x4 (&x)[4][2], f32x4 (&y)[4][2], int c0) {
    load_xrow(p, l, r, x, c0); load_row_bf((const bf16_t*)(p.ws + WS_U + U_Y) + (size_t)r * D, y, c0);
}
DI void postmix_finish(PR p, int l, int r, f32x4 (&x)[4][2], const f32x4 (&y)[4][2], int c0) {
    const float* mod = (const float*)(p.ws + WS_MOD) + (size_t)l * 5 * 12288;
    bf16_t* XR = (bf16_t*)(p.ws + WS_XRES);
    bf16_t* hb = (bf16_t*)(p.ws + WS_HBUF); bf16_t* hl = (bf16_t*)(p.ws + WS_U + U_HLO);
    const Tok t = tok_of(r);
    residual_add(x, y, p.g_post_mix + l * D, mod + (size_t)t.mrow * 12288 + 2 * D, c0);
    store_row_bf(XR + (size_t)r * D, x, c0);
    adaln_store(x, p.g_pre_ffn + l * D, mod + (size_t)t.mrow * 12288 + 3 * D, mod + (size_t)t.mrow * 12288 + 4 * D, hb + (size_t)r * D, ROUTER_SPLIT ? hl + (size_t)r * D : nullptr, c0,
                MOE_FP8 ? (unsigned char*)hl + (size_t)r * D : nullptr);
}
DI void postmix_row(PR p, int l, int r, int lane) {
    int c0 = lane * 8; asm volatile("" : "+v"(c0));
    f32x4 x[4][2], y[4][2]; postmix_load(p, l, r, x, y, c0); postmix_finish(p, l, r, x, y, c0);
}
DI void phase_postmix(PR p, int l, char* lds, bool with_router) {
    const int tid_ = tid_here(), lane = tid_ & 63, wid = tid_ >> 6;
    const int nrows = l == 0 ? NTOK : NLAT, ngrp = nrows / 16;
    if (!with_router) {
        const int stride = (int)gridDim.x * 8; int r = bid_here() * 8 + wid;
        f32x4 xn[4][2], yn[4][2]; int c0 = lane * 8; asm volatile("" : "+v"(c0));
        if (r < nrows) postmix_load(p, l, r, xn, yn, c0);
        for (; r < nrows; r += stride) {
            f32x4 x[4][2], y[4][2];
#pragma unroll
            for (int i = 0; i < 4; ++i) { x[i][0] = xn[i][0]; x[i][1] = xn[i][1]; y[i][0] = yn[i][0]; y[i][1] = yn[i][1]; }
            asm volatile("" : "+v"(c0));
            if (r + stride < nrows) postmix_load(p, l, r + stride, xn, yn, c0);
            postmix_finish(p, l, r, x, y, c0);
        }
        return; }
    for (int g = wid * (int)gridDim.x + bid_here(); g < ngrp; g += 8 * (int)gridDim.x) {
#pragma unroll 1
        for (int i = 0; i < 16; ++i) postmix_row(p, l, g * 16 + i, lane);
        if (with_router) { asm volatile("s_waitcnt vmcnt(0)" ::: "memory"); router_group(p, l, (float*)lds + wid * (16 * 65 + 16 * 64), g * 16, false); }
    }
}
DI float row_sumsq16(const f32x4 (&v)[2][4]) {
    float s = 0.f;
#pragma unroll
    for (int i = 0; i < 2; ++i)
#pragma unroll
        for (int q = 0; q < 4; ++q) s += v[i][q][0] * v[i][q][0] + v[i][q][1] * v[i][q][1] + v[i][q][2] * v[i][q][2] + v[i][q][3] * v[i][q][3];
    return wave_sum(s);
}
DI void load_row_bf16(const bf16_t* src, f32x4 (&v)[2][4], int c0) {
#pragma unroll
    for (int i = 0; i < 2; ++i) { unpack8(*(const u32x4*)(src + i * 1024 + c0), v[i][0], v[i][1]); unpack8(*(const u32x4*)(src + i * 1024 + c0 + 8), v[i][2], v[i][3]); }
}
DI void store_row_bf16(bf16_t* dst, const f32x4 (&v)[2][4], int c0) {
#pragma unroll
    for (int i = 0; i < 2; ++i) { *(u32x4*)(dst + i * 1024 + c0) = pack8(v[i][0], v[i][1]); *(u32x4*)(dst + i * 1024 + c0 + 8) = pack8(v[i][2], v[i][3]); }
}
DI void phase_postffn(PR p, int l, char* lds) {
    const int tid_ = tid_here(), lane = tid_ & 63, wid = __builtin_amdgcn_readfirstlane(tid_ >> 6);
    const float* mod = (const float*)(p.ws + WS_MOD) + (size_t)l * 5 * 12288;
    const bf16_t* YS = (const bf16_t*)(p.ws + WS_U + U_YSH);
    const unsigned char* OA = p.ws + WS_U + U_OASG;
    bf16_t* XR = (bf16_t*)(p.ws + WS_XRES);
    bf16_t* hb = (bf16_t*)(p.ws + WS_HBUF);
    const int nrows = l == 0 ? NTOK : NLAT;
    const bool fp8 = (OASG_FP8_MASK >> l) & 1;
    const int* EPOS = (const int*)(p.ws + WS_EPOS); const float* EW = (const float*)(p.ws + WS_EW);
    LAS unsigned char* LB = (LAS unsigned char*)lds + wid * 16384;
    const int stride = (int)gridDim.x * 8;
#define PF_DMA(pe_) do { _Pragma("unroll 1") for (int kk = 0; kk < 8; ++kk) { const unsigned char* rowp_ = OA + (size_t)__builtin_amdgcn_readlane((pe_), kk) * D + lane * 16; \
        _Pragma("unroll") for (int i = 0; i < 2; ++i) __builtin_amdgcn_global_load_lds((const unsigned*)(rowp_ + i * 1024), (LAS unsigned*)(LB + kk * 2048 + i * 1024), 16, 0, 0); } } while (0)
#define PF_NEXT() do { if (fp8) { const int rn_ = r + stride; if (rn_ < nrows) PF_DMA(pe_n); we = we_n; \
        if (rn_ + stride < nrows) { pe_n = EPOS[(size_t)(rn_ + stride) * 8 + (lane & 7)]; we_n = EW[(size_t)(rn_ + stride) * 8 + (lane & 7)]; } } } while (0)
    int pe_n = 0; float we = 0.f, we_n = 0.f;
    { const int r0 = bid_here() * 8 + wid;
      if (fp8 && r0 < nrows) { const int pe0 = EPOS[(size_t)r0 * 8 + (lane & 7)]; we = EW[(size_t)r0 * 8 + (lane & 7)]; PF_DMA(pe0); }
      if (fp8 && r0 + stride < nrows) { pe_n = EPOS[(size_t)(r0 + stride) * 8 + (lane & 7)]; we_n = EW[(size_t)(r0 + stride) * 8 + (lane & 7)]; } }
    for (int r = bid_here() * 8 + wid; r < nrows; r += stride) {
        const Tok t = tok_of(r);
        int c0 = lane * 16; asm volatile("" : "+v"(c0));
        f32x4 x[2][4], y[2][4]; load_row_bf16(XR + (size_t)r * D, x, c0); load_row_bf16(YS + (size_t)r * D, y, c0);
        if (fp8) {
            const float wsc = we * (1.f / OASG_SCALE);
#pragma unroll 2
            for (int kk = 0; kk < 8; ++kk) { const float wk = __int_as_float(__builtin_amdgcn_readlane(__float_as_int(wsc), kk));
#pragma unroll
                for (int i = 0; i < 2; ++i) { const u32x4 w = *(const LAS u32x4*)(LB + kk * 2048 + i * 1024 + lane * 16);
#pragma unroll
                    for (int q = 0; q < 4; ++q) { const unsigned ww = q == 0 ? w.x : q == 1 ? w.y : q == 2 ? w.z : w.w;
                        const auto f0 = __builtin_amdgcn_cvt_pk_f32_fp8(ww, false), f1 = __builtin_amdgcn_cvt_pk_f32_fp8(ww, true);
                        y[i][q][0] += f0[0] * wk; y[i][q][1] += f0[1] * wk; y[i][q][2] += f1[0] * wk; y[i][q][3] += f1[1] * wk; } } }
            asm volatile("s_waitcnt lgkmcnt(0)" ::: "memory");
        } else {
#pragma unroll 2
            for (int k = 0; k < 8; ++k) {
                const bf16_t* o = (const bf16_t*)OA + ((size_t)r * 8 + k) * D;
#pragma unroll
                for (int i = 0; i < 2; ++i) { f32x4 a, b; unpack8(*(const u32x4*)(o + i * 1024 + c0), a, b); y[i][0] += a; y[i][1] += b; unpack8(*(const u32x4*)(o + i * 1024 + c0 + 8), a, b); y[i][2] += a; y[i][3] += b; }
            }
        }
        {
            const float rstd = rsqrtf(row_sumsq16(y) * (1.f / D) + EPS); const float* g = p.g_post_ffn + l * D; const float* gate = mod + (size_t)t.mrow * 12288 + 5 * D;
#pragma unroll
            for (int i = 0; i < 2; ++i)
#pragma unroll
                for (int q = 0; q < 4; ++q) { const int c = i * 1024 + c0 + 4 * q; const f32x4 gg = *(const f32x4*)(g + c), gt = *(const f32x4*)(gate + c);
#pragma unroll
                    for (int j = 0; j < 4; ++j) x[i][q][j] += gt[j] * (y[i][q][j] * rstd * gg[j]); }
        }
        if (l == 0) {
            store_row_bf16(XR + (size_t)r * D, x, c0);
            const float* mod1 = (const float*)(p.ws + WS_MOD) + (size_t)1 * 5 * 12288;
            const float* g = p.g_pre_mix + 1 * D; const float* shift = mod1 + (size_t)t.mrow * 12288 + 0 * D; const float* scale = mod1 + (size_t)t.mrow * 12288 + 1 * D;
            const float rstd = rsqrtf(row_sumsq16(x) * (1.f / D) + EPS);
            f32x4 h[2][4];
#pragma unroll
            for (int i = 0; i < 2; ++i)
#pragma unroll
                for (int q = 0; q < 4; ++q) { const int c = i * 1024 + c0 + 4 * q; const f32x4 gg = *(const f32x4*)(g + c), sh = *(const f32x4*)(shift + c), sc = *(const f32x4*)(scale + c);
#pragma unroll
                    for (int j = 0; j < 4; ++j) h[i][q][j] = x[i][q][j] * rstd * gg[j] * (1.f + sc[j]) + sh[j]; }
            PF_NEXT();
            if (!INPROJ_FP8) store_row_bf16(hb + (size_t)r * D, h, c0);
            if (INPROJ_FP8) { unsigned char* h8 = p.ws + WS_U + U_Y + (size_t)r * D;
#pragma unroll
                for (int i = 0; i < 2; ++i) { u32x4 w8;
                    w8.x = f8pack4(h[i][0][0] * F8_SH, h[i][0][1] * F8_SH, h[i][0][2] * F8_SH, h[i][0][3] * F8_SH); w8.y = f8pack4(h[i][1][0] * F8_SH, h[i][1][1] * F8_SH, h[i][1][2] * F8_SH, h[i][1][3] * F8_SH);
                    w8.z = f8pack4(h[i][2][0] * F8_SH, h[i][2][1] * F8_SH, h[i][2][2] * F8_SH, h[i][2][3] * F8_SH); w8.w = f8pack4(h[i][3][0] * F8_SH, h[i][3][1] * F8_SH, h[i][3][2] * F8_SH, h[i][3][3] * F8_SH);
                    *(u32x4*)(h8 + i * 1024 + c0) = w8; } }
        } else {
            PF_NEXT();
            float* dstrow = p.out + (size_t)r * D;
#pragma unroll
            for (int i = 0; i < 2; ++i)
#pragma unroll
                for (int q = 0; q < 4; ++q) *(f32x4*)(dstrow + i * 1024 + c0 + 4 * q) = x[i][q];
        }
    }
}

#undef PF_DMA
#undef PF_NEXT
struct GemmUnit {
    const bf16_t* A; long lda; const int* rows; int rowshift;
    const bf16_t* Bt; long ldb;
    int K;
};
constexpr int GS_LD = 72;
struct LaneId { int wr, wc, fr, fq; };
DI LaneId gemm_kloop_simple(char* lds, const GemmUnit& g, f32x4 (&acc)[2][2][4][2]) {
    int tid = threadIdx.x; asm volatile("" : "+v"(tid));
    const int wid = tid >> 6, lane = tid & 63, wr = wid >> 2, wc = wid & 3, fr = lane & 15, fq = lane >> 4;
    bf16_t* As = (bf16_t*)lds; bf16_t* Bs = As + 256 * GS_LD;
#pragma unroll
    for (int a = 0; a < 2; ++a)
#pragma unroll
        for (int b = 0; b < 2; ++b)
#pragma unroll
            for (int m = 0; m < 4; ++m)
#pragma unroll
                for (int n = 0; n < 2; ++n) acc[a][b][m][n] = (f32x4){0.f, 0.f, 0.f, 0.f};
    const int srow = tid >> 3, skc = (tid & 7) * 8;
    const bf16_t* ap[4]; const bf16_t* bp[4];
#pragma unroll
    for (int i = 0; i < 4; ++i) {
        const int r = srow + 64 * i;
        if (g.rows) { const int idx = g.rows[r]; ap[i] = g.A + (size_t)(idx >= 0 ? (idx >> g.rowshift) : 0) * g.lda + skc; }
        else ap[i] = g.A + (size_t)r * g.lda + skc;
        bp[i] = g.Bt + (size_t)r * g.ldb + skc;
    }
    const int nkt = g.K / 64;
    u32x4 ra[4], rb[4];
#pragma unroll
    for (int i = 0; i < 4; ++i) { ra[i] = *(const u32x4*)(ap[i]); rb[i] = *(const u32x4*)(bp[i]); }
    for (int kt = 0; kt < nkt; ++kt) {
        __syncthreads();
#pragma unroll
        for (int i = 0; i < 4; ++i) { *(u32x4*)(As + (srow + 64 * i) * GS_LD + skc) = ra[i]; *(u32x4*)(Bs + (srow + 64 * i) * GS_LD + skc) = rb[i]; }
        __syncthreads();
        if (kt + 1 < nkt) {
#pragma unroll
            for (int i = 0; i < 4; ++i) { ra[i] = *(const u32x4*)(ap[i] + (kt + 1) * 64); rb[i] = *(const u32x4*)(bp[i] + (kt + 1) * 64); }
        }
#pragma unroll
        for (int kk = 0; kk < 2; ++kk) {
            bf16x8 bf[2][2];
#pragma unroll
            for (int bj = 0; bj < 2; ++bj)
#pragma unroll
                for (int n = 0; n < 2; ++n) bf[bj][n] = *(const bf16x8*)(Bs + (128 * bj + 32 * wc + 16 * n + fr) * GS_LD + kk * 32 + fq * 8);
#pragma unroll
            for (int ai = 0; ai < 2; ++ai)
#pragma unroll
                for (int m = 0; m < 4; ++m) {
                    const bf16x8 af = *(const bf16x8*)(As + (128 * ai + 64 * wr + 16 * m + fr) * GS_LD + kk * 32 + fq * 8);
#pragma unroll
                    for (int bj = 0; bj < 2; ++bj)
#pragma unroll
                        for (int n = 0; n < 2; ++n) acc[ai][bj][m][n] = __builtin_amdgcn_mfma_f32_16x16x32_bf16(bf[bj][n], af, acc[ai][bj][m][n], 0, 0, 0);
                }
        }
    }
    __syncthreads();
    LaneId id; id.wr = wr; id.wc = wc; id.fr = fr; id.fq = fq; return id;
}
#define GEMM_ACC f32x4 acc[2][2][4][2]
#define ACC_FOREACH(...) \
    _Pragma("unroll") for (int ai = 0; ai < 2; ++ai) _Pragma("unroll") for (int m = 0; m < 4; ++m) { const int trow = 128 * ai + 64 * wr + 16 * m + fr; \
    _Pragma("unroll") for (int bj = 0; bj < 2; ++bj) _Pragma("unroll") for (int n = 0; n < 2; ++n) { const int tcol = 128 * bj + 32 * wc + 16 * n + 4 * fq; const f32x4 v = acc[ai][bj][m][n]; __VA_ARGS__ } }

struct EpiProj {
    bf16_t* O; int row0, col0;
    DI void operator()(const f32x4 (&acc)[2][2][4][2], int wr, int wc, int fr, int fq) const {
        ACC_FOREACH({ u32x2 w; w.x = pk2(v[0], v[1]); w.y = pk2(v[2], v[3]); *(u32x2*)(O + (size_t)(row0 + trow) * INWP + col0 + tcol) = w; })
    }
};
struct EpiB16 {
    bf16_t* O; int row0, col0, ld;
    DI void operator()(const f32x4 (&acc)[2][2][4][2], int wr, int wc, int fr, int fq) const {
        ACC_FOREACH({ u32x2 w; w.x = pk2(v[0], v[1]); w.y = pk2(v[2], v[3]); *(u32x2*)(O + (size_t)(row0 + trow) * ld + col0 + tcol) = w; })
    }
};
struct EpiF32 {
    float* O; int row0, col0, ld;
    DI void operator()(const f32x4 (&acc)[2][2][4][2], int wr, int wc, int fr, int fq) const {
        ACC_FOREACH({ *(f32x4*)(O + (size_t)(row0 + trow) * ld + col0 + tcol) = v; })
    }
};
struct EpiUq {
    bf16_t* Q; const float2* ropem; int row0, col0;
    DI void operator()(const f32x4 (&acc)[2][2][4][2], int wr, int wc, int fr, int fq) const {
#pragma unroll
        for (int bj = 0; bj < 2; ++bj) {
            const int cbase = col0 + 128 * bj + 32 * wc;
            if (cbase >= 1152) continue;
            const int h = cbase / 192, jb = cbase % 192;
            float2 cs[2][4][4]; Tok tk[2][4];
#pragma unroll
            for (int ai = 0; ai < 2; ++ai)
#pragma unroll
                for (int m = 0; m < 4; ++m) { tk[ai][m] = tok_of(row0 + 128 * ai + 64 * wr + 16 * m + fr); const Tok t = tk[ai][m];
                    const int pos = (jb == 128) ? (t.s >> 6) : (t.s & 63); const bool rot = jb >= 128 && !t.isctx;
#pragma unroll
                    for (int i = 0; i < 4; ++i) cs[ai][m][i] = rot ? ropem[pos * 16 + 4 * fq + i] : make_float2(1.f, 0.f); }
#pragma unroll
            for (int ai = 0; ai < 2; ++ai)
#pragma unroll
                for (int m = 0; m < 4; ++m) { const Tok t = tk[ai][m];
                    f32x4 v0 = acc[ai][bj][m][0], v1 = acc[ai][bj][m][1];
#pragma unroll
                    for (int i = 0; i < 4; ++i) { const float2 c = cs[ai][m][i]; const float x1 = v0[i], x2 = v1[i]; v0[i] = x1 * c.x - x2 * c.y; v1[i] = x2 * c.x + x1 * c.y; }
                    bf16_t* dst = Q + (((size_t)t.b * 6 + h) * SKV + t.kvpos) * 192 + jb + 4 * fq;
                    u32x2 w0; w0.x = pk2(v0[0], v0[1]); w0.y = pk2(v0[2], v0[3]); *(u32x2*)(dst) = w0;
                    u32x2 w1; w1.x = pk2(v1[0], v1[1]); w1.y = pk2(v1[2], v1[3]); *(u32x2*)(dst + 16) = w1; }
        }
    }
};
struct EpiUkv {
    bf16_t* Km; bf16_t* Vm; int row0, col0;
    DI void operator()(const f32x4 (&acc)[2][2][4][2], int wr, int wc, int fr, int fq) const {
        ACC_FOREACH({ const int r = row0 + trow; const Tok t = tok_of(r); const int c = col0 + tcol, h = c >> 8, j = c & 255;
            u32x2 w; w.x = pk2(v[0], v[1]); w.y = pk2(v[2], v[3]);
            if (j < 128) *(u32x2*)(Km + (((size_t)t.b * 6 + h) * SKV + t.kvpos) * 192 + j) = w;
            else *(u32x2*)(Vm + (((size_t)t.b * 6 + h) * SKV + t.kvpos) * 128 + (j - 128)) = w; })
    }
};
struct EpiMoe1 {
    bf16_t* act; int arow0, hcol0;
    DI void operator()(const f32x4 (&acc)[2][2][4][2], int wr, int wc, int fr, int fq) const {
#pragma unroll
        for (int ai = 0; ai < 2; ++ai)
#pragma unroll
            for (int m = 0; m < 4; ++m) {
                const int trow = 128 * ai + 64 * wr + 16 * m + fr;
#pragma unroll
                for (int n = 0; n < 2; ++n) {
                    const f32x4 a = acc[ai][0][m][n], b = acc[ai][1][m][n]; f32x4 h;
#pragma unroll
                    for (int i = 0; i < 4; ++i) h[i] = silu_f(a[i]) * b[i];
                    u32x2 w; w.x = pk2(h[0], h[1]); w.y = pk2(h[2], h[3]);
                    *(u32x2*)(act + (size_t)(arow0 + trow) * 512 + hcol0 + 32 * wc + 16 * n + 4 * fq) = w;
                }
            }
    }
};
struct EpiMoe2 {
    bf16_t* oasg; const int* sasg; const float* sw; int srow0, col0;
    DI void operator()(const f32x4 (&acc)[2][2][4][2], int wr, int wc, int fr, int fq) const {
        int a[2][4]; float wgt[2][4];
#pragma unroll
        for (int ai = 0; ai < 2; ++ai)
#pragma unroll
            for (int m = 0; m < 4; ++m) { const int trow = 128 * ai + 64 * wr + 16 * m + fr; a[ai][m] = sasg[srow0 + trow]; wgt[ai][m] = sw[srow0 + trow]; }
#pragma unroll
        for (int ai = 0; ai < 2; ++ai)
#pragma unroll
            for (int m = 0; m < 4; ++m) {
                if (a[ai][m] < 0) continue;
#pragma unroll
                for (int bj = 0; bj < 2; ++bj)
#pragma unroll
                    for (int n = 0; n < 2; ++n) { const f32x4 v = acc[ai][bj][m][n] * wgt[ai][m]; u32x2 w; w.x = pk2(v[0], v[1]); w.y = pk2(v[2], v[3]);
                        *(u32x2*)(oasg + (size_t)a[ai][m] * D + col0 + 128 * bj + 32 * wc + 16 * n + 4 * fq) = w; }
            }
    }
};
struct EpiB16P {
    bf16_t* O; int row0, col0, ld; float mul;
    DI void operator()(const f32x4 (&acc)[2][2][4][2], int wr, int wc, int fr, int fq) const {
#pragma unroll
        for (int ai = 0; ai < 2; ++ai)
#pragma unroll
            for (int m = 0; m < 4; ++m) { bf16_t* rowp = O + (size_t)(row0 + 128 * ai + 64 * wr + 16 * m + fr) * ld + col0 + 32 * wc + 8 * fq;
#pragma unroll
                for (int bj = 0; bj < 2; ++bj) *(u32x4*)(rowp + 128 * bj) = pack8(acc[ai][bj][m][0] * mul, acc[ai][bj][m][1] * mul); }
    }
};
struct EpiMoe1P {
    bf16_t* act; int arow0, hcol0;
    DI void operator()(const f32x4 (&acc)[2][2][4][2], int wr, int wc, int fr, int fq) const {
#pragma unroll
        for (int ai = 0; ai < 2; ++ai)
#pragma unroll
            for (int m = 0; m < 4; ++m) {
                f32x4 h0, h1;
#pragma unroll
                for (int i = 0; i < 4; ++i) { h0[i] = silu_f(acc[ai][0][m][0][i]) * acc[ai][1][m][0][i]; h1[i] = silu_f(acc[ai][0][m][1][i]) * acc[ai][1][m][1][i]; }
                *(u32x4*)(act + (size_t)(arow0 + 128 * ai + 64 * wr + 16 * m + fr) * 512 + hcol0 + 32 * wc + 8 * fq) = pack8(h0, h1);
            }
    }
};
DI float swiglu_scaled(float a0, float a1) {
    constexpr float C2 = F8_INV1 * F8_INV1 * F8_SACT, K1 = -F8_INV1 * 1.4426950408889634f, K0 = 21.f;
    static_assert(C2 == 1.f / 2097152.f, "K0 = -log2(C2)");
    const float t = __builtin_amdgcn_exp2f(__builtin_fmaf(a0, K1, K0));
    return (a0 * a1) * __builtin_amdgcn_rcpf((1.f / C2) + t);
}
struct EpiMoe1F8 {
    unsigned char* act; int arow0, hcol0;
    DI void operator()(const f32x4 (&acc)[2][2][4][2], int wr, int wc, int fr, int fq) const {
#pragma unroll
        for (int ai = 0; ai < 2; ++ai)
#pragma unroll
            for (int m = 0; m < 4; ++m) {
                f32x4 h0, h1;
#pragma unroll
                for (int i = 0; i < 4; ++i) { h0[i] = swiglu_scaled(acc[ai][0][m][0][i], acc[ai][1][m][0][i]); h1[i] = swiglu_scaled(acc[ai][0][m][1][i], acc[ai][1][m][1][i]); }
                u32x2 w; w.x = f8pack4(h0[0], h0[1], h0[2], h0[3]); w.y = f8pack4(h1[0], h1[1], h1[2], h1[3]);
                *(u32x2*)(act + (size_t)(arow0 + 128 * ai + 64 * wr + 16 * m + fr) * 512 + hcol0 + 32 * wc + 8 * fq) = w;
            }
    }
};
struct EpiMoe2P {
    bf16_t* oasg; const int* sasg; const float* sw; int srow0, col0;
    DI void operator()(const f32x4 (&acc)[2][2][4][2], int wr, int wc, int fr, int fq) const {
        int a[2][4]; float wgt[2][4];
#pragma unroll
        for (int ai = 0; ai < 2; ++ai)
#pragma unroll
            for (int m = 0; m < 4; ++m) { const int trow = 128 * ai + 64 * wr + 16 * m + fr; a[ai][m] = sasg[srow0 + trow]; wgt[ai][m] = sw[srow0 + trow]; }
#pragma unroll
        for (int ai = 0; ai < 2; ++ai)
#pragma unroll
            for (int m = 0; m < 4; ++m) {
                if (a[ai][m] < 0) continue;
                bf16_t* rowp = oasg + (size_t)a[ai][m] * D + col0 + 32 * wc + 8 * fq;
#pragma unroll
                for (int bj = 0; bj < 2; ++bj) *(u32x4*)(rowp + 128 * bj) = pack8(acc[ai][bj][m][0] * wgt[ai][m], acc[ai][bj][m][1] * wgt[ai][m]);
            }
    }
};
struct EpiMoe2F8 {
    unsigned char* oasg; const int* sasg; const float* sw; int srow0, col0;
    DI void operator()(const f32x4 (&acc)[2][2][4][2], int wr, int wc, int fr, int fq) const {
        int a[2][4]; float wgt[2][4];
#pragma unroll
        for (int ai = 0; ai < 2; ++ai)
#pragma unroll
            for (int m = 0; m < 4; ++m) { const int trow = 128 * ai + 64 * wr + 16 * m + fr; a[ai][m] = sasg[srow0 + trow]; wgt[ai][m] = sw[srow0 + trow] * OASG_SCALE; }
#pragma unroll
        for (int ai = 0; ai < 2; ++ai)
#pragma unroll
            for (int m = 0; m < 4; ++m) {
                if (a[ai][m] < 0) continue;
                unsigned char* rowp = oasg + (size_t)a[ai][m] * D + col0 + 32 * wc + 8 * fq;
#pragma unroll
                for (int bj = 0; bj < 2; ++bj) { f32x4 v0 = acc[ai][bj][m][0] * wgt[ai][m], v1 = acc[ai][bj][m][1] * wgt[ai][m]; u32x2 w;
#pragma unroll
                    for (int i = 0; i < 4; ++i) { v0[i] = __builtin_amdgcn_fmed3f(v0[i], -440.f, 440.f); v1[i] = __builtin_amdgcn_fmed3f(v1[i], -440.f, 440.f); }
                    int t0 = __builtin_amdgcn_cvt_pk_fp8_f32(v0[0], v0[1], 0, false); t0 = __builtin_amdgcn_cvt_pk_fp8_f32(v0[2], v0[3], t0, true);
                    int t1 = __builtin_amdgcn_cvt_pk_fp8_f32(v1[0], v1[1], 0, false); t1 = __builtin_amdgcn_cvt_pk_fp8_f32(v1[2], v1[3], t1, true);
                    w.x = (unsigned)t0; w.y = (unsigned)t1; *(u32x2*)(rowp + 128 * bj) = w; }
            }
    }
};
struct EpiMoe2F8W {
    unsigned char* oasg; int srow0, col0;
    DI void operator()(const f32x4 (&acc)[2][2][4][2], int wr, int wc, int fr, int fq) const {
        constexpr float mul = OASG_SCALE * (MOE_FP8 ? F8_INV2 : 1.f);
#pragma unroll
        for (int ai = 0; ai < 2; ++ai)
#pragma unroll
            for (int m = 0; m < 4; ++m) {
                u32x4 w;
                w.x = f8pack4(acc[ai][0][m][0][0] * mul, acc[ai][0][m][0][1] * mul, acc[ai][0][m][0][2] * mul, acc[ai][0][m][0][3] * mul);
                w.y = f8pack4(acc[ai][0][m][1][0] * mul, acc[ai][0][m][1][1] * mul, acc[ai][0][m][1][2] * mul, acc[ai][0][m][1][3] * mul);
                w.z = f8pack4(acc[ai][1][m][0][0] * mul, acc[ai][1][m][0][1] * mul, acc[ai][1][m][0][2] * mul, acc[ai][1][m][0][3] * mul);
                w.w = f8pack4(acc[ai][1][m][1][0] * mul, acc[ai][1][m][1][1] * mul, acc[ai][1][m][1][2] * mul, acc[ai][1][m][1][3] * mul);
                *(u32x4*)(oasg + (size_t)(srow0 + 128 * ai + 64 * wr + 16 * m + fr) * D + col0 + 64 * wc + 16 * fq) = w;
            }
    }
};
struct EpiB16W {
    bf16_t* O; int row0, col0, ld;
    DI void operator()(const f32x4 (&acc)[2][2][4][2], int wr, int wc, int fr, int fq) const {
        constexpr float mul = MOE_FP8 ? F8_INV2 : 1.f;
#pragma unroll
        for (int ai = 0; ai < 2; ++ai)
#pragma unroll
            for (int m = 0; m < 4; ++m) { bf16_t* rowp = O + (size_t)(row0 + 128 * ai + 64 * wr + 16 * m + fr) * ld + col0 + 64 * wc + 16 * fq;
                *(u32x4*)(rowp) = pack8(acc[ai][0][m][0] * mul, acc[ai][0][m][1] * mul); *(u32x4*)(rowp + 8) = pack8(acc[ai][1][m][0] * mul, acc[ai][1][m][1] * mul); }
    }
};
struct EpiMoe2W {
    bf16_t* oasg; const int* sasg; const float* sw; int srow0, col0;
    DI void operator()(const f32x4 (&acc)[2][2][4][2], int wr, int wc, int fr, int fq) const {
        int a[2][4]; float wgt[2][4];
#pragma unroll
        for (int ai = 0; ai < 2; ++ai)
#pragma unroll
            for (int m = 0; m < 4; ++m) { const int trow = 128 * ai + 64 * wr + 16 * m + fr; a[ai][m] = sasg[srow0 + trow]; wgt[ai][m] = (a[ai][m] >= 0 ? sw[a[ai][m]] : 0.f) * (MOE_FP8 ? F8_INV2 : 1.f); }
#pragma unroll
        for (int ai = 0; ai < 2; ++ai)
#pragma unroll
            for (int m = 0; m < 4; ++m) {
                if (a[ai][m] < 0) continue;
                bf16_t* rowp = oasg + (size_t)a[ai][m] * D + col0 + 64 * wc + 16 * fq;
                *(u32x4*)(rowp) = pack8(acc[ai][0][m][0] * wgt[ai][m], acc[ai][0][m][1] * wgt[ai][m]); *(u32x4*)(rowp + 8) = pack8(acc[ai][1][m][0] * wgt[ai][m], acc[ai][1][m][1] * wgt[ai][m]);
            }
    }
};
DI void phase_postproj_rows(PR p, int l) {
    const int tid_ = tid_here(), lane = tid_ & 63, wid = tid_ >> 6;
    unsigned char* U = p.ws + WS_U;
    const bf16_t* PR_ = (const bf16_t*)(U + U_PROJ);
    bf16_t* CQN = (bf16_t*)(U + U_CQN); bf16_t* CKVN = (bf16_t*)(U + U_CKVN);
    bf16_t* Km = (bf16_t*)(U + U_KM); bf16_t* Qg = (bf16_t*)(U + U_QG); bf16_t* Kg = (bf16_t*)(U + U_KG); bf16_t* Vg = (bf16_t*)(U + U_VG);
    const float2* ropeg = (const float2*)(p.ws + WS_ROPEG); const float2* ropem = (const float2*)(p.ws + WS_ROPEM);
    const float gq0 = p.gqa_g_q[l * 128 + 2 * lane], gq1 = p.gqa_g_q[l * 128 + 2 * lane + 1], gk0 = p.gqa_g_k[l * 128 + 2 * lane], gk1 = p.gqa_g_k[l * 128 + 2 * lane + 1];
    struct RowRaw { unsigned cq0, cq1, cq2; u32x4 ckv; bf16_t kr; unsigned qk[8]; u32x2 v; };
#define ROW_LOAD(R, row) do { const bf16_t* pr_ = PR_ + (size_t)(row) * INWP; const unsigned* s_ = (const unsigned*)(pr_ + C_CQ + 6 * lane); R.cq0 = s_[0]; R.cq1 = s_[1]; R.cq2 = s_[2]; \
        R.ckv = *(const u32x4*)(pr_ + C_CKV + 8 * lane); R.kr = pr_[C_KR + lane]; \
        _Pragma("unroll") for (int hh_ = 0; hh_ < 8; ++hh_) R.qk[hh_] = *(const unsigned*)(pr_ + (hh_ < 6 ? C_AQ + hh_ * 128 : C_AK + (hh_ - 6) * 128) + 2 * lane); \
        R.v = *(const u32x2*)(pr_ + C_AV + 4 * lane); } while (0)
    const int stride_ = (int)gridDim.x * 8; int r = bid_here() * 8 + wid;
    RowRaw nx; if (r < NTOK) ROW_LOAD(nx, r);
    for (; r < NTOK; r += stride_) {
        const Tok t = tok_of(r);
        const RowRaw cu = nx;
        if (r + stride_ < NTOK) ROW_LOAD(nx, r + stride_);
        {
            const unsigned w0 = cu.cq0, w1 = cu.cq1, w2 = cu.cq2;
            float v[6] = {__uint_as_float(w0 << 16), __uint_as_float(w0 & 0xFFFF0000u), __uint_as_float(w1 << 16), __uint_as_float(w1 & 0xFFFF0000u), __uint_as_float(w2 << 16), __uint_as_float(w2 & 0xFFFF0000u)};
            float ss = 0.f;
#pragma unroll
            for (int i = 0; i < 6; ++i) ss += v[i] * v[i];
            const float rstd = rsqrtf(wave_sum(ss) * (1.f / 384.f) + EPS);
            unsigned* dst = (unsigned*)(CQN + (size_t)r * 512 + 6 * lane); dst[0] = pk2(v[0] * rstd, v[1] * rstd); dst[1] = pk2(v[2] * rstd, v[3] * rstd); dst[2] = pk2(v[4] * rstd, v[5] * rstd);
            *(unsigned*)(CQN + (size_t)r * 512 + 384 + 2 * lane) = 0u;
        }
        {
            f32x4 a, b; unpack8(cu.ckv, a, b);
            const float ss = a[0] * a[0] + a[1] * a[1] + a[2] * a[2] + a[3] * a[3] + b[0] * b[0] + b[1] * b[1] + b[2] * b[2] + b[3] * b[3];
            const float rstd = rsqrtf(wave_sum(ss) * (1.f / 512.f) + EPS);
            u32x4 w; w.x = pk2(a[0] * rstd, a[1] * rstd); w.y = pk2(a[2] * rstd, a[3] * rstd); w.z = pk2(b[0] * rstd, b[1] * rstd); w.w = pk2(b[2] * rstd, b[3] * rstd);
            *(u32x4*)(CKVN + (size_t)r * 512 + 8 * lane) = w;
        }
        {
            float x = bf2f(cu.kr);
            const float other = shx(x, 16, lane);
            if (!t.isctx) {
                const int g = lane >> 5, idx = lane & 31, fi = idx & 15; const bool second = idx >= 16;
                const int pos = g == 0 ? (t.s >> 6) : (t.s & 63);
                const float2 cs = ropem[pos * 16 + fi];
                x = second ? x * cs.x + other * cs.y : x * cs.x - other * cs.y;
            }
            const bf16_t xb = f2bf(x);
#pragma unroll
            for (int h = 0; h < 6; ++h) Km[(((size_t)t.b * 6 + h) * SKV + t.kvpos) * 192 + 128 + lane] = xb;
        }
        const int f0 = (2 * lane) & 31; const bool second = (lane & 16) != 0;
        float2 csa = make_float2(1.f, 0.f), csb = make_float2(1.f, 0.f);
        if (!t.isctx) { const int pos = lane < 32 ? (t.s >> 6) : (t.s & 63); csa = ropeg[pos * 32 + f0]; csb = ropeg[pos * 32 + f0 + 1]; }
#pragma unroll
        for (int hh = 0; hh < 8; ++hh) {
            const bool isq = hh < 6; const int h = isq ? hh : hh - 6;
            const unsigned wv = cu.qk[hh];
            float e0 = __uint_as_float(wv << 16), e1 = __uint_as_float(wv & 0xFFFF0000u);
            const float rstd = rsqrtf(wave_sum(e0 * e0 + e1 * e1) * (1.f / 128.f) + EPS);
            e0 = e0 * rstd * (isq ? gq0 : gk0); e1 = e1 * rstd * (isq ? gq1 : gk1);
            const float o0 = shx(e0, 16, lane), o1 = shx(e1, 16, lane);
            const float r0 = second ? e0 * csa.x + o0 * csa.y : e0 * csa.x - o0 * csa.y;
            const float r1 = second ? e1 * csb.x + o1 * csb.y : e1 * csb.x - o1 * csb.y;
            bf16_t* dst = isq ? Qg + (((size_t)t.b * 6 + h) * SKV + t.kvpos) * 128 : Kg + (((size_t)t.b * 2 + h) * SKV + t.kvpos) * 128;
            *(unsigned*)(dst + 2 * lane) = pk2(r0, r1);
        }
        *(u32x2*)(Vg + (((size_t)t.b * 2 + (lane >> 5)) * SKV + t.kvpos) * 128 + 4 * (lane & 31)) = cu.v;
    }
#undef ROW_LOAD
}

#define SBAR() __builtin_amdgcn_sched_barrier(0)
DI int crow(int r, int hi) { return (r & 3) + 8 * (r >> 2) + 4 * hi; }
DI unsigned cvtpk(float lo, float hi) { unsigned r; asm volatile("v_cvt_pk_bf16_f32 %0, %1, %2" : "=v"(r) : "v"(lo), "v"(hi)); return r; }
constexpr float ATT_THR = 8.f;
template <int DQK> struct AttnCfg {
    static constexpr int KROWB = DQK * 2;
    static constexpr int SHM_V = 64 * 128 * 2, SHM_K = 64 * DQK * 2;
    static constexpr int ND0 = DQK / 16;
    static constexpr int NKCH = DQK / 64;
    static constexpr int NQR = DQK == 128 ? 8 : ATT_NQR_M;
    static constexpr int SHM_Q = 8 * (ND0 - NQR) * 1024;
    static constexpr int SHM_TOTAL = 2 * SHM_V + 2 * SHM_K + 8 * 64 * 4 + SHM_Q;
};
template <int DQK> DI int kswz(int row, int colB) { return row * (DQK * 2) + (colB ^ ((row & 7) << 4)); }
DI void partialSM(f32x16& p0, f32x16& p1, float& m_reg, float& mn, float& alpha, const float SCALE) {
    const float C = SCALE * 1.4426950408889634f;
    float pmax = p0[0];
#pragma unroll
    for (int r = 1; r < 16; ++r) pmax = fmaxf(pmax, p0[r]);
#pragma unroll
    for (int r = 0; r < 16; ++r) pmax = fmaxf(pmax, p1[r]);
    { auto rr = __builtin_amdgcn_permlane32_swap(__float_as_uint(pmax), __float_as_uint(pmax), false, false);
      pmax = fmaxf(__uint_as_float(rr[0]), __uint_as_float(rr[1])); }
    if (__builtin_expect(__all(pmax - m_reg <= ATT_THR / SCALE), 1)) { mn = m_reg; alpha = 1.f; }
    else { mn = fmaxf(m_reg, pmax); alpha = __builtin_amdgcn_exp2f((m_reg - mn) * C); m_reg = mn; }
    const float mnC = -mn * C;
#pragma unroll
    for (int r = 0; r < 16; ++r) p0[r] = fmaf(p0[r], C, mnC);
#pragma unroll
    for (int r = 0; r < 16; ++r) p1[r] = fmaf(p1[r], C, mnC);
#pragma unroll
    for (int r = 0; r < 16; ++r) p0[r] = __builtin_amdgcn_exp2f(p0[r]);
}
DI void finishSM(f32x16& p0, f32x16& p1, float alpha, float& l_reg, bf16x8& pa0, bf16x8& pa1, bf16x8& pa2, bf16x8& pa3) {
#pragma unroll
    for (int r = 0; r < 16; ++r) p1[r] = __builtin_amdgcn_exp2f(p1[r]);
    float ps = 0;
#pragma unroll
    for (int r = 0; r < 16; ++r) ps += p0[r];
#pragma unroll
    for (int r = 0; r < 16; ++r) ps += p1[r];
    { auto rr = __builtin_amdgcn_permlane32_swap(__float_as_uint(ps), __float_as_uint(ps), false, false);
      ps = __uint_as_float(rr[0]) + __uint_as_float(rr[1]); }
    l_reg = l_reg * alpha + ps;
#define PK4(P, BASE, OUT) do { unsigned a0 = cvtpk(P[BASE + 0], P[BASE + 1]), a1 = cvtpk(P[BASE + 2], P[BASE + 3]);   \
    unsigned b0 = cvtpk(P[BASE + 4], P[BASE + 5]), b1 = cvtpk(P[BASE + 6], P[BASE + 7]);                              \
    auto r0 = __builtin_amdgcn_permlane32_swap(a0, b0, false, false); auto r1 = __builtin_amdgcn_permlane32_swap(a1, b1, false, false); \
    u32x4 w = {r0[0], r1[0], r0[1], r1[1]}; OUT = *reinterpret_cast<bf16x8*>(&w); } while (0)
    PK4(p0, 0, pa0); PK4(p0, 8, pa1); PK4(p1, 0, pa2); PK4(p1, 8, pa3);
#undef PK4
}
DI void partialSM2(f32x16& p0, f32x16& p1, float& M, const float Mused, float& alpha) {
    float pmax = p0[0];
#pragma unroll
    for (int r = 1; r < 16; ++r) pmax = fmaxf(pmax, p0[r]);
#pragma unroll
    for (int r = 0; r < 16; ++r) pmax = fmaxf(pmax, p1[r]);
    { auto rr = __builtin_amdgcn_permlane32_swap(__float_as_uint(pmax), __float_as_uint(pmax), false, false);
      pmax = fmaxf(__uint_as_float(rr[0]), __uint_as_float(rr[1])); }
    if (__builtin_expect(__all((pmax + Mused) - M <= ATT_THR * 1.4426950408889634f), 1)) { alpha = 1.f; }
    else { const float Mn = fmaxf(M, pmax + Mused), sh = Mused - Mn; alpha = __builtin_amdgcn_exp2f(M - Mn); M = Mn;
#pragma unroll
        for (int r = 0; r < 16; ++r) { p0[r] += sh; p1[r] += sh; } }
#pragma unroll
    for (int r = 0; r < 16; ++r) p0[r] = __builtin_amdgcn_exp2f(p0[r]);
}
template <int DQK>
DI void qkt2(f32x16& p0, f32x16& p1, const int (&kb)[4], int bufoff, const bf16x8* qr, const float init) {
#pragma unroll
    for (int r = 0; r < 16; ++r) { p0[r] = init; p1[r] = init; }
#pragma unroll
    for (int d0 = 0; d0 < DQK / 16; ++d0) {
        const LAS char* ka = (const LAS char*)(kb[d0 & 3]) + bufoff + 128 * (d0 >> 2);
        const bf16x8 b0 = *(const LAS bf16x8*)(ka);
        const bf16x8 b1 = *(const LAS bf16x8*)(ka + 32 * DQK * 2);
        p0 = __builtin_amdgcn_mfma_f32_32x32x16_bf16(b0, qr[d0], p0, 0, 0, 0);
        p1 = __builtin_amdgcn_mfma_f32_32x32x16_bf16(b1, qr[d0], p1, 0, 0, 0); }
}
template <int DQK, int NQR>
DI void qkt(f32x16& p0, f32x16& p1, const int (&kb)[4], int bufoff, const bf16x8* qr, int qs_addr, int r32, int hi) {
    asm volatile("" : "+v"(qs_addr));
    const LAS char* Qs = (const LAS char*)qs_addr;
#pragma unroll
    for (int r = 0; r < 16; ++r) { p0[r] = 0.f; p1[r] = 0.f; }
#pragma unroll
    for (int d0 = 0; d0 < DQK / 16; ++d0) {
        const LAS char* ka = (const LAS char*)(kb[d0 & 3]) + bufoff + 128 * (d0 >> 2);
        const bf16x8 b0 = *(const LAS bf16x8*)(ka);
        const bf16x8 b1 = *(const LAS bf16x8*)(ka + 32 * DQK * 2);
        bf16x8 q;
        if (d0 < NQR) q = qr[d0]; else q = *(const LAS bf16x8*)(Qs + (d0 - NQR) * 1024);
        p0 = __builtin_amdgcn_mfma_f32_32x32x16_bf16(b0, q, p0, 0, 0, 0);
        p1 = __builtin_amdgcn_mfma_f32_32x32x16_bf16(b1, q, p1, 0, 0, 0); }
}
DI int v_st(int k, int c) { const int kk = (k & ~0xC) | ((k & 4) << 1) | ((k & 8) >> 1); return ((kk >> 3) * 4 + (c >> 5)) * 512 + ((kk & 7) * 32 + (c & 31)) * 2; }
DI int v_rd_base(int lane) { return ((lane & 3) << 3) | (((lane >> 2) & 3) << 6) | (((lane >> 4) & 1) << 5) | (((lane >> 5) & 1) << 8); }
constexpr int v_rd_off(int d0, int ks, int half) { return d0 * 512 + ks * 4096 + half * 2048; }
template <int OFF> DI s16x4 tr_read(int vb) { s16x4 r; asm volatile("ds_read_b64_tr_b16 %0, %1 offset:%2" : "=&v"(r) : "v"(vb), "i"(OFF) : "memory"); return r; }
template <int D0> DI void pv_one(f32x16& od, int vb, bf16x8 pa0, bf16x8 pa1, bf16x8 pa2, bf16x8 pa3) {
    const s16x4 l0 = tr_read<v_rd_off(D0, 0, 0)>(vb), h0 = tr_read<v_rd_off(D0, 0, 1)>(vb), l1 = tr_read<v_rd_off(D0, 1, 0)>(vb), h1 = tr_read<v_rd_off(D0, 1, 1)>(vb);
    const s16x4 l2 = tr_read<v_rd_off(D0, 2, 0)>(vb), h2 = tr_read<v_rd_off(D0, 2, 1)>(vb), l3 = tr_read<v_rd_off(D0, 3, 0)>(vb), h3 = tr_read<v_rd_off(D0, 3, 1)>(vb);
    asm volatile("s_waitcnt lgkmcnt(0)" ::: "memory"); SBAR();
#define PKV(L, H) (bf16x8){L[0], L[1], L[2], L[3], H[0], H[1], H[2], H[3]}
    od = __builtin_amdgcn_mfma_f32_32x32x16_bf16(pa0, PKV(l0, h0), od, 0, 0, 0);
    od = __builtin_amdgcn_mfma_f32_32x32x16_bf16(pa1, PKV(l1, h1), od, 0, 0, 0);
    od = __builtin_amdgcn_mfma_f32_32x32x16_bf16(pa2, PKV(l2, h2), od, 0, 0, 0);
    od = __builtin_amdgcn_mfma_f32_32x32x16_bf16(pa3, PKV(l3, h3), od, 0, 0, 0);
#undef PKV
}
DI void pv_d0(f32x16* o, int vb, bf16x8 pa0, bf16x8 pa1, bf16x8 pa2, bf16x8 pa3) {
    pv_one<0>(o[0], vb, pa0, pa1, pa2, pa3); pv_one<1>(o[1], vb, pa0, pa1, pa2, pa3); pv_one<2>(o[2], vb, pa0, pa1, pa2, pa3); pv_one<3>(o[3], vb, pa0, pa1, pa2, pa3);
}
template <int DQK, int SDEPTH>
DI void attn_body(const bf16_t* __restrict__ Qb, const bf16_t* __restrict__ Kh, const bf16_t* __restrict__ Vh, bf16_t* __restrict__ Ob, int ldo, int seq, char* lds, const float SCALE) {
    using Cfg = AttnCfg<DQK>;
    constexpr int SHM_V = Cfg::SHM_V, SHM_K = Cfg::SHM_K, ND0 = Cfg::ND0, NKCH = Cfg::NKCH, KCPR = DQK / 8, NQR = Cfg::NQR;
    int tid = threadIdx.x; asm volatile("" : "+v"(tid));
    const int wid = tid >> 6, lane = tid & 63, r32 = lane & 31, hi = lane >> 5;
    char* V_lds = lds; char* K_lds = lds + 2 * SHM_V;
    float* ws = (float*)(lds + 2 * SHM_V + 2 * SHM_K) + wid * 64; float* li_l = ws; float* al_l = ws + 32;
    float m_reg = -1e30f, l_reg = 0; f32x16 o[4]; bf16x8 qr[NQR > 0 ? NQR : 1];
    char* Qs = lds + 2 * SHM_V + 2 * SHM_K + 8 * 64 * 4 + (wid * (ND0 - NQR) * 64 + lane) * 16;
#pragma unroll
    for (int d = 0; d < 4; ++d)
#pragma unroll
        for (int r = 0; r < 16; ++r) o[d][r] = 0.f;
    const bf16_t* Qw = Qb + (long)(wid * 32 + r32) * DQK + hi * 8;
#pragma unroll
    for (int d0 = 0; d0 < ND0; ++d0) { const bf16x8 qv = *reinterpret_cast<const bf16x8*>(Qw + d0 * 16); if (d0 < NQR) qr[d0] = qv; else *reinterpret_cast<bf16x8*>(Qs + (d0 - NQR) * 1024) = qv; }
    asm volatile("s_waitcnt lgkmcnt(0)" ::: "memory");
    const int sr = tid >> 4, sc = (tid & 15) * 8, vst0 = v_st(sr, sc), vst1 = v_st(32 + sr, sc);
    const int kgo = (tid >> 3) * DQK + (tid & 7) * 8, klo = (tid >> 3) * (DQK * 2) + (((tid & 7) << 4) ^ (((tid >> 3) & 7) << 4));
    const int vb0 = (int)(uintptr_t)V_lds + v_rd_base(lane);
    int kb[4];
#pragma unroll
    for (int m = 0; m < 4; ++m) { kb[m] = (int)(uintptr_t)K_lds + r32 * (DQK * 2) + 16 * (hi ^ (r32 & 1)) + 32 * (m ^ ((r32 >> 1) & 3)); asm volatile("" : "+v"(kb[m])); }
    struct { bf16x8 vs0, vs1, ks[NKCH]; } sr_[SDEPTH];
#define SLOAD(i, k0) do { sr_[i].vs0 = *(const bf16x8*)(&Vh[(long)((k0) + sr) * 128 + sc]); sr_[i].vs1 = *(const bf16x8*)(&Vh[(long)((k0) + 32 + sr) * 128 + sc]); \
    _Pragma("unroll") for (int q_ = 0; q_ < NKCH; ++q_) sr_[i].ks[q_] = *(const bf16x8*)(&Kh[(long)(k0) * DQK + kgo + q_ * 64]); } while (0)
#define SWRITE(b, i) do { *(bf16x8*)(V_lds + (b) * SHM_V + vst0) = sr_[i].vs0; *(bf16x8*)(V_lds + (b) * SHM_V + vst1) = sr_[i].vs1; \
    _Pragma("unroll") for (int q_ = 0; q_ < NKCH; ++q_) *(bf16x8*)(K_lds + (b) * SHM_K + klo + q_ * 128) = sr_[i].ks[q_]; } while (0)
#define SWAIT() do { if constexpr (SDEPTH == 1) asm volatile("s_waitcnt vmcnt(0)" ::: "memory"); else if constexpr (NKCH == 2) asm volatile("s_waitcnt vmcnt(4)" ::: "memory"); else asm volatile("s_waitcnt vmcnt(5)" ::: "memory"); } while (0)
#define RESC(a) do { if (__any((a) < 1.f)) { if (hi == 0) al_l[r32] = (a); asm volatile("s_waitcnt lgkmcnt(0)" ::: "memory"); \
    _Pragma("unroll") for (int d = 0; d < 4; ++d) _Pragma("unroll") for (int r = 0; r < 16; ++r) o[d][r] *= al_l[crow(r, hi)]; } } while (0)
    f32x16 pA0, pA1, pB0, pB1; float mnA, mnB, alA, alB; bf16x8 pa0, pa1, pa2, pa3; const int NT = seq / 64;
    constexpr int SE = 0, SO = SDEPTH - 1;
    SLOAD(SE, 0); asm volatile("s_waitcnt vmcnt(0)" ::: "memory"); SWRITE(0, SE); __syncthreads();
    qkt<DQK, NQR>(pA0, pA1, kb, 0, qr, (int)(uintptr_t)Qs, r32, hi); partialSM(pA0, pA1, m_reg, mnA, alA, SCALE);
    SLOAD(SO, 64); if constexpr (SDEPTH == 2) { if (2 < NT) SLOAD(SE, 2 * 64); }
    SWAIT(); SWRITE(1, SO); __syncthreads();
    for (int j = 1; j + 1 < NT; j += 2) {
        SBAR(); qkt<DQK, NQR>(pB0, pB1, kb, SHM_K, qr, (int)(uintptr_t)Qs, r32, hi);
        finishSM(pA0, pA1, alA, l_reg, pa0, pa1, pa2, pa3); SBAR();
        SLOAD(SO, (j + SDEPTH) * 64); SBAR();
        pv_d0(o, vb0, pa0, pa1, pa2, pa3); partialSM(pB0, pB1, m_reg, mnB, alB, SCALE);
        __syncthreads(); SWAIT(); SWRITE(0, SE);
        RESC(alB); __syncthreads();
        SBAR(); qkt<DQK, NQR>(pA0, pA1, kb, 0, qr, (int)(uintptr_t)Qs, r32, hi);
        finishSM(pB0, pB1, alB, l_reg, pa0, pa1, pa2, pa3); SBAR();
        if (SDEPTH == 1 || j + 3 < NT) SLOAD(SE, (j + 1 + SDEPTH) * 64); SBAR();
        pv_d0(o, vb0 + SHM_V, pa0, pa1, pa2, pa3); partialSM(pA0, pA1, m_reg, mnA, alA, SCALE);
        __syncthreads(); SWAIT(); SWRITE(1, SO);
        RESC(alA); __syncthreads();
    }
    SBAR(); qkt<DQK, NQR>(pB0, pB1, kb, SHM_K, qr, (int)(uintptr_t)Qs, r32, hi);
    finishSM(pA0, pA1, alA, l_reg, pa0, pa1, pa2, pa3); SBAR();
    pv_d0(o, vb0, pa0, pa1, pa2, pa3); partialSM(pB0, pB1, m_reg, mnB, alB, SCALE);
    __syncthreads(); RESC(alB);
    finishSM(pB0, pB1, alB, l_reg, pa0, pa1, pa2, pa3); SBAR();
    pv_d0(o, vb0 + SHM_V, pa0, pa1, pa2, pa3);
    if (hi == 0) li_l[r32] = l_reg; asm volatile("s_waitcnt lgkmcnt(0)" ::: "memory");
    float rli[16];
#pragma unroll
    for (int r = 0; r < 16; ++r) rli[r] = __builtin_amdgcn_rcpf(li_l[crow(r, hi)]);
    bf16_t* Ow = Ob + (long)(wid * 32) * ldo;
#pragma unroll
    for (int r = 0; r < 16; ++r) { const int orow = crow(r, hi);
#pragma unroll
        for (int d0 = 0; d0 < 4; ++d0) Ow[(long)orow * ldo + d0 * 32 + r32] = f2bf(o[d0][r] * rli[r]); }
    __syncthreads();
#undef SLOAD
#undef SWRITE
#undef SWAIT
#undef RESC
}

template <int DQK> DI void attn_body_old(const bf16_t* Qb, const bf16_t* Kh, const bf16_t* Vh, bf16_t* Ob, int ldo, int seq, char* lds, const float SCALE, PR p, SideCvt& sc) {
    if constexpr (DQK == 192) attn_body<192, ATT_SD_M>(Qb, Kh, Vh, Ob, ldo, seq, lds, SCALE); else attn_body<128, ATT_SD_G>(Qb, Kh, Vh, Ob, ldo, seq, lds, SCALE);
}
#if MOE_FP8
DI CvtDesc side_desc(PR p, int l, int e, int r) {
    CvtDesc d; unsigned char* wl = p.ws + WS_WEIGHTS + (size_t)l * WL_END; const int m = r >> 6, t = r & 63, sp = (t & 48) | ((t & 3) << 2) | ((t >> 2) & 3); const bool sh = e >= 64; const size_t eo = sh ? (size_t)l : (size_t)(l * 64 + e);
    d.drow0 = m;
    if (m < 2) { const float* b_ = m == 0 ? (sh ? p.sh_w1 : p.exp_w1) : (sh ? p.sh_w3 : p.exp_w3); d.src = b_ + (eo << 20);
        d.dst = (bf16_t*)(wl + WL_W13 + ((size_t)e << 21)); d.ldS = 512; d.ldD = D; d.k0 = 32 * sp; d.n0 = 0; }
    else { d.src = (sh ? p.sh_w2 : p.exp_w2) + (eo << 20);
        d.dst = (bf16_t*)(wl + WL_W2 + ((size_t)e << 20)); d.ldS = D; d.ldD = 512; d.k0 = 32 * (sp & 15); d.n0 = 512 * (sp >> 4); }
    return d;
}
DI void side_advance(SideCvt& sc) { --sc.rem; sc.e += sc.de; sc.r += sc.dr; if (sc.r >= 192) { sc.r -= 192; ++sc.e; } }
template <int NQ> struct SideV { typedef f32x4 T; };
template <> struct SideV<2> { typedef float __attribute__((ext_vector_type(2))) T; };
template <int NQ>
DI void side_load(PR p, const SideCvt& sc, int h, typename SideV<NQ>::T (&v)[4], unsigned char*& dstp, int& ldd, float& scl, int lane) {
    const CvtDesc d = side_desc(p, sc.l, sc.e, sc.r); const int kg = lane >> 3, ng = lane & 7, nnb = 32 * sc.sub, nl = NQ == 4 ? 4 * ng : 16 * h + 2 * ng;
    const int k0 = d.k0 + 4 * kg, nn = d.n0 + nnb + nl;
    const int drow = d.drow0 < 2 ? ((nnb >> 7) << 8) + d.drow0 * 128 + (nnb & 127) + nl : nn;
    const float* s0 = d.src + (size_t)k0 * d.ldS + nn;
#pragma unroll
    for (int i = 0; i < 4; ++i) { const float* a_ = s0 + (size_t)i * d.ldS;
        if constexpr (NQ == 4) asm volatile("global_load_dwordx4 %0, %1, off nt" : "=v"(v[i]) : "v"(a_) : "memory");
        else asm volatile("global_load_dwordx2 %0, %1, off nt" : "=v"(v[i]) : "v"(a_) : "memory"); }
    dstp = (unsigned char*)d.dst + (size_t)drow * d.ldD + k0; ldd = d.ldD;
    scl = d.ldD == D ? F8_SW13 : F8_SW2;
}
template <int NQ>
DI void side_finish(const typename SideV<NQ>::T (&v)[4], unsigned char* dstp, int ldd, float scl) {
#pragma unroll
    for (int q = 0; q < NQ; ++q) *(unsigned*)(dstp + (size_t)q * ldd) = f8pack4(v[0][q] * scl, v[1][q] * scl, v[2][q] * scl, v[3][q] * scl);
}
DI void side_cleanup(PR p, SideCvt& sc, int lane) {
    while (sc.rem > 0) { f32x4 v[4]; unsigned char* dp; int ldd; float scl; side_load<4>(p, sc, 0, v, dp, ldd, scl, lane);
        asm volatile("s_waitcnt vmcnt(0)" : "+v"(v[0]), "+v"(v[1]), "+v"(v[2]), "+v"(v[3]) :: "memory"); side_finish<4>(v, dp, ldd, scl); side_advance(sc); }
}
#endif
template <int DQK, int SIDE> DI void attn_body2(const bf16_t* __restrict__ Qb, const bf16_t* __restrict__ Kh, const bf16_t* __restrict__ Vh, bf16_t* __restrict__ Ob, int ldo, int seq, char* lds, const float SCALE, PR p, SideCvt& sc);
template <int DQK> DI void attn_body2_sel(const bf16_t* Qb, const bf16_t* Kh, const bf16_t* Vh, bf16_t* Ob, int ldo, int seq, char* lds, const float SCALE, PR p, SideCvt& sc) {
    attn_body2<DQK, (SIDE_STREAM == 0) ? 0 : (DQK == 128 ? 1 : 2)>(Qb, Kh, Vh, Ob, ldo, seq, lds, SCALE, p, sc);
}
template <int DQK, int SIDE>
DI void attn_body2(const bf16_t* __restrict__ Qb, const bf16_t* __restrict__ Kh, const bf16_t* __restrict__ Vh, bf16_t* __restrict__ Ob, int ldo, int seq, char* lds, const float SCALE, PR p, SideCvt& sc) {
    constexpr int SHM_V = 64 * 128 * 2, SHM_K = 64 * DQK * 2, ND0 = DQK / 16, KP = SHM_K / 8192, VP = 2, NP = KP + VP;
    constexpr int V_RING = 0, K_RING = 4 * SHM_V, WS_OFF = K_RING + 3 * SHM_K;
    int tid = threadIdx.x; asm volatile("" : "+v"(tid));
    const int wid = __builtin_amdgcn_readfirstlane(tid >> 6), lane = tid & 63, r32 = lane & 31, hi = lane >> 5;
    float* ws = (float*)(lds + WS_OFF) + wid * 64; float* li_l = ws; float* al_l = ws + 32;
    float m_reg = -1e30f, l_reg = 0; f32x16 o[4]; bf16x8 qr[ND0];
#pragma unroll
    for (int d = 0; d < 4; ++d)
#pragma unroll
        for (int r = 0; r < 16; ++r) o[d][r] = 0.f;
    int kgo[KP], vgo[VP];
#pragma unroll
    for (int q = 0; q < KP; ++q) { const int sl = (wid * KP + q) * 64 + lane, row = sl / (DQK / 8), ch = sl % (DQK / 8), gch = (ch & ~7) | ((ch & 7) ^ (row & 7)); kgo[q] = row * DQK + gch * 8; }
#pragma unroll
    for (int q = 0; q < VP; ++q) { const int off = (wid * VP + q) * 1024 + lane * 16, sub = off >> 9, w = off & 511, kk = (sub >> 2) * 8 + (w >> 6), k = (kk & ~0xC) | ((kk & 4) << 1) | ((kk & 8) >> 1), c = (sub & 3) * 32 + ((w & 63) >> 1); vgo[q] = k * 128 + c; }
    LAS unsigned char* L = (LAS unsigned char*)lds;
#define DMA_TILE(t, ks, vs) do { \
    _Pragma("unroll") for (int q_ = 0; q_ < KP; ++q_) __builtin_amdgcn_global_load_lds((const unsigned*)(Kh + (size_t)(t) * 64 * DQK + kgo[q_]), (LAS unsigned*)(L + K_RING + (ks) * SHM_K + (wid * KP + q_) * 1024), 16, 0, 0); \
    _Pragma("unroll") for (int q_ = 0; q_ < VP; ++q_) __builtin_amdgcn_global_load_lds((const unsigned*)(Vh + (size_t)(t) * 64 * 128 + vgo[q_]), (LAS unsigned*)(L + V_RING + (vs) * SHM_V + (wid * VP + q_) * 1024), 16, 0, 0); } while (0)
    const int NT = seq / 64;
    DMA_TILE(0, 0, 0); DMA_TILE(1, 1, 1);
    typedef __attribute__((address_space(1))) const bf16x8 gq_t; typedef __attribute__((address_space(1))) bf16_t go_t;
    const bf16_t* Qw = Qb + (long)(wid * 32 + r32) * DQK + hi * 8;
#pragma unroll
    for (int d0 = 0; d0 < ND0; ++d0) qr[d0] = *(gq_t*)(Qw + d0 * 16);
    const int vb0 = (int)(uintptr_t)(lds + V_RING) + v_rd_base(lane);
    int kb[4];
#pragma unroll
    for (int m = 0; m < 4; ++m) { kb[m] = (int)(uintptr_t)(lds + K_RING) + r32 * (DQK * 2) + 16 * (hi ^ (r32 & 1)) + 32 * (m ^ ((r32 >> 1) & 3)); asm volatile("" : "+v"(kb[m])); }
#define RESC(a) do { if (__any((a) < 1.f)) { if (hi == 0) al_l[r32] = (a); asm volatile("s_waitcnt lgkmcnt(0)" ::: "memory"); \
    _Pragma("unroll") for (int d = 0; d < 4; ++d) _Pragma("unroll") for (int r = 0; r < 16; ++r) o[d][r] *= al_l[crow(r, hi)]; } } while (0)
    const int NTs = seq / 64;
    int jmax; { const int rem = sc.rem; if (SIDE == 1) jmax = rem < NTs - 2 ? rem : NTs - 2; else if (SIDE == 2) { const int cap = (NTs - 2) & ~1; jmax = 2 * rem < cap ? 2 * rem : cap; } else jmax = 0; }
#define ACT(j) (SIDE != 0 && (j) >= 0 && (j) < jmax)
#define WAITV_IMM(n) asm volatile("s_waitcnt vmcnt(" #n ")" ::: "memory")
#define STEP_SYNC(j) do { if ((j) + 1 < NT) { if (ACT((j) - 1) && ACT((j) - 2)) { if constexpr (SIDE == 1) { if constexpr (NP == 5) WAITV_IMM(17); else WAITV_IMM(16); } else { if constexpr (NP == 5) WAITV_IMM(13); else WAITV_IMM(12); } } \
        else { if constexpr (NP == 5) WAITV_IMM(5); else WAITV_IMM(4); } } else WAITV_IMM(0); \
    asm volatile("s_waitcnt lgkmcnt(0)" ::: "memory"); __builtin_amdgcn_s_barrier(); asm volatile("" ::: "memory"); } while (0)
    constexpr int SNQ = SIDE == 2 ? 2 : 4;
#define SIDE_TOP(j) const bool sa_ = ACT(j); const int sh_ = SIDE == 2 ? ((j) & 1) : 0; typename SideV<SNQ>::T sv_[4]; unsigned char* sdp_ = nullptr; int sld_ = 0; float ssc_ = 0.f; if (sa_) side_load<SNQ>(p, sc, sh_, sv_, sdp_, sld_, ssc_, lane)
#define SIDE_WAIT() asm volatile("s_waitcnt vmcnt(%4)" : "+v"(sv_[0]), "+v"(sv_[1]), "+v"(sv_[2]), "+v"(sv_[3]) : "n"(NP) : "memory")
#define SIDE_END() do { if (sa_) { SIDE_WAIT(); if (!(PROBE_SIDE_DRY && sc.dry)) side_finish<SNQ>(sv_, sdp_, sld_, ssc_); if (SIDE == 1 || sh_ == 1) side_advance(sc); } } while (0)
    f32x16 pA0, pA1, pB0, pB1; float alA, alB; bf16x8 pa0, pa1, pa2, pa3;
    asm volatile("s_waitcnt vmcnt(0)" ::: "memory");
    { const float C = SCALE * 1.4426950408889634f;
#pragma unroll
      for (int d0 = 0; d0 < ND0; ++d0) { bf16x8 v = qr[d0]; u32x4 w;
          w.x = pk2(bf2f((bf16_t)v[0]) * C, bf2f((bf16_t)v[1]) * C); w.y = pk2(bf2f((bf16_t)v[2]) * C, bf2f((bf16_t)v[3]) * C); w.z = pk2(bf2f((bf16_t)v[4]) * C, bf2f((bf16_t)v[5]) * C); w.w = pk2(bf2f((bf16_t)v[6]) * C, bf2f((bf16_t)v[7]) * C);
          qr[d0] = *reinterpret_cast<bf16x8*>(&w); } }
    asm volatile("s_waitcnt lgkmcnt(0)" ::: "memory"); __builtin_amdgcn_s_barrier(); asm volatile("" ::: "memory");
    { SIDE_TOP(0);
      if (2 < NT) DMA_TILE(2, 2, 2);
      qkt2<DQK>(pA0, pA1, kb, 0, qr, 0.f); partialSM2(pA0, pA1, m_reg, 0.f, alA);
      SIDE_END(); }
    int ks = 1, vs = 0;
    for (int j = 1; j + 1 < NT; j += 2) {
        STEP_SYNC(j);
        { SIDE_TOP(j);
        if (j + 2 < NT) { const int ks2 = ks == 0 ? 2 : ks - 1, vs2 = (vs + 3) & 3; DMA_TILE(j + 2, ks2, vs2); }
        SBAR(); qkt2<DQK>(pB0, pB1, kb, ks * SHM_K, qr, -m_reg);
        finishSM(pA0, pA1, alA, l_reg, pa0, pa1, pa2, pa3); SBAR();
        pv_d0(o, vb0 + vs * SHM_V, pa0, pa1, pa2, pa3); partialSM2(pB0, pB1, m_reg, m_reg, alB);
        RESC(alB);
        SIDE_END(); }
        ks = ks == 2 ? 0 : ks + 1; vs = (vs + 1) & 3;
        STEP_SYNC(j + 1);
        { SIDE_TOP(j + 1);
        if (j + 3 < NT) { const int ks2 = ks == 0 ? 2 : ks - 1, vs2 = (vs + 3) & 3; DMA_TILE(j + 3, ks2, vs2); }
        SBAR(); qkt2<DQK>(pA0, pA1, kb, ks * SHM_K, qr, -m_reg);
        finishSM(pB0, pB1, alB, l_reg, pa0, pa1, pa2, pa3); SBAR();
        pv_d0(o, vb0 + vs * SHM_V, pa0, pa1, pa2, pa3); partialSM2(pA0, pA1, m_reg, m_reg, alA);
        RESC(alA);
        SIDE_END(); }
        ks = ks == 2 ? 0 : ks + 1; vs = (vs + 1) & 3;
    }
    STEP_SYNC(NT - 1);
    SBAR(); qkt2<DQK>(pB0, pB1, kb, ks * SHM_K, qr, -m_reg);
    finishSM(pA0, pA1, alA, l_reg, pa0, pa1, pa2, pa3); SBAR();
    pv_d0(o, vb0 + vs * SHM_V, pa0, pa1, pa2, pa3); partialSM2(pB0, pB1, m_reg, m_reg, alB);
    RESC(alB);
    vs = (vs + 1) & 3;
    finishSM(pB0, pB1, alB, l_reg, pa0, pa1, pa2, pa3); SBAR();
    pv_d0(o, vb0 + vs * SHM_V, pa0, pa1, pa2, pa3);
    if (hi == 0) li_l[r32] = l_reg; asm volatile("s_waitcnt lgkmcnt(0)" ::: "memory");
    float rli[16];
#pragma unroll
    for (int r = 0; r < 16; ++r) rli[r] = __builtin_amdgcn_rcpf(li_l[crow(r, hi)]) * (OUTPROJ_FP8 ? F8_SMIX : 1.f);
    go_t* Ow = OUTPROJ_FP8 ? (go_t*)((unsigned char*)Ob + (long)(wid * 32) * ldo) : (go_t*)(Ob + (long)(wid * 32) * ldo);
#pragma unroll
    for (int r = 0; r < 16; ++r) { const int orow = crow(r, hi);
#pragma unroll
        for (int d0 = 0; d0 < 4; ++d0) {
            if (OUTPROJ_FP8) ((__attribute__((address_space(1))) unsigned char*)Ow)[(long)orow * ldo + d0 * 32 + r32] = (unsigned char)(f8pack4(o[d0][r] * rli[r], 0.f, 0.f, 0.f) & 0xFFu);
            else Ow[(long)orow * ldo + d0 * 32 + r32] = f2bf(o[d0][r] * rli[r]); } }
    asm volatile("s_waitcnt lgkmcnt(0)" ::: "memory"); __builtin_amdgcn_s_barrier(); asm volatile("" ::: "memory");
#undef DMA_TILE
#undef RESC
#undef STEP_SYNC
#undef ACT
#undef WAITV_IMM
#undef SIDE_TOP
#undef SIDE_END
#undef SIDE_WAIT
}

constexpr int GL_V = 0;
constexpr int GL_K = 16384;
constexpr int GL_Q = GL_K + 9216;
constexpr int GL_ZF = GL_Q + 9216;
constexpr int GL_ZB = GL_ZF + 4096;
constexpr int GL_LF = GL_ZB + 4096;
constexpr int GL_LB = GL_LF + 16640;
constexpr int GL_X0 = GL_LB + 16640;
constexpr int GL_KEF = GL_X0, GL_KEB = GL_X0 + 9216;
constexpr int GL_QD = GL_X0, GL_KI = GL_X0 + 9216;
constexpr int GL_O = GL_X0 + 18432;
static_assert(GL_O + 64 * 132 * 4 <= 160 * 1024 - 256, "GLA LDS");
DI int gla_row0(int b, int c) { return c < 4 ? NLAT + b * CTXL + c * 64 : b * SEQ + (c - 4) * 64; }
DI void gla_prep(PR p, int l, char* lds, int b, int h, int c, bool needq) {
    const int tid = tid_here(), lane = tid & 63, wid = tid >> 6;
    const bf16_t* PR_ = (const bf16_t*)(p.ws + WS_U + U_PROJ);
    const int row0 = gla_row0(b, c);
    {
        const int t = tid >> 3, dg = (tid & 7) * 8; const bf16_t* pr = PR_ + (size_t)(row0 + t) * INWP;
        *(bf16x8*)(lds + GL_K + t * 144 + dg * 2) = *(const bf16x8*)(pr + C_GK + h * 64 + dg);
        if (needq) { const bf16x8 qv = *(const bf16x8*)(pr + C_GQ + h * 64 + dg); u32x4 w;
            w.x = pk2(bf2f((bf16_t)qv[0]) * 0.125f, bf2f((bf16_t)qv[1]) * 0.125f); w.y = pk2(bf2f((bf16_t)qv[2]) * 0.125f, bf2f((bf16_t)qv[3]) * 0.125f);
            w.z = pk2(bf2f((bf16_t)qv[4]) * 0.125f, bf2f((bf16_t)qv[5]) * 0.125f); w.w = pk2(bf2f((bf16_t)qv[6]) * 0.125f, bf2f((bf16_t)qv[7]) * 0.125f);
            *(u32x4*)(lds + GL_Q + t * 144 + dg * 2) = w; }
        const int sr = tid >> 4, sc = (tid & 15) * 8;
        *(bf16x8*)(lds + GL_V + v_st(sr, sc)) = *(const bf16x8*)(PR_ + (size_t)(row0 + sr) * INWP + C_GV + h * 128 + sc);
        *(bf16x8*)(lds + GL_V + v_st(32 + sr, sc)) = *(const bf16x8*)(PR_ + (size_t)(row0 + 32 + sr) * INWP + C_GV + h * 128 + sc);
        if (tid < 256) { const int tt = (tid & 127) >> 1, half = tid & 1, dir = tid >> 7; const bf16x8 zv = *(const bf16x8*)(PR_ + (size_t)(row0 + tt) * INWP + (dir ? C_ZB : C_ZF) + half * 8);
            float* Z = (float*)(lds + (dir ? GL_ZB : GL_ZF)) + tt * 16 + half * 8;
#pragma unroll
            for (int j = 0; j < 8; ++j) Z[j] = bf2f((bf16_t)zv[j]); }
    }
    float wf[16], wb[16];
#pragma unroll
    for (int r = 0; r < 16; ++r) { wf[r] = p.gla_wg2_f[((size_t)l * 16 + r) * 256 + h * 64 + lane]; wb[r] = p.gla_wg2_b[((size_t)l * 16 + r) * 256 + h * 64 + lane]; }
    const float bgf = p.gla_bg_f[l * 256 + h * 64 + lane], bgb = p.gla_bg_b[l * 256 + h * 64 + lane];
    __syncthreads();
#pragma unroll
    for (int i = 0; i < 8; ++i) {
        const int t = wid * 8 + i; const float* ZF = (const float*)(lds + GL_ZF) + t * 16; const float* ZB = (const float*)(lds + GL_ZB) + t * 16;
        float zf = bgf, zb = bgb;
#pragma unroll
        for (int r = 0; r < 16; ++r) { zf += ZF[r] * wf[r]; zb += ZB[r] * wb[r]; }
        const float lf = fminf(zf, 0.f) - __logf(1.f + __expf(-fabsf(zf))), lb = fminf(zb, 0.f) - __logf(1.f + __expf(-fabsf(zb)));
        ((float*)(lds + GL_LF))[t * 65 + lane] = lf * 0.0625f; ((float*)(lds + GL_LB))[t * 65 + lane] = lb * 0.0625f;
    }
    __syncthreads();
#pragma unroll
    for (int i = 0; i < 8; ++i) {
        const int d = wid * 8 + i;
        float* F = (float*)(lds + GL_LF) + lane * 65 + d; float* Bk = (float*)(lds + GL_LB) + lane * 65 + d;
        float f = *F; const float g0 = *Bk;
        f = wave_scan_incl(f);
        const float gp = wave_scan_incl(g0), gtot = __int_as_float(__builtin_amdgcn_readlane(__float_as_int(gp), 63));
        *F = f; *Bk = gtot - gp + g0;
    }
    __syncthreads();
}
DI void gla_prep_cached(PR p, char* lds, int b, int h, int c, int unit) {
    const int tid = tid_here();
    const bf16_t* PR_ = (const bf16_t*)(p.ws + WS_U + U_PROJ);
    const int row0 = gla_row0(b, c);
    const int t = tid >> 3, dg = (tid & 7) * 8; const bf16_t* pr = PR_ + (size_t)(row0 + t) * INWP;
    const float* G = (const float*)(p.ws + WS_U + U_GLC) + (size_t)unit * 8192 + t * 64 + dg;
    const f32x4 f0 = *(const f32x4*)(G), f1 = *(const f32x4*)(G + 4), g0 = *(const f32x4*)(G + 4096), g1 = *(const f32x4*)(G + 4100);
    *(bf16x8*)(lds + GL_K + t * 144 + dg * 2) = *(const bf16x8*)(pr + C_GK + h * 64 + dg);
    { const bf16x8 qv = *(const bf16x8*)(pr + C_GQ + h * 64 + dg); u32x4 w;
      w.x = pk2(bf2f((bf16_t)qv[0]) * 0.125f, bf2f((bf16_t)qv[1]) * 0.125f); w.y = pk2(bf2f((bf16_t)qv[2]) * 0.125f, bf2f((bf16_t)qv[3]) * 0.125f);
      w.z = pk2(bf2f((bf16_t)qv[4]) * 0.125f, bf2f((bf16_t)qv[5]) * 0.125f); w.w = pk2(bf2f((bf16_t)qv[6]) * 0.125f, bf2f((bf16_t)qv[7]) * 0.125f);
      *(u32x4*)(lds + GL_Q + t * 144 + dg * 2) = w; }
    const int sr = tid >> 4, sc = (tid & 15) * 8;
    *(bf16x8*)(lds + GL_V + v_st(sr, sc)) = *(const bf16x8*)(PR_ + (size_t)(row0 + sr) * INWP + C_GV + h * 128 + sc);
    *(bf16x8*)(lds + GL_V + v_st(32 + sr, sc)) = *(const bf16x8*)(PR_ + (size_t)(row0 + 32 + sr) * INWP + C_GV + h * 128 + sc);
    float* LF = (float*)(lds + GL_LF) + t * 65 + dg; float* LB = (float*)(lds + GL_LB) + t * 65 + dg;
#pragma unroll
    for (int j = 0; j < 4; ++j) { LF[j] = f0[j]; LF[4 + j] = f1[j]; LB[j] = g0[j]; LB[4 + j] = g1[j]; }
    __syncthreads();
}
DI void gla_gates_store(PR p, char* lds, int unit) {
    const int tid = tid_here(), t = tid >> 3, dg = (tid & 7) * 8;
    const float* LF = (const float*)(lds + GL_LF) + t * 65 + dg; const float* LB = (const float*)(lds + GL_LB) + t * 65 + dg;
    float* G = (float*)(p.ws + WS_U + U_GLC) + (size_t)unit * 8192 + t * 64 + dg;
    *(f32x4*)(G) = (f32x4){LF[0], LF[1], LF[2], LF[3]}; *(f32x4*)(G + 4) = (f32x4){LF[4], LF[5], LF[6], LF[7]};
    *(f32x4*)(G + 4096) = (f32x4){LB[0], LB[1], LB[2], LB[3]}; *(f32x4*)(G + 4100) = (f32x4){LB[4], LB[5], LB[6], LB[7]};
}
DI void gla_phaseA(PR p, int l, char* lds) {
    float* GS = (float*)(p.ws + WS_U + U_GS); float* GD = (float*)(p.ws + WS_GDEC);
    for (int u = bid_here(); u < 16 * 68; u += gridDim.x) {
        const int h = u & 3, t2_ = u >> 2, c = t2_ % 68, b = t2_ / 68, bh = b * 4 + h;
        gla_prep(p, l, lds, b, h, c, false);
        gla_gates_store(p, lds, bh * 68 + c);
        const int tid = tid_here(), lane = tid & 63, wid = tid >> 6, r32 = lane & 31, hi = lane >> 5;
        {
            const float* LF = (const float*)(lds + GL_LF); const float* LB = (const float*)(lds + GL_LB);
            const float lastf = LF[63 * 65 + lane], lastb = LB[0 * 65 + lane];
            float ef[8], eb[8];
#pragma unroll
            for (int i = 0; i < 8; ++i) { const int t = wid * 8 + i; const float k = bf2f(*(const bf16_t*)(lds + GL_K + t * 144 + lane * 2));
                ef[i] = k * __expf(lastf - LF[t * 65 + lane]); eb[i] = k * __expf(lastb - LB[t * 65 + lane]); }
            u32x4 w; w.x = pk2(ef[0], ef[1]); w.y = pk2(ef[2], ef[3]); w.z = pk2(ef[4], ef[5]); w.w = pk2(ef[6], ef[7]); *(u32x4*)(lds + GL_KEF + lane * 144 + wid * 16) = w;
            w.x = pk2(eb[0], eb[1]); w.y = pk2(eb[2], eb[3]); w.z = pk2(eb[4], eb[5]); w.w = pk2(eb[6], eb[7]); *(u32x4*)(lds + GL_KEB + lane * 144 + wid * 16) = w;
            if (wid == 0) { GD[((size_t)(0 * 16 + bh) * 68 + c) * 64 + lane] = __expf(lastf); GD[((size_t)(1 * 16 + bh) * 68 + c) * 64 + lane] = __expf(lastb); }
        }
        __syncthreads();
        {
            const int rh = wid & 1, cb = wid >> 1;
            const int vb = (int)(uintptr_t)(lds + GL_V) + v_rd_base(lane) + cb * 512;
#pragma unroll
            for (int dir = 0; dir < 2; ++dir) {
                const char* KE = lds + (dir ? GL_KEB : GL_KEF) + (rh * 32 + r32) * 144 + hi * 16;
                const bf16x8 a0 = *(const bf16x8*)(KE), a1 = *(const bf16x8*)(KE + 32), a2 = *(const bf16x8*)(KE + 64), a3 = *(const bf16x8*)(KE + 96);
                f32x16 od;
#pragma unroll
                for (int r = 0; r < 16; ++r) od[r] = 0.f;
                pv_one<0>(od, vb, a0, a1, a2, a3);
                float* dst = GS + ((size_t)(dir * 16 + bh) * 68 + c) * 8192 + (size_t)(cb * 32 + r32) * 64 + rh * 32 + 4 * hi;
#pragma unroll
                for (int g = 0; g < 4; ++g) *(f32x4*)(dst + 8 * g) = (f32x4){od[4 * g], od[4 * g + 1], od[4 * g + 2], od[4 * g + 3]};
            }
        }
        __syncthreads();
    }
}
DI void gla_scan(PR p) {
    const float* GS = (const float*)(p.ws + WS_U + U_GS); const float* GD = (const float*)(p.ws + WS_GDEC); bf16_t* GST = (bf16_t*)(p.ws + WS_U + U_GST);
    const int tid = tid_here();
    if (tid >= 256) return;
    for (int u = bid_here(); u < 256; u += gridDim.x) {
        const int e = u * 256 + tid, db = e >> 11, jd4 = e & 2047, d4 = (jd4 & 15) * 4;
        const int dir = db >> 4;
        const float* base = GS + (size_t)db * 68 * 8192 + jd4 * 4; const float* dbase = GD + (size_t)db * 68 * 64 + d4; bf16_t* obase = GST + (size_t)db * 68 * 8192 + jd4 * 4;
#define SC_C(i) (dir == 0 ? (i) : ((i) < 4 ? 3 - (i) : 71 - (i)))
        float z0 = 0.f; asm volatile("" : "+v"(z0));
        f32x4 S = {z0, z0, z0, z0};
        f32x4 cur[4], nxt[4], dc[4], dn[4];
#pragma unroll
        for (int q = 0; q < 4; ++q) { const int c = SC_C(q); cur[q] = *(const f32x4*)(base + (size_t)c * 8192); dc[q] = *(const f32x4*)(dbase + c * 64); }
        for (int i = 0; i < 68; i += 4) {
            if (i + 4 < 68) {
#pragma unroll
                for (int q = 0; q < 4; ++q) { const int c = SC_C(i + 4 + q); nxt[q] = *(const f32x4*)(base + (size_t)c * 8192); dn[q] = *(const f32x4*)(dbase + c * 64); }
            }
#pragma unroll
            for (int q = 0; q < 4; ++q) { const int c = SC_C(i + q); u32x2 w; w.x = pk2(S[0], S[1]); w.y = pk2(S[2], S[3]); *(u32x2*)(obase + (size_t)c * 8192) = w; S = S * dc[q] + cur[q]; }
#pragma unroll
            for (int q = 0; q < 4; ++q) { cur[q] = nxt[q]; dc[q] = dn[q]; }
        }
#undef SC_C
    }
}
DI void gla_phaseC(PR p, int l, char* lds, int qsel = 0) {
    const bf16_t* GST = (const bf16_t*)(p.ws + WS_U + U_GST);
    const bf16_t* PR_ = (const bf16_t*)(p.ws + WS_U + U_PROJ); bf16_t* MIX = (bf16_t*)(p.ws + WS_U + U_MIX);
    unsigned* qctr = (unsigned*)(p.ws + WS_CTL) + 64 * (28 + l + 2 * qsel);
    const int nunits = l == 0 ? 16 * 68 : 16 * 64;
    int pend = 0; if (tid_here() == 0) pend = (int)CTL_ADD(qctr, 1u);
    for (;;) {
        volatile LAS int* flag = (volatile LAS int*)(shm + 32);
        __syncthreads();
        if (tid_here() == 0) *flag = pend;
        __syncthreads();
        const int u = __builtin_amdgcn_readfirstlane(*flag);
        if (u >= nunits) break;
        if (tid_here() == 0) pend = (int)CTL_ADD(qctr, 1u);
        const int bh = l == 0 ? u / 68 : u >> 6, c = l == 0 ? u % 68 : 4 + (u & 63), b = bh >> 2, h = bh & 3;
        gla_prep_cached(p, lds, b, h, c, bh * 68 + c);
        const int tid = tid_here(), lane = tid & 63, wid = tid >> 6, r32 = lane & 31, hi = lane >> 5, rh = wid & 1, cb = wid >> 1;
        const int vb = (int)(uintptr_t)(lds + GL_V) + v_rd_base(lane) + cb * 512;
        f32x16 o;
#pragma unroll
        for (int r = 0; r < 16; ++r) o[r] = 0.f;
#pragma unroll
        for (int dir = 0; dir < 2; ++dir) {
            {
                const int t = tid >> 3, dg = (tid & 7) * 8; const float* LC = (const float*)(lds + (dir ? GL_LB : GL_LF)) + t * 65 + dg;
                const bf16x8 qv = *(const bf16x8*)(lds + GL_Q + t * 144 + dg * 2), kv = *(const bf16x8*)(lds + GL_K + t * 144 + dg * 2);
                float qd[8], ki[8];
#pragma unroll
                for (int j = 0; j < 8; ++j) { const float bc = LC[j]; qd[j] = bf2f((bf16_t)qv[j]) * __expf(bc); ki[j] = bf2f((bf16_t)kv[j]) * __expf(-bc); }
                u32x4 w; w.x = pk2(qd[0], qd[1]); w.y = pk2(qd[2], qd[3]); w.z = pk2(qd[4], qd[5]); w.w = pk2(qd[6], qd[7]); *(u32x4*)(lds + GL_QD + t * 144 + dg * 2) = w;
                w.x = pk2(ki[0], ki[1]); w.y = pk2(ki[2], ki[3]); w.z = pk2(ki[4], ki[5]); w.w = pk2(ki[6], ki[7]); *(u32x4*)(lds + GL_KI + t * 144 + dg * 2) = w;
            }
            __syncthreads();
            {
                const char* QD = lds + GL_QD + (rh * 32 + r32) * 144 + hi * 16; const char* KI = lds + GL_KI + r32 * 144 + hi * 16;
                bf16x8 qf[4];
#pragma unroll
                for (int d0 = 0; d0 < 4; ++d0) qf[d0] = *(const bf16x8*)(QD + d0 * 32);
                f32x16 p0, p1;
#pragma unroll
                for (int r = 0; r < 16; ++r) { p0[r] = 0.f; p1[r] = 0.f; }
#pragma unroll
                for (int d0 = 0; d0 < 4; ++d0) {
                    const bf16x8 k0 = *(const bf16x8*)(KI + d0 * 32), k1 = *(const bf16x8*)(KI + 32 * 144 + d0 * 32);
                    p0 = __builtin_amdgcn_mfma_f32_32x32x16_bf16(k0, qf[d0], p0, 0, 0, 0);
                    p1 = __builtin_amdgcn_mfma_f32_32x32x16_bf16(k1, qf[d0], p1, 0, 0, 0);
                }
                const int tq = rh * 32 + r32;
#pragma unroll
                for (int r = 0; r < 16; ++r) { const int s0 = crow(r, hi), s1 = 32 + s0;
                    const bool ok0 = dir == 0 ? (s0 <= tq) : (s0 >= tq), ok1 = dir == 0 ? (s1 <= tq) : (s1 >= tq);
                    p0[r] = ok0 ? p0[r] : 0.f; p1[r] = ok1 ? p1[r] : 0.f; }
                bf16x8 pa0, pa1, pa2, pa3;
#define PK4(P, BASE, OUT) do { unsigned a0 = cvtpk(P[BASE + 0], P[BASE + 1]), a1 = cvtpk(P[BASE + 2], P[BASE + 3]);   \
    unsigned b0 = cvtpk(P[BASE + 4], P[BASE + 5]), b1 = cvtpk(P[BASE + 6], P[BASE + 7]);                              \
    auto r0 = __builtin_amdgcn_permlane32_swap(a0, b0, false, false); auto r1 = __builtin_amdgcn_permlane32_swap(a1, b1, false, false); \
    u32x4 w_ = {r0[0], r1[0], r0[1], r1[1]}; OUT = *reinterpret_cast<bf16x8*>(&w_); } while (0)
                PK4(p0, 0, pa0); PK4(p0, 8, pa1); PK4(p1, 0, pa2); PK4(p1, 8, pa3);
#undef PK4
                pv_one<0>(o, vb, pa0, pa1, pa2, pa3);
                const bf16_t* Sg = GST + ((size_t)(dir * 16 + bh) * 68 + c) * 8192 + (size_t)(cb * 32 + r32) * 64 + hi * 8;
                const bf16x8 s0 = *(const bf16x8*)(Sg), s1 = *(const bf16x8*)(Sg + 16), s2 = *(const bf16x8*)(Sg + 32), s3 = *(const bf16x8*)(Sg + 48);
                o = __builtin_amdgcn_mfma_f32_32x32x16_bf16(qf[0], s0, o, 0, 0, 0);
                o = __builtin_amdgcn_mfma_f32_32x32x16_bf16(qf[1], s1, o, 0, 0, 0);
                o = __builtin_amdgcn_mfma_f32_32x32x16_bf16(qf[2], s2, o, 0, 0, 0);
                o = __builtin_amdgcn_mfma_f32_32x32x16_bf16(qf[3], s3, o, 0, 0, 0);
            }
            __syncthreads();
        }
        { float* O = (float*)(lds + GL_O);
#pragma unroll
          for (int r = 0; r < 16; ++r) O[(rh * 32 + crow(r, hi)) * 132 + cb * 32 + r32] = o[r]; }
        __syncthreads();
        {
            const int t = tid >> 3, jg = (tid & 7) * 16; const float* O = (const float*)(lds + GL_O) + t * 132 + jg;
            float v[16], ss = 0.f;
#pragma unroll
            for (int q = 0; q < 4; ++q) { const f32x4 x = *(const f32x4*)(O + 4 * q); v[4 * q] = x[0]; v[4 * q + 1] = x[1]; v[4 * q + 2] = x[2]; v[4 * q + 3] = x[3]; ss += x[0] * x[0] + x[1] * x[1] + x[2] * x[2] + x[3] * x[3]; }
            ss += shx(ss, 1, lane); ss += shx(ss, 2, lane); ss += shx(ss, 4, lane);
            const float rstd = rsqrtf(ss * (1.f / 128.f) + EPS);
            const int row = gla_row0(b, c) + t;
            const bf16_t* gp = PR_ + (size_t)row * INWP + C_GG + h * 128 + jg; const float* go = p.gla_g_out + l * 128 + jg;
            const bf16x8 g0 = *(const bf16x8*)(gp), g1 = *(const bf16x8*)(gp + 8);
            float ov[16];
#pragma unroll
            for (int j = 0; j < 16; ++j) { const float gate = bf2f((bf16_t)(j < 8 ? g0[j] : g1[j - 8])); ov[j] = v[j] * rstd * go[j] * silu_f(gate); }
            u32x4 w0, w1; w0.x = pk2(ov[0], ov[1]); w0.y = pk2(ov[2], ov[3]); w0.z = pk2(ov[4], ov[5]); w0.w = pk2(ov[6], ov[7]); w1.x = pk2(ov[8], ov[9]); w1.y = pk2(ov[10], ov[11]); w1.z = pk2(ov[12], ov[13]); w1.w = pk2(ov[14], ov[15]);
            if (OUTPROJ_FP8) { u32x4 w8; w8.x = f8pack4(ov[0] * F8_SMIX, ov[1] * F8_SMIX, ov[2] * F8_SMIX, ov[3] * F8_SMIX); w8.y = f8pack4(ov[4] * F8_SMIX, ov[5] * F8_SMIX, ov[6] * F8_SMIX, ov[7] * F8_SMIX);
                w8.z = f8pack4(ov[8] * F8_SMIX, ov[9] * F8_SMIX, ov[10] * F8_SMIX, ov[11] * F8_SMIX); w8.w = f8pack4(ov[12] * F8_SMIX, ov[13] * F8_SMIX, ov[14] * F8_SMIX, ov[15] * F8_SMIX);
                *(u32x4*)((unsigned char*)MIX + (size_t)row * D + h * 128 + jg) = w8; }
            else { bf16_t* dst = MIX + (size_t)row * D + h * 128 + jg; *(u32x4*)(dst) = w0; *(u32x4*)(dst + 8) = w1; }
        }
        __syncthreads();
    }
}

namespace pg {
constexpr int BK = 64, HALF = 128, HTB = HALF * BK * 2, STAGE_BYTES = 8 * HTB;
DI int lds_byte(int r, int c) { const int st = (r >> 4) * 2 + (c >> 5), rr = r & 15, cc = c & 31, ob = rr * 64 + cc * 2; return st * 1024 + (ob ^ (((ob >> 9) & 1) << 5)); }
DI int perm32(int rho) { const int n = rho >> 4, i = rho & 15; return 8 * (i >> 2) + 4 * n + (i & 3); }
DI void stage_rc(int b, int& R, int& C) { const int st = b / 1024, sb = b % 1024, swz = sb ^ (((sb >> 9) & 1) << 5); R = (st >> 1) * 16 + swz / 64; C = (st & 1) * 32 + (swz % 64) / 2; }
typedef int i32x4_t __attribute__((ext_vector_type(4))); typedef int i32x8_t __attribute__((ext_vector_type(8)));
DI i32x8_t cat8(const bf16x8& lo, const bf16x8& hi) { const i32x4_t a = __builtin_bit_cast(i32x4_t, lo), b = __builtin_bit_cast(i32x4_t, hi); return __builtin_shufflevector(a, b, 0, 1, 2, 3, 4, 5, 6, 7); }
struct XUnit {
    const char* A;
    const char* B;
    int arow0;
    int list;
    int e0, e1, e2, e3;
};
template <class Sched>
DI void gemm_phase(LAS unsigned char* lds, const LAS int* rowlists, const Sched& S) {
    int tid = threadIdx.x; asm volatile("" : "+v"(tid));
    const int wid = __builtin_amdgcn_readfirstlane(tid >> 6), lane = tid & 63, wr = wid >> 2, wc = wid & 3, fr = lane & 15, fq = lane >> 4;
    const int K = S.K, nt = K / BK;
    unsigned voffB[2], voffB1[2];
#pragma unroll
    for (int i = 0; i < 2; ++i) { int R_, C_; stage_rc(tid * 16 + i * 8192, R_, C_);
        if (Sched::PERM == 2) { const int wc_ = R_ >> 5, n_ = (R_ >> 4) & 1, fq_ = (R_ >> 2) & 3, k_ = R_ & 3, row0_ = wc_ * 64 + fq_ * 16 + n_ * 4 + k_;
            voffB[i] = (unsigned)row0_ * (unsigned)S.ldb + (unsigned)C_ * 2u; voffB1[i] = (unsigned)(row0_ + 8) * (unsigned)S.ldb + (unsigned)C_ * 2u; }
        else { if (Sched::PERM == 1) R_ = (R_ & ~31) + perm32(R_ & 31); voffB[i] = (unsigned)R_ * (unsigned)S.ldb + (unsigned)C_ * 2u; voffB1[i] = voffB[i] + (unsigned)HALF * (unsigned)S.ldb; } }
    const size_t kstep = (size_t)(BK * 2);
    const unsigned ldsw = (unsigned)wid * 1024u;
    const int aoff = lds_byte(wr * 64 + fr, fq * 8), boff = lds_byte(wc * 32 + fr, fq * 8);
#define PG_SA(b, h) (((b) * 2 + (h)) * HTB)
#define PG_SB(b, h) ((4 + (b) * 2 + (h)) * HTB)
#define PG_STAGE(bufoff, gbase, voff) do { _Pragma("unroll") for (int _i = 0; _i < 2; ++_i) \
        __builtin_amdgcn_global_load_lds((const unsigned*)((const char*)(gbase) + (voff)[_i]), (LAS unsigned*)(lds + (bufoff) + ldsw + _i * 8192), 16, 0, 0); } while (0)
#define PG_LDA(dst, b, h) do { _Pragma("unroll") for (int m = 0; m < 4; ++m) _Pragma("unroll") for (int k = 0; k < 2; ++k) dst[m][k] = *(const LAS bf16x8*)(lds + PG_SA(b, h) + aoff + m * 2048 + k * 1024); } while (0)
#define PG_LDB(dst, b, h) do { _Pragma("unroll") for (int n = 0; n < 2; ++n) _Pragma("unroll") for (int k = 0; k < 2; ++k) dst[n][k] = *(const LAS bf16x8*)(lds + PG_SB(b, h) + boff + n * 2048 + k * 1024); } while (0)
#define PG_MMA(ai, bj, At, Bt) do { __builtin_amdgcn_s_setprio(1); _Pragma("unroll") for (int m = 0; m < 4; ++m) _Pragma("unroll") for (int n = 0; n < 2; ++n) { \
        if constexpr (Sched::F8) acc[ai][bj][m][n] = __builtin_amdgcn_mfma_scale_f32_16x16x128_f8f6f4(cat8(Bt[n][0], Bt[n][1]), cat8(At[m][0], At[m][1]), acc[ai][bj][m][n], 0, 0, 0, 0, 0, 0); \
        else { _Pragma("unroll") for (int k = 0; k < 2; ++k) acc[ai][bj][m][n] = __builtin_amdgcn_mfma_f32_16x16x32_bf16(Bt[n][k], At[m][k], acc[ai][bj][m][n], 0, 0, 0); } } __builtin_amdgcn_s_setprio(0); } while (0)
#define PG_WAIT_V(n) asm volatile("s_waitcnt vmcnt(" #n ")" ::: "memory")
#define PG_WAIT_L(n) asm volatile("s_waitcnt lgkmcnt(" #n ")" ::: "memory")
#define PG_BAR __builtin_amdgcn_s_barrier()
#define PG_SCHED __builtin_amdgcn_sched_barrier(0)
#define PG_AOFFS(dst, u) do { const int _t = tid_here(); _Pragma("unroll") for (int _i = 0; _i < 2; ++_i) { int _R, _C; stage_rc(_t * 16 + _i * 8192, _R, _C); _Pragma("unroll") for (int _h = 0; _h < 2; ++_h) { \
        unsigned _row; if ((u).list >= 0) { const int _x = rowlists[(u).list + _h * HALF + _R]; _row = _x >= 0 ? (unsigned)(_x >> S.rowshift) : 0u; } else _row = (unsigned)((u).arow0 + _h * HALF + _R); \
        dst[_h][_i] = _row * (unsigned)S.lda + (unsigned)_C * 2u; } } } while (0)
    XUnit cur, nxt; int ui = 0;
    if (!S.next(0, cur)) return;
    if (Sched::STAGGER > 0) { const unsigned long long t0 = __builtin_amdgcn_s_memrealtime(); const unsigned long long dl = (unsigned long long)((blockIdx.x & 7) * Sched::STAGGER); while (__builtin_amdgcn_s_memrealtime() - t0 < dl) __builtin_amdgcn_s_sleep(4); }
    f32x4 acc[2][2][4][2];
#pragma unroll
    for (int a = 0; a < 2; ++a)
#pragma unroll
        for (int b = 0; b < 2; ++b)
#pragma unroll
            for (int m = 0; m < 4; ++m)
#pragma unroll
                for (int n = 0; n < 2; ++n) acc[a][b][m][n] = (f32x4){0.f, 0.f, 0.f, 0.f};
    bf16x8 At[4][2], B0[2][2], B1[2][2];
    unsigned ao[2][2];
    PG_AOFFS(ao, cur);
    PG_WAIT_L(0); PG_SCHED;
    const char* cA = cur.A; const char* cB = cur.B;
    PG_STAGE(PG_SB(0, 0), cB, voffB); PG_STAGE(PG_SA(0, 0), cA, ao[0]); PG_STAGE(PG_SB(0, 1), cB, voffB1); PG_STAGE(PG_SA(0, 1), cA, ao[1]);
    if (wr == 1) PG_BAR;
    PG_WAIT_V(4); PG_BAR;
    PG_STAGE(PG_SB(1, 0), cB + kstep, voffB); PG_STAGE(PG_SA(1, 0), cA + kstep, ao[0]); PG_STAGE(PG_SB(1, 1), cB + kstep, voffB1); PG_STAGE(PG_SA(1, 1), cA + kstep, ao[1]);
    PG_WAIT_V(8); PG_BAR;
    for (;;) {
        const bool has_next = S.next(ui + 1, nxt);
        const char* nA = has_next ? nxt.A : cA; const char* nB = has_next ? nxt.B : cB;
        const bool fast = ui > 0 && Sched::EPI_STORES > 0 && S.fast_first();
        for (int t = 0; t < nt; t += 2) {
            const bool last = (t == nt - 2);
            const char* a2 = last ? nA : cA + (size_t)(t + 2) * kstep; const char* b2 = last ? nB : cB + (size_t)(t + 2) * kstep;
            const char* a3 = a2 + kstep; const char* b3 = b2 + kstep;
            PG_LDB(B0, 0, 0); PG_SCHED; PG_LDA(At, 0, 0);
            PG_WAIT_L(8); PG_BAR; PG_WAIT_L(0); PG_MMA(0, 0, At, B0); PG_BAR; PG_SCHED;
            if (last && has_next) { PG_AOFFS(ao, nxt); }
            PG_LDB(B1, 0, 1); PG_STAGE(PG_SB(0, 0), b2, voffB);
            PG_BAR; PG_WAIT_L(0); PG_MMA(0, 1, At, B1); PG_BAR;
            PG_LDA(At, 0, 1); PG_STAGE(PG_SA(0, 0), a2, ao[0]);
            PG_BAR; PG_WAIT_L(0); PG_MMA(1, 0, At, B0); PG_BAR; PG_SCHED;
            PG_STAGE(PG_SB(0, 1), b2, voffB1);
            { const int relax_ = (t == 0 && fast) ? 1 : 0;
              asm volatile("v_cmp_ne_u32_e32 vcc, 0, %0\n\ts_cbranch_vccnz .Lrelax_a%=\n\ts_waitcnt vmcnt(6)\n\ts_branch .Lrelax_b%=\n.Lrelax_a%=:\n\ts_waitcnt vmcnt(%1)\n.Lrelax_b%=:" :: "v"(relax_), "n"(6 + Sched::EPI_STORES) : "memory", "vcc"); }
            PG_BAR; PG_MMA(1, 1, At, B1); PG_BAR;
            PG_LDB(B0, 1, 0); PG_SCHED; PG_LDA(At, 1, 0); PG_STAGE(PG_SA(0, 1), a2, ao[1]);
            PG_WAIT_L(8); PG_BAR; PG_WAIT_L(0); PG_MMA(0, 0, At, B0); PG_BAR; PG_SCHED;
            PG_LDB(B1, 1, 1); PG_STAGE(PG_SB(1, 0), b3, voffB);
            PG_BAR; PG_WAIT_L(0); PG_MMA(0, 1, At, B1); PG_BAR;
            PG_LDA(At, 1, 1); PG_STAGE(PG_SA(1, 0), a3, ao[0]);
            PG_BAR; PG_WAIT_L(0); PG_MMA(1, 0, At, B0); PG_BAR; PG_SCHED;
            PG_STAGE(PG_SB(1, 1), b3, voffB1);
            PG_WAIT_V(6); PG_BAR; PG_STAGE(PG_SA(1, 1), a3, ao[1]); PG_MMA(1, 1, At, B1); PG_BAR;
        }
        { const int t2 = tid_here(), w2 = t2 >> 6, l2 = t2 & 63; S.epi(acc, cur, w2 >> 2, w2 & 3, l2 & 15, l2 >> 4); }
        if (!has_next) break;
#pragma unroll
        for (int a = 0; a < 2; ++a)
#pragma unroll
            for (int b = 0; b < 2; ++b)
#pragma unroll
                for (int m = 0; m < 4; ++m)
#pragma unroll
                    for (int n = 0; n < 2; ++n) acc[a][b][m][n] = (f32x4){0.f, 0.f, 0.f, 0.f};
        cur = nxt; cA = nA; cB = nB; ++ui;
    }
    PG_WAIT_V(0);
    if (wr == 0) PG_BAR;
    PG_BAR;
#undef PG_SA
#undef PG_SB
#undef PG_STAGE
#undef PG_LDA
#undef PG_LDB
#undef PG_MMA
#undef PG_WAIT_V
#undef PG_WAIT_L
#undef PG_BAR
#undef PG_SCHED
#undef PG_AOFFS
}
}

DI float wave_max(float v, int lane) {
#define DPP_MAX(v, ctrl) (v) = fmaxf((v), __int_as_float(__builtin_amdgcn_update_dpp(0, __float_as_int(v), (ctrl), 0xF, 0xF, true)))
    DPP_MAX(v, 0xB1); DPP_MAX(v, 0x4E); DPP_MAX(v, 0x141); DPP_MAX(v, 0x140);
#undef DPP_MAX
    v = fmaxf(v, shx(v, 16, lane));
    { auto rr = __builtin_amdgcn_permlane32_swap(__float_as_uint(v), __float_as_uint(v), false, false); v = fmaxf(__uint_as_float(rr[0]), __uint_as_float(rr[1])); }
    return v;
}
DI void router_group(PR p, int l, float* LG, int row0, bool dry, int stage, int* count_out, unsigned base_in) {
    const int lane = tid_here() & 63;
    const unsigned char* wl = p.ws + WS_WEIGHTS + (size_t)l * WL_END;
    const bf16_t* WH = (const bf16_t*)(wl + WL_WRH);
    const bf16_t* HH = (const bf16_t*)(p.ws + WS_HBUF);
    int* EIDX = (int*)(p.ws + WS_EIDX); float* EW = (float*)(p.ws + WS_EW); int* EPOS = (int*)(p.ws + WS_EPOS);
    unsigned* cnt = (unsigned*)(p.ws + WS_CNT) + l * 64;
    const float rbias = p.router_b[l * 64 + lane];
    int* PKI = (int*)(LG + 16 * 65);
    const int fr = lane & 15, fq = lane >> 4;
    if (stage == 2) {
#pragma unroll
        for (int t = 0; t < 16; ++t) { const int pk = PKI[t * 64 + lane]; if (pk >= 0) EPOS[(row0 + t) * 8 + (pk & 255)] = (int)base_in + (pk >> 8); }
        asm volatile("s_waitcnt lgkmcnt(0)" ::: "memory");
        __builtin_amdgcn_wave_barrier();
        return;
    }
    {
        f32x4 acc[4];
#pragma unroll
        for (int e = 0; e < 4; ++e) acc[e] = (f32x4){0.f, 0.f, 0.f, 0.f};
        const bf16_t* ah = HH + (size_t)(row0 + fr) * D + fq * 8;
        const bf16_t* bh = WH + (size_t)fr * D + fq * 8;
        bf16x8 aA[4], bA[4][4], aB[4], bB[4][4];
#define RT_LOAD(a_, b_, k0_) do { _Pragma("unroll") for (int j = 0; j < 4; ++j) { a_[j] = *(const bf16x8*)(ah + (k0_) + 32 * j); \
        _Pragma("unroll") for (int e = 0; e < 4; ++e) b_[j][e] = *(const bf16x8*)(bh + (size_t)e * 16 * D + (k0_) + 32 * j); } } while (0)
#define RT_MMA(a_, b_) do { _Pragma("unroll") for (int j = 0; j < 4; ++j) _Pragma("unroll") for (int e = 0; e < 4; ++e) acc[e] = __builtin_amdgcn_mfma_f32_16x16x32_bf16(a_[j], b_[j][e], acc[e], 0, 0, 0); } while (0)
        RT_LOAD(aA, bA, 0);
#pragma unroll 1
        for (int k0 = 0; k0 < D; k0 += 256) {
            RT_LOAD(aB, bB, k0 + 128);
            RT_MMA(aA, bA);
            if (k0 + 256 < D) RT_LOAD(aA, bA, k0 + 256);
            RT_MMA(aB, bB);
        }
#undef RT_LOAD
#undef RT_MMA
#pragma unroll
        for (int e = 0; e < 4; ++e)
#pragma unroll
            for (int i = 0; i < 4; ++i) LG[(fq * 4 + i) * 65 + e * 16 + fr] = acc[e][i];
        asm volatile("s_waitcnt lgkmcnt(0)" ::: "memory");
        __builtin_amdgcn_wave_barrier();
        int mycount = 0;
        constexpr int RT_TU = 4;
        for (int t0 = 0; t0 < 16; t0 += RT_TU) {
            float sc[RT_TU], v[RT_TU], cand[RT_TU]; int erk[RT_TU];
#pragma unroll
            for (int u = 0; u < RT_TU; ++u) { sc[u] = sigmoid_f(LG[(t0 + u) * 65 + lane]); v[u] = sc[u] + rbias; }
            float m1[RT_TU], m2[RT_TU];
#pragma unroll
            for (int u = 0; u < RT_TU; ++u) { m1[u] = v[u]; m2[u] = -INFINITY; }
#pragma unroll
            for (int o = 1; o < 8; o <<= 1) {
#pragma unroll
                for (int u = 0; u < RT_TU; ++u) { const float b1 = shx(m1[u], o, lane), b2 = shx(m2[u], o, lane); const float n1 = fmaxf(m1[u], b1), n2 = fmaxf(fminf(m1[u], b1), fmaxf(m2[u], b2)); m1[u] = n1; m2[u] = n2; } }
            const int g = lane >> 3;
#pragma unroll
            for (int u = 0; u < RT_TU; ++u) { const float gs = m1[u] + m2[u]; int grank = 0;
#pragma unroll
                for (int gg = 0; gg < 8; ++gg) { const float s_ = __int_as_float(__builtin_amdgcn_readlane(__float_as_int(gs), gg * 8)); grank += (s_ > gs || (s_ == gs && gg < g)) ? 1 : 0; }
                cand[u] = grank < 4 ? v[u] : -INFINITY; erk[u] = -1; }
#pragma unroll 1
            for (int k = 0; k < 8; ++k) {
                float m[RT_TU];
#pragma unroll
                for (int u = 0; u < RT_TU; ++u) m[u] = wave_max(cand[u], lane);
#pragma unroll
                for (int u = 0; u < RT_TU; ++u) { const unsigned long long bal = __ballot(cand[u] == m[u]); const int win = __builtin_amdgcn_readfirstlane((int)__builtin_ctzll(bal));
                    if (lane == win) { erk[u] = k; cand[u] = -INFINITY; } }
            }
#pragma unroll
            for (int u = 0; u < RT_TU; ++u) { const int t = t0 + u;
                const bool chosen = erk[u] >= 0;
                const float wsum = wave_sum(chosen ? sc[u] : 0.f);
                int pk = -1;
                if (chosen) { const int a = (row0 + t) * 8 + erk[u]; EIDX[a] = lane; EW[a] = sc[u] * (2.5f / wsum); pk = erk[u] | (mycount << 8); ++mycount; }
                PKI[t * 64 + lane] = pk; }
        }
        if (stage == 1) { *count_out = mycount; asm volatile("s_waitcnt lgkmcnt(0)" ::: "memory"); __builtin_amdgcn_wave_barrier(); return; }
        const unsigned base = (mycount && !dry) ? atomicAdd(&cnt[lane], (unsigned)mycount) : 0u;
        if (!dry) {
#pragma unroll
            for (int t = 0; t < 16; ++t) { const int pk = PKI[t * 64 + lane]; if (pk >= 0) EPOS[(row0 + t) * 8 + (pk & 255)] = (int)base + (pk >> 8); }
        }
        asm volatile("s_waitcnt lgkmcnt(0)" ::: "memory");
        __builtin_amdgcn_wave_barrier();
    }
}
DI void phase_router(PR p, int l, char* lds, bool dry = false) {
    const int tid = tid_here(), wid = __builtin_amdgcn_readfirstlane(tid >> 6), lane = tid & 63, G = (int)gridDim.x;
    const int ntok = l == 0 ? NTOK : NLAT, ngrp = ntok / 16, iters = (ngrp + G * 8 - 1) / (G * 8);
    float* LGw = (float*)lds + wid * (16 * 65 + 16 * 64);
    volatile LAS int* CW = (volatile LAS int*)((LAS char*)lds + 8 * (16 * 65 + 16 * 64) * 4);
    unsigned* cnt = (unsigned*)(p.ws + WS_CNT) + l * 64;
    for (int it = 0; it < iters; ++it) {
        const int gidx = wid * G + bid_here() + it * G * 8; const bool has = gidx < ngrp;
        int mc = 0;
        if (has) router_group(p, l, LGw, gidx * 16, dry, 1, &mc);
        CW[wid * 64 + lane] = has ? mc : 0;
        __syncthreads();
        if (wid == 0) { int tot = 0;
#pragma unroll
            for (int w = 0; w < 8; ++w) tot += CW[w * 64 + lane];
            CW[512 + lane] = (tot && !dry) ? (int)atomicAdd(&cnt[lane], (unsigned)tot) : 0; }
        __syncthreads();
        if (has && !dry) { unsigned b = (unsigned)CW[512 + lane]; for (int w = 0; w < wid; ++w) b += (unsigned)CW[w * 64 + lane]; router_group(p, l, LGw, gidx * 16, dry, 2, nullptr, b); }
        __syncthreads();
    }
}
DI void phase_moe_index(PR p, int l, char* lds) {
    const int tid = tid_here();
    int* S = (int*)lds;
    const unsigned* cnt = (const unsigned*)(p.ws + WS_CNT) + l * 64;
    int* META = (int*)(p.ws + WS_META) + l * 1024;
    const int* EIDX = (const int*)(p.ws + WS_EIDX); int* EPOS = (int*)(p.ws + WS_EPOS);
    int* SASG = (int*)(p.ws + WS_SASG);
    if (tid < 64) {
        const int c = (int)cnt[tid]; S[128 + tid] = c;
        const float padded = (float)((c + 255) / 256 * 256), incl = wave_scan_incl(padded);
        S[tid] = (int)(incl - padded); if (tid == 63) S[64] = (int)incl; }
    __syncthreads();
    const int ntok = l == 0 ? NTOK : NLAT;
    for (int a = bid_here() * NTHREADS + tid; a < ntok * 8; a += gridDim.x * NTHREADS) { const int e = EIDX[a], pos = S[e] + EPOS[a]; SASG[pos] = a; EPOS[a] = pos; }
    for (int i = bid_here() * NTHREADS + tid; i < 64 * 256; i += gridDim.x * NTHREADS) { const int e = i >> 8, q = i & 255, c = S[128 + e]; if (S[e] + c + q < S[e + 1]) SASG[S[e] + c + q] = -1; }
    if (blockIdx.x == 0) {
        if (tid == 0) META[0] = S[64] / 256;
        if (tid < 64) { for (int t = S[tid] / 256; t < S[tid + 1] / 256; ++t) META[256 + t] = tid; }
    }
}

struct OrderXcd {
    int nM, nN, nwg;
    DI void init(int nM_, int nN_) { nM = nM_; nN = nN_; nwg = nM_ * nN_; }
    DI bool map(int i, int& pm, int& pn) const {
        const int L = i * (int)gridDim.x + (int)blockIdx.x; if (L >= nwg) return false;
        int wgid = L; { const int q = nwg / 8, r = nwg % 8, xcd = wgid % 8, off = wgid / 8; wgid = (xcd < r ? xcd * (q + 1) : r * (q + 1) + (xcd - r) * q) + off; }
        const int nig = 8 * nN, gid = wgid / nig, fm = gid * 8, gsz = (nM - fm) < 8 ? (nM - fm) : 8;
        pm = fm + ((wgid % nig) % gsz); pn = (wgid % nig) / gsz; return true;
    }
    DI bool lin(int i, int& w) const {
        const int L = i * (int)gridDim.x + (int)blockIdx.x; if (L >= nwg) return false;
        const int q = nwg / 8, r = nwg % 8, xcd = L % 8, off = L / 8; w = (xcd < r ? xcd * (q + 1) : r * (q + 1) + (xcd - r) * q) + off; return true;
    }
};
#define GACC const f32x4 (&acc)[2][2][4][2]
struct SchedInproj {
    static constexpr int PERM = 1; static constexpr int F8 = INPROJ_FP8; static constexpr int EPI_STORES = 16; DI bool fast_first() const { return true; } static constexpr int STAGGER = 0;
    int lda, ldb, K, rowshift; const char* A; const char* W; bf16_t* proj; OrderXcd o;
    DI bool next(int i, pg::XUnit& u) const { int pm, pn; if (!o.map(i, pm, pn)) return false; u.A = A; u.B = W + (size_t)pn * 256 * ldb; u.arow0 = pm * 256; u.list = -1; u.e0 = pm * 256; u.e1 = pn * 256; return true; }
    DI void epi(GACC, const pg::XUnit& u, int wr, int wc, int fr, int fq) const { EpiB16P E; E.O = proj; E.row0 = u.e0; E.col0 = u.e1; E.ld = INWP; E.mul = INPROJ_FP8 ? F8_INV1 : 1.f; E(acc, wr, wc, fr, fq); }
};
DI void phase_inproj(PR p, int l, char* lds) {
    SchedInproj S; S.lda = INPROJ_FP8 ? D : D * 2; S.ldb = S.lda; S.K = INPROJ_FP8 ? D / 2 : D; S.rowshift = 0; S.A = INPROJ_FP8 ? (const char*)(p.ws + WS_U + U_Y) : (const char*)(p.ws + WS_HBUF); S.W = (const char*)(p.ws + WS_WEIGHTS + (size_t)l * WL_END + WL_WIN);
    S.proj = (bf16_t*)(p.ws + WS_U + U_PROJ); S.o.init(68, 15);
    pg::gemm_phase((LAS unsigned char*)lds, (const LAS int*)(lds + pg::STAGE_BYTES), S);
}
struct SchedMlaUp {
    static constexpr int PERM = 0; static constexpr int F8 = 0; static constexpr int EPI_STORES = 0; DI bool fast_first() const { return false; } static constexpr int STAGGER = 0;
    int lda, ldb, K, rowshift; const char* CQ; const char* CKV; const char* WQ; const char* WKV; bf16_t* Qm; bf16_t* Km; bf16_t* Vm; const float2* ropem; OrderXcd o;
    DI bool next(int i, pg::XUnit& u) const { int w; if (!o.lin(i, w)) return false; u.list = -1;
        if (w < 340) { const int pm = w / 5, pn = w % 5; u.A = CQ; u.B = WQ + (size_t)pn * 256 * ldb; u.arow0 = pm * 256; u.e0 = pm * 256; u.e1 = pn * 256; u.e3 = 0; }
        else { const int v = w - 340, pm = v / 6, pn = v % 6; u.A = CKV; u.B = WKV + (size_t)pn * 256 * ldb; u.arow0 = pm * 256; u.e0 = pm * 256; u.e1 = pn * 256; u.e3 = 1; }
        return true; }
    DI void epi(GACC, const pg::XUnit& u, int wr, int wc, int fr, int fq) const {
        if (u.e3 == 0) { EpiUq E; E.Q = Qm; E.ropem = ropem; E.row0 = u.e0; E.col0 = u.e1; E(acc, wr, wc, fr, fq); }
        else { EpiUkv E; E.Km = Km; E.Vm = Vm; E.row0 = u.e0; E.col0 = u.e1; E(acc, wr, wc, fr, fq); } }
};
DI void phase_mla_up(PR p, int l, char* lds) {
    unsigned char* U = p.ws + WS_U; const unsigned char* wl = p.ws + WS_WEIGHTS + (size_t)l * WL_END;
    SchedMlaUp S; S.lda = 1024; S.ldb = 1024; S.K = 512; S.rowshift = 0; S.CQ = (const char*)(U + U_CQN); S.CKV = (const char*)(U + U_CKVN); S.WQ = (const char*)(wl + WL_WUQ); S.WKV = (const char*)(wl + WL_WUKV);
    S.Qm = (bf16_t*)(U + U_QM); S.Km = (bf16_t*)(U + U_KM); S.Vm = (bf16_t*)(U + U_VM); S.ropem = (const float2*)(p.ws + WS_ROPEM); S.o.init(748, 1);
    pg::gemm_phase((LAS unsigned char*)lds, (const LAS int*)(lds + pg::STAGE_BYTES), S);
}
struct SchedOutproj {
    static constexpr int PERM = 1; static constexpr int F8 = OUTPROJ_FP8; static constexpr int EPI_STORES = 16; DI bool fast_first() const { return true; } static constexpr int STAGGER = 0;
    int lda, ldb, K, rowshift; const char* A; const char* W; bf16_t* Y; OrderXcd o;
    DI bool next(int i, pg::XUnit& u) const { int pm, pn; if (!o.map(i, pm, pn)) return false; u.A = A; u.B = W + (size_t)pn * 256 * ldb; u.arow0 = pm * 256; u.list = -1; u.e0 = pm * 256; u.e1 = pn * 256; return true; }
    DI void epi(GACC, const pg::XUnit& u, int wr, int wc, int fr, int fq) const { EpiB16P E; E.O = Y; E.row0 = u.e0; E.col0 = u.e1; E.ld = D; E.mul = OUTPROJ_FP8 ? F8_INV3 : 1.f; E(acc, wr, wc, fr, fq); }
};
DI void phase_outproj(PR p, int l, char* lds) {
    SchedOutproj S; S.lda = OUTPROJ_FP8 ? D : D * 2; S.ldb = S.lda; S.K = OUTPROJ_FP8 ? D / 2 : D; S.rowshift = 0; S.A = (const char*)(p.ws + WS_U + U_MIX); S.W = (const char*)(p.ws + WS_WEIGHTS + (size_t)l * WL_END + WL_WOUT);
    S.Y = (bf16_t*)(p.ws + WS_U + U_Y); S.o.init(l == 0 ? 68 : 64, 8);
    pg::gemm_phase((LAS unsigned char*)lds, (const LAS int*)(lds + pg::STAGE_BYTES), S);
}
struct SchedMoe1 {
    static constexpr int PERM = 1; static constexpr int F8 = MOE_FP8; static constexpr int EPI_STORES = 8; DI bool fast_first() const { return !dry; } static constexpr int STAGGER = STAG_MOE1;
    int lda, ldb, K, rowshift; const char* H; const char* W13; bf16_t* act; const LAS int* uexp; int ntiles; int dry; OrderXcd o;
    DI bool next(int i, pg::XUnit& u) const { int tile, pn; if (!o.map(i, tile, pn)) return false; u.A = H;
        if (tile < ntiles) { const int e = __builtin_amdgcn_readfirstlane(uexp[i]); u.B = W13 + ((size_t)e * 1024 + pn * 256) * ldb; u.list = i * 256; u.arow0 = 0; u.e0 = tile * 256; }
        else { const int ts = tile - ntiles; u.B = W13 + ((size_t)64 * 1024 + pn * 256) * ldb; u.list = -1; u.arow0 = ts * 256; u.e0 = PMAX + ts * 256; }
        u.e1 = pn * 128; return true; }
    DI void epi(GACC, const pg::XUnit& u, int wr, int wc, int fr, int fq) const {
        if (dry) { _Pragma("unroll") for (int a_ = 0; a_ < 2; ++a_) _Pragma("unroll") for (int b_ = 0; b_ < 2; ++b_) _Pragma("unroll") for (int m_ = 0; m_ < 4; ++m_) asm volatile("" :: "v"(acc[a_][b_][m_][0]), "v"(acc[a_][b_][m_][1])); return; }
        if constexpr (MOE_FP8) { EpiMoe1F8 E; E.act = (unsigned char*)act; E.arow0 = u.e0; E.hcol0 = u.e1; E(acc, wr, wc, fr, fq); }
        else { EpiMoe1P E; E.act = act; E.arow0 = u.e0; E.hcol0 = u.e1; E(acc, wr, wc, fr, fq); } }
};
DI void phase_moe1(PR p, int l, char* lds, int dry = 0) {
    const int* META = (const int*)(p.ws + WS_META) + l * 1024; const int ntiles = __builtin_amdgcn_readfirstlane(META[0]), nsh = l == 0 ? 68 : 64;
    SchedMoe1 S; S.lda = MOE_FP8 ? D : D * 2; S.ldb = S.lda; S.K = MOE_FP8 ? D / 2 : D; S.rowshift = 3; S.H = MOE_FP8 ? (const char*)(p.ws + WS_U + U_HLO) : (const char*)(p.ws + WS_HBUF);
    S.W13 = (const char*)(p.ws + WS_WEIGHTS + (size_t)l * WL_END + WL_W13);
    S.act = (bf16_t*)(p.ws + WS_U + U_ACT); S.uexp = (const LAS int*)(lds + pg::STAGE_BYTES) + 31 * 256; S.ntiles = ntiles; S.dry = dry; S.o.init(ntiles + nsh, 4);
    { const int tid = tid_here(); LAS int* RL = (LAS int*)(lds + pg::STAGE_BYTES); const int* SASG = (const int*)(p.ws + WS_SASG);
      for (int i = 0; i < 31; ++i) { int tile, pn; if (!S.o.map(i, tile, pn)) break; if (tile < ntiles && tid < 256) RL[i * 256 + tid] = SASG[tile * 256 + tid];
          if (tid == 0) RL[31 * 256 + i] = tile < ntiles ? META[256 + tile] : 64; }
      __syncthreads(); }
    pg::gemm_phase((LAS unsigned char*)lds, (const LAS int*)(lds + pg::STAGE_BYTES), S);
}
struct SchedMoe2 {
    static constexpr int PERM = 2; static constexpr int F8 = MOE_FP8; static constexpr int EPI_STORES = 8; DI bool fast_first() const { return !dry; } static constexpr int STAGGER = STAG_MOE2;
    int lda, ldb, K, rowshift; const char* ACT; const char* W2; bf16_t* oasg; const int* sasg; const float* sw; bf16_t* ysh; const LAS int* uexp; int ntiles; int fp8; int dry; OrderXcd o;
    DI bool next(int i, pg::XUnit& u) const { int tile, pn; if (!o.map(i, tile, pn)) return false; u.A = ACT; u.list = -1;
        if (tile < ntiles) { const int e = __builtin_amdgcn_readfirstlane(uexp[i]); u.B = W2 + ((size_t)e * D + pn * 256) * ldb; u.arow0 = tile * 256; u.e0 = tile * 256; u.e3 = 0; }
        else { const int ts = tile - ntiles; u.B = W2 + ((size_t)64 * D + pn * 256) * ldb; u.arow0 = PMAX + ts * 256; u.e0 = ts * 256; u.e3 = 1; }
        u.e1 = pn * 256; return true; }
    DI void epi(GACC, const pg::XUnit& u, int wr, int wc, int fr, int fq) const {
        if (dry) { _Pragma("unroll") for (int a_ = 0; a_ < 2; ++a_) _Pragma("unroll") for (int b_ = 0; b_ < 2; ++b_) _Pragma("unroll") for (int m_ = 0; m_ < 4; ++m_) asm volatile("" :: "v"(acc[a_][b_][m_][0]), "v"(acc[a_][b_][m_][1])); return; }
        if (u.e3 == 0 && fp8) { EpiMoe2F8W E; E.oasg = (unsigned char*)oasg; E.srow0 = u.e0; E.col0 = u.e1; E(acc, wr, wc, fr, fq); }
        else if (u.e3 == 0) { EpiMoe2W E; E.oasg = oasg; E.sasg = sasg; E.sw = sw; E.srow0 = u.e0; E.col0 = u.e1; E(acc, wr, wc, fr, fq); }
        else { EpiB16W E; E.O = ysh; E.row0 = u.e0; E.col0 = u.e1; E.ld = D; E(acc, wr, wc, fr, fq); } }
};
DI void phase_moe2(PR p, int l, char* lds, int dry = 0) {
    const int* META = (const int*)(p.ws + WS_META) + l * 1024; const int ntiles = __builtin_amdgcn_readfirstlane(META[0]), nsh = l == 0 ? 68 : 64;
    SchedMoe2 S; S.lda = MOE_FP8 ? 512 : 1024; S.ldb = S.lda; S.K = MOE_FP8 ? 256 : 512; S.rowshift = 0; S.ACT = (const char*)(p.ws + WS_U + U_ACT); S.W2 = (const char*)(p.ws + WS_WEIGHTS + (size_t)l * WL_END + WL_W2);
    S.oasg = (bf16_t*)(p.ws + WS_U + U_OASG); S.sasg = (const int*)(p.ws + WS_SASG); S.sw = (const float*)(p.ws + WS_EW); S.ysh = (bf16_t*)(p.ws + WS_U + U_YSH); S.uexp = (const LAS int*)(lds + pg::STAGE_BYTES); S.ntiles = ntiles; S.fp8 = (OASG_FP8_MASK >> l) & 1; S.dry = dry; S.o.init(ntiles + nsh, 8);
    { const int tid = tid_here(); LAS int* UE = (LAS int*)(lds + pg::STAGE_BYTES);
      if (tid < 64) { int tile, pn; if (S.o.map(tid, tile, pn)) UE[tid] = tile < ntiles ? META[256 + tile] : 64; }
      __syncthreads(); }
    pg::gemm_phase((LAS unsigned char*)lds, (const LAS int*)(lds + pg::STAGE_BYTES), S);
}
DI void phase_attention(PR p, int l, char* lds, int sub = SUB, int side_on = 1, int qsel = 0) {
#define ATT_PTRS unsigned char* U = p.ws + WS_U; asm volatile("" : "+s"(U)); \
    const bf16_t* Qm = (const bf16_t*)(U + U_QM); const bf16_t* Km = (const bf16_t*)(U + U_KM); const bf16_t* Vm = (const bf16_t*)(U + U_VM); \
    const bf16_t* Qg = (const bf16_t*)(U + U_QG); const bf16_t* Kg = (const bf16_t*)(U + U_KG); const bf16_t* Vg = (const bf16_t*)(U + U_VG); bf16_t* MIX = (bf16_t*)(U + U_MIX);
    const int xcd = blockIdx.x & 7, rank = blockIdx.x >> 3, nr = (gridDim.x + 7 - xcd) >> 3;
    const int nloc = 48 + (l == 0 ? 3 : 0);
    SideCvt sc; { const int wid_ = __builtin_amdgcn_readfirstlane(tid_here() >> 6), G = (int)gridDim.x, mt0 = (int)blockIdx.x * 8 + wid_, total = CHUNKS_PER_LAYER * 16, stride = 8 * G, c0 = mt0 >> 4, cstep = stride >> 4;
        sc.l = l; sc.sub = mt0 & 15; sc.e = c0 / 192; sc.r = c0 % 192; sc.de = cstep / 192; sc.dr = cstep % 192; sc.dry = qsel;
        sc.rem = (SIDE_STREAM && side_on && mt0 < total) ? (total - mt0 + stride - 1) / stride : 0; }
    const int cslot = CVT_IN_ATT ? (int)((blockIdx.x >> 3) & 3) : -1;
    if (cslot == 0) cvt_static(p, lds, l);
    if (sub & 1) for (int v = rank; v < nloc; v += nr) {
        ATT_PTRS; (void)Qg; (void)Kg; (void)Vg;
        int b, h, qt, isctx;
        if (v < 48) { const int bh = xcd * 3 + v / 16; b = bh / 6; h = bh % 6; qt = v & 15; isctx = 0; } else { const int bh = xcd * 3 + (v - 48); b = bh / 6; h = bh % 6; qt = 0; isctx = 1; }
        const int qpos = isctx ? 0 : CTXL + qt * 256, seq = isctx ? CTXL : SKV, orow = isctx ? NLAT + b * CTXL : b * SEQ + qt * 256;
        ATT_BODY<192>(Qm + (((size_t)b * 6 + h) * SKV + qpos) * 192, Km + ((size_t)b * 6 + h) * SKV * 192, Vm + ((size_t)b * 6 + h) * SKV * 128,
                                 OUTPROJ_FP8 ? (bf16_t*)((unsigned char*)MIX + (size_t)orow * D + 512 + h * 128) : MIX + (size_t)orow * D + 512 + h * 128, D, seq, lds, 0.07216878364870322f, p, sc);
    }
    if (cslot == 1) cvt_static(p, lds, l);
    if (sub & 2) for (int v = nr - 1 - rank; v < nloc; v += nr) {
        ATT_PTRS; (void)Qm; (void)Km; (void)Vm;
        int b, h, qt, isctx; const int kvh = xcd & 1; b = xcd >> 1;
        if (v < 48) { h = kvh * 3 + v / 16; qt = v & 15; isctx = 0; } else { h = kvh * 3 + (v - 48); qt = 0; isctx = 1; }
        const int qpos = isctx ? 0 : CTXL + qt * 256, seq = isctx ? CTXL : SKV, orow = isctx ? NLAT + b * CTXL : b * SEQ + qt * 256;
        ATT_BODY<128>(Qg + (((size_t)b * 6 + h) * SKV + qpos) * 128, Kg + ((size_t)b * 2 + kvh) * SKV * 128, Vg + ((size_t)b * 2 + kvh) * SKV * 128,
                                 OUTPROJ_FP8 ? (bf16_t*)((unsigned char*)MIX + (size_t)orow * D + 1280 + h * 128) : MIX + (size_t)orow * D + 1280 + h * 128, D, seq, lds, 0.08838834764831845f, p, sc);
    }
#undef ATT_PTRS
    if (cslot == 2) cvt_static(p, lds, l);
    if (SIDE_STREAM) { const int t_ = tid_here(); side_cleanup(p, sc, t_ & 63); __syncthreads(); }
    if (sub & 4) gla_phaseC(p, l, lds, qsel);
    if (cslot == 3) cvt_static(p, lds, l);
}

constexpr int NPH_LAYER = 12, NPH = 1 + 2 * NPH_LAYER;
constexpr int LDS_BYTES = 160 * 1024;
__global__ void __launch_bounds__(NTHREADS, 2) fwd(Params p_arg, int ph_lo, int ph_hi) {
    char* lds = shm + 256;
    volatile LAS unsigned* xbw = (volatile LAS unsigned*)shm;
    const bool fused = (ph_hi - ph_lo) > 1;
    XcdBarrier bar; bar.bar = (unsigned*)(p_arg.ws + WS_BAR); bar.x = 0; bar.st = xbw;
    if (fused) {
        if (threadIdx.x == 0) { xbw[0] = 0u; xbw[1] = 0u; xbw[2] = 0u; xbw[3] = 0u; }
        __syncthreads();
        bar = xcd_barrier_post((unsigned*)(p_arg.ws + WS_BAR), xbw);
    }
    const CAS Params* pk = (const CAS Params*)__builtin_amdgcn_kernarg_segment_ptr();
#define PHASE(idx, CALL) do { if (((PH_MASK >> ((idx) == 0 ? 0 : ((idx) - 1) % NPH_LAYER + 1)) & 1) && (idx) >= ph_lo && (idx) < ph_hi) { const CAS Params* q_ = pk; asm volatile("" : "+s"(q_)); PR p = *q_; int probe_pass = 0; (void)probe_pass; CALL; if ((PROBE_MASK >> ((idx) == 0 ? 0 : ((idx) - 1) % NPH_LAYER + 1)) & 1) { probe_pass = 1; CALL; } if (fused && (idx) + 1 < ph_hi) xcd_barrier(bar); } } while (0)
#define TAIL(ph) ((!CVT_IN_ATT && !SIDE_STREAM && fused && !probe_pass) ? fill_tail(p, lds, (ph)) : (void)0)
    PHASE(0, phase_prologue(p, lds));
    for (int l = 0; l < 2; ++l) {
        const int b0 = 1 + l * NPH_LAYER;
        if (l == 0) PHASE(b0 + 0, phase_norm1(p, 0));
        PHASE(b0 + 1, phase_inproj(p, l, lds));
        PHASE(b0 + 2, (phase_postproj_rows(p, l), gla_phaseA(p, l, lds)));
        PHASE(b0 + 3, (phase_mla_up(p, l, lds), gla_scan(p)));
        PHASE(b0 + 4, (phase_attention(p, l, lds, probe_pass ? PROBE_SUB : SUB, probe_pass ? PROBE_SIDE : 1, probe_pass), TAIL(b0 + 4)));
        PHASE(b0 + 5, phase_outproj(p, l, lds));
        PHASE(b0 + 6, ((probe_pass && l == 1) ? (void)0 : phase_postmix(p, l, lds, FUSE_ROUTER && !probe_pass)));
        if (!FUSE_ROUTER) PHASE(b0 + 7, phase_router(p, l, lds, probe_pass != 0));
        PHASE(b0 + 8, (phase_moe_index(p, l, lds), ((CVT_IN_ATT || SIDE_STREAM) ? (void)0 : fill_drain(p, lds, (l + 1) * CHUNKS_PER_LAYER))));
        PHASE(b0 + 9, (((CVT_IN_ATT || SIDE_STREAM) ? (void)0 : move_head(p, (l + 1) * CHUNKS_PER_LAYER)), phase_moe1(p, l, lds, PROBE_DRY && probe_pass), TAIL(b0 + 9)));
        PHASE(b0 + 10, (phase_moe2(p, l, lds, PROBE_DRY && probe_pass), TAIL(b0 + 10)));
        PHASE(b0 + 11, ((probe_pass && l == 0) ? (void)0 : phase_postffn(p, l, lds)));
    }
#undef PHASE
#undef TAIL
}

extern "C" void kernel_launch(void* const* d_in, const int* in_sizes, int n_in, void* d_out, int out_size, void* d_ws, size_t ws_size, hipStream_t stream) {
    static int grid = 0;
    if (!grid) {
        if (ws_size < WS_TOTAL) { fprintf(stderr, "kernel_launch: workspace too small: %zu < %zu\n", ws_size, (size_t)WS_TOTAL); return; }
        if (hipFuncSetAttribute((const void*)fwd, hipFuncAttributeMaxDynamicSharedMemorySize, LDS_BYTES) != hipSuccess) { fprintf(stderr, "kernel_launch: hipFuncSetAttribute failed\n"); return; }
        int dev = 0, cus = 0, per_cu = 0;
        hipGetDevice(&dev);
        hipDeviceGetAttribute(&cus, hipDeviceAttributeMultiprocessorCount, dev);
        hipOccupancyMaxActiveBlocksPerMultiprocessor(&per_cu, fwd, NTHREADS, LDS_BYTES);
        if (per_cu < 1) { fprintf(stderr, "kernel_launch: occupancy query says %d\n", per_cu); return; }
        grid = cus & ~1;
    }
    Params p{};
    const float** f = (const float**)&p;
    for (int i = 0; i < 31; ++i) f[i] = (const float*)d_in[i];
    p.out = (float*)d_out; p.ws = (unsigned char*)d_ws;
    hipMemsetAsync((unsigned char*)d_ws + WS_BAR, 0, WS_CNT, stream);
#if MK_MULTI
    for (int ph = 0; ph < NPH; ++ph) { if (ph == 1 + NPH_LAYER) continue; hipLaunchKernelGGL(fwd, dim3(grid), dim3(NTHREADS), LDS_BYTES, stream, p, ph, ph + 1); }
#else
    hipLaunchKernelGGL(fwd, dim3(grid), dim3(NTHREADS), LDS_BYTES, stream, p, 0, NPH);
#endif
    const hipError_t le = hipPeekAtLastError();
    if (le != hipSuccess) fprintf(stderr, "kernel_launch: launch failed: %s\n", hipGetErrorName(le));
}
```
